# Optimizing an MI355X kernel written in HIP

```python
import jax, jax.numpy as jnp
from jax import lax
import numpy as np

D_MODEL = 2048
BATCH = 4
SEQ = 8192
DEPTH = 1
DEC_BATCH = 8
DEC_SEQ = 64
PAST_LEN = 2048

CHUNK = 64
EPS = 1e-6
M_EXPAND = 2
M_D_INNER = M_EXPAND * D_MODEL
M_HEAD_DIM = 64
M_N_HEADS = M_D_INNER // M_HEAD_DIM
M_N_GROUPS = 8
M_D_STATE = 128
M_D_CONV = 4
M_CONV_DIM = M_D_INNER + 2 * M_N_GROUPS * M_D_STATE
F_N_HEADS = 16
F_HEAD_DIM = 128
F_WIDTH = F_N_HEADS * F_HEAD_DIM
Q_BLOCK = 128
D_FF = 5504
FFN_CONV = 3
N_MOD = 6
IN_SIZES = (M_D_INNER, M_CONV_DIM, M_N_HEADS, F_WIDTH, F_WIDTH, F_WIDTH, F_N_HEADS, D_MODEL, D_MODEL)
IN_COLS = M_D_INNER + M_CONV_DIM + M_N_HEADS + 3 * F_WIDTH + F_N_HEADS + 2 * D_MODEL

kernel_name = "hybrid_ssd_fox_convffn_stream_step"


def _rms(x):
    xf = x.astype(jnp.float32)
    return (xf * lax.rsqrt(jnp.mean(xf * xf, axis=-1, keepdims=True) + EPS)).astype(x.dtype)


def _split_cols(t, sizes):
    outs, off = [], 0
    for s in sizes:
        outs.append(t[..., off:off + s])
        off += s
    return outs


def _causal_dwconv(u, buf, w, b):
    width = w.shape[0]
    L = u.shape[1]
    up = jnp.concatenate([buf.astype(u.dtype), u], axis=1)
    y = b
    for j in range(width):
        y = y + up[:, j:j + L] * w[j]
    return y, up[:, L:]


def _ssd(x, dt, a, bm, cm, h0):
    bsz, L, H, P = x.shape
    G, N = bm.shape[2], bm.shape[3]
    Hg = H // G
    Q = min(CHUNK, L)
    nc = L // Q

    def to_chunks(t):
        return jnp.moveaxis(t.reshape((bsz, nc, Q) + t.shape[2:]), 1, 0)

    xs = (to_chunks(x.reshape(bsz, L, G, Hg, P)), to_chunks(dt.reshape(bsz, L, G, Hg)),
          to_chunks(bm), to_chunks(cm))
    causal = jnp.tril(jnp.ones((Q, Q), dtype=bool))
    a_g = a.astype(jnp.float32).reshape(G, Hg)

    def step(h, inp):
        xc, dtc, bc, cc = inp
        cum = jnp.cumsum(dtc.astype(jnp.float32) * a_g, axis=1)
        seg = cum[:, :, None] - cum[:, None, :]
        lmat = jnp.exp(jnp.where(causal[None, :, :, None, None], seg, -jnp.inf))
        xdt = xc * dtc[..., None]
        cb = jnp.einsum('bqgn,bsgn->bqsg', cc, bc)
        y = jnp.einsum('bqsg,bqsgh,bsghp->bqghp', cb, lmat, xdt)
        y = y + jnp.einsum('bqgn,bghpn->bqghp', cc, h) * jnp.exp(cum)[..., None]
        decay_end = jnp.exp(cum[:, -1:] - cum)
        h = h * jnp.exp(cum[:, -1])[..., None, None] + jnp.einsum('bsgn,bsgh,bsghp->bghpn', bc, decay_end, xdt)
        return h, y.astype(jnp.float32)

    h, ys = lax.scan(step, h0.astype(jnp.float32).reshape(bsz, G, Hg, P, N), xs)
    y = jnp.moveaxis(ys, 0, 1).reshape(bsz, L, H, P).astype(x.dtype)
    return y, h.reshape(bsz, H, P, N).astype(h0.dtype)


def _fox_attention(q, k, v, cum_q, cum_k, pos_q, pos_k):
    bsz, T, H, Dh = q.shape
    QB = min(Q_BLOCK, T)
    nb = T // QB
    scale = Dh ** -0.5
    ck = jnp.swapaxes(cum_k, 1, 2)

    def blocks(t):
        return jnp.moveaxis(t.reshape((bsz, nb, QB) + t.shape[2:]), 1, 0)

    def one(args):
        qi, cqi, pi = args
        s = jnp.einsum('bqhd,bkhd->bhqk', qi, k).astype(jnp.float32) * scale
        s = s + jnp.swapaxes(cqi, 1, 2)[..., None] - ck[:, :, None, :]
        mask = pos_k[None, :] <= pi[:, None]
        p = jax.nn.softmax(jnp.where(mask, s, -jnp.inf), axis=-1)
        return jnp.einsum('bhqk,bkhd->bqhd', p.astype(v.dtype), v)

    o = lax.map(one, (blocks(q), blocks(cum_q), pos_q.reshape(nb, QB)))
    return jnp.moveaxis(o, 0, 1).reshape(bsz, T, H, Dh)


def _layer(x, c, k_past, v_past, logf_past, ssm_h0, mconv_buf, ffn_buf, p):
    bsz, T, _ = x.shape
    p0 = k_past.shape[1]
    mod = jnp.einsum('bd,de->be', jax.nn.silu(c), p['w_ada']) + p['b_ada']
    sh1, sc1, g1, sh2, sc2, g2 = jnp.split(mod, N_MOD, axis=-1)
    h = _rms(x) * p['norm1_w'] * (1 + sc1[:, None]) + sh1[:, None]
    proj = jnp.einsum('btd,de->bte', h, p['w_in'])
    z, xbc, dt_raw, q, k, v, f_raw, gm_raw, gf_raw = _split_cols(proj, IN_SIZES)

    xbc, new_mconv = _causal_dwconv(xbc, mconv_buf, p['m_conv_w'], p['m_conv_b'])
    xbc = jax.nn.silu(xbc)
    xm, bm, cm = _split_cols(xbc, (M_D_INNER, M_N_GROUPS * M_D_STATE, M_N_GROUPS * M_D_STATE))
    xm = xm.reshape(bsz, T, M_N_HEADS, M_HEAD_DIM)
    dt = jax.nn.softplus(dt_raw + p['m_dt_bias'])
    a = -jnp.exp(p['m_a_log'])
    ym, new_h = _ssd(xm, dt, a, bm.reshape(bsz, T, M_N_GROUPS, M_D_STATE),
                     cm.reshape(bsz, T, M_N_GROUPS, M_D_STATE), ssm_h0)
    ym = (ym + xm * p['m_d'][:, None]).reshape(bsz, T, M_D_INNER) * jax.nn.silu(z)
    ym = _rms(ym.reshape(bsz, T, M_N_GROUPS, M_D_INNER // M_N_GROUPS)).reshape(bsz, T, M_D_INNER) * p['m_norm_w']
    ym = jnp.einsum('bte,ed->btd', ym, p['w_proj_m'])

    q = _rms(q.reshape(bsz, T, F_N_HEADS, F_HEAD_DIM)) * p['q_norm_w']
    k = _rms(k.reshape(bsz, T, F_N_HEADS, F_HEAD_DIM)) * p['k_norm_w']
    v = v.reshape(bsz, T, F_N_HEADS, F_HEAD_DIM)
    logf = jax.nn.log_sigmoid((f_raw + p['f_bias']).astype(jnp.float32))
    k_all = jnp.concatenate([k_past.astype(k.dtype), k], axis=1)
    v_all = jnp.concatenate([v_past.astype(v.dtype), v], axis=1)
    cum_all = jnp.cumsum(jnp.concatenate([logf_past.astype(jnp.float32), logf], axis=1), axis=1)
    pos_k = jnp.arange(p0 + T)
    yf = _fox_attention(q, k_all, v_all, cum_all[:, p0:], cum_all, p0 + jnp.arange(T), pos_k)
    yf = jnp.einsum('bte,ed->btd', yf.reshape(bsz, T, F_WIDTH), p['w_proj_f'])

    mix = jax.nn.sigmoid(gm_raw) * ym + jax.nn.sigmoid(gf_raw) * yf
    x = x + g1[:, None] * jnp.einsum('btd,de->bte', mix, p['w_out'])

    h2 = _rms(x) * p['norm2_w'] * (1 + sc2[:, None]) + sh2[:, None]
    u = jnp.einsum('btd,de->bte', h2, p['w_up'])
    u, new_ffn = _causal_dwconv(u, ffn_buf, p['ffn_conv_w'], p['ffn_conv_b'])
    ua, ub = _split_cols(u, (D_FF, D_FF))
    x = x + g2[:, None] * jnp.einsum('btf,fd->btd', jax.nn.silu(ua) * ub, p['w_down'])
    return x, k, v, logf.astype(x.dtype), new_h, new_mconv, new_ffn


def setup_inputs(seed: int = 0) -> dict:
    key = jax.random.key(seed)
    ks = iter(jax.random.split(key, 40))

    def nrm(shape, s=1.0):
        return s * jax.random.normal(next(ks), shape, jnp.float32)

    def uni(shape, lo, hi):
        return jax.random.uniform(next(ks), shape, jnp.float32, lo, hi)

    dt0 = jnp.exp(uni((DEPTH, M_N_HEADS), np.log(1e-3), np.log(1e-1)))
    return {
        "x_prompt": nrm((BATCH, SEQ, D_MODEL)),
        "x_sample": nrm((DEC_BATCH, DEC_SEQ, D_MODEL)),
        "c_prompt": nrm((BATCH, D_MODEL)),
        "c_sample": nrm((DEC_BATCH, D_MODEL)),
        "cache_fox_k": nrm((DEPTH, DEC_BATCH, PAST_LEN, F_N_HEADS, F_HEAD_DIM)),
        "cache_fox_v": nrm((DEPTH, DEC_BATCH, PAST_LEN, F_N_HEADS, F_HEAD_DIM)),
        "cache_fox_logf": jax.nn.log_sigmoid(2.0 + nrm((DEPTH, DEC_BATCH, PAST_LEN, F_N_HEADS))),
        "state_ssm": nrm((DEPTH, DEC_BATCH, M_N_HEADS, M_HEAD_DIM, M_D_STATE), 0.1),
        "state_mamba_conv": nrm((DEPTH, DEC_BATCH, M_D_CONV - 1, M_CONV_DIM)),
        "state_ffn_conv": nrm((DEPTH, DEC_BATCH, FFN_CONV - 1, 2 * D_FF)),
        "norm1_w": 1.0 + nrm((DEPTH, D_MODEL), 0.02),
        "norm2_w": 1.0 + nrm((DEPTH, D_MODEL), 0.02),
        "w_ada": nrm((DEPTH, D_MODEL, N_MOD * D_MODEL), 0.5 * D_MODEL ** -0.5),
        "b_ada": nrm((DEPTH, N_MOD * D_MODEL), 0.02),
        "w_in": nrm((DEPTH, D_MODEL, IN_COLS), D_MODEL ** -0.5),
        "m_conv_w": nrm((DEPTH, M_D_CONV, M_CONV_DIM), M_D_CONV ** -0.5),
        "m_conv_b": nrm((DEPTH, M_CONV_DIM), 0.02),
        "m_dt_bias": dt0 + jnp.log(-jnp.expm1(-dt0)),
        "m_a_log": jnp.log(uni((DEPTH, M_N_HEADS), 1.0, 16.0)),
        "m_d": 1.0 + nrm((DEPTH, M_N_HEADS), 0.02),
        "m_norm_w": 1.0 + nrm((DEPTH, M_D_INNER), 0.02),
        "f_bias": 2.0 + nrm((DEPTH, F_N_HEADS), 0.1),
        "q_norm_w": 1.0 + nrm((DEPTH, F_HEAD_DIM), 0.02),
        "k_norm_w": 1.0 + nrm((DEPTH, F_HEAD_DIM), 0.02),
        "w_proj_m": nrm((DEPTH, M_D_INNER, D_MODEL), M_D_INNER ** -0.5),
        "w_proj_f": nrm((DEPTH, F_WIDTH, D_MODEL), F_WIDTH ** -0.5),
        "w_out": nrm((DEPTH, D_MODEL, D_MODEL), D_MODEL ** -0.5),
        "w_up": nrm((DEPTH, D_MODEL, 2 * D_FF), D_MODEL ** -0.5),
        "ffn_conv_w": nrm((DEPTH, FFN_CONV, 2 * D_FF), FFN_CONV ** -0.5),
        "ffn_conv_b": nrm((DEPTH, 2 * D_FF), 0.02),
        "w_down": nrm((DEPTH, D_FF, D_MODEL), D_FF ** -0.5),
    }


def reference(x_prompt, x_sample, c_prompt, c_sample, cache_fox_k, cache_fox_v, cache_fox_logf,
              state_ssm, state_mamba_conv, state_ffn_conv, norm1_w, norm2_w, w_ada, b_ada, w_in,
              m_conv_w, m_conv_b, m_dt_bias, m_a_log, m_d, m_norm_w, f_bias, q_norm_w, k_norm_w,
              w_proj_m, w_proj_f, w_out, w_up, ffn_conv_w, ffn_conv_b, w_down):
    bp, dtp = x_prompt.shape[0], x_prompt.dtype
    xp, xs = x_prompt, x_sample
    outs_p = [[] for _ in range(6)]
    outs_s = [[] for _ in range(6)]
    for l in range(DEPTH):
        p = {
            'norm1_w': norm1_w[l], 'norm2_w': norm2_w[l], 'w_ada': w_ada[l], 'b_ada': b_ada[l],
            'w_in': w_in[l], 'm_conv_w': m_conv_w[l], 'm_conv_b': m_conv_b[l], 'm_dt_bias': m_dt_bias[l],
            'm_a_log': m_a_log[l], 'm_d': m_d[l], 'm_norm_w': m_norm_w[l], 'f_bias': f_bias[l],
            'q_norm_w': q_norm_w[l], 'k_norm_w': k_norm_w[l], 'w_proj_m': w_proj_m[l], 'w_proj_f': w_proj_f[l],
            'w_out': w_out[l], 'w_up': w_up[l], 'ffn_conv_w': ffn_conv_w[l], 'ffn_conv_b': ffn_conv_b[l],
            'w_down': w_down[l],
        }
        res_p = _layer(xp, c_prompt,
                       jnp.zeros((bp, 0, F_N_HEADS, F_HEAD_DIM), dtp), jnp.zeros((bp, 0, F_N_HEADS, F_HEAD_DIM), dtp),
                       jnp.zeros((bp, 0, F_N_HEADS), dtp), jnp.zeros((bp, M_N_HEADS, M_HEAD_DIM, M_D_STATE), dtp),
                       jnp.zeros((bp, M_D_CONV - 1, M_CONV_DIM), dtp), jnp.zeros((bp, FFN_CONV - 1, 2 * D_FF), dtp), p)
        res_s = _layer(xs, c_sample, cache_fox_k[l], cache_fox_v[l], cache_fox_logf[l], state_ssm[l],
                       state_mamba_conv[l], state_ffn_conv[l], p)
        xp, xs = res_p[0], res_s[0]
        for i in range(6):
            outs_p[i].append(res_p[i + 1])
            outs_s[i].append(res_s[i + 1])
    k_p, v_p, lf_p, ssm_p, mc_p, fc_p = [jnp.stack(o, axis=0) for o in outs_p]
    k_s, v_s, lf_s, ssm_s, mc_s, fc_s = [jnp.stack(o, axis=0) for o in outs_s]
    return (xp, xs, k_p, v_p, lf_p, ssm_p, mc_p, fc_p, k_s, v_s, lf_s, ssm_s, mc_s, fc_s)
```

```cpp
#include <hip/hip_runtime.h>
#include <hip/hip_cooperative_groups.h>
#include <hip/hip_bf16.h>
#include <cstdio>
#include <cstdint>
namespace cg = cooperative_groups;
namespace pg8 {
#define PG8_LAS __attribute__((address_space(3)))
typedef unsigned short bf16_t;
typedef short bf16x8 __attribute__((ext_vector_type(8)));
typedef float f32x4 __attribute__((ext_vector_type(4)));
typedef unsigned u32x4 __attribute__((ext_vector_type(4)));
constexpr int BM = 256, BK = 64, HALF = 128, HTB = HALF * BK * 2  , STAGE_BYTES = 8 * HTB, NXCD = 8, WGM = 8;

__host__ __device__ __forceinline__ int lds_byte(int r, int c) { const int st = (r >> 4) * 2 + (c >> 5), rr = r & 15, cc = c & 31, ob = rr * 64 + cc * 2; return st * 1024 + (ob ^ (((ob >> 9) & 1) << 5)); }
__host__ __device__ __forceinline__ void stage_rc(int b, int& R, int& C) { const int st = b / 1024, sb = b % 1024, swz = sb ^ (((sb >> 9) & 1) << 5); R = (st >> 1) * 16 + swz / 64; C = (st & 1) * 32 + (swz % 64) / 2; }
__host__ __device__ __forceinline__ int perm32(int rho) { const int n = rho >> 4, i = rho & 15; return 8 * (i >> 2) + 4 * n + (i & 3); }

struct Unit { int pm, pn; };
struct Gemm { const bf16_t* A; const bf16_t* Bt; int M, N, K; };

struct StaticOrder {
    int nM, nN, nwg, G, c;
    __host__ __device__ void init(int M, int N, int G_, int c_) { nM = M / BM; nN = N / BM; nwg = nM * nN; G = G_; c = c_; }
    __host__ __device__ bool next(int i, Unit& u) const {
        const long L = (long)i * G + c; if (L >= nwg) return false;
        int wgid = (int)L; { const int q = nwg / NXCD, r = nwg % NXCD, xcd = wgid % NXCD, off = wgid / NXCD; wgid = (xcd < r ? xcd * (q + 1) : r * (q + 1) + (xcd - r) * q) + off; }
        const int nig = WGM * nN, gid = wgid / nig, fm = gid * WGM, gsz = (nM - fm) < WGM ? (nM - fm) : WGM;
        u.pm = fm + ((wgid % nig) % gsz); u.pn = (wgid % nig) / gsz; return true;
    }
    __device__ __forceinline__ void a_ready(const Unit&) const {}
    __device__ __forceinline__ void done(const Unit&) const {}
};
__device__ __forceinline__ unsigned cvt_pk_bf16(float lo, float hi) { unsigned r; asm volatile("v_cvt_pk_bf16_f32 %0, %1, %2" : "=v"(r) : "v"(lo), "v"(hi)); return r; }
typedef float f32x2 __attribute__((ext_vector_type(2)));
template <class Epi, class Sched, bool ALIGN_EPI = false, bool SP2 = false>
__device__ __forceinline__ void gemm_phase(PG8_LAS unsigned char* lds, const Gemm g, const Sched& S, const Epi& E, const int tid) {
    const int wid = __builtin_amdgcn_readfirstlane(tid >> 6), lane = tid & 63, wr = wid >> 2, wc = wid & 3, fr = lane & 15, fq = lane >> 4;
    const int K = g.K, nt = K / BK;
    unsigned voffA[2], voffB[2];
#pragma unroll
    for (int i = 0; i < 2; ++i) { int R, C; stage_rc(tid * 16 + i * 8192, R, C); const int Rb = Epi::PERM ? ((R & ~31) + perm32(R & 31)) : R;
        voffA[i] = (unsigned)(R * K + C) * 2u; voffB[i] = (unsigned)(Rb * K + C) * 2u; }
    const size_t kstep = (size_t)(BK * 2);
    const size_t hstep = (size_t)HALF * K * 2;
    const size_t tstep = 2 * hstep;
    const unsigned ldsw = (unsigned)wid * 1024u;
    const int aoff = lds_byte(wr * 64 + fr, fq * 8), boff = lds_byte(wc * 32 + fr, fq * 8);
#define PG8_SA(b, h) (((b) * 2 + (h)) * HTB)
#define PG8_SB(b, h) ((4 + (b) * 2 + (h)) * HTB)
#define PG8_STAGE(bufoff, gbase, voff) do { _Pragma("unroll") for (int _i = 0; _i < 2; ++_i) \
        __builtin_amdgcn_global_load_lds((const unsigned*)((const char*)(gbase) + (voff)[_i]), (PG8_LAS unsigned*)(lds + (bufoff) + ldsw + _i * 8192), 16, 0, 0); } while (0)
#define PG8_LDA(dst, b, h) do { _Pragma("unroll") for (int m = 0; m < 4; ++m) _Pragma("unroll") for (int k = 0; k < 2; ++k) dst[m][k] = *(const PG8_LAS bf16x8*)(lds + PG8_SA(b, h) + aoff + m * 2048 + k * 1024); } while (0)
#define PG8_LDB(dst, b, h) do { _Pragma("unroll") for (int n = 0; n < 2; ++n) _Pragma("unroll") for (int k = 0; k < 2; ++k) dst[n][k] = *(const PG8_LAS bf16x8*)(lds + PG8_SB(b, h) + boff + n * 2048 + k * 1024); } while (0)
#define PG8_MMA(ai, bj, At, Bt) do { __builtin_amdgcn_s_setprio(1); _Pragma("unroll") for (int m = 0; m < 4; ++m) _Pragma("unroll") for (int n = 0; n < 2; ++n) _Pragma("unroll") for (int k = 0; k < 2; ++k) \
        acc[ai][bj][m][n] = __builtin_amdgcn_mfma_f32_16x16x32_bf16(Bt[n][k], At[m][k], acc[ai][bj][m][n], 0, 0, 0); __builtin_amdgcn_s_setprio(0); } while (0)
#define PG8_WAIT_V(n) asm volatile("s_waitcnt vmcnt(" #n ")" ::: "memory")
#define PG8_WAIT_L(n) asm volatile("s_waitcnt lgkmcnt(" #n ")" ::: "memory")
#define PG8_BAR __builtin_amdgcn_s_barrier()
#define PG8_SCHED __builtin_amdgcn_sched_barrier(0)
    Unit cur, nxt; int ui = 0;
    if (!S.next(0, cur)) return;
    f32x4 acc[2][2][4][2];
#pragma unroll
    for (int a = 0; a < 2; ++a)
#pragma unroll
        for (int b = 0; b < 2; ++b)
#pragma unroll
            for (int m = 0; m < 4; ++m)
#pragma unroll
                for (int n = 0; n < 2; ++n) acc[a][b][m][n] = (f32x4){0.f, 0.f, 0.f, 0.f};
    bf16x8 At[4][2], B0[2][2], B1[2][2];
    const char* cA = (const char*)g.A + (size_t)cur.pm * tstep; const char* cB = (const char*)g.Bt + (size_t)cur.pn * tstep;
    S.a_ready(cur);
    if constexpr (SP2) {
        PG8_STAGE(PG8_SB(0, 0), cB, voffB); PG8_STAGE(PG8_SB(0, 1), cB + hstep, voffB); PG8_STAGE(PG8_SA(0, 0), cA, voffA); PG8_STAGE(PG8_SA(0, 1), cA + hstep, voffA);
        if (wr == 1) PG8_BAR;
        PG8_WAIT_V(2); PG8_BAR;
        PG8_STAGE(PG8_SB(1, 0), cB + kstep, voffB); PG8_STAGE(PG8_SA(1, 0), cA + kstep, voffA); PG8_STAGE(PG8_SB(1, 1), cB + hstep + kstep, voffB);
        PG8_WAIT_V(6); PG8_BAR;
    } else {
        PG8_STAGE(PG8_SB(0, 0), cB, voffB); PG8_STAGE(PG8_SA(0, 0), cA, voffA); PG8_STAGE(PG8_SB(0, 1), cB + hstep, voffB); PG8_STAGE(PG8_SA(0, 1), cA + hstep, voffA);
        if (wr == 1) PG8_BAR;
        PG8_WAIT_V(4); PG8_BAR;
        PG8_STAGE(PG8_SB(1, 0), cB + kstep, voffB); PG8_STAGE(PG8_SA(1, 0), cA + kstep, voffA); PG8_STAGE(PG8_SB(1, 1), cB + hstep + kstep, voffB);
        PG8_WAIT_V(6); PG8_BAR;
    }
    for (;;) {
        const bool has_next = S.next(ui + 1, nxt);
        const char* nA = has_next ? (const char*)g.A + (size_t)nxt.pm * tstep : cA; const char* nB = has_next ? (const char*)g.Bt + (size_t)nxt.pn * tstep : cB;
        for (int t = 0; t < nt; t += 2) {
            const bool last = (t == nt - 2);
            const char* a1 = cA + (size_t)(t + 1) * kstep;
            const char* a2 = last ? nA : cA + (size_t)(t + 2) * kstep; const char* b2 = last ? nB : cB + (size_t)(t + 2) * kstep;
            const char* a3 = a2 + kstep; const char* b3 = b2 + kstep;
            if (last && has_next) S.a_ready(nxt);
            if constexpr (SP2) {
            PG8_LDB(B0, 0, 0); PG8_LDB(B1, 0, 1); PG8_SCHED; PG8_LDA(At, 0, 0); PG8_STAGE(PG8_SA(1, 1), a1 + hstep, voffA);
            PG8_WAIT_V(8); PG8_WAIT_L(0); PG8_BAR; PG8_MMA(0, 0, At, B0); PG8_MMA(0, 1, At, B1); PG8_BAR; PG8_SCHED;
            PG8_LDA(At, 0, 1); PG8_STAGE(PG8_SB(0, 0), b2, voffB); PG8_STAGE(PG8_SB(0, 1), b2 + hstep, voffB); PG8_STAGE(PG8_SA(0, 0), a2, voffA);
            PG8_WAIT_V(8); PG8_WAIT_L(0); PG8_BAR; PG8_MMA(1, 0, At, B0); PG8_MMA(1, 1, At, B1); PG8_BAR; PG8_SCHED;
            PG8_LDB(B0, 1, 0); PG8_LDB(B1, 1, 1); PG8_SCHED; PG8_LDA(At, 1, 0); PG8_STAGE(PG8_SA(0, 1), a2 + hstep, voffA);
            PG8_WAIT_V(8); PG8_WAIT_L(0); PG8_BAR; PG8_MMA(0, 0, At, B0); PG8_MMA(0, 1, At, B1); PG8_BAR; PG8_SCHED;
            PG8_LDA(At, 1, 1); PG8_STAGE(PG8_SB(1, 0), b3, voffB); PG8_STAGE(PG8_SB(1, 1), b3 + hstep, voffB); PG8_STAGE(PG8_SA(1, 0), a3, voffA);
            PG8_WAIT_V(8); PG8_WAIT_L(0); PG8_BAR; PG8_MMA(1, 0, At, B0); PG8_MMA(1, 1, At, B1); PG8_BAR; PG8_SCHED;
            } else {
            PG8_LDB(B0, 0, 0); PG8_SCHED; PG8_LDA(At, 0, 0); PG8_STAGE(PG8_SA(1, 1), a1 + hstep, voffA);
            PG8_WAIT_L(8); PG8_BAR; PG8_WAIT_L(0); PG8_MMA(0, 0, At, B0); PG8_BAR; PG8_SCHED;
            PG8_LDB(B1, 0, 1); PG8_STAGE(PG8_SB(0, 0), b2, voffB);
            PG8_BAR; PG8_WAIT_L(0); PG8_MMA(0, 1, At, B1); PG8_BAR;
            PG8_LDA(At, 0, 1); PG8_STAGE(PG8_SA(0, 0), a2, voffA);
            PG8_BAR; PG8_WAIT_L(0); PG8_MMA(1, 0, At, B0); PG8_BAR; PG8_SCHED;
            PG8_STAGE(PG8_SB(0, 1), b2 + hstep, voffB);
            PG8_WAIT_V(6); PG8_BAR; PG8_MMA(1, 1, At, B1); PG8_BAR;
            PG8_LDB(B0, 1, 0); PG8_SCHED; PG8_LDA(At, 1, 0); PG8_STAGE(PG8_SA(0, 1), a2 + hstep, voffA);
            PG8_WAIT_L(8); PG8_BAR; PG8_WAIT_L(0); PG8_MMA(0, 0, At, B0); PG8_BAR; PG8_SCHED;
            PG8_LDB(B1, 1, 1); PG8_STAGE(PG8_SB(1, 0), b3, voffB);
            PG8_BAR; PG8_WAIT_L(0); PG8_MMA(0, 1, At, B1); PG8_BAR;
            PG8_LDA(At, 1, 1); PG8_STAGE(PG8_SA(1, 0), a3, voffA);
            PG8_BAR; PG8_WAIT_L(0); PG8_MMA(1, 0, At, B0); PG8_BAR; PG8_SCHED;
            PG8_STAGE(PG8_SB(1, 1), b3 + hstep, voffB);
            PG8_WAIT_V(6); PG8_BAR; PG8_MMA(1, 1, At, B1); PG8_BAR;
            }
        }
        if constexpr (ALIGN_EPI) { if (wr == 0) PG8_BAR; }
        if constexpr (!Epi::AFTER_DRAIN) { E(acc, cur, wr, wc, fr, fq); S.done(cur); }
        if (!has_next) break;
#pragma unroll
        for (int a = 0; a < 2; ++a)
#pragma unroll
            for (int b = 0; b < 2; ++b)
#pragma unroll
                for (int m = 0; m < 4; ++m)
#pragma unroll
                    for (int n = 0; n < 2; ++n) acc[a][b][m][n] = (f32x4){0.f, 0.f, 0.f, 0.f};
        cur = nxt; cA = nA; cB = nB; ++ui;
        if constexpr (ALIGN_EPI) { if (wr == 1) PG8_BAR; }
    }
    PG8_WAIT_V(0);
    if constexpr (!ALIGN_EPI) { if (wr == 0) PG8_BAR; }
    PG8_BAR;
    if constexpr (Epi::AFTER_DRAIN) { E.fused(acc, cur, wr, wc, fr, fq, lds, wid, lane); S.done(cur); }
#undef PG8_SA
#undef PG8_SB
#undef PG8_STAGE
#undef PG8_LDA
#undef PG8_LDB
#undef PG8_MMA
#undef PG8_WAIT_V
#undef PG8_WAIT_L
#undef PG8_BAR
#undef PG8_SCHED
}
}
namespace att {
constexpr int D = 128, PITCH = 2048, NW = 8, QBLK = 32, KVBLK = 64, QB = NW * QBLK;
constexpr int SHM_V = KVBLK * D * 2, SHM_K = KVBLK * D * 2;
constexpr int LDS_BIAS = 2 * SHM_V + 2 * SHM_K + NW * 64 * 4;
constexpr int NQX = 3, LDS_QX = LDS_BIAS + 512;
constexpr int LDS_BYTES = LDS_QX + NW * NQX * 1024;
constexpr float THR2 = 11.5f;
constexpr bool WSKIP = false;
typedef __hip_bfloat16 bf16;
typedef short bf16x8 __attribute__((ext_vector_type(8)));
typedef short s16x4 __attribute__((ext_vector_type(4)));
typedef float f32x16 __attribute__((ext_vector_type(16)));
typedef float f32x4 __attribute__((ext_vector_type(4)));
typedef unsigned u32x4 __attribute__((ext_vector_type(4)));
template <class A, class Bt> struct same_t { static constexpr bool v = false; };
template <class A> struct same_t<A, A> { static constexpr bool v = true; };

#define KSWZ(row, colB) ((row) * 256 + ((colB) ^ (((row) & 7) << 4)))
#define SBAR() __builtin_amdgcn_sched_barrier(0)
__device__ __forceinline__ int v_st(int k, int c) { const int kk = (k & ~0xC) | ((k & 4) << 1) | ((k & 8) >> 1); return ((kk >> 3) * 4 + (c >> 5)) * 512 + ((kk & 7) * 32 + (c & 31)) * 2; }
__device__ __forceinline__ int v_rd_base(int lane) { return ((lane & 3) << 3) | (((lane >> 2) & 3) << 6) | (((lane >> 4) & 1) << 5) | (((lane >> 5) & 1) << 8); }
constexpr int v_rd_off(int d0, int ks, int half) { return d0 * 512 + ks * 4096 + half * 2048; }
__device__ __forceinline__ int crow(int r, int hi) { return (r & 3) + 8 * (r >> 2) + 4 * hi; }
__device__ __forceinline__ unsigned cvtpk(float lo, float hi) {
    unsigned r; asm volatile("v_cvt_pk_bf16_f32 %0, %1, %2" : "=v"(r) : "v"(lo), "v"(hi)); return r;
}
__device__ __forceinline__ bf16x8 pack8(f32x4 a, f32x4 b) {
    u32x4 w = {cvtpk(a[0], a[1]), cvtpk(a[2], a[3]), cvtpk(b[0], b[1]), cvtpk(b[2], b[3])};
    return *reinterpret_cast<bf16x8*>(&w);
}
template <class T> __device__ __forceinline__ bf16x8 load8(const T* p) {
    if constexpr (same_t<T, float>::v) { return pack8(*(const f32x4*)p, *(const f32x4*)(p + 4)); }
    else { return *reinterpret_cast<const bf16x8*>(p); }
}
__device__ __forceinline__ void mask_tile(f32x16& p0, f32x16& p1, int dq, unsigned W) {
    const float NEG = -__builtin_inff();
#pragma unroll
    for (int r = 0; r < 16; ++r) {
        const int c = (r & 3) + 8 * (r >> 2);
        if (dq - c < 0) p0[r] = NEG;
        if (dq - c - 32 < 0) p1[r] = NEG;
    }
}
__device__ __forceinline__ void partialSM(f32x16& p0, f32x16& p1, float& m_reg, float& mn, float& alpha) {
    float pmax = p0[0]; for (int r = 1; r < 16; ++r) pmax = fmaxf(pmax, p0[r]); for (int r = 0; r < 16; ++r) pmax = fmaxf(pmax, p1[r]);
    { auto rr = __builtin_amdgcn_permlane32_swap(__float_as_uint(pmax), __float_as_uint(pmax), false, false);
      pmax = fmaxf(__uint_as_float(rr[0]), __uint_as_float(rr[1])); }
    if (__builtin_expect(__all((pmax - m_reg) <= THR2), 1)) { mn = m_reg; alpha = 1.f; }
    else { mn = fmaxf(m_reg, pmax); alpha = __builtin_amdgcn_exp2f(m_reg - mn); m_reg = mn; }
    for (int r = 0; r < 16; ++r) p0[r] = p0[r] - mn; for (int r = 0; r < 16; ++r) p1[r] = p1[r] - mn;
    for (int r = 0; r < 16; ++r) p0[r] = __builtin_amdgcn_exp2f(p0[r]);
}
__device__ __forceinline__ void finishSM(f32x16& p0, f32x16& p1, float alpha, float& l_reg, bf16x8& pa0, bf16x8& pa1, bf16x8& pa2, bf16x8& pa3) {
    for (int r = 0; r < 16; ++r) p1[r] = __builtin_amdgcn_exp2f(p1[r]);
    float ps = 0; for (int r = 0; r < 16; ++r) ps += p0[r]; for (int r = 0; r < 16; ++r) ps += p1[r];
    { auto rr = __builtin_amdgcn_permlane32_swap(__float_as_uint(ps), __float_as_uint(ps), false, false);
      ps = __uint_as_float(rr[0]) + __uint_as_float(rr[1]); }
    l_reg = l_reg * alpha + ps;
#define PK4(P, B_, OUT) do { unsigned a0 = cvtpk(P[B_+0], P[B_+1]), a1 = cvtpk(P[B_+2], P[B_+3]);                          \
        unsigned b0 = cvtpk(P[B_+4], P[B_+5]), b1 = cvtpk(P[B_+6], P[B_+7]);                                             \
        auto r0 = __builtin_amdgcn_permlane32_swap(a0, b0, false, false); auto r1 = __builtin_amdgcn_permlane32_swap(a1, b1, false, false); \
        u32x4 w = {r0[0], r1[0], r0[1], r1[1]}; OUT = *reinterpret_cast<bf16x8*>(&w); } while (0)
    PK4(p0, 0, pa0); PK4(p0, 8, pa1); PK4(p1, 0, pa2); PK4(p1, 8, pa3);
#undef PK4
}
template <int KB, bool SK>
__device__ __forceinline__ void qkt(f32x16& p0, f32x16& p1, const char* K_lds, int r32, int hi, const bf16x8* qr, bool act, const char* qx) {
    if (SK && !act) { const float NEG = -__builtin_inff();
#pragma unroll
        for (int r = 0; r < 16; ++r) { p0[r] = NEG; p1[r] = NEG; } return; }
    { const float* bl = (const float*)(K_lds - 2 * SHM_V + LDS_BIAS) + KB * 64 + 4 * hi;
#pragma unroll
      for (int g = 0; g < 4; ++g) { const f32x4 u0 = *(const f32x4*)(bl + 8 * g), u1 = *(const f32x4*)(bl + 32 + 8 * g);
        p0[4*g] = u0[0]; p0[4*g+1] = u0[1]; p0[4*g+2] = u0[2]; p0[4*g+3] = u0[3]; p1[4*g] = u1[0]; p1[4*g+1] = u1[1]; p1[4*g+2] = u1[2]; p1[4*g+3] = u1[3]; } }
    const char* kb[4];
#pragma unroll
    for (int dd = 0; dd < 4; ++dd) kb[dd] = K_lds + KB * SHM_K + KSWZ(r32, (dd * 16 + hi * 8) * 2);
#pragma unroll
    for (int d0 = 0; d0 < 8; ++d0) { const char* a = kb[d0 & 3] + (d0 >> 2) * 128;
        bf16x8 b0 = *reinterpret_cast<const bf16x8*>(a);
        bf16x8 b1 = *reinterpret_cast<const bf16x8*>(a + 32 * 256);
        const bf16x8 qv = (d0 < 8 - NQX) ? qr[d0] : *reinterpret_cast<const bf16x8*>(qx + (d0 - (8 - NQX)) * 1024);
        p0 = __builtin_amdgcn_mfma_f32_32x32x16_bf16(b0, qv, p0, 0, 0, 0);
        p1 = __builtin_amdgcn_mfma_f32_32x32x16_bf16(b1, qv, p1, 0, 0, 0); }
}
template <int VB, bool SK>
__device__ __forceinline__ void pv_tile(f32x16* o, int vb0, bf16x8 pa0, bf16x8 pa1, bf16x8 pa2, bf16x8 pa3, bool act) {
    if (SK && !act) return;
#define TRRD(dst, off) asm volatile("ds_read_b64_tr_b16 %0, %1 offset:%2" : "=&v"(dst) : "v"(vb0), "i"(off) : "memory")
#define PV_D0(d0) do { s16x4 l0, l1, l2, l3, h0, h1, h2, h3; constexpr int b_ = VB * SHM_V + v_rd_off(d0, 0, 0);     \
        TRRD(l0, b_); TRRD(h0, b_ + 2048); TRRD(l1, b_ + 4096); TRRD(h1, b_ + 6144); TRRD(l2, b_ + 8192); TRRD(h2, b_ + 10240); TRRD(l3, b_ + 12288); TRRD(h3, b_ + 14336); \
        asm volatile("s_waitcnt lgkmcnt(0)" ::: "memory"); SBAR();                 \
        o[d0] = __builtin_amdgcn_mfma_f32_32x32x16_bf16(pa0, (bf16x8){l0[0], l0[1], l0[2], l0[3], h0[0], h0[1], h0[2], h0[3]}, o[d0], 0, 0, 0);   \
        o[d0] = __builtin_amdgcn_mfma_f32_32x32x16_bf16(pa1, (bf16x8){l1[0], l1[1], l1[2], l1[3], h1[0], h1[1], h1[2], h1[3]}, o[d0], 0, 0, 0);   \
        o[d0] = __builtin_amdgcn_mfma_f32_32x32x16_bf16(pa2, (bf16x8){l2[0], l2[1], l2[2], l2[3], h2[0], h2[1], h2[2], h2[3]}, o[d0], 0, 0, 0);   \
        o[d0] = __builtin_amdgcn_mfma_f32_32x32x16_bf16(pa3, (bf16x8){l3[0], l3[1], l3[2], l3[3], h3[0], h3[1], h3[2], h3[3]}, o[d0], 0, 0, 0); } while (0)
    PV_D0(0); PV_D0(1); PV_D0(2); PV_D0(3);
#undef PV_D0
#undef TRRD
}

template <class TIn, class TOut> struct BlockRef { const TIn* Q; const TIn* K; const TIn* V; TOut* O; const float* Bs; int P0; int nvalid; };
template <class TIn> struct Seam {
    bf16x8 qr[8];
    bf16x8 st_v0, st_v1, st_k0, st_k1; f32x4 sf0, sf1, sf2, sf3;
    f32x4 tq[16];
};
__device__ __forceinline__ int swa_jlo(int P0, int W) { const int lowk = P0 - W + 1; return lowk > 0 ? lowk / KVBLK : 0; }
#define ROW(p, k0, rr) ((p) + (size_t)((k0) + (rr)) * PITCH + sc)
#define VMW() asm volatile("s_waitcnt vmcnt(0)" ::: "memory")
#define VMWN(n) asm volatile("s_waitcnt vmcnt(%0)" :: "i"(n) : "memory")
#define GLDS(gp_, lp_, sz_) __builtin_amdgcn_global_load_lds((const unsigned*)(gp_), (__attribute__((address_space(3))) unsigned*)(lp_), sz_, 0, 0)
#define SLOAD_H(Kp, Vp, Bp, k0, bb_) do { S.st_v0 = load8<TIn>(ROW(Vp, k0, sr)); S.st_v1 = load8<TIn>(ROW(Vp, k0, 32 + sr));              \
                         { const TIn* kg_ = (Kp) + (size_t)(k0) * PITCH; char* kl_ = K_lds + (bb_) * SHM_K + wid * 2048; GLDS(kg_ + ksrc0, kl_, 16); GLDS(kg_ + ksrc1, kl_ + 1024, 16); } \
                         if (wid == 0) GLDS((Bp) + (k0) + lane, lds + LDS_BIAS + (bb_) * 256, 4); } while (0)
#define SWRITE_HK(bf) do { } while (0)
#define SWRITE_HV(bf) do { *(bf16x8*)(V_lds + (bf) * SHM_V + vst0) = S.st_v0; *(bf16x8*)(V_lds + (bf) * SHM_V + vst1) = S.st_v1; } while (0)
#define SWRITE_H(bf) do { SWRITE_HV(bf); SWRITE_HK(bf); } while (0)
#define SLOAD_F(p, k0) do { S.sf0 = *(const f32x4*)ROW(p, k0, sr); S.sf1 = *(const f32x4*)(ROW(p, k0, sr) + 4);                \
                            S.sf2 = *(const f32x4*)ROW(p, k0, 32 + sr); S.sf3 = *(const f32x4*)(ROW(p, k0, 32 + sr) + 4); } while (0)
#define SWRITE_KF(bf) do { *(bf16x8*)(K_lds + (bf) * SHM_K + kws) = pack8(S.sf0, S.sf1); *(bf16x8*)(K_lds + (bf) * SHM_K + kws + 32 * 256) = pack8(S.sf2, S.sf3); } while (0)
#define SWRITE_VF(bf) do { *(bf16x8*)(V_lds + (bf) * SHM_V + vst0) = pack8(S.sf0, S.sf1); *(bf16x8*)(V_lds + (bf) * SHM_V + vst1) = pack8(S.sf2, S.sf3); } while (0)
template <class TIn, class TOut>
__device__ __forceinline__ void causal_swa_prime(const BlockRef<TIn, TOut>& cur, int W, char* lds, Seam<TIn>& S, const int tid) {
    constexpr bool F32 = same_t<TIn, float>::v;
    const int wid = __builtin_amdgcn_readfirstlane(tid >> 6), lane = tid & 63, r32 = lane & 31, hi = lane >> 5;
    const int sr = tid >> 4, sc = (tid & 15) * 8, kws = KSWZ(sr, sc * 2); char* K_lds = lds + 2 * SHM_V; (void)kws;
    const int ksrc0 = (8 * wid + (lane >> 4)) * PITCH + ((lane & 15) ^ (lane >> 4)) * 8, ksrc1 = (8 * wid + 4 + (lane >> 4)) * PITCH + ((lane & 15) ^ (4 + (lane >> 4))) * 8;
    const int kb0 = swa_jlo(cur.P0, W) * KVBLK;
    for (int d0 = 0; d0 < 8; ++d0) S.qr[d0] = load8<TIn>(cur.Q + (size_t)(wid * QBLK + r32) * PITCH + d0 * 16 + hi * 8);
    if constexpr (F32) { SLOAD_F((const float*)cur.K, kb0); VMW(); SWRITE_KF(0); SBAR(); SLOAD_F((const float*)cur.V, kb0); }
    else { SLOAD_H(cur.K, cur.V, cur.Bs, kb0, 0); VMW(); SWRITE_HK(0); }
    __syncthreads();
}
template <class TIn, class TOut>
__device__ __forceinline__ void causal_swa_block(const BlockRef<TIn, TOut>& cur, const BlockRef<TIn, TOut>& nxt, int skv, int W, char* lds, Seam<TIn>& S, const int tid) {
    constexpr bool F32 = same_t<TIn, float>::v;
    const int wid = __builtin_amdgcn_readfirstlane(tid >> 6), lane = tid & 63, r32 = lane & 31, hi = lane >> 5;
    const int j_lo = swa_jlo(cur.P0, W);
    int j_hi = (cur.P0 + QB - 1) / KVBLK + 1; if (j_hi > skv / KVBLK) j_hi = skv / KVBLK;
    const int NT = j_hi - j_lo;
    const int kbn = swa_jlo(nxt.P0, W) * KVBLK;
    const int qlo = cur.P0 + wid * QBLK, qm = qlo + r32 - 4 * hi;
    char* V_lds = lds; char* K_lds = lds + 2 * SHM_V;
    float* ws = (float*)(lds + 2 * SHM_V + 2 * SHM_K) + wid * 64; float* li_l = ws, * al_l = ws + 32;
    float m_reg = -1e30f, l_reg = 0; f32x16 o[4] = {};
    const int sr = tid >> 4, sc = (tid & 15) * 8, vst0 = v_st(sr, sc), vst1 = v_st(32 + sr, sc), kws = KSWZ(sr, sc * 2);
    const int vb0 = (int)(uintptr_t)V_lds + v_rd_base(lane); (void)kws;
    const int ksrc0 = (8 * wid + (lane >> 4)) * PITCH + ((lane & 15) ^ (lane >> 4)) * 8, ksrc1 = (8 * wid + 4 + (lane >> 4)) * PITCH + ((lane & 15) ^ (4 + (lane >> 4))) * 8;
    const TIn* Kh = cur.K; const TIn* Vh = cur.V; const float* Bh = cur.Bs;
#define RESC(a) do { if (__any((a) < 1.f)) { if (hi == 0) al_l[r32] = (a); asm volatile("s_waitcnt lgkmcnt(0)" ::: "memory");              \
                     for (int d_ = 0; d_ < 4; ++d_) for (int r = 0; r < 16; ++r) o[d_][r] *= al_l[crow(r, hi)]; } } while (0)
#define KBASE(t) ((j_lo + (t)) * KVBLK)
#define ACT(t) (KBASE(t) <= qlo + QBLK - 1 && KBASE(t) + KVBLK - 1 >= qlo - W + 1)
#define MASKT(P0_, P1_, t) do { const int kb_ = KBASE(t); if ((!SK || ACT(t)) && (kb_ + KVBLK - 1 > qlo || kb_ <= qlo + QBLK - 1 - W)) mask_tile(P0_, P1_, qm - kb_, (unsigned)W); } while (0)
    constexpr int NQL = F32 ? 16 : 8;
    constexpr bool SK = WSKIP && !F32;
#define SEAM_K0() do { VMWN(NQL); if constexpr (F32) { SWRITE_KF(0); SBAR(); SLOAD_F((const float*)nxt.V, kbn); } else { SWRITE_HK(0); } SBAR(); } while (0)
    f32x16 pA0, pA1, pB0, pB1; float mnA, mnB, alA, alB; bf16x8 pa0, pa1, pa2, pa3;
    char* qx = lds + LDS_QX + wid * (NQX * 1024) + lane * 16;
#pragma unroll
    for (int e = 0; e < NQX; ++e) *reinterpret_cast<bf16x8*>(qx + e * 1024) = S.qr[8 - NQX + e];
    if constexpr (F32) { VMW(); SWRITE_VF(0); SBAR(); } else { SWRITE_HV(0); SBAR(); }
    if (NT > 1) { if constexpr (F32) SLOAD_F((const float*)Kh, KBASE(1)); else SLOAD_H(Kh, Vh, Bh, KBASE(1), 1); }
    SBAR(); qkt<0, SK>(pA0, pA1, K_lds, r32, hi, S.qr, ACT(0), qx);
    if constexpr (F32) { if (NT > 1) { VMW(); SWRITE_KF(1); SBAR(); SLOAD_F((const float*)Vh, KBASE(1)); } }
    MASKT(pA0, pA1, 0); partialSM(pA0, pA1, m_reg, mnA, alA);
    if (NT > 1) { VMW(); if constexpr (F32) { SWRITE_VF(1); SBAR(); if (NT > 2) SLOAD_F((const float*)Kh, KBASE(2)); } else SWRITE_H(1); }
    __syncthreads();
#define HALF_STEP(PX0, PX1, mnX, alX, PY0, PY1, alY, t, KB, VB, SB) do {                                                      \
        SBAR(); qkt<KB, SK>(PX0, PX1, K_lds, r32, hi, S.qr, ACT(t), qx);                                             \
        finishSM(PY0, PY1, alY, l_reg, pa0, pa1, pa2, pa3); SBAR();                                                           \
        if ((t) + 1 < NT) { if constexpr (F32) { VMW(); SWRITE_KF(SB); SBAR(); SLOAD_F((const float*)Vh, KBASE((t) + 1)); }  \
                            else { SLOAD_H(Kh, Vh, Bh, KBASE((t) + 1), SB); } SBAR(); }                                               \
        pv_tile<VB, SK>(o, vb0, pa0, pa1, pa2, pa3, ACT((t) - 1)); MASKT(PX0, PX1, (t)); partialSM(PX0, PX1, m_reg, mnX, alX);                                        \
        __syncthreads();                                                                                                      \
        if ((t) + 1 < NT) { VMW(); if constexpr (F32) { SWRITE_VF(SB); SBAR(); if ((t) + 2 < NT) SLOAD_F((const float*)Kh, KBASE((t) + 2)); } \
                            else { SWRITE_H(SB); } }                                                                          \
        RESC(alX); __syncthreads(); } while (0)
    for (int t = 1; t + 1 < NT; t += 2) {
        HALF_STEP(pB0, pB1, mnB, alB, pA0, pA1, alA, t, 1, 0, 0);
        HALF_STEP(pA0, pA1, mnA, alA, pB0, pB1, alB, t + 1, 0, 1, 1);
    }
    const bool even = (NT & 1) == 0;
    if (even) { SBAR(); qkt<1, SK>(pB0, pB1, K_lds, r32, hi, S.qr, ACT(NT - 1), qx); SBAR(); }
#define QROW(e) (nxt.Q + (size_t)(wid * QBLK + r32) * PITCH + ((e) >> 1) * 16 + hi * 8 + ((e) & 1) * 4)
    if constexpr (F32) { SLOAD_F((const float*)nxt.K, kbn); SBAR();
#pragma unroll
        for (int e = 0; e < 8; ++e) S.tq[e] = *(const f32x4*)QROW(e); }
    else { SLOAD_H(nxt.K, nxt.V, nxt.Bs, kbn, 0); SBAR();
#pragma unroll
        for (int d0 = 0; d0 < 8; ++d0) S.qr[d0] = load8<TIn>(nxt.Q + (size_t)(wid * QBLK + r32) * PITCH + d0 * 16 + hi * 8); }
    SBAR();
    finishSM(pA0, pA1, alA, l_reg, pa0, pa1, pa2, pa3); SBAR();
    if constexpr (F32) {
#pragma unroll
        for (int e = 8; e < 16; ++e) S.tq[e] = *(const f32x4*)QROW(e); SBAR(); }
#undef QROW
    pv_tile<0, SK>(o, vb0, pa0, pa1, pa2, pa3, ACT(even ? NT - 2 : NT - 1));
    if (even) { MASKT(pB0, pB1, NT - 1); partialSM(pB0, pB1, m_reg, mnB, alB); __syncthreads(); RESC(alB);
        finishSM(pB0, pB1, alB, l_reg, pa0, pa1, pa2, pa3); SBAR(); pv_tile<1, SK>(o, vb0, pa0, pa1, pa2, pa3, ACT(NT - 1)); }
    SBAR(); SEAM_K0();
    if (hi == 0) li_l[r32] = l_reg; asm volatile("s_waitcnt lgkmcnt(0)" ::: "memory");
    float rli[16];
#pragma unroll
    for (int r = 0; r < 16; ++r) rli[r] = __builtin_amdgcn_rcpf(li_l[crow(r, hi)]);
    int tidE = tid; asm volatile("" : "+v"(tidE));
    const int widE = __builtin_amdgcn_readfirstlane(tidE >> 6), r32E = tidE & 31, hiE = (tidE >> 5) & 1;
    TOut* Ow = cur.O + (size_t)(widE * QBLK) * PITCH; const bool wval = widE * QBLK < cur.nvalid;
    if (wval) {
#pragma unroll
    for (int r = 0; r < 16; ++r) { const int orow = crow(r, hiE);
#pragma unroll
        for (int d0 = 0; d0 < 4; ++d0) { const float v = o[d0][r] * rli[r];
            if constexpr (same_t<TOut, float>::v) { Ow[(size_t)orow * PITCH + d0 * 32 + r32E] = v; }
            else { const float vn = __shfl_xor(v, 1);
                   if ((r32E & 1) == 0) *(unsigned*)(Ow + (size_t)orow * PITCH + d0 * 32 + r32E) = cvtpk(v, vn); } } } }
    if constexpr (F32) {
#pragma unroll
        for (int d0 = 0; d0 < 8; ++d0) S.qr[d0] = pack8(S.tq[2 * d0], S.tq[2 * d0 + 1]); }
    __syncthreads();
#undef RESC
#undef KBASE
#undef ACT
#undef MASKT
#undef SEAM_K0
#undef HALF_STEP
}
#undef ROW
#undef VMW
#undef VMWN
#undef SLOAD_H
#undef GLDS
#undef SWRITE_HK
#undef SWRITE_HV
#undef SWRITE_H
#undef SLOAD_F
#undef SWRITE_KF
#undef SWRITE_VF

}
typedef unsigned short u16;
typedef float f32x4 __attribute__((ext_vector_type(4)));
typedef unsigned u32x4 __attribute__((ext_vector_type(4)));
typedef unsigned u32x2 __attribute__((ext_vector_type(2)));
typedef short bf16x8 __attribute__((ext_vector_type(8)));
constexpr int DM = 2048, TP = 8192, NBP = 4, NBS = 8, TS = 64, PAST = 2048, SKVS = PAST + TS;
constexpr int MP = NBP * TP, MS_ = NBS * TS, M = MP + MS_;
constexpr int DI = 4096, CD = 6144, NH = 64, DFF = 5504, DFF2 = 11008, NIN = 20560;
constexpr int NMOD = 12288;
constexpr float EPS = 1e-6f, LOG2E = 1.4426950408889634f;
constexpr int HALF_ROWS = 16640;
constexpr size_t O_YP = 0, O_YS = O_YP + (size_t)MP * DM, O_KP = O_YS + (size_t)MS_ * DM, O_VP = O_KP + (size_t)MP * DM,
    O_LFP = O_VP + (size_t)MP * DM, O_SSMP = O_LFP + (size_t)MP * 16, O_MCP = O_SSMP + (size_t)NBP * 64 * 64 * 128, O_FCP = O_MCP + (size_t)NBP * 3 * CD,
    O_KS = O_FCP + (size_t)NBP * 2 * DFF2, O_VS = O_KS + (size_t)MS_ * DM, O_LFS = O_VS + (size_t)MS_ * DM, O_SSMS = O_LFS + (size_t)MS_ * 16,
    O_MCS = O_SSMS + (size_t)NBS * 64 * 64 * 128, O_FCS = O_MCS + (size_t)NBS * 3 * CD, O_END = O_FCS + (size_t)NBS * 2 * DFF2;
constexpr size_t MiB = 1u << 20;
constexpr size_t W_MOD = 0, W_BIASP = 1 * MiB, W_BIASS = 3 * MiB, W_HALO = 5 * MiB,
    W_WUP = 8 * MiB, W_WDN = 51 * MiB, W_H = 73 * MiB, W_WIN = 203 * MiB, W_WPM = 284 * MiB, W_WPF = 300 * MiB, W_WOUT = 308 * MiB,
    W_SMALL = 316 * MiB, W_R = 349 * MiB,
    W_XBC = W_R, W_Z = W_R + 390 * MiB, W_GM = W_R, W_GF = W_R + 130 * MiB, W_Q = W_R + 260 * MiB, W_K = W_Q + 130 * MiB, W_V = W_K + 130 * MiB,
    W_U = 203 * MiB, W_G = 553 * MiB, W_END = 999 * MiB;
static_assert((size_t)M * DM * 2 == 130 * MiB && (size_t)M * CD * 2 == 390 * MiB && (size_t)M * DI * 2 == 260 * MiB, "sizes");
static_assert(W_U + (size_t)HALF_ROWS * DFF2 * 2 <= W_G && W_G + (size_t)M * DFF * 2 <= 1024 * MiB, "ffn map");
static_assert(W_SMALL + (size_t)M * 256 * 4 <= W_R, "small map");

struct Prm { const float* in[31]; float* out; unsigned char* ws; };
typedef const __attribute__((address_space(4))) Prm* KPrm;
struct Ctx { int tid, bid, G; };
enum { I_XP = 0, I_XS, I_CP, I_CS, I_CK, I_CV, I_CLF, I_SSM, I_MCV, I_FCV, I_N1W, I_N2W, I_WADA, I_BADA, I_WIN, I_MCW, I_MCB, I_DTB, I_ALOG, I_MD, I_MNW,
       I_FB, I_QNW, I_KNW, I_WPM, I_WPF, I_WOUT, I_WUP, I_FCW, I_FCB, I_WDN };

__device__ __forceinline__ float bflo(unsigned w) { return __uint_as_float(w << 16); }
__device__ __forceinline__ float bfhi(unsigned w) { return __uint_as_float(w & 0xffff0000u); }
__device__ __forceinline__ unsigned pk2(float lo, float hi) { return pg8::cvt_pk_bf16(lo, hi); }
__device__ __forceinline__ u16 f2bf(float f) { return (u16)(pk2(f, 0.f) & 0xffffu); }
__device__ __forceinline__ void unpack8(u32x4 w, float* v) { v[0] = bflo(w.x); v[1] = bfhi(w.x); v[2] = bflo(w.y); v[3] = bfhi(w.y); v[4] = bflo(w.z); v[5] = bfhi(w.z); v[6] = bflo(w.w); v[7] = bfhi(w.w); }
__device__ __forceinline__ u32x4 pack8f(const float* v) { u32x4 w; w.x = pk2(v[0], v[1]); w.y = pk2(v[2], v[3]); w.z = pk2(v[4], v[5]); w.w = pk2(v[6], v[7]); return w; }
__device__ __forceinline__ float bfel(const u32x4& w, int e) { const unsigned x = w[e >> 1]; return (e & 1) ? bfhi(x) : bflo(x); }
__device__ __forceinline__ float sigmoidf_(float x) { return 1.f / (1.f + __expf(-x)); }
__device__ __forceinline__ float siluf_(float x) { return x / (1.f + __expf(-x)); }
__device__ __forceinline__ float wave_sum(float v) {
#pragma unroll
    for (int o = 1; o < 64; o <<= 1) v += __shfl_xor(v, o);
    return v;
}
__device__ __forceinline__ int mod_row(int row) { return row < MP ? (row >> 13) : 4 + ((row - MP) >> 6); }

struct Epi {
    static constexpr bool PERM = true, AFTER_DRAIN = false;
    int mode;
    u16* d0; u16* d1; u16* d2; int t1, t2, p0, p1, p2, f32seg2;
    const float* xp; const float* xs; float* y; const float* mod; u16* gbuf; const u16* gf;
    __device__ __forceinline__ void operator()(const f32x4 (&acc)[2][2][4][2], const pg8::Unit& u, int wr, int wc, int fr, int fq) const {
        const int rl = u.pm * 256 + wr * 64 + fr, cl = wc * 32 + 8 * fq;
        if (mode == 0) {
            u16* base; int pitch, ct; bool f32o = false;
            if (u.pn < t1) { base = d0; pitch = p0; ct = u.pn; } else if (u.pn < t2) { base = d1; pitch = p1; ct = u.pn - t1; } else { base = d2; pitch = p2; ct = u.pn - t2; f32o = (f32seg2 != 0); }
            if (!f32o) {
#pragma unroll
                for (int ai = 0; ai < 2; ++ai)
#pragma unroll
                    for (int m = 0; m < 4; ++m) { u16* rp = base + (size_t)(rl + ai * 128 + m * 16) * pitch + ct * 256 + cl;
#pragma unroll
                        for (int bj = 0; bj < 2; ++bj) { const f32x4 v0 = acc[ai][bj][m][0], v1 = acc[ai][bj][m][1]; u32x4 w; w.x = pk2(v0[0], v0[1]); w.y = pk2(v0[2], v0[3]); w.z = pk2(v1[0], v1[1]); w.w = pk2(v1[2], v1[3]);
                            *(u32x4*)(rp + bj * 128) = w; } }
            } else {
                float* fb = (float*)base;
#pragma unroll
                for (int ai = 0; ai < 2; ++ai)
#pragma unroll
                    for (int m = 0; m < 4; ++m) { float* rp = fb + (size_t)(rl + ai * 128 + m * 16) * pitch + ct * 256 + cl;
#pragma unroll
                        for (int bj = 0; bj < 2; ++bj) { *(f32x4*)(rp + bj * 128) = acc[ai][bj][m][0]; *(f32x4*)(rp + bj * 128 + 4) = acc[ai][bj][m][1]; } }
            }
        } else if (mode == 1 || mode == 2) {
#pragma unroll
            for (int ai = 0; ai < 2; ++ai)
#pragma unroll
                for (int m = 0; m < 4; ++m) { const size_t off = (size_t)(rl + ai * 128 + m * 16) * DM + u.pn * 256 + cl;
#pragma unroll
                    for (int bj = 0; bj < 2; ++bj) { const f32x4 v0 = acc[ai][bj][m][0], v1 = acc[ai][bj][m][1];
                        float a[8] = {v0[0], v0[1], v0[2], v0[3], v1[0], v1[1], v1[2], v1[3]}, g[8], o[8];
                        unpack8(*(const u32x4*)(gbuf + off + bj * 128), g);
                        if (mode == 1) {
#pragma unroll
                            for (int e = 0; e < 8; ++e) o[e] = sigmoidf_(g[e]) * a[e];
                        } else { float f[8]; unpack8(*(const u32x4*)(gf + off + bj * 128), f);
#pragma unroll
                            for (int e = 0; e < 8; ++e) o[e] = g[e] + sigmoidf_(f[e]) * a[e]; }
                        *(u32x4*)(gbuf + off + bj * 128) = pack8f(o); } }
        } else {
#pragma unroll
            for (int ai = 0; ai < 2; ++ai) {
                const int mb = (u.pm < 128) ? (u.pm >> 5) : (4 + (u.pm - 128) * 4 + ai * 2 + wr);
                const float* gp = mod + (size_t)mb * NMOD + (mode == 3 ? 4096 : 10240) + u.pn * 256 + cl;
                f32x4 gv[2][2];
#pragma unroll
                for (int bj = 0; bj < 2; ++bj) { gv[bj][0] = *(const f32x4*)(gp + bj * 128); gv[bj][1] = *(const f32x4*)(gp + bj * 128 + 4); }
#pragma unroll
                for (int m = 0; m < 4; ++m) { const int row = rl + ai * 128 + m * 16; const size_t off = (size_t)row * DM + u.pn * 256 + cl;
                    const float* xr = (mode == 3) ? ((row < MP) ? xp + off : xs + (off - (size_t)MP * DM)) : (const float*)(y + off);
#pragma unroll
                    for (int bj = 0; bj < 2; ++bj) { const f32x4 b0 = *(const f32x4*)(xr + bj * 128), b1 = *(const f32x4*)(xr + bj * 128 + 4);
                        *(f32x4*)(y + off + bj * 128) = b0 + gv[bj][0] * acc[ai][bj][m][0]; *(f32x4*)(y + off + bj * 128 + 4) = b1 + gv[bj][1] * acc[ai][bj][m][1]; } }
            }
        }
    }
};

__device__ __forceinline__ int map_in(int n) {
    if (n < 4096) return 6144 + n;
    if (n < 10240) return n - 4096;
    if (n < 10304) return 10240 + (n - 10240);
    if (n < 12352) return 14592 + (n - 10304);
    if (n < 14400) return 16640 + (n - 12352);
    if (n < 16448) return 18688 + (n - 14400);
    if (n < 16464) return 10304 + (n - 16448);
    if (n < 18512) return 10496 + (n - 16464);
    return 12544 + (n - 18512);
}
__device__ __forceinline__ int map_up(int n) { if (n < DFF) return (n >> 7) * 256 + (n & 127); const int f = n - DFF; return (f >> 7) * 256 + 128 + (f & 127); }
template <int MAP> __device__ __forceinline__ void tr_item(const float* __restrict__ W, int K, int N, u16* WT, float* scr, int item, int lane) {
    const int nblk = (N + 31) / 32, kb = item / nblk, nb = item % nblk, k0 = 64 * kb, n0 = 32 * nb;
    const int nn = n0 + (lane & 31);
#pragma unroll 8
    for (int i = 0; i < 32; ++i) { const int kk = 2 * i + (lane >> 5); scr[kk * 33 + (lane & 31)] = (nn < N) ? W[(size_t)(k0 + kk) * N + nn] : 0.f; }
    asm volatile("s_waitcnt lgkmcnt(0)" ::: "memory");
    const int c = lane & 7;
#pragma unroll
    for (int j = 0; j < 4; ++j) { const int n = (lane >> 3) + 8 * j; const float* s = scr + (8 * c) * 33 + n;
        if (n0 + n < N) { const int row = (MAP == 1) ? map_in(n0 + n) : (MAP == 2) ? map_up(n0 + n) : (n0 + n);
            u32x4 o; o.x = pk2(s[0 * 33], s[1 * 33]); o.y = pk2(s[2 * 33], s[3 * 33]); o.z = pk2(s[4 * 33], s[5 * 33]); o.w = pk2(s[6 * 33], s[7 * 33]);
            *(u32x4*)(WT + (size_t)row * K + k0 + 8 * c) = o; } }
    asm volatile("s_waitcnt lgkmcnt(0)" ::: "memory");
}
__device__ __forceinline__ void phase_prep(KPrm p, const Ctx cx, unsigned char* lds) {
    const int tid = cx.tid, lane = tid & 63, wid = tid >> 6, G = cx.G;
    unsigned char* ws = p->ws;
    {
        float* scr = (float*)(lds + wid * 8448);
        const int gw = cx.bid * 8 + wid, NGW = G * 8;
        constexpr int I_IN = 32 * 643, I_PM = 64 * 64, I_PF = 32 * 64, I_OUT = 32 * 64, I_UP = 32 * 344, I_DN = 86 * 64;
        constexpr int NIT = I_IN + I_PM + I_PF + I_OUT + I_UP + I_DN;
        for (int it = gw; it < NIT; it += NGW) {
            int r = it;
            if (r < I_IN) { tr_item<1>(p->in[I_WIN], DM, NIN, (u16*)(ws + W_WIN), scr, r, lane); continue; } r -= I_IN;
            if (r < I_PM) { tr_item<0>(p->in[I_WPM], DI, DM, (u16*)(ws + W_WPM), scr, r, lane); continue; } r -= I_PM;
            if (r < I_PF) { tr_item<0>(p->in[I_WPF], DM, DM, (u16*)(ws + W_WPF), scr, r, lane); continue; } r -= I_PF;
            if (r < I_OUT) { tr_item<0>(p->in[I_WOUT], DM, DM, (u16*)(ws + W_WOUT), scr, r, lane); continue; } r -= I_OUT;
            if (r < I_UP) { tr_item<2>(p->in[I_WUP], DM, DFF2, (u16*)(ws + W_WUP), scr, r, lane); continue; } r -= I_UP;
            tr_item<0>(p->in[I_WDN], DFF, DM, (u16*)(ws + W_WDN), scr, r, lane);
        }
    }
    __syncthreads();
    {
        float* sl = (float*)lds;
        float* red = (float*)(lds + 12 * 2048 * 4);
        for (int e = tid; e < 12 * 2048; e += 512) { const int b = e >> 11, i = e & 2047; const float cv = (b < 4) ? p->in[I_CP][b * 2048 + i] : p->in[I_CS][(b - 4) * 2048 + i]; sl[e] = siluf_(cv); }
        __syncthreads();
        const float* wada = p->in[I_WADA]; float* mod = (float*)(ws + W_MOD);
        const int col = tid & 31, part = tid >> 5;
        for (int item = cx.bid; item < NMOD / 32; item += G) {
            float acc[12];
#pragma unroll
            for (int b = 0; b < 12; ++b) acc[b] = 0.f;
            const float* wp = wada + (size_t)(part * 128) * NMOD + item * 32 + col;
#pragma unroll 4
            for (int d = 0; d < 128; ++d) { const float w = wp[(size_t)d * NMOD];
#pragma unroll
                for (int b = 0; b < 12; ++b) acc[b] += sl[b * 2048 + part * 128 + d] * w; }
#pragma unroll
            for (int b = 0; b < 12; ++b) red[(part * 12 + b) * 32 + col] = acc[b];
            __syncthreads();
            if (tid < 384) { const int b = tid >> 5; float s = p->in[I_BADA][item * 32 + col];
#pragma unroll
                for (int q = 0; q < 16; ++q) s += red[(q * 12 + b) * 32 + col];
                mod[b * NMOD + item * 32 + col] = s; }
            __syncthreads();
        }
    }
    {
        u16* Ks = (u16*)p->out; u16* Vs = Ks + (size_t)NBS * SKVS * DM;
        const size_t tot8 = (size_t)NBS * PAST * DM / 8, gt = (size_t)cx.bid * 512 + tid, GT = (size_t)G * 512;
        for (size_t i = gt; i < 2 * tot8; i += GT) { const int which = i >= tot8; const size_t j = i - (which ? tot8 : 0);
            const size_t sb = j / ((size_t)PAST * 256), rem = j % ((size_t)PAST * 256), row = rem >> 8, c8 = rem & 255;
            const float* src = p->in[which ? I_CV : I_CK] + ((sb * PAST + row) * DM + c8 * 8);
            const f32x4 a = *(const f32x4*)src, b = *(const f32x4*)(src + 4);
            u32x4 o; o.x = pk2(a[0], a[1]); o.y = pk2(a[2], a[3]); o.z = pk2(b[0], b[1]); o.w = pk2(b[2], b[3]);
            *(u32x4*)((which ? Vs : Ks) + ((sb * SKVS + row) * DM + c8 * 8)) = o; }
    }
}
__device__ __forceinline__ void phase_norm(KPrm p, const Ctx cx, int which) {
    const int tid = cx.tid, lane = tid & 63, wid = tid >> 6;
    const int gw = cx.bid * 8 + wid, NGW = cx.G * 8;
    const float* mod = (const float*)(p->ws + W_MOD); u16* H = (u16*)(p->ws + W_H);
    const float* nw = p->in[which ? I_N2W : I_N1W];
    const int osh = which ? 6144 : 0, osc = which ? 8192 : 2048;
    for (int row = gw; row < M; row += NGW) {
        const float* xr = which ? (p->out + (size_t)row * DM) : ((row < MP) ? p->in[I_XP] + (size_t)row * DM : p->in[I_XS] + (size_t)(row - MP) * DM);
        const float* mr = mod + (size_t)mod_row(row) * NMOD;
        f32x4 v[8]; float ss = 0.f;
#pragma unroll
        for (int j = 0; j < 8; ++j) { v[j] = ((const f32x4*)xr)[lane + 64 * j]; ss += (v[j][0] * v[j][0] + v[j][1] * v[j][1]) + (v[j][2] * v[j][2] + v[j][3] * v[j][3]); }
        const float rs = rsqrtf(wave_sum(ss) * (1.f / DM) + EPS);
#pragma unroll
        for (int j = 0; j < 8; ++j) { const int col = 4 * (lane + 64 * j);
            const f32x4 w = *(const f32x4*)(nw + col), sc = *(const f32x4*)(mr + osc + col), sh = *(const f32x4*)(mr + osh + col);
            const f32x4 o = v[j] * rs * w * (sc + 1.f) + sh;
            u32x2 q; q.x = pk2(o[0], o[1]); q.y = pk2(o[2], o[3]);
            *(u32x2*)(H + (size_t)row * DM + col) = q; }
    }
}
constexpr int SXP = 72, SNP = 136, SYP = 68;
constexpr int L_XT = 0, L_CN = L_XT + 64 * SXP * 2, L_BN = L_CN + 64 * SNP * 2, L_BWT = L_BN + 64 * SNP * 2, L_MS = L_BWT + 128 * SXP * 2, L_HS = L_MS + 64 * SXP * 2,
              L_YS = L_HS + 64 * SNP * 2, L_DT = L_YS + 64 * SYP * 4, L_CUM = L_DT + 256, L_SSD_END = L_CUM + 256;
static_assert(L_SSD_END <= 131072, "ssd lds");
__device__ __forceinline__ u32x4 ssd_raw8(const u16* XBC, const float* hist, long rowbase, int seqpos, int col, bool smp) {
    if (seqpos >= 0) return *(const u32x4*)(XBC + (size_t)(rowbase + seqpos) * CD + col);
    u32x4 o = {0u, 0u, 0u, 0u};
    if (smp) { const float* s = hist + (size_t)(3 + seqpos) * CD + col; const f32x4 a = *(const f32x4*)s, b = *(const f32x4*)(s + 4);
        o.x = pk2(a[0], a[1]); o.y = pk2(a[2], a[3]); o.z = pk2(b[0], b[1]); o.w = pk2(b[2], b[3]); }
    return o;
}
__device__ __forceinline__ void phase_ssd(KPrm p, const Ctx cx, unsigned char* lds) {
    const int tid = cx.tid, lane = tid & 63, wid = tid >> 6, quad = lane >> 4, l15 = lane & 15;
    u16* XT = (u16*)(lds + L_XT); u16* CN = (u16*)(lds + L_CN); u16* BN = (u16*)(lds + L_BN); u16* BWT = (u16*)(lds + L_BWT);
    u16* MSm = (u16*)(lds + L_MS); u16* HS = (u16*)(lds + L_HS); float* YS = (float*)(lds + L_YS); float* DT = (float*)(lds + L_DT); float* CUM = (float*)(lds + L_CUM);
    const u16* XBC = (const u16*)(p->ws + W_XBC); u16* Z = (u16*)(p->ws + W_Z); const float* SM = (const float*)(p->ws + W_SMALL);
    const float* cw = p->in[I_MCW]; const float* cb = p->in[I_MCB];
    const int cg8 = tid & 31, tq = tid >> 5, cgx = tid & 7, tx = tid >> 3;
    const int pb = wid >> 1;
    for (int ch = cx.bid; ch < 256 + 512; ch += cx.G) {
        const bool smp = ch >= 256; int b, hd, nc; long rowbase;
        if (!smp) { b = ch >> 6; hd = ch & 63; nc = TP / 64; rowbase = (long)b * TP; } else { const int su = ch - 256; b = su >> 6; hd = su & 63; nc = 1; rowbase = MP + (long)b * TS; }
        const int g = hd >> 3;
        const float a_h = -__expf(p->in[I_ALOG][hd]), dtb = p->in[I_DTB][hd], Dh = p->in[I_MD][hd];
        const int bccol = (cg8 < 16) ? (4096 + g * 128 + cg8 * 8) : (5120 + g * 128 + (cg8 - 16) * 8);
        const int xcol = hd * 64 + cgx * 8;
        const float* hist = p->in[I_MCV] + (size_t)b * 3 * CD;
        f32x4 st[4];
        const int st_off = (pb * 16 + quad * 4) * 128 + (4 * (wid & 1)) * 16 + l15, hs_off = (pb * 16 + quad * 4) * SNP + (4 * (wid & 1)) * 16 + l15;
        { const float* sin_ = p->in[I_SSM] + ((size_t)b * 64 + hd) * 64 * 128 + st_off;
#pragma unroll
          for (int i = 0; i < 4; ++i)
#pragma unroll
            for (int j = 0; j < 4; ++j) st[i][j] = smp ? sin_[j * 128 + i * 16] : 0.f; }
        __syncthreads();
        { u16* hp_ = HS + hs_off;
#pragma unroll
          for (int i = 0; i < 4; ++i)
#pragma unroll
            for (int j = 0; j < 4; ++j) hp_[j * SNP + i * 16] = f2bf(st[i][j]); }
        for (int c = 0; c < nc; ++c) {
            const long r0 = rowbase + (long)c * 64; const int t0 = c * 64;
            u32x4 rbc[7], rx[4];
#pragma unroll
            for (int i = 0; i < 7; ++i) rbc[i] = ssd_raw8(XBC, hist, rowbase, t0 + 4 * tq - 3 + i, bccol, smp);
#pragma unroll
            for (int i = 0; i < 4; ++i) rx[i] = ssd_raw8(XBC, hist, rowbase, t0 + tx - 3 + i, xcol, smp);
            const u32x4 zw = *(const u32x4*)(Z + (size_t)(r0 + tx) * DI + xcol);
            if (wid == 0) {
                const float dr = SM[(size_t)(r0 + lane) * 256 + hd] + dtb; const float dtv = dr > 20.f ? dr : log1pf(__expf(dr));
                float x = dtv * a_h;
#pragma unroll
                for (int o = 1; o < 64; o <<= 1) { const float y = __shfl_up(x, o); if (lane >= o) x += y; }
                DT[lane] = dtv; CUM[lane] = x;
            }
            __syncthreads();
            const float cum_end = CUM[63];
            {
                float wbc[4][8], bbc[8];
#pragma unroll
                for (int j = 0; j < 4; ++j) { const f32x4 a0 = *(const f32x4*)(cw + j * CD + bccol), a1 = *(const f32x4*)(cw + j * CD + bccol + 4);
#pragma unroll
                    for (int e = 0; e < 4; ++e) { wbc[j][e] = a0[e]; wbc[j][4 + e] = a1[e]; } }
                { const f32x4 a0 = *(const f32x4*)(cb + bccol), a1 = *(const f32x4*)(cb + bccol + 4);
#pragma unroll
                  for (int e = 0; e < 4; ++e) { bbc[e] = a0[e]; bbc[4 + e] = a1[e]; } }
                float vb[4][8];
#pragma unroll
                for (int ii = 0; ii < 4; ++ii)
#pragma unroll
                    for (int e = 0; e < 8; ++e) { float s = bbc[e];
#pragma unroll
                        for (int j = 0; j < 4; ++j) s += wbc[j][e] * bfel(rbc[ii + j], e);
                        vb[ii][e] = siluf_(s); }
                u16* NAT = (cg8 < 16) ? BN : CN; const int nc0 = (cg8 & 15) * 8;
#pragma unroll
                for (int ii = 0; ii < 4; ++ii) *(u32x4*)(NAT + (4 * tq + ii) * SNP + nc0) = pack8f(vb[ii]);
                if (cg8 < 16) {
                    float wg[4];
#pragma unroll
                    for (int ii = 0; ii < 4; ++ii) { const int t = 4 * tq + ii; wg[ii] = DT[t] * __expf(cum_end - CUM[t]); }
#pragma unroll
                    for (int e = 0; e < 8; ++e) { u32x2 q; q.x = pk2(vb[0][e] * wg[0], vb[1][e] * wg[1]); q.y = pk2(vb[2][e] * wg[2], vb[3][e] * wg[3]);
                        *(u32x2*)(BWT + (nc0 + e) * SXP + 4 * tq) = q; }
                }
            }
            float wx[4][8], bx[8];
#pragma unroll
            for (int j = 0; j < 4; ++j) { const f32x4 c0 = *(const f32x4*)(cw + j * CD + xcol), c1 = *(const f32x4*)(cw + j * CD + xcol + 4);
#pragma unroll
                for (int e = 0; e < 4; ++e) { wx[j][e] = c0[e]; wx[j][4 + e] = c1[e]; } }
            { const f32x4 c0 = *(const f32x4*)(cb + xcol), c1 = *(const f32x4*)(cb + xcol + 4);
#pragma unroll
              for (int e = 0; e < 4; ++e) { bx[e] = c0[e]; bx[4 + e] = c1[e]; } }
            float xv[8];
#pragma unroll
            for (int e = 0; e < 8; ++e) { float s = bx[e];
#pragma unroll
                for (int j = 0; j < 4; ++j) s += wx[j][e] * bfel(rx[j], e);
                xv[e] = siluf_(s); XT[(cgx * 8 + e) * SXP + tx] = f2bf(xv[e]); }
            __syncthreads();
            {
                const int ti = wid >> 1;
#pragma unroll
                for (int s2 = 0; s2 < 2; ++s2) { const int si = 2 * (wid & 1) + s2; f32x4 gacc = {0.f, 0.f, 0.f, 0.f};
                    if (si <= ti) {
#pragma unroll
                        for (int kk = 0; kk < 4; ++kk) { const bf16x8 av = *(const bf16x8*)(CN + (ti * 16 + l15) * SNP + kk * 32 + quad * 8), bv = *(const bf16x8*)(BN + (si * 16 + l15) * SNP + kk * 32 + quad * 8);
                            gacc = __builtin_amdgcn_mfma_f32_16x16x32_bf16(av, bv, gacc, 0, 0, 0); } }
                    const int s = si * 16 + l15; const float cs = CUM[s], ds = DT[s];
#pragma unroll
                    for (int j = 0; j < 4; ++j) { const int t = ti * 16 + quad * 4 + j; const float val = (s <= t) ? gacc[j] * __expf(CUM[t] - cs) * ds : 0.f; MSm[t * SXP + s] = f2bf(val); } }
            }
            __syncthreads();
            {
                const int ti = wid >> 1;
#pragma unroll
                for (int p2 = 0; p2 < 2; ++p2) { const int pi = 2 * (wid & 1) + p2; f32x4 y = {0.f, 0.f, 0.f, 0.f};
#pragma unroll
                    for (int kk = 0; kk < 4; ++kk) { const bf16x8 av = *(const bf16x8*)(CN + (ti * 16 + l15) * SNP + kk * 32 + quad * 8), bv = *(const bf16x8*)(HS + (pi * 16 + l15) * SNP + kk * 32 + quad * 8);
                        y = __builtin_amdgcn_mfma_f32_16x16x32_bf16(av, bv, y, 0, 0, 0); }
#pragma unroll
                    for (int j = 0; j < 4; ++j) y[j] *= __expf(CUM[ti * 16 + quad * 4 + j]);
#pragma unroll
                    for (int kk = 0; kk < 2; ++kk) { const bf16x8 av = *(const bf16x8*)(MSm + (ti * 16 + l15) * SXP + kk * 32 + quad * 8), bv = *(const bf16x8*)(XT + (pi * 16 + l15) * SXP + kk * 32 + quad * 8);
                        y = __builtin_amdgcn_mfma_f32_16x16x32_bf16(av, bv, y, 0, 0, 0); }
#pragma unroll
                    for (int j = 0; j < 4; ++j) YS[(ti * 16 + quad * 4 + j) * SYP + pi * 16 + l15] = y[j]; }
                const float dec = __expf(cum_end);
#pragma unroll
                for (int i = 0; i < 4; ++i) { const int nb = 4 * (wid & 1) + i; st[i] = st[i] * dec;
#pragma unroll
                    for (int kk = 0; kk < 2; ++kk) { const bf16x8 av = *(const bf16x8*)(XT + (pb * 16 + l15) * SXP + kk * 32 + quad * 8), bv = *(const bf16x8*)(BWT + (nb * 16 + l15) * SXP + kk * 32 + quad * 8);
                        st[i] = __builtin_amdgcn_mfma_f32_16x16x32_bf16(av, bv, st[i], 0, 0, 0); } }
            }
            __syncthreads();
            { u16* hp_ = HS + hs_off;
#pragma unroll
              for (int i = 0; i < 4; ++i)
#pragma unroll
                for (int j = 0; j < 4; ++j) hp_[j * SNP + i * 16] = f2bf(st[i][j]); }
            {
                const f32x4 y0 = *(const f32x4*)(YS + tx * SYP + cgx * 8), y1 = *(const f32x4*)(YS + tx * SYP + cgx * 8 + 4);
                float zf[8], o[8]; unpack8(zw, zf);
#pragma unroll
                for (int e = 0; e < 8; ++e) { const float yv = (e < 4 ? y0[e & 3] : y1[e & 3]) + Dh * xv[e]; o[e] = yv * siluf_(zf[e]); }
                *(u32x4*)(Z + (size_t)(r0 + tx) * DI + xcol) = pack8f(o);
            }
        }
        float* so = p->out + (smp ? O_SSMS : O_SSMP) + ((size_t)b * 64 + hd) * 64 * 128 + st_off;
#pragma unroll
        for (int i = 0; i < 4; ++i)
#pragma unroll
            for (int j = 0; j < 4; ++j) so[j * 128 + i * 16] = st[i][j];
        __syncthreads();
    }
}
__device__ __forceinline__ float logsig_(float f) { return fminf(f, 0.f) - log1pf(__expf(-fabsf(f))); }
__device__ __forceinline__ void phase_gn(KPrm p, const Ctx cx) {
    const int tid = cx.tid, lane = tid & 63, wid = tid >> 6;
    const int gw = cx.bid * 8 + wid, NGW = cx.G * 8;
    const float* SM = (const float*)(p->ws + W_SMALL);
    if (gw < 192) {
        if (gw < 64) { const int b = gw >> 4, h = gw & 15; const float fb = p->in[I_FB][h];
            float* bias = (float*)(p->ws + W_BIASP) + (size_t)(b * 16 + h) * TP; float* lo = p->out + O_LFP;
            const int tb = lane * 128; float s = 0.f;
            for (int i = 0; i < 128; ++i) s += logsig_(SM[(size_t)(b * TP + tb + i) * 256 + 64 + h] + fb);
            float inc = s;
#pragma unroll
            for (int o = 1; o < 64; o <<= 1) { const float y = __shfl_up(inc, o); if (lane >= o) inc += y; }
            float run = inc - s;
            for (int i = 0; i < 128; ++i) { const float lf = logsig_(SM[(size_t)(b * TP + tb + i) * 256 + 64 + h] + fb); run += lf;
                lo[(size_t)(b * TP + tb + i) * 16 + h] = lf; bias[tb + i] = -run * LOG2E; }
        } else { const int u = gw - 64, sb = u >> 4, h = u & 15; const float fb = p->in[I_FB][h];
            float* bias = (float*)(p->ws + W_BIASS) + (size_t)(sb * 16 + h) * SKVS; float* lo = p->out + O_LFS;
            const int tb = lane * 33; float s = 0.f;
            for (int i = 0; i < 33; ++i) { const int pos = tb + i;
                s += (pos < PAST) ? p->in[I_CLF][(size_t)(sb * PAST + pos) * 16 + h] : logsig_(SM[(size_t)(MP + sb * TS + pos - PAST) * 256 + 64 + h] + fb); }
            float inc = s;
#pragma unroll
            for (int o = 1; o < 64; o <<= 1) { const float y = __shfl_up(inc, o); if (lane >= o) inc += y; }
            float run = inc - s;
            for (int i = 0; i < 33; ++i) { const int pos = tb + i; float lf;
                if (pos < PAST) lf = p->in[I_CLF][(size_t)(sb * PAST + pos) * 16 + h];
                else { lf = logsig_(SM[(size_t)(MP + sb * TS + pos - PAST) * 256 + 64 + h] + fb); lo[(size_t)(sb * TS + pos - PAST) * 16 + h] = lf; }
                run += lf; bias[pos] = -run * LOG2E; }
        }
    }
    {
        const u16* XBC = (const u16*)(p->ws + W_XBC);
        const int gt = cx.bid * 512 + tid, GT = cx.G * 512;
        for (int i = gt; i < 12 * 3 * CD; i += GT) { const int bb = i / (3 * CD), r = (i / CD) % 3, c = i % CD;
            if (bb < 4) p->out[O_MCP + i] = bflo(XBC[(size_t)(bb * TP + TP - 3 + r) * CD + c]);
            else p->out[O_MCS + (i - 4 * 3 * CD)] = bflo(XBC[(size_t)(MP + (bb - 4) * TS + TS - 3 + r) * CD + c]); }
    }
    u16* Z = (u16*)(p->ws + W_Z); const float* mnw = p->in[I_MNW];
    for (int row = gw; row < M; row += NGW) {
#pragma unroll 2
        for (int i = 0; i < 8; ++i) { const int col = i * 512 + lane * 8; u16* zp = Z + (size_t)row * DI + col;
            float v[8]; unpack8(*(const u32x4*)zp, v); float ss = 0.f;
#pragma unroll
            for (int e = 0; e < 8; ++e) ss += v[e] * v[e];
            const float rs = rsqrtf(wave_sum(ss) * (1.f / 512.f) + EPS);
            const f32x4 w0 = *(const f32x4*)(mnw + col), w1 = *(const f32x4*)(mnw + col + 4);
#pragma unroll
            for (int e = 0; e < 8; ++e) v[e] = v[e] * rs * (e < 4 ? w0[e & 3] : w1[e & 3]);
            *(u32x4*)zp = pack8f(v); }
    }
}
__device__ __forceinline__ void phase_qk(KPrm p, const Ctx cx) {
    const int tid = cx.tid, lane = tid & 63, wid = tid >> 6;
    const int gw = cx.bid * 8 + wid, NGW = cx.G * 8;
    u16* Q = (u16*)(p->ws + W_Q); u16* K = (u16*)(p->ws + W_K); const u16* V = (const u16*)(p->ws + W_V);
    u16* Ks = (u16*)p->out; u16* Vs = Ks + (size_t)NBS * SKVS * DM;
    const float QS = 0.08838834764831845f * LOG2E;
    const int hc = (lane & 15) * 8;
    const f32x4 qw0 = *(const f32x4*)(p->in[I_QNW] + hc), qw1 = *(const f32x4*)(p->in[I_QNW] + hc + 4), kw0 = *(const f32x4*)(p->in[I_KNW] + hc), kw1 = *(const f32x4*)(p->in[I_KNW] + hc + 4);
    for (int row = gw; row < M; row += NGW) {
        const bool smp = row >= MP;
        float* ko = smp ? p->out + O_KS + (size_t)(row - MP) * DM : p->out + O_KP + (size_t)row * DM;
        float* vo = smp ? p->out + O_VS + (size_t)(row - MP) * DM : p->out + O_VP + (size_t)row * DM;
        size_t srow = 0; if (smp) { const int sb = (row - MP) >> 6, t = (row - MP) & 63; srow = (size_t)(sb * SKVS + PAST + t) * DM; }
#pragma unroll
        for (int it = 0; it < 4; ++it) { const int col = it * 512 + lane * 8; const size_t off = (size_t)row * DM + col;
            float v[8], ss;
            unpack8(*(const u32x4*)(Q + off), v); ss = 0.f;
#pragma unroll
            for (int e = 0; e < 8; ++e) ss += v[e] * v[e];
            ss += __shfl_xor(ss, 1); ss += __shfl_xor(ss, 2); ss += __shfl_xor(ss, 4); ss += __shfl_xor(ss, 8);
            float rs = rsqrtf(ss * (1.f / 128.f) + EPS) * QS;
#pragma unroll
            for (int e = 0; e < 8; ++e) v[e] = v[e] * rs * (e < 4 ? qw0[e & 3] : qw1[e & 3]);
            *(u32x4*)(Q + off) = pack8f(v);
            unpack8(*(const u32x4*)(K + off), v); ss = 0.f;
#pragma unroll
            for (int e = 0; e < 8; ++e) ss += v[e] * v[e];
            ss += __shfl_xor(ss, 1); ss += __shfl_xor(ss, 2); ss += __shfl_xor(ss, 4); ss += __shfl_xor(ss, 8);
            rs = rsqrtf(ss * (1.f / 128.f) + EPS);
#pragma unroll
            for (int e = 0; e < 8; ++e) v[e] = v[e] * rs * (e < 4 ? kw0[e & 3] : kw1[e & 3]);
            const u32x4 kp = pack8f(v);
            *(u32x4*)(K + off) = kp;
            *(f32x4*)(ko + col) = (f32x4){v[0], v[1], v[2], v[3]}; *(f32x4*)(ko + col + 4) = (f32x4){v[4], v[5], v[6], v[7]};
            const u32x4 vw = *(const u32x4*)(V + off); unpack8(vw, v);
            *(f32x4*)(vo + col) = (f32x4){v[0], v[1], v[2], v[3]}; *(f32x4*)(vo + col + 4) = (f32x4){v[4], v[5], v[6], v[7]};
            if (smp) { *(u32x4*)(Ks + srow + col) = kp; *(u32x4*)(Vs + srow + col) = vw; } }
    }
}
typedef att::BlockRef<att::bf16, att::bf16> ARef;
__device__ __forceinline__ ARef att_ref(KPrm p, const Ctx cx, int i, int nbp, int& skv) {
    const int G = cx.G, bid = cx.bid; ARef r;
    att::bf16* Qb = (att::bf16*)(p->ws + W_Q); const att::bf16* Kb = (const att::bf16*)(p->ws + W_K); const att::bf16* Vb = (const att::bf16*)(p->ws + W_V);
    if (i < nbp) { const int L = bid + (i >> 1) * G, bh = L >> 4, x = L & 15, qb = (i & 1) ? 31 - x : x, b = bh >> 4, h = bh & 15;
        const size_t rq = ((size_t)b * TP + (size_t)qb * 256) * DM + h * 128, rk = (size_t)b * TP * DM + h * 128;
        r.Q = Qb + rq; r.O = Qb + rq; r.K = Kb + rk; r.V = Vb + rk; r.Bs = (const float*)(p->ws + W_BIASP) + (size_t)bh * TP; r.P0 = qb * 256; r.nvalid = 256; skv = TP;
    } else { const int su = bid + (i - nbp) * G, sb = su >> 4, h = su & 15;
        const att::bf16* Ks = (const att::bf16*)p->out; const att::bf16* Vs = Ks + (size_t)NBS * SKVS * DM;
        const size_t rq = ((size_t)MP + (size_t)sb * TS) * DM + h * 128, rk = (size_t)sb * SKVS * DM + h * 128;
        r.Q = Qb + rq; r.O = Qb + rq; r.K = Ks + rk; r.V = Vs + rk; r.Bs = (const float*)(p->ws + W_BIASS) + (size_t)su * SKVS; r.P0 = PAST; r.nvalid = TS; skv = SKVS; }
    return r;
}
__device__ __forceinline__ void phase_att(KPrm p, const Ctx cx, char* lds) {
    const int G = cx.G, bid = cx.bid;
    const int nip = (bid < 1024) ? (1024 - bid + G - 1) / G : 0, nbp = 2 * nip, nbs = (bid < 128) ? (128 - bid + G - 1) / G : 0, nb = nbp + nbs;
    if (nb == 0) return;
    const int W = 1 << 30;
    int skv, skvn; ARef cur = att_ref(p, cx, 0, nbp, skv);
    att::Seam<att::bf16> S;
    att::causal_swa_prime<att::bf16, att::bf16>(cur, W, lds, S, cx.tid);
    for (int i = 0; i < nb; ++i) {
        const bool last = (i + 1 == nb);
        ARef nxt = cur; skvn = skv; if (!last) nxt = att_ref(p, cx, i + 1, nbp, skvn);
        att::causal_swa_block<att::bf16, att::bf16>(cur, nxt, skv, W, lds, S, cx.tid);
        cur = nxt; skv = skvn;
    }
}
__device__ __forceinline__ void phase_cv(KPrm p, const Ctx cx, int half) {
    const int tid = cx.tid;
    const u16* U = (const u16*)(p->ws + W_U); u16* Gb = (u16*)(p->ws + W_G); u16* HALO = (u16*)(p->ws + W_HALO);
    const float* cw = p->in[I_FCW]; const float* cb = p->in[I_FCB];
    const int row_lo = half ? HALF_ROWS : 0;
    constexpr int NCG = DFF / 8, RB = 16, NRB = HALF_ROWS / RB;
    const long gt = (long)cx.bid * 512 + tid, GT = (long)cx.G * 512;
    for (long it = gt; it < (long)NCG * NRB; it += GT) {
        const int cgi = (int)(it % NCG), rb = (int)(it / NCG); const int f0 = cgi * 8, r0 = row_lo + rb * RB;
        const int ca = (f0 >> 7) * 256 + (f0 & 127), cbb = ca + 128;
        float wa[3][8], wb[3][8], ba[8], bb[8];
#pragma unroll
        for (int k = 0; k < 3; ++k) { const f32x4 a0 = *(const f32x4*)(cw + k * DFF2 + f0), a1 = *(const f32x4*)(cw + k * DFF2 + f0 + 4), b0 = *(const f32x4*)(cw + k * DFF2 + DFF + f0), b1 = *(const f32x4*)(cw + k * DFF2 + DFF + f0 + 4);
#pragma unroll
            for (int e = 0; e < 4; ++e) { wa[k][e] = a0[e]; wa[k][4 + e] = a1[e]; wb[k][e] = b0[e]; wb[k][4 + e] = b1[e]; } }
        { const f32x4 a0 = *(const f32x4*)(cb + f0), a1 = *(const f32x4*)(cb + f0 + 4), b0 = *(const f32x4*)(cb + DFF + f0), b1 = *(const f32x4*)(cb + DFF + f0 + 4);
#pragma unroll
          for (int e = 0; e < 4; ++e) { ba[e] = a0[e]; ba[4 + e] = a1[e]; bb[e] = b0[e]; bb[4 + e] = b1[e]; } }
        float ha[2][8], hb[2][8];
        const bool smp = r0 >= MP; const int tb = smp ? ((r0 - MP) & 63) : (r0 & (TP - 1));
        if (tb == 0) {
            if (smp) { const float* s = p->in[I_FCV] + (size_t)((r0 - MP) >> 6) * 2 * DFF2;
#pragma unroll
                for (int k = 0; k < 2; ++k)
#pragma unroll
                    for (int e = 0; e < 8; ++e) { ha[k][e] = s[k * DFF2 + f0 + e]; hb[k][e] = s[k * DFF2 + DFF + f0 + e]; }
            } else {
#pragma unroll
                for (int k = 0; k < 2; ++k)
#pragma unroll
                    for (int e = 0; e < 8; ++e) { ha[k][e] = 0.f; hb[k][e] = 0.f; } }
        } else if (half && rb == 0) {
#pragma unroll
            for (int k = 0; k < 2; ++k) { unpack8(*(const u32x4*)(HALO + (size_t)k * DFF2 + ca), ha[k]); unpack8(*(const u32x4*)(HALO + (size_t)k * DFF2 + cbb), hb[k]); }
        } else {
#pragma unroll
            for (int k = 0; k < 2; ++k) { const size_t ro = (size_t)(r0 - row_lo - 2 + k) * DFF2; unpack8(*(const u32x4*)(U + ro + ca), ha[k]); unpack8(*(const u32x4*)(U + ro + cbb), hb[k]); }
        }
#pragma unroll 4
        for (int i = 0; i < RB; ++i) { const int r = r0 + i; const size_t ro = (size_t)(r - row_lo) * DFF2;
            const u32x4 uaw = *(const u32x4*)(U + ro + ca), ubw = *(const u32x4*)(U + ro + cbb);
            float ua[8], ub[8], o[8]; unpack8(uaw, ua); unpack8(ubw, ub);
#pragma unroll
            for (int e = 0; e < 8; ++e) { const float va = ba[e] + wa[0][e] * ha[0][e] + wa[1][e] * ha[1][e] + wa[2][e] * ua[e], vb = bb[e] + wb[0][e] * hb[0][e] + wb[1][e] * hb[1][e] + wb[2][e] * ub[e];
                o[e] = siluf_(va) * vb; ha[0][e] = ha[1][e]; ha[1][e] = ua[e]; hb[0][e] = hb[1][e]; hb[1][e] = ub[e]; }
            *(u32x4*)(Gb + (size_t)r * DFF + f0) = pack8f(o);
            const int tpos = (r >= MP) ? ((r - MP) & 63) : (r & (TP - 1)), tlen = (r >= MP) ? TS : TP;
            if (tpos >= tlen - 2) { float* fo = (r >= MP) ? p->out + O_FCS + ((size_t)((r - MP) >> 6) * 2 + (tpos - (tlen - 2))) * DFF2 : p->out + O_FCP + ((size_t)(r >> 13) * 2 + (tpos - (tlen - 2))) * DFF2;
#pragma unroll
                for (int e = 0; e < 8; ++e) { fo[f0 + e] = ua[e]; fo[DFF + f0 + e] = ub[e]; } }
            if (!half && r >= HALF_ROWS - 2) { *(u32x4*)(HALO + (size_t)(r - (HALF_ROWS - 2)) * DFF2 + ca) = uaw; *(u32x4*)(HALO + (size_t)(r - (HALF_ROWS - 2)) * DFF2 + cbb) = ubw; }
        }
    }
}
constexpr int LDS_TOTAL = 147456;
enum { PH_PREP = 0, PH_N1, PH_G1A, PH_SSD, PH_GN, PH_G1B, PH_G2, PH_G1C, PH_QK, PH_ATT, PH_G3, PH_G4, PH_N2, PH_G5A, PH_CVA, PH_G5B, PH_CVB, PH_G6, PH_COUNT };
__device__ __forceinline__ void run_gemms(KPrm p, const Ctx cx, unsigned char* lds, const int first, const int last, cg::grid_group& grid) {
#pragma unroll 1
    for (int ph = first; ph <= last; ++ph) {
        unsigned char* ws = p->ws;
        pg8::Gemm g; Epi E;
        g.A = (const u16*)(ws + W_H); g.Bt = nullptr; g.M = M; g.N = DM; g.K = DM;
        E.mode = 0; E.d0 = E.d1 = E.d2 = nullptr; E.t1 = E.t2 = 1 << 20; E.p0 = E.p1 = E.p2 = 0; E.f32seg2 = 0;
        E.xp = p->in[I_XP]; E.xs = p->in[I_XS]; E.y = p->out; E.mod = (const float*)(ws + W_MOD); E.gbuf = (u16*)(ws + W_GM); E.gf = (const u16*)(ws + W_GF);
        switch (ph) {
        case PH_G1A: g.Bt = (const u16*)(ws + W_WIN); g.N = 41 * 256;
            E.d0 = (u16*)(ws + W_XBC); E.p0 = CD; E.t1 = 24; E.d1 = (u16*)(ws + W_Z); E.p1 = DI; E.t2 = 40; E.d2 = (u16*)(ws + W_SMALL); E.p2 = 256; E.f32seg2 = 1; break;
        case PH_G1B: g.Bt = (const u16*)(ws + W_WIN) + (size_t)10496 * DM; g.N = 16 * 256;
            E.d0 = (u16*)(ws + W_GM); E.p0 = DM; E.t1 = 8; E.d1 = (u16*)(ws + W_GF); E.p1 = DM; break;
        case PH_G2: g.A = (const u16*)(ws + W_Z); g.Bt = (const u16*)(ws + W_WPM); g.K = DI; E.mode = 1; break;
        case PH_G1C: g.Bt = (const u16*)(ws + W_WIN) + (size_t)14592 * DM; g.N = 24 * 256;
            E.d0 = (u16*)(ws + W_Q); E.p0 = DM; E.t1 = 8; E.d1 = (u16*)(ws + W_K); E.p1 = DM; E.t2 = 16; E.d2 = (u16*)(ws + W_V); E.p2 = DM; break;
        case PH_G3: g.A = (const u16*)(ws + W_Q); g.Bt = (const u16*)(ws + W_WPF); E.mode = 2; break;
        case PH_G4: g.A = (const u16*)(ws + W_GM); g.Bt = (const u16*)(ws + W_WOUT); E.mode = 3; break;
        case PH_G5A: g.Bt = (const u16*)(ws + W_WUP); g.M = HALF_ROWS; g.N = DFF2; E.d0 = (u16*)(ws + W_U); E.p0 = DFF2; break;
        case PH_G5B: g.A = (const u16*)(ws + W_H) + (size_t)HALF_ROWS * DM; g.Bt = (const u16*)(ws + W_WUP); g.M = HALF_ROWS; g.N = DFF2; E.d0 = (u16*)(ws + W_U); E.p0 = DFF2; break;
        default:   g.A = (const u16*)(ws + W_G); g.Bt = (const u16*)(ws + W_WDN); g.K = DFF; E.mode = 5; break;
        }
        pg8::StaticOrder S; S.init(g.M, g.N, cx.G, cx.bid);
        pg8::gemm_phase<Epi, pg8::StaticOrder, true, true>((PG8_LAS unsigned char*)lds, g, S, E, cx.tid);
        if (ph < last) grid.sync();
    }
}
#define PH_BEGIN() Ctx cx; { int t_ = threadIdx.x; asm volatile("" : "+v"(t_)); int b_ = blockIdx.x, g_ = gridDim.x; asm volatile("" : "+s"(b_), "+s"(g_)); cx.tid = t_; cx.bid = b_; cx.G = g_; } \
    KPrm p = (KPrm)__builtin_amdgcn_kernarg_segment_ptr(); asm volatile("" : "+s"(p))
#ifdef ONLY_PH
#define PH_ON(k) ((k) == ONLY_PH)
#else
#define PH_ON(k) true
#endif
__global__ void __launch_bounds__(512, 2) mega_fwd(Prm prm_unused) {
    extern __shared__ __attribute__((aligned(16))) unsigned char lds[];
    cg::grid_group grid = cg::this_grid();
    if (PH_ON(PH_PREP)) { PH_BEGIN(); phase_prep(p, cx, lds); } grid.sync();
    if (PH_ON(PH_N1)) { PH_BEGIN(); phase_norm(p, cx, 0); } grid.sync();
    if (PH_ON(PH_G1A)) { PH_BEGIN(); run_gemms(p, cx, lds, PH_G1A, PH_G1A, grid); } grid.sync();
    if (PH_ON(PH_SSD)) { PH_BEGIN(); phase_ssd(p, cx, lds); } grid.sync();
    if (PH_ON(PH_GN)) { PH_BEGIN(); phase_gn(p, cx); } grid.sync();
    if (PH_ON(PH_G1B)) { PH_BEGIN(); run_gemms(p, cx, lds, PH_G1B, PH_G1C, grid); } grid.sync();
    if (PH_ON(PH_QK)) { PH_BEGIN(); phase_qk(p, cx); } grid.sync();
    if (PH_ON(PH_ATT)) { PH_BEGIN(); phase_att(p, cx, (char*)lds); } grid.sync();
    if (PH_ON(PH_G3)) { PH_BEGIN(); run_gemms(p, cx, lds, PH_G3, PH_G4, grid); } grid.sync();
    if (PH_ON(PH_N2)) { PH_BEGIN(); phase_norm(p, cx, 1); } grid.sync();
    if (PH_ON(PH_G5A)) { PH_BEGIN(); run_gemms(p, cx, lds, PH_G5A, PH_G5A, grid); } grid.sync();
    if (PH_ON(PH_CVA)) { PH_BEGIN(); phase_cv(p, cx, 0); } grid.sync();
    if (PH_ON(PH_G5B)) { PH_BEGIN(); run_gemms(p, cx, lds, PH_G5B, PH_G5B, grid); } grid.sync();
    if (PH_ON(PH_CVB)) { PH_BEGIN(); phase_cv(p, cx, 1); } grid.sync();
    if (PH_ON(PH_G6)) { PH_BEGIN(); run_gemms(p, cx, lds, PH_G6, PH_G6, grid); }
}

extern "C" void kernel_launch(void* const* d_in, const int* in_sizes, int n_in, void* d_out, int out_size, void* d_ws, size_t ws_size, hipStream_t stream) {
    static int grid = 0;
    if (grid == 0) {
        if (n_in != 31 || (size_t)out_size != O_END || ws_size < 1024 * MiB) { fprintf(stderr, "kernel_launch: unexpected sizes n_in %d out %d ws %zu\n", n_in, out_size, ws_size); }
        int dev = 0, cus = 0, per_cu = 0;
        hipGetDevice(&dev); hipDeviceGetAttribute(&cus, hipDeviceAttributeMultiprocessorCount, dev);
        hipFuncSetAttribute((const void*)mega_fwd, hipFuncAttributeMaxDynamicSharedMemorySize, LDS_TOTAL);
        hipOccupancyMaxActiveBlocksPerMultiprocessor(&per_cu, (const void*)mega_fwd, 512, LDS_TOTAL);
        (void)hipGetLastError();
        if (per_cu < 1) per_cu = 1;
        grid = cus;
    }
    Prm prm{};
    for (int i = 0; i < 31; ++i) prm.in[i] = (const float*)d_in[i];
    prm.out = (float*)d_out; prm.ws = (unsigned char*)d_ws;
    void* args[] = {&prm};
    hipError_t e = hipLaunchCooperativeKernel((const void*)mega_fwd, dim3(grid), dim3(512), args, LDS_TOTAL, stream);
    if (e != hipSuccess) fprintf(stderr, "cooperative launch failed: %s (grid %d)\n", hipGetErrorString(e), grid);
}
```

```cpp
#include <hip/hip_runtime.h>
#include <hip/hip_cooperative_groups.h>
#include <hip/hip_bf16.h>
#include <cstdio>
#include <cstdint>
namespace cg = cooperative_groups;
namespace pg8 {
#define PG8_LAS __attribute__((address_space(3)))
typedef unsigned short bf16_t;
typedef short bf16x8 __attribute__((ext_vector_type(8)));
typedef float f32x4 __attribute__((ext_vector_type(4)));
typedef unsigned u32x4 __attribute__((ext_vector_type(4)));
constexpr int BM = 256, BK = 64, HALF = 128, HTB = HALF * BK * 2  , STAGE_BYTES = 8 * HTB, NXCD = 8, WGM = 8;

__host__ __device__ __forceinline__ int lds_byte(int r, int c) { const int st = (r >> 4) * 2 + (c >> 5), rr = r & 15, cc = c & 31, ob = rr * 64 + cc * 2; return st * 1024 + (ob ^ (((ob >> 9) & 1) << 5)); }
__host__ __device__ __forceinline__ void stage_rc(int b, int& R, int& C) { const int st = b / 1024, sb = b % 1024, swz = sb ^ (((sb >> 9) & 1) << 5); R = (st >> 1) * 16 + swz / 64; C = (st & 1) * 32 + (swz % 64) / 2; }
__host__ __device__ __forceinline__ int perm32(int rho) { const int n = rho >> 4, i = rho & 15; return 8 * (i >> 2) + 4 * n + (i & 3); }

struct Unit { int pm, pn; };
struct Gemm { const bf16_t* A; const bf16_t* Bt; int M, N, K; };

struct StaticOrder {
    int nM, nN, nwg, G, c;
    __host__ __device__ void init(int M, int N, int G_, int c_) { nM = M / BM; nN = N / BM; nwg = nM * nN; G = G_; c = c_; }
    __host__ __device__ bool next(int i, Unit& u) const {
        const long L = (long)i * G + c; if (L >= nwg) return false;
        int wgid = (int)L; { const int q = nwg / NXCD, r = nwg % NXCD, xcd = wgid % NXCD, off = wgid / NXCD; wgid = (xcd < r ? xcd * (q + 1) : r * (q + 1) + (xcd - r) * q) + off; }
        const int nig = WGM * nN, gid = wgid / nig, fm = gid * WGM, gsz = (nM - fm) < WGM ? (nM - fm) : WGM;
        u.pm = fm + ((wgid % nig) % gsz); u.pn = (wgid % nig) / gsz; return true;
    }
    __device__ __forceinline__ void a_ready(const Unit&) const {}
    __device__ __forceinline__ void done(const Unit&) const {}
};
__device__ __forceinline__ unsigned cvt_pk_bf16(float lo, float hi) { unsigned r; asm volatile("v_cvt_pk_bf16_f32 %0, %1, %2" : "=v"(r) : "v"(lo), "v"(hi)); return r; }
typedef float f32x2 __attribute__((ext_vector_type(2)));
template <class Epi, class Sched, bool ALIGN_EPI = false, bool SP2 = false>
__device__ __forceinline__ void gemm_phase(PG8_LAS unsigned char* lds, const Gemm g, const Sched& S, const Epi& E, const int tid) {
    const int wid = __builtin_amdgcn_readfirstlane(tid >> 6), lane = tid & 63, wr = wid >> 2, wc = wid & 3, fr = lane & 15, fq = lane >> 4;
    const int K = g.K, nt = K / BK;
    unsigned voffA[2], voffB[2];
#pragma unroll
    for (int i = 0; i < 2; ++i) { int R, C; stage_rc(tid * 16 + i * 8192, R, C); const int Rb = Epi::PERM ? ((R & ~31) + perm32(R & 31)) : R;
        voffA[i] = (unsigned)(R * K + C) * 2u; voffB[i] = (unsigned)(Rb * K + C) * 2u; }
    const size_t kstep = (size_t)(BK * 2);
    const size_t hstep = (size_t)HALF * K * 2;
    const size_t tstep = 2 * hstep;
    const unsigned ldsw = (unsigned)wid * 1024u;
    const int aoff = lds_byte(wr * 64 + fr, fq * 8), boff = lds_byte(wc * 32 + fr, fq * 8);
#define PG8_SA(b, h) (((b) * 2 + (h)) * HTB)
#define PG8_SB(b, h) ((4 + (b) * 2 + (h)) * HTB)
#define PG8_STAGE(bufoff, gbase, voff) do { _Pragma("unroll") for (int _i = 0; _i < 2; ++_i) \
        __builtin_amdgcn_global_load_lds((const unsigned*)((const char*)(gbase) + (voff)[_i]), (PG8_LAS unsigned*)(lds + (bufoff) + ldsw + _i * 8192), 16, 0, 0); } while (0)
#define PG8_LDA(dst, b, h) do { _Pragma("unroll") for (int m = 0; m < 4; ++m) _Pragma("unroll") for (int k = 0; k < 2; ++k) dst[m][k] = *(const PG8_LAS bf16x8*)(lds + PG8_SA(b, h) + aoff + m * 2048 + k * 1024); } while (0)
#define PG8_LDB(dst, b, h) do { _Pragma("unroll") for (int n = 0; n < 2; ++n) _Pragma("unroll") for (int k = 0; k < 2; ++k) dst[n][k] = *(const PG8_LAS bf16x8*)(lds + PG8_SB(b, h) + boff + n * 2048 + k * 1024); } while (0)
#define PG8_MMA(ai, bj, At, Bt) do { __builtin_amdgcn_s_setprio(1); _Pragma("unroll") for (int m = 0; m < 4; ++m) _Pragma("unroll") for (int n = 0; n < 2; ++n) _Pragma("unroll") for (int k = 0; k < 2; ++k) \
        acc[ai][bj][m][n] = __builtin_amdgcn_mfma_f32_16x16x32_bf16(Bt[n][k], At[m][k], acc[ai][bj][m][n], 0, 0, 0); __builtin_amdgcn_s_setprio(0); } while (0)
#define PG8_WAIT_V(n) asm volatile("s_waitcnt vmcnt(" #n ")" ::: "memory")
#define PG8_WAIT_L(n) asm volatile("s_waitcnt lgkmcnt(" #n ")" ::: "memory")
#define PG8_BAR __builtin_amdgcn_s_barrier()
#define PG8_SCHED __builtin_amdgcn_sched_barrier(0)
    Unit cur, nxt; int ui = 0;
    if (!S.next(0, cur)) return;
    f32x4 acc[2][2][4][2];
#pragma unroll
    for (int a = 0; a < 2; ++a)
#pragma unroll
        for (int b = 0; b < 2; ++b)
#pragma unroll
            for (int m = 0; m < 4; ++m)
#pragma unroll
                for (int n = 0; n < 2; ++n) acc[a][b][m][n] = (f32x4){0.f, 0.f, 0.f, 0.f};
    bf16x8 At[4][2], B0[2][2], B1[2][2];
    const char* cA = (const char*)g.A + (size_t)cur.pm * tstep; const char* cB = (const char*)g.Bt + (size_t)cur.pn * tstep;
    S.a_ready(cur);
    if constexpr (SP2) {
        PG8_STAGE(PG8_SB(0, 0), cB, voffB); PG8_STAGE(PG8_SB(0, 1), cB + hstep, voffB); PG8_STAGE(PG8_SA(0, 0), cA, voffA); PG8_STAGE(PG8_SA(0, 1), cA + hstep, voffA);
        if (wr == 1) PG8_BAR;
        PG8_WAIT_V(2); PG8_BAR;
        PG8_STAGE(PG8_SB(1, 0), cB + kstep, voffB); PG8_STAGE(PG8_SA(1, 0), cA + kstep, voffA); PG8_STAGE(PG8_SB(1, 1), cB + hstep + kstep, voffB);
        PG8_WAIT_V(6); PG8_BAR;
    } else {
        PG8_STAGE(PG8_SB(0, 0), cB, voffB); PG8_STAGE(PG8_SA(0, 0), cA, voffA); PG8_STAGE(PG8_SB(0, 1), cB + hstep, voffB); PG8_STAGE(PG8_SA(0, 1), cA + hstep, voffA);
        if (wr == 1) PG8_BAR;
        PG8_WAIT_V(4); PG8_BAR;
        PG8_STAGE(PG8_SB(1, 0), cB + kstep, voffB); PG8_STAGE(PG8_SA(1, 0), cA + kstep, voffA); PG8_STAGE(PG8_SB(1, 1), cB + hstep + kstep, voffB);
        PG8_WAIT_V(6); PG8_BAR;
    }
    for (;;) {
        const bool has_next = S.next(ui + 1, nxt);
        const char* nA = has_next ? (const char*)g.A + (size_t)nxt.pm * tstep : cA; const char* nB = has_next ? (const char*)g.Bt + (size_t)nxt.pn * tstep : cB;
        for (int t = 0; t < nt; t += 2) {
            const bool last = (t == nt - 2);
            const char* a1 = cA + (size_t)(t + 1) * kstep;
            const char* a2 = last ? nA : cA + (size_t)(t + 2) * kstep; const char* b2 = last ? nB : cB + (size_t)(t + 2) * kstep;
            const char* a3 = a2 + kstep; const char* b3 = b2 + kstep;
            if (last && has_next) S.a_ready(nxt);
            if constexpr (SP2) {
            PG8_LDB(B0, 0, 0); PG8_LDB(B1, 0, 1); PG8_SCHED; PG8_LDA(At, 0, 0); PG8_STAGE(PG8_SA(1, 1), a1 + hstep, voffA);
            PG8_WAIT_V(8); PG8_WAIT_L(0); PG8_BAR; PG8_MMA(0, 0, At, B0); PG8_MMA(0, 1, At, B1); PG8_BAR; PG8_SCHED;
            PG8_LDA(At, 0, 1); PG8_STAGE(PG8_SB(0, 0), b2, voffB); PG8_STAGE(PG8_SB(0, 1), b2 + hstep, voffB); PG8_STAGE(PG8_SA(0, 0), a2, voffA);
            PG8_WAIT_V(8); PG8_WAIT_L(0); PG8_BAR; PG8_MMA(1, 0, At, B0); PG8_MMA(1, 1, At, B1); PG8_BAR; PG8_SCHED;
            PG8_LDB(B0, 1, 0); PG8_LDB(B1, 1, 1); PG8_SCHED; PG8_LDA(At, 1, 0); PG8_STAGE(PG8_SA(0, 1), a2 + hstep, voffA);
            PG8_WAIT_V(8); PG8_WAIT_L(0); PG8_BAR; PG8_MMA(0, 0, At, B0); PG8_MMA(0, 1, At, B1); PG8_BAR; PG8_SCHED;
            PG8_LDA(At, 1, 1); PG8_STAGE(PG8_SB(1, 0), b3, voffB); PG8_STAGE(PG8_SB(1, 1), b3 + hstep, voffB); PG8_STAGE(PG8_SA(1, 0), a3, voffA);
            PG8_WAIT_V(8); PG8_WAIT_L(0); PG8_BAR; PG8_MMA(1, 0, At, B0); PG8_MMA(1, 1, At, B1); PG8_BAR; PG8_SCHED;
            } else {
            PG8_LDB(B0, 0, 0); PG8_SCHED; PG8_LDA(At, 0, 0); PG8_STAGE(PG8_SA(1, 1), a1 + hstep, voffA);
            PG8_WAIT_L(8); PG8_BAR; PG8_WAIT_L(0); PG8_MMA(0, 0, At, B0); PG8_BAR; PG8_SCHED;
            PG8_LDB(B1, 0, 1); PG8_STAGE(PG8_SB(0, 0), b2, voffB);
            PG8_BAR; PG8_WAIT_L(0); PG8_MMA(0, 1, At, B1); PG8_BAR;
            PG8_LDA(At, 0, 1); PG8_STAGE(PG8_SA(0, 0), a2, voffA);
            PG8_BAR; PG8_WAIT_L(0); PG8_MMA(1, 0, At, B0); PG8_BAR; PG8_SCHED;
            PG8_STAGE(PG8_SB(0, 1), b2 + hstep, voffB);
            PG8_WAIT_V(6); PG8_BAR; PG8_MMA(1, 1, At, B1); PG8_BAR;
            PG8_LDB(B0, 1, 0); PG8_SCHED; PG8_LDA(At, 1, 0); PG8_STAGE(PG8_SA(0, 1), a2 + hstep, voffA);
            PG8_WAIT_L(8); PG8_BAR; PG8_WAIT_L(0); PG8_MMA(0, 0, At, B0); PG8_BAR; PG8_SCHED;
            PG8_LDB(B1, 1, 1); PG8_STAGE(PG8_SB(1, 0), b3, voffB);
            PG8_BAR; PG8_WAIT_L(0); PG8_MMA(0, 1, At, B1); PG8_BAR;
            PG8_LDA(At, 1, 1); PG8_STAGE(PG8_SA(1, 0), a3, voffA);
            PG8_BAR; PG8_WAIT_L(0); PG8_MMA(1, 0, At, B0); PG8_BAR; PG8_SCHED;
            PG8_STAGE(PG8_SB(1, 1), b3 + hstep, voffB);
            PG8_WAIT_V(6); PG8_BAR; PG8_MMA(1, 1, At, B1); PG8_BAR;
            }
        }
        if constexpr (ALIGN_EPI) { if (wr == 0) PG8_BAR; }
        if constexpr (!Epi::AFTER_DRAIN) { E(acc, cur, wr, wc, fr, fq); S.done(cur); }
        if (!has_next) break;
#pragma unroll
        for (int a = 0; a < 2; ++a)
#pragma unroll
            for (int b = 0; b < 2; ++b)
#pragma unroll
                for (int m = 0; m < 4; ++m)
#pragma unroll
                    for (int n = 0; n < 2; ++n) acc[a][b][m][n] = (f32x4){0.f, 0.f, 0.f, 0.f};
        cur = nxt; cA = nA; cB = nB; ++ui;
        if constexpr (ALIGN_EPI) { if (wr == 1) PG8_BAR; }
    }
    PG8_WAIT_V(0);
    if constexpr (!ALIGN_EPI) { if (wr == 0) PG8_BAR; }
    PG8_BAR;
    if constexpr (Epi::AFTER_DRAIN) { E.fused(acc, cur, wr, wc, fr, fq, lds, wid, lane); S.done(cur); }
#undef PG8_SA
#undef PG8_SB
#undef PG8_STAGE
#undef PG8_LDA
#undef PG8_LDB
#undef PG8_MMA
#undef PG8_WAIT_V
#undef PG8_WAIT_L
#undef PG8_BAR
#undef PG8_SCHED
}
}
namespace att {
constexpr int D = 128, PITCH = 2048, NW = 8, QBLK = 32, KVBLK = 64, QB = NW * QBLK;
constexpr int SHM_V = KVBLK * D * 2, SHM_K = KVBLK * D * 2;
constexpr int LDS_BIAS = 2 * SHM_V + 2 * SHM_K + NW * 64 * 4;
constexpr int NQX = 3, LDS_QX = LDS_BIAS + 512;
constexpr int LDS_BYTES = LDS_QX + NW * NQX * 1024;
constexpr float THR2 = 64.f;
constexpr bool WSKIP = false;
typedef __hip_bfloat16 bf16;
typedef short bf16x8 __attribute__((ext_vector_type(8)));
typedef short s16x4 __attribute__((ext_vector_type(4)));
typedef float f32x16 __attribute__((ext_vector_type(16)));
typedef float f32x4 __attribute__((ext_vector_type(4)));
typedef unsigned u32x4 __attribute__((ext_vector_type(4)));
template <class A, class Bt> struct same_t { static constexpr bool v = false; };
template <class A> struct same_t<A, A> { static constexpr bool v = true; };

#define KSWZ(row, colB) ((row) * 256 + ((colB) ^ (((row) & 7) << 4)))
#define SBAR() __builtin_amdgcn_sched_barrier(0)
__device__ __forceinline__ int v_st(int k, int c) { const int kk = (k & ~0xC) | ((k & 4) << 1) | ((k & 8) >> 1); return ((kk >> 3) * 4 + (c >> 5)) * 512 + ((kk & 7) * 32 + (c & 31)) * 2; }
__device__ __forceinline__ int v_rd_base(int lane) { return ((lane & 3) << 3) | (((lane >> 2) & 3) << 6) | (((lane >> 4) & 1) << 5) | (((lane >> 5) & 1) << 8); }
constexpr int v_rd_off(int d0, int ks, int half) { return d0 * 512 + ks * 4096 + half * 2048; }
__device__ __forceinline__ int crow(int r, int hi) { return (r & 3) + 8 * (r >> 2) + 4 * hi; }
__device__ __forceinline__ unsigned cvtpk(float lo, float hi) {
    unsigned r; asm volatile("v_cvt_pk_bf16_f32 %0, %1, %2" : "=v"(r) : "v"(lo), "v"(hi)); return r;
}
__device__ __forceinline__ bf16x8 pack8(f32x4 a, f32x4 b) {
    u32x4 w = {cvtpk(a[0], a[1]), cvtpk(a[2], a[3]), cvtpk(b[0], b[1]), cvtpk(b[2], b[3])};
    return *reinterpret_cast<bf16x8*>(&w);
}
template <class T> __device__ __forceinline__ bf16x8 load8(const T* p) {
    if constexpr (same_t<T, float>::v) { return pack8(*(const f32x4*)p, *(const f32x4*)(p + 4)); }
    else { return *reinterpret_cast<const bf16x8*>(p); }
}
__device__ __forceinline__ void mask_tile(f32x16& p0, f32x16& p1, int dq, unsigned W) {
    const float NEG = -__builtin_inff();
#pragma unroll
    for (int r = 0; r < 16; ++r) {
        const int c = (r & 3) + 8 * (r >> 2);
        if (dq - c < 0) p0[r] = NEG;
        if (dq - c - 32 < 0) p1[r] = NEG;
    }
}
__device__ __forceinline__ void partialSM(f32x16& p0, f32x16& p1, float& m_reg, float& mn, float& alpha) {
    float pmax = p0[0]; for (int r = 1; r < 16; ++r) pmax = fmaxf(pmax, p0[r]); for (int r = 0; r < 16; ++r) pmax = fmaxf(pmax, p1[r]);
    { auto rr = __builtin_amdgcn_permlane32_swap(__float_as_uint(pmax), __float_as_uint(pmax), false, false);
      pmax = fmaxf(__uint_as_float(rr[0]), __uint_as_float(rr[1])); }
    if (__builtin_expect(__all((pmax - m_reg) <= THR2), 1)) { mn = m_reg; alpha = 1.f; }
    else { mn = fmaxf(m_reg, pmax); alpha = __builtin_amdgcn_exp2f(m_reg - mn); m_reg = mn; }
    for (int r = 0; r < 16; ++r) p0[r] = p0[r] - mn; for (int r = 0; r < 16; ++r) p1[r] = p1[r] - mn;
    for (int r = 0; r < 16; ++r) p0[r] = __builtin_amdgcn_exp2f(p0[r]);
}
__device__ __forceinline__ void finishSM(f32x16& p0, f32x16& p1, float alpha, float& l_reg, bf16x8& pa0, bf16x8& pa1, bf16x8& pa2, bf16x8& pa3) {
    for (int r = 0; r < 16; ++r) p1[r] = __builtin_amdgcn_exp2f(p1[r]);
    float ps = 0; for (int r = 0; r < 16; ++r) ps += p0[r]; for (int r = 0; r < 16; ++r) ps += p1[r];
    { auto rr = __builtin_amdgcn_permlane32_swap(__float_as_uint(ps), __float_as_uint(ps), false, false);
      ps = __uint_as_float(rr[0]) + __uint_as_float(rr[1]); }
    l_reg = l_reg * alpha + ps;
#define PK4(P, B_, OUT) do { unsigned a0 = cvtpk(P[B_+0], P[B_+1]), a1 = cvtpk(P[B_+2], P[B_+3]);                          \
        unsigned b0 = cvtpk(P[B_+4], P[B_+5]), b1 = cvtpk(P[B_+6], P[B_+7]);                                             \
        auto r0 = __builtin_amdgcn_permlane32_swap(a0, b0, false, false); auto r1 = __builtin_amdgcn_permlane32_swap(a1, b1, false, false); \
        u32x4 w = {r0[0], r1[0], r0[1], r1[1]}; OUT = *reinterpret_cast<bf16x8*>(&w); } while (0)
    PK4(p0, 0, pa0); PK4(p0, 8, pa1); PK4(p1, 0, pa2); PK4(p1, 8, pa3);
#undef PK4
}
template <int KB, bool SK>
__device__ __forceinline__ void qkt(f32x16& p0, f32x16& p1, const char* K_lds, int r32, int hi, const bf16x8* qr, bool act, const char* qx) {
    if (SK && !act) { const float NEG = -__builtin_inff();
#pragma unroll
        for (int r = 0; r < 16; ++r) { p0[r] = NEG; p1[r] = NEG; } return; }
    { const float* bl = (const float*)(K_lds - 2 * SHM_V + LDS_BIAS) + KB * 64 + 4 * hi;
#pragma unroll
      for (int g = 0; g < 4; ++g) { const f32x4 u0 = *(const f32x4*)(bl + 8 * g), u1 = *(const f32x4*)(bl + 32 + 8 * g);
        p0[4*g] = u0[0]; p0[4*g+1] = u0[1]; p0[4*g+2] = u0[2]; p0[4*g+3] = u0[3]; p1[4*g] = u1[0]; p1[4*g+1] = u1[1]; p1[4*g+2] = u1[2]; p1[4*g+3] = u1[3]; } }
    const char* kb[4];
#pragma unroll
    for (int dd = 0; dd < 4; ++dd) kb[dd] = K_lds + KB * SHM_K + KSWZ(r32, (dd * 16 + hi * 8) * 2);
#pragma unroll
    for (int d0 = 0; d0 < 8; ++d0) { const char* a = kb[d0 & 3] + (d0 >> 2) * 128;
        bf16x8 b0 = *reinterpret_cast<const bf16x8*>(a);
        bf16x8 b1 = *reinterpret_cast<const bf16x8*>(a + 32 * 256);
        const bf16x8 qv = (d0 < 8 - NQX) ? qr[d0] : *reinterpret_cast<const bf16x8*>(qx + (d0 - (8 - NQX)) * 1024);
        p0 = __builtin_amdgcn_mfma_f32_32x32x16_bf16(b0, qv, p0, 0, 0, 0);
        p1 = __builtin_amdgcn_mfma_f32_32x32x16_bf16(b1, qv, p1, 0, 0, 0); }
}
template <int VB, bool SK>
__device__ __forceinline__ void pv_tile(f32x16* o, int vb0, bf16x8 pa0, bf16x8 pa1, bf16x8 pa2, bf16x8 pa3, bool act) {
    if (SK && !act) return;
#define TRRD(dst, off) asm volatile("ds_read_b64_tr_b16 %0, %1 offset:%2" : "=&v"(dst) : "v"(vb0), "i"(off) : "memory")
#define PV_D0(d0) do { s16x4 l0, l1, l2, l3, h0, h1, h2, h3; constexpr int b_ = VB * SHM_V + v_rd_off(d0, 0, 0);     \
        TRRD(l0, b_); TRRD(h0, b_ + 2048); TRRD(l1, b_ + 4096); TRRD(h1, b_ + 6144); TRRD(l2, b_ + 8192); TRRD(h2, b_ + 10240); TRRD(l3, b_ + 12288); TRRD(h3, b_ + 14336); \
        asm volatile("s_waitcnt lgkmcnt(0)" ::: "memory"); SBAR();                 \
        o[d0] = __builtin_amdgcn_mfma_f32_32x32x16_bf16(pa0, (bf16x8){l0[0], l0[1], l0[2], l0[3], h0[0], h0[1], h0[2], h0[3]}, o[d0], 0, 0, 0);   \
        o[d0] = __builtin_amdgcn_mfma_f32_32x32x16_bf16(pa1, (bf16x8){l1[0], l1[1], l1[2], l1[3], h1[0], h1[1], h1[2], h1[3]}, o[d0], 0, 0, 0);   \
        o[d0] = __builtin_amdgcn_mfma_f32_32x32x16_bf16(pa2, (bf16x8){l2[0], l2[1], l2[2], l2[3], h2[0], h2[1], h2[2], h2[3]}, o[d0], 0, 0, 0);   \
        o[d0] = __builtin_amdgcn_mfma_f32_32x32x16_bf16(pa3, (bf16x8){l3[0], l3[1], l3[2], l3[3], h3[0], h3[1], h3[2], h3[3]}, o[d0], 0, 0, 0); } while (0)
    PV_D0(0); PV_D0(1); PV_D0(2); PV_D0(3);
#undef PV_D0
#undef TRRD
}

template <class TIn, class TOut> struct BlockRef { const TIn* Q; const TIn* K; const TIn* V; TOut* O; const float* Bs; int P0; int nvalid; };
template <class TIn> struct Seam {
    bf16x8 qr[8];
    bf16x8 st_v0, st_v1, st_k0, st_k1; f32x4 sf0, sf1, sf2, sf3;
    f32x4 tq[16];
};
__device__ __forceinline__ int swa_jlo(int P0, int W) { const int lowk = P0 - W + 1; return lowk > 0 ? lowk / KVBLK : 0; }
#define ROW(p, k0, rr) ((p) + (size_t)((k0) + (rr)) * PITCH + sc)
#define VMW() asm volatile("s_waitcnt vmcnt(0)" ::: "memory")
#define VMWN(n) asm volatile("s_waitcnt vmcnt(%0)" :: "i"(n) : "memory")
#define GLDS(gp_, lp_, sz_) __builtin_amdgcn_global_load_lds((const unsigned*)(gp_), (__attribute__((address_space(3))) unsigned*)(lp_), sz_, 0, 0)
#define SLOAD_H(Kp, Vp, Bp, k0, bb_) do { S.st_v0 = load8<TIn>(ROW(Vp, k0, sr)); S.st_v1 = load8<TIn>(ROW(Vp, k0, 32 + sr));              \
                         { const TIn* kg_ = (Kp) + (size_t)(k0) * PITCH; char* kl_ = K_lds + (bb_) * SHM_K + wid * 2048; GLDS(kg_ + ksrc0, kl_, 16); GLDS(kg_ + ksrc1, kl_ + 1024, 16); } \
                         if (wid == 0) GLDS((Bp) + (k0) + lane, lds + LDS_BIAS + (bb_) * 256, 4); } while (0)
#define SWRITE_HK(bf) do { } while (0)
#define SWRITE_HV(bf) do { *(bf16x8*)(V_lds + (bf) * SHM_V + vst0) = S.st_v0; *(bf16x8*)(V_lds + (bf) * SHM_V + vst1) = S.st_v1; } while (0)
#define SWRITE_H(bf) do { SWRITE_HV(bf); SWRITE_HK(bf); } while (0)
#define SLOAD_F(p, k0) do { S.sf0 = *(const f32x4*)ROW(p, k0, sr); S.sf1 = *(const f32x4*)(ROW(p, k0, sr) + 4);                \
                            S.sf2 = *(const f32x4*)ROW(p, k0, 32 + sr); S.sf3 = *(const f32x4*)(ROW(p, k0, 32 + sr) + 4); } while (0)
#define SWRITE_KF(bf) do { *(bf16x8*)(K_lds + (bf) * SHM_K + kws) = pack8(S.sf0, S.sf1); *(bf16x8*)(K_lds + (bf) * SHM_K + kws + 32 * 256) = pack8(S.sf2, S.sf3); } while (0)
#define SWRITE_VF(bf) do { *(bf16x8*)(V_lds + (bf) * SHM_V + vst0) = pack8(S.sf0, S.sf1); *(bf16x8*)(V_lds + (bf) * SHM_V + vst1) = pack8(S.sf2, S.sf3); } while (0)
template <class TIn, class TOut>
__device__ __forceinline__ void causal_swa_prime(const BlockRef<TIn, TOut>& cur, int W, char* lds, Seam<TIn>& S, const int tid) {
    constexpr bool F32 = same_t<TIn, float>::v;
    const int wid = __builtin_amdgcn_readfirstlane(tid >> 6), lane = tid & 63, r32 = lane & 31, hi = lane >> 5;
    const int sr = tid >> 4, sc = (tid & 15) * 8, kws = KSWZ(sr, sc * 2); char* K_lds = lds + 2 * SHM_V; (void)kws;
    const int ksrc0 = (8 * wid + (lane >> 4)) * PITCH + ((lane & 15) ^ (lane >> 4)) * 8, ksrc1 = (8 * wid + 4 + (lane >> 4)) * PITCH + ((lane & 15) ^ (4 + (lane >> 4))) * 8;
    const int kb0 = swa_jlo(cur.P0, W) * KVBLK;
    for (int d0 = 0; d0 < 8; ++d0) S.qr[d0] = load8<TIn>(cur.Q + (size_t)(wid * QBLK + r32) * PITCH + d0 * 16 + hi * 8);
    if constexpr (F32) { SLOAD_F((const float*)cur.K, kb0); VMW(); SWRITE_KF(0); SBAR(); SLOAD_F((const float*)cur.V, kb0); }
    else { SLOAD_H(cur.K, cur.V, cur.Bs, kb0, 0); VMW(); SWRITE_HK(0); }
    __syncthreads();
}
template <class TIn, class TOut>
__device__ __forceinline__ void causal_swa_block(const BlockRef<TIn, TOut>& cur, const BlockRef<TIn, TOut>& nxt, int skv, int W, char* lds, Seam<TIn>& S, const int tid) {
    constexpr bool F32 = same_t<TIn, float>::v;
    const int wid = __builtin_amdgcn_readfirstlane(tid >> 6), lane = tid & 63, r32 = lane & 31, hi = lane >> 5;
    const int j_lo = swa_jlo(cur.P0, W);
    int j_hi = (cur.P0 + QB - 1) / KVBLK + 1; if (j_hi > skv / KVBLK) j_hi = skv / KVBLK;
    const int NT = j_hi - j_lo;
    const int kbn = swa_jlo(nxt.P0, W) * KVBLK;
    const int qlo = cur.P0 + wid * QBLK, qm = qlo + r32 - 4 * hi;
    char* V_lds = lds; char* K_lds = lds + 2 * SHM_V;
    float* ws = (float*)(lds + 2 * SHM_V + 2 * SHM_K) + wid * 64; float* li_l = ws, * al_l = ws + 32;
    float m_reg = -1e30f, l_reg = 0; f32x16 o[4] = {};
    const int sr = tid >> 4, sc = (tid & 15) * 8, vst0 = v_st(sr, sc), vst1 = v_st(32 + sr, sc), kws = KSWZ(sr, sc * 2);
    const int vb0 = (int)(uintptr_t)V_lds + v_rd_base(lane); (void)kws;
    const int ksrc0 = (8 * wid + (lane >> 4)) * PITCH + ((lane & 15) ^ (lane >> 4)) * 8, ksrc1 = (8 * wid + 4 + (lane >> 4)) * PITCH + ((lane & 15) ^ (4 + (lane >> 4))) * 8;
    const TIn* Kh = cur.K; const TIn* Vh = cur.V; const float* Bh = cur.Bs;
#define RESC(a) do { if (__any((a) < 1.f)) { if (hi == 0) al_l[r32] = (a); asm volatile("s_waitcnt lgkmcnt(0)" ::: "memory");              \
                     for (int d_ = 0; d_ < 4; ++d_) for (int r = 0; r < 16; ++r) o[d_][r] *= al_l[crow(r, hi)]; } } while (0)
#define KBASE(t) ((j_lo + (t)) * KVBLK)
#define ACT(t) (KBASE(t) <= qlo + QBLK - 1 && KBASE(t) + KVBLK - 1 >= qlo - W + 1)
#define MASKT(P0_, P1_, t) do { const int kb_ = KBASE(t); if ((!SK || ACT(t)) && (kb_ + KVBLK - 1 > qlo || kb_ <= qlo + QBLK - 1 - W)) mask_tile(P0_, P1_, qm - kb_, (unsigned)W); } while (0)
    constexpr int NQL = F32 ? 16 : 8;
    constexpr bool SK = WSKIP && !F32;
#define SEAM_K0() do { VMWN(NQL); if constexpr (F32) { SWRITE_KF(0); SBAR(); SLOAD_F((const float*)nxt.V, kbn); } else { SWRITE_HK(0); } SBAR(); } while (0)
    f32x16 pA0, pA1, pB0, pB1; float mnA, mnB, alA, alB; bf16x8 pa0, pa1, pa2, pa3;
    char* qx = lds + LDS_QX + wid * (NQX * 1024) + lane * 16;
#pragma unroll
    for (int e = 0; e < NQX; ++e) *reinterpret_cast<bf16x8*>(qx + e * 1024) = S.qr[8 - NQX + e];
    if constexpr (F32) { VMW(); SWRITE_VF(0); SBAR(); } else { SWRITE_HV(0); SBAR(); }
    if (NT > 1) { if constexpr (F32) SLOAD_F((const float*)Kh, KBASE(1)); else SLOAD_H(Kh, Vh, Bh, KBASE(1), 1); }
    SBAR(); qkt<0, SK>(pA0, pA1, K_lds, r32, hi, S.qr, ACT(0), qx);
    if constexpr (F32) { if (NT > 1) { VMW(); SWRITE_KF(1); SBAR(); SLOAD_F((const float*)Vh, KBASE(1)); } }
    MASKT(pA0, pA1, 0); partialSM(pA0, pA1, m_reg, mnA, alA);
    if (NT > 1) { VMW(); if constexpr (F32) { SWRITE_VF(1); SBAR(); if (NT > 2) SLOAD_F((const float*)Kh, KBASE(2)); } else SWRITE_H(1); }
    __syncthreads();
#define HALF_STEP(PX0, PX1, mnX, alX, PY0, PY1, alY, t, KB, VB, SB) do {                                                      \
        SBAR(); qkt<KB, SK>(PX0, PX1, K_lds, r32, hi, S.qr, ACT(t), qx);                                             \
        finishSM(PY0, PY1, alY, l_reg, pa0, pa1, pa2, pa3); SBAR();                                                           \
        if ((t) + 1 < NT) { if constexpr (F32) { VMW(); SWRITE_KF(SB); SBAR(); SLOAD_F((const float*)Vh, KBASE((t) + 1)); }  \
                            else { SLOAD_H(Kh, Vh, Bh, KBASE((t) + 1), SB); } SBAR(); }                                               \
        pv_tile<VB, SK>(o, vb0, pa0, pa1, pa2, pa3, ACT((t) - 1)); MASKT(PX0, PX1, (t)); partialSM(PX0, PX1, m_reg, mnX, alX);                                        \
        __syncthreads();                                                                                                      \
        if ((t) + 1 < NT) { VMW(); if constexpr (F32) { SWRITE_VF(SB); SBAR(); if ((t) + 2 < NT) SLOAD_F((const float*)Kh, KBASE((t) + 2)); } \
                            else { SWRITE_H(SB); } }                                                                          \
        RESC(alX); __syncthreads(); } while (0)
    for (int t = 1; t + 1 < NT; t += 2) {
        HALF_STEP(pB0, pB1, mnB, alB, pA0, pA1, alA, t, 1, 0, 0);
        HALF_STEP(pA0, pA1, mnA, alA, pB0, pB1, alB, t + 1, 0, 1, 1);
    }
    const bool even = (NT & 1) == 0;
    if (even) { SBAR(); qkt<1, SK>(pB0, pB1, K_lds, r32, hi, S.qr, ACT(NT - 1), qx); SBAR(); }
#define QROW(e) (nxt.Q + (size_t)(wid * QBLK + r32) * PITCH + ((e) >> 1) * 16 + hi * 8 + ((e) & 1) * 4)
    if constexpr (F32) { SLOAD_F((const float*)nxt.K, kbn); SBAR();
#pragma unroll
        for (int e = 0; e < 8; ++e) S.tq[e] = *(const f32x4*)QROW(e); }
    else { SLOAD_H(nxt.K, nxt.V, nxt.Bs, kbn, 0); SBAR();
#pragma unroll
        for (int d0 = 0; d0 < 8; ++d0) S.qr[d0] = load8<TIn>(nxt.Q + (size_t)(wid * QBLK + r32) * PITCH + d0 * 16 + hi * 8); }
    SBAR();
    finishSM(pA0, pA1, alA, l_reg, pa0, pa1, pa2, pa3); SBAR();
    if constexpr (F32) {
#pragma unroll
        for (int e = 8; e < 16; ++e) S.tq[e] = *(const f32x4*)QROW(e); SBAR(); }
#undef QROW
    pv_tile<0, SK>(o, vb0, pa0, pa1, pa2, pa3, ACT(even ? NT - 2 : NT - 1));
    if (even) { MASKT(pB0, pB1, NT - 1); partialSM(pB0, pB1, m_reg, mnB, alB); __syncthreads(); RESC(alB);
        finishSM(pB0, pB1, alB, l_reg, pa0, pa1, pa2, pa3); SBAR(); pv_tile<1, SK>(o, vb0, pa0, pa1, pa2, pa3, ACT(NT - 1)); }
    SBAR(); SEAM_K0();
    if (hi == 0) li_l[r32] = l_reg; asm volatile("s_waitcnt lgkmcnt(0)" ::: "memory");
    float rli[16];
#pragma unroll
    for (int r = 0; r < 16; ++r) rli[r] = __builtin_amdgcn_rcpf(li_l[crow(r, hi)]);
    int tidE = tid; asm volatile("" : "+v"(tidE));
    const int widE = __builtin_amdgcn_readfirstlane(tidE >> 6), r32E = tidE & 31, hiE = (tidE >> 5) & 1;
    TOut* Ow = cur.O + (size_t)(widE * QBLK) * PITCH; const bool wval = widE * QBLK < cur.nvalid;
    if (wval) {
#pragma unroll
    for (int r = 0; r < 16; ++r) { const int orow = crow(r, hiE);
#pragma unroll
        for (int d0 = 0; d0 < 4; ++d0) { const float v = o[d0][r] * rli[r];
            if constexpr (same_t<TOut, float>::v) { Ow[(size_t)orow * PITCH + d0 * 32 + r32E] = v; }
            else { const float vn = __shfl_xor(v, 1);
                   if ((r32E & 1) == 0) *(unsigned*)(Ow + (size_t)orow * PITCH + d0 * 32 + r32E) = cvtpk(v, vn); } } } }
    if constexpr (F32) {
#pragma unroll
        for (int d0 = 0; d0 < 8; ++d0) S.qr[d0] = pack8(S.tq[2 * d0], S.tq[2 * d0 + 1]); }
    __syncthreads();
#undef RESC
#undef KBASE
#undef ACT
#undef MASKT
#undef SEAM_K0
#undef HALF_STEP
}
#undef ROW
#undef VMW
#undef VMWN
#undef SLOAD_H
#undef GLDS
#undef SWRITE_HK
#undef SWRITE_HV
#undef SWRITE_H
#undef SLOAD_F
#undef SWRITE_KF
#undef SWRITE_VF

}
typedef unsigned short u16;
typedef float f32x4 __attribute__((ext_vector_type(4)));
typedef unsigned u32x4 __attribute__((ext_vector_type(4)));
typedef unsigned u32x2 __attribute__((ext_vector_type(2)));
typedef short bf16x8 __attribute__((ext_vector_type(8)));
constexpr int DM = 2048, TP = 8192, NBP = 4, NBS = 8, TS = 64, PAST = 2048, SKVS = PAST + TS;
constexpr int MP = NBP * TP, MS_ = NBS * TS, M = MP + MS_;
constexpr int DI = 4096, CD = 6144, NH = 64, DFF = 5504, DFF2 = 11008, NIN = 20560;
constexpr int NMOD = 12288;
constexpr float EPS = 1e-6f, LOG2E = 1.4426950408889634f;
constexpr int HALF_ROWS = 16640;
constexpr size_t O_YP = 0, O_YS = O_YP + (size_t)MP * DM, O_KP = O_YS + (size_t)MS_ * DM, O_VP = O_KP + (size_t)MP * DM,
    O_LFP = O_VP + (size_t)MP * DM, O_SSMP = O_LFP + (size_t)MP * 16, O_MCP = O_SSMP + (size_t)NBP * 64 * 64 * 128, O_FCP = O_MCP + (size_t)NBP * 3 * CD,
    O_KS = O_FCP + (size_t)NBP * 2 * DFF2, O_VS = O_KS + (size_t)MS_ * DM, O_LFS = O_VS + (size_t)MS_ * DM, O_SSMS = O_LFS + (size_t)MS_ * 16,
    O_MCS = O_SSMS + (size_t)NBS * 64 * 64 * 128, O_FCS = O_MCS + (size_t)NBS * 3 * CD, O_END = O_FCS + (size_t)NBS * 2 * DFF2;
constexpr size_t MiB = 1u << 20;
constexpr size_t W_MOD = 0, W_BIASP = 1 * MiB, W_BIASS = 3 * MiB, W_HALO = 5 * MiB,
    W_WUP = 8 * MiB, W_WDN = 51 * MiB, W_H = 73 * MiB, W_WIN = 203 * MiB, W_WPM = 284 * MiB, W_WPF = 300 * MiB, W_WOUT = 308 * MiB,
    W_SMALL = 316 * MiB, W_R = 349 * MiB,
    W_XBC = W_R, W_Z = W_R + 390 * MiB, W_GM = W_R, W_GF = W_R + 130 * MiB, W_Q = W_R + 260 * MiB, W_K = W_Q + 130 * MiB, W_V = W_K + 130 * MiB,
    W_U = 203 * MiB, W_G = 553 * MiB, W_END = 999 * MiB;
static_assert((size_t)M * DM * 2 == 130 * MiB && (size_t)M * CD * 2 == 390 * MiB && (size_t)M * DI * 2 == 260 * MiB, "sizes");
static_assert(W_U + (size_t)HALF_ROWS * DFF2 * 2 <= W_G && W_G + (size_t)M * DFF * 2 <= 1024 * MiB, "ffn map");
static_assert(W_SMALL + (size_t)M * 256 * 4 <= W_R, "small map");

struct Prm { const float* in[31]; float* out; unsigned char* ws; };
typedef const __attribute__((address_space(4))) Prm* KPrm;
struct Ctx { int tid, bid, G; };
enum { I_XP = 0, I_XS, I_CP, I_CS, I_CK, I_CV, I_CLF, I_SSM, I_MCV, I_FCV, I_N1W, I_N2W, I_WADA, I_BADA, I_WIN, I_MCW, I_MCB, I_DTB, I_ALOG, I_MD, I_MNW,
       I_FB, I_QNW, I_KNW, I_WPM, I_WPF, I_WOUT, I_WUP, I_FCW, I_FCB, I_WDN };

__device__ __forceinline__ float bflo(unsigned w) { return __uint_as_float(w << 16); }
__device__ __forceinline__ float bfhi(unsigned w) { return __uint_as_float(w & 0xffff0000u); }
__device__ __forceinline__ unsigned pk2(float lo, float hi) { return pg8::cvt_pk_bf16(lo, hi); }
__device__ __forceinline__ u16 f2bf(float f) { return (u16)(pk2(f, 0.f) & 0xffffu); }
__device__ __forceinline__ void unpack8(u32x4 w, float* v) { v[0] = bflo(w.x); v[1] = bfhi(w.x); v[2] = bflo(w.y); v[3] = bfhi(w.y); v[4] = bflo(w.z); v[5] = bfhi(w.z); v[6] = bflo(w.w); v[7] = bfhi(w.w); }
__device__ __forceinline__ u32x4 pack8f(const float* v) { u32x4 w; w.x = pk2(v[0], v[1]); w.y = pk2(v[2], v[3]); w.z = pk2(v[4], v[5]); w.w = pk2(v[6], v[7]); return w; }
__device__ __forceinline__ float bfel(const u32x4& w, int e) { const unsigned x = w[e >> 1]; return (e & 1) ? bfhi(x) : bflo(x); }
__device__ __forceinline__ float sigmoidf_(float x) { return 1.f / (1.f + __expf(-x)); }
__device__ __forceinline__ float siluf_(float x) { return x / (1.f + __expf(-x)); }
__device__ __forceinline__ float wave_sum(float v) {
#pragma unroll
    for (int o = 1; o < 64; o <<= 1) v += __shfl_xor(v, o);
    return v;
}
__device__ __forceinline__ int mod_row(int row) { return row < MP ? (row >> 13) : 4 + ((row - MP) >> 6); }

struct Epi {
    static constexpr bool PERM = true, AFTER_DRAIN = false;
    int mode;
    u16* d0; u16* d1; u16* d2; int t1, t2, p0, p1, p2, f32seg2;
    const float* xp; const float* xs; float* y; const float* mod; u16* gbuf; const u16* gf;
    __device__ __forceinline__ void operator()(const f32x4 (&acc)[2][2][4][2], const pg8::Unit& u, int wr, int wc, int fr, int fq) const {
        const int rl = u.pm * 256 + wr * 64 + fr, cl = wc * 32 + 8 * fq;
        if (mode == 0) {
            u16* base; int pitch, ct; bool f32o = false;
            if (u.pn < t1) { base = d0; pitch = p0; ct = u.pn; } else if (u.pn < t2) { base = d1; pitch = p1; ct = u.pn - t1; } else { base = d2; pitch = p2; ct = u.pn - t2; f32o = (f32seg2 != 0); }
            if (!f32o) {
#pragma unroll
                for (int ai = 0; ai < 2; ++ai)
#pragma unroll
                    for (int m = 0; m < 4; ++m) { u16* rp = base + (size_t)(rl + ai * 128 + m * 16) * pitch + ct * 256 + cl;
#pragma unroll
                        for (int bj = 0; bj < 2; ++bj) { const f32x4 v0 = acc[ai][bj][m][0], v1 = acc[ai][bj][m][1]; u32x4 w; w.x = pk2(v0[0], v0[1]); w.y = pk2(v0[2], v0[3]); w.z = pk2(v1[0], v1[1]); w.w = pk2(v1[2], v1[3]);
                            *(u32x4*)(rp + bj * 128) = w; } }
            } else {
                float* fb = (float*)base;
#pragma unroll
                for (int ai = 0; ai < 2; ++ai)
#pragma unroll
                    for (int m = 0; m < 4; ++m) { float* rp = fb + (size_t)(rl + ai * 128 + m * 16) * pitch + ct * 256 + cl;
#pragma unroll
                        for (int bj = 0; bj < 2; ++bj) { *(f32x4*)(rp + bj * 128) = acc[ai][bj][m][0]; *(f32x4*)(rp + bj * 128 + 4) = acc[ai][bj][m][1]; } }
            }
        } else if (mode == 1 || mode == 2) {
#pragma unroll
            for (int ai = 0; ai < 2; ++ai)
#pragma unroll
                for (int m = 0; m < 4; ++m) { const size_t off = (size_t)(rl + ai * 128 + m * 16) * DM + u.pn * 256 + cl;
#pragma unroll
                    for (int bj = 0; bj < 2; ++bj) { const f32x4 v0 = acc[ai][bj][m][0], v1 = acc[ai][bj][m][1];
                        float a[8] = {v0[0], v0[1], v0[2], v0[3], v1[0], v1[1], v1[2], v1[3]}, g[8], o[8];
                        unpack8(*(const u32x4*)(gbuf + off + bj * 128), g);
                        if (mode == 1) {
#pragma unroll
                            for (int e = 0; e < 8; ++e) o[e] = sigmoidf_(g[e]) * a[e];
                        } else { float f[8]; unpack8(*(const u32x4*)(gf + off + bj * 128), f);
#pragma unroll
                            for (int e = 0; e < 8; ++e) o[e] = g[e] + sigmoidf_(f[e]) * a[e]; }
                        *(u32x4*)(gbuf + off + bj * 128) = pack8f(o); } }
        } else {
#pragma unroll
            for (int ai = 0; ai < 2; ++ai) {
                const int mb = (u.pm < 128) ? (u.pm >> 5) : (4 + (u.pm - 128) * 4 + ai * 2 + wr);
                const float* gp = mod + (size_t)mb * NMOD + (mode == 3 ? 4096 : 10240) + u.pn * 256 + cl;
                f32x4 gv[2][2];
#pragma unroll
                for (int bj = 0; bj < 2; ++bj) { gv[bj][0] = *(const f32x4*)(gp + bj * 128); gv[bj][1] = *(const f32x4*)(gp + bj * 128 + 4); }
#pragma unroll
                for (int m = 0; m < 4; ++m) { const int row = rl + ai * 128 + m * 16; const size_t off = (size_t)row * DM + u.pn * 256 + cl;
                    const float* xr = (mode == 3) ? ((row < MP) ? xp + off : xs + (off - (size_t)MP * DM)) : (const float*)(y + off);
#pragma unroll
                    for (int bj = 0; bj < 2; ++bj) { const f32x4 b0 = *(const f32x4*)(xr + bj * 128), b1 = *(const f32x4*)(xr + bj * 128 + 4);
                        *(f32x4*)(y + off + bj * 128) = b0 + gv[bj][0] * acc[ai][bj][m][0]; *(f32x4*)(y + off + bj * 128 + 4) = b1 + gv[bj][1] * acc[ai][bj][m][1]; } }
            }
        }
    }
};

__device__ __forceinline__ int map_in(int n) {
    if (n < 4096) return 6144 + n;
    if (n < 10240) return n - 4096;
    if (n < 10304) return 10240 + (n - 10240);
    if (n < 12352) return 14592 + (n - 10304);
    if (n < 14400) return 16640 + (n - 12352);
    if (n < 16448) return 18688 + (n - 14400);
    if (n < 16464) return 10304 + (n - 16448);
    if (n < 18512) return 10496 + (n - 16464);
    return 12544 + (n - 18512);
}
__device__ __forceinline__ int map_up(int n) { if (n < DFF) return (n >> 7) * 256 + (n & 127); const int f = n - DFF; return (f >> 7) * 256 + 128 + (f & 127); }
template <int MAP> __device__ __forceinline__ void tr_item(const float* __restrict__ W, int K, int N, u16* WT, float* scr, int item, int lane) {
    const int nblk = (N + 31) / 32, kb = item / nblk, nb = item % nblk, k0 = 64 * kb, n0 = 32 * nb;
    const int nn = n0 + (lane & 31);
#pragma unroll 8
    for (int i = 0; i < 32; ++i) { const int kk = 2 * i + (lane >> 5); scr[kk * 33 + (lane & 31)] = (nn < N) ? W[(size_t)(k0 + kk) * N + nn] : 0.f; }
    asm volatile("s_waitcnt lgkmcnt(0)" ::: "memory");
    const int c = lane & 7;
#pragma unroll
    for (int j = 0; j < 4; ++j) { const int n = (lane >> 3) + 8 * j; const float* s = scr + (8 * c) * 33 + n;
        if (n0 + n < N) { const int row = (MAP == 1) ? map_in(n0 + n) : (MAP == 2) ? map_up(n0 + n) : (n0 + n);
            u32x4 o; o.x = pk2(s[0 * 33], s[1 * 33]); o.y = pk2(s[2 * 33], s[3 * 33]); o.z = pk2(s[4 * 33], s[5 * 33]); o.w = pk2(s[6 * 33], s[7 * 33]);
            *(u32x4*)(WT + (size_t)row * K + k0 + 8 * c) = o; } }
    asm volatile("s_waitcnt lgkmcnt(0)" ::: "memory");
}
__device__ __forceinline__ void phase_prep(KPrm p, const Ctx cx, unsigned char* lds) {
    const int tid = cx.tid, lane = tid & 63, wid = tid >> 6, G = cx.G;
    unsigned char* ws = p->ws;
    {
        float* scr = (float*)(lds + wid * 8448);
        const int gw = cx.bid * 8 + wid, NGW = G * 8;
        constexpr int I_IN = 32 * 643, I_PM = 64 * 64, I_PF = 32 * 64, I_OUT = 32 * 64, I_UP = 32 * 344, I_DN = 86 * 64;
        constexpr int NIT = I_IN + I_PM + I_PF + I_OUT + I_UP + I_DN;
        for (int it = gw; it < NIT; it += NGW) {
            int r = it;
            if (r < I_IN) { tr_item<1>(p->in[I_WIN], DM, NIN, (u16*)(ws + W_WIN), scr, r, lane); continue; } r -= I_IN;
            if (r < I_PM) { tr_item<0>(p->in[I_WPM], DI, DM, (u16*)(ws + W_WPM), scr, r, lane); continue; } r -= I_PM;
            if (r < I_PF) { tr_item<0>(p->in[I_WPF], DM, DM, (u16*)(ws + W_WPF), scr, r, lane); continue; } r -= I_PF;
            if (r < I_OUT) { tr_item<0>(p->in[I_WOUT], DM, DM, (u16*)(ws + W_WOUT), scr, r, lane); continue; } r -= I_OUT;
            if (r < I_UP) { tr_item<2>(p->in[I_WUP], DM, DFF2, (u16*)(ws + W_WUP), scr, r, lane); continue; } r -= I_UP;
            tr_item<0>(p->in[I_WDN], DFF, DM, (u16*)(ws + W_WDN), scr, r, lane);
        }
    }
    __syncthreads();
    {
        float* sl = (float*)lds;
        float* red = (float*)(lds + 12 * 2048 * 4);
        for (int e = tid; e < 12 * 2048; e += 512) { const int b = e >> 11, i = e & 2047; const float cv = (b < 4) ? p->in[I_CP][b * 2048 + i] : p->in[I_CS][(b - 4) * 2048 + i]; sl[e] = siluf_(cv); }
        __syncthreads();
        const float* wada = p->in[I_WADA]; float* mod = (float*)(ws + W_MOD);
        const int col = tid & 31, part = tid >> 5;
        for (int item = cx.bid; item < NMOD / 32; item += G) {
            float acc[12];
#pragma unroll
            for (int b = 0; b < 12; ++b) acc[b] = 0.f;
            const float* wp = wada + (size_t)(part * 128) * NMOD + item * 32 + col;
#pragma unroll 4
            for (int d = 0; d < 128; ++d) { const float w = wp[(size_t)d * NMOD];
#pragma unroll
                for (int b = 0; b < 12; ++b) acc[b] += sl[b * 2048 + part * 128 + d] * w; }
#pragma unroll
            for (int b = 0; b < 12; ++b) red[(part * 12 + b) * 32 + col] = acc[b];
            __syncthreads();
            if (tid < 384) { const int b = tid >> 5; float s = p->in[I_BADA][item * 32 + col];
#pragma unroll
                for (int q = 0; q < 16; ++q) s += red[(q * 12 + b) * 32 + col];
                mod[b * NMOD + item * 32 + col] = s; }
            __syncthreads();
        }
    }
    {
        u16* Ks = (u16*)p->out; u16* Vs = Ks + (size_t)NBS * SKVS * DM;
        const size_t tot8 = (size_t)NBS * PAST * DM / 8, gt = (size_t)cx.bid * 512 + tid, GT = (size_t)G * 512;
        for (size_t i = gt; i < 2 * tot8; i += GT) { const int which = i >= tot8; const size_t j = i - (which ? tot8 : 0);
            const size_t sb = j / ((size_t)PAST * 256), rem = j % ((size_t)PAST * 256), row = rem >> 8, c8 = rem & 255;
            const float* src = p->in[which ? I_CV : I_CK] + ((sb * PAST + row) * DM + c8 * 8);
            const f32x4 a = *(const f32x4*)src, b = *(const f32x4*)(src + 4);
            u32x4 o; o.x = pk2(a[0], a[1]); o.y = pk2(a[2], a[3]); o.z = pk2(b[0], b[1]); o.w = pk2(b[2], b[3]);
            *(u32x4*)((which ? Vs : Ks) + ((sb * SKVS + row) * DM + c8 * 8)) = o; }
    }
}
__device__ __forceinline__ void phase_norm(KPrm p, const Ctx cx, int which) {
    const int tid = cx.tid, lane = tid & 63, wid = tid >> 6;
    const int gw = cx.bid * 8 + wid, NGW = cx.G * 8;
    const float* mod = (const float*)(p->ws + W_MOD); u16* H = (u16*)(p->ws + W_H);
    const float* nw = p->in[which ? I_N2W : I_N1W];
    const int osh = which ? 6144 : 0, osc = which ? 8192 : 2048;
    for (int row = gw; row < M; row += NGW) {
        const float* xr = which ? (p->out + (size_t)row * DM) : ((row < MP) ? p->in[I_XP] + (size_t)row * DM : p->in[I_XS] + (size_t)(row - MP) * DM);
        const float* mr = mod + (size_t)mod_row(row) * NMOD;
        f32x4 v[8]; float ss = 0.f;
#pragma unroll
        for (int j = 0; j < 8; ++j) { v[j] = ((const f32x4*)xr)[lane + 64 * j]; ss += (v[j][0] * v[j][0] + v[j][1] * v[j][1]) + (v[j][2] * v[j][2] + v[j][3] * v[j][3]); }
        const float rs = rsqrtf(wave_sum(ss) * (1.f / DM) + EPS);
#pragma unroll
        for (int j = 0; j < 8; ++j) { const int col = 4 * (lane + 64 * j);
            const f32x4 w = *(const f32x4*)(nw + col), sc = *(const f32x4*)(mr + osc + col), sh = *(const f32x4*)(mr + osh + col);
            const f32x4 o = v[j] * rs * w * (sc + 1.f) + sh;
            u32x2 q; q.x = pk2(o[0], o[1]); q.y = pk2(o[2], o[3]);
            *(u32x2*)(H + (size_t)row * DM + col) = q; }
    }
}
constexpr int SXP = 72, SNP = 136, SYP = 68;
constexpr int L_XT = 0, L_CN = L_XT + 64 * SXP * 2, L_BN = L_CN + 64 * SNP * 2, L_BWT = L_BN + 64 * SNP * 2, L_MS = L_BWT + 128 * SXP * 2, L_HS = L_MS + 64 * SXP * 2,
              L_YS = L_HS + 64 * SNP * 2, L_DT = L_YS + 64 * SYP * 4, L_CUM = L_DT + 256, L_SSD_END = L_CUM + 256;
static_assert(L_SSD_END <= 131072, "ssd lds");
__device__ __forceinline__ u32x4 ssd_raw8(const u16* rp, const float* hp, int seqpos, bool smp) {
    if (seqpos >= 0) return *(const u32x4*)rp;
    u32x4 o = {0u, 0u, 0u, 0u};
    if (smp) { const float* s = hp; const f32x4 a = *(const f32x4*)s, b = *(const f32x4*)(s + 4);
        o.x = pk2(a[0], a[1]); o.y = pk2(a[2], a[3]); o.z = pk2(b[0], b[1]); o.w = pk2(b[2], b[3]); }
    return o;
}
__device__ __forceinline__ void phase_ssd(KPrm p, const Ctx cx, unsigned char* lds) {
    const int tid = cx.tid, lane = tid & 63, wid = tid >> 6, quad = lane >> 4, l15 = lane & 15;
    u16* XT = (u16*)(lds + L_XT); u16* CN = (u16*)(lds + L_CN); u16* BN = (u16*)(lds + L_BN); u16* BWT = (u16*)(lds + L_BWT);
    u16* MSm = (u16*)(lds + L_MS); u16* HS = (u16*)(lds + L_HS); float* YS = (float*)(lds + L_YS); float* DT = (float*)(lds + L_DT); float* CUM = (float*)(lds + L_CUM);
    const u16* XBC = (const u16*)(p->ws + W_XBC); u16* Z = (u16*)(p->ws + W_Z); const float* SM = (const float*)(p->ws + W_SMALL);
    const float* cw = p->in[I_MCW]; const float* cb = p->in[I_MCB];
    const int cg8 = tid & 31, tq = tid >> 5, cgx = tid & 7, tx = tid >> 3;
    const int pb = wid >> 1;
    for (int ch = cx.bid; ch < 256 + 512; ch += cx.G) {
        const bool smp = ch >= 256; int b, hd, nc; long rowbase;
        if (!smp) { b = ch >> 6; hd = ch & 63; nc = TP / 64; rowbase = (long)b * TP; } else { const int su = ch - 256; b = su >> 6; hd = su & 63; nc = 1; rowbase = MP + (long)b * TS; }
        const int g = hd >> 3;
        const float a_h = -__expf(p->in[I_ALOG][hd]), dtb = p->in[I_DTB][hd], Dh = p->in[I_MD][hd];
        const int bccol = (cg8 < 16) ? (4096 + g * 128 + cg8 * 8) : (5120 + g * 128 + (cg8 - 16) * 8);
        const int xcol = hd * 64 + cgx * 8;
        const float* hist = p->in[I_MCV] + (size_t)b * 3 * CD;
        f32x4 st[4];
        const int st_off = (pb * 16 + quad * 4) * 128 + (4 * (wid & 1)) * 16 + l15, hs_off = (pb * 16 + quad * 4) * SNP + (4 * (wid & 1)) * 16 + l15;
        { const float* sin_ = p->in[I_SSM] + ((size_t)b * 64 + hd) * 64 * 128 + st_off;
#pragma unroll
          for (int i = 0; i < 4; ++i)
#pragma unroll
            for (int j = 0; j < 4; ++j) st[i][j] = smp ? sin_[j * 128 + i * 16] : 0.f; }
        __syncthreads();
        { u16* hp_ = HS + hs_off;
#pragma unroll
          for (int i = 0; i < 4; ++i)
#pragma unroll
            for (int j = 0; j < 4; ++j) hp_[j * SNP + i * 16] = f2bf(st[i][j]); }
        u32x4 rbc[7], rx[4], zn; float dtr = 0.f;
#define SSD_LOADS(cc, FIRST) do { const int t0_ = (cc) * 64; \
            const u16* pb_ = XBC + (rowbase + t0_ + 4 * tq - 3) * (long)CD + bccol; const u16* px_ = XBC + (rowbase + t0_ + tx - 3) * (long)CD + xcol; \
            const float* hb_ = hist + (4 * tq) * CD + bccol; const float* hx_ = hist + tx * CD + xcol;     \
            asm volatile("" : "+v"(pb_), "+v"(px_), "+v"(hb_), "+v"(hx_));     \
            _Pragma("unroll") for (int i = 0; i < 7; ++i) rbc[i] = (FIRST) ? ssd_raw8(pb_ + i * CD, hb_ + i * CD, 4 * tq - 3 + i, smp) : *(const u32x4*)(pb_ + i * CD); \
            _Pragma("unroll") for (int i = 0; i < 4; ++i) rx[i] = (FIRST) ? ssd_raw8(px_ + i * CD, hx_ + i * CD, tx - 3 + i, smp) : *(const u32x4*)(px_ + i * CD); \
            zn = *(const u32x4*)(Z + (size_t)(rowbase + t0_ + tx) * DI + xcol); \
            if (wid == 0) dtr = SM[(size_t)(rowbase + t0_ + lane) * 256 + hd]; } while (0)
        SSD_LOADS(0, true);
        for (int c = 0; c < nc; ++c) {
            const long r0 = rowbase + (long)c * 64;
            const u32x4 zw = zn;
            if (wid == 0) {
                const float dr = dtr + dtb; const float dtv = dr > 20.f ? dr : log1pf(__expf(dr));
                float x = dtv * a_h;
#pragma unroll
                for (int o = 1; o < 64; o <<= 1) { const float y = __shfl_up(x, o); if (lane >= o) x += y; }
                DT[lane] = dtv; CUM[lane] = x;
            }
            __syncthreads();
            const float cum_end = CUM[63];
            {
                float wbc[4][8], bbc[8];
#pragma unroll
                for (int j = 0; j < 4; ++j) { const f32x4 a0 = *(const f32x4*)(cw + j * CD + bccol), a1 = *(const f32x4*)(cw + j * CD + bccol + 4);
#pragma unroll
                    for (int e = 0; e < 4; ++e) { wbc[j][e] = a0[e]; wbc[j][4 + e] = a1[e]; } }
                { const f32x4 a0 = *(const f32x4*)(cb + bccol), a1 = *(const f32x4*)(cb + bccol + 4);
#pragma unroll
                  for (int e = 0; e < 4; ++e) { bbc[e] = a0[e]; bbc[4 + e] = a1[e]; } }
                float vb[4][8];
#pragma unroll
                for (int ii = 0; ii < 4; ++ii)
#pragma unroll
                    for (int e = 0; e < 8; ++e) { float s = bbc[e];
#pragma unroll
                        for (int j = 0; j < 4; ++j) s += wbc[j][e] * bfel(rbc[ii + j], e);
                        vb[ii][e] = siluf_(s); }
                u16* NAT = (cg8 < 16) ? BN : CN; const int nc0 = (cg8 & 15) * 8;
#pragma unroll
                for (int ii = 0; ii < 4; ++ii) *(u32x4*)(NAT + (4 * tq + ii) * SNP + nc0) = pack8f(vb[ii]);
                if (cg8 < 16) {
                    float wg[4];
#pragma unroll
                    for (int ii = 0; ii < 4; ++ii) { const int t = 4 * tq + ii; wg[ii] = DT[t] * __expf(cum_end - CUM[t]); }
#pragma unroll
                    for (int e = 0; e < 8; ++e) { u32x2 q; q.x = pk2(vb[0][e] * wg[0], vb[1][e] * wg[1]); q.y = pk2(vb[2][e] * wg[2], vb[3][e] * wg[3]);
                        *(u32x2*)(BWT + (nc0 + e) * SXP + 4 * tq) = q; }
                }
            }
            float wx[4][8], bx[8];
#pragma unroll
            for (int j = 0; j < 4; ++j) { const f32x4 c0 = *(const f32x4*)(cw + j * CD + xcol), c1 = *(const f32x4*)(cw + j * CD + xcol + 4);
#pragma unroll
                for (int e = 0; e < 4; ++e) { wx[j][e] = c0[e]; wx[j][4 + e] = c1[e]; } }
            { const f32x4 c0 = *(const f32x4*)(cb + xcol), c1 = *(const f32x4*)(cb + xcol + 4);
#pragma unroll
              for (int e = 0; e < 4; ++e) { bx[e] = c0[e]; bx[4 + e] = c1[e]; } }
            float xv[8];
#pragma unroll
            for (int e = 0; e < 8; ++e) { float s = bx[e];
#pragma unroll
                for (int j = 0; j < 4; ++j) s += wx[j][e] * bfel(rx[j], e);
                xv[e] = siluf_(s); XT[(cgx * 8 + e) * SXP + tx] = f2bf(xv[e]); }
            __syncthreads();
            if (c + 1 < nc) SSD_LOADS(c + 1, false);
            {
                const int ti = wid >> 1;
#pragma unroll
                for (int s2 = 0; s2 < 2; ++s2) { const int si = 2 * (wid & 1) + s2; f32x4 gacc = {0.f, 0.f, 0.f, 0.f};
                    if (si <= ti) {
#pragma unroll
                        for (int kk = 0; kk < 4; ++kk) { const bf16x8 av = *(const bf16x8*)(CN + (ti * 16 + l15) * SNP + kk * 32 + quad * 8), bv = *(const bf16x8*)(BN + (si * 16 + l15) * SNP + kk * 32 + quad * 8);
                            gacc = __builtin_amdgcn_mfma_f32_16x16x32_bf16(av, bv, gacc, 0, 0, 0); } }
                    const int s = si * 16 + l15; const float cs = CUM[s], ds = DT[s];
#pragma unroll
                    for (int j = 0; j < 4; ++j) { const int t = ti * 16 + quad * 4 + j; const float val = (s <= t) ? gacc[j] * __expf(CUM[t] - cs) * ds : 0.f; MSm[t * SXP + s] = f2bf(val); } }
            }
            __syncthreads();
            {
                const int ti = wid >> 1;
#pragma unroll
                for (int p2 = 0; p2 < 2; ++p2) { const int pi = 2 * (wid & 1) + p2; f32x4 y = {0.f, 0.f, 0.f, 0.f};
#pragma unroll
                    for (int kk = 0; kk < 4; ++kk) { const bf16x8 av = *(const bf16x8*)(CN + (ti * 16 + l15) * SNP + kk * 32 + quad * 8), bv = *(const bf16x8*)(HS + (pi * 16 + l15) * SNP + kk * 32 + quad * 8);
                        y = __builtin_amdgcn_mfma_f32_16x16x32_bf16(av, bv, y, 0, 0, 0); }
#pragma unroll
                    for (int j = 0; j < 4; ++j) y[j] *= __expf(CUM[ti * 16 + quad * 4 + j]);
#pragma unroll
                    for (int kk = 0; kk < 2; ++kk) { const bf16x8 av = *(const bf16x8*)(MSm + (ti * 16 + l15) * SXP + kk * 32 + quad * 8), bv = *(const bf16x8*)(XT + (pi * 16 + l15) * SXP + kk * 32 + quad * 8);
                        y = __builtin_amdgcn_mfma_f32_16x16x32_bf16(av, bv, y, 0, 0, 0); }
#pragma unroll
                    for (int j = 0; j < 4; ++j) YS[(ti * 16 + quad * 4 + j) * SYP + pi * 16 + l15] = y[j]; }
                const float dec = __expf(cum_end);
#pragma unroll
                for (int i = 0; i < 4; ++i) { const int nb = 4 * (wid & 1) + i; st[i] = st[i] * dec;
#pragma unroll
                    for (int kk = 0; kk < 2; ++kk) { const bf16x8 av = *(const bf16x8*)(XT + (pb * 16 + l15) * SXP + kk * 32 + quad * 8), bv = *(const bf16x8*)(BWT + (nb * 16 + l15) * SXP + kk * 32 + quad * 8);
                        st[i] = __builtin_amdgcn_mfma_f32_16x16x32_bf16(av, bv, st[i], 0, 0, 0); } }
            }
            __syncthreads();
            { u16* hp_ = HS + hs_off;
#pragma unroll
              for (int i = 0; i < 4; ++i)
#pragma unroll
                for (int j = 0; j < 4; ++j) hp_[j * SNP + i * 16] = f2bf(st[i][j]); }
            {
                const f32x4 y0 = *(const f32x4*)(YS + tx * SYP + cgx * 8), y1 = *(const f32x4*)(YS + tx * SYP + cgx * 8 + 4);
                float zf[8], o[8]; unpack8(zw, zf);
#pragma unroll
                for (int e = 0; e < 8; ++e) { const float yv = (e < 4 ? y0[e & 3] : y1[e & 3]) + Dh * xv[e]; o[e] = yv * siluf_(zf[e]); }
                *(u32x4*)(Z + (size_t)(r0 + tx) * DI + xcol) = pack8f(o);
            }
        }
#undef SSD_LOADS
        float* so = p->out + (smp ? O_SSMS : O_SSMP) + ((size_t)b * 64 + hd) * 64 * 128 + st_off;
#pragma unroll
        for (int i = 0; i < 4; ++i)
#pragma unroll
            for (int j = 0; j < 4; ++j) so[j * 128 + i * 16] = st[i][j];
        __syncthreads();
    }
}
__device__ __forceinline__ float logsig_(float f) { return fminf(f, 0.f) - log1pf(__expf(-fabsf(f))); }
__device__ __forceinline__ void phase_gn(KPrm p, const Ctx cx) {
    const int tid = cx.tid, lane = tid & 63, wid = tid >> 6;
    const int gw = cx.bid * 8 + wid, NGW = cx.G * 8;
    const float* SM = (const float*)(p->ws + W_SMALL);
    if (gw < 192) {
        if (gw < 64) { const int b = gw >> 4, h = gw & 15; const float fb = p->in[I_FB][h];
            float* bias = (float*)(p->ws + W_BIASP) + (size_t)(b * 16 + h) * TP; float* lo = p->out + O_LFP;
            const int tb = lane * 128; float s = 0.f;
            for (int i = 0; i < 128; ++i) s += logsig_(SM[(size_t)(b * TP + tb + i) * 256 + 64 + h] + fb);
            float inc = s;
#pragma unroll
            for (int o = 1; o < 64; o <<= 1) { const float y = __shfl_up(inc, o); if (lane >= o) inc += y; }
            float run = inc - s;
            for (int i = 0; i < 128; ++i) { const float lf = logsig_(SM[(size_t)(b * TP + tb + i) * 256 + 64 + h] + fb); run += lf;
                lo[(size_t)(b * TP + tb + i) * 16 + h] = lf; bias[tb + i] = -run * LOG2E; }
        } else { const int u = gw - 64, sb = u >> 4, h = u & 15; const float fb = p->in[I_FB][h];
            float* bias = (float*)(p->ws + W_BIASS) + (size_t)(sb * 16 + h) * SKVS; float* lo = p->out + O_LFS;
            const int tb = lane * 33; float s = 0.f;
            for (int i = 0; i < 33; ++i) { const int pos = tb + i;
                s += (pos < PAST) ? p->in[I_CLF][(size_t)(sb * PAST + pos) * 16 + h] : logsig_(SM[(size_t)(MP + sb * TS + pos - PAST) * 256 + 64 + h] + fb); }
            float inc = s;
#pragma unroll
            for (int o = 1; o < 64; o <<= 1) { const float y = __shfl_up(inc, o); if (lane >= o) inc += y; }
            float run = inc - s;
            for (int i = 0; i < 33; ++i) { const int pos = tb + i; float lf;
                if (pos < PAST) lf = p->in[I_CLF][(size_t)(sb * PAST + pos) * 16 + h];
                else { lf = logsig_(SM[(size_t)(MP + sb * TS + pos - PAST) * 256 + 64 + h] + fb); lo[(size_t)(sb * TS + pos - PAST) * 16 + h] = lf; }
                run += lf; bias[pos] = -run * LOG2E; }
        }
    }
    {
        const u16* XBC = (const u16*)(p->ws + W_XBC);
        const int gt = cx.bid * 512 + tid, GT = cx.G * 512;
        for (int i = gt; i < 12 * 3 * CD; i += GT) { const int bb = i / (3 * CD), r = (i / CD) % 3, c = i % CD;
            if (bb < 4) p->out[O_MCP + i] = bflo(XBC[(size_t)(bb * TP + TP - 3 + r) * CD + c]);
            else p->out[O_MCS + (i - 4 * 3 * CD)] = bflo(XBC[(size_t)(MP + (bb - 4) * TS + TS - 3 + r) * CD + c]); }
    }
    u16* Z = (u16*)(p->ws + W_Z); const float* mnw = p->in[I_MNW];
    for (int row = gw; row < M; row += NGW) {
#pragma unroll 2
        for (int i = 0; i < 8; ++i) { const int col = i * 512 + lane * 8; u16* zp = Z + (size_t)row * DI + col;
            float v[8]; unpack8(*(const u32x4*)zp, v); float ss = 0.f;
#pragma unroll
            for (int e = 0; e < 8; ++e) ss += v[e] * v[e];
            const float rs = rsqrtf(wave_sum(ss) * (1.f / 512.f) + EPS);
            const f32x4 w0 = *(const f32x4*)(mnw + col), w1 = *(const f32x4*)(mnw + col + 4);
#pragma unroll
            for (int e = 0; e < 8; ++e) v[e] = v[e] * rs * (e < 4 ? w0[e & 3] : w1[e & 3]);
            *(u32x4*)zp = pack8f(v); }
    }
}
__device__ __forceinline__ void phase_qk(KPrm p, const Ctx cx) {
    const int tid = cx.tid, lane = tid & 63, wid = tid >> 6;
    const int gw = cx.bid * 8 + wid, NGW = cx.G * 8;
    u16* Q = (u16*)(p->ws + W_Q); u16* K = (u16*)(p->ws + W_K); const u16* V = (const u16*)(p->ws + W_V);
    u16* Ks = (u16*)p->out; u16* Vs = Ks + (size_t)NBS * SKVS * DM;
    const float QS = 0.08838834764831845f * LOG2E;
    const int hc = (lane & 15) * 8;
    const f32x4 qw0 = *(const f32x4*)(p->in[I_QNW] + hc), qw1 = *(const f32x4*)(p->in[I_QNW] + hc + 4), kw0 = *(const f32x4*)(p->in[I_KNW] + hc), kw1 = *(const f32x4*)(p->in[I_KNW] + hc + 4);
    for (int row = gw; row < M; row += NGW) {
        const bool smp = row >= MP;
        float* ko = smp ? p->out + O_KS + (size_t)(row - MP) * DM : p->out + O_KP + (size_t)row * DM;
        float* vo = smp ? p->out + O_VS + (size_t)(row - MP) * DM : p->out + O_VP + (size_t)row * DM;
        size_t srow = 0; if (smp) { const int sb = (row - MP) >> 6, t = (row - MP) & 63; srow = (size_t)(sb * SKVS + PAST + t) * DM; }
#pragma unroll
        for (int it = 0; it < 4; ++it) { const int col = it * 512 + lane * 8; const size_t off = (size_t)row * DM + col;
            float v[8], ss;
            unpack8(*(const u32x4*)(Q + off), v); ss = 0.f;
#pragma unroll
            for (int e = 0; e < 8; ++e) ss += v[e] * v[e];
            ss += __shfl_xor(ss, 1); ss += __shfl_xor(ss, 2); ss += __shfl_xor(ss, 4); ss += __shfl_xor(ss, 8);
            float rs = rsqrtf(ss * (1.f / 128.f) + EPS) * QS;
#pragma unroll
            for (int e = 0; e < 8; ++e) v[e] = v[e] * rs * (e < 4 ? qw0[e & 3] : qw1[e & 3]);
            *(u32x4*)(Q + off) = pack8f(v);
            unpack8(*(const u32x4*)(K + off), v); ss = 0.f;
#pragma unroll
            for (int e = 0; e < 8; ++e) ss += v[e] * v[e];
            ss += __shfl_xor(ss, 1); ss += __shfl_xor(ss, 2); ss += __shfl_xor(ss, 4); ss += __shfl_xor(ss, 8);
            rs = rsqrtf(ss * (1.f / 128.f) + EPS);
#pragma unroll
            for (int e = 0; e < 8; ++e) v[e] = v[e] * rs * (e < 4 ? kw0[e & 3] : kw1[e & 3]);
            const u32x4 kp = pack8f(v);
            *(u32x4*)(K + off) = kp;
            *(f32x4*)(ko + col) = (f32x4){v[0], v[1], v[2], v[3]}; *(f32x4*)(ko + col + 4) = (f32x4){v[4], v[5], v[6], v[7]};
            const u32x4 vw = *(const u32x4*)(V + off); unpack8(vw, v);
            *(f32x4*)(vo + col) = (f32x4){v[0], v[1], v[2], v[3]}; *(f32x4*)(vo + col + 4) = (f32x4){v[4], v[5], v[6], v[7]};
            if (smp) { *(u32x4*)(Ks + srow + col) = kp; *(u32x4*)(Vs + srow + col) = vw; } }
    }
}
typedef att::BlockRef<att::bf16, att::bf16> ARef;
__device__ __forceinline__ ARef att_ref(KPrm p, const Ctx cx, int i, int nbp, int& skv) {
    const int G = cx.G, bid = (cx.G % 8 == 0) ? (cx.bid % 8) * (cx.G / 8) + cx.bid / 8 : cx.bid; ARef r;
    att::bf16* Qb = (att::bf16*)(p->ws + W_Q); const att::bf16* Kb = (const att::bf16*)(p->ws + W_K); const att::bf16* Vb = (const att::bf16*)(p->ws + W_V);
    if (i < nbp) { const int L = bid + (i >> 1) * G, bh = L >> 4, x = L & 15, qb = (i & 1) ? 31 - x : x, b = bh >> 4, h = bh & 15;
        const size_t rq = ((size_t)b * TP + (size_t)qb * 256) * DM + h * 128, rk = (size_t)b * TP * DM + h * 128;
        r.Q = Qb + rq; r.O = Qb + rq; r.K = Kb + rk; r.V = Vb + rk; r.Bs = (const float*)(p->ws + W_BIASP) + (size_t)bh * TP; r.P0 = qb * 256; r.nvalid = 256; skv = TP;
    } else { const int su = bid + (i - nbp) * G, sb = su >> 4, h = su & 15;
        const att::bf16* Ks = (const att::bf16*)p->out; const att::bf16* Vs = Ks + (size_t)NBS * SKVS * DM;
        const size_t rq = ((size_t)MP + (size_t)sb * TS) * DM + h * 128, rk = (size_t)sb * SKVS * DM + h * 128;
        r.Q = Qb + rq; r.O = Qb + rq; r.K = Ks + rk; r.V = Vs + rk; r.Bs = (const float*)(p->ws + W_BIASS) + (size_t)su * SKVS; r.P0 = PAST; r.nvalid = TS; skv = SKVS; }
    return r;
}
__device__ __forceinline__ void phase_att(KPrm p, const Ctx cx, char* lds) {
    const int G = cx.G, bid = (cx.G % 8 == 0) ? (cx.bid % 8) * (cx.G / 8) + cx.bid / 8 : cx.bid;
    const int nip = (bid < 1024) ? (1024 - bid + G - 1) / G : 0, nbp = 2 * nip, nbs = (bid < 128) ? (128 - bid + G - 1) / G : 0, nb = nbp + nbs;
    if (nb == 0) return;
    const int W = 1 << 30;
    int skv, skvn; ARef cur = att_ref(p, cx, 0, nbp, skv);
    att::Seam<att::bf16> S;
    att::causal_swa_prime<att::bf16, att::bf16>(cur, W, lds, S, cx.tid);
    for (int i = 0; i < nb; ++i) {
        const bool last = (i + 1 == nb);
        ARef nxt = cur; skvn = skv; if (!last) nxt = att_ref(p, cx, i + 1, nbp, skvn);
        att::causal_swa_block<att::bf16, att::bf16>(cur, nxt, skv, W, lds, S, cx.tid);
        cur = nxt; skv = skvn;
    }
}
__device__ __forceinline__ void phase_cv(KPrm p, const Ctx cx, int half) {
    const int tid = cx.tid;
    const u16* U = (const u16*)(p->ws + W_U); u16* Gb = (u16*)(p->ws + W_G); u16* HALO = (u16*)(p->ws + W_HALO);
    const float* cw = p->in[I_FCW]; const float* cb = p->in[I_FCB];
    const int row_lo = half ? HALF_ROWS : 0;
    constexpr int NCG = DFF / 8, RB = 16, NRB = HALF_ROWS / RB;
    const long gt = (long)cx.bid * 512 + tid, GT = (long)cx.G * 512;
    for (long it = gt; it < (long)NCG * NRB; it += GT) {
        const int cgi = (int)(it % NCG), rb = (int)(it / NCG); const int f0 = cgi * 8, r0 = row_lo + rb * RB;
        const int ca = (f0 >> 7) * 256 + (f0 & 127), cbb = ca + 128;
        float wa[3][8], wb[3][8], ba[8], bb[8];
#pragma unroll
        for (int k = 0; k < 3; ++k) { const f32x4 a0 = *(const f32x4*)(cw + k * DFF2 + f0), a1 = *(const f32x4*)(cw + k * DFF2 + f0 + 4), b0 = *(const f32x4*)(cw + k * DFF2 + DFF + f0), b1 = *(const f32x4*)(cw + k * DFF2 + DFF + f0 + 4);
#pragma unroll
            for (int e = 0; e < 4; ++e) { wa[k][e] = a0[e]; wa[k][4 + e] = a1[e]; wb[k][e] = b0[e]; wb[k][4 + e] = b1[e]; } }
        { const f32x4 a0 = *(const f32x4*)(cb + f0), a1 = *(const f32x4*)(cb + f0 + 4), b0 = *(const f32x4*)(cb + DFF + f0), b1 = *(const f32x4*)(cb + DFF + f0 + 4);
#pragma unroll
          for (int e = 0; e < 4; ++e) { ba[e] = a0[e]; ba[4 + e] = a1[e]; bb[e] = b0[e]; bb[4 + e] = b1[e]; } }
        float ha[2][8], hb[2][8];
        const bool smp = r0 >= MP; const int tb = smp ? ((r0 - MP) & 63) : (r0 & (TP - 1));
        if (tb == 0) {
            if (smp) { const float* s = p->in[I_FCV] + (size_t)((r0 - MP) >> 6) * 2 * DFF2;
#pragma unroll
                for (int k = 0; k < 2; ++k)
#pragma unroll
                    for (int e = 0; e < 8; ++e) { ha[k][e] = s[k * DFF2 + f0 + e]; hb[k][e] = s[k * DFF2 + DFF + f0 + e]; }
            } else {
#pragma unroll
                for (int k = 0; k < 2; ++k)
#pragma unroll
                    for (int e = 0; e < 8; ++e) { ha[k][e] = 0.f; hb[k][e] = 0.f; } }
        } else if (half && rb == 0) {
#pragma unroll
            for (int k = 0; k < 2; ++k) { unpack8(*(const u32x4*)(HALO + (size_t)k * DFF2 + ca), ha[k]); unpack8(*(const u32x4*)(HALO + (size_t)k * DFF2 + cbb), hb[k]); }
        } else {
#pragma unroll
            for (int k = 0; k < 2; ++k) { const size_t ro = (size_t)(r0 - row_lo - 2 + k) * DFF2; unpack8(*(const u32x4*)(U + ro + ca), ha[k]); unpack8(*(const u32x4*)(U + ro + cbb), hb[k]); }
        }
#pragma unroll 4
        for (int i = 0; i < RB; ++i) { const int r = r0 + i; const size_t ro = (size_t)(r - row_lo) * DFF2;
            const u32x4 uaw = *(const u32x4*)(U + ro + ca), ubw = *(const u32x4*)(U + ro + cbb);
            float ua[8], ub[8], o[8]; unpack8(uaw, ua); unpack8(ubw, ub);
#pragma unroll
            for (int e = 0; e < 8; ++e) { const float va = ba[e] + wa[0][e] * ha[0][e] + wa[1][e] * ha[1][e] + wa[2][e] * ua[e], vb = bb[e] + wb[0][e] * hb[0][e] + wb[1][e] * hb[1][e] + wb[2][e] * ub[e];
                o[e] = siluf_(va) * vb; ha[0][e] = ha[1][e]; ha[1][e] = ua[e]; hb[0][e] = hb[1][e]; hb[1][e] = ub[e]; }
            *(u32x4*)(Gb + (size_t)r * DFF + f0) = pack8f(o);
            const int tpos = (r >= MP) ? ((r - MP) & 63) : (r & (TP - 1)), tlen = (r >= MP) ? TS : TP;
            if (tpos >= tlen - 2) { float* fo = (r >= MP) ? p->out + O_FCS + ((size_t)((r - MP) >> 6) * 2 + (tpos - (tlen - 2))) * DFF2 : p->out + O_FCP + ((size_t)(r >> 13) * 2 + (tpos - (tlen - 2))) * DFF2;
#pragma unroll
                for (int e = 0; e < 8; ++e) { fo[f0 + e] = ua[e]; fo[DFF + f0 + e] = ub[e]; } }
            if (!half && r >= HALF_ROWS - 2) { *(u32x4*)(HALO + (size_t)(r - (HALF_ROWS - 2)) * DFF2 + ca) = uaw; *(u32x4*)(HALO + (size_t)(r - (HALF_ROWS - 2)) * DFF2 + cbb) = ubw; }
        }
    }
}
constexpr int LDS_TOTAL = 147456;
enum { PH_PREP = 0, PH_N1, PH_G1A, PH_SSD, PH_GN, PH_G1B, PH_G2, PH_G1C, PH_QK, PH_ATT, PH_G3, PH_G4, PH_N2, PH_G5A, PH_CVA, PH_G5B, PH_CVB, PH_G6, PH_COUNT };
__device__ __forceinline__ void run_gemms(KPrm p, const Ctx cx, unsigned char* lds, const int first, const int last, cg::grid_group& grid) {
#pragma unroll 1
    for (int ph = first; ph <= last; ++ph) {
        unsigned char* ws = p->ws;
        pg8::Gemm g; Epi E;
        g.A = (const u16*)(ws + W_H); g.Bt = nullptr; g.M = M; g.N = DM; g.K = DM;
        E.mode = 0; E.d0 = E.d1 = E.d2 = nullptr; E.t1 = E.t2 = 1 << 20; E.p0 = E.p1 = E.p2 = 0; E.f32seg2 = 0;
        E.xp = p->in[I_XP]; E.xs = p->in[I_XS]; E.y = p->out; E.mod = (const float*)(ws + W_MOD); E.gbuf = (u16*)(ws + W_GM); E.gf = (const u16*)(ws + W_GF);
        switch (ph) {
        case PH_G1A: g.Bt = (const u16*)(ws + W_WIN); g.N = 41 * 256;
            E.d0 = (u16*)(ws + W_XBC); E.p0 = CD; E.t1 = 24; E.d1 = (u16*)(ws + W_Z); E.p1 = DI; E.t2 = 40; E.d2 = (u16*)(ws + W_SMALL); E.p2 = 256; E.f32seg2 = 1; break;
        case PH_G1B: g.Bt = (const u16*)(ws + W_WIN) + (size_t)10496 * DM; g.N = 16 * 256;
            E.d0 = (u16*)(ws + W_GM); E.p0 = DM; E.t1 = 8; E.d1 = (u16*)(ws + W_GF); E.p1 = DM; break;
        case PH_G2: g.A = (const u16*)(ws + W_Z); g.Bt = (const u16*)(ws + W_WPM); g.K = DI; E.mode = 1; break;
        case PH_G1C: g.Bt = (const u16*)(ws + W_WIN) + (size_t)14592 * DM; g.N = 24 * 256;
            E.d0 = (u16*)(ws + W_Q); E.p0 = DM; E.t1 = 8; E.d1 = (u16*)(ws + W_K); E.p1 = DM; E.t2 = 16; E.d2 = (u16*)(ws + W_V); E.p2 = DM; break;
        case PH_G3: g.A = (const u16*)(ws + W_Q); g.Bt = (const u16*)(ws + W_WPF); E.mode = 2; break;
        case PH_G4: g.A = (const u16*)(ws + W_GM); g.Bt = (const u16*)(ws + W_WOUT); E.mode = 3; break;
        case PH_G5A: g.Bt = (const u16*)(ws + W_WUP); g.M = HALF_ROWS; g.N = DFF2; E.d0 = (u16*)(ws + W_U); E.p0 = DFF2; break;
        case PH_G5B: g.A = (const u16*)(ws + W_H) + (size_t)HALF_ROWS * DM; g.Bt = (const u16*)(ws + W_WUP); g.M = HALF_ROWS; g.N = DFF2; E.d0 = (u16*)(ws + W_U); E.p0 = DFF2; break;
        default:   g.A = (const u16*)(ws + W_G); g.Bt = (const u16*)(ws + W_WDN); g.K = DFF; E.mode = 5; break;
        }
        pg8::StaticOrder S; S.init(g.M, g.N, cx.G, cx.bid);
        pg8::gemm_phase<Epi, pg8::StaticOrder, true, true>((PG8_LAS unsigned char*)lds, g, S, E, cx.tid);
        if (ph < last) grid.sync();
    }
}
#define PH_BEGIN() Ctx cx; { int t_ = threadIdx.x; asm volatile("" : "+v"(t_)); int b_ = blockIdx.x, g_ = gridDim.x; asm volatile("" : "+s"(b_), "+s"(g_)); cx.tid = t_; cx.bid = b_; cx.G = g_; } \
    KPrm p = (KPrm)__builtin_amdgcn_kernarg_segment_ptr(); asm volatile("" : "+s"(p))
#ifdef ONLY_PH
#define PH_ON(k) ((k) == ONLY_PH)
#else
#define PH_ON(k) true
#endif
__global__ void __launch_bounds__(512, 2) mega_fwd(Prm prm_unused) {
    extern __shared__ __attribute__((aligned(16))) unsigned char lds[];
    cg::grid_group grid = cg::this_grid();
    if (PH_ON(PH_PREP)) { PH_BEGIN(); phase_prep(p, cx, lds); } grid.sync();
    if (PH_ON(PH_N1)) { PH_BEGIN(); phase_norm(p, cx, 0); } grid.sync();
    if (PH_ON(PH_G1A)) { PH_BEGIN(); run_gemms(p, cx, lds, PH_G1A, PH_G1A, grid); } grid.sync();
    if (PH_ON(PH_SSD)) { PH_BEGIN(); phase_ssd(p, cx, lds); } grid.sync();
    if (PH_ON(PH_GN)) { PH_BEGIN(); phase_gn(p, cx); } grid.sync();
    if (PH_ON(PH_G1B)) { PH_BEGIN(); run_gemms(p, cx, lds, PH_G1B, PH_G1C, grid); } grid.sync();
    if (PH_ON(PH_QK)) { PH_BEGIN(); phase_qk(p, cx); } grid.sync();
    if (PH_ON(PH_ATT)) { PH_BEGIN(); phase_att(p, cx, (char*)lds); } grid.sync();
    if (PH_ON(PH_G3)) { PH_BEGIN(); run_gemms(p, cx, lds, PH_G3, PH_G4, grid); } grid.sync();
    if (PH_ON(PH_N2)) { PH_BEGIN(); phase_norm(p, cx, 1); } grid.sync();
    if (PH_ON(PH_G5A)) { PH_BEGIN(); run_gemms(p, cx, lds, PH_G5A, PH_G5A, grid); } grid.sync();
    if (PH_ON(PH_CVA)) { PH_BEGIN(); phase_cv(p, cx, 0); } grid.sync();
    if (PH_ON(PH_G5B)) { PH_BEGIN(); run_gemms(p, cx, lds, PH_G5B, PH_G5B, grid); } grid.sync();
    if (PH_ON(PH_CVB)) { PH_BEGIN(); phase_cv(p, cx, 1); } grid.sync();
    if (PH_ON(PH_G6)) { PH_BEGIN(); run_gemms(p, cx, lds, PH_G6, PH_G6, grid); }
}

extern "C" void kernel_launch(void* const* d_in, const int* in_sizes, int n_in, void* d_out, int out_size, void* d_ws, size_t ws_size, hipStream_t stream) {
    static int grid = 0;
    if (grid == 0) {
        if (n_in != 31 || (size_t)out_size != O_END || ws_size < 1024 * MiB) { fprintf(stderr, "kernel_launch: unexpected sizes n_in %d out %d ws %zu\n", n_in, out_size, ws_size); }
        int dev = 0, cus = 0, per_cu = 0;
        hipGetDevice(&dev); hipDeviceGetAttribute(&cus, hipDeviceAttributeMultiprocessorCount, dev);
        hipFuncSetAttribute((const void*)mega_fwd, hipFuncAttributeMaxDynamicSharedMemorySize, LDS_TOTAL);
        hipOccupancyMaxActiveBlocksPerMultiprocessor(&per_cu, (const void*)mega_fwd, 512, LDS_TOTAL);
        (void)hipGetLastError();
        if (per_cu < 1) per_cu = 1;
        grid = cus;
    }
    Prm prm{};
    for (int i = 0; i < 31; ++i) prm.in[i] = (const float*)d_in[i];
    prm.out = (float*)d_out; prm.ws = (unsigned char*)d_ws;
    void* args[] = {&prm};
    hipError_t e = hipLaunchCooperativeKernel((const void*)mega_fwd, dim3(grid), dim3(512), args, LDS_TOTAL, stream);
    if (e != hipSuccess) fprintf(stderr, "cooperative launch failed: %s (grid %d)\n", hipGetErrorString(e), grid);
}
```

```cpp
#include <hip/hip_runtime.h>
#include <hip/hip_cooperative_groups.h>
#include <hip/hip_bf16.h>
#include <cstdio>
#include <cstdint>
namespace cg = cooperative_groups;
namespace pg8 {
#define PG8_LAS __attribute__((address_space(3)))
typedef unsigned short bf16_t;
typedef short bf16x8 __attribute__((ext_vector_type(8)));
typedef float f32x4 __attribute__((ext_vector_type(4)));
typedef unsigned u32x4 __attribute__((ext_vector_type(4)));
constexpr int BM = 256, BK = 64, HALF = 128, HTB = HALF * BK * 2  , STAGE_BYTES = 8 * HTB, NXCD = 8, WGM = 8;

__host__ __device__ __forceinline__ int lds_byte(int r, int c) { const int st = (r >> 4) * 2 + (c >> 5), rr = r & 15, cc = c & 31, ob = rr * 64 + cc * 2; return st * 1024 + (ob ^ (((ob >> 9) & 1) << 5)); }
__host__ __device__ __forceinline__ void stage_rc(int b, int& R, int& C) { const int st = b / 1024, sb = b % 1024, swz = sb ^ (((sb >> 9) & 1) << 5); R = (st >> 1) * 16 + swz / 64; C = (st & 1) * 32 + (swz % 64) / 2; }
__host__ __device__ __forceinline__ int perm32(int rho) { const int n = rho >> 4, i = rho & 15; return 8 * (i >> 2) + 4 * n + (i & 3); }

struct Unit { int pm, pn; };
struct Gemm { const bf16_t* A; const bf16_t* Bt; int M, N, K; };

struct StaticOrder {
    int nM, nN, nwg, G, c;
    __host__ __device__ void init(int M, int N, int G_, int c_) { nM = M / BM; nN = N / BM; nwg = nM * nN; G = G_; c = c_; }
    __host__ __device__ bool next(int i, Unit& u) const {
        const long L = (long)i * G + c; if (L >= nwg) return false;
        int wgid = (int)L; { const int q = nwg / NXCD, r = nwg % NXCD, xcd = wgid % NXCD, off = wgid / NXCD; wgid = (xcd < r ? xcd * (q + 1) : r * (q + 1) + (xcd - r) * q) + off; }
        const int nig = WGM * nN, gid = wgid / nig, fm = gid * WGM, gsz = (nM - fm) < WGM ? (nM - fm) : WGM;
        u.pm = fm + ((wgid % nig) % gsz); u.pn = (wgid % nig) / gsz; return true;
    }
    __device__ __forceinline__ void a_ready(const Unit&) const {}
    __device__ __forceinline__ void done(const Unit&) const {}
};
__device__ __forceinline__ unsigned cvt_pk_bf16(float lo, float hi) { unsigned r; asm volatile("v_cvt_pk_bf16_f32 %0, %1, %2" : "=v"(r) : "v"(lo), "v"(hi)); return r; }
typedef float f32x2 __attribute__((ext_vector_type(2)));
template <class Epi, class Sched, bool ALIGN_EPI = false, bool SP2 = false>
__device__ __forceinline__ void gemm_phase(PG8_LAS unsigned char* lds, const Gemm g, const Sched& S, const Epi& E, const int tid) {
    const int wid = __builtin_amdgcn_readfirstlane(tid >> 6), lane = tid & 63, wr = wid >> 2, wc = wid & 3, fr = lane & 15, fq = lane >> 4;
    const int K = g.K, nt = K / BK;
    unsigned voffA[2], voffB[2];
#pragma unroll
    for (int i = 0; i < 2; ++i) { int R, C; stage_rc(tid * 16 + i * 8192, R, C); const int Rb = Epi::PERM ? ((R & ~31) + perm32(R & 31)) : R;
        voffA[i] = (unsigned)(R * K + C) * 2u; voffB[i] = (unsigned)(Rb * K + C) * 2u; }
    const size_t kstep = (size_t)(BK * 2);
    const size_t hstep = (size_t)HALF * K * 2;
    const size_t tstep = 2 * hstep;
    const unsigned ldsw = (unsigned)wid * 1024u;
    const int aoff = lds_byte(wr * 64 + fr, fq * 8), boff = lds_byte(wc * 32 + fr, fq * 8);
#define PG8_SA(b, h) (((b) * 2 + (h)) * HTB)
#define PG8_SB(b, h) ((4 + (b) * 2 + (h)) * HTB)
#define PG8_STAGE(bufoff, gbase, voff) do { _Pragma("unroll") for (int _i = 0; _i < 2; ++_i) \
        __builtin_amdgcn_global_load_lds((const unsigned*)((const char*)(gbase) + (voff)[_i]), (PG8_LAS unsigned*)(lds + (bufoff) + ldsw + _i * 8192), 16, 0, 0); } while (0)
#define PG8_LDA(dst, b, h) do { _Pragma("unroll") for (int m = 0; m < 4; ++m) _Pragma("unroll") for (int k = 0; k < 2; ++k) dst[m][k] = *(const PG8_LAS bf16x8*)(lds + PG8_SA(b, h) + aoff + m * 2048 + k * 1024); } while (0)
#define PG8_LDB(dst, b, h) do { _Pragma("unroll") for (int n = 0; n < 2; ++n) _Pragma("unroll") for (int k = 0; k < 2; ++k) dst[n][k] = *(const PG8_LAS bf16x8*)(lds + PG8_SB(b, h) + boff + n * 2048 + k * 1024); } while (0)
#define PG8_MMA(ai, bj, At, Bt) do { __builtin_amdgcn_s_setprio(1); _Pragma("unroll") for (int m = 0; m < 4; ++m) _Pragma("unroll") for (int n = 0; n < 2; ++n) _Pragma("unroll") for (int k = 0; k < 2; ++k) \
        acc[ai][bj][m][n] = __builtin_amdgcn_mfma_f32_16x16x32_bf16(Bt[n][k], At[m][k], acc[ai][bj][m][n], 0, 0, 0); __builtin_amdgcn_s_setprio(0); } while (0)
#define PG8_WAIT_V(n) asm volatile("s_waitcnt vmcnt(" #n ")" ::: "memory")
#define PG8_WAIT_L(n) asm volatile("s_waitcnt lgkmcnt(" #n ")" ::: "memory")
#define PG8_BAR __builtin_amdgcn_s_barrier()
#define PG8_SCHED __builtin_amdgcn_sched_barrier(0)
    Unit cur, nxt; int ui = 0;
    if (!S.next(0, cur)) return;
    f32x4 acc[2][2][4][2];
#pragma unroll
    for (int a = 0; a < 2; ++a)
#pragma unroll
        for (int b = 0; b < 2; ++b)
#pragma unroll
            for (int m = 0; m < 4; ++m)
#pragma unroll
                for (int n = 0; n < 2; ++n) acc[a][b][m][n] = (f32x4){0.f, 0.f, 0.f, 0.f};
    bf16x8 At[4][2], B0[2][2], B1[2][2];
    const char* cA = (const char*)g.A + (size_t)cur.pm * tstep; const char* cB = (const char*)g.Bt + (size_t)cur.pn * tstep;
    S.a_ready(cur);
    if constexpr (SP2) {
        PG8_STAGE(PG8_SB(0, 0), cB, voffB); PG8_STAGE(PG8_SB(0, 1), cB + hstep, voffB); PG8_STAGE(PG8_SA(0, 0), cA, voffA); PG8_STAGE(PG8_SA(0, 1), cA + hstep, voffA);
        if (wr == 1) PG8_BAR;
        PG8_WAIT_V(2); PG8_BAR;
        PG8_STAGE(PG8_SB(1, 0), cB + kstep, voffB); PG8_STAGE(PG8_SA(1, 0), cA + kstep, voffA); PG8_STAGE(PG8_SB(1, 1), cB + hstep + kstep, voffB);
        PG8_WAIT_V(6); PG8_BAR;
    } else {
        PG8_STAGE(PG8_SB(0, 0), cB, voffB); PG8_STAGE(PG8_SA(0, 0), cA, voffA); PG8_STAGE(PG8_SB(0, 1), cB + hstep, voffB); PG8_STAGE(PG8_SA(0, 1), cA + hstep, voffA);
        if (wr == 1) PG8_BAR;
        PG8_WAIT_V(4); PG8_BAR;
        PG8_STAGE(PG8_SB(1, 0), cB + kstep, voffB); PG8_STAGE(PG8_SA(1, 0), cA + kstep, voffA); PG8_STAGE(PG8_SB(1, 1), cB + hstep + kstep, voffB);
        PG8_WAIT_V(6); PG8_BAR;
    }
    for (;;) {
        const bool has_next = S.next(ui + 1, nxt);
        const char* nA = has_next ? (const char*)g.A + (size_t)nxt.pm * tstep : cA; const char* nB = has_next ? (const char*)g.Bt + (size_t)nxt.pn * tstep : cB;
        for (int t = 0; t < nt; t += 2) {
            const bool last = (t == nt - 2);
            const char* a1 = cA + (size_t)(t + 1) * kstep;
            const char* a2 = last ? nA : cA + (size_t)(t + 2) * kstep; const char* b2 = last ? nB : cB + (size_t)(t + 2) * kstep;
            const char* a3 = a2 + kstep; const char* b3 = b2 + kstep;
            if (last && has_next) S.a_ready(nxt);
            if constexpr (SP2) {
            PG8_LDB(B0, 0, 0); PG8_LDB(B1, 0, 1); PG8_SCHED; PG8_LDA(At, 0, 0); PG8_STAGE(PG8_SA(1, 1), a1 + hstep, voffA);
            PG8_WAIT_V(8); PG8_WAIT_L(0); PG8_BAR; PG8_MMA(0, 0, At, B0); PG8_MMA(0, 1, At, B1); PG8_BAR; PG8_SCHED;
            PG8_LDA(At, 0, 1); PG8_STAGE(PG8_SB(0, 0), b2, voffB); PG8_STAGE(PG8_SB(0, 1), b2 + hstep, voffB); PG8_STAGE(PG8_SA(0, 0), a2, voffA);
            PG8_WAIT_V(8); PG8_WAIT_L(0); PG8_BAR; PG8_MMA(1, 0, At, B0); PG8_MMA(1, 1, At, B1); PG8_BAR; PG8_SCHED;
            PG8_LDB(B0, 1, 0); PG8_LDB(B1, 1, 1); PG8_SCHED; PG8_LDA(At, 1, 0); PG8_STAGE(PG8_SA(0, 1), a2 + hstep, voffA);
            PG8_WAIT_V(8); PG8_WAIT_L(0); PG8_BAR; PG8_MMA(0, 0, At, B0); PG8_MMA(0, 1, At, B1); PG8_BAR; PG8_SCHED;
            PG8_LDA(At, 1, 1); PG8_STAGE(PG8_SB(1, 0), b3, voffB); PG8_STAGE(PG8_SB(1, 1), b3 + hstep, voffB); PG8_STAGE(PG8_SA(1, 0), a3, voffA);
            PG8_WAIT_V(8); PG8_WAIT_L(0); PG8_BAR; PG8_MMA(1, 0, At, B0); PG8_MMA(1, 1, At, B1); PG8_BAR; PG8_SCHED;
            } else {
            PG8_LDB(B0, 0, 0); PG8_SCHED; PG8_LDA(At, 0, 0); PG8_STAGE(PG8_SA(1, 1), a1 + hstep, voffA);
            PG8_WAIT_L(8); PG8_BAR; PG8_WAIT_L(0); PG8_MMA(0, 0, At, B0); PG8_BAR; PG8_SCHED;
            PG8_LDB(B1, 0, 1); PG8_STAGE(PG8_SB(0, 0), b2, voffB);
            PG8_BAR; PG8_WAIT_L(0); PG8_MMA(0, 1, At, B1); PG8_BAR;
            PG8_LDA(At, 0, 1); PG8_STAGE(PG8_SA(0, 0), a2, voffA);
            PG8_BAR; PG8_WAIT_L(0); PG8_MMA(1, 0, At, B0); PG8_BAR; PG8_SCHED;
            PG8_STAGE(PG8_SB(0, 1), b2 + hstep, voffB);
            PG8_WAIT_V(6); PG8_BAR; PG8_MMA(1, 1, At, B1); PG8_BAR;
            PG8_LDB(B0, 1, 0); PG8_SCHED; PG8_LDA(At, 1, 0); PG8_STAGE(PG8_SA(0, 1), a2 + hstep, voffA);
            PG8_WAIT_L(8); PG8_BAR; PG8_WAIT_L(0); PG8_MMA(0, 0, At, B0); PG8_BAR; PG8_SCHED;
            PG8_LDB(B1, 1, 1); PG8_STAGE(PG8_SB(1, 0), b3, voffB);
            PG8_BAR; PG8_WAIT_L(0); PG8_MMA(0, 1, At, B1); PG8_BAR;
            PG8_LDA(At, 1, 1); PG8_STAGE(PG8_SA(1, 0), a3, voffA);
            PG8_BAR; PG8_WAIT_L(0); PG8_MMA(1, 0, At, B0); PG8_BAR; PG8_SCHED;
            PG8_STAGE(PG8_SB(1, 1), b3 + hstep, voffB);
            PG8_WAIT_V(6); PG8_BAR; PG8_MMA(1, 1, At, B1); PG8_BAR;
            }
        }
        if constexpr (ALIGN_EPI) { if (wr == 0) PG8_BAR; }
        if constexpr (!Epi::AFTER_DRAIN) { E(acc, cur, wr, wc, fr, fq); S.done(cur); }
        if (!has_next) break;
#pragma unroll
        for (int a = 0; a < 2; ++a)
#pragma unroll
            for (int b = 0; b < 2; ++b)
#pragma unroll
                for (int m = 0; m < 4; ++m)
#pragma unroll
                    for (int n = 0; n < 2; ++n) acc[a][b][m][n] = (f32x4){0.f, 0.f, 0.f, 0.f};
        cur = nxt; cA = nA; cB = nB; ++ui;
        if constexpr (ALIGN_EPI) { if (wr == 1) PG8_BAR; }
    }
    PG8_WAIT_V(0);
    if constexpr (!ALIGN_EPI) { if (wr == 0) PG8_BAR; }
    PG8_BAR;
    if constexpr (Epi::AFTER_DRAIN) { E.fused(acc, cur, wr, wc, fr, fq, lds, wid, lane); S.done(cur); }
#undef PG8_SA
#undef PG8_SB
#undef PG8_STAGE
#undef PG8_LDA
#undef PG8_LDB
#undef PG8_MMA
#undef PG8_WAIT_V
#undef PG8_WAIT_L
#undef PG8_BAR
#undef PG8_SCHED
}
}
namespace att {
constexpr int D = 128, PITCH = 2048, NW = 8, QBLK = 32, KVBLK = 64, QB = NW * QBLK;
constexpr int SHM_V = KVBLK * D * 2, SHM_K = KVBLK * D * 2;
constexpr int LDS_BIAS = 2 * SHM_V + 2 * SHM_K + NW * 64 * 4;
constexpr int NQX = 3, LDS_QX = LDS_BIAS + 512;
constexpr int LDS_BYTES = LDS_QX + NW * NQX * 1024;
constexpr float THR2 = 64.f;
constexpr bool WSKIP = false;
typedef __hip_bfloat16 bf16;
typedef short bf16x8 __attribute__((ext_vector_type(8)));
typedef short s16x4 __attribute__((ext_vector_type(4)));
typedef float f32x16 __attribute__((ext_vector_type(16)));
typedef float f32x4 __attribute__((ext_vector_type(4)));
typedef unsigned u32x4 __attribute__((ext_vector_type(4)));
template <class A, class Bt> struct same_t { static constexpr bool v = false; };
template <class A> struct same_t<A, A> { static constexpr bool v = true; };

#define KSWZ(row, colB) ((row) * 256 + ((colB) ^ (((row) & 7) << 4)))
#define SBAR() __builtin_amdgcn_sched_barrier(0)
__device__ __forceinline__ int v_st(int k, int c) { const int kk = (k & ~0xC) | ((k & 4) << 1) | ((k & 8) >> 1); return ((kk >> 3) * 4 + (c >> 5)) * 512 + ((kk & 7) * 32 + (c & 31)) * 2; }
__device__ __forceinline__ int v_rd_base(int lane) { return ((lane & 3) << 3) | (((lane >> 2) & 3) << 6) | (((lane >> 4) & 1) << 5) | (((lane >> 5) & 1) << 8); }
constexpr int v_rd_off(int d0, int ks, int half) { return d0 * 512 + ks * 4096 + half * 2048; }
__device__ __forceinline__ int crow(int r, int hi) { return (r & 3) + 8 * (r >> 2) + 4 * hi; }
__device__ __forceinline__ unsigned cvtpk(float lo, float hi) {
    unsigned r; asm volatile("v_cvt_pk_bf16_f32 %0, %1, %2" : "=v"(r) : "v"(lo), "v"(hi)); return r;
}
__device__ __forceinline__ bf16x8 pack8(f32x4 a, f32x4 b) {
    u32x4 w = {cvtpk(a[0], a[1]), cvtpk(a[2], a[3]), cvtpk(b[0], b[1]), cvtpk(b[2], b[3])};
    return *reinterpret_cast<bf16x8*>(&w);
}
template <class T> __device__ __forceinline__ bf16x8 load8(const T* p) {
    if constexpr (same_t<T, float>::v) { return pack8(*(const f32x4*)p, *(const f32x4*)(p + 4)); }
    else { return *reinterpret_cast<const bf16x8*>(p); }
}
__device__ __forceinline__ void mask_tile(f32x16& p0, f32x16& p1, int dq, unsigned W) {
    const float NEG = -__builtin_inff();
#pragma unroll
    for (int r = 0; r < 16; ++r) {
        const int c = (r & 3) + 8 * (r >> 2);
        if (dq - c < 0) p0[r] = NEG;
        if (dq - c - 32 < 0) p1[r] = NEG;
    }
}
__device__ __forceinline__ void partialSM(f32x16& p0, f32x16& p1, float& m_reg, float& mn, float& alpha) {
    float pmax = p0[0]; for (int r = 1; r < 16; ++r) pmax = fmaxf(pmax, p0[r]); for (int r = 0; r < 16; ++r) pmax = fmaxf(pmax, p1[r]);
    { auto rr = __builtin_amdgcn_permlane32_swap(__float_as_uint(pmax), __float_as_uint(pmax), false, false);
      pmax = fmaxf(__uint_as_float(rr[0]), __uint_as_float(rr[1])); }
    if (__builtin_expect(__all((pmax - m_reg) <= THR2), 1)) { mn = m_reg; alpha = 1.f; }
    else { mn = fmaxf(m_reg, pmax); alpha = __builtin_amdgcn_exp2f(m_reg - mn); m_reg = mn; }
    for (int r = 0; r < 16; ++r) p0[r] = p0[r] - mn; for (int r = 0; r < 16; ++r) p1[r] = p1[r] - mn;
    for (int r = 0; r < 16; ++r) p0[r] = __builtin_amdgcn_exp2f(p0[r]);
}
__device__ __forceinline__ void finishSM(f32x16& p0, f32x16& p1, float alpha, float& l_reg, bf16x8& pa0, bf16x8& pa1, bf16x8& pa2, bf16x8& pa3) {
    for (int r = 0; r < 16; ++r) p1[r] = __builtin_amdgcn_exp2f(p1[r]);
    float ps = 0; for (int r = 0; r < 16; ++r) ps += p0[r]; for (int r = 0; r < 16; ++r) ps += p1[r];
    { auto rr = __builtin_amdgcn_permlane32_swap(__float_as_uint(ps), __float_as_uint(ps), false, false);
      ps = __uint_as_float(rr[0]) + __uint_as_float(rr[1]); }
    l_reg = l_reg * alpha + ps;
#define PK4(P, B_, OUT) do { unsigned a0 = cvtpk(P[B_+0], P[B_+1]), a1 = cvtpk(P[B_+2], P[B_+3]);                          \
        unsigned b0 = cvtpk(P[B_+4], P[B_+5]), b1 = cvtpk(P[B_+6], P[B_+7]);                                             \
        auto r0 = __builtin_amdgcn_permlane32_swap(a0, b0, false, false); auto r1 = __builtin_amdgcn_permlane32_swap(a1, b1, false, false); \
        u32x4 w = {r0[0], r1[0], r0[1], r1[1]}; OUT = *reinterpret_cast<bf16x8*>(&w); } while (0)
    PK4(p0, 0, pa0); PK4(p0, 8, pa1); PK4(p1, 0, pa2); PK4(p1, 8, pa3);
#undef PK4
}
template <int KB, bool SK>
__device__ __forceinline__ void qkt(f32x16& p0, f32x16& p1, const char* K_lds, int r32, int hi, const bf16x8* qr, bool act, const char* qx) {
    if (SK && !act) { const float NEG = -__builtin_inff();
#pragma unroll
        for (int r = 0; r < 16; ++r) { p0[r] = NEG; p1[r] = NEG; } return; }
    { const float* bl = (const float*)(K_lds - 2 * SHM_V + LDS_BIAS) + KB * 64 + 4 * hi;
#pragma unroll
      for (int g = 0; g < 4; ++g) { const f32x4 u0 = *(const f32x4*)(bl + 8 * g), u1 = *(const f32x4*)(bl + 32 + 8 * g);
        p0[4*g] = u0[0]; p0[4*g+1] = u0[1]; p0[4*g+2] = u0[2]; p0[4*g+3] = u0[3]; p1[4*g] = u1[0]; p1[4*g+1] = u1[1]; p1[4*g+2] = u1[2]; p1[4*g+3] = u1[3]; } }
    const char* kb[4];
#pragma unroll
    for (int dd = 0; dd < 4; ++dd) kb[dd] = K_lds + KB * SHM_K + KSWZ(r32, (dd * 16 + hi * 8) * 2);
#pragma unroll
    for (int d0 = 0; d0 < 8; ++d0) { const char* a = kb[d0 & 3] + (d0 >> 2) * 128;
        bf16x8 b0 = *reinterpret_cast<const bf16x8*>(a);
        bf16x8 b1 = *reinterpret_cast<const bf16x8*>(a + 32 * 256);
        const bf16x8 qv = (d0 < 8 - NQX) ? qr[d0] : *reinterpret_cast<const bf16x8*>(qx + (d0 - (8 - NQX)) * 1024);
        p0 = __builtin_amdgcn_mfma_f32_32x32x16_bf16(b0, qv, p0, 0, 0, 0);
        p1 = __builtin_amdgcn_mfma_f32_32x32x16_bf16(b1, qv, p1, 0, 0, 0); }
}
template <int VB, bool SK>
__device__ __forceinline__ void pv_tile(f32x16* o, int vb0, bf16x8 pa0, bf16x8 pa1, bf16x8 pa2, bf16x8 pa3, bool act) {
    if (SK && !act) return;
#define TRRD(dst, off) asm volatile("ds_read_b64_tr_b16 %0, %1 offset:%2" : "=&v"(dst) : "v"(vb0), "i"(off) : "memory")
#define PV_D0(d0) do { s16x4 l0, l1, l2, l3, h0, h1, h2, h3; constexpr int b_ = VB * SHM_V + v_rd_off(d0, 0, 0);     \
        TRRD(l0, b_); TRRD(h0, b_ + 2048); TRRD(l1, b_ + 4096); TRRD(h1, b_ + 6144); TRRD(l2, b_ + 8192); TRRD(h2, b_ + 10240); TRRD(l3, b_ + 12288); TRRD(h3, b_ + 14336); \
        asm volatile("s_waitcnt lgkmcnt(0)" ::: "memory"); SBAR();                 \
        o[d0] = __builtin_amdgcn_mfma_f32_32x32x16_bf16(pa0, (bf16x8){l0[0], l0[1], l0[2], l0[3], h0[0], h0[1], h0[2], h0[3]}, o[d0], 0, 0, 0);   \
        o[d0] = __builtin_amdgcn_mfma_f32_32x32x16_bf16(pa1, (bf16x8){l1[0], l1[1], l1[2], l1[3], h1[0], h1[1], h1[2], h1[3]}, o[d0], 0, 0, 0);   \
        o[d0] = __builtin_amdgcn_mfma_f32_32x32x16_bf16(pa2, (bf16x8){l2[0], l2[1], l2[2], l2[3], h2[0], h2[1], h2[2], h2[3]}, o[d0], 0, 0, 0);   \
        o[d0] = __builtin_amdgcn_mfma_f32_32x32x16_bf16(pa3, (bf16x8){l3[0], l3[1], l3[2], l3[3], h3[0], h3[1], h3[2], h3[3]}, o[d0], 0, 0, 0); } while (0)
    PV_D0(0); PV_D0(1); PV_D0(2); PV_D0(3);
#undef PV_D0
#undef TRRD
}

template <class TIn, class TOut> struct BlockRef { const TIn* Q; const TIn* K; const TIn* V; TOut* O; const float* Bs; int P0; int nvalid; };
template <class TIn> struct Seam {
    bf16x8 qr[8];
    bf16x8 st_v0, st_v1, st_k0, st_k1; f32x4 sf0, sf1, sf2, sf3;
    f32x4 tq[16];
};
__device__ __forceinline__ int swa_jlo(int P0, int W) { const int lowk = P0 - W + 1; return lowk > 0 ? lowk / KVBLK : 0; }
#define ROW(p, k0, rr) ((p) + (size_t)((k0) + (rr)) * PITCH + sc)
#define VMW() asm volatile("s_waitcnt vmcnt(0)" ::: "memory")
#define VMWN(n) asm volatile("s_waitcnt vmcnt(%0)" :: "i"(n) : "memory")
#define GLDS(gp_, lp_, sz_) __builtin_amdgcn_global_load_lds((const unsigned*)(gp_), (__attribute__((address_space(3))) unsigned*)(lp_), sz_, 0, 0)
#define SLOAD_H(Kp, Vp, Bp, k0, bb_) do { S.st_v0 = load8<TIn>(ROW(Vp, k0, sr)); S.st_v1 = load8<TIn>(ROW(Vp, k0, 32 + sr));              \
                         { const TIn* kg_ = (Kp) + (size_t)(k0) * PITCH; char* kl_ = K_lds + (bb_) * SHM_K + wid * 2048; GLDS(kg_ + ksrc0, kl_, 16); GLDS(kg_ + ksrc1, kl_ + 1024, 16); } \
                         if (wid == 0) GLDS((Bp) + (k0) + lane, lds + LDS_BIAS + (bb_) * 256, 4); } while (0)
#define SWRITE_HK(bf) do { } while (0)
#define SWRITE_HV(bf) do { *(bf16x8*)(V_lds + (bf) * SHM_V + vst0) = S.st_v0; *(bf16x8*)(V_lds + (bf) * SHM_V + vst1) = S.st_v1; } while (0)
#define SWRITE_H(bf) do { SWRITE_HV(bf); SWRITE_HK(bf); } while (0)
#define SLOAD_F(p, k0) do { S.sf0 = *(const f32x4*)ROW(p, k0, sr); S.sf1 = *(const f32x4*)(ROW(p, k0, sr) + 4);                \
                            S.sf2 = *(const f32x4*)ROW(p, k0, 32 + sr); S.sf3 = *(const f32x4*)(ROW(p, k0, 32 + sr) + 4); } while (0)
#define SWRITE_KF(bf) do { *(bf16x8*)(K_lds + (bf) * SHM_K + kws) = pack8(S.sf0, S.sf1); *(bf16x8*)(K_lds + (bf) * SHM_K + kws + 32 * 256) = pack8(S.sf2, S.sf3); } while (0)
#define SWRITE_VF(bf) do { *(bf16x8*)(V_lds + (bf) * SHM_V + vst0) = pack8(S.sf0, S.sf1); *(bf16x8*)(V_lds + (bf) * SHM_V + vst1) = pack8(S.sf2, S.sf3); } while (0)
template <class TIn, class TOut>
__device__ __forceinline__ void causal_swa_prime(const BlockRef<TIn, TOut>& cur, int W, char* lds, Seam<TIn>& S, const int tid) {
    constexpr bool F32 = same_t<TIn, float>::v;
    const int wid = __builtin_amdgcn_readfirstlane(tid >> 6), lane = tid & 63, r32 = lane & 31, hi = lane >> 5;
    const int sr = tid >> 4, sc = (tid & 15) * 8, kws = KSWZ(sr, sc * 2); char* K_lds = lds + 2 * SHM_V; (void)kws;
    const int ksrc0 = (8 * wid + (lane >> 4)) * PITCH + ((lane & 15) ^ (lane >> 4)) * 8, ksrc1 = (8 * wid + 4 + (lane >> 4)) * PITCH + ((lane & 15) ^ (4 + (lane >> 4))) * 8;
    const int kb0 = swa_jlo(cur.P0, W) * KVBLK;
    for (int d0 = 0; d0 < 8; ++d0) S.qr[d0] = load8<TIn>(cur.Q + (size_t)(wid * QBLK + r32) * PITCH + d0 * 16 + hi * 8);
    if constexpr (F32) { SLOAD_F((const float*)cur.K, kb0); VMW(); SWRITE_KF(0); SBAR(); SLOAD_F((const float*)cur.V, kb0); }
    else { SLOAD_H(cur.K, cur.V, cur.Bs, kb0, 0); VMW(); SWRITE_HK(0); }
    __syncthreads();
}
template <class TIn, class TOut>
__device__ __forceinline__ void causal_swa_block(const BlockRef<TIn, TOut>& cur, const BlockRef<TIn, TOut>& nxt, int skv, int W, char* lds, Seam<TIn>& S, const int tid) {
    constexpr bool F32 = same_t<TIn, float>::v;
    const int wid = __builtin_amdgcn_readfirstlane(tid >> 6), lane = tid & 63, r32 = lane & 31, hi = lane >> 5;
    const int j_lo = swa_jlo(cur.P0, W);
    int j_hi = (cur.P0 + QB - 1) / KVBLK + 1; if (j_hi > skv / KVBLK) j_hi = skv / KVBLK;
    const int NT = j_hi - j_lo;
    const int kbn = swa_jlo(nxt.P0, W) * KVBLK;
    const int qlo = cur.P0 + wid * QBLK, qm = qlo + r32 - 4 * hi;
    char* V_lds = lds; char* K_lds = lds + 2 * SHM_V;
    float* ws = (float*)(lds + 2 * SHM_V + 2 * SHM_K) + wid * 64; float* li_l = ws, * al_l = ws + 32;
    float m_reg = -1e30f, l_reg = 0; f32x16 o[4] = {};
    const int sr = tid >> 4, sc = (tid & 15) * 8, vst0 = v_st(sr, sc), vst1 = v_st(32 + sr, sc), kws = KSWZ(sr, sc * 2);
    const int vb0 = (int)(uintptr_t)V_lds + v_rd_base(lane); (void)kws;
    const int ksrc0 = (8 * wid + (lane >> 4)) * PITCH + ((lane & 15) ^ (lane >> 4)) * 8, ksrc1 = (8 * wid + 4 + (lane >> 4)) * PITCH + ((lane & 15) ^ (4 + (lane >> 4))) * 8;
    const TIn* Kh = cur.K; const TIn* Vh = cur.V; const float* Bh = cur.Bs;
#define RESC(a) do { if (__any((a) < 1.f)) { if (hi == 0) al_l[r32] = (a); asm volatile("s_waitcnt lgkmcnt(0)" ::: "memory");              \
                     for (int d_ = 0; d_ < 4; ++d_) for (int r = 0; r < 16; ++r) o[d_][r] *= al_l[crow(r, hi)]; } } while (0)
#define KBASE(t) ((j_lo + (t)) * KVBLK)
#define ACT(t) (KBASE(t) <= qlo + QBLK - 1 && KBASE(t) + KVBLK - 1 >= qlo - W + 1)
#define MASKT(P0_, P1_, t) do { const int kb_ = KBASE(t); if ((!SK || ACT(t)) && (kb_ + KVBLK - 1 > qlo || kb_ <= qlo + QBLK - 1 - W)) mask_tile(P0_, P1_, qm - kb_, (unsigned)W); } while (0)
    constexpr int NQL = F32 ? 16 : 8;
    constexpr bool SK = WSKIP && !F32;
#define SEAM_K0() do { VMWN(NQL); if constexpr (F32) { SWRITE_KF(0); SBAR(); SLOAD_F((const float*)nxt.V, kbn); } else { SWRITE_HK(0); } SBAR(); } while (0)
    f32x16 pA0, pA1, pB0, pB1; float mnA, mnB, alA, alB; bf16x8 pa0, pa1, pa2, pa3;
    char* qx = lds + LDS_QX + wid * (NQX * 1024) + lane * 16;
#pragma unroll
    for (int e = 0; e < NQX; ++e) *reinterpret_cast<bf16x8*>(qx + e * 1024) = S.qr[8 - NQX + e];
    if constexpr (F32) { VMW(); SWRITE_VF(0); SBAR(); } else { SWRITE_HV(0); SBAR(); }
    if (NT > 1) { if constexpr (F32) SLOAD_F((const float*)Kh, KBASE(1)); else SLOAD_H(Kh, Vh, Bh, KBASE(1), 1); }
    SBAR(); qkt<0, SK>(pA0, pA1, K_lds, r32, hi, S.qr, ACT(0), qx);
    if constexpr (F32) { if (NT > 1) { VMW(); SWRITE_KF(1); SBAR(); SLOAD_F((const float*)Vh, KBASE(1)); } }
    MASKT(pA0, pA1, 0); partialSM(pA0, pA1, m_reg, mnA, alA);
    if (NT > 1) { VMW(); if constexpr (F32) { SWRITE_VF(1); SBAR(); if (NT > 2) SLOAD_F((const float*)Kh, KBASE(2)); } else SWRITE_H(1); }
    __syncthreads();
#define HALF_STEP(PX0, PX1, mnX, alX, PY0, PY1, alY, t, KB, VB, SB) do {                                                      \
        SBAR(); qkt<KB, SK>(PX0, PX1, K_lds, r32, hi, S.qr, ACT(t), qx);                                             \
        finishSM(PY0, PY1, alY, l_reg, pa0, pa1, pa2, pa3); SBAR();                                                           \
        if ((t) + 1 < NT) { if constexpr (F32) { VMW(); SWRITE_KF(SB); SBAR(); SLOAD_F((const float*)Vh, KBASE((t) + 1)); }  \
                            else { SLOAD_H(Kh, Vh, Bh, KBASE((t) + 1), SB); } SBAR(); }                                               \
        pv_tile<VB, SK>(o, vb0, pa0, pa1, pa2, pa3, ACT((t) - 1)); MASKT(PX0, PX1, (t)); partialSM(PX0, PX1, m_reg, mnX, alX);                                        \
        __syncthreads();                                                                                                      \
        if ((t) + 1 < NT) { VMW(); if constexpr (F32) { SWRITE_VF(SB); SBAR(); if ((t) + 2 < NT) SLOAD_F((const float*)Kh, KBASE((t) + 2)); } \
                            else { SWRITE_H(SB); } }                                                                          \
        RESC(alX); __syncthreads(); } while (0)
    for (int t = 1; t + 1 < NT; t += 2) {
        HALF_STEP(pB0, pB1, mnB, alB, pA0, pA1, alA, t, 1, 0, 0);
        HALF_STEP(pA0, pA1, mnA, alA, pB0, pB1, alB, t + 1, 0, 1, 1);
    }
    const bool even = (NT & 1) == 0;
    if (even) { SBAR(); qkt<1, SK>(pB0, pB1, K_lds, r32, hi, S.qr, ACT(NT - 1), qx); SBAR(); }
#define QROW(e) (nxt.Q + (size_t)(wid * QBLK + r32) * PITCH + ((e) >> 1) * 16 + hi * 8 + ((e) & 1) * 4)
    if constexpr (F32) { SLOAD_F((const float*)nxt.K, kbn); SBAR();
#pragma unroll
        for (int e = 0; e < 8; ++e) S.tq[e] = *(const f32x4*)QROW(e); }
    else { SLOAD_H(nxt.K, nxt.V, nxt.Bs, kbn, 0); SBAR();
#pragma unroll
        for (int d0 = 0; d0 < 8; ++d0) S.qr[d0] = load8<TIn>(nxt.Q + (size_t)(wid * QBLK + r32) * PITCH + d0 * 16 + hi * 8); }
    SBAR();
    finishSM(pA0, pA1, alA, l_reg, pa0, pa1, pa2, pa3); SBAR();
    if constexpr (F32) {
#pragma unroll
        for (int e = 8; e < 16; ++e) S.tq[e] = *(const f32x4*)QROW(e); SBAR(); }
#undef QROW
    pv_tile<0, SK>(o, vb0, pa0, pa1, pa2, pa3, ACT(even ? NT - 2 : NT - 1));
    if (even) { MASKT(pB0, pB1, NT - 1); partialSM(pB0, pB1, m_reg, mnB, alB); __syncthreads(); RESC(alB);
        finishSM(pB0, pB1, alB, l_reg, pa0, pa1, pa2, pa3); SBAR(); pv_tile<1, SK>(o, vb0, pa0, pa1, pa2, pa3, ACT(NT - 1)); }
    SBAR(); SEAM_K0();
    if (hi == 0) li_l[r32] = l_reg; asm volatile("s_waitcnt lgkmcnt(0)" ::: "memory");
    float rli[16];
#pragma unroll
    for (int r = 0; r < 16; ++r) rli[r] = __builtin_amdgcn_rcpf(li_l[crow(r, hi)]);
    int tidE = tid; asm volatile("" : "+v"(tidE));
    const int widE = __builtin_amdgcn_readfirstlane(tidE >> 6), r32E = tidE & 31, hiE = (tidE >> 5) & 1;
    TOut* Ow = cur.O + (size_t)(widE * QBLK) * PITCH; const bool wval = widE * QBLK < cur.nvalid;
    if (wval) {
#pragma unroll
    for (int r = 0; r < 16; ++r) { const int orow = crow(r, hiE);
#pragma unroll
        for (int d0 = 0; d0 < 4; ++d0) { const float v = o[d0][r] * rli[r];
            if constexpr (same_t<TOut, float>::v) { Ow[(size_t)orow * PITCH + d0 * 32 + r32E] = v; }
            else { const float vn = __shfl_xor(v, 1);
                   if ((r32E & 1) == 0) *(unsigned*)(Ow + (size_t)orow * PITCH + d0 * 32 + r32E) = cvtpk(v, vn); } } } }
    if constexpr (F32) {
#pragma unroll
        for (int d0 = 0; d0 < 8; ++d0) S.qr[d0] = pack8(S.tq[2 * d0], S.tq[2 * d0 + 1]); }
    __syncthreads();
#undef RESC
#undef KBASE
#undef ACT
#undef MASKT
#undef SEAM_K0
#undef HALF_STEP
}
#undef ROW
#undef VMW
#undef VMWN
#undef SLOAD_H
#undef GLDS
#undef SWRITE_HK
#undef SWRITE_HV
#undef SWRITE_H
#undef SLOAD_F
#undef SWRITE_KF
#undef SWRITE_VF

}
typedef unsigned short u16;
typedef float f32x4 __attribute__((ext_vector_type(4)));
typedef unsigned u32x4 __attribute__((ext_vector_type(4)));
typedef unsigned u32x2 __attribute__((ext_vector_type(2)));
typedef short bf16x8 __attribute__((ext_vector_type(8)));
constexpr int DM = 2048, TP = 8192, NBP = 4, NBS = 8, TS = 64, PAST = 2048, SKVS = PAST + TS;
constexpr int MP = NBP * TP, MS_ = NBS * TS, M = MP + MS_;
constexpr int DI = 4096, CD = 6144, NH = 64, DFF = 5504, DFF2 = 11008, NIN = 20560;
constexpr int NMOD = 12288;
constexpr float EPS = 1e-6f, LOG2E = 1.4426950408889634f;
constexpr int HALF_ROWS = 16640;
constexpr size_t O_YP = 0, O_YS = O_YP + (size_t)MP * DM, O_KP = O_YS + (size_t)MS_ * DM, O_VP = O_KP + (size_t)MP * DM,
    O_LFP = O_VP + (size_t)MP * DM, O_SSMP = O_LFP + (size_t)MP * 16, O_MCP = O_SSMP + (size_t)NBP * 64 * 64 * 128, O_FCP = O_MCP + (size_t)NBP * 3 * CD,
    O_KS = O_FCP + (size_t)NBP * 2 * DFF2, O_VS = O_KS + (size_t)MS_ * DM, O_LFS = O_VS + (size_t)MS_ * DM, O_SSMS = O_LFS + (size_t)MS_ * 16,
    O_MCS = O_SSMS + (size_t)NBS * 64 * 64 * 128, O_FCS = O_MCS + (size_t)NBS * 3 * CD, O_END = O_FCS + (size_t)NBS * 2 * DFF2;
constexpr size_t MiB = 1u << 20;
constexpr size_t W_MOD = 0, W_BIASP = 1 * MiB, W_BIASS = 3 * MiB, W_HALO = 5 * MiB,
    W_WUP = 8 * MiB, W_WDN = 51 * MiB, W_H = 73 * MiB, W_WIN = 203 * MiB, W_WPM = 284 * MiB, W_WPF = 300 * MiB, W_WOUT = 308 * MiB,
    W_SMALL = 316 * MiB, W_R = 349 * MiB,
    W_XBC = W_R, W_Z = W_R + 390 * MiB, W_GM = W_R, W_GF = W_R + 130 * MiB, W_Q = W_R + 260 * MiB, W_K = W_Q + 130 * MiB, W_V = W_K + 130 * MiB,
    W_U = 203 * MiB, W_G = 553 * MiB, W_END = 999 * MiB;
static_assert((size_t)M * DM * 2 == 130 * MiB && (size_t)M * CD * 2 == 390 * MiB && (size_t)M * DI * 2 == 260 * MiB, "sizes");
static_assert(W_U + (size_t)HALF_ROWS * DFF2 * 2 <= W_G && W_G + (size_t)M * DFF * 2 <= 1024 * MiB, "ffn map");
static_assert(W_SMALL + (size_t)M * 256 * 4 <= W_R, "small map");

struct Prm { const float* in[31]; float* out; unsigned char* ws; };
typedef const __attribute__((address_space(4))) Prm* KPrm;
struct Ctx { int tid, bid, G; };
enum { I_XP = 0, I_XS, I_CP, I_CS, I_CK, I_CV, I_CLF, I_SSM, I_MCV, I_FCV, I_N1W, I_N2W, I_WADA, I_BADA, I_WIN, I_MCW, I_MCB, I_DTB, I_ALOG, I_MD, I_MNW,
       I_FB, I_QNW, I_KNW, I_WPM, I_WPF, I_WOUT, I_WUP, I_FCW, I_FCB, I_WDN };

__device__ __forceinline__ float bflo(unsigned w) { return __uint_as_float(w << 16); }
__device__ __forceinline__ float bfhi(unsigned w) { return __uint_as_float(w & 0xffff0000u); }
__device__ __forceinline__ unsigned pk2(float lo, float hi) { return pg8::cvt_pk_bf16(lo, hi); }
__device__ __forceinline__ u16 f2bf(float f) { return (u16)(pk2(f, 0.f) & 0xffffu); }
__device__ __forceinline__ void unpack8(u32x4 w, float* v) { v[0] = bflo(w.x); v[1] = bfhi(w.x); v[2] = bflo(w.y); v[3] = bfhi(w.y); v[4] = bflo(w.z); v[5] = bfhi(w.z); v[6] = bflo(w.w); v[7] = bfhi(w.w); }
__device__ __forceinline__ u32x4 pack8f(const float* v) { u32x4 w; w.x = pk2(v[0], v[1]); w.y = pk2(v[2], v[3]); w.z = pk2(v[4], v[5]); w.w = pk2(v[6], v[7]); return w; }
__device__ __forceinline__ float bfel(const u32x4& w, int e) { const unsigned x = w[e >> 1]; return (e & 1) ? bfhi(x) : bflo(x); }
__device__ __forceinline__ float sigmoidf_(float x) { return 1.f / (1.f + __expf(-x)); }
__device__ __forceinline__ float siluf_(float x) { return x / (1.f + __expf(-x)); }
__device__ __forceinline__ float wave_sum(float v) {
#pragma unroll
    for (int o = 1; o < 64; o <<= 1) v += __shfl_xor(v, o);
    return v;
}
__device__ __forceinline__ int mod_row(int row) { return row < MP ? (row >> 13) : 4 + ((row - MP) >> 6); }

struct Epi {
    static constexpr bool PERM = true, AFTER_DRAIN = false;
    int mode;
    u16* d0; u16* d1; u16* d2; int t1, t2, p0, p1, p2, f32seg2;
    const float* xp; const float* xs; float* y; const float* mod; u16* gbuf; const u16* gf;
    __device__ __forceinline__ void operator()(const f32x4 (&acc)[2][2][4][2], const pg8::Unit& u, int wr, int wc, int fr, int fq) const {
        const int rl = u.pm * 256 + wr * 64 + fr, cl = wc * 32 + 8 * fq;
        if (mode == 0) {
            u16* base; int pitch, ct; bool f32o = false;
            if (u.pn < t1) { base = d0; pitch = p0; ct = u.pn; } else if (u.pn < t2) { base = d1; pitch = p1; ct = u.pn - t1; } else { base = d2; pitch = p2; ct = u.pn - t2; f32o = (f32seg2 != 0); }
            if (!f32o) {
#pragma unroll
                for (int ai = 0; ai < 2; ++ai)
#pragma unroll
                    for (int m = 0; m < 4; ++m) { u16* rp = base + (size_t)(rl + ai * 128 + m * 16) * pitch + ct * 256 + cl;
#pragma unroll
                        for (int bj = 0; bj < 2; ++bj) { const f32x4 v0 = acc[ai][bj][m][0], v1 = acc[ai][bj][m][1]; u32x4 w; w.x = pk2(v0[0], v0[1]); w.y = pk2(v0[2], v0[3]); w.z = pk2(v1[0], v1[1]); w.w = pk2(v1[2], v1[3]);
                            *(u32x4*)(rp + bj * 128) = w; } }
            } else {
                float* fb = (float*)base;
#pragma unroll
                for (int ai = 0; ai < 2; ++ai)
#pragma unroll
                    for (int m = 0; m < 4; ++m) { float* rp = fb + (size_t)(rl + ai * 128 + m * 16) * pitch + ct * 256 + cl;
#pragma unroll
                        for (int bj = 0; bj < 2; ++bj) { *(f32x4*)(rp + bj * 128) = acc[ai][bj][m][0]; *(f32x4*)(rp + bj * 128 + 4) = acc[ai][bj][m][1]; } }
            }
        } else if (mode == 1 || mode == 2) {
#pragma unroll
            for (int ai = 0; ai < 2; ++ai)
#pragma unroll
                for (int m = 0; m < 4; ++m) { const size_t off = (size_t)(rl + ai * 128 + m * 16) * DM + u.pn * 256 + cl;
#pragma unroll
                    for (int bj = 0; bj < 2; ++bj) { const f32x4 v0 = acc[ai][bj][m][0], v1 = acc[ai][bj][m][1];
                        float a[8] = {v0[0], v0[1], v0[2], v0[3], v1[0], v1[1], v1[2], v1[3]}, g[8], o[8];
                        unpack8(*(const u32x4*)(gbuf + off + bj * 128), g);
                        if (mode == 1) {
#pragma unroll
                            for (int e = 0; e < 8; ++e) o[e] = sigmoidf_(g[e]) * a[e];
                        } else { float f[8]; unpack8(*(const u32x4*)(gf + off + bj * 128), f);
#pragma unroll
                            for (int e = 0; e < 8; ++e) o[e] = g[e] + sigmoidf_(f[e]) * a[e]; }
                        *(u32x4*)(gbuf + off + bj * 128) = pack8f(o); } }
        } else {
#pragma unroll
            for (int ai = 0; ai < 2; ++ai) {
                const int mb = (u.pm < 128) ? (u.pm >> 5) : (4 + (u.pm - 128) * 4 + ai * 2 + wr);
                const float* gp = mod + (size_t)mb * NMOD + (mode == 3 ? 4096 : 10240) + u.pn * 256 + cl;
                f32x4 gv[2][2];
#pragma unroll
                for (int bj = 0; bj < 2; ++bj) { gv[bj][0] = *(const f32x4*)(gp + bj * 128); gv[bj][1] = *(const f32x4*)(gp + bj * 128 + 4); }
#pragma unroll
                for (int m = 0; m < 4; ++m) { const int row = rl + ai * 128 + m * 16; const size_t off = (size_t)row * DM + u.pn * 256 + cl;
                    const float* xr = (mode == 3) ? ((row < MP) ? xp + off : xs + (off - (size_t)MP * DM)) : (const float*)(y + off);
#pragma unroll
                    for (int bj = 0; bj < 2; ++bj) { const f32x4 b0 = *(const f32x4*)(xr + bj * 128), b1 = *(const f32x4*)(xr + bj * 128 + 4);
                        *(f32x4*)(y + off + bj * 128) = b0 + gv[bj][0] * acc[ai][bj][m][0]; *(f32x4*)(y + off + bj * 128 + 4) = b1 + gv[bj][1] * acc[ai][bj][m][1]; } }
            }
        }
    }
};

__device__ __forceinline__ int map_in(int n) {
    if (n < 4096) return 6144 + n;
    if (n < 10240) return n - 4096;
    if (n < 10304) return 10240 + (n - 10240);
    if (n < 12352) return 14592 + (n - 10304);
    if (n < 14400) return 16640 + (n - 12352);
    if (n < 16448) return 18688 + (n - 14400);
    if (n < 16464) return 10304 + (n - 16448);
    if (n < 18512) return 10496 + (n - 16464);
    return 12544 + (n - 18512);
}
__device__ __forceinline__ int map_up(int n) { if (n < DFF) return (n >> 7) * 256 + (n & 127); const int f = n - DFF; return (f >> 7) * 256 + 128 + (f & 127); }
template <int MAP> __device__ __forceinline__ void tr_item(const float* __restrict__ W, int K, int N, u16* WT, float* scr, int item, int lane) {
    const int nblk = (N + 31) / 32, kb = item / nblk, nb = item % nblk, k0 = 64 * kb, n0 = 32 * nb;
    const int nn = n0 + (lane & 31);
#pragma unroll 8
    for (int i = 0; i < 32; ++i) { const int kk = 2 * i + (lane >> 5); scr[kk * 33 + (lane & 31)] = (nn < N) ? W[(size_t)(k0 + kk) * N + nn] : 0.f; }
    asm volatile("s_waitcnt lgkmcnt(0)" ::: "memory");
    const int c = lane & 7;
#pragma unroll
    for (int j = 0; j < 4; ++j) { const int n = (lane >> 3) + 8 * j; const float* s = scr + (8 * c) * 33 + n;
        if (n0 + n < N) { const int row = (MAP == 1) ? map_in(n0 + n) : (MAP == 2) ? map_up(n0 + n) : (n0 + n);
            u32x4 o; o.x = pk2(s[0 * 33], s[1 * 33]); o.y = pk2(s[2 * 33], s[3 * 33]); o.z = pk2(s[4 * 33], s[5 * 33]); o.w = pk2(s[6 * 33], s[7 * 33]);
            *(u32x4*)(WT + (size_t)row * K + k0 + 8 * c) = o; } }
    asm volatile("s_waitcnt lgkmcnt(0)" ::: "memory");
}
__device__ __forceinline__ void phase_prep(KPrm p, const Ctx cx, unsigned char* lds) {
    const int tid = cx.tid, lane = tid & 63, wid = tid >> 6, G = cx.G;
    unsigned char* ws = p->ws;
    {
        float* scr = (float*)(lds + wid * 8448);
        const int gw = cx.bid * 8 + wid, NGW = G * 8;
        constexpr int I_IN = 32 * 643, I_PM = 64 * 64, I_PF = 32 * 64, I_OUT = 32 * 64, I_UP = 32 * 344, I_DN = 86 * 64;
        constexpr int NIT = I_IN + I_PM + I_PF + I_OUT + I_UP + I_DN;
        for (int it = gw; it < NIT; it += NGW) {
            int r = it;
            if (r < I_IN) { tr_item<1>(p->in[I_WIN], DM, NIN, (u16*)(ws + W_WIN), scr, r, lane); continue; } r -= I_IN;
            if (r < I_PM) { tr_item<0>(p->in[I_WPM], DI, DM, (u16*)(ws + W_WPM), scr, r, lane); continue; } r -= I_PM;
            if (r < I_PF) { tr_item<0>(p->in[I_WPF], DM, DM, (u16*)(ws + W_WPF), scr, r, lane); continue; } r -= I_PF;
            if (r < I_OUT) { tr_item<0>(p->in[I_WOUT], DM, DM, (u16*)(ws + W_WOUT), scr, r, lane); continue; } r -= I_OUT;
            if (r < I_UP) { tr_item<2>(p->in[I_WUP], DM, DFF2, (u16*)(ws + W_WUP), scr, r, lane); continue; } r -= I_UP;
            tr_item<0>(p->in[I_WDN], DFF, DM, (u16*)(ws + W_WDN), scr, r, lane);
        }
    }
    __syncthreads();
    {
        float* sl = (float*)lds;
        float* red = (float*)(lds + 12 * 2048 * 4);
        for (int e = tid; e < 12 * 2048; e += 512) { const int b = e >> 11, i = e & 2047; const float cv = (b < 4) ? p->in[I_CP][b * 2048 + i] : p->in[I_CS][(b - 4) * 2048 + i]; sl[e] = siluf_(cv); }
        __syncthreads();
        const float* wada = p->in[I_WADA]; float* mod = (float*)(ws + W_MOD);
        const int col = tid & 31, part = tid >> 5;
        for (int item = cx.bid; item < NMOD / 32; item += G) {
            float acc[12];
#pragma unroll
            for (int b = 0; b < 12; ++b) acc[b] = 0.f;
            const float* wp = wada + (size_t)(part * 128) * NMOD + item * 32 + col;
#pragma unroll 4
            for (int d = 0; d < 128; ++d) { const float w = wp[(size_t)d * NMOD];
#pragma unroll
                for (int b = 0; b < 12; ++b) acc[b] += sl[b * 2048 + part * 128 + d] * w; }
#pragma unroll
            for (int b = 0; b < 12; ++b) red[(part * 12 + b) * 32 + col] = acc[b];
            __syncthreads();
            if (tid < 384) { const int b = tid >> 5; float s = p->in[I_BADA][item * 32 + col];
#pragma unroll
                for (int q = 0; q < 16; ++q) s += red[(q * 12 + b) * 32 + col];
                mod[b * NMOD + item * 32 + col] = s; }
            __syncthreads();
        }
    }
    {
        u16* Ks = (u16*)p->out; u16* Vs = Ks + (size_t)NBS * SKVS * DM;
        const size_t tot8 = (size_t)NBS * PAST * DM / 8, gt = (size_t)cx.bid * 512 + tid, GT = (size_t)G * 512;
        for (size_t i = gt; i < 2 * tot8; i += GT) { const int which = i >= tot8; const size_t j = i - (which ? tot8 : 0);
            const size_t sb = j / ((size_t)PAST * 256), rem = j % ((size_t)PAST * 256), row = rem >> 8, c8 = rem & 255;
            const float* src = p->in[which ? I_CV : I_CK] + ((sb * PAST + row) * DM + c8 * 8);
            const f32x4 a = *(const f32x4*)src, b = *(const f32x4*)(src + 4);
            u32x4 o; o.x = pk2(a[0], a[1]); o.y = pk2(a[2], a[3]); o.z = pk2(b[0], b[1]); o.w = pk2(b[2], b[3]);
            *(u32x4*)((which ? Vs : Ks) + ((sb * SKVS + row) * DM + c8 * 8)) = o; }
    }
}
__device__ __forceinline__ void phase_norm(KPrm p, const Ctx cx, int which) {
    const int tid = cx.tid, lane = tid & 63, wid = tid >> 6;
    const int gw = cx.bid * 8 + wid, NGW = cx.G * 8;
    const float* mod = (const float*)(p->ws + W_MOD); u16* H = (u16*)(p->ws + W_H);
    const float* nw = p->in[which ? I_N2W : I_N1W];
    const int osh = which ? 6144 : 0, osc = which ? 8192 : 2048;
    for (int row = gw; row < M; row += NGW) {
        const float* xr = which ? (p->out + (size_t)row * DM) : ((row < MP) ? p->in[I_XP] + (size_t)row * DM : p->in[I_XS] + (size_t)(row - MP) * DM);
        const float* mr = mod + (size_t)mod_row(row) * NMOD;
        f32x4 v[8]; float ss = 0.f;
#pragma unroll
        for (int j = 0; j < 8; ++j) { v[j] = ((const f32x4*)xr)[lane + 64 * j]; ss += (v[j][0] * v[j][0] + v[j][1] * v[j][1]) + (v[j][2] * v[j][2] + v[j][3] * v[j][3]); }
        const float rs = rsqrtf(wave_sum(ss) * (1.f / DM) + EPS);
#pragma unroll
        for (int j = 0; j < 8; ++j) { const int col = 4 * (lane + 64 * j);
            const f32x4 w = *(const f32x4*)(nw + col), sc = *(const f32x4*)(mr + osc + col), sh = *(const f32x4*)(mr + osh + col);
            const f32x4 o = v[j] * rs * w * (sc + 1.f) + sh;
            u32x2 q; q.x = pk2(o[0], o[1]); q.y = pk2(o[2], o[3]);
            *(u32x2*)(H + (size_t)row * DM + col) = q; }
    }
}
__device__ __forceinline__ void phase_conv(KPrm p, const Ctx cx) {
    const u16* XBC = (const u16*)(p->ws + W_XBC); u16* ACT = (u16*)(p->out + O_KP);
    const float* cw = p->in[I_MCW]; const float* cb = p->in[I_MCB];
    constexpr int NCG = CD / 8, RB = 16, NRB = M / RB;
    const long gt = (long)cx.bid * 512 + cx.tid, GT = (long)cx.G * 512;
    for (long it = gt; it < (long)NCG * NRB; it += GT) {
        const int cgi = (int)(it % NCG), rb = (int)(it / NCG), c0 = cgi * 8, r0 = rb * RB;
        float w[4][8], bs[8];
#pragma unroll
        for (int j = 0; j < 4; ++j) { const f32x4 a0 = *(const f32x4*)(cw + j * CD + c0), a1 = *(const f32x4*)(cw + j * CD + c0 + 4);
#pragma unroll
            for (int e = 0; e < 4; ++e) { w[j][e] = a0[e]; w[j][4 + e] = a1[e]; } }
        { const f32x4 a0 = *(const f32x4*)(cb + c0), a1 = *(const f32x4*)(cb + c0 + 4);
#pragma unroll
          for (int e = 0; e < 4; ++e) { bs[e] = a0[e]; bs[4 + e] = a1[e]; } }
        float h[3][8];
        const bool smp = r0 >= MP; const int tb = smp ? ((r0 - MP) & 63) : (r0 & (TP - 1));
        if (tb == 0) {
            if (smp) { const float* s = p->in[I_MCV] + (size_t)((r0 - MP) >> 6) * 3 * CD + c0;
#pragma unroll
                for (int k = 0; k < 3; ++k)
#pragma unroll
                    for (int e = 0; e < 8; ++e) h[k][e] = s[k * CD + e];
            } else {
#pragma unroll
                for (int k = 0; k < 3; ++k)
#pragma unroll
                    for (int e = 0; e < 8; ++e) h[k][e] = 0.f; }
        } else {
#pragma unroll
            for (int k = 0; k < 3; ++k) unpack8(*(const u32x4*)(XBC + (size_t)(r0 - 3 + k) * CD + c0), h[k]);
        }
#pragma unroll 4
        for (int i = 0; i < RB; ++i) { float u[8], o[8]; unpack8(*(const u32x4*)(XBC + (size_t)(r0 + i) * CD + c0), u);
#pragma unroll
            for (int e = 0; e < 8; ++e) { const float v = bs[e] + w[0][e] * h[0][e] + w[1][e] * h[1][e] + w[2][e] * h[2][e] + w[3][e] * u[e];
                o[e] = siluf_(v); h[0][e] = h[1][e]; h[1][e] = h[2][e]; h[2][e] = u[e]; }
            *(u32x4*)(ACT + (size_t)(r0 + i) * CD + c0) = pack8f(o); }
    }
}
constexpr int SXP = 72, SNP = 136, SYP = 68;
constexpr int L_XT = 0, L_CN = L_XT + 64 * SXP * 2, L_BN = L_CN + 64 * SNP * 2, L_BWT = L_BN + 64 * SNP * 2, L_MS = L_BWT + 128 * SXP * 2, L_HS = L_MS + 64 * SXP * 2,
              L_YS = L_HS + 64 * SNP * 2, L_DT = L_YS + 64 * SYP * 4, L_CUM = L_DT + 256, L_SSD_END = L_CUM + 256;
static_assert(L_SSD_END <= 131072, "ssd lds");
__device__ __forceinline__ void phase_ssd(KPrm p, const Ctx cx, unsigned char* lds) {
    const int tid = cx.tid, lane = tid & 63, wid = tid >> 6, quad = lane >> 4, l15 = lane & 15;
    u16* XT = (u16*)(lds + L_XT); u16* CN = (u16*)(lds + L_CN); u16* BN = (u16*)(lds + L_BN); u16* BWT = (u16*)(lds + L_BWT);
    u16* MSm = (u16*)(lds + L_MS); u16* HS = (u16*)(lds + L_HS); float* YS = (float*)(lds + L_YS); float* DT = (float*)(lds + L_DT); float* CUM = (float*)(lds + L_CUM);
    const u16* XBC = (const u16*)(p->out + O_KP);     u16* Z = (u16*)(p->ws + W_Z); const float* SM = (const float*)(p->ws + W_SMALL);
    const int cg8 = tid & 31, tq = tid >> 5, cgx = tid & 7, tx = tid >> 3;
    const int pb = wid >> 1;
    for (int ch = cx.bid; ch < 256 + 512; ch += cx.G) {
        const bool smp = ch >= 256; int b, hd, nc; long rowbase;
        if (!smp) { b = ch >> 6; hd = ch & 63; nc = TP / 64; rowbase = (long)b * TP; } else { const int su = ch - 256; b = su >> 6; hd = su & 63; nc = 1; rowbase = MP + (long)b * TS; }
        const int g = hd >> 3;
        const float a_h = -__expf(p->in[I_ALOG][hd]), dtb = p->in[I_DTB][hd], Dh = p->in[I_MD][hd];
        const int bccol = (cg8 < 16) ? (4096 + g * 128 + cg8 * 8) : (5120 + g * 128 + (cg8 - 16) * 8);
        const int xcol = hd * 64 + cgx * 8;
        f32x4 st[4];
        const int st_off = (pb * 16 + quad * 4) * 128 + (4 * (wid & 1)) * 16 + l15, hs_off = (pb * 16 + quad * 4) * SNP + (4 * (wid & 1)) * 16 + l15;
        { const float* sin_ = p->in[I_SSM] + ((size_t)b * 64 + hd) * 64 * 128 + st_off;
#pragma unroll
          for (int i = 0; i < 4; ++i)
#pragma unroll
            for (int j = 0; j < 4; ++j) st[i][j] = smp ? sin_[j * 128 + i * 16] : 0.f; }
        __syncthreads();
        { u16* hp_ = HS + hs_off;
#pragma unroll
          for (int i = 0; i < 4; ++i)
#pragma unroll
            for (int j = 0; j < 4; ++j) hp_[j * SNP + i * 16] = f2bf(st[i][j]); }
        u32x4 rbc[4], rx, zn; float dtr = 0.f;
#define SSD_LOADS(cc) do { const int t0_ = (cc) * 64; \
            const u16* pb_ = XBC + (rowbase + t0_ + 4 * tq) * (long)CD + bccol; const u16* px_ = XBC + (rowbase + t0_ + tx) * (long)CD + xcol; \
            asm volatile("" : "+v"(pb_), "+v"(px_));     \
            _Pragma("unroll") for (int i = 0; i < 4; ++i) rbc[i] = *(const u32x4*)(pb_ + i * CD); \
            rx = *(const u32x4*)px_; \
            zn = *(const u32x4*)(Z + (size_t)(rowbase + t0_ + tx) * DI + xcol); \
            if (wid == 0) dtr = SM[(size_t)(rowbase + t0_ + lane) * 256 + hd]; } while (0)
        SSD_LOADS(0);
        for (int c = 0; c < nc; ++c) {
            const long r0 = rowbase + (long)c * 64;
            const u32x4 zw = zn;
            if (wid == 0) {
                const float dr = dtr + dtb; const float dtv = dr > 20.f ? dr : log1pf(__expf(dr));
                float x = dtv * a_h;
#pragma unroll
                for (int o = 1; o < 64; o <<= 1) { const float y = __shfl_up(x, o); if (lane >= o) x += y; }
                DT[lane] = dtv; CUM[lane] = x;
            }
            __syncthreads();
            const float cum_end = CUM[63];
            {
                u16* NAT = (cg8 < 16) ? BN : CN; const int nc0 = (cg8 & 15) * 8;
#pragma unroll
                for (int ii = 0; ii < 4; ++ii) *(u32x4*)(NAT + (4 * tq + ii) * SNP + nc0) = rbc[ii];
                if (cg8 < 16) {
                    float wg[4];
#pragma unroll
                    for (int ii = 0; ii < 4; ++ii) { const int t = 4 * tq + ii; wg[ii] = DT[t] * __expf(cum_end - CUM[t]); }
#pragma unroll
                    for (int e = 0; e < 8; ++e) { u32x2 q; q.x = pk2(bfel(rbc[0], e) * wg[0], bfel(rbc[1], e) * wg[1]); q.y = pk2(bfel(rbc[2], e) * wg[2], bfel(rbc[3], e) * wg[3]);
                        *(u32x2*)(BWT + (nc0 + e) * SXP + 4 * tq) = q; }
                }
            }
            float xv[8]; unpack8(rx, xv);
#pragma unroll
            for (int e = 0; e < 8; ++e) XT[(cgx * 8 + e) * SXP + tx] = (u16)((e & 1) ? (rx[e >> 1] >> 16) : (rx[e >> 1] & 0xffffu));
            __syncthreads();
            if (c + 1 < nc) SSD_LOADS(c + 1);
            {
                const int ti = wid >> 1;
#pragma unroll
                for (int s2 = 0; s2 < 2; ++s2) { const int si = 2 * (wid & 1) + s2; f32x4 gacc = {0.f, 0.f, 0.f, 0.f};
                    if (si <= ti) {
#pragma unroll
                        for (int kk = 0; kk < 4; ++kk) { const bf16x8 av = *(const bf16x8*)(CN + (ti * 16 + l15) * SNP + kk * 32 + quad * 8), bv = *(const bf16x8*)(BN + (si * 16 + l15) * SNP + kk * 32 + quad * 8);
                            gacc = __builtin_amdgcn_mfma_f32_16x16x32_bf16(av, bv, gacc, 0, 0, 0); } }
                    const int s = si * 16 + l15; const float cs = CUM[s], ds = DT[s];
#pragma unroll
                    for (int j = 0; j < 4; ++j) { const int t = ti * 16 + quad * 4 + j; const float val = (s <= t) ? gacc[j] * __expf(CUM[t] - cs) * ds : 0.f; MSm[t * SXP + s] = f2bf(val); } }
            }
            __syncthreads();
            {
                const int ti = wid >> 1;
#pragma unroll
                for (int p2 = 0; p2 < 2; ++p2) { const int pi = 2 * (wid & 1) + p2; f32x4 y = {0.f, 0.f, 0.f, 0.f};
#pragma unroll
                    for (int kk = 0; kk < 4; ++kk) { const bf16x8 av = *(const bf16x8*)(CN + (ti * 16 + l15) * SNP + kk * 32 + quad * 8), bv = *(const bf16x8*)(HS + (pi * 16 + l15) * SNP + kk * 32 + quad * 8);
                        y = __builtin_amdgcn_mfma_f32_16x16x32_bf16(av, bv, y, 0, 0, 0); }
#pragma unroll
                    for (int j = 0; j < 4; ++j) y[j] *= __expf(CUM[ti * 16 + quad * 4 + j]);
#pragma unroll
                    for (int kk = 0; kk < 2; ++kk) { const bf16x8 av = *(const bf16x8*)(MSm + (ti * 16 + l15) * SXP + kk * 32 + quad * 8), bv = *(const bf16x8*)(XT + (pi * 16 + l15) * SXP + kk * 32 + quad * 8);
                        y = __builtin_amdgcn_mfma_f32_16x16x32_bf16(av, bv, y, 0, 0, 0); }
#pragma unroll
                    for (int j = 0; j < 4; ++j) YS[(ti * 16 + quad * 4 + j) * SYP + pi * 16 + l15] = y[j]; }
                const float dec = __expf(cum_end);
#pragma unroll
                for (int i = 0; i < 4; ++i) { const int nb = 4 * (wid & 1) + i; st[i] = st[i] * dec;
#pragma unroll
                    for (int kk = 0; kk < 2; ++kk) { const bf16x8 av = *(const bf16x8*)(XT + (pb * 16 + l15) * SXP + kk * 32 + quad * 8), bv = *(const bf16x8*)(BWT + (nb * 16 + l15) * SXP + kk * 32 + quad * 8);
                        st[i] = __builtin_amdgcn_mfma_f32_16x16x32_bf16(av, bv, st[i], 0, 0, 0); } }
            }
            __syncthreads();
            { u16* hp_ = HS + hs_off;
#pragma unroll
              for (int i = 0; i < 4; ++i)
#pragma unroll
                for (int j = 0; j < 4; ++j) hp_[j * SNP + i * 16] = f2bf(st[i][j]); }
            {
                const f32x4 y0 = *(const f32x4*)(YS + tx * SYP + cgx * 8), y1 = *(const f32x4*)(YS + tx * SYP + cgx * 8 + 4);
                float zf[8], o[8]; unpack8(zw, zf);
#pragma unroll
                for (int e = 0; e < 8; ++e) { const float yv = (e < 4 ? y0[e & 3] : y1[e & 3]) + Dh * xv[e]; o[e] = yv * siluf_(zf[e]); }
                *(u32x4*)(Z + (size_t)(r0 + tx) * DI + xcol) = pack8f(o);
            }
        }
#undef SSD_LOADS
        float* so = p->out + (smp ? O_SSMS : O_SSMP) + ((size_t)b * 64 + hd) * 64 * 128 + st_off;
#pragma unroll
        for (int i = 0; i < 4; ++i)
#pragma unroll
            for (int j = 0; j < 4; ++j) so[j * 128 + i * 16] = st[i][j];
        __syncthreads();
    }
}
__device__ __forceinline__ float logsig_(float f) { return fminf(f, 0.f) - log1pf(__expf(-fabsf(f))); }
__device__ __forceinline__ void phase_gn(KPrm p, const Ctx cx) {
    const int tid = cx.tid, lane = tid & 63, wid = tid >> 6;
    const int gw = cx.bid * 8 + wid, NGW = cx.G * 8;
    const float* SM = (const float*)(p->ws + W_SMALL);
    if (gw < 192) {
        if (gw < 64) { const int b = gw >> 4, h = gw & 15; const float fb = p->in[I_FB][h];
            float* bias = (float*)(p->ws + W_BIASP) + (size_t)(b * 16 + h) * TP; float* lo = p->out + O_LFP;
            const int tb = lane * 128; float s = 0.f;
            for (int i = 0; i < 128; ++i) s += logsig_(SM[(size_t)(b * TP + tb + i) * 256 + 64 + h] + fb);
            float inc = s;
#pragma unroll
            for (int o = 1; o < 64; o <<= 1) { const float y = __shfl_up(inc, o); if (lane >= o) inc += y; }
            float run = inc - s;
            for (int i = 0; i < 128; ++i) { const float lf = logsig_(SM[(size_t)(b * TP + tb + i) * 256 + 64 + h] + fb); run += lf;
                lo[(size_t)(b * TP + tb + i) * 16 + h] = lf; bias[tb + i] = -run * LOG2E; }
        } else { const int u = gw - 64, sb = u >> 4, h = u & 15; const float fb = p->in[I_FB][h];
            float* bias = (float*)(p->ws + W_BIASS) + (size_t)(sb * 16 + h) * SKVS; float* lo = p->out + O_LFS;
            const int tb = lane * 33; float s = 0.f;
            for (int i = 0; i < 33; ++i) { const int pos = tb + i;
                s += (pos < PAST) ? p->in[I_CLF][(size_t)(sb * PAST + pos) * 16 + h] : logsig_(SM[(size_t)(MP + sb * TS + pos - PAST) * 256 + 64 + h] + fb); }
            float inc = s;
#pragma unroll
            for (int o = 1; o < 64; o <<= 1) { const float y = __shfl_up(inc, o); if (lane >= o) inc += y; }
            float run = inc - s;
            for (int i = 0; i < 33; ++i) { const int pos = tb + i; float lf;
                if (pos < PAST) lf = p->in[I_CLF][(size_t)(sb * PAST + pos) * 16 + h];
                else { lf = logsig_(SM[(size_t)(MP + sb * TS + pos - PAST) * 256 + 64 + h] + fb); lo[(size_t)(sb * TS + pos - PAST) * 16 + h] = lf; }
                run += lf; bias[pos] = -run * LOG2E; }
        }
    }
    {
        const u16* XBC = (const u16*)(p->ws + W_XBC);
        const int gt = cx.bid * 512 + tid, GT = cx.G * 512;
        for (int i = gt; i < 12 * 3 * CD; i += GT) { const int bb = i / (3 * CD), r = (i / CD) % 3, c = i % CD;
            if (bb < 4) p->out[O_MCP + i] = bflo(XBC[(size_t)(bb * TP + TP - 3 + r) * CD + c]);
            else p->out[O_MCS + (i - 4 * 3 * CD)] = bflo(XBC[(size_t)(MP + (bb - 4) * TS + TS - 3 + r) * CD + c]); }
    }
    u16* Z = (u16*)(p->ws + W_Z); const float* mnw = p->in[I_MNW];
    for (int row = gw; row < M; row += NGW) {
#pragma unroll 2
        for (int i = 0; i < 8; ++i) { const int col = i * 512 + lane * 8; u16* zp = Z + (size_t)row * DI + col;
            float v[8]; unpack8(*(const u32x4*)zp, v); float ss = 0.f;
#pragma unroll
            for (int e = 0; e < 8; ++e) ss += v[e] * v[e];
            const float rs = rsqrtf(wave_sum(ss) * (1.f / 512.f) + EPS);
            const f32x4 w0 = *(const f32x4*)(mnw + col), w1 = *(const f32x4*)(mnw + col + 4);
#pragma unroll
            for (int e = 0; e < 8; ++e) v[e] = v[e] * rs * (e < 4 ? w0[e & 3] : w1[e & 3]);
            *(u32x4*)zp = pack8f(v); }
    }
}
__device__ __forceinline__ void phase_qk(KPrm p, const Ctx cx) {
    const int tid = cx.tid, lane = tid & 63, wid = tid >> 6;
    const int gw = cx.bid * 8 + wid, NGW = cx.G * 8;
    u16* Q = (u16*)(p->ws + W_Q); u16* K = (u16*)(p->ws + W_K); const u16* V = (const u16*)(p->ws + W_V);
    u16* Ks = (u16*)p->out; u16* Vs = Ks + (size_t)NBS * SKVS * DM;
    const float QS = 0.08838834764831845f * LOG2E;
    const int hc = (lane & 15) * 8;
    const f32x4 qw0 = *(const f32x4*)(p->in[I_QNW] + hc), qw1 = *(const f32x4*)(p->in[I_QNW] + hc + 4), kw0 = *(const f32x4*)(p->in[I_KNW] + hc), kw1 = *(const f32x4*)(p->in[I_KNW] + hc + 4);
    for (int row = gw; row < M; row += NGW) {
        const bool smp = row >= MP;
        float* ko = smp ? p->out + O_KS + (size_t)(row - MP) * DM : p->out + O_KP + (size_t)row * DM;
        float* vo = smp ? p->out + O_VS + (size_t)(row - MP) * DM : p->out + O_VP + (size_t)row * DM;
        size_t srow = 0; if (smp) { const int sb = (row - MP) >> 6, t = (row - MP) & 63; srow = (size_t)(sb * SKVS + PAST + t) * DM; }
#pragma unroll
        for (int it = 0; it < 4; ++it) { const int col = it * 512 + lane * 8; const size_t off = (size_t)row * DM + col;
            float v[8], ss;
            unpack8(*(const u32x4*)(Q + off), v); ss = 0.f;
#pragma unroll
            for (int e = 0; e < 8; ++e) ss += v[e] * v[e];
            ss += __shfl_xor(ss, 1); ss += __shfl_xor(ss, 2); ss += __shfl_xor(ss, 4); ss += __shfl_xor(ss, 8);
            float rs = rsqrtf(ss * (1.f / 128.f) + EPS) * QS;
#pragma unroll
            for (int e = 0; e < 8; ++e) v[e] = v[e] * rs * (e < 4 ? qw0[e & 3] : qw1[e & 3]);
            *(u32x4*)(Q + off) = pack8f(v);
            unpack8(*(const u32x4*)(K + off), v); ss = 0.f;
#pragma unroll
            for (int e = 0; e < 8; ++e) ss += v[e] * v[e];
            ss += __shfl_xor(ss, 1); ss += __shfl_xor(ss, 2); ss += __shfl_xor(ss, 4); ss += __shfl_xor(ss, 8);
            rs = rsqrtf(ss * (1.f / 128.f) + EPS);
#pragma unroll
            for (int e = 0; e < 8; ++e) v[e] = v[e] * rs * (e < 4 ? kw0[e & 3] : kw1[e & 3]);
            const u32x4 kp = pack8f(v);
            *(u32x4*)(K + off) = kp;
            *(f32x4*)(ko + col) = (f32x4){v[0], v[1], v[2], v[3]}; *(f32x4*)(ko + col + 4) = (f32x4){v[4], v[5], v[6], v[7]};
            const u32x4 vw = *(const u32x4*)(V + off); unpack8(vw, v);
            *(f32x4*)(vo + col) = (f32x4){v[0], v[1], v[2], v[3]}; *(f32x4*)(vo + col + 4) = (f32x4){v[4], v[5], v[6], v[7]};
            if (smp) { *(u32x4*)(Ks + srow + col) = kp; *(u32x4*)(Vs + srow + col) = vw; } }
    }
}
typedef att::BlockRef<att::bf16, att::bf16> ARef;
__device__ __forceinline__ ARef att_ref(KPrm p, const Ctx cx, int i, int nbp, int& skv) {
    const int G = cx.G, bid = (cx.G % 8 == 0) ? (cx.bid % 8) * (cx.G / 8) + cx.bid / 8 : cx.bid; ARef r;
    att::bf16* Qb = (att::bf16*)(p->ws + W_Q); const att::bf16* Kb = (const att::bf16*)(p->ws + W_K); const att::bf16* Vb = (const att::bf16*)(p->ws + W_V);
    if (i < nbp) { const int L = bid + (i >> 1) * G, bh = L >> 4, x = L & 15, qb = (i & 1) ? 31 - x : x, b = bh >> 4, h = bh & 15;
        const size_t rq = ((size_t)b * TP + (size_t)qb * 256) * DM + h * 128, rk = (size_t)b * TP * DM + h * 128;
        r.Q = Qb + rq; r.O = Qb + rq; r.K = Kb + rk; r.V = Vb + rk; r.Bs = (const float*)(p->ws + W_BIASP) + (size_t)bh * TP; r.P0 = qb * 256; r.nvalid = 256; skv = TP;
    } else { const int su = bid + (i - nbp) * G, sb = su >> 4, h = su & 15;
        const att::bf16* Ks = (const att::bf16*)p->out; const att::bf16* Vs = Ks + (size_t)NBS * SKVS * DM;
        const size_t rq = ((size_t)MP + (size_t)sb * TS) * DM + h * 128, rk = (size_t)sb * SKVS * DM + h * 128;
        r.Q = Qb + rq; r.O = Qb + rq; r.K = Ks + rk; r.V = Vs + rk; r.Bs = (const float*)(p->ws + W_BIASS) + (size_t)su * SKVS; r.P0 = PAST; r.nvalid = TS; skv = SKVS; }
    return r;
}
__device__ __forceinline__ void phase_att(KPrm p, const Ctx cx, char* lds) {
    const int G = cx.G, bid = (cx.G % 8 == 0) ? (cx.bid % 8) * (cx.G / 8) + cx.bid / 8 : cx.bid;
    const int nip = (bid < 1024) ? (1024 - bid + G - 1) / G : 0, nbp = 2 * nip, nbs = (bid < 128) ? (128 - bid + G - 1) / G : 0, nb = nbp + nbs;
    if (nb == 0) return;
    const int W = 1 << 30;
    int skv, skvn; ARef cur = att_ref(p, cx, 0, nbp, skv);
    att::Seam<att::bf16> S;
    att::causal_swa_prime<att::bf16, att::bf16>(cur, W, lds, S, cx.tid);
    for (int i = 0; i < nb; ++i) {
        const bool last = (i + 1 == nb);
        ARef nxt = cur; skvn = skv; if (!last) nxt = att_ref(p, cx, i + 1, nbp, skvn);
        att::causal_swa_block<att::bf16, att::bf16>(cur, nxt, skv, W, lds, S, cx.tid);
        cur = nxt; skv = skvn;
    }
}
__device__ __forceinline__ void phase_cv(KPrm p, const Ctx cx, int half) {
    const int tid = cx.tid;
    const u16* U = (const u16*)(p->ws + W_U); u16* Gb = (u16*)(p->ws + W_G); u16* HALO = (u16*)(p->ws + W_HALO);
    const float* cw = p->in[I_FCW]; const float* cb = p->in[I_FCB];
    const int row_lo = half ? HALF_ROWS : 0;
    constexpr int NCG = DFF / 8, RB = 16, NRB = HALF_ROWS / RB;
    const long gt = (long)cx.bid * 512 + tid, GT = (long)cx.G * 512;
    for (long it = gt; it < (long)NCG * NRB; it += GT) {
        const int cgi = (int)(it % NCG), rb = (int)(it / NCG); const int f0 = cgi * 8, r0 = row_lo + rb * RB;
        const int ca = (f0 >> 7) * 256 + (f0 & 127), cbb = ca + 128;
        float wa[3][8], wb[3][8], ba[8], bb[8];
#pragma unroll
        for (int k = 0; k < 3; ++k) { const f32x4 a0 = *(const f32x4*)(cw + k * DFF2 + f0), a1 = *(const f32x4*)(cw + k * DFF2 + f0 + 4), b0 = *(const f32x4*)(cw + k * DFF2 + DFF + f0), b1 = *(const f32x4*)(cw + k * DFF2 + DFF + f0 + 4);
#pragma unroll
            for (int e = 0; e < 4; ++e) { wa[k][e] = a0[e]; wa[k][4 + e] = a1[e]; wb[k][e] = b0[e]; wb[k][4 + e] = b1[e]; } }
        { const f32x4 a0 = *(const f32x4*)(cb + f0), a1 = *(const f32x4*)(cb + f0 + 4), b0 = *(const f32x4*)(cb + DFF + f0), b1 = *(const f32x4*)(cb + DFF + f0 + 4);
#pragma unroll
          for (int e = 0; e < 4; ++e) { ba[e] = a0[e]; ba[4 + e] = a1[e]; bb[e] = b0[e]; bb[4 + e] = b1[e]; } }
        float ha[2][8], hb[2][8];
        const bool smp = r0 >= MP; const int tb = smp ? ((r0 - MP) & 63) : (r0 & (TP - 1));
        if (tb == 0) {
            if (smp) { const float* s = p->in[I_FCV] + (size_t)((r0 - MP) >> 6) * 2 * DFF2;
#pragma unroll
                for (int k = 0; k < 2; ++k)
#pragma unroll
                    for (int e = 0; e < 8; ++e) { ha[k][e] = s[k * DFF2 + f0 + e]; hb[k][e] = s[k * DFF2 + DFF + f0 + e]; }
            } else {
#pragma unroll
                for (int k = 0; k < 2; ++k)
#pragma unroll
                    for (int e = 0; e < 8; ++e) { ha[k][e] = 0.f; hb[k][e] = 0.f; } }
        } else if (half && rb == 0) {
#pragma unroll
            for (int k = 0; k < 2; ++k) { unpack8(*(const u32x4*)(HALO + (size_t)k * DFF2 + ca), ha[k]); unpack8(*(const u32x4*)(HALO + (size_t)k * DFF2 + cbb), hb[k]); }
        } else {
#pragma unroll
            for (int k = 0; k < 2; ++k) { const size_t ro = (size_t)(r0 - row_lo - 2 + k) * DFF2; unpack8(*(const u32x4*)(U + ro + ca), ha[k]); unpack8(*(const u32x4*)(U + ro + cbb), hb[k]); }
        }
#pragma unroll 4
        for (int i = 0; i < RB; ++i) { const int r = r0 + i; const size_t ro = (size_t)(r - row_lo) * DFF2;
            const u32x4 uaw = *(const u32x4*)(U + ro + ca), ubw = *(const u32x4*)(U + ro + cbb);
            float ua[8], ub[8], o[8]; unpack8(uaw, ua); unpack8(ubw, ub);
#pragma unroll
            for (int e = 0; e < 8; ++e) { const float va = ba[e] + wa[0][e] * ha[0][e] + wa[1][e] * ha[1][e] + wa[2][e] * ua[e], vb = bb[e] + wb[0][e] * hb[0][e] + wb[1][e] * hb[1][e] + wb[2][e] * ub[e];
                o[e] = siluf_(va) * vb; ha[0][e] = ha[1][e]; ha[1][e] = ua[e]; hb[0][e] = hb[1][e]; hb[1][e] = ub[e]; }
            *(u32x4*)(Gb + (size_t)r * DFF + f0) = pack8f(o);
            const int tpos = (r >= MP) ? ((r - MP) & 63) : (r & (TP - 1)), tlen = (r >= MP) ? TS : TP;
            if (tpos >= tlen - 2) { float* fo = (r >= MP) ? p->out + O_FCS + ((size_t)((r - MP) >> 6) * 2 + (tpos - (tlen - 2))) * DFF2 : p->out + O_FCP + ((size_t)(r >> 13) * 2 + (tpos - (tlen - 2))) * DFF2;
#pragma unroll
                for (int e = 0; e < 8; ++e) { fo[f0 + e] = ua[e]; fo[DFF + f0 + e] = ub[e]; } }
            if (!half && r >= HALF_ROWS - 2) { *(u32x4*)(HALO + (size_t)(r - (HALF_ROWS - 2)) * DFF2 + ca) = uaw; *(u32x4*)(HALO + (size_t)(r - (HALF_ROWS - 2)) * DFF2 + cbb) = ubw; }
        }
    }
}
constexpr int LDS_TOTAL = 147456;
enum { PH_CONV = 100 };
enum { PH_PREP = 0, PH_N1, PH_G1A, PH_SSD, PH_GN, PH_G1B, PH_G2, PH_G1C, PH_QK, PH_ATT, PH_G3, PH_G4, PH_N2, PH_G5A, PH_CVA, PH_G5B, PH_CVB, PH_G6, PH_COUNT };
__device__ __forceinline__ void run_gemms(KPrm p, const Ctx cx, unsigned char* lds, const int first, const int last, cg::grid_group& grid) {
#pragma unroll 1
    for (int ph = first; ph <= last; ++ph) {
        unsigned char* ws = p->ws;
        pg8::Gemm g; Epi E;
        g.A = (const u16*)(ws + W_H); g.Bt = nullptr; g.M = M; g.N = DM; g.K = DM;
        E.mode = 0; E.d0 = E.d1 = E.d2 = nullptr; E.t1 = E.t2 = 1 << 20; E.p0 = E.p1 = E.p2 = 0; E.f32seg2 = 0;
        E.xp = p->in[I_XP]; E.xs = p->in[I_XS]; E.y = p->out; E.mod = (const float*)(ws + W_MOD); E.gbuf = (u16*)(ws + W_GM); E.gf = (const u16*)(ws + W_GF);
        switch (ph) {
        case PH_G1A: g.Bt = (const u16*)(ws + W_WIN); g.N = 41 * 256;
            E.d0 = (u16*)(ws + W_XBC); E.p0 = CD; E.t1 = 24; E.d1 = (u16*)(ws + W_Z); E.p1 = DI; E.t2 = 40; E.d2 = (u16*)(ws + W_SMALL); E.p2 = 256; E.f32seg2 = 1; break;
        case PH_G1B: g.Bt = (const u16*)(ws + W_WIN) + (size_t)10496 * DM; g.N = 16 * 256;
            E.d0 = (u16*)(ws + W_GM); E.p0 = DM; E.t1 = 8; E.d1 = (u16*)(ws + W_GF); E.p1 = DM; break;
        case PH_G2: g.A = (const u16*)(ws + W_Z); g.Bt = (const u16*)(ws + W_WPM); g.K = DI; E.mode = 1; break;
        case PH_G1C: g.Bt = (const u16*)(ws + W_WIN) + (size_t)14592 * DM; g.N = 24 * 256;
            E.d0 = (u16*)(ws + W_Q); E.p0 = DM; E.t1 = 8; E.d1 = (u16*)(ws + W_K); E.p1 = DM; E.t2 = 16; E.d2 = (u16*)(ws + W_V); E.p2 = DM; break;
        case PH_G3: g.A = (const u16*)(ws + W_Q); g.Bt = (const u16*)(ws + W_WPF); E.mode = 2; break;
        case PH_G4: g.A = (const u16*)(ws + W_GM); g.Bt = (const u16*)(ws + W_WOUT); E.mode = 3; break;
        case PH_G5A: g.Bt = (const u16*)(ws + W_WUP); g.M = HALF_ROWS; g.N = DFF2; E.d0 = (u16*)(ws + W_U); E.p0 = DFF2; break;
        case PH_G5B: g.A = (const u16*)(ws + W_H) + (size_t)HALF_ROWS * DM; g.Bt = (const u16*)(ws + W_WUP); g.M = HALF_ROWS; g.N = DFF2; E.d0 = (u16*)(ws + W_U); E.p0 = DFF2; break;
        default:   g.A = (const u16*)(ws + W_G); g.Bt = (const u16*)(ws + W_WDN); g.K = DFF; E.mode = 5; break;
        }
        pg8::StaticOrder S; S.init(g.M, g.N, cx.G, cx.bid);
        pg8::gemm_phase<Epi, pg8::StaticOrder, true, true>((PG8_LAS unsigned char*)lds, g, S, E, cx.tid);
        if (ph < last) grid.sync();
    }
}
#define PH_BEGIN() Ctx cx; { int t_ = threadIdx.x; asm volatile("" : "+v"(t_)); int b_ = blockIdx.x, g_ = gridDim.x; asm volatile("" : "+s"(b_), "+s"(g_)); cx.tid = t_; cx.bid = b_; cx.G = g_; } \
    KPrm p = (KPrm)__builtin_amdgcn_kernarg_segment_ptr(); asm volatile("" : "+s"(p))
#ifdef ONLY_PH
#define PH_ON(k) ((k) == ONLY_PH)
#else
#define PH_ON(k) true
#endif
__global__ void __launch_bounds__(512, 2) mega_fwd(Prm prm_unused) {
    extern __shared__ __attribute__((aligned(16))) unsigned char lds[];
    cg::grid_group grid = cg::this_grid();
#ifndef EXP
#define EXP 0
#endif
    if (PH_ON(PH_PREP)) { PH_BEGIN(); phase_prep(p, cx, lds); } grid.sync();
#if EXP == 3
    { PH_BEGIN(); phase_prep(p, cx, lds); } grid.sync();
#endif
    if (PH_ON(PH_N1)) { PH_BEGIN(); phase_norm(p, cx, 0); } grid.sync();
    if (PH_ON(PH_G1A)) { PH_BEGIN(); run_gemms(p, cx, lds, PH_G1A, PH_G1A, grid); } grid.sync();
#if EXP == 1
    { PH_BEGIN(); run_gemms(p, cx, lds, PH_G1A, PH_G1A, grid); } grid.sync();
#endif
    if (PH_ON(PH_CONV)) { PH_BEGIN(); phase_conv(p, cx); } grid.sync();
    if (PH_ON(PH_SSD)) { PH_BEGIN(); phase_ssd(p, cx, lds); } grid.sync();
#if EXP == 2
    { PH_BEGIN(); run_gemms(p, cx, lds, PH_G1A, PH_G1A, grid); } grid.sync();
    { PH_BEGIN(); phase_conv(p, cx); } grid.sync();
    { PH_BEGIN(); phase_ssd(p, cx, lds); } grid.sync();
#endif
    if (PH_ON(PH_GN)) { PH_BEGIN(); phase_gn(p, cx); } grid.sync();
    if (PH_ON(PH_G1B)) { PH_BEGIN(); run_gemms(p, cx, lds, PH_G1B, PH_G1C, grid); } grid.sync();
    if (PH_ON(PH_QK)) { PH_BEGIN(); phase_qk(p, cx); } grid.sync();
    if (PH_ON(PH_ATT)) { PH_BEGIN(); phase_att(p, cx, (char*)lds); } grid.sync();
#if EXP == 4
    { PH_BEGIN(); run_gemms(p, cx, lds, PH_G1C, PH_G1C, grid); } grid.sync();
    { PH_BEGIN(); phase_qk(p, cx); } grid.sync();
    { PH_BEGIN(); phase_att(p, cx, (char*)lds); } grid.sync();
#endif
    if (PH_ON(PH_G3)) { PH_BEGIN(); run_gemms(p, cx, lds, PH_G3, PH_G4, grid); } grid.sync();
    if (PH_ON(PH_N2)) { PH_BEGIN(); phase_norm(p, cx, 1); } grid.sync();
    if (PH_ON(PH_G5A)) { PH_BEGIN(); run_gemms(p, cx, lds, PH_G5A, PH_G5A, grid); } grid.sync();
    if (PH_ON(PH_CVA)) { PH_BEGIN(); phase_cv(p, cx, 0); } grid.sync();
    if (PH_ON(PH_G5B)) { PH_BEGIN(); run_gemms(p, cx, lds, PH_G5B, PH_G5B, grid); } grid.sync();
    if (PH_ON(PH_CVB)) { PH_BEGIN(); phase_cv(p, cx, 1); } grid.sync();
    if (PH_ON(PH_G6)) { PH_BEGIN(); run_gemms(p, cx, lds, PH_G6, PH_G6, grid); }
}

extern "C" void kernel_launch(void* const* d_in, const int* in_sizes, int n_in, void* d_out, int out_size, void* d_ws, size_t ws_size, hipStream_t stream) {
    static int grid = 0;
    if (grid == 0) {
        if (n_in != 31 || (size_t)out_size != O_END || ws_size < 1024 * MiB) { fprintf(stderr, "kernel_launch: unexpected sizes n_in %d out %d ws %zu\n", n_in, out_size, ws_size); }
        int dev = 0, cus = 0, per_cu = 0;
        hipGetDevice(&dev); hipDeviceGetAttribute(&cus, hipDeviceAttributeMultiprocessorCount, dev);
        hipFuncSetAttribute((const void*)mega_fwd, hipFuncAttributeMaxDynamicSharedMemorySize, LDS_TOTAL);
        hipOccupancyMaxActiveBlocksPerMultiprocessor(&per_cu, (const void*)mega_fwd, 512, LDS_TOTAL);
        (void)hipGetLastError();
        if (per_cu < 1) per_cu = 1;
        grid = cus;
    }
    Prm prm{};
    for (int i = 0; i < 31; ++i) prm.in[i] = (const float*)d_in[i];
    prm.out = (float*)d_out; prm.ws = (unsigned char*)d_ws;
    void* args[] = {&prm};
    hipError_t e = hipLaunchCooperativeKernel((const void*)mega_fwd, dim3(grid), dim3(512), args, LDS_TOTAL, stream);
    if (e != hipSuccess) fprintf(stderr, "cooperative launch failed: %s (grid %d)\n", hipGetErrorString(e), grid);
}
```

```cpp
#include <hip/hip_runtime.h>
#include <hip/hip_cooperative_groups.h>
#include <hip/hip_bf16.h>
#include <cstdio>
#include <cstdint>
namespace cg = cooperative_groups;
namespace pg8 {
#define PG8_LAS __attribute__((address_space(3)))
typedef unsigned short bf16_t;
typedef short bf16x8 __attribute__((ext_vector_type(8)));
typedef float f32x4 __attribute__((ext_vector_type(4)));
typedef unsigned u32x4 __attribute__((ext_vector_type(4)));
constexpr int BM = 256, BK = 64, HALF = 128, HTB = HALF * BK * 2  , STAGE_BYTES = 8 * HTB, NXCD = 8, WGM = 8;

__host__ __device__ __forceinline__ int lds_byte(int r, int c) { const int st = (r >> 4) * 2 + (c >> 5), rr = r & 15, cc = c & 31, ob = rr * 64 + cc * 2; return st * 1024 + (ob ^ (((ob >> 9) & 1) << 5)); }
__host__ __device__ __forceinline__ void stage_rc(int b, int& R, int& C) { const int st = b / 1024, sb = b % 1024, swz = sb ^ (((sb >> 9) & 1) << 5); R = (st >> 1) * 16 + swz / 64; C = (st & 1) * 32 + (swz % 64) / 2; }
__host__ __device__ __forceinline__ int perm32(int rho) { const int n = rho >> 4, i = rho & 15; return 8 * (i >> 2) + 4 * n + (i & 3); }

struct Unit { int pm, pn; };
struct Gemm { const bf16_t* A; const bf16_t* Bt; int M, N, K; };

struct StaticOrder {
    int nM, nN, nwg, G, c;
    __host__ __device__ void init(int M, int N, int G_, int c_) { nM = M / BM; nN = N / BM; nwg = nM * nN; G = G_; c = c_; }
    __host__ __device__ bool next(int i, Unit& u) const {
        const long L = (long)i * G + c; if (L >= nwg) return false;
        int wgid = (int)L; { const int q = nwg / NXCD, r = nwg % NXCD, xcd = wgid % NXCD, off = wgid / NXCD; wgid = (xcd < r ? xcd * (q + 1) : r * (q + 1) + (xcd - r) * q) + off; }
        const int nig = WGM * nN, gid = wgid / nig, fm = gid * WGM, gsz = (nM - fm) < WGM ? (nM - fm) : WGM;
        u.pm = fm + ((wgid % nig) % gsz); u.pn = (wgid % nig) / gsz; return true;
    }
    __device__ __forceinline__ void a_ready(const Unit&) const {}
    __device__ __forceinline__ void done(const Unit&) const {}
};
__device__ __forceinline__ unsigned cvt_pk_bf16(float lo, float hi) { unsigned r; asm volatile("v_cvt_pk_bf16_f32 %0, %1, %2" : "=v"(r) : "v"(lo), "v"(hi)); return r; }
typedef float f32x2 __attribute__((ext_vector_type(2)));
template <class Epi, class Sched, bool ALIGN_EPI = false, bool SP2 = false>
__device__ __forceinline__ void gemm_phase(PG8_LAS unsigned char* lds, const Gemm g, const Sched& S, const Epi& E, const int tid) {
    const int wid = __builtin_amdgcn_readfirstlane(tid >> 6), lane = tid & 63, wr = wid >> 2, wc = wid & 3, fr = lane & 15, fq = lane >> 4;
    const int K = g.K, nt = K / BK;
    unsigned voffA[2], voffB[2];
#pragma unroll
    for (int i = 0; i < 2; ++i) { int R, C; stage_rc(tid * 16 + i * 8192, R, C); const int Rb = Epi::PERM ? ((R & ~31) + perm32(R & 31)) : R;
        voffA[i] = (unsigned)(R * K + C) * 2u; voffB[i] = (unsigned)(Rb * K + C) * 2u; }
    const size_t kstep = (size_t)(BK * 2);
    const size_t hstep = (size_t)HALF * K * 2;
    const size_t tstep = 2 * hstep;
    const unsigned ldsw = (unsigned)wid * 1024u;
    const int aoff = lds_byte(wr * 64 + fr, fq * 8), boff = lds_byte(wc * 32 + fr, fq * 8);
#define PG8_SA(b, h) (((b) * 2 + (h)) * HTB)
#define PG8_SB(b, h) ((4 + (b) * 2 + (h)) * HTB)
#define PG8_STAGE(bufoff, gbase, voff) do { _Pragma("unroll") for (int _i = 0; _i < 2; ++_i) \
        __builtin_amdgcn_global_load_lds((const unsigned*)((const char*)(gbase) + (voff)[_i]), (PG8_LAS unsigned*)(lds + (bufoff) + ldsw + _i * 8192), 16, 0, 0); } while (0)
#define PG8_LDA(dst, b, h) do { _Pragma("unroll") for (int m = 0; m < 4; ++m) _Pragma("unroll") for (int k = 0; k < 2; ++k) dst[m][k] = *(const PG8_LAS bf16x8*)(lds + PG8_SA(b, h) + aoff + m * 2048 + k * 1024); } while (0)
#define PG8_LDB(dst, b, h) do { _Pragma("unroll") for (int n = 0; n < 2; ++n) _Pragma("unroll") for (int k = 0; k < 2; ++k) dst[n][k] = *(const PG8_LAS bf16x8*)(lds + PG8_SB(b, h) + boff + n * 2048 + k * 1024); } while (0)
#define PG8_MMA(ai, bj, At, Bt) do { __builtin_amdgcn_s_setprio(1); _Pragma("unroll") for (int m = 0; m < 4; ++m) _Pragma("unroll") for (int n = 0; n < 2; ++n) _Pragma("unroll") for (int k = 0; k < 2; ++k) \
        acc[ai][bj][m][n] = __builtin_amdgcn_mfma_f32_16x16x32_bf16(Bt[n][k], At[m][k], acc[ai][bj][m][n], 0, 0, 0); __builtin_amdgcn_s_setprio(0); } while (0)
#define PG8_WAIT_V(n) asm volatile("s_waitcnt vmcnt(" #n ")" ::: "memory")
#define PG8_WAIT_L(n) asm volatile("s_waitcnt lgkmcnt(" #n ")" ::: "memory")
#define PG8_BAR __builtin_amdgcn_s_barrier()
#define PG8_SCHED __builtin_amdgcn_sched_barrier(0)
    Unit cur, nxt; int ui = 0;
    if (!S.next(0, cur)) return;
    f32x4 acc[2][2][4][2];
#pragma unroll
    for (int a = 0; a < 2; ++a)
#pragma unroll
        for (int b = 0; b < 2; ++b)
#pragma unroll
            for (int m = 0; m < 4; ++m)
#pragma unroll
                for (int n = 0; n < 2; ++n) acc[a][b][m][n] = (f32x4){0.f, 0.f, 0.f, 0.f};
    bf16x8 At[4][2], B0[2][2], B1[2][2];
    const char* cA = (const char*)g.A + (size_t)cur.pm * tstep; const char* cB = (const char*)g.Bt + (size_t)cur.pn * tstep;
    S.a_ready(cur);
    if constexpr (SP2) {
        PG8_STAGE(PG8_SB(0, 0), cB, voffB); PG8_STAGE(PG8_SB(0, 1), cB + hstep, voffB); PG8_STAGE(PG8_SA(0, 0), cA, voffA); PG8_STAGE(PG8_SA(0, 1), cA + hstep, voffA);
        if (wr == 1) PG8_BAR;
        PG8_WAIT_V(2); PG8_BAR;
        PG8_STAGE(PG8_SB(1, 0), cB + kstep, voffB); PG8_STAGE(PG8_SA(1, 0), cA + kstep, voffA); PG8_STAGE(PG8_SB(1, 1), cB + hstep + kstep, voffB);
        PG8_WAIT_V(6); PG8_BAR;
    } else {
        PG8_STAGE(PG8_SB(0, 0), cB, voffB); PG8_STAGE(PG8_SA(0, 0), cA, voffA); PG8_STAGE(PG8_SB(0, 1), cB + hstep, voffB); PG8_STAGE(PG8_SA(0, 1), cA + hstep, voffA);
        if (wr == 1) PG8_BAR;
        PG8_WAIT_V(4); PG8_BAR;
        PG8_STAGE(PG8_SB(1, 0), cB + kstep, voffB); PG8_STAGE(PG8_SA(1, 0), cA + kstep, voffA); PG8_STAGE(PG8_SB(1, 1), cB + hstep + kstep, voffB);
        PG8_WAIT_V(6); PG8_BAR;
    }
    for (;;) {
        const bool has_next = S.next(ui + 1, nxt);
        const char* nA = has_next ? (const char*)g.A + (size_t)nxt.pm * tstep : cA; const char* nB = has_next ? (const char*)g.Bt + (size_t)nxt.pn * tstep : cB;
        for (int t = 0; t < nt; t += 2) {
            const bool last = (t == nt - 2);
            const char* a1 = cA + (size_t)(t + 1) * kstep;
            const char* a2 = last ? nA : cA + (size_t)(t + 2) * kstep; const char* b2 = last ? nB : cB + (size_t)(t + 2) * kstep;
            const char* a3 = a2 + kstep; const char* b3 = b2 + kstep;
            if (last && has_next) S.a_ready(nxt);
            if constexpr (SP2) {
            PG8_LDB(B0, 0, 0); PG8_LDB(B1, 0, 1); PG8_SCHED; PG8_LDA(At, 0, 0); PG8_STAGE(PG8_SA(1, 1), a1 + hstep, voffA);
            PG8_WAIT_V(8); PG8_WAIT_L(0); PG8_BAR; PG8_MMA(0, 0, At, B0); PG8_MMA(0, 1, At, B1); PG8_BAR; PG8_SCHED;
            PG8_LDA(At, 0, 1); PG8_STAGE(PG8_SB(0, 0), b2, voffB); PG8_STAGE(PG8_SB(0, 1), b2 + hstep, voffB); PG8_STAGE(PG8_SA(0, 0), a2, voffA);
            PG8_WAIT_V(8); PG8_WAIT_L(0); PG8_BAR; PG8_MMA(1, 0, At, B0); PG8_MMA(1, 1, At, B1); PG8_BAR; PG8_SCHED;
            PG8_LDB(B0, 1, 0); PG8_LDB(B1, 1, 1); PG8_SCHED; PG8_LDA(At, 1, 0); PG8_STAGE(PG8_SA(0, 1), a2 + hstep, voffA);
            PG8_WAIT_V(8); PG8_WAIT_L(0); PG8_BAR; PG8_MMA(0, 0, At, B0); PG8_MMA(0, 1, At, B1); PG8_BAR; PG8_SCHED;
            PG8_LDA(At, 1, 1); PG8_STAGE(PG8_SB(1, 0), b3, voffB); PG8_STAGE(PG8_SB(1, 1), b3 + hstep, voffB); PG8_STAGE(PG8_SA(1, 0), a3, voffA);
            PG8_WAIT_V(8); PG8_WAIT_L(0); PG8_BAR; PG8_MMA(1, 0, At, B0); PG8_MMA(1, 1, At, B1); PG8_BAR; PG8_SCHED;
            } else {
            PG8_LDB(B0, 0, 0); PG8_SCHED; PG8_LDA(At, 0, 0); PG8_STAGE(PG8_SA(1, 1), a1 + hstep, voffA);
            PG8_WAIT_L(8); PG8_BAR; PG8_WAIT_L(0); PG8_MMA(0, 0, At, B0); PG8_BAR; PG8_SCHED;
            PG8_LDB(B1, 0, 1); PG8_STAGE(PG8_SB(0, 0), b2, voffB);
            PG8_BAR; PG8_WAIT_L(0); PG8_MMA(0, 1, At, B1); PG8_BAR;
            PG8_LDA(At, 0, 1); PG8_STAGE(PG8_SA(0, 0), a2, voffA);
            PG8_BAR; PG8_WAIT_L(0); PG8_MMA(1, 0, At, B0); PG8_BAR; PG8_SCHED;
            PG8_STAGE(PG8_SB(0, 1), b2 + hstep, voffB);
            PG8_WAIT_V(6); PG8_BAR; PG8_MMA(1, 1, At, B1); PG8_BAR;
            PG8_LDB(B0, 1, 0); PG8_SCHED; PG8_LDA(At, 1, 0); PG8_STAGE(PG8_SA(0, 1), a2 + hstep, voffA);
            PG8_WAIT_L(8); PG8_BAR; PG8_WAIT_L(0); PG8_MMA(0, 0, At, B0); PG8_BAR; PG8_SCHED;
            PG8_LDB(B1, 1, 1); PG8_STAGE(PG8_SB(1, 0), b3, voffB);
            PG8_BAR; PG8_WAIT_L(0); PG8_MMA(0, 1, At, B1); PG8_BAR;
            PG8_LDA(At, 1, 1); PG8_STAGE(PG8_SA(1, 0), a3, voffA);
            PG8_BAR; PG8_WAIT_L(0); PG8_MMA(1, 0, At, B0); PG8_BAR; PG8_SCHED;
            PG8_STAGE(PG8_SB(1, 1), b3 + hstep, voffB);
            PG8_WAIT_V(6); PG8_BAR; PG8_MMA(1, 1, At, B1); PG8_BAR;
            }
        }
        if constexpr (ALIGN_EPI) { if (wr == 0) PG8_BAR; }
        if constexpr (!Epi::AFTER_DRAIN) { E(acc, cur, wr, wc, fr, fq); S.done(cur); }
        if (!has_next) break;
#pragma unroll
        for (int a = 0; a < 2; ++a)
#pragma unroll
            for (int b = 0; b < 2; ++b)
#pragma unroll
                for (int m = 0; m < 4; ++m)
#pragma unroll
                    for (int n = 0; n < 2; ++n) acc[a][b][m][n] = (f32x4){0.f, 0.f, 0.f, 0.f};
        cur = nxt; cA = nA; cB = nB; ++ui;
        if constexpr (ALIGN_EPI) { if (wr == 1) PG8_BAR; }
    }
    PG8_WAIT_V(0);
    if constexpr (!ALIGN_EPI) { if (wr == 0) PG8_BAR; }
    PG8_BAR;
    if constexpr (Epi::AFTER_DRAIN) { E.fused(acc, cur, wr, wc, fr, fq, lds, wid, lane); S.done(cur); }
#undef PG8_SA
#undef PG8_SB
#undef PG8_STAGE
#undef PG8_LDA
#undef PG8_LDB
#undef PG8_MMA
#undef PG8_WAIT_V
#undef PG8_WAIT_L
#undef PG8_BAR
#undef PG8_SCHED
}
}
namespace att {
constexpr int D = 128, PITCH = 2048, NW = 8, QBLK = 32, KVBLK = 64, QB = NW * QBLK;
constexpr int SHM_V = KVBLK * D * 2, SHM_K = KVBLK * D * 2;
constexpr int LDS_BIAS = 2 * SHM_V + 2 * SHM_K + NW * 64 * 4;
constexpr int NQX = 3, LDS_QX = LDS_BIAS + 512;
constexpr int LDS_BYTES = LDS_QX + NW * NQX * 1024;
constexpr float THR2 = 64.f;
constexpr bool WSKIP = false;
typedef __hip_bfloat16 bf16;
typedef short bf16x8 __attribute__((ext_vector_type(8)));
typedef short s16x4 __attribute__((ext_vector_type(4)));
typedef float f32x16 __attribute__((ext_vector_type(16)));
typedef float f32x4 __attribute__((ext_vector_type(4)));
typedef unsigned u32x4 __attribute__((ext_vector_type(4)));
template <class A, class Bt> struct same_t { static constexpr bool v = false; };
template <class A> struct same_t<A, A> { static constexpr bool v = true; };

#define KSWZ(row, colB) ((row) * 256 + ((colB) ^ (((row) & 7) << 4)))
#define SBAR() __builtin_amdgcn_sched_barrier(0)
__device__ __forceinline__ int v_st(int k, int c) { const int kk = (k & ~0xC) | ((k & 4) << 1) | ((k & 8) >> 1); return ((kk >> 3) * 4 + (c >> 5)) * 512 + ((kk & 7) * 32 + (c & 31)) * 2; }
__device__ __forceinline__ int v_rd_base(int lane) { return ((lane & 3) << 3) | (((lane >> 2) & 3) << 6) | (((lane >> 4) & 1) << 5) | (((lane >> 5) & 1) << 8); }
constexpr int v_rd_off(int d0, int ks, int half) { return d0 * 512 + ks * 4096 + half * 2048; }
__device__ __forceinline__ int crow(int r, int hi) { return (r & 3) + 8 * (r >> 2) + 4 * hi; }
__device__ __forceinline__ unsigned cvtpk(float lo, float hi) {
    unsigned r; asm volatile("v_cvt_pk_bf16_f32 %0, %1, %2" : "=v"(r) : "v"(lo), "v"(hi)); return r;
}
__device__ __forceinline__ bf16x8 pack8(f32x4 a, f32x4 b) {
    u32x4 w = {cvtpk(a[0], a[1]), cvtpk(a[2], a[3]), cvtpk(b[0], b[1]), cvtpk(b[2], b[3])};
    return *reinterpret_cast<bf16x8*>(&w);
}
template <class T> __device__ __forceinline__ bf16x8 load8(const T* p) {
    if constexpr (same_t<T, float>::v) { return pack8(*(const f32x4*)p, *(const f32x4*)(p + 4)); }
    else { return *reinterpret_cast<const bf16x8*>(p); }
}
__device__ __forceinline__ void mask_tile(f32x16& p0, f32x16& p1, int dq, unsigned W) {
    const float NEG = -__builtin_inff();
#pragma unroll
    for (int r = 0; r < 16; ++r) {
        const int c = (r & 3) + 8 * (r >> 2);
        if (dq - c < 0) p0[r] = NEG;
        if (dq - c - 32 < 0) p1[r] = NEG;
    }
}
__device__ __forceinline__ void partialSM(f32x16& p0, f32x16& p1, float& m_reg, float& mn, float& alpha) {
    float pmax = p0[0]; for (int r = 1; r < 16; ++r) pmax = fmaxf(pmax, p0[r]); for (int r = 0; r < 16; ++r) pmax = fmaxf(pmax, p1[r]);
    { auto rr = __builtin_amdgcn_permlane32_swap(__float_as_uint(pmax), __float_as_uint(pmax), false, false);
      pmax = fmaxf(__uint_as_float(rr[0]), __uint_as_float(rr[1])); }
    if (__builtin_expect(__all((pmax - m_reg) <= THR2), 1)) { mn = m_reg; alpha = 1.f; }
    else { mn = fmaxf(m_reg, pmax); alpha = __builtin_amdgcn_exp2f(m_reg - mn); m_reg = mn; }
    for (int r = 0; r < 16; ++r) p0[r] = p0[r] - mn; for (int r = 0; r < 16; ++r) p1[r] = p1[r] - mn;
    for (int r = 0; r < 16; ++r) p0[r] = __builtin_amdgcn_exp2f(p0[r]);
}
__device__ __forceinline__ void finishSM(f32x16& p0, f32x16& p1, float alpha, float& l_reg, bf16x8& pa0, bf16x8& pa1, bf16x8& pa2, bf16x8& pa3) {
    for (int r = 0; r < 16; ++r) p1[r] = __builtin_amdgcn_exp2f(p1[r]);
    float ps = 0; for (int r = 0; r < 16; ++r) ps += p0[r]; for (int r = 0; r < 16; ++r) ps += p1[r];
    { auto rr = __builtin_amdgcn_permlane32_swap(__float_as_uint(ps), __float_as_uint(ps), false, false);
      ps = __uint_as_float(rr[0]) + __uint_as_float(rr[1]); }
    l_reg = l_reg * alpha + ps;
#define PK4(P, B_, OUT) do { unsigned a0 = cvtpk(P[B_+0], P[B_+1]), a1 = cvtpk(P[B_+2], P[B_+3]);                          \
        unsigned b0 = cvtpk(P[B_+4], P[B_+5]), b1 = cvtpk(P[B_+6], P[B_+7]);                                             \
        auto r0 = __builtin_amdgcn_permlane32_swap(a0, b0, false, false); auto r1 = __builtin_amdgcn_permlane32_swap(a1, b1, false, false); \
        u32x4 w = {r0[0], r1[0], r0[1], r1[1]}; OUT = *reinterpret_cast<bf16x8*>(&w); } while (0)
    PK4(p0, 0, pa0); PK4(p0, 8, pa1); PK4(p1, 0, pa2); PK4(p1, 8, pa3);
#undef PK4
}
template <int KB, bool SK>
__device__ __forceinline__ void qkt(f32x16& p0, f32x16& p1, const char* K_lds, int r32, int hi, const bf16x8* qr, bool act, const char* qx) {
    if (SK && !act) { const float NEG = -__builtin_inff();
#pragma unroll
        for (int r = 0; r < 16; ++r) { p0[r] = NEG; p1[r] = NEG; } return; }
    { const float* bl = (const float*)(K_lds - 2 * SHM_V + LDS_BIAS) + KB * 64 + 4 * hi;
#pragma unroll
      for (int g = 0; g < 4; ++g) { const f32x4 u0 = *(const f32x4*)(bl + 8 * g), u1 = *(const f32x4*)(bl + 32 + 8 * g);
        p0[4*g] = u0[0]; p0[4*g+1] = u0[1]; p0[4*g+2] = u0[2]; p0[4*g+3] = u0[3]; p1[4*g] = u1[0]; p1[4*g+1] = u1[1]; p1[4*g+2] = u1[2]; p1[4*g+3] = u1[3]; } }
    const char* kb[4];
#pragma unroll
    for (int dd = 0; dd < 4; ++dd) kb[dd] = K_lds + KB * SHM_K + KSWZ(r32, (dd * 16 + hi * 8) * 2);
#pragma unroll
    for (int d0 = 0; d0 < 8; ++d0) { const char* a = kb[d0 & 3] + (d0 >> 2) * 128;
        bf16x8 b0 = *reinterpret_cast<const bf16x8*>(a);
        bf16x8 b1 = *reinterpret_cast<const bf16x8*>(a + 32 * 256);
        const bf16x8 qv = (d0 < 8 - NQX) ? qr[d0] : *reinterpret_cast<const bf16x8*>(qx + (d0 - (8 - NQX)) * 1024);
        p0 = __builtin_amdgcn_mfma_f32_32x32x16_bf16(b0, qv, p0, 0, 0, 0);
        p1 = __builtin_amdgcn_mfma_f32_32x32x16_bf16(b1, qv, p1, 0, 0, 0); }
}
template <int VB, bool SK>
__device__ __forceinline__ void pv_tile(f32x16* o, int vb0, bf16x8 pa0, bf16x8 pa1, bf16x8 pa2, bf16x8 pa3, bool act) {
    if (SK && !act) return;
#define TRRD(dst, off) asm volatile("ds_read_b64_tr_b16 %0, %1 offset:%2" : "=&v"(dst) : "v"(vb0), "i"(off) : "memory")
#define PV_D0(d0) do { s16x4 l0, l1, l2, l3, h0, h1, h2, h3; constexpr int b_ = VB * SHM_V + v_rd_off(d0, 0, 0);     \
        TRRD(l0, b_); TRRD(h0, b_ + 2048); TRRD(l1, b_ + 4096); TRRD(h1, b_ + 6144); TRRD(l2, b_ + 8192); TRRD(h2, b_ + 10240); TRRD(l3, b_ + 12288); TRRD(h3, b_ + 14336); \
        asm volatile("s_waitcnt lgkmcnt(0)" ::: "memory"); SBAR();                 \
        o[d0] = __builtin_amdgcn_mfma_f32_32x32x16_bf16(pa0, (bf16x8){l0[0], l0[1], l0[2], l0[3], h0[0], h0[1], h0[2], h0[3]}, o[d0], 0, 0, 0);   \
        o[d0] = __builtin_amdgcn_mfma_f32_32x32x16_bf16(pa1, (bf16x8){l1[0], l1[1], l1[2], l1[3], h1[0], h1[1], h1[2], h1[3]}, o[d0], 0, 0, 0);   \
        o[d0] = __builtin_amdgcn_mfma_f32_32x32x16_bf16(pa2, (bf16x8){l2[0], l2[1], l2[2], l2[3], h2[0], h2[1], h2[2], h2[3]}, o[d0], 0, 0, 0);   \
        o[d0] = __builtin_amdgcn_mfma_f32_32x32x16_bf16(pa3, (bf16x8){l3[0], l3[1], l3[2], l3[3], h3[0], h3[1], h3[2], h3[3]}, o[d0], 0, 0, 0); } while (0)
    PV_D0(0); PV_D0(1); PV_D0(2); PV_D0(3);
#undef PV_D0
#undef TRRD
}

template <class TIn, class TOut> struct BlockRef { const TIn* Q; const TIn* K; const TIn* V; TOut* O; const float* Bs; int P0; int nvalid; };
template <class TIn> struct Seam {
    bf16x8 qr[8];
    bf16x8 st_v0, st_v1, st_k0, st_k1; f32x4 sf0, sf1, sf2, sf3;
    f32x4 tq[16];
};
__device__ __forceinline__ int swa_jlo(int P0, int W) { const int lowk = P0 - W + 1; return lowk > 0 ? lowk / KVBLK : 0; }
#define ROW(p, k0, rr) ((p) + (size_t)((k0) + (rr)) * PITCH + sc)
#define VMW() asm volatile("s_waitcnt vmcnt(0)" ::: "memory")
#define VMWN(n) asm volatile("s_waitcnt vmcnt(%0)" :: "i"(n) : "memory")
#define GLDS(gp_, lp_, sz_) __builtin_amdgcn_global_load_lds((const unsigned*)(gp_), (__attribute__((address_space(3))) unsigned*)(lp_), sz_, 0, 0)
#define SLOAD_H(Kp, Vp, Bp, k0, bb_) do { S.st_v0 = load8<TIn>(ROW(Vp, k0, sr)); S.st_v1 = load8<TIn>(ROW(Vp, k0, 32 + sr));              \
                         { const TIn* kg_ = (Kp) + (size_t)(k0) * PITCH; char* kl_ = K_lds + (bb_) * SHM_K + wid * 2048; GLDS(kg_ + ksrc0, kl_, 16); GLDS(kg_ + ksrc1, kl_ + 1024, 16); } \
                         if (wid == 0) GLDS((Bp) + (k0) + lane, lds + LDS_BIAS + (bb_) * 256, 4); } while (0)
#define SWRITE_HK(bf) do { } while (0)
#define SWRITE_HV(bf) do { *(bf16x8*)(V_lds + (bf) * SHM_V + vst0) = S.st_v0; *(bf16x8*)(V_lds + (bf) * SHM_V + vst1) = S.st_v1; } while (0)
#define SWRITE_H(bf) do { SWRITE_HV(bf); SWRITE_HK(bf); } while (0)
#define SLOAD_F(p, k0) do { S.sf0 = *(const f32x4*)ROW(p, k0, sr); S.sf1 = *(const f32x4*)(ROW(p, k0, sr) + 4);                \
                            S.sf2 = *(const f32x4*)ROW(p, k0, 32 + sr); S.sf3 = *(const f32x4*)(ROW(p, k0, 32 + sr) + 4); } while (0)
#define SWRITE_KF(bf) do { *(bf16x8*)(K_lds + (bf) * SHM_K + kws) = pack8(S.sf0, S.sf1); *(bf16x8*)(K_lds + (bf) * SHM_K + kws + 32 * 256) = pack8(S.sf2, S.sf3); } while (0)
#define SWRITE_VF(bf) do { *(bf16x8*)(V_lds + (bf) * SHM_V + vst0) = pack8(S.sf0, S.sf1); *(bf16x8*)(V_lds + (bf) * SHM_V + vst1) = pack8(S.sf2, S.sf3); } while (0)
template <class TIn, class TOut>
__device__ __forceinline__ void causal_swa_prime(const BlockRef<TIn, TOut>& cur, int W, char* lds, Seam<TIn>& S, const int tid) {
    constexpr bool F32 = same_t<TIn, float>::v;
    const int wid = __builtin_amdgcn_readfirstlane(tid >> 6), lane = tid & 63, r32 = lane & 31, hi = lane >> 5;
    const int sr = tid >> 4, sc = (tid & 15) * 8, kws = KSWZ(sr, sc * 2); char* K_lds = lds + 2 * SHM_V; (void)kws;
    const int ksrc0 = (8 * wid + (lane >> 4)) * PITCH + ((lane & 15) ^ (lane >> 4)) * 8, ksrc1 = (8 * wid + 4 + (lane >> 4)) * PITCH + ((lane & 15) ^ (4 + (lane >> 4))) * 8;
    const int kb0 = swa_jlo(cur.P0, W) * KVBLK;
    for (int d0 = 0; d0 < 8; ++d0) S.qr[d0] = load8<TIn>(cur.Q + (size_t)(wid * QBLK + r32) * PITCH + d0 * 16 + hi * 8);
    if constexpr (F32) { SLOAD_F((const float*)cur.K, kb0); VMW(); SWRITE_KF(0); SBAR(); SLOAD_F((const float*)cur.V, kb0); }
    else { SLOAD_H(cur.K, cur.V, cur.Bs, kb0, 0); VMW(); SWRITE_HK(0); }
    __syncthreads();
}
template <class TIn, class TOut>
__device__ __forceinline__ void causal_swa_block(const BlockRef<TIn, TOut>& cur, const BlockRef<TIn, TOut>& nxt, int skv, int W, char* lds, Seam<TIn>& S, const int tid) {
    constexpr bool F32 = same_t<TIn, float>::v;
    const int wid = __builtin_amdgcn_readfirstlane(tid >> 6), lane = tid & 63, r32 = lane & 31, hi = lane >> 5;
    const int j_lo = swa_jlo(cur.P0, W);
    int j_hi = (cur.P0 + QB - 1) / KVBLK + 1; if (j_hi > skv / KVBLK) j_hi = skv / KVBLK;
    const int NT = j_hi - j_lo;
    const int kbn = swa_jlo(nxt.P0, W) * KVBLK;
    const int qlo = cur.P0 + wid * QBLK, qm = qlo + r32 - 4 * hi;
    char* V_lds = lds; char* K_lds = lds + 2 * SHM_V;
    float* ws = (float*)(lds + 2 * SHM_V + 2 * SHM_K) + wid * 64; float* li_l = ws, * al_l = ws + 32;
    float m_reg = -1e30f, l_reg = 0; f32x16 o[4] = {};
    const int sr = tid >> 4, sc = (tid & 15) * 8, vst0 = v_st(sr, sc), vst1 = v_st(32 + sr, sc), kws = KSWZ(sr, sc * 2);
    const int vb0 = (int)(uintptr_t)V_lds + v_rd_base(lane); (void)kws;
    const int ksrc0 = (8 * wid + (lane >> 4)) * PITCH + ((lane & 15) ^ (lane >> 4)) * 8, ksrc1 = (8 * wid + 4 + (lane >> 4)) * PITCH + ((lane & 15) ^ (4 + (lane >> 4))) * 8;
    const TIn* Kh = cur.K; const TIn* Vh = cur.V; const float* Bh = cur.Bs;
#define RESC(a) do { if (__any((a) < 1.f)) { if (hi == 0) al_l[r32] = (a); asm volatile("s_waitcnt lgkmcnt(0)" ::: "memory");              \
                     for (int d_ = 0; d_ < 4; ++d_) for (int r = 0; r < 16; ++r) o[d_][r] *= al_l[crow(r, hi)]; } } while (0)
#define KBASE(t) ((j_lo + (t)) * KVBLK)
#define ACT(t) (KBASE(t) <= qlo + QBLK - 1 && KBASE(t) + KVBLK - 1 >= qlo - W + 1)
#define MASKT(P0_, P1_, t) do { const int kb_ = KBASE(t); if ((!SK || ACT(t)) && (kb_ + KVBLK - 1 > qlo || kb_ <= qlo + QBLK - 1 - W)) mask_tile(P0_, P1_, qm - kb_, (unsigned)W); } while (0)
    constexpr int NQL = F32 ? 16 : 8;
    constexpr bool SK = WSKIP && !F32;
#define SEAM_K0() do { VMWN(NQL); if constexpr (F32) { SWRITE_KF(0); SBAR(); SLOAD_F((const float*)nxt.V, kbn); } else { SWRITE_HK(0); } SBAR(); } while (0)
    f32x16 pA0, pA1, pB0, pB1; float mnA, mnB, alA, alB; bf16x8 pa0, pa1, pa2, pa3;
    char* qx = lds + LDS_QX + wid * (NQX * 1024) + lane * 16;
#pragma unroll
    for (int e = 0; e < NQX; ++e) *reinterpret_cast<bf16x8*>(qx + e * 1024) = S.qr[8 - NQX + e];
    if constexpr (F32) { VMW(); SWRITE_VF(0); SBAR(); } else { SWRITE_HV(0); SBAR(); }
    if (NT > 1) { if constexpr (F32) SLOAD_F((const float*)Kh, KBASE(1)); else SLOAD_H(Kh, Vh, Bh, KBASE(1), 1); }
    SBAR(); qkt<0, SK>(pA0, pA1, K_lds, r32, hi, S.qr, ACT(0), qx);
    if constexpr (F32) { if (NT > 1) { VMW(); SWRITE_KF(1); SBAR(); SLOAD_F((const float*)Vh, KBASE(1)); } }
    MASKT(pA0, pA1, 0); partialSM(pA0, pA1, m_reg, mnA, alA);
    if (NT > 1) { VMW(); if constexpr (F32) { SWRITE_VF(1); SBAR(); if (NT > 2) SLOAD_F((const float*)Kh, KBASE(2)); } else SWRITE_H(1); }
    __syncthreads();
#define HALF_STEP(PX0, PX1, mnX, alX, PY0, PY1, alY, t, KB, VB, SB) do {                                                      \
        SBAR(); qkt<KB, SK>(PX0, PX1, K_lds, r32, hi, S.qr, ACT(t), qx);                                             \
        finishSM(PY0, PY1, alY, l_reg, pa0, pa1, pa2, pa3); SBAR();                                                           \
        if ((t) + 1 < NT) { if constexpr (F32) { VMW(); SWRITE_KF(SB); SBAR(); SLOAD_F((const float*)Vh, KBASE((t) + 1)); }  \
                            else { SLOAD_H(Kh, Vh, Bh, KBASE((t) + 1), SB); } SBAR(); }                                               \
        pv_tile<VB, SK>(o, vb0, pa0, pa1, pa2, pa3, ACT((t) - 1)); MASKT(PX0, PX1, (t)); partialSM(PX0, PX1, m_reg, mnX, alX);                                        \
        __syncthreads();                                                                                                      \
        if ((t) + 1 < NT) { VMW(); if constexpr (F32) { SWRITE_VF(SB); SBAR(); if ((t) + 2 < NT) SLOAD_F((const float*)Kh, KBASE((t) + 2)); } \
                            else { SWRITE_H(SB); } }                                                                          \
        RESC(alX); __syncthreads(); } while (0)
    for (int t = 1; t + 1 < NT; t += 2) {
        HALF_STEP(pB0, pB1, mnB, alB, pA0, pA1, alA, t, 1, 0, 0);
        HALF_STEP(pA0, pA1, mnA, alA, pB0, pB1, alB, t + 1, 0, 1, 1);
    }
    const bool even = (NT & 1) == 0;
    if (even) { SBAR(); qkt<1, SK>(pB0, pB1, K_lds, r32, hi, S.qr, ACT(NT - 1), qx); SBAR(); }
#define QROW(e) (nxt.Q + (size_t)(wid * QBLK + r32) * PITCH + ((e) >> 1) * 16 + hi * 8 + ((e) & 1) * 4)
    if constexpr (F32) { SLOAD_F((const float*)nxt.K, kbn); SBAR();
#pragma unroll
        for (int e = 0; e < 8; ++e) S.tq[e] = *(const f32x4*)QROW(e); }
    else { SLOAD_H(nxt.K, nxt.V, nxt.Bs, kbn, 0); SBAR();
#pragma unroll
        for (int d0 = 0; d0 < 8; ++d0) S.qr[d0] = load8<TIn>(nxt.Q + (size_t)(wid * QBLK + r32) * PITCH + d0 * 16 + hi * 8); }
    SBAR();
    finishSM(pA0, pA1, alA, l_reg, pa0, pa1, pa2, pa3); SBAR();
    if constexpr (F32) {
#pragma unroll
        for (int e = 8; e < 16; ++e) S.tq[e] = *(const f32x4*)QROW(e); SBAR(); }
#undef QROW
    pv_tile<0, SK>(o, vb0, pa0, pa1, pa2, pa3, ACT(even ? NT - 2 : NT - 1));
    if (even) { MASKT(pB0, pB1, NT - 1); partialSM(pB0, pB1, m_reg, mnB, alB); __syncthreads(); RESC(alB);
        finishSM(pB0, pB1, alB, l_reg, pa0, pa1, pa2, pa3); SBAR(); pv_tile<1, SK>(o, vb0, pa0, pa1, pa2, pa3, ACT(NT - 1)); }
    SBAR(); SEAM_K0();
    if (hi == 0) li_l[r32] = l_reg; asm volatile("s_waitcnt lgkmcnt(0)" ::: "memory");
    float rli[16];
#pragma unroll
    for (int r = 0; r < 16; ++r) rli[r] = __builtin_amdgcn_rcpf(li_l[crow(r, hi)]);
    int tidE = tid; asm volatile("" : "+v"(tidE));
    const int widE = __builtin_amdgcn_readfirstlane(tidE >> 6), r32E = tidE & 31, hiE = (tidE >> 5) & 1;
    TOut* Ow = cur.O + (size_t)(widE * QBLK) * PITCH; const bool wval = widE * QBLK < cur.nvalid;
    if (wval) {
#pragma unroll
    for (int r = 0; r < 16; ++r) { const int orow = crow(r, hiE);
#pragma unroll
        for (int d0 = 0; d0 < 4; ++d0) { const float v = o[d0][r] * rli[r];
            if constexpr (same_t<TOut, float>::v) { Ow[(size_t)orow * PITCH + d0 * 32 + r32E] = v; }
            else { const float vn = __shfl_xor(v, 1);
                   if ((r32E & 1) == 0) *(unsigned*)(Ow + (size_t)orow * PITCH + d0 * 32 + r32E) = cvtpk(v, vn); } } } }
    if constexpr (F32) {
#pragma unroll
        for (int d0 = 0; d0 < 8; ++d0) S.qr[d0] = pack8(S.tq[2 * d0], S.tq[2 * d0 + 1]); }
    __syncthreads();
#undef RESC
#undef KBASE
#undef ACT
#undef MASKT
#undef SEAM_K0
#undef HALF_STEP
}
#undef ROW
#undef VMW
#undef VMWN
#undef SLOAD_H
#undef GLDS
#undef SWRITE_HK
#undef SWRITE_HV
#undef SWRITE_H
#undef SLOAD_F
#undef SWRITE_KF
#undef SWRITE_VF

}
typedef unsigned short u16;
typedef float f32x4 __attribute__((ext_vector_type(4)));
typedef unsigned u32x4 __attribute__((ext_vector_type(4)));
typedef unsigned u32x2 __attribute__((ext_vector_type(2)));
typedef short bf16x8 __attribute__((ext_vector_type(8)));
constexpr int DM = 2048, TP = 8192, NBP = 4, NBS = 8, TS = 64, PAST = 2048, SKVS = PAST + TS;
constexpr int MP = NBP * TP, MS_ = NBS * TS, M = MP + MS_;
constexpr int DI = 4096, CD = 6144, NH = 64, DFF = 5504, DFF2 = 11008, NIN = 20560;
constexpr int NMOD = 12288;
constexpr float EPS = 1e-6f, LOG2E = 1.4426950408889634f;
constexpr int HALF_ROWS = 16640;
constexpr size_t O_YP = 0, O_YS = O_YP + (size_t)MP * DM, O_KP = O_YS + (size_t)MS_ * DM, O_VP = O_KP + (size_t)MP * DM,
    O_LFP = O_VP + (size_t)MP * DM, O_SSMP = O_LFP + (size_t)MP * 16, O_MCP = O_SSMP + (size_t)NBP * 64 * 64 * 128, O_FCP = O_MCP + (size_t)NBP * 3 * CD,
    O_KS = O_FCP + (size_t)NBP * 2 * DFF2, O_VS = O_KS + (size_t)MS_ * DM, O_LFS = O_VS + (size_t)MS_ * DM, O_SSMS = O_LFS + (size_t)MS_ * 16,
    O_MCS = O_SSMS + (size_t)NBS * 64 * 64 * 128, O_FCS = O_MCS + (size_t)NBS * 3 * CD, O_END = O_FCS + (size_t)NBS * 2 * DFF2;
constexpr size_t MiB = 1u << 20;
constexpr size_t W_MOD = 0, W_BIASP = 1 * MiB, W_BIASS = 3 * MiB, W_HALO = 5 * MiB,
    W_WUP = 8 * MiB, W_WDN = 51 * MiB, W_H = 73 * MiB, W_WIN = 203 * MiB, W_WPM = 284 * MiB, W_WPF = 300 * MiB, W_WOUT = 308 * MiB,
    W_SMALL = 316 * MiB, W_R = 349 * MiB,
    W_XBC = W_R, W_Z = W_R + 390 * MiB, W_GM = W_R, W_GF = W_R + 130 * MiB, W_Q = W_R + 260 * MiB, W_K = W_Q + 130 * MiB, W_V = W_K + 130 * MiB,
    W_U = 203 * MiB, W_G = 553 * MiB, W_END = 999 * MiB;
static_assert((size_t)M * DM * 2 == 130 * MiB && (size_t)M * CD * 2 == 390 * MiB && (size_t)M * DI * 2 == 260 * MiB, "sizes");
static_assert(W_U + (size_t)HALF_ROWS * DFF2 * 2 <= W_G && W_G + (size_t)M * DFF * 2 <= 1024 * MiB, "ffn map");
static_assert(W_SMALL + (size_t)M * 256 * 4 <= W_R, "small map");

struct Prm { const float* in[31]; float* out; unsigned char* ws; };
typedef const __attribute__((address_space(4))) Prm* KPrm;
struct Ctx { int tid, bid, G; };
enum { I_XP = 0, I_XS, I_CP, I_CS, I_CK, I_CV, I_CLF, I_SSM, I_MCV, I_FCV, I_N1W, I_N2W, I_WADA, I_BADA, I_WIN, I_MCW, I_MCB, I_DTB, I_ALOG, I_MD, I_MNW,
       I_FB, I_QNW, I_KNW, I_WPM, I_WPF, I_WOUT, I_WUP, I_FCW, I_FCB, I_WDN };

__device__ __forceinline__ float bflo(unsigned w) { return __uint_as_float(w << 16); }
__device__ __forceinline__ float bfhi(unsigned w) { return __uint_as_float(w & 0xffff0000u); }
typedef float f32x2_t __attribute__((ext_vector_type(2))); typedef __bf16 bf16x2_t __attribute__((ext_vector_type(2)));
__device__ __forceinline__ unsigned pk2(float lo, float hi) { f32x2_t v = {lo, hi}; bf16x2_t b = __builtin_convertvector(v, bf16x2_t); return __builtin_bit_cast(unsigned, b); }
__device__ __forceinline__ u16 f2bf(float f) { return (u16)(pk2(f, 0.f) & 0xffffu); }
__device__ __forceinline__ void unpack8(u32x4 w, float* v) { v[0] = bflo(w.x); v[1] = bfhi(w.x); v[2] = bflo(w.y); v[3] = bfhi(w.y); v[4] = bflo(w.z); v[5] = bfhi(w.z); v[6] = bflo(w.w); v[7] = bfhi(w.w); }
__device__ __forceinline__ u32x4 pack8f(const float* v) { u32x4 w; w.x = pk2(v[0], v[1]); w.y = pk2(v[2], v[3]); w.z = pk2(v[4], v[5]); w.w = pk2(v[6], v[7]); return w; }
__device__ __forceinline__ float bfel(const u32x4& w, int e) { const unsigned x = w[e >> 1]; return (e & 1) ? bfhi(x) : bflo(x); }
__device__ __forceinline__ float sigmoidf_(float x) { return 1.f / (1.f + __expf(-x)); }
__device__ __forceinline__ float siluf_(float x) { return x / (1.f + __expf(-x)); }
__device__ __forceinline__ float wave_sum(float v) {
#pragma unroll
    for (int o = 1; o < 64; o <<= 1) v += __shfl_xor(v, o);
    return v;
}
__device__ __forceinline__ int mod_row(int row) { return row < MP ? (row >> 13) : 4 + ((row - MP) >> 6); }

struct Epi {
    static constexpr bool PERM = true, AFTER_DRAIN = false;
    int mode;
    u16* d0; u16* d1; u16* d2; int t1, t2, p0, p1, p2, f32seg2;
    const float* xp; const float* xs; float* y; const float* mod; u16* gbuf; const u16* gf;
    __device__ __forceinline__ void operator()(const f32x4 (&acc)[2][2][4][2], const pg8::Unit& u, int wr, int wc, int fr, int fq) const {
        const int rl = u.pm * 256 + wr * 64 + fr, cl = wc * 32 + 8 * fq;
        if (mode == 0) {
            u16* base; int pitch, ct; bool f32o = false;
            if (u.pn < t1) { base = d0; pitch = p0; ct = u.pn; } else if (u.pn < t2) { base = d1; pitch = p1; ct = u.pn - t1; } else { base = d2; pitch = p2; ct = u.pn - t2; f32o = (f32seg2 != 0); }
            if (!f32o) {
#pragma unroll
                for (int ai = 0; ai < 2; ++ai)
#pragma unroll
                    for (int m = 0; m < 4; ++m) { u16* rp = base + (size_t)(rl + ai * 128 + m * 16) * pitch + ct * 256 + cl;
#pragma unroll
                        for (int bj = 0; bj < 2; ++bj) { const f32x4 v0 = acc[ai][bj][m][0], v1 = acc[ai][bj][m][1]; u32x4 w; w.x = pk2(v0[0], v0[1]); w.y = pk2(v0[2], v0[3]); w.z = pk2(v1[0], v1[1]); w.w = pk2(v1[2], v1[3]);
                            *(u32x4*)(rp + bj * 128) = w; } }
            } else {
                float* fb = (float*)base;
#pragma unroll
                for (int ai = 0; ai < 2; ++ai)
#pragma unroll
                    for (int m = 0; m < 4; ++m) { float* rp = fb + (size_t)(rl + ai * 128 + m * 16) * pitch + ct * 256 + cl;
#pragma unroll
                        for (int bj = 0; bj < 2; ++bj) { *(f32x4*)(rp + bj * 128) = acc[ai][bj][m][0]; *(f32x4*)(rp + bj * 128 + 4) = acc[ai][bj][m][1]; } }
            }
        } else if (mode == 1 || mode == 2) {
#pragma unroll
            for (int ai = 0; ai < 2; ++ai)
#pragma unroll
                for (int m = 0; m < 4; ++m) { const size_t off = (size_t)(rl + ai * 128 + m * 16) * DM + u.pn * 256 + cl;
#pragma unroll
                    for (int bj = 0; bj < 2; ++bj) { const f32x4 v0 = acc[ai][bj][m][0], v1 = acc[ai][bj][m][1];
                        float a[8] = {v0[0], v0[1], v0[2], v0[3], v1[0], v1[1], v1[2], v1[3]}, g[8], o[8];
                        unpack8(*(const u32x4*)(gbuf + off + bj * 128), g);
                        if (mode == 1) {
#pragma unroll
                            for (int e = 0; e < 8; ++e) o[e] = sigmoidf_(g[e]) * a[e];
                        } else { float f[8]; unpack8(*(const u32x4*)(gf + off + bj * 128), f);
#pragma unroll
                            for (int e = 0; e < 8; ++e) o[e] = g[e] + sigmoidf_(f[e]) * a[e]; }
                        *(u32x4*)(gbuf + off + bj * 128) = pack8f(o); } }
        } else {
#pragma unroll
            for (int ai = 0; ai < 2; ++ai) {
                const int mb = (u.pm < 128) ? (u.pm >> 5) : (4 + (u.pm - 128) * 4 + ai * 2 + wr);
                const float* gp = mod + (size_t)mb * NMOD + (mode == 3 ? 4096 : 10240) + u.pn * 256 + cl;
                f32x4 gv[2][2];
#pragma unroll
                for (int bj = 0; bj < 2; ++bj) { gv[bj][0] = *(const f32x4*)(gp + bj * 128); gv[bj][1] = *(const f32x4*)(gp + bj * 128 + 4); }
#pragma unroll
                for (int m = 0; m < 4; ++m) { const int row = rl + ai * 128 + m * 16; const size_t off = (size_t)row * DM + u.pn * 256 + cl;
                    const float* xr = (mode == 3) ? ((row < MP) ? xp + off : xs + (off - (size_t)MP * DM)) : (const float*)(y + off);
#pragma unroll
                    for (int bj = 0; bj < 2; ++bj) { const f32x4 b0 = *(const f32x4*)(xr + bj * 128), b1 = *(const f32x4*)(xr + bj * 128 + 4);
                        *(f32x4*)(y + off + bj * 128) = b0 + gv[bj][0] * acc[ai][bj][m][0]; *(f32x4*)(y + off + bj * 128 + 4) = b1 + gv[bj][1] * acc[ai][bj][m][1]; } }
            }
        }
    }
};

__device__ __forceinline__ int map_in(int n) {
    if (n < 4096) return 6144 + n;
    if (n < 10240) return n - 4096;
    if (n < 10304) return 10240 + (n - 10240);
    if (n < 12352) return 14592 + (n - 10304);
    if (n < 14400) return 16640 + (n - 12352);
    if (n < 16448) return 18688 + (n - 14400);
    if (n < 16464) return 10304 + (n - 16448);
    if (n < 18512) return 10496 + (n - 16464);
    return 12544 + (n - 18512);
}
__device__ __forceinline__ int map_up(int n) { if (n < DFF) return (n >> 7) * 256 + (n & 127); const int f = n - DFF; return (f >> 7) * 256 + 128 + (f & 127); }
template <int MAP> __device__ __forceinline__ void tr_item(const float* __restrict__ W, int K, int N, u16* WT, float* scr, int item, int lane) {
    const int nblk = (N + 31) / 32, kb = item / nblk, nb = item % nblk, k0 = 64 * kb, n0 = 32 * nb;
    const int nn = n0 + (lane & 31);
#pragma unroll 8
    for (int i = 0; i < 32; ++i) { const int kk = 2 * i + (lane >> 5); scr[kk * 33 + (lane & 31)] = (nn < N) ? W[(size_t)(k0 + kk) * N + nn] : 0.f; }
    asm volatile("s_waitcnt lgkmcnt(0)" ::: "memory");
    const int c = lane & 7;
#pragma unroll
    for (int j = 0; j < 4; ++j) { const int n = (lane >> 3) + 8 * j; const float* s = scr + (8 * c) * 33 + n;
        if (n0 + n < N) { const int row = (MAP == 1) ? map_in(n0 + n) : (MAP == 2) ? map_up(n0 + n) : (n0 + n);
            u32x4 o; o.x = pk2(s[0 * 33], s[1 * 33]); o.y = pk2(s[2 * 33], s[3 * 33]); o.z = pk2(s[4 * 33], s[5 * 33]); o.w = pk2(s[6 * 33], s[7 * 33]);
            *(u32x4*)(WT + (size_t)row * K + k0 + 8 * c) = o; } }
    asm volatile("s_waitcnt lgkmcnt(0)" ::: "memory");
}
__device__ __forceinline__ void phase_prep(KPrm p, const Ctx cx, unsigned char* lds) {
    const int tid = cx.tid, lane = tid & 63, wid = tid >> 6, G = cx.G;
    unsigned char* ws = p->ws;
    {
        float* scr = (float*)(lds + wid * 8448);
        const int gw = cx.bid * 8 + wid, NGW = G * 8;
        constexpr int I_IN = 32 * 643, I_PM = 64 * 64, I_PF = 32 * 64, I_OUT = 32 * 64, I_UP = 32 * 344, I_DN = 86 * 64;
        constexpr int NIT = I_IN + I_PM + I_PF + I_OUT + I_UP + I_DN;
        for (int it = gw; it < NIT; it += NGW) {
            int r = it;
            if (r < I_IN) { tr_item<1>(p->in[I_WIN], DM, NIN, (u16*)(ws + W_WIN), scr, r, lane); continue; } r -= I_IN;
            if (r < I_PM) { tr_item<0>(p->in[I_WPM], DI, DM, (u16*)(ws + W_WPM), scr, r, lane); continue; } r -= I_PM;
            if (r < I_PF) { tr_item<0>(p->in[I_WPF], DM, DM, (u16*)(ws + W_WPF), scr, r, lane); continue; } r -= I_PF;
            if (r < I_OUT) { tr_item<0>(p->in[I_WOUT], DM, DM, (u16*)(ws + W_WOUT), scr, r, lane); continue; } r -= I_OUT;
            if (r < I_UP) { tr_item<2>(p->in[I_WUP], DM, DFF2, (u16*)(ws + W_WUP), scr, r, lane); continue; } r -= I_UP;
            tr_item<0>(p->in[I_WDN], DFF, DM, (u16*)(ws + W_WDN), scr, r, lane);
        }
    }
    __syncthreads();
    {
        float* sl = (float*)lds;
        float* red = (float*)(lds + 12 * 2048 * 4);
        for (int e = tid; e < 12 * 2048; e += 512) { const int b = e >> 11, i = e & 2047; const float cv = (b < 4) ? p->in[I_CP][b * 2048 + i] : p->in[I_CS][(b - 4) * 2048 + i]; sl[e] = siluf_(cv); }
        __syncthreads();
        const float* wada = p->in[I_WADA]; float* mod = (float*)(ws + W_MOD);
        const int col = tid & 31, part = tid >> 5;
        for (int item = cx.bid; item < NMOD / 32; item += G) {
            float acc[12];
#pragma unroll
            for (int b = 0; b < 12; ++b) acc[b] = 0.f;
            const float* wp = wada + (size_t)(part * 128) * NMOD + item * 32 + col;
#pragma unroll 4
            for (int d = 0; d < 128; ++d) { const float w = wp[(size_t)d * NMOD];
#pragma unroll
                for (int b = 0; b < 12; ++b) acc[b] += sl[b * 2048 + part * 128 + d] * w; }
#pragma unroll
            for (int b = 0; b < 12; ++b) red[(part * 12 + b) * 32 + col] = acc[b];
            __syncthreads();
            if (tid < 384) { const int b = tid >> 5; float s = p->in[I_BADA][item * 32 + col];
#pragma unroll
                for (int q = 0; q < 16; ++q) s += red[(q * 12 + b) * 32 + col];
                mod[b * NMOD + item * 32 + col] = s; }
            __syncthreads();
        }
    }
    {
        u16* Ks = (u16*)p->out; u16* Vs = Ks + (size_t)NBS * SKVS * DM;
        const size_t tot8 = (size_t)NBS * PAST * DM / 8, gt = (size_t)cx.bid * 512 + tid, GT = (size_t)G * 512;
        for (size_t i = gt; i < 2 * tot8; i += GT) { const int which = i >= tot8; const size_t j = i - (which ? tot8 : 0);
            const size_t sb = j / ((size_t)PAST * 256), rem = j % ((size_t)PAST * 256), row = rem >> 8, c8 = rem & 255;
            const float* src = p->in[which ? I_CV : I_CK] + ((sb * PAST + row) * DM + c8 * 8);
            const f32x4 a = *(const f32x4*)src, b = *(const f32x4*)(src + 4);
            u32x4 o; o.x = pk2(a[0], a[1]); o.y = pk2(a[2], a[3]); o.z = pk2(b[0], b[1]); o.w = pk2(b[2], b[3]);
            *(u32x4*)((which ? Vs : Ks) + ((sb * SKVS + row) * DM + c8 * 8)) = o; }
    }
}
__device__ __forceinline__ void phase_norm(KPrm p, const Ctx cx, int which) {
    const int tid = cx.tid, lane = tid & 63, wid = tid >> 6;
    const int gw = cx.bid * 8 + wid, NGW = cx.G * 8;
    const float* mod = (const float*)(p->ws + W_MOD); u16* H = (u16*)(p->ws + W_H);
    const float* nw = p->in[which ? I_N2W : I_N1W];
    const int osh = which ? 6144 : 0, osc = which ? 8192 : 2048;
    for (int row = gw; row < M; row += NGW) {
        const float* xr = which ? (p->out + (size_t)row * DM) : ((row < MP) ? p->in[I_XP] + (size_t)row * DM : p->in[I_XS] + (size_t)(row - MP) * DM);
        const float* mr = mod + (size_t)mod_row(row) * NMOD;
        f32x4 v[8]; float ss = 0.f;
#pragma unroll
        for (int j = 0; j < 8; ++j) { v[j] = ((const f32x4*)xr)[lane + 64 * j]; ss += (v[j][0] * v[j][0] + v[j][1] * v[j][1]) + (v[j][2] * v[j][2] + v[j][3] * v[j][3]); }
        const float rs = rsqrtf(wave_sum(ss) * (1.f / DM) + EPS);
#pragma unroll
        for (int j = 0; j < 8; ++j) { const int col = 4 * (lane + 64 * j);
            const f32x4 w = *(const f32x4*)(nw + col), sc = *(const f32x4*)(mr + osc + col), sh = *(const f32x4*)(mr + osh + col);
            const f32x4 o = v[j] * rs * w * (sc + 1.f) + sh;
            u32x2 q; q.x = pk2(o[0], o[1]); q.y = pk2(o[2], o[3]);
            *(u32x2*)(H + (size_t)row * DM + col) = q; }
    }
}
__device__ __forceinline__ void phase_conv(KPrm p, const Ctx cx) {
    const u16* XBC = (const u16*)(p->ws + W_XBC); u16* ACT = (u16*)(p->out + O_KP);
    const float* cw = p->in[I_MCW]; const float* cb = p->in[I_MCB];
    constexpr int NCG = CD / 8, RB = 16, NRB = M / RB;
    const long gt = (long)cx.bid * 512 + cx.tid, GT = (long)cx.G * 512;
    for (long it = gt; it < (long)NCG * NRB; it += GT) {
        const int cgi = (int)(it % NCG), rb = (int)(it / NCG), c0 = cgi * 8, r0 = rb * RB;
        float w[4][8], bs[8];
#pragma unroll
        for (int j = 0; j < 4; ++j) { const f32x4 a0 = *(const f32x4*)(cw + j * CD + c0), a1 = *(const f32x4*)(cw + j * CD + c0 + 4);
#pragma unroll
            for (int e = 0; e < 4; ++e) { w[j][e] = a0[e]; w[j][4 + e] = a1[e]; } }
        { const f32x4 a0 = *(const f32x4*)(cb + c0), a1 = *(const f32x4*)(cb + c0 + 4);
#pragma unroll
          for (int e = 0; e < 4; ++e) { bs[e] = a0[e]; bs[4 + e] = a1[e]; } }
        float h[3][8];
        const bool smp = r0 >= MP; const int tb = smp ? ((r0 - MP) & 63) : (r0 & (TP - 1));
        if (tb == 0) {
            if (smp) { const float* s = p->in[I_MCV] + (size_t)((r0 - MP) >> 6) * 3 * CD + c0;
#pragma unroll
                for (int k = 0; k < 3; ++k)
#pragma unroll
                    for (int e = 0; e < 8; ++e) h[k][e] = s[k * CD + e];
            } else {
#pragma unroll
                for (int k = 0; k < 3; ++k)
#pragma unroll
                    for (int e = 0; e < 8; ++e) h[k][e] = 0.f; }
        } else {
#pragma unroll
            for (int k = 0; k < 3; ++k) unpack8(*(const u32x4*)(XBC + (size_t)(r0 - 3 + k) * CD + c0), h[k]);
        }
#pragma unroll 4
        for (int i = 0; i < RB; ++i) { float u[8], o[8]; unpack8(*(const u32x4*)(XBC + (size_t)(r0 + i) * CD + c0), u);
#pragma unroll
            for (int e = 0; e < 8; ++e) { const float v = bs[e] + w[0][e] * h[0][e] + w[1][e] * h[1][e] + w[2][e] * h[2][e] + w[3][e] * u[e];
                o[e] = siluf_(v); h[0][e] = h[1][e]; h[1][e] = h[2][e]; h[2][e] = u[e]; }
            *(u32x4*)(ACT + (size_t)(r0 + i) * CD + c0) = pack8f(o); }
    }
}
constexpr int SXP = 72, SNP = 136, SYP = 68;
constexpr int L_XT = 0, L_CN = L_XT + 64 * SXP * 2, L_BN = L_CN + 64 * SNP * 2, L_BWT = L_BN + 64 * SNP * 2, L_MS = L_BWT + 128 * SXP * 2, L_HS = L_MS + 64 * SXP * 2,
              L_YS = L_HS + 64 * SNP * 2, L_DT = L_YS + 64 * SYP * 4, L_CUM = L_DT + 256, L_SSD_END = L_CUM + 256;
static_assert(L_SSD_END <= 131072, "ssd lds");
__device__ __forceinline__ void phase_ssd(KPrm p, const Ctx cx, unsigned char* lds) {
    const int tid = cx.tid, lane = tid & 63, wid = __builtin_amdgcn_readfirstlane(tid >> 6), quad = lane >> 4, l15 = lane & 15;
    u16* XT = (u16*)(lds + L_XT); u16* CN = (u16*)(lds + L_CN); u16* BN = (u16*)(lds + L_BN); u16* BWT = (u16*)(lds + L_BWT);
    u16* MSm = (u16*)(lds + L_MS); u16* HS = (u16*)(lds + L_HS); float* YS = (float*)(lds + L_YS); float* DT = (float*)(lds + L_DT); float* CUM = (float*)(lds + L_CUM);
    const u16* XBC = (const u16*)(p->out + O_KP);     u16* Z = (u16*)(p->ws + W_Z); const float* SM = (const float*)(p->ws + W_SMALL);
    const int cg8 = tid & 31, tq = tid >> 5, cgx = tid & 7, tx = tid >> 3;
    const int pb = wid >> 1;
    for (int ch = cx.bid; ch < 256 + 512; ch += cx.G) {
        const bool smp = ch >= 256; int b, hd, nc; long rowbase;
        if (!smp) { b = ch >> 6; hd = ch & 63; nc = TP / 64; rowbase = (long)b * TP; } else { const int su = ch - 256; b = su >> 6; hd = su & 63; nc = 1; rowbase = MP + (long)b * TS; }
        const int g = hd >> 3;
        const float a_h = -__expf(p->in[I_ALOG][hd]), dtb = p->in[I_DTB][hd], Dh = p->in[I_MD][hd];
        const int bccol = (cg8 < 16) ? (4096 + g * 128 + cg8 * 8) : (5120 + g * 128 + (cg8 - 16) * 8);
        const int xcol = hd * 64 + cgx * 8;
        f32x4 st[4];
        const int st_off = (pb * 16 + quad * 4) * 128 + (4 * (wid & 1)) * 16 + l15, hs_off = (pb * 16 + quad * 4) * SNP + (4 * (wid & 1)) * 16 + l15;
        { const float* sin_ = p->in[I_SSM] + ((size_t)b * 64 + hd) * 64 * 128 + st_off;
#pragma unroll
          for (int i = 0; i < 4; ++i)
#pragma unroll
            for (int j = 0; j < 4; ++j) st[i][j] = smp ? sin_[j * 128 + i * 16] : 0.f; }
        __syncthreads();
        { u16* hp_ = HS + hs_off;
#pragma unroll
          for (int i = 0; i < 4; ++i)
#pragma unroll
            for (int j = 0; j < 4; ++j) hp_[j * SNP + i * 16] = f2bf(st[i][j]); }
        u32x4 rbc[4], rx, zn, pend = {0u, 0u, 0u, 0u}; float dtr = 0.f;
#define SSD_LOADS(cc) do { const int t0_ = (cc) * 64; \
            const u16* pb_ = XBC + (rowbase + t0_ + 4 * tq) * (long)CD + bccol; const u16* px_ = XBC + (rowbase + t0_ + tx) * (long)CD + xcol; \
            asm volatile("" : "+v"(pb_), "+v"(px_));     \
            _Pragma("unroll") for (int i = 0; i < 4; ++i) rbc[i] = *(const u32x4*)(pb_ + i * CD); \
            rx = *(const u32x4*)px_; \
            zn = *(const u32x4*)(Z + (size_t)(rowbase + t0_ + tx) * DI + xcol); \
            dtr = SM[(size_t)(rowbase + t0_ + lane) * 256 + hd]; } while (0)
#define LBAR() do { asm volatile("s_waitcnt lgkmcnt(0)" ::: "memory"); __builtin_amdgcn_s_barrier(); asm volatile("" ::: "memory"); } while (0)
        SSD_LOADS(0);
        for (int c = 0; c < nc; ++c) {
            const long r0 = rowbase + (long)c * 64;
            const u32x4 zw = zn;
            float cum_end;
            { const float dr = dtr + dtb; const float dtv = dr > 20.f ? dr : __logf(1.f + __expf(dr));
              float x = dtv * a_h;
#define DPP_ADD(ctrl, rmask) x += __int_as_float(__builtin_amdgcn_update_dpp(0, __float_as_int(x), ctrl, rmask, 0xf, true))
              DPP_ADD(0x111, 0xf); DPP_ADD(0x112, 0xf); DPP_ADD(0x114, 0xf); DPP_ADD(0x118, 0xf);
              DPP_ADD(0x142, 0xa);
              DPP_ADD(0x143, 0xc);
#undef DPP_ADD
              DT[lane] = dtv; CUM[lane] = x; cum_end = __int_as_float(__builtin_amdgcn_readlane(__float_as_int(x), 63)); }
            {
                u16* NAT = (cg8 < 16) ? BN : CN; const int nc0 = (cg8 & 15) * 8;
#pragma unroll
                for (int ii = 0; ii < 4; ++ii) *(u32x4*)(NAT + (4 * tq + ii) * SNP + nc0) = rbc[ii];
                if (cg8 < 16) {
                    float wg[4]; const f32x4 dt4 = *(const f32x4*)(DT + 4 * tq), cu4 = *(const f32x4*)(CUM + 4 * tq);
#pragma unroll
                    for (int ii = 0; ii < 4; ++ii) wg[ii] = dt4[ii] * __expf(cum_end - cu4[ii]);
#pragma unroll
                    for (int e = 0; e < 8; ++e) { u32x2 q; q.x = pk2(bfel(rbc[0], e) * wg[0], bfel(rbc[1], e) * wg[1]); q.y = pk2(bfel(rbc[2], e) * wg[2], bfel(rbc[3], e) * wg[3]);
                        *(u32x2*)(BWT + (nc0 + e) * SXP + 4 * tq) = q; }
                }
            }
            float xv[8]; unpack8(rx, xv);
#pragma unroll
            for (int e = 0; e < 8; ++e) XT[(cgx * 8 + e) * SXP + tx] = (u16)((e & 1) ? (rx[e >> 1] >> 16) : (rx[e >> 1] & 0xffffu));
            LBAR();
            if (c > 0) *(u32x4*)(Z + (size_t)(r0 - 64 + tx) * DI + xcol) = pend;
            if (c + 1 < nc) SSD_LOADS(c + 1);
            const int ti = wid >> 1;
            f32x4 yo[2];
            {
                bf16x8 ca[4], bb[2][4], hb[2][4];
#pragma unroll
                for (int kk = 0; kk < 4; ++kk) ca[kk] = *(const bf16x8*)(CN + (ti * 16 + l15) * SNP + kk * 32 + quad * 8);
#pragma unroll
                for (int s2 = 0; s2 < 2; ++s2)
#pragma unroll
                    for (int kk = 0; kk < 4; ++kk) { bb[s2][kk] = *(const bf16x8*)(BN + ((2 * (wid & 1) + s2) * 16 + l15) * SNP + kk * 32 + quad * 8);
                        hb[s2][kk] = *(const bf16x8*)(HS + ((2 * (wid & 1) + s2) * 16 + l15) * SNP + kk * 32 + quad * 8); }
                const f32x4 ct4 = *(const f32x4*)(CUM + ti * 16 + quad * 4);
                float cs[2], ds[2];
#pragma unroll
                for (int s2 = 0; s2 < 2; ++s2) { const int sx = (2 * (wid & 1) + s2) * 16 + l15; cs[s2] = CUM[sx]; ds[s2] = DT[sx]; }
                f32x4 ga[2] = {{0.f, 0.f, 0.f, 0.f}, {0.f, 0.f, 0.f, 0.f}}; yo[0] = (f32x4){0.f, 0.f, 0.f, 0.f}; yo[1] = (f32x4){0.f, 0.f, 0.f, 0.f};
#pragma unroll
                for (int kk = 0; kk < 4; ++kk) {
                    ga[0] = __builtin_amdgcn_mfma_f32_16x16x32_bf16(ca[kk], bb[0][kk], ga[0], 0, 0, 0); ga[1] = __builtin_amdgcn_mfma_f32_16x16x32_bf16(ca[kk], bb[1][kk], ga[1], 0, 0, 0);
                    yo[0] = __builtin_amdgcn_mfma_f32_16x16x32_bf16(ca[kk], hb[0][kk], yo[0], 0, 0, 0); yo[1] = __builtin_amdgcn_mfma_f32_16x16x32_bf16(ca[kk], hb[1][kk], yo[1], 0, 0, 0); }
#pragma unroll
                for (int s2 = 0; s2 < 2; ++s2) { const int s_ = (2 * (wid & 1) + s2) * 16 + l15;
#pragma unroll
                    for (int j = 0; j < 4; ++j) { const int t = ti * 16 + quad * 4 + j; const float msk = (s_ <= t) ? ds[s2] : 0.f;
                        const float val = ga[s2][j] * __expf(fminf(ct4[j] - cs[s2], 0.f)) * msk; MSm[t * SXP + s_] = f2bf(val); } }
#pragma unroll
                for (int p2 = 0; p2 < 2; ++p2)
#pragma unroll
                    for (int j = 0; j < 4; ++j) yo[p2][j] *= __expf(ct4[j]);
            }
            LBAR();
            {
                bf16x8 ma[2], xa[2], xb[2][2], wb[4][2];
#pragma unroll
                for (int kk = 0; kk < 2; ++kk) { ma[kk] = *(const bf16x8*)(MSm + (ti * 16 + l15) * SXP + kk * 32 + quad * 8); xa[kk] = *(const bf16x8*)(XT + (pb * 16 + l15) * SXP + kk * 32 + quad * 8);
#pragma unroll
                    for (int p2 = 0; p2 < 2; ++p2) xb[p2][kk] = *(const bf16x8*)(XT + ((2 * (wid & 1) + p2) * 16 + l15) * SXP + kk * 32 + quad * 8);
#pragma unroll
                    for (int i = 0; i < 4; ++i) wb[i][kk] = *(const bf16x8*)(BWT + ((4 * (wid & 1) + i) * 16 + l15) * SXP + kk * 32 + quad * 8); }
                const float dec = __expf(cum_end);
#pragma unroll
                for (int i = 0; i < 4; ++i) st[i] = st[i] * dec;
#pragma unroll
                for (int kk = 0; kk < 2; ++kk) {
                    yo[0] = __builtin_amdgcn_mfma_f32_16x16x32_bf16(ma[kk], xb[0][kk], yo[0], 0, 0, 0); yo[1] = __builtin_amdgcn_mfma_f32_16x16x32_bf16(ma[kk], xb[1][kk], yo[1], 0, 0, 0);
#pragma unroll
                    for (int i = 0; i < 4; ++i) st[i] = __builtin_amdgcn_mfma_f32_16x16x32_bf16(xa[kk], wb[i][kk], st[i], 0, 0, 0); }
#pragma unroll
                for (int p2 = 0; p2 < 2; ++p2)
#pragma unroll
                    for (int j = 0; j < 4; ++j) YS[(ti * 16 + quad * 4 + j) * SYP + (2 * (wid & 1) + p2) * 16 + l15] = yo[p2][j];
                u16* hp_ = HS + hs_off;
#pragma unroll
                for (int i = 0; i < 4; ++i)
#pragma unroll
                    for (int j = 0; j < 4; ++j) hp_[j * SNP + i * 16] = f2bf(st[i][j]);
            }
            LBAR();
            {
                const f32x4 y0 = *(const f32x4*)(YS + tx * SYP + cgx * 8), y1 = *(const f32x4*)(YS + tx * SYP + cgx * 8 + 4);
                float zf[8], o[8]; unpack8(zw, zf);
#pragma unroll
                for (int e = 0; e < 8; ++e) { const float yv = (e < 4 ? y0[e & 3] : y1[e & 3]) + Dh * xv[e]; o[e] = yv * siluf_(zf[e]); }
                pend = pack8f(o);
            }
        }
        *(u32x4*)(Z + (size_t)(rowbase + (long)(nc - 1) * 64 + tx) * DI + xcol) = pend;
#undef SSD_LOADS
#undef LBAR
        float* so = p->out + (smp ? O_SSMS : O_SSMP) + ((size_t)b * 64 + hd) * 64 * 128 + st_off;
#pragma unroll
        for (int i = 0; i < 4; ++i)
#pragma unroll
            for (int j = 0; j < 4; ++j) so[j * 128 + i * 16] = st[i][j];
        __syncthreads();
    }
}
__device__ __forceinline__ float logsig_(float f) { return fminf(f, 0.f) - log1pf(__expf(-fabsf(f))); }
__device__ __forceinline__ void phase_gn(KPrm p, const Ctx cx) {
    const int tid = cx.tid, lane = tid & 63, wid = tid >> 6;
    const int gw = cx.bid * 8 + wid, NGW = cx.G * 8;
    const float* SM = (const float*)(p->ws + W_SMALL);
    if (gw < 192) {
        if (gw < 64) { const int b = gw >> 4, h = gw & 15; const float fb = p->in[I_FB][h];
            float* bias = (float*)(p->ws + W_BIASP) + (size_t)(b * 16 + h) * TP; float* lo = p->out + O_LFP;
            const int tb = lane * 128; float s = 0.f;
            for (int i = 0; i < 128; ++i) s += logsig_(SM[(size_t)(b * TP + tb + i) * 256 + 64 + h] + fb);
            float inc = s;
#pragma unroll
            for (int o = 1; o < 64; o <<= 1) { const float y = __shfl_up(inc, o); if (lane >= o) inc += y; }
            float run = inc - s;
            for (int i = 0; i < 128; ++i) { const float lf = logsig_(SM[(size_t)(b * TP + tb + i) * 256 + 64 + h] + fb); run += lf;
                lo[(size_t)(b * TP + tb + i) * 16 + h] = lf; bias[tb + i] = -run * LOG2E; }
        } else { const int u = gw - 64, sb = u >> 4, h = u & 15; const float fb = p->in[I_FB][h];
            float* bias = (float*)(p->ws + W_BIASS) + (size_t)(sb * 16 + h) * SKVS; float* lo = p->out + O_LFS;
            const int tb = lane * 33; float s = 0.f;
            for (int i = 0; i < 33; ++i) { const int pos = tb + i;
                s += (pos < PAST) ? p->in[I_CLF][(size_t)(sb * PAST + pos) * 16 + h] : logsig_(SM[(size_t)(MP + sb * TS + pos - PAST) * 256 + 64 + h] + fb); }
            float inc = s;
#pragma unroll
            for (int o = 1; o < 64; o <<= 1) { const float y = __shfl_up(inc, o); if (lane >= o) inc += y; }
            float run = inc - s;
            for (int i = 0; i < 33; ++i) { const int pos = tb + i; float lf;
                if (pos < PAST) lf = p->in[I_CLF][(size_t)(sb * PAST + pos) * 16 + h];
                else { lf = logsig_(SM[(size_t)(MP + sb * TS + pos - PAST) * 256 + 64 + h] + fb); lo[(size_t)(sb * TS + pos - PAST) * 16 + h] = lf; }
                run += lf; bias[pos] = -run * LOG2E; }
        }
    }
    {
        const u16* XBC = (const u16*)(p->ws + W_XBC);
        const int gt = cx.bid * 512 + tid, GT = cx.G * 512;
        for (int i = gt; i < 12 * 3 * CD; i += GT) { const int bb = i / (3 * CD), r = (i / CD) % 3, c = i % CD;
            if (bb < 4) p->out[O_MCP + i] = bflo(XBC[(size_t)(bb * TP + TP - 3 + r) * CD + c]);
            else p->out[O_MCS + (i - 4 * 3 * CD)] = bflo(XBC[(size_t)(MP + (bb - 4) * TS + TS - 3 + r) * CD + c]); }
    }
    u16* Z = (u16*)(p->ws + W_Z); const float* mnw = p->in[I_MNW];
    for (int row = gw; row < M; row += NGW) {
#pragma unroll 2
        for (int i = 0; i < 8; ++i) { const int col = i * 512 + lane * 8; u16* zp = Z + (size_t)row * DI + col;
            float v[8]; unpack8(*(const u32x4*)zp, v); float ss = 0.f;
#pragma unroll
            for (int e = 0; e < 8; ++e) ss += v[e] * v[e];
            const float rs = rsqrtf(wave_sum(ss) * (1.f / 512.f) + EPS);
            const f32x4 w0 = *(const f32x4*)(mnw + col), w1 = *(const f32x4*)(mnw + col + 4);
#pragma unroll
            for (int e = 0; e < 8; ++e) v[e] = v[e] * rs * (e < 4 ? w0[e & 3] : w1[e & 3]);
            *(u32x4*)zp = pack8f(v); }
    }
}
__device__ __forceinline__ void phase_qk(KPrm p, const Ctx cx) {
    const int tid = cx.tid, lane = tid & 63, wid = tid >> 6;
    const int gw = cx.bid * 8 + wid, NGW = cx.G * 8;
    u16* Q = (u16*)(p->ws + W_Q); u16* K = (u16*)(p->ws + W_K); const u16* V = (const u16*)(p->ws + W_V);
    u16* Ks = (u16*)p->out; u16* Vs = Ks + (size_t)NBS * SKVS * DM;
    const float QS = 0.08838834764831845f * LOG2E;
    const int hc = (lane & 15) * 8;
    const f32x4 qw0 = *(const f32x4*)(p->in[I_QNW] + hc), qw1 = *(const f32x4*)(p->in[I_QNW] + hc + 4), kw0 = *(const f32x4*)(p->in[I_KNW] + hc), kw1 = *(const f32x4*)(p->in[I_KNW] + hc + 4);
    for (int row = gw; row < M; row += NGW) {
        const bool smp = row >= MP;
        float* ko = smp ? p->out + O_KS + (size_t)(row - MP) * DM : p->out + O_KP + (size_t)row * DM;
        float* vo = smp ? p->out + O_VS + (size_t)(row - MP) * DM : p->out + O_VP + (size_t)row * DM;
        size_t srow = 0; if (smp) { const int sb = (row - MP) >> 6, t = (row - MP) & 63; srow = (size_t)(sb * SKVS + PAST + t) * DM; }
#pragma unroll
        for (int it = 0; it < 4; ++it) { const int col = it * 512 + lane * 8; const size_t off = (size_t)row * DM + col;
            float v[8], ss;
            unpack8(*(const u32x4*)(Q + off), v); ss = 0.f;
#pragma unroll
            for (int e = 0; e < 8; ++e) ss += v[e] * v[e];
            ss += __shfl_xor(ss, 1); ss += __shfl_xor(ss, 2); ss += __shfl_xor(ss, 4); ss += __shfl_xor(ss, 8);
            float rs = rsqrtf(ss * (1.f / 128.f) + EPS) * QS;
#pragma unroll
            for (int e = 0; e < 8; ++e) v[e] = v[e] * rs * (e < 4 ? qw0[e & 3] : qw1[e & 3]);
            *(u32x4*)(Q + off) = pack8f(v);
            unpack8(*(const u32x4*)(K + off), v); ss = 0.f;
#pragma unroll
            for (int e = 0; e < 8; ++e) ss += v[e] * v[e];
            ss += __shfl_xor(ss, 1); ss += __shfl_xor(ss, 2); ss += __shfl_xor(ss, 4); ss += __shfl_xor(ss, 8);
            rs = rsqrtf(ss * (1.f / 128.f) + EPS);
#pragma unroll
            for (int e = 0; e < 8; ++e) v[e] = v[e] * rs * (e < 4 ? kw0[e & 3] : kw1[e & 3]);
            const u32x4 kp = pack8f(v);
            *(u32x4*)(K + off) = kp;
            *(f32x4*)(ko + col) = (f32x4){v[0], v[1], v[2], v[3]}; *(f32x4*)(ko + col + 4) = (f32x4){v[4], v[5], v[6], v[7]};
            const u32x4 vw = *(const u32x4*)(V + off); unpack8(vw, v);
            *(f32x4*)(vo + col) = (f32x4){v[0], v[1], v[2], v[3]}; *(f32x4*)(vo + col + 4) = (f32x4){v[4], v[5], v[6], v[7]};
            if (smp) { *(u32x4*)(Ks + srow + col) = kp; *(u32x4*)(Vs + srow + col) = vw; } }
    }
}
typedef att::BlockRef<att::bf16, att::bf16> ARef;
__device__ __forceinline__ ARef att_ref(KPrm p, const Ctx cx, int i, int nbp, int& skv) {
    const int G = cx.G, bid = (cx.G % 8 == 0) ? (cx.bid % 8) * (cx.G / 8) + cx.bid / 8 : cx.bid; ARef r;
    att::bf16* Qb = (att::bf16*)(p->ws + W_Q); const att::bf16* Kb = (const att::bf16*)(p->ws + W_K); const att::bf16* Vb = (const att::bf16*)(p->ws + W_V);
    if (i < nbp) { const int L = bid + (i >> 1) * G, bh = L >> 4, x = L & 15, qb = (i & 1) ? 31 - x : x, b = bh >> 4, h = bh & 15;
        const size_t rq = ((size_t)b * TP + (size_t)qb * 256) * DM + h * 128, rk = (size_t)b * TP * DM + h * 128;
        r.Q = Qb + rq; r.O = Qb + rq; r.K = Kb + rk; r.V = Vb + rk; r.Bs = (const float*)(p->ws + W_BIASP) + (size_t)bh * TP; r.P0 = qb * 256; r.nvalid = 256; skv = TP;
    } else { const int su = bid + (i - nbp) * G, sb = su >> 4, h = su & 15;
        const att::bf16* Ks = (const att::bf16*)p->out; const att::bf16* Vs = Ks + (size_t)NBS * SKVS * DM;
        const size_t rq = ((size_t)MP + (size_t)sb * TS) * DM + h * 128, rk = (size_t)sb * SKVS * DM + h * 128;
        r.Q = Qb + rq; r.O = Qb + rq; r.K = Ks + rk; r.V = Vs + rk; r.Bs = (const float*)(p->ws + W_BIASS) + (size_t)su * SKVS; r.P0 = PAST; r.nvalid = TS; skv = SKVS; }
    return r;
}
__device__ __forceinline__ void phase_att(KPrm p, const Ctx cx, char* lds) {
    const int G = cx.G, bid = (cx.G % 8 == 0) ? (cx.bid % 8) * (cx.G / 8) + cx.bid / 8 : cx.bid;
    const int nip = (bid < 1024) ? (1024 - bid + G - 1) / G : 0, nbp = 2 * nip, nbs = (bid < 128) ? (128 - bid + G - 1) / G : 0, nb = nbp + nbs;
    if (nb == 0) return;
    const int W = 1 << 30;
    int skv, skvn; ARef cur = att_ref(p, cx, 0, nbp, skv);
    att::Seam<att::bf16> S;
    att::causal_swa_prime<att::bf16, att::bf16>(cur, W, lds, S, cx.tid);
    for (int i = 0; i < nb; ++i) {
        const bool last = (i + 1 == nb);
        ARef nxt = cur; skvn = skv; if (!last) nxt = att_ref(p, cx, i + 1, nbp, skvn);
        att::causal_swa_block<att::bf16, att::bf16>(cur, nxt, skv, W, lds, S, cx.tid);
        cur = nxt; skv = skvn;
    }
}
__device__ __forceinline__ void phase_cv(KPrm p, const Ctx cx, int half) {
    const int tid = cx.tid;
    const u16* U = (const u16*)(p->ws + W_U); u16* Gb = (u16*)(p->ws + W_G); u16* HALO = (u16*)(p->ws + W_HALO);
    const float* cw = p->in[I_FCW]; const float* cb = p->in[I_FCB];
    const int row_lo = half ? HALF_ROWS : 0;
    constexpr int NCG = DFF / 8, RB = 16, NRB = HALF_ROWS / RB;
    const long gt = (long)cx.bid * 512 + tid, GT = (long)cx.G * 512;
    for (long it = gt; it < (long)NCG * NRB; it += GT) {
        const int cgi = (int)(it % NCG), rb = (int)(it / NCG); const int f0 = cgi * 8, r0 = row_lo + rb * RB;
        const int ca = (f0 >> 7) * 256 + (f0 & 127), cbb = ca + 128;
        float wa[3][8], wb[3][8], ba[8], bb[8];
#pragma unroll
        for (int k = 0; k < 3; ++k) { const f32x4 a0 = *(const f32x4*)(cw + k * DFF2 + f0), a1 = *(const f32x4*)(cw + k * DFF2 + f0 + 4), b0 = *(const f32x4*)(cw + k * DFF2 + DFF + f0), b1 = *(const f32x4*)(cw + k * DFF2 + DFF + f0 + 4);
#pragma unroll
            for (int e = 0; e < 4; ++e) { wa[k][e] = a0[e]; wa[k][4 + e] = a1[e]; wb[k][e] = b0[e]; wb[k][4 + e] = b1[e]; } }
        { const f32x4 a0 = *(const f32x4*)(cb + f0), a1 = *(const f32x4*)(cb + f0 + 4), b0 = *(const f32x4*)(cb + DFF + f0), b1 = *(const f32x4*)(cb + DFF + f0 + 4);
#pragma unroll
          for (int e = 0; e < 4; ++e) { ba[e] = a0[e]; ba[4 + e] = a1[e]; bb[e] = b0[e]; bb[4 + e] = b1[e]; } }
        float ha[2][8], hb[2][8];
        const bool smp = r0 >= MP; const int tb = smp ? ((r0 - MP) & 63) : (r0 & (TP - 1));
        if (tb == 0) {
            if (smp) { const float* s = p->in[I_FCV] + (size_t)((r0 - MP) >> 6) * 2 * DFF2;
#pragma unroll
                for (int k = 0; k < 2; ++k)
#pragma unroll
                    for (int e = 0; e < 8; ++e) { ha[k][e] = s[k * DFF2 + f0 + e]; hb[k][e] = s[k * DFF2 + DFF + f0 + e]; }
            } else {
#pragma unroll
                for (int k = 0; k < 2; ++k)
#pragma unroll
                    for (int e = 0; e < 8; ++e) { ha[k][e] = 0.f; hb[k][e] = 0.f; } }
        } else if (half && rb == 0) {
#pragma unroll
            for (int k = 0; k < 2; ++k) { unpack8(*(const u32x4*)(HALO + (size_t)k * DFF2 + ca), ha[k]); unpack8(*(const u32x4*)(HALO + (size_t)k * DFF2 + cbb), hb[k]); }
        } else {
#pragma unroll
            for (int k = 0; k < 2; ++k) { const size_t ro = (size_t)(r0 - row_lo - 2 + k) * DFF2; unpack8(*(const u32x4*)(U + ro + ca), ha[k]); unpack8(*(const u32x4*)(U + ro + cbb), hb[k]); }
        }
#pragma unroll 4
        for (int i = 0; i < RB; ++i) { const int r = r0 + i; const size_t ro = (size_t)(r - row_lo) * DFF2;
            const u32x4 uaw = *(const u32x4*)(U + ro + ca), ubw = *(const u32x4*)(U + ro + cbb);
            float ua[8], ub[8], o[8]; unpack8(uaw, ua); unpack8(ubw, ub);
#pragma unroll
            for (int e = 0; e < 8; ++e) { const float va = ba[e] + wa[0][e] * ha[0][e] + wa[1][e] * ha[1][e] + wa[2][e] * ua[e], vb = bb[e] + wb[0][e] * hb[0][e] + wb[1][e] * hb[1][e] + wb[2][e] * ub[e];
                o[e] = siluf_(va) * vb; ha[0][e] = ha[1][e]; ha[1][e] = ua[e]; hb[0][e] = hb[1][e]; hb[1][e] = ub[e]; }
            *(u32x4*)(Gb + (size_t)r * DFF + f0) = pack8f(o);
            const int tpos = (r >= MP) ? ((r - MP) & 63) : (r & (TP - 1)), tlen = (r >= MP) ? TS : TP;
            if (tpos >= tlen - 2) { float* fo = (r >= MP) ? p->out + O_FCS + ((size_t)((r - MP) >> 6) * 2 + (tpos - (tlen - 2))) * DFF2 : p->out + O_FCP + ((size_t)(r >> 13) * 2 + (tpos - (tlen - 2))) * DFF2;
#pragma unroll
                for (int e = 0; e < 8; ++e) { fo[f0 + e] = ua[e]; fo[DFF + f0 + e] = ub[e]; } }
            if (!half && r >= HALF_ROWS - 2) { *(u32x4*)(HALO + (size_t)(r - (HALF_ROWS - 2)) * DFF2 + ca) = uaw; *(u32x4*)(HALO + (size_t)(r - (HALF_ROWS - 2)) * DFF2 + cbb) = ubw; }
        }
    }
}
constexpr int LDS_TOTAL = 147456;
enum { PH_CONV = 100 };
enum { PH_PREP = 0, PH_N1, PH_G1A, PH_SSD, PH_GN, PH_G1B, PH_G2, PH_G1C, PH_QK, PH_ATT, PH_G3, PH_G4, PH_N2, PH_G5A, PH_CVA, PH_G5B, PH_CVB, PH_G6, PH_COUNT };
__device__ __forceinline__ void run_gemms(KPrm p, const Ctx cx, unsigned char* lds, const int first, const int last, cg::grid_group& grid) {
#pragma unroll 1
    for (int ph = first; ph <= last; ++ph) {
        unsigned char* ws = p->ws;
        pg8::Gemm g; Epi E;
        g.A = (const u16*)(ws + W_H); g.Bt = nullptr; g.M = M; g.N = DM; g.K = DM;
        E.mode = 0; E.d0 = E.d1 = E.d2 = nullptr; E.t1 = E.t2 = 1 << 20; E.p0 = E.p1 = E.p2 = 0; E.f32seg2 = 0;
        E.xp = p->in[I_XP]; E.xs = p->in[I_XS]; E.y = p->out; E.mod = (const float*)(ws + W_MOD); E.gbuf = (u16*)(ws + W_GM); E.gf = (const u16*)(ws + W_GF);
        switch (ph) {
        case PH_G1A: g.Bt = (const u16*)(ws + W_WIN); g.N = 41 * 256;
            E.d0 = (u16*)(ws + W_XBC); E.p0 = CD; E.t1 = 24; E.d1 = (u16*)(ws + W_Z); E.p1 = DI; E.t2 = 40; E.d2 = (u16*)(ws + W_SMALL); E.p2 = 256; E.f32seg2 = 1; break;
        case PH_G1B: g.Bt = (const u16*)(ws + W_WIN) + (size_t)10496 * DM; g.N = 16 * 256;
            E.d0 = (u16*)(ws + W_GM); E.p0 = DM; E.t1 = 8; E.d1 = (u16*)(ws + W_GF); E.p1 = DM; break;
        case PH_G2: g.A = (const u16*)(ws + W_Z); g.Bt = (const u16*)(ws + W_WPM); g.K = DI; E.mode = 1; break;
        case PH_G1C: g.Bt = (const u16*)(ws + W_WIN) + (size_t)14592 * DM; g.N = 24 * 256;
            E.d0 = (u16*)(ws + W_Q); E.p0 = DM; E.t1 = 8; E.d1 = (u16*)(ws + W_K); E.p1 = DM; E.t2 = 16; E.d2 = (u16*)(ws + W_V); E.p2 = DM; break;
        case PH_G3: g.A = (const u16*)(ws + W_Q); g.Bt = (const u16*)(ws + W_WPF); E.mode = 2; break;
        case PH_G4: g.A = (const u16*)(ws + W_GM); g.Bt = (const u16*)(ws + W_WOUT); E.mode = 3; break;
        case PH_G5A: g.Bt = (const u16*)(ws + W_WUP); g.M = HALF_ROWS; g.N = DFF2; E.d0 = (u16*)(ws + W_U); E.p0 = DFF2; break;
        case PH_G5B: g.A = (const u16*)(ws + W_H) + (size_t)HALF_ROWS * DM; g.Bt = (const u16*)(ws + W_WUP); g.M = HALF_ROWS; g.N = DFF2; E.d0 = (u16*)(ws + W_U); E.p0 = DFF2; break;
        default:   g.A = (const u16*)(ws + W_G); g.Bt = (const u16*)(ws + W_WDN); g.K = DFF; E.mode = 5; break;
        }
        pg8::StaticOrder S; S.init(g.M, g.N, cx.G, cx.bid);
        pg8::gemm_phase<Epi, pg8::StaticOrder, true, true>((PG8_LAS unsigned char*)lds, g, S, E, cx.tid);
        if (ph < last) grid.sync();
    }
}
#define PH_BEGIN() Ctx cx; { int t_ = threadIdx.x; asm volatile("" : "+v"(t_)); int b_ = blockIdx.x, g_ = gridDim.x; asm volatile("" : "+s"(b_), "+s"(g_)); cx.tid = t_; cx.bid = b_; cx.G = g_; } \
    KPrm p = (KPrm)__builtin_amdgcn_kernarg_segment_ptr(); asm volatile("" : "+s"(p))
#ifdef ONLY_PH
#define PH_ON(k) ((k) == ONLY_PH)
#else
#define PH_ON(k) true
#endif
__global__ void __launch_bounds__(512, 2) mega_fwd(Prm prm_unused) {
    extern __shared__ __attribute__((aligned(16))) unsigned char lds[];
    cg::grid_group grid = cg::this_grid();
#ifndef EXP
#define EXP 0
#endif
    if (PH_ON(PH_PREP)) { PH_BEGIN(); phase_prep(p, cx, lds); } grid.sync();
#if EXP == 3
    { PH_BEGIN(); phase_prep(p, cx, lds); } grid.sync();
#endif
    if (PH_ON(PH_N1)) { PH_BEGIN(); phase_norm(p, cx, 0); } grid.sync();
    if (PH_ON(PH_G1A)) { PH_BEGIN(); run_gemms(p, cx, lds, PH_G1A, PH_G1A, grid); } grid.sync();
#if EXP == 1
    { PH_BEGIN(); run_gemms(p, cx, lds, PH_G1A, PH_G1A, grid); } grid.sync();
#endif
    if (PH_ON(PH_CONV)) { PH_BEGIN(); phase_conv(p, cx); } grid.sync();
    if (PH_ON(PH_SSD)) { PH_BEGIN(); phase_ssd(p, cx, lds); } grid.sync();
#if EXP == 2
    { PH_BEGIN(); run_gemms(p, cx, lds, PH_G1A, PH_G1A, grid); } grid.sync();
    { PH_BEGIN(); phase_conv(p, cx); } grid.sync();
    { PH_BEGIN(); phase_ssd(p, cx, lds); } grid.sync();
#endif
    if (PH_ON(PH_GN)) { PH_BEGIN(); phase_gn(p, cx); } grid.sync();
    if (PH_ON(PH_G1B)) { PH_BEGIN(); run_gemms(p, cx, lds, PH_G1B, PH_G1C, grid); } grid.sync();
    if (PH_ON(PH_QK)) { PH_BEGIN(); phase_qk(p, cx); } grid.sync();
    if (PH_ON(PH_ATT)) { PH_BEGIN(); phase_att(p, cx, (char*)lds); } grid.sync();
#if EXP == 4
    { PH_BEGIN(); run_gemms(p, cx, lds, PH_G1C, PH_G1C, grid); } grid.sync();
    { PH_BEGIN(); phase_qk(p, cx); } grid.sync();
    { PH_BEGIN(); phase_att(p, cx, (char*)lds); } grid.sync();
#endif
    if (PH_ON(PH_G3)) { PH_BEGIN(); run_gemms(p, cx, lds, PH_G3, PH_G4, grid); } grid.sync();
    if (PH_ON(PH_N2)) { PH_BEGIN(); phase_norm(p, cx, 1); } grid.sync();
    if (PH_ON(PH_G5A)) { PH_BEGIN(); run_gemms(p, cx, lds, PH_G5A, PH_G5A, grid); } grid.sync();
    if (PH_ON(PH_CVA)) { PH_BEGIN(); phase_cv(p, cx, 0); } grid.sync();
    if (PH_ON(PH_G5B)) { PH_BEGIN(); run_gemms(p, cx, lds, PH_G5B, PH_G5B, grid); } grid.sync();
    if (PH_ON(PH_CVB)) { PH_BEGIN(); phase_cv(p, cx, 1); } grid.sync();
    if (PH_ON(PH_G6)) { PH_BEGIN(); run_gemms(p, cx, lds, PH_G6, PH_G6, grid); }
}

extern "C" void kernel_launch(void* const* d_in, const int* in_sizes, int n_in, void* d_out, int out_size, void* d_ws, size_t ws_size, hipStream_t stream) {
    static int grid = 0;
    if (grid == 0) {
        if (n_in != 31 || (size_t)out_size != O_END || ws_size < 1024 * MiB) { fprintf(stderr, "kernel_launch: unexpected sizes n_in %d out %d ws %zu\n", n_in, out_size, ws_size); }
        int dev = 0, cus = 0, per_cu = 0;
        hipGetDevice(&dev); hipDeviceGetAttribute(&cus, hipDeviceAttributeMultiprocessorCount, dev);
        hipFuncSetAttribute((const void*)mega_fwd, hipFuncAttributeMaxDynamicSharedMemorySize, LDS_TOTAL);
        hipOccupancyMaxActiveBlocksPerMultiprocessor(&per_cu, (const void*)mega_fwd, 512, LDS_TOTAL);
        (void)hipGetLastError();
        if (per_cu < 1) per_cu = 1;
        grid = cus;
    }
    Prm prm{};
    for (int i = 0; i < 31; ++i) prm.in[i] = (const float*)d_in[i];
    prm.out = (float*)d_out; prm.ws = (unsigned char*)d_ws;
    void* args[] = {&prm};
    hipError_t e = hipLaunchCooperativeKernel((const void*)mega_fwd, dim3(grid), dim3(512), args, LDS_TOTAL, stream);
    if (e != hipSuccess) fprintf(stderr, "cooperative launch failed: %s (grid %d)\n", hipGetErrorString(e), grid);
}
```

```cpp
#include <hip/hip_runtime.h>
#include <hip/hip_cooperative_groups.h>
#include <hip/hip_bf16.h>
#include <cstdio>
#include <cstdint>
namespace cg = cooperative_groups;
namespace pg8 {
#define PG8_LAS __attribute__((address_space(3)))
typedef unsigned short bf16_t;
typedef short bf16x8 __attribute__((ext_vector_type(8)));
typedef float f32x4 __attribute__((ext_vector_type(4)));
typedef unsigned u32x4 __attribute__((ext_vector_type(4)));
constexpr int BM = 256, BK = 64, HALF = 128, HTB = HALF * BK * 2  , STAGE_BYTES = 8 * HTB, NXCD = 8, WGM = 8;

__host__ __device__ __forceinline__ int lds_byte(int r, int c) { const int st = (r >> 4) * 2 + (c >> 5), rr = r & 15, cc = c & 31, ob = rr * 64 + cc * 2; return st * 1024 + (ob ^ (((ob >> 9) & 1) << 5)); }
__host__ __device__ __forceinline__ void stage_rc(int b, int& R, int& C) { const int st = b / 1024, sb = b % 1024, swz = sb ^ (((sb >> 9) & 1) << 5); R = (st >> 1) * 16 + swz / 64; C = (st & 1) * 32 + (swz % 64) / 2; }
__host__ __device__ __forceinline__ int perm32(int rho) { const int n = rho >> 4, i = rho & 15; return 8 * (i >> 2) + 4 * n + (i & 3); }

struct Unit { int pm, pn; };
struct Gemm { const bf16_t* A; const bf16_t* Bt; int M, N, K; };

struct StaticOrder {
    int nM, nN, nwg, G, c;
    __host__ __device__ void init(int M, int N, int G_, int c_) { nM = M / BM; nN = N / BM; nwg = nM * nN; G = G_; c = c_; }
    __host__ __device__ bool next(int i, Unit& u) const {
        const long L = (long)i * G + c; if (L >= nwg) return false;
        int wgid = (int)L; { const int q = nwg / NXCD, r = nwg % NXCD, xcd = wgid % NXCD, off = wgid / NXCD; wgid = (xcd < r ? xcd * (q + 1) : r * (q + 1) + (xcd - r) * q) + off; }
        const int nig = WGM * nN, gid = wgid / nig, fm = gid * WGM, gsz = (nM - fm) < WGM ? (nM - fm) : WGM;
        u.pm = fm + ((wgid % nig) % gsz); u.pn = (wgid % nig) / gsz; return true;
    }
    __device__ __forceinline__ void a_ready(const Unit&) const {}
    __device__ __forceinline__ void done(const Unit&) const {}
};
__device__ __forceinline__ unsigned cvt_pk_bf16(float lo, float hi) { unsigned r; asm volatile("v_cvt_pk_bf16_f32 %0, %1, %2" : "=v"(r) : "v"(lo), "v"(hi)); return r; }
typedef float f32x2 __attribute__((ext_vector_type(2)));
template <class Epi, class Sched, bool ALIGN_EPI = false, bool SP2 = false>
__device__ __forceinline__ void gemm_phase(PG8_LAS unsigned char* lds, const Gemm g, const Sched& S, const Epi& E, const int tid) {
    const int wid = __builtin_amdgcn_readfirstlane(tid >> 6), lane = tid & 63, wr = wid >> 2, wc = wid & 3, fr = lane & 15, fq = lane >> 4;
    const int K = g.K, nt = K / BK;
    unsigned voffA[2], voffB[2];
#pragma unroll
    for (int i = 0; i < 2; ++i) { int R, C; stage_rc(tid * 16 + i * 8192, R, C); const int Rb = Epi::PERM ? ((R & ~31) + perm32(R & 31)) : R;
        voffA[i] = (unsigned)(R * K + C) * 2u; voffB[i] = (unsigned)(Rb * K + C) * 2u; }
    const size_t kstep = (size_t)(BK * 2);
    const size_t hstep = (size_t)HALF * K * 2;
    const size_t tstep = 2 * hstep;
    const unsigned ldsw = (unsigned)wid * 1024u;
    const int aoff = lds_byte(wr * 64 + fr, fq * 8), boff = lds_byte(wc * 32 + fr, fq * 8);
#define PG8_SA(b, h) (((b) * 2 + (h)) * HTB)
#define PG8_SB(b, h) ((4 + (b) * 2 + (h)) * HTB)
#define PG8_STAGE(bufoff, gbase, voff) do { _Pragma("unroll") for (int _i = 0; _i < 2; ++_i) \
        __builtin_amdgcn_global_load_lds((const unsigned*)((const char*)(gbase) + (voff)[_i]), (PG8_LAS unsigned*)(lds + (bufoff) + ldsw + _i * 8192), 16, 0, 0); } while (0)
#define PG8_LDA(dst, b, h) do { _Pragma("unroll") for (int m = 0; m < 4; ++m) _Pragma("unroll") for (int k = 0; k < 2; ++k) dst[m][k] = *(const PG8_LAS bf16x8*)(lds + PG8_SA(b, h) + aoff + m * 2048 + k * 1024); } while (0)
#define PG8_LDB(dst, b, h) do { _Pragma("unroll") for (int n = 0; n < 2; ++n) _Pragma("unroll") for (int k = 0; k < 2; ++k) dst[n][k] = *(const PG8_LAS bf16x8*)(lds + PG8_SB(b, h) + boff + n * 2048 + k * 1024); } while (0)
#define PG8_MMA(ai, bj, At, Bt) do { __builtin_amdgcn_s_setprio(1); _Pragma("unroll") for (int m = 0; m < 4; ++m) _Pragma("unroll") for (int n = 0; n < 2; ++n) _Pragma("unroll") for (int k = 0; k < 2; ++k) \
        acc[ai][bj][m][n] = __builtin_amdgcn_mfma_f32_16x16x32_bf16(Bt[n][k], At[m][k], acc[ai][bj][m][n], 0, 0, 0); __builtin_amdgcn_s_setprio(0); } while (0)
#define PG8_WAIT_V(n) asm volatile("s_waitcnt vmcnt(" #n ")" ::: "memory")
#define PG8_WAIT_L(n) asm volatile("s_waitcnt lgkmcnt(" #n ")" ::: "memory")
#define PG8_BAR __builtin_amdgcn_s_barrier()
#define PG8_SCHED __builtin_amdgcn_sched_barrier(0)
    Unit cur, nxt; int ui = 0;
    if (!S.next(0, cur)) return;
    f32x4 acc[2][2][4][2];
#pragma unroll
    for (int a = 0; a < 2; ++a)
#pragma unroll
        for (int b = 0; b < 2; ++b)
#pragma unroll
            for (int m = 0; m < 4; ++m)
#pragma unroll
                for (int n = 0; n < 2; ++n) acc[a][b][m][n] = (f32x4){0.f, 0.f, 0.f, 0.f};
    bf16x8 At[4][2], B0[2][2], B1[2][2];
    const char* cA = (const char*)g.A + (size_t)cur.pm * tstep; const char* cB = (const char*)g.Bt + (size_t)cur.pn * tstep;
    S.a_ready(cur);
    if constexpr (SP2) {
        PG8_STAGE(PG8_SB(0, 0), cB, voffB); PG8_STAGE(PG8_SB(0, 1), cB + hstep, voffB); PG8_STAGE(PG8_SA(0, 0), cA, voffA); PG8_STAGE(PG8_SA(0, 1), cA + hstep, voffA);
        if (wr == 1) PG8_BAR;
        PG8_WAIT_V(2); PG8_BAR;
        PG8_STAGE(PG8_SB(1, 0), cB + kstep, voffB); PG8_STAGE(PG8_SA(1, 0), cA + kstep, voffA); PG8_STAGE(PG8_SB(1, 1), cB + hstep + kstep, voffB);
        PG8_WAIT_V(6); PG8_BAR;
    } else {
        PG8_STAGE(PG8_SB(0, 0), cB, voffB); PG8_STAGE(PG8_SA(0, 0), cA, voffA); PG8_STAGE(PG8_SB(0, 1), cB + hstep, voffB); PG8_STAGE(PG8_SA(0, 1), cA + hstep, voffA);
        if (wr == 1) PG8_BAR;
        PG8_WAIT_V(4); PG8_BAR;
        PG8_STAGE(PG8_SB(1, 0), cB + kstep, voffB); PG8_STAGE(PG8_SA(1, 0), cA + kstep, voffA); PG8_STAGE(PG8_SB(1, 1), cB + hstep + kstep, voffB);
        PG8_WAIT_V(6); PG8_BAR;
    }
    for (;;) {
        const bool has_next = S.next(ui + 1, nxt);
        const char* nA = has_next ? (const char*)g.A + (size_t)nxt.pm * tstep : cA; const char* nB = has_next ? (const char*)g.Bt + (size_t)nxt.pn * tstep : cB;
        for (int t = 0; t < nt; t += 2) {
            const bool last = (t == nt - 2);
            const char* a1 = cA + (size_t)(t + 1) * kstep;
            const char* a2 = last ? nA : cA + (size_t)(t + 2) * kstep; const char* b2 = last ? nB : cB + (size_t)(t + 2) * kstep;
            const char* a3 = a2 + kstep; const char* b3 = b2 + kstep;
            if (last && has_next) S.a_ready(nxt);
            if constexpr (SP2) {
            PG8_LDB(B0, 0, 0); PG8_LDB(B1, 0, 1); PG8_SCHED; PG8_LDA(At, 0, 0); PG8_STAGE(PG8_SA(1, 1), a1 + hstep, voffA);
            PG8_WAIT_V(8); PG8_WAIT_L(0); PG8_BAR; PG8_MMA(0, 0, At, B0); PG8_MMA(0, 1, At, B1); PG8_BAR; PG8_SCHED;
            PG8_LDA(At, 0, 1); PG8_STAGE(PG8_SB(0, 0), b2, voffB); PG8_STAGE(PG8_SB(0, 1), b2 + hstep, voffB); PG8_STAGE(PG8_SA(0, 0), a2, voffA);
            PG8_WAIT_V(8); PG8_WAIT_L(0); PG8_BAR; PG8_MMA(1, 0, At, B0); PG8_MMA(1, 1, At, B1); PG8_BAR; PG8_SCHED;
            PG8_LDB(B0, 1, 0); PG8_LDB(B1, 1, 1); PG8_SCHED; PG8_LDA(At, 1, 0); PG8_STAGE(PG8_SA(0, 1), a2 + hstep, voffA);
            PG8_WAIT_V(8); PG8_WAIT_L(0); PG8_BAR; PG8_MMA(0, 0, At, B0); PG8_MMA(0, 1, At, B1); PG8_BAR; PG8_SCHED;
            PG8_LDA(At, 1, 1); PG8_STAGE(PG8_SB(1, 0), b3, voffB); PG8_STAGE(PG8_SB(1, 1), b3 + hstep, voffB); PG8_STAGE(PG8_SA(1, 0), a3, voffA);
            PG8_WAIT_V(8); PG8_WAIT_L(0); PG8_BAR; PG8_MMA(1, 0, At, B0); PG8_MMA(1, 1, At, B1); PG8_BAR; PG8_SCHED;
            } else {
            PG8_LDB(B0, 0, 0); PG8_SCHED; PG8_LDA(At, 0, 0); PG8_STAGE(PG8_SA(1, 1), a1 + hstep, voffA);
            PG8_WAIT_L(8); PG8_BAR; PG8_WAIT_L(0); PG8_MMA(0, 0, At, B0); PG8_BAR; PG8_SCHED;
            PG8_LDB(B1, 0, 1); PG8_STAGE(PG8_SB(0, 0), b2, voffB);
            PG8_BAR; PG8_WAIT_L(0); PG8_MMA(0, 1, At, B1); PG8_BAR;
            PG8_LDA(At, 0, 1); PG8_STAGE(PG8_SA(0, 0), a2, voffA);
            PG8_BAR; PG8_WAIT_L(0); PG8_MMA(1, 0, At, B0); PG8_BAR; PG8_SCHED;
            PG8_STAGE(PG8_SB(0, 1), b2 + hstep, voffB);
            PG8_WAIT_V(6); PG8_BAR; PG8_MMA(1, 1, At, B1); PG8_BAR;
            PG8_LDB(B0, 1, 0); PG8_SCHED; PG8_LDA(At, 1, 0); PG8_STAGE(PG8_SA(0, 1), a2 + hstep, voffA);
            PG8_WAIT_L(8); PG8_BAR; PG8_WAIT_L(0); PG8_MMA(0, 0, At, B0); PG8_BAR; PG8_SCHED;
            PG8_LDB(B1, 1, 1); PG8_STAGE(PG8_SB(1, 0), b3, voffB);
            PG8_BAR; PG8_WAIT_L(0); PG8_MMA(0, 1, At, B1); PG8_BAR;
            PG8_LDA(At, 1, 1); PG8_STAGE(PG8_SA(1, 0), a3, voffA);
            PG8_BAR; PG8_WAIT_L(0); PG8_MMA(1, 0, At, B0); PG8_BAR; PG8_SCHED;
            PG8_STAGE(PG8_SB(1, 1), b3 + hstep, voffB);
            PG8_WAIT_V(6); PG8_BAR; PG8_MMA(1, 1, At, B1); PG8_BAR;
            }
        }
        if constexpr (ALIGN_EPI) { if (wr == 0) PG8_BAR; }
        if constexpr (!Epi::AFTER_DRAIN) { E(acc, cur, wr, wc, fr, fq); S.done(cur); }
        if (!has_next) break;
#pragma unroll
        for (int a = 0; a < 2; ++a)
#pragma unroll
            for (int b = 0; b < 2; ++b)
#pragma unroll
                for (int m = 0; m < 4; ++m)
#pragma unroll
                    for (int n = 0; n < 2; ++n) acc[a][b][m][n] = (f32x4){0.f, 0.f, 0.f, 0.f};
        cur = nxt; cA = nA; cB = nB; ++ui;
        if constexpr (ALIGN_EPI) { if (wr == 1) PG8_BAR; }
    }
    PG8_WAIT_V(0);
    if constexpr (!ALIGN_EPI) { if (wr == 0) PG8_BAR; }
    PG8_BAR;
    if constexpr (Epi::AFTER_DRAIN) { E.fused(acc, cur, wr, wc, fr, fq, lds, wid, lane); S.done(cur); }
#undef PG8_SA
#undef PG8_SB
#undef PG8_STAGE
#undef PG8_LDA
#undef PG8_LDB
#undef PG8_MMA
#undef PG8_WAIT_V
#undef PG8_WAIT_L
#undef PG8_BAR
#undef PG8_SCHED
}
}
namespace att {
constexpr int D = 128, PITCH = 2048, NW = 8, QBLK = 32, KVBLK = 64, QB = NW * QBLK;
constexpr int SHM_V = KVBLK * D * 2, SHM_K = KVBLK * D * 2;
constexpr int LDS_BIAS = 2 * SHM_V + 2 * SHM_K + NW * 64 * 4;
constexpr int NQX = 3, LDS_QX = LDS_BIAS + 512;
constexpr int LDS_BYTES = LDS_QX + NW * NQX * 1024;
constexpr float THR2 = 64.f;
constexpr bool WSKIP = false;
typedef __hip_bfloat16 bf16;
typedef short bf16x8 __attribute__((ext_vector_type(8)));
typedef short s16x4 __attribute__((ext_vector_type(4)));
typedef float f32x16 __attribute__((ext_vector_type(16)));
typedef float f32x4 __attribute__((ext_vector_type(4)));
typedef unsigned u32x4 __attribute__((ext_vector_type(4)));
template <class A, class Bt> struct same_t { static constexpr bool v = false; };
template <class A> struct same_t<A, A> { static constexpr bool v = true; };

#define KSWZ(row, colB) ((row) * 256 + ((colB) ^ (((row) & 7) << 4)))
#define SBAR() __builtin_amdgcn_sched_barrier(0)
__device__ __forceinline__ int v_st(int k, int c) { const int kk = (k & ~0xC) | ((k & 4) << 1) | ((k & 8) >> 1); return ((kk >> 3) * 4 + (c >> 5)) * 512 + ((kk & 7) * 32 + (c & 31)) * 2; }
__device__ __forceinline__ int v_rd_base(int lane) { return ((lane & 3) << 3) | (((lane >> 2) & 3) << 6) | (((lane >> 4) & 1) << 5) | (((lane >> 5) & 1) << 8); }
constexpr int v_rd_off(int d0, int ks, int half) { return d0 * 512 + ks * 4096 + half * 2048; }
__device__ __forceinline__ int crow(int r, int hi) { return (r & 3) + 8 * (r >> 2) + 4 * hi; }
__device__ __forceinline__ unsigned cvtpk(float lo, float hi) {
    unsigned r; asm volatile("v_cvt_pk_bf16_f32 %0, %1, %2" : "=v"(r) : "v"(lo), "v"(hi)); return r;
}
__device__ __forceinline__ bf16x8 pack8(f32x4 a, f32x4 b) {
    u32x4 w = {cvtpk(a[0], a[1]), cvtpk(a[2], a[3]), cvtpk(b[0], b[1]), cvtpk(b[2], b[3])};
    return *reinterpret_cast<bf16x8*>(&w);
}
template <class T> __device__ __forceinline__ bf16x8 load8(const T* p) {
    if constexpr (same_t<T, float>::v) { return pack8(*(const f32x4*)p, *(const f32x4*)(p + 4)); }
    else { return *reinterpret_cast<const bf16x8*>(p); }
}
__device__ __forceinline__ void mask_tile(f32x16& p0, f32x16& p1, int dq, unsigned W) {
    const float NEG = -__builtin_inff();
#pragma unroll
    for (int r = 0; r < 16; ++r) {
        const int c = (r & 3) + 8 * (r >> 2);
        if (dq - c < 0) p0[r] = NEG;
        if (dq - c - 32 < 0) p1[r] = NEG;
    }
}
__device__ __forceinline__ void partialSM(f32x16& p0, f32x16& p1, float& m_reg, float& mn, float& alpha) {
    float pmax = p0[0]; for (int r = 1; r < 16; ++r) pmax = fmaxf(pmax, p0[r]); for (int r = 0; r < 16; ++r) pmax = fmaxf(pmax, p1[r]);
    { auto rr = __builtin_amdgcn_permlane32_swap(__float_as_uint(pmax), __float_as_uint(pmax), false, false);
      pmax = fmaxf(__uint_as_float(rr[0]), __uint_as_float(rr[1])); }
    if (__builtin_expect(__all((pmax - m_reg) <= THR2), 1)) { mn = m_reg; alpha = 1.f; }
    else { mn = fmaxf(m_reg, pmax); alpha = __builtin_amdgcn_exp2f(m_reg - mn); m_reg = mn; }
    for (int r = 0; r < 16; ++r) p0[r] = p0[r] - mn; for (int r = 0; r < 16; ++r) p1[r] = p1[r] - mn;
    for (int r = 0; r < 16; ++r) p0[r] = __builtin_amdgcn_exp2f(p0[r]);
}
__device__ __forceinline__ void finishSM(f32x16& p0, f32x16& p1, float alpha, float& l_reg, bf16x8& pa0, bf16x8& pa1, bf16x8& pa2, bf16x8& pa3) {
    for (int r = 0; r < 16; ++r) p1[r] = __builtin_amdgcn_exp2f(p1[r]);
    float ps = 0; for (int r = 0; r < 16; ++r) ps += p0[r]; for (int r = 0; r < 16; ++r) ps += p1[r];
    { auto rr = __builtin_amdgcn_permlane32_swap(__float_as_uint(ps), __float_as_uint(ps), false, false);
      ps = __uint_as_float(rr[0]) + __uint_as_float(rr[1]); }
    l_reg = l_reg * alpha + ps;
#define PK4(P, B_, OUT) do { unsigned a0 = cvtpk(P[B_+0], P[B_+1]), a1 = cvtpk(P[B_+2], P[B_+3]);                          \
        unsigned b0 = cvtpk(P[B_+4], P[B_+5]), b1 = cvtpk(P[B_+6], P[B_+7]);                                             \
        auto r0 = __builtin_amdgcn_permlane32_swap(a0, b0, false, false); auto r1 = __builtin_amdgcn_permlane32_swap(a1, b1, false, false); \
        u32x4 w = {r0[0], r1[0], r0[1], r1[1]}; OUT = *reinterpret_cast<bf16x8*>(&w); } while (0)
    PK4(p0, 0, pa0); PK4(p0, 8, pa1); PK4(p1, 0, pa2); PK4(p1, 8, pa3);
#undef PK4
}
template <int KB, bool SK>
__device__ __forceinline__ void qkt(f32x16& p0, f32x16& p1, const char* K_lds, int r32, int hi, const bf16x8* qr, bool act, const char* qx) {
    if (SK && !act) { const float NEG = -__builtin_inff();
#pragma unroll
        for (int r = 0; r < 16; ++r) { p0[r] = NEG; p1[r] = NEG; } return; }
    { const float* bl = (const float*)(K_lds - 2 * SHM_V + LDS_BIAS) + KB * 64 + 4 * hi;
#pragma unroll
      for (int g = 0; g < 4; ++g) { const f32x4 u0 = *(const f32x4*)(bl + 8 * g), u1 = *(const f32x4*)(bl + 32 + 8 * g);
        p0[4*g] = u0[0]; p0[4*g+1] = u0[1]; p0[4*g+2] = u0[2]; p0[4*g+3] = u0[3]; p1[4*g] = u1[0]; p1[4*g+1] = u1[1]; p1[4*g+2] = u1[2]; p1[4*g+3] = u1[3]; } }
    const char* kb[4];
#pragma unroll
    for (int dd = 0; dd < 4; ++dd) kb[dd] = K_lds + KB * SHM_K + KSWZ(r32, (dd * 16 + hi * 8) * 2);
#pragma unroll
    for (int d0 = 0; d0 < 8; ++d0) { const char* a = kb[d0 & 3] + (d0 >> 2) * 128;
        bf16x8 b0 = *reinterpret_cast<const bf16x8*>(a);
        bf16x8 b1 = *reinterpret_cast<const bf16x8*>(a + 32 * 256);
        const bf16x8 qv = (d0 < 8 - NQX) ? qr[d0] : *reinterpret_cast<const bf16x8*>(qx + (d0 - (8 - NQX)) * 1024);
        p0 = __builtin_amdgcn_mfma_f32_32x32x16_bf16(b0, qv, p0, 0, 0, 0);
        p1 = __builtin_amdgcn_mfma_f32_32x32x16_bf16(b1, qv, p1, 0, 0, 0); }
}
template <int VB, bool SK>
__device__ __forceinline__ void pv_tile(f32x16* o, int vb0, bf16x8 pa0, bf16x8 pa1, bf16x8 pa2, bf16x8 pa3, bool act) {
    if (SK && !act) return;
#define TRRD(dst, off) asm volatile("ds_read_b64_tr_b16 %0, %1 offset:%2" : "=&v"(dst) : "v"(vb0), "i"(off) : "memory")
#define PV_D0(d0) do { s16x4 l0, l1, l2, l3, h0, h1, h2, h3; constexpr int b_ = VB * SHM_V + v_rd_off(d0, 0, 0);     \
        TRRD(l0, b_); TRRD(h0, b_ + 2048); TRRD(l1, b_ + 4096); TRRD(h1, b_ + 6144); TRRD(l2, b_ + 8192); TRRD(h2, b_ + 10240); TRRD(l3, b_ + 12288); TRRD(h3, b_ + 14336); \
        asm volatile("s_waitcnt lgkmcnt(0)" ::: "memory"); SBAR();                 \
        o[d0] = __builtin_amdgcn_mfma_f32_32x32x16_bf16(pa0, (bf16x8){l0[0], l0[1], l0[2], l0[3], h0[0], h0[1], h0[2], h0[3]}, o[d0], 0, 0, 0);   \
        o[d0] = __builtin_amdgcn_mfma_f32_32x32x16_bf16(pa1, (bf16x8){l1[0], l1[1], l1[2], l1[3], h1[0], h1[1], h1[2], h1[3]}, o[d0], 0, 0, 0);   \
        o[d0] = __builtin_amdgcn_mfma_f32_32x32x16_bf16(pa2, (bf16x8){l2[0], l2[1], l2[2], l2[3], h2[0], h2[1], h2[2], h2[3]}, o[d0], 0, 0, 0);   \
        o[d0] = __builtin_amdgcn_mfma_f32_32x32x16_bf16(pa3, (bf16x8){l3[0], l3[1], l3[2], l3[3], h3[0], h3[1], h3[2], h3[3]}, o[d0], 0, 0, 0); } while (0)
    PV_D0(0); PV_D0(1); PV_D0(2); PV_D0(3);
#undef PV_D0
#undef TRRD
}

template <class TIn, class TOut> struct BlockRef { const TIn* Q; const TIn* K; const TIn* V; TOut* O; const float* Bs; int P0; int nvalid; };
template <class TIn> struct Seam {
    bf16x8 qr[8];
    bf16x8 st_v0, st_v1, st_k0, st_k1; f32x4 sf0, sf1, sf2, sf3;
    f32x4 tq[16];
};
__device__ __forceinline__ int swa_jlo(int P0, int W) { const int lowk = P0 - W + 1; return lowk > 0 ? lowk / KVBLK : 0; }
#define ROW(p, k0, rr) ((p) + (size_t)((k0) + (rr)) * PITCH + sc)
#define VMW() asm volatile("s_waitcnt vmcnt(0)" ::: "memory")
#define VMWN(n) asm volatile("s_waitcnt vmcnt(%0)" :: "i"(n) : "memory")
#define GLDS(gp_, lp_, sz_) __builtin_amdgcn_global_load_lds((const unsigned*)(gp_), (__attribute__((address_space(3))) unsigned*)(lp_), sz_, 0, 0)
#define SLOAD_H(Kp, Vp, Bp, k0, bb_) do { S.st_v0 = load8<TIn>(ROW(Vp, k0, sr)); S.st_v1 = load8<TIn>(ROW(Vp, k0, 32 + sr));              \
                         { const TIn* kg_ = (Kp) + (size_t)(k0) * PITCH; char* kl_ = K_lds + (bb_) * SHM_K + wid * 2048; GLDS(kg_ + ksrc0, kl_, 16); GLDS(kg_ + ksrc1, kl_ + 1024, 16); } \
                         if (wid == 0) GLDS((Bp) + (k0) + lane, lds + LDS_BIAS + (bb_) * 256, 4); } while (0)
#define SWRITE_HK(bf) do { } while (0)
#define SWRITE_HV(bf) do { *(bf16x8*)(V_lds + (bf) * SHM_V + vst0) = S.st_v0; *(bf16x8*)(V_lds + (bf) * SHM_V + vst1) = S.st_v1; } while (0)
#define SWRITE_H(bf) do { SWRITE_HV(bf); SWRITE_HK(bf); } while (0)
#define SLOAD_F(p, k0) do { S.sf0 = *(const f32x4*)ROW(p, k0, sr); S.sf1 = *(const f32x4*)(ROW(p, k0, sr) + 4);                \
                            S.sf2 = *(const f32x4*)ROW(p, k0, 32 + sr); S.sf3 = *(const f32x4*)(ROW(p, k0, 32 + sr) + 4); } while (0)
#define SWRITE_KF(bf) do { *(bf16x8*)(K_lds + (bf) * SHM_K + kws) = pack8(S.sf0, S.sf1); *(bf16x8*)(K_lds + (bf) * SHM_K + kws + 32 * 256) = pack8(S.sf2, S.sf3); } while (0)
#define SWRITE_VF(bf) do { *(bf16x8*)(V_lds + (bf) * SHM_V + vst0) = pack8(S.sf0, S.sf1); *(bf16x8*)(V_lds + (bf) * SHM_V + vst1) = pack8(S.sf2, S.sf3); } while (0)
template <class TIn, class TOut>
__device__ __forceinline__ void causal_swa_prime(const BlockRef<TIn, TOut>& cur, int W, char* lds, Seam<TIn>& S, const int tid) {
    constexpr bool F32 = same_t<TIn, float>::v;
    const int wid = __builtin_amdgcn_readfirstlane(tid >> 6), lane = tid & 63, r32 = lane & 31, hi = lane >> 5;
    const int sr = tid >> 4, sc = (tid & 15) * 8, kws = KSWZ(sr, sc * 2); char* K_lds = lds + 2 * SHM_V; (void)kws;
    const int ksrc0 = (8 * wid + (lane >> 4)) * PITCH + ((lane & 15) ^ (lane >> 4)) * 8, ksrc1 = (8 * wid + 4 + (lane >> 4)) * PITCH + ((lane & 15) ^ (4 + (lane >> 4))) * 8;
    const int kb0 = swa_jlo(cur.P0, W) * KVBLK;
    for (int d0 = 0; d0 < 8; ++d0) S.qr[d0] = load8<TIn>(cur.Q + (size_t)(wid * QBLK + r32) * PITCH + d0 * 16 + hi * 8);
    if constexpr (F32) { SLOAD_F((const float*)cur.K, kb0); VMW(); SWRITE_KF(0); SBAR(); SLOAD_F((const float*)cur.V, kb0); }
    else { SLOAD_H(cur.K, cur.V, cur.Bs, kb0, 0); VMW(); SWRITE_HK(0); }
    __syncthreads();
}
template <class TIn, class TOut>
__device__ __forceinline__ void causal_swa_block(const BlockRef<TIn, TOut>& cur, const BlockRef<TIn, TOut>& nxt, int skv, int W, char* lds, Seam<TIn>& S, const int tid) {
    constexpr bool F32 = same_t<TIn, float>::v;
    const int wid = __builtin_amdgcn_readfirstlane(tid >> 6), lane = tid & 63, r32 = lane & 31, hi = lane >> 5;
    const int j_lo = swa_jlo(cur.P0, W);
    int j_hi = (cur.P0 + QB - 1) / KVBLK + 1; if (j_hi > skv / KVBLK) j_hi = skv / KVBLK;
    const int NT = j_hi - j_lo;
    const int kbn = swa_jlo(nxt.P0, W) * KVBLK;
    const int qlo = cur.P0 + wid * QBLK, qm = qlo + r32 - 4 * hi;
    char* V_lds = lds; char* K_lds = lds + 2 * SHM_V;
    float* ws = (float*)(lds + 2 * SHM_V + 2 * SHM_K) + wid * 64; float* li_l = ws, * al_l = ws + 32;
    float m_reg = -1e30f, l_reg = 0; f32x16 o[4] = {};
    const int sr = tid >> 4, sc = (tid & 15) * 8, vst0 = v_st(sr, sc), vst1 = v_st(32 + sr, sc), kws = KSWZ(sr, sc * 2);
    const int vb0 = (int)(uintptr_t)V_lds + v_rd_base(lane); (void)kws;
    const int ksrc0 = (8 * wid + (lane >> 4)) * PITCH + ((lane & 15) ^ (lane >> 4)) * 8, ksrc1 = (8 * wid + 4 + (lane >> 4)) * PITCH + ((lane & 15) ^ (4 + (lane >> 4))) * 8;
    const TIn* Kh = cur.K; const TIn* Vh = cur.V; const float* Bh = cur.Bs;
#define RESC(a) do { if (__any((a) < 1.f)) { if (hi == 0) al_l[r32] = (a); asm volatile("s_waitcnt lgkmcnt(0)" ::: "memory");              \
                     for (int d_ = 0; d_ < 4; ++d_) for (int r = 0; r < 16; ++r) o[d_][r] *= al_l[crow(r, hi)]; } } while (0)
#define KBASE(t) ((j_lo + (t)) * KVBLK)
#define ACT(t) (KBASE(t) <= qlo + QBLK - 1 && KBASE(t) + KVBLK - 1 >= qlo - W + 1)
#define MASKT(P0_, P1_, t) do { const int kb_ = KBASE(t); if ((!SK || ACT(t)) && (kb_ + KVBLK - 1 > qlo || kb_ <= qlo + QBLK - 1 - W)) mask_tile(P0_, P1_, qm - kb_, (unsigned)W); } while (0)
    constexpr int NQL = F32 ? 16 : 8;
    constexpr bool SK = WSKIP && !F32;
#define SEAM_K0() do { VMWN(NQL); if constexpr (F32) { SWRITE_KF(0); SBAR(); SLOAD_F((const float*)nxt.V, kbn); } else { SWRITE_HK(0); } SBAR(); } while (0)
    f32x16 pA0, pA1, pB0, pB1; float mnA, mnB, alA, alB; bf16x8 pa0, pa1, pa2, pa3;
    char* qx = lds + LDS_QX + wid * (NQX * 1024) + lane * 16;
#pragma unroll
    for (int e = 0; e < NQX; ++e) *reinterpret_cast<bf16x8*>(qx + e * 1024) = S.qr[8 - NQX + e];
    if constexpr (F32) { VMW(); SWRITE_VF(0); SBAR(); } else { SWRITE_HV(0); SBAR(); }
    if (NT > 1) { if constexpr (F32) SLOAD_F((const float*)Kh, KBASE(1)); else SLOAD_H(Kh, Vh, Bh, KBASE(1), 1); }
    SBAR(); qkt<0, SK>(pA0, pA1, K_lds, r32, hi, S.qr, ACT(0), qx);
    if constexpr (F32) { if (NT > 1) { VMW(); SWRITE_KF(1); SBAR(); SLOAD_F((const float*)Vh, KBASE(1)); } }
    MASKT(pA0, pA1, 0); partialSM(pA0, pA1, m_reg, mnA, alA);
    if (NT > 1) { VMW(); if constexpr (F32) { SWRITE_VF(1); SBAR(); if (NT > 2) SLOAD_F((const float*)Kh, KBASE(2)); } else SWRITE_H(1); }
    __syncthreads();
#define HALF_STEP(PX0, PX1, mnX, alX, PY0, PY1, alY, t, KB, VB, SB) do {                                                      \
        SBAR(); qkt<KB, SK>(PX0, PX1, K_lds, r32, hi, S.qr, ACT(t), qx);                                             \
        finishSM(PY0, PY1, alY, l_reg, pa0, pa1, pa2, pa3); SBAR();                                                           \
        if ((t) + 1 < NT) { if constexpr (F32) { VMW(); SWRITE_KF(SB); SBAR(); SLOAD_F((const float*)Vh, KBASE((t) + 1)); }  \
                            else { SLOAD_H(Kh, Vh, Bh, KBASE((t) + 1), SB); } SBAR(); }                                               \
        pv_tile<VB, SK>(o, vb0, pa0, pa1, pa2, pa3, ACT((t) - 1)); MASKT(PX0, PX1, (t)); partialSM(PX0, PX1, m_reg, mnX, alX);                                        \
        __syncthreads();                                                                                                      \
        if ((t) + 1 < NT) { VMW(); if constexpr (F32) { SWRITE_VF(SB); SBAR(); if ((t) + 2 < NT) SLOAD_F((const float*)Kh, KBASE((t) + 2)); } \
                            else { SWRITE_H(SB); } }                                                                          \
        RESC(alX); __syncthreads(); } while (0)
    for (int t = 1; t + 1 < NT; t += 2) {
        HALF_STEP(pB0, pB1, mnB, alB, pA0, pA1, alA, t, 1, 0, 0);
        HALF_STEP(pA0, pA1, mnA, alA, pB0, pB1, alB, t + 1, 0, 1, 1);
    }
    const bool even = (NT & 1) == 0;
    if (even) { SBAR(); qkt<1, SK>(pB0, pB1, K_lds, r32, hi, S.qr, ACT(NT - 1), qx); SBAR(); }
#define QROW(e) (nxt.Q + (size_t)(wid * QBLK + r32) * PITCH + ((e) >> 1) * 16 + hi * 8 + ((e) & 1) * 4)
    if constexpr (F32) { SLOAD_F((const float*)nxt.K, kbn); SBAR();
#pragma unroll
        for (int e = 0; e < 8; ++e) S.tq[e] = *(const f32x4*)QROW(e); }
    else { SLOAD_H(nxt.K, nxt.V, nxt.Bs, kbn, 0); SBAR();
#pragma unroll
        for (int d0 = 0; d0 < 8; ++d0) S.qr[d0] = load8<TIn>(nxt.Q + (size_t)(wid * QBLK + r32) * PITCH + d0 * 16 + hi * 8); }
    SBAR();
    finishSM(pA0, pA1, alA, l_reg, pa0, pa1, pa2, pa3); SBAR();
    if constexpr (F32) {
#pragma unroll
        for (int e = 8; e < 16; ++e) S.tq[e] = *(const f32x4*)QROW(e); SBAR(); }
#undef QROW
    pv_tile<0, SK>(o, vb0, pa0, pa1, pa2, pa3, ACT(even ? NT - 2 : NT - 1));
    if (even) { MASKT(pB0, pB1, NT - 1); partialSM(pB0, pB1, m_reg, mnB, alB); __syncthreads(); RESC(alB);
        finishSM(pB0, pB1, alB, l_reg, pa0, pa1, pa2, pa3); SBAR(); pv_tile<1, SK>(o, vb0, pa0, pa1, pa2, pa3, ACT(NT - 1)); }
    SBAR(); SEAM_K0();
    if (hi == 0) li_l[r32] = l_reg; asm volatile("s_waitcnt lgkmcnt(0)" ::: "memory");
    float rli[16];
#pragma unroll
    for (int r = 0; r < 16; ++r) rli[r] = __builtin_amdgcn_rcpf(li_l[crow(r, hi)]);
    int tidE = tid; asm volatile("" : "+v"(tidE));
    const int widE = __builtin_amdgcn_readfirstlane(tidE >> 6), r32E = tidE & 31, hiE = (tidE >> 5) & 1;
    TOut* Ow = cur.O + (size_t)(widE * QBLK) * PITCH; const bool wval = widE * QBLK < cur.nvalid;
    if (wval) {
#pragma unroll
    for (int r = 0; r < 16; ++r) { const int orow = crow(r, hiE);
#pragma unroll
        for (int d0 = 0; d0 < 4; ++d0) { const float v = o[d0][r] * rli[r];
            if constexpr (same_t<TOut, float>::v) { Ow[(size_t)orow * PITCH + d0 * 32 + r32E] = v; }
            else { const float vn = __shfl_xor(v, 1);
                   if ((r32E & 1) == 0) *(unsigned*)(Ow + (size_t)orow * PITCH + d0 * 32 + r32E) = cvtpk(v, vn); } } } }
    if constexpr (F32) {
#pragma unroll
        for (int d0 = 0; d0 < 8; ++d0) S.qr[d0] = pack8(S.tq[2 * d0], S.tq[2 * d0 + 1]); }
    __syncthreads();
#undef RESC
#undef KBASE
#undef ACT
#undef MASKT
#undef SEAM_K0
#undef HALF_STEP
}
#undef ROW
#undef VMW
#undef VMWN
#undef SLOAD_H
#undef GLDS
#undef SWRITE_HK
#undef SWRITE_HV
#undef SWRITE_H
#undef SLOAD_F
#undef SWRITE_KF
#undef SWRITE_VF

}
#define GAS __attribute__((address_space(1)))
#define LAS __attribute__((address_space(3)))
typedef GAS unsigned gu32;
typedef GAS unsigned long long gu64;
#define RLX_AGENT __ATOMIC_RELAXED, __HIP_MEMORY_SCOPE_AGENT
#define LDS_WAIT() asm volatile("s_waitcnt lgkmcnt(0)" ::: "memory")
#define VM_WAIT() asm volatile("s_waitcnt vmcnt(0)" ::: "memory")
__device__ __forceinline__ unsigned long long rt() { return __builtin_amdgcn_s_memrealtime(); }
#define XB_TMO      128
#define XB_XCNT(j)  (256  + 64 * (j))
#define XB_XSUB(j)  (1280 + 64 * (j))
#define XB_XGEN(j)  (2304 + 64 * (j))
#define XB_TOP      3328
#define XB_TOPGEN   3392
#define XCD_BAR_WORDS 3456
#define XB_SPIN_CAP (1u << 18)

__device__ __forceinline__ unsigned xb_ld(unsigned* p)              { return __hip_atomic_load(p, __ATOMIC_RELAXED, __HIP_MEMORY_SCOPE_AGENT); }
__device__ __forceinline__ unsigned xb_add(unsigned* p, unsigned v) { return __hip_atomic_fetch_add(p, v, __ATOMIC_RELAXED, __HIP_MEMORY_SCOPE_AGENT); }
__device__ __forceinline__ unsigned xb_xcc_id() { return (unsigned)__builtin_amdgcn_s_getreg((3 << 11) | 20) & 0xFu; }
#define XB_SPIN(cond, bar) do { unsigned _sp = 0; while (cond) { __builtin_amdgcn_s_sleep(1); \
    if ((++_sp & 255u) == 0u) { if (xb_ld(&(bar)[XB_TMO])) break; if (_sp > XB_SPIN_CAP) { atomicAdd(&(bar)[XB_TMO], 1u); break; } } } } while (0)

struct XcdBarrier {
    unsigned* bar; unsigned x;
    volatile LAS unsigned* st;
};

__device__ __forceinline__ XcdBarrier xcd_barrier_post(unsigned* bar, volatile LAS unsigned* st) {
    XcdBarrier b; b.bar = bar; b.x = xb_xcc_id(); b.st = st;
    if (threadIdx.x == 0) (void)xb_add(&bar[XB_XCNT(b.x)], 1u);
    return b;
}
__device__ __forceinline__ void xcd_barrier_complete(unsigned* bar, unsigned x, unsigned& nloc, unsigned& nx) {
    const unsigned G = gridDim.x * gridDim.y * gridDim.z;
    unsigned sum, cnt, mine, sp = 0u;
    for (;;) {
        sum = 0u; cnt = 0u; mine = 0u;
#pragma unroll
        for (unsigned j = 0; j < 16; ++j) { const unsigned c = xb_ld(&bar[XB_XCNT(j)]); sum += c; cnt += (c > 0u) ? 1u : 0u; mine = (j == x) ? c : mine; }
        if (sum == G) break;
        __builtin_amdgcn_s_sleep(1);
        if ((++sp & 255u) == 0u) { if (xb_ld(&bar[XB_TMO])) break; if (sp > XB_SPIN_CAP) { atomicAdd(&bar[XB_TMO], 1u); break; } }
    }
    nloc = mine > 0u ? mine : 1u; nx = cnt > 0u ? cnt : 1u;
}

__device__ __forceinline__ void xcd_barrier(const XcdBarrier& b) {
    asm volatile("s_waitcnt vmcnt(0)" ::: "memory");
    __syncthreads();
    if (threadIdx.x == 0) {
        unsigned* bar = b.bar;
        __builtin_amdgcn_s_waitcnt(0);
        unsigned nloc = b.st[0], nx = b.st[1];
        if (nloc == 0u) { xcd_barrier_complete(bar, b.x, nloc, nx); b.st[0] = nloc; b.st[1] = nx; }
        const unsigned old = xb_add(&bar[XB_XSUB(b.x)], 1u);
        const unsigned gen = old / nloc;
        if (old + 1u == (gen + 1u) * nloc) {
            __builtin_amdgcn_fence(__ATOMIC_RELEASE, "agent");
            asm volatile("s_waitcnt vmcnt(0)" ::: "memory");
            const unsigned og = xb_add(&bar[XB_TOP], 1u);
            const unsigned tg = og / nx;
            if (og + 1u == (tg + 1u) * nx) xb_add(&bar[XB_TOPGEN], 1u);
            else XB_SPIN(xb_ld(&bar[XB_TOPGEN]) == tg, bar);
            __builtin_amdgcn_fence(__ATOMIC_ACQUIRE, "agent");
            xb_add(&bar[XB_XGEN(b.x)], 1u);
            asm volatile("s_waitcnt vmcnt(0)" ::: "memory");
        } else {
            XB_SPIN(xb_ld(&bar[XB_XGEN(b.x)]) == gen, bar);
            __builtin_amdgcn_fence(__ATOMIC_ACQUIRE, "agent");
            asm volatile("s_waitcnt vmcnt(0)" ::: "memory");
        }
    }
    __syncthreads();
}

typedef unsigned short u16;
typedef float f32x4 __attribute__((ext_vector_type(4)));
typedef unsigned u32x4 __attribute__((ext_vector_type(4)));
typedef unsigned u32x2 __attribute__((ext_vector_type(2)));
typedef short bf16x8 __attribute__((ext_vector_type(8)));
constexpr int DM = 2048, TP = 8192, NBP = 4, NBS = 8, TS = 64, PAST = 2048, SKVS = PAST + TS;
constexpr int MP = NBP * TP, MS_ = NBS * TS, M = MP + MS_;
constexpr int DI = 4096, CD = 6144, NH = 64, DFF = 5504, DFF2 = 11008, NIN = 20560;
constexpr int NMOD = 12288;
constexpr float EPS = 1e-6f, LOG2E = 1.4426950408889634f;
constexpr int HALF_ROWS = 16640;
constexpr size_t O_YP = 0, O_YS = O_YP + (size_t)MP * DM, O_KP = O_YS + (size_t)MS_ * DM, O_VP = O_KP + (size_t)MP * DM,
    O_LFP = O_VP + (size_t)MP * DM, O_SSMP = O_LFP + (size_t)MP * 16, O_MCP = O_SSMP + (size_t)NBP * 64 * 64 * 128, O_FCP = O_MCP + (size_t)NBP * 3 * CD,
    O_KS = O_FCP + (size_t)NBP * 2 * DFF2, O_VS = O_KS + (size_t)MS_ * DM, O_LFS = O_VS + (size_t)MS_ * DM, O_SSMS = O_LFS + (size_t)MS_ * 16,
    O_MCS = O_SSMS + (size_t)NBS * 64 * 64 * 128, O_FCS = O_MCS + (size_t)NBS * 3 * CD, O_END = O_FCS + (size_t)NBS * 2 * DFF2;
constexpr size_t MiB = 1u << 20;
constexpr size_t W_MOD = 0, W_BAR = 768 * 1024  , W_BIASP = 1 * MiB, W_BIASS = 3 * MiB, W_HALO = 5 * MiB,
    W_WUP = 8 * MiB, W_WDN = 51 * MiB, W_H = 73 * MiB, W_WIN = 203 * MiB, W_WPM = 284 * MiB, W_WPF = 300 * MiB, W_WOUT = 308 * MiB,
    W_SMALL = 316 * MiB, W_R = 349 * MiB,
    W_XBC = W_R, W_Z = W_R + 390 * MiB, W_GM = W_R, W_GF = W_R + 130 * MiB, W_Q = W_R + 260 * MiB, W_K = W_Q + 130 * MiB, W_V = W_K + 130 * MiB,
    W_U = 203 * MiB, W_G = 553 * MiB, W_END = 999 * MiB;
static_assert((size_t)M * DM * 2 == 130 * MiB && (size_t)M * CD * 2 == 390 * MiB && (size_t)M * DI * 2 == 260 * MiB, "sizes");
static_assert(W_U + (size_t)HALF_ROWS * DFF2 * 2 <= W_G && W_G + (size_t)M * DFF * 2 <= 1024 * MiB, "ffn map");
static_assert(W_SMALL + (size_t)M * 256 * 4 <= W_R, "small map");

struct Prm { const float* in[31]; float* out; unsigned char* ws; };
typedef const __attribute__((address_space(4))) Prm* KPrm;
struct Ctx { int tid, bid, G; };
enum { I_XP = 0, I_XS, I_CP, I_CS, I_CK, I_CV, I_CLF, I_SSM, I_MCV, I_FCV, I_N1W, I_N2W, I_WADA, I_BADA, I_WIN, I_MCW, I_MCB, I_DTB, I_ALOG, I_MD, I_MNW,
       I_FB, I_QNW, I_KNW, I_WPM, I_WPF, I_WOUT, I_WUP, I_FCW, I_FCB, I_WDN };

__device__ __forceinline__ float bflo(unsigned w) { return __uint_as_float(w << 16); }
__device__ __forceinline__ float bfhi(unsigned w) { return __uint_as_float(w & 0xffff0000u); }
typedef float f32x2_t __attribute__((ext_vector_type(2))); typedef __bf16 bf16x2_t __attribute__((ext_vector_type(2)));
__device__ __forceinline__ unsigned pk2(float lo, float hi) { f32x2_t v = {lo, hi}; bf16x2_t b = __builtin_convertvector(v, bf16x2_t); return __builtin_bit_cast(unsigned, b); }
__device__ __forceinline__ u16 f2bf(float f) { return (u16)(pk2(f, 0.f) & 0xffffu); }
__device__ __forceinline__ void unpack8(u32x4 w, float* v) { v[0] = bflo(w.x); v[1] = bfhi(w.x); v[2] = bflo(w.y); v[3] = bfhi(w.y); v[4] = bflo(w.z); v[5] = bfhi(w.z); v[6] = bflo(w.w); v[7] = bfhi(w.w); }
__device__ __forceinline__ u32x4 pack8f(const float* v) { u32x4 w; w.x = pk2(v[0], v[1]); w.y = pk2(v[2], v[3]); w.z = pk2(v[4], v[5]); w.w = pk2(v[6], v[7]); return w; }
__device__ __forceinline__ float bfel(const u32x4& w, int e) { const unsigned x = w[e >> 1]; return (e & 1) ? bfhi(x) : bflo(x); }
__device__ __forceinline__ float sigmoidf_(float x) { return 1.f / (1.f + __expf(-x)); }
__device__ __forceinline__ float siluf_(float x) { return x / (1.f + __expf(-x)); }
__device__ __forceinline__ float wave_sum(float v) {
#pragma unroll
    for (int o = 1; o < 64; o <<= 1) v += __shfl_xor(v, o);
    return v;
}
__device__ __forceinline__ int mod_row(int row) { return row < MP ? (row >> 13) : 4 + ((row - MP) >> 6); }

struct Epi {
    static constexpr bool PERM = true, AFTER_DRAIN = false;
    int mode;
    u16* d0; u16* d1; u16* d2; int t1, t2, p0, p1, p2, f32seg2;
    const float* xp; const float* xs; float* y; const float* mod; u16* gbuf; const u16* gf;
    __device__ __forceinline__ void operator()(const f32x4 (&acc)[2][2][4][2], const pg8::Unit& u, int wr, int wc, int fr, int fq) const {
        const int rl = u.pm * 256 + wr * 64 + fr, cl = wc * 32 + 8 * fq;
        if (mode == 0) {
            u16* base; int pitch, ct; bool f32o = false;
            if (u.pn < t1) { base = d0; pitch = p0; ct = u.pn; } else if (u.pn < t2) { base = d1; pitch = p1; ct = u.pn - t1; } else { base = d2; pitch = p2; ct = u.pn - t2; f32o = (f32seg2 != 0); }
            if (!f32o) {
#pragma unroll
                for (int ai = 0; ai < 2; ++ai)
#pragma unroll
                    for (int m = 0; m < 4; ++m) { u16* rp = base + (size_t)(rl + ai * 128 + m * 16) * pitch + ct * 256 + cl;
#pragma unroll
                        for (int bj = 0; bj < 2; ++bj) { const f32x4 v0 = acc[ai][bj][m][0], v1 = acc[ai][bj][m][1]; u32x4 w; w.x = pk2(v0[0], v0[1]); w.y = pk2(v0[2], v0[3]); w.z = pk2(v1[0], v1[1]); w.w = pk2(v1[2], v1[3]);
                            *(u32x4*)(rp + bj * 128) = w; } }
            } else {
                float* fb = (float*)base;
#pragma unroll
                for (int ai = 0; ai < 2; ++ai)
#pragma unroll
                    for (int m = 0; m < 4; ++m) { float* rp = fb + (size_t)(rl + ai * 128 + m * 16) * pitch + ct * 256 + cl;
#pragma unroll
                        for (int bj = 0; bj < 2; ++bj) { *(f32x4*)(rp + bj * 128) = acc[ai][bj][m][0]; *(f32x4*)(rp + bj * 128 + 4) = acc[ai][bj][m][1]; } }
            }
        } else if (mode == 1 || mode == 2) {
#pragma unroll
            for (int ai = 0; ai < 2; ++ai)
#pragma unroll
                for (int m = 0; m < 4; ++m) { const size_t off = (size_t)(rl + ai * 128 + m * 16) * DM + u.pn * 256 + cl;
#pragma unroll
                    for (int bj = 0; bj < 2; ++bj) { const f32x4 v0 = acc[ai][bj][m][0], v1 = acc[ai][bj][m][1];
                        float a[8] = {v0[0], v0[1], v0[2], v0[3], v1[0], v1[1], v1[2], v1[3]}, g[8], o[8];
                        unpack8(*(const u32x4*)(gbuf + off + bj * 128), g);
                        if (mode == 1) {
#pragma unroll
                            for (int e = 0; e < 8; ++e) o[e] = sigmoidf_(g[e]) * a[e];
                        } else { float f[8]; unpack8(*(const u32x4*)(gf + off + bj * 128), f);
#pragma unroll
                            for (int e = 0; e < 8; ++e) o[e] = g[e] + sigmoidf_(f[e]) * a[e]; }
                        *(u32x4*)(gbuf + off + bj * 128) = pack8f(o); } }
        } else {
#pragma unroll
            for (int ai = 0; ai < 2; ++ai) {
                const int mb = (u.pm < 128) ? (u.pm >> 5) : (4 + (u.pm - 128) * 4 + ai * 2 + wr);
                const float* gp = mod + (size_t)mb * NMOD + (mode == 3 ? 4096 : 10240) + u.pn * 256 + cl;
                f32x4 gv[2][2];
#pragma unroll
                for (int bj = 0; bj < 2; ++bj) { gv[bj][0] = *(const f32x4*)(gp + bj * 128); gv[bj][1] = *(const f32x4*)(gp + bj * 128 + 4); }
#pragma unroll
                for (int m = 0; m < 4; ++m) { const int row = rl + ai * 128 + m * 16; const size_t off = (size_t)row * DM + u.pn * 256 + cl;
                    const float* xr = (mode == 3) ? ((row < MP) ? xp + off : xs + (off - (size_t)MP * DM)) : (const float*)(y + off);
#pragma unroll
                    for (int bj = 0; bj < 2; ++bj) { const f32x4 b0 = *(const f32x4*)(xr + bj * 128), b1 = *(const f32x4*)(xr + bj * 128 + 4);
                        *(f32x4*)(y + off + bj * 128) = b0 + gv[bj][0] * acc[ai][bj][m][0]; *(f32x4*)(y + off + bj * 128 + 4) = b1 + gv[bj][1] * acc[ai][bj][m][1]; } }
            }
        }
    }
};

__device__ __forceinline__ int map_in(int n) {
    if (n < 4096) return 6144 + n;
    if (n < 10240) return n - 4096;
    if (n < 10304) return 10240 + (n - 10240);
    if (n < 12352) return 14592 + (n - 10304);
    if (n < 14400) return 16640 + (n - 12352);
    if (n < 16448) return 18688 + (n - 14400);
    if (n < 16464) return 10304 + (n - 16448);
    if (n < 18512) return 10496 + (n - 16464);
    return 12544 + (n - 18512);
}
__device__ __forceinline__ int map_up(int n) { if (n < DFF) return (n >> 7) * 256 + (n & 127); const int f = n - DFF; return (f >> 7) * 256 + 128 + (f & 127); }
template <int MAP> __device__ __forceinline__ void tr_item(const float* __restrict__ W, int K, int N, u16* WT, float* scr, int item, int lane) {
    const int nblk = (N + 31) / 32, kb = item / nblk, nb = item % nblk, k0 = 64 * kb, n0 = 32 * nb;
    const int nn = n0 + (lane & 31);
#pragma unroll 8
    for (int i = 0; i < 32; ++i) { const int kk = 2 * i + (lane >> 5); scr[kk * 33 + (lane & 31)] = (nn < N) ? W[(size_t)(k0 + kk) * N + nn] : 0.f; }
    asm volatile("s_waitcnt lgkmcnt(0)" ::: "memory");
    const int c = lane & 7;
#pragma unroll
    for (int j = 0; j < 4; ++j) { const int n = (lane >> 3) + 8 * j; const float* s = scr + (8 * c) * 33 + n;
        if (n0 + n < N) { const int row = (MAP == 1) ? map_in(n0 + n) : (MAP == 2) ? map_up(n0 + n) : (n0 + n);
            u32x4 o; o.x = pk2(s[0 * 33], s[1 * 33]); o.y = pk2(s[2 * 33], s[3 * 33]); o.z = pk2(s[4 * 33], s[5 * 33]); o.w = pk2(s[6 * 33], s[7 * 33]);
            *(u32x4*)(WT + (size_t)row * K + k0 + 8 * c) = o; } }
    asm volatile("s_waitcnt lgkmcnt(0)" ::: "memory");
}
__device__ __forceinline__ void phase_prep(KPrm p, const Ctx cx, unsigned char* lds) {
    const int tid = cx.tid, lane = tid & 63, wid = tid >> 6, G = cx.G;
    unsigned char* ws = p->ws;
    {
        float* scr = (float*)(lds + wid * 8448);
        const int gw = cx.bid * 8 + wid, NGW = G * 8;
        constexpr int I_IN = 32 * 643, I_PM = 64 * 64, I_PF = 32 * 64, I_OUT = 32 * 64, I_UP = 32 * 344, I_DN = 86 * 64;
        constexpr int NIT = I_IN + I_PM + I_PF + I_OUT + I_UP + I_DN;
        for (int it = gw; it < NIT; it += NGW) {
            int r = it;
            if (r < I_IN) { tr_item<1>(p->in[I_WIN], DM, NIN, (u16*)(ws + W_WIN), scr, r, lane); continue; } r -= I_IN;
            if (r < I_PM) { tr_item<0>(p->in[I_WPM], DI, DM, (u16*)(ws + W_WPM), scr, r, lane); continue; } r -= I_PM;
            if (r < I_PF) { tr_item<0>(p->in[I_WPF], DM, DM, (u16*)(ws + W_WPF), scr, r, lane); continue; } r -= I_PF;
            if (r < I_OUT) { tr_item<0>(p->in[I_WOUT], DM, DM, (u16*)(ws + W_WOUT), scr, r, lane); continue; } r -= I_OUT;
            if (r < I_UP) { tr_item<2>(p->in[I_WUP], DM, DFF2, (u16*)(ws + W_WUP), scr, r, lane); continue; } r -= I_UP;
            tr_item<0>(p->in[I_WDN], DFF, DM, (u16*)(ws + W_WDN), scr, r, lane);
        }
    }
    __syncthreads();
    {
        float* sl = (float*)lds;
        float* red = (float*)(lds + 12 * 2048 * 4);
        for (int e = tid; e < 12 * 2048; e += 512) { const int b = e >> 11, i = e & 2047; const float cv = (b < 4) ? p->in[I_CP][b * 2048 + i] : p->in[I_CS][(b - 4) * 2048 + i]; sl[e] = siluf_(cv); }
        __syncthreads();
        const float* wada = p->in[I_WADA]; float* mod = (float*)(ws + W_MOD);
        const int col = tid & 31, part = tid >> 5;
        for (int item = cx.bid; item < NMOD / 32; item += G) {
            float acc[12];
#pragma unroll
            for (int b = 0; b < 12; ++b) acc[b] = 0.f;
            const float* wp = wada + (size_t)(part * 128) * NMOD + item * 32 + col;
#pragma unroll 4
            for (int d = 0; d < 128; ++d) { const float w = wp[(size_t)d * NMOD];
#pragma unroll
                for (int b = 0; b < 12; ++b) acc[b] += sl[b * 2048 + part * 128 + d] * w; }
#pragma unroll
            for (int b = 0; b < 12; ++b) red[(part * 12 + b) * 32 + col] = acc[b];
            __syncthreads();
            if (tid < 384) { const int b = tid >> 5; float s = p->in[I_BADA][item * 32 + col];
#pragma unroll
                for (int q = 0; q < 16; ++q) s += red[(q * 12 + b) * 32 + col];
                mod[b * NMOD + item * 32 + col] = s; }
            __syncthreads();
        }
    }
    {
        u16* Ks = (u16*)p->out; u16* Vs = Ks + (size_t)NBS * SKVS * DM;
        const size_t tot8 = (size_t)NBS * PAST * DM / 8, gt = (size_t)cx.bid * 512 + tid, GT = (size_t)G * 512;
        for (size_t i = gt; i < 2 * tot8; i += GT) { const int which = i >= tot8; const size_t j = i - (which ? tot8 : 0);
            const size_t sb = j / ((size_t)PAST * 256), rem = j % ((size_t)PAST * 256), row = rem >> 8, c8 = rem & 255;
            const float* src = p->in[which ? I_CV : I_CK] + ((sb * PAST + row) * DM + c8 * 8);
            const f32x4 a = *(const f32x4*)src, b = *(const f32x4*)(src + 4);
            u32x4 o; o.x = pk2(a[0], a[1]); o.y = pk2(a[2], a[3]); o.z = pk2(b[0], b[1]); o.w = pk2(b[2], b[3]);
            *(u32x4*)((which ? Vs : Ks) + ((sb * SKVS + row) * DM + c8 * 8)) = o; }
    }
}
__device__ __forceinline__ void phase_norm(KPrm p, const Ctx cx, int which) {
    const int tid = cx.tid, lane = tid & 63, wid = tid >> 6;
    const int gw = cx.bid * 8 + wid, NGW = cx.G * 8;
    const float* mod = (const float*)(p->ws + W_MOD); u16* H = (u16*)(p->ws + W_H);
    const float* nw = p->in[which ? I_N2W : I_N1W];
    const int osh = which ? 6144 : 0, osc = which ? 8192 : 2048;
    for (int row = gw; row < M; row += NGW) {
        const float* xr = which ? (p->out + (size_t)row * DM) : ((row < MP) ? p->in[I_XP] + (size_t)row * DM : p->in[I_XS] + (size_t)(row - MP) * DM);
        const float* mr = mod + (size_t)mod_row(row) * NMOD;
        f32x4 v[8]; float ss = 0.f;
#pragma unroll
        for (int j = 0; j < 8; ++j) { v[j] = ((const f32x4*)xr)[lane + 64 * j]; ss += (v[j][0] * v[j][0] + v[j][1] * v[j][1]) + (v[j][2] * v[j][2] + v[j][3] * v[j][3]); }
        const float rs = rsqrtf(wave_sum(ss) * (1.f / DM) + EPS);
#pragma unroll
        for (int j = 0; j < 8; ++j) { const int col = 4 * (lane + 64 * j);
            const f32x4 w = *(const f32x4*)(nw + col), sc = *(const f32x4*)(mr + osc + col), sh = *(const f32x4*)(mr + osh + col);
            const f32x4 o = v[j] * rs * w * (sc + 1.f) + sh;
            u32x2 q; q.x = pk2(o[0], o[1]); q.y = pk2(o[2], o[3]);
            *(u32x2*)(H + (size_t)row * DM + col) = q; }
    }
}
__device__ __forceinline__ void phase_conv(KPrm p, const Ctx cx) {
    const u16* XBC = (const u16*)(p->ws + W_XBC); u16* ACT = (u16*)(p->out + O_KP);
    const float* cw = p->in[I_MCW]; const float* cb = p->in[I_MCB];
    constexpr int NCG = CD / 8, RB = 16, NRB = M / RB;
    const long gt = (long)cx.bid * 512 + cx.tid, GT = (long)cx.G * 512;
    for (long it = gt; it < (long)NCG * NRB; it += GT) {
        const int cgi = (int)(it % NCG), rb = (int)(it / NCG), c0 = cgi * 8, r0 = rb * RB;
        float w[4][8], bs[8];
#pragma unroll
        for (int j = 0; j < 4; ++j) { const f32x4 a0 = *(const f32x4*)(cw + j * CD + c0), a1 = *(const f32x4*)(cw + j * CD + c0 + 4);
#pragma unroll
            for (int e = 0; e < 4; ++e) { w[j][e] = a0[e]; w[j][4 + e] = a1[e]; } }
        { const f32x4 a0 = *(const f32x4*)(cb + c0), a1 = *(const f32x4*)(cb + c0 + 4);
#pragma unroll
          for (int e = 0; e < 4; ++e) { bs[e] = a0[e]; bs[4 + e] = a1[e]; } }
        float h[3][8];
        const bool smp = r0 >= MP; const int tb = smp ? ((r0 - MP) & 63) : (r0 & (TP - 1));
        if (tb == 0) {
            if (smp) { const float* s = p->in[I_MCV] + (size_t)((r0 - MP) >> 6) * 3 * CD + c0;
#pragma unroll
                for (int k = 0; k < 3; ++k)
#pragma unroll
                    for (int e = 0; e < 8; ++e) h[k][e] = s[k * CD + e];
            } else {
#pragma unroll
                for (int k = 0; k < 3; ++k)
#pragma unroll
                    for (int e = 0; e < 8; ++e) h[k][e] = 0.f; }
        } else {
#pragma unroll
            for (int k = 0; k < 3; ++k) unpack8(*(const u32x4*)(XBC + (size_t)(r0 - 3 + k) * CD + c0), h[k]);
        }
#pragma unroll 4
        for (int i = 0; i < RB; ++i) { float u[8], o[8]; unpack8(*(const u32x4*)(XBC + (size_t)(r0 + i) * CD + c0), u);
#pragma unroll
            for (int e = 0; e < 8; ++e) { const float v = bs[e] + w[0][e] * h[0][e] + w[1][e] * h[1][e] + w[2][e] * h[2][e] + w[3][e] * u[e];
                o[e] = siluf_(v); h[0][e] = h[1][e]; h[1][e] = h[2][e]; h[2][e] = u[e]; }
            *(u32x4*)(ACT + (size_t)(r0 + i) * CD + c0) = pack8f(o); }
    }
}
constexpr int SXP = 72, SNP = 136, SYP = 68;
constexpr int L_XT = 0, L_CN = L_XT + 64 * SXP * 2, L_BN = L_CN + 64 * SNP * 2, L_BWT = L_BN + 64 * SNP * 2, L_MS = L_BWT + 128 * SXP * 2, L_HS = L_MS + 64 * SXP * 2,
              L_YS = L_HS + 64 * SNP * 2, L_DT = L_YS + 64 * SYP * 4, L_CUM = L_DT + 256, L_SSD_END = L_CUM + 256;
static_assert(L_SSD_END <= 131072, "ssd lds");
__device__ __forceinline__ void phase_ssd(KPrm p, const Ctx cx, unsigned char* lds) {
    const int tid = cx.tid, lane = tid & 63, wid = __builtin_amdgcn_readfirstlane(tid >> 6), quad = lane >> 4, l15 = lane & 15;
    u16* XT = (u16*)(lds + L_XT); u16* CN = (u16*)(lds + L_CN); u16* BN = (u16*)(lds + L_BN); u16* BWT = (u16*)(lds + L_BWT);
    u16* MSm = (u16*)(lds + L_MS); u16* HS = (u16*)(lds + L_HS); float* YS = (float*)(lds + L_YS); float* DT = (float*)(lds + L_DT); float* CUM = (float*)(lds + L_CUM);
    const u16* XBC = (const u16*)(p->out + O_KP);     u16* Z = (u16*)(p->ws + W_Z); const float* SM = (const float*)(p->ws + W_SMALL);
    const int cg8 = tid & 31, tq = tid >> 5, cgx = tid & 7, tx = tid >> 3;
    const int pb = wid >> 1;
    for (int ch = cx.bid; ch < 256 + 512; ch += cx.G) {
        const bool smp = ch >= 256; int b, hd, nc; long rowbase;
        if (!smp) { b = ch >> 6; hd = ch & 63; nc = TP / 64; rowbase = (long)b * TP; } else { const int su = ch - 256; b = su >> 6; hd = su & 63; nc = 1; rowbase = MP + (long)b * TS; }
        const int g = hd >> 3;
        const float a_h = -__expf(p->in[I_ALOG][hd]), dtb = p->in[I_DTB][hd], Dh = p->in[I_MD][hd];
        const int bccol = (cg8 < 16) ? (4096 + g * 128 + cg8 * 8) : (5120 + g * 128 + (cg8 - 16) * 8);
        const int xcol = hd * 64 + cgx * 8;
        f32x4 st[4];
        const int st_off = (pb * 16 + quad * 4) * 128 + (4 * (wid & 1)) * 16 + l15, hs_off = (pb * 16 + quad * 4) * SNP + (4 * (wid & 1)) * 16 + l15;
        { const float* sin_ = p->in[I_SSM] + ((size_t)b * 64 + hd) * 64 * 128 + st_off;
#pragma unroll
          for (int i = 0; i < 4; ++i)
#pragma unroll
            for (int j = 0; j < 4; ++j) st[i][j] = smp ? sin_[j * 128 + i * 16] : 0.f; }
        __syncthreads();
        { u16* hp_ = HS + hs_off;
#pragma unroll
          for (int i = 0; i < 4; ++i)
#pragma unroll
            for (int j = 0; j < 4; ++j) hp_[j * SNP + i * 16] = f2bf(st[i][j]); }
        u32x4 rbcA[4], rxA, znA, rbcB[4], rxB, znB, pend = {0u, 0u, 0u, 0u}; float dtrA = 0.f, dtrB = 0.f;
#define SSD_LOADS(cc, rbc, rx, zn, dtr) do { const int t0_ = (cc) * 64; \
            const u16* pb_ = XBC + (rowbase + t0_ + 4 * tq) * (long)CD + bccol; const u16* px_ = XBC + (rowbase + t0_ + tx) * (long)CD + xcol; \
            asm volatile("" : "+v"(pb_), "+v"(px_));     \
            _Pragma("unroll") for (int i = 0; i < 4; ++i) rbc[i] = *(const u32x4*)(pb_ + i * CD); \
            rx = *(const u32x4*)px_; \
            zn = *(const u32x4*)(Z + (size_t)(rowbase + t0_ + tx) * DI + xcol); \
            dtr = SM[(size_t)(rowbase + t0_ + lane) * 256 + hd]; } while (0)
#define LBAR() do { asm volatile("s_waitcnt lgkmcnt(0)" ::: "memory"); __builtin_amdgcn_s_barrier(); asm volatile("" ::: "memory"); } while (0)
        SSD_LOADS(0, rbcA, rxA, znA, dtrA); if (nc > 1) SSD_LOADS(1, rbcB, rxB, znB, dtrB);
        auto body = [&](const int c, u32x4 (&rbc)[4], u32x4& rx, u32x4& zn, float& dtr) __attribute__((always_inline)) {
            const long r0 = rowbase + (long)c * 64;
            const u32x4 zw = zn;
            float cum_end;
            { const float dr = dtr + dtb; const float dtv = dr > 20.f ? dr : __logf(1.f + __expf(dr));
              float x = dtv * a_h;
#define DPP_ADD(ctrl, rmask) x += __int_as_float(__builtin_amdgcn_update_dpp(0, __float_as_int(x), ctrl, rmask, 0xf, true))
              DPP_ADD(0x111, 0xf); DPP_ADD(0x112, 0xf); DPP_ADD(0x114, 0xf); DPP_ADD(0x118, 0xf);
              DPP_ADD(0x142, 0xa);
              DPP_ADD(0x143, 0xc);
#undef DPP_ADD
              DT[lane] = dtv; CUM[lane] = x; cum_end = __int_as_float(__builtin_amdgcn_readlane(__float_as_int(x), 63)); }
            {
                u16* NAT = (cg8 < 16) ? BN : CN; const int nc0 = (cg8 & 15) * 8;
#pragma unroll
                for (int ii = 0; ii < 4; ++ii) *(u32x4*)(NAT + (4 * tq + ii) * SNP + nc0) = rbc[ii];
                if (cg8 < 16) {
                    float wg[4]; const f32x4 dt4 = *(const f32x4*)(DT + 4 * tq), cu4 = *(const f32x4*)(CUM + 4 * tq);
#pragma unroll
                    for (int ii = 0; ii < 4; ++ii) wg[ii] = dt4[ii] * __expf(cum_end - cu4[ii]);
#pragma unroll
                    for (int e = 0; e < 8; ++e) { u32x2 q; q.x = pk2(bfel(rbc[0], e) * wg[0], bfel(rbc[1], e) * wg[1]); q.y = pk2(bfel(rbc[2], e) * wg[2], bfel(rbc[3], e) * wg[3]);
                        *(u32x2*)(BWT + (nc0 + e) * SXP + 4 * tq) = q; }
                }
            }
            float xv[8]; unpack8(rx, xv);
#pragma unroll
            for (int e = 0; e < 8; ++e) XT[(cgx * 8 + e) * SXP + tx] = (u16)((e & 1) ? (rx[e >> 1] >> 16) : (rx[e >> 1] & 0xffffu));
            LBAR();
            if (c > 0) *(u32x4*)(Z + (size_t)(r0 - 64 + tx) * DI + xcol) = pend;
            if (c + 2 < nc) SSD_LOADS(c + 2, rbc, rx, zn, dtr);
            const int ti = wid >> 1;
            f32x4 yo[2];
            {
                bf16x8 ca[4], bb[2][4], hb[2][4];
#pragma unroll
                for (int kk = 0; kk < 4; ++kk) ca[kk] = *(const bf16x8*)(CN + (ti * 16 + l15) * SNP + kk * 32 + quad * 8);
#pragma unroll
                for (int s2 = 0; s2 < 2; ++s2)
#pragma unroll
                    for (int kk = 0; kk < 4; ++kk) { bb[s2][kk] = *(const bf16x8*)(BN + ((2 * (wid & 1) + s2) * 16 + l15) * SNP + kk * 32 + quad * 8);
                        hb[s2][kk] = *(const bf16x8*)(HS + ((2 * (wid & 1) + s2) * 16 + l15) * SNP + kk * 32 + quad * 8); }
                const f32x4 ct4 = *(const f32x4*)(CUM + ti * 16 + quad * 4);
                float cs[2], ds[2];
#pragma unroll
                for (int s2 = 0; s2 < 2; ++s2) { const int sx = (2 * (wid & 1) + s2) * 16 + l15; cs[s2] = CUM[sx]; ds[s2] = DT[sx]; }
                f32x4 ga[2] = {{0.f, 0.f, 0.f, 0.f}, {0.f, 0.f, 0.f, 0.f}}; yo[0] = (f32x4){0.f, 0.f, 0.f, 0.f}; yo[1] = (f32x4){0.f, 0.f, 0.f, 0.f};
#pragma unroll
                for (int kk = 0; kk < 4; ++kk) {
                    ga[0] = __builtin_amdgcn_mfma_f32_16x16x32_bf16(ca[kk], bb[0][kk], ga[0], 0, 0, 0); ga[1] = __builtin_amdgcn_mfma_f32_16x16x32_bf16(ca[kk], bb[1][kk], ga[1], 0, 0, 0);
                    yo[0] = __builtin_amdgcn_mfma_f32_16x16x32_bf16(ca[kk], hb[0][kk], yo[0], 0, 0, 0); yo[1] = __builtin_amdgcn_mfma_f32_16x16x32_bf16(ca[kk], hb[1][kk], yo[1], 0, 0, 0); }
#pragma unroll
                for (int s2 = 0; s2 < 2; ++s2) { const int s_ = (2 * (wid & 1) + s2) * 16 + l15;
#pragma unroll
                    for (int j = 0; j < 4; ++j) { const int t = ti * 16 + quad * 4 + j; const float msk = (s_ <= t) ? ds[s2] : 0.f;
                        const float val = ga[s2][j] * __expf(fminf(ct4[j] - cs[s2], 0.f)) * msk; MSm[t * SXP + s_] = f2bf(val); } }
#pragma unroll
                for (int p2 = 0; p2 < 2; ++p2)
#pragma unroll
                    for (int j = 0; j < 4; ++j) yo[p2][j] *= __expf(ct4[j]);
            }
            LBAR();
            {
                bf16x8 ma[2], xa[2], xb[2][2], wb[4][2];
#pragma unroll
                for (int kk = 0; kk < 2; ++kk) { ma[kk] = *(const bf16x8*)(MSm + (ti * 16 + l15) * SXP + kk * 32 + quad * 8); xa[kk] = *(const bf16x8*)(XT + (pb * 16 + l15) * SXP + kk * 32 + quad * 8);
#pragma unroll
                    for (int p2 = 0; p2 < 2; ++p2) xb[p2][kk] = *(const bf16x8*)(XT + ((2 * (wid & 1) + p2) * 16 + l15) * SXP + kk * 32 + quad * 8);
#pragma unroll
                    for (int i = 0; i < 4; ++i) wb[i][kk] = *(const bf16x8*)(BWT + ((4 * (wid & 1) + i) * 16 + l15) * SXP + kk * 32 + quad * 8); }
                const float dec = __expf(cum_end);
#pragma unroll
                for (int i = 0; i < 4; ++i) st[i] = st[i] * dec;
#pragma unroll
                for (int kk = 0; kk < 2; ++kk) {
                    yo[0] = __builtin_amdgcn_mfma_f32_16x16x32_bf16(ma[kk], xb[0][kk], yo[0], 0, 0, 0); yo[1] = __builtin_amdgcn_mfma_f32_16x16x32_bf16(ma[kk], xb[1][kk], yo[1], 0, 0, 0);
#pragma unroll
                    for (int i = 0; i < 4; ++i) st[i] = __builtin_amdgcn_mfma_f32_16x16x32_bf16(xa[kk], wb[i][kk], st[i], 0, 0, 0); }
#pragma unroll
                for (int p2 = 0; p2 < 2; ++p2)
#pragma unroll
                    for (int j = 0; j < 4; ++j) YS[(ti * 16 + quad * 4 + j) * SYP + (2 * (wid & 1) + p2) * 16 + l15] = yo[p2][j];
                u16* hp_ = HS + hs_off;
#pragma unroll
                for (int i = 0; i < 4; ++i)
#pragma unroll
                    for (int j = 0; j < 4; ++j) hp_[j * SNP + i * 16] = f2bf(st[i][j]);
            }
            LBAR();
            {
                const f32x4 y0 = *(const f32x4*)(YS + tx * SYP + cgx * 8), y1 = *(const f32x4*)(YS + tx * SYP + cgx * 8 + 4);
                float zf[8], o[8]; unpack8(zw, zf);
#pragma unroll
                for (int e = 0; e < 8; ++e) { const float yv = (e < 4 ? y0[e & 3] : y1[e & 3]) + Dh * xv[e]; o[e] = yv * siluf_(zf[e]); }
                pend = pack8f(o);
            }
        };
        for (int c = 0; c < nc; c += 2) { body(c, rbcA, rxA, znA, dtrA); if (c + 1 < nc) body(c + 1, rbcB, rxB, znB, dtrB); }
        *(u32x4*)(Z + (size_t)(rowbase + (long)(nc - 1) * 64 + tx) * DI + xcol) = pend;
#undef SSD_LOADS
#undef LBAR
        float* so = p->out + (smp ? O_SSMS : O_SSMP) + ((size_t)b * 64 + hd) * 64 * 128 + st_off;
#pragma unroll
        for (int i = 0; i < 4; ++i)
#pragma unroll
            for (int j = 0; j < 4; ++j) so[j * 128 + i * 16] = st[i][j];
        __syncthreads();
    }
}
__device__ __forceinline__ float logsig_(float f) { return fminf(f, 0.f) - log1pf(__expf(-fabsf(f))); }
__device__ __forceinline__ void phase_gn(KPrm p, const Ctx cx) {
    const int tid = cx.tid, lane = tid & 63, wid = tid >> 6;
    const int gw = cx.bid * 8 + wid, NGW = cx.G * 8;
    const float* SM = (const float*)(p->ws + W_SMALL);
    if (gw < 192) {
        if (gw < 64) { const int b = gw >> 4, h = gw & 15; const float fb = p->in[I_FB][h];
            float* bias = (float*)(p->ws + W_BIASP) + (size_t)(b * 16 + h) * TP; float* lo = p->out + O_LFP;
            const int tb = lane * 128; float s = 0.f;
            for (int i = 0; i < 128; ++i) s += logsig_(SM[(size_t)(b * TP + tb + i) * 256 + 64 + h] + fb);
            float inc = s;
#pragma unroll
            for (int o = 1; o < 64; o <<= 1) { const float y = __shfl_up(inc, o); if (lane >= o) inc += y; }
            float run = inc - s;
            for (int i = 0; i < 128; ++i) { const float lf = logsig_(SM[(size_t)(b * TP + tb + i) * 256 + 64 + h] + fb); run += lf;
                lo[(size_t)(b * TP + tb + i) * 16 + h] = lf; bias[tb + i] = -run * LOG2E; }
        } else { const int u = gw - 64, sb = u >> 4, h = u & 15; const float fb = p->in[I_FB][h];
            float* bias = (float*)(p->ws + W_BIASS) + (size_t)(sb * 16 + h) * SKVS; float* lo = p->out + O_LFS;
            const int tb = lane * 33; float s = 0.f;
            for (int i = 0; i < 33; ++i) { const int pos = tb + i;
                s += (pos < PAST) ? p->in[I_CLF][(size_t)(sb * PAST + pos) * 16 + h] : logsig_(SM[(size_t)(MP + sb * TS + pos - PAST) * 256 + 64 + h] + fb); }
            float inc = s;
#pragma unroll
            for (int o = 1; o < 64; o <<= 1) { const float y = __shfl_up(inc, o); if (lane >= o) inc += y; }
            float run = inc - s;
            for (int i = 0; i < 33; ++i) { const int pos = tb + i; float lf;
                if (pos < PAST) lf = p->in[I_CLF][(size_t)(sb * PAST + pos) * 16 + h];
                else { lf = logsig_(SM[(size_t)(MP + sb * TS + pos - PAST) * 256 + 64 + h] + fb); lo[(size_t)(sb * TS + pos - PAST) * 16 + h] = lf; }
                run += lf; bias[pos] = -run * LOG2E; }
        }
    }
    {
        const u16* XBC = (const u16*)(p->ws + W_XBC);
        const int gt = cx.bid * 512 + tid, GT = cx.G * 512;
        for (int i = gt; i < 12 * 3 * CD; i += GT) { const int bb = i / (3 * CD), r = (i / CD) % 3, c = i % CD;
            if (bb < 4) p->out[O_MCP + i] = bflo(XBC[(size_t)(bb * TP + TP - 3 + r) * CD + c]);
            else p->out[O_MCS + (i - 4 * 3 * CD)] = bflo(XBC[(size_t)(MP + (bb - 4) * TS + TS - 3 + r) * CD + c]); }
    }
    u16* Z = (u16*)(p->ws + W_Z); const float* mnw = p->in[I_MNW];
    for (int row = gw; row < M; row += NGW) {
#pragma unroll 2
        for (int i = 0; i < 8; ++i) { const int col = i * 512 + lane * 8; u16* zp = Z + (size_t)row * DI + col;
            float v[8]; unpack8(*(const u32x4*)zp, v); float ss = 0.f;
#pragma unroll
            for (int e = 0; e < 8; ++e) ss += v[e] * v[e];
            const float rs = rsqrtf(wave_sum(ss) * (1.f / 512.f) + EPS);
            const f32x4 w0 = *(const f32x4*)(mnw + col), w1 = *(const f32x4*)(mnw + col + 4);
#pragma unroll
            for (int e = 0; e < 8; ++e) v[e] = v[e] * rs * (e < 4 ? w0[e & 3] : w1[e & 3]);
            *(u32x4*)zp = pack8f(v); }
    }
}
__device__ __forceinline__ void phase_qk(KPrm p, const Ctx cx) {
    const int tid = cx.tid, lane = tid & 63, wid = tid >> 6;
    const int gw = cx.bid * 8 + wid, NGW = cx.G * 8;
    u16* Q = (u16*)(p->ws + W_Q); u16* K = (u16*)(p->ws + W_K); const u16* V = (const u16*)(p->ws + W_V);
    u16* Ks = (u16*)p->out; u16* Vs = Ks + (size_t)NBS * SKVS * DM;
    const float QS = 0.08838834764831845f * LOG2E;
    const int hc = (lane & 15) * 8;
    const f32x4 qw0 = *(const f32x4*)(p->in[I_QNW] + hc), qw1 = *(const f32x4*)(p->in[I_QNW] + hc + 4), kw0 = *(const f32x4*)(p->in[I_KNW] + hc), kw1 = *(const f32x4*)(p->in[I_KNW] + hc + 4);
    for (int row = gw; row < M; row += NGW) {
        const bool smp = row >= MP;
        float* ko = smp ? p->out + O_KS + (size_t)(row - MP) * DM : p->out + O_KP + (size_t)row * DM;
        float* vo = smp ? p->out + O_VS + (size_t)(row - MP) * DM : p->out + O_VP + (size_t)row * DM;
        size_t srow = 0; if (smp) { const int sb = (row - MP) >> 6, t = (row - MP) & 63; srow = (size_t)(sb * SKVS + PAST + t) * DM; }
#pragma unroll
        for (int it = 0; it < 4; ++it) { const int col = it * 512 + lane * 8; const size_t off = (size_t)row * DM + col;
            float v[8], ss;
            unpack8(*(const u32x4*)(Q + off), v); ss = 0.f;
#pragma unroll
            for (int e = 0; e < 8; ++e) ss += v[e] * v[e];
            ss += __shfl_xor(ss, 1); ss += __shfl_xor(ss, 2); ss += __shfl_xor(ss, 4); ss += __shfl_xor(ss, 8);
            float rs = rsqrtf(ss * (1.f / 128.f) + EPS) * QS;
#pragma unroll
            for (int e = 0; e < 8; ++e) v[e] = v[e] * rs * (e < 4 ? qw0[e & 3] : qw1[e & 3]);
            *(u32x4*)(Q + off) = pack8f(v);
            unpack8(*(const u32x4*)(K + off), v); ss = 0.f;
#pragma unroll
            for (int e = 0; e < 8; ++e) ss += v[e] * v[e];
            ss += __shfl_xor(ss, 1); ss += __shfl_xor(ss, 2); ss += __shfl_xor(ss, 4); ss += __shfl_xor(ss, 8);
            rs = rsqrtf(ss * (1.f / 128.f) + EPS);
#pragma unroll
            for (int e = 0; e < 8; ++e) v[e] = v[e] * rs * (e < 4 ? kw0[e & 3] : kw1[e & 3]);
            const u32x4 kp = pack8f(v);
            *(u32x4*)(K + off) = kp;
            *(f32x4*)(ko + col) = (f32x4){v[0], v[1], v[2], v[3]}; *(f32x4*)(ko + col + 4) = (f32x4){v[4], v[5], v[6], v[7]};
            const u32x4 vw = *(const u32x4*)(V + off); unpack8(vw, v);
            *(f32x4*)(vo + col) = (f32x4){v[0], v[1], v[2], v[3]}; *(f32x4*)(vo + col + 4) = (f32x4){v[4], v[5], v[6], v[7]};
            if (smp) { *(u32x4*)(Ks + srow + col) = kp; *(u32x4*)(Vs + srow + col) = vw; } }
    }
}
typedef att::BlockRef<att::bf16, att::bf16> ARef;
__device__ __forceinline__ ARef att_ref(KPrm p, const Ctx cx, int i, int nbp, int& skv) {
    const int G = cx.G, bid = (cx.G % 8 == 0) ? (cx.bid % 8) * (cx.G / 8) + cx.bid / 8 : cx.bid; ARef r;
    att::bf16* Qb = (att::bf16*)(p->ws + W_Q); const att::bf16* Kb = (const att::bf16*)(p->ws + W_K); const att::bf16* Vb = (const att::bf16*)(p->ws + W_V);
    if (i < nbp) { const int L = bid + (i >> 1) * G, bh = L >> 4, x = L & 15, qb = (i & 1) ? 31 - x : x, b = bh >> 4, h = bh & 15;
        const size_t rq = ((size_t)b * TP + (size_t)qb * 256) * DM + h * 128, rk = (size_t)b * TP * DM + h * 128;
        r.Q = Qb + rq; r.O = Qb + rq; r.K = Kb + rk; r.V = Vb + rk; r.Bs = (const float*)(p->ws + W_BIASP) + (size_t)bh * TP; r.P0 = qb * 256; r.nvalid = 256; skv = TP;
    } else { const int su = bid + (i - nbp) * G, sb = su >> 4, h = su & 15;
        const att::bf16* Ks = (const att::bf16*)p->out; const att::bf16* Vs = Ks + (size_t)NBS * SKVS * DM;
        const size_t rq = ((size_t)MP + (size_t)sb * TS) * DM + h * 128, rk = (size_t)sb * SKVS * DM + h * 128;
        r.Q = Qb + rq; r.O = Qb + rq; r.K = Ks + rk; r.V = Vs + rk; r.Bs = (const float*)(p->ws + W_BIASS) + (size_t)su * SKVS; r.P0 = PAST; r.nvalid = TS; skv = SKVS; }
    return r;
}
__device__ __forceinline__ void phase_att(KPrm p, const Ctx cx, char* lds) {
    const int G = cx.G, bid = (cx.G % 8 == 0) ? (cx.bid % 8) * (cx.G / 8) + cx.bid / 8 : cx.bid;
    const int nip = (bid < 1024) ? (1024 - bid + G - 1) / G : 0, nbp = 2 * nip, nbs = (bid < 128) ? (128 - bid + G - 1) / G : 0, nb = nbp + nbs;
    if (nb == 0) return;
    const int W = 1 << 30;
    int skv, skvn; ARef cur = att_ref(p, cx, 0, nbp, skv);
    att::Seam<att::bf16> S;
    att::causal_swa_prime<att::bf16, att::bf16>(cur, W, lds, S, cx.tid);
    for (int i = 0; i < nb; ++i) {
        const bool last = (i + 1 == nb);
        ARef nxt = cur; skvn = skv; if (!last) nxt = att_ref(p, cx, i + 1, nbp, skvn);
        att::causal_swa_block<att::bf16, att::bf16>(cur, nxt, skv, W, lds, S, cx.tid);
        cur = nxt; skv = skvn;
    }
}
__device__ __forceinline__ void phase_cv(KPrm p, const Ctx cx, int half) {
    const int tid = cx.tid;
    const u16* U = (const u16*)(p->ws + W_U); u16* Gb = (u16*)(p->ws + W_G); u16* HALO = (u16*)(p->ws + W_HALO);
    const float* cw = p->in[I_FCW]; const float* cb = p->in[I_FCB];
    const int row_lo = half ? HALF_ROWS : 0;
    constexpr int NCG = DFF / 8, RB = 16, NRB = HALF_ROWS / RB;
    const long gt = (long)cx.bid * 512 + tid, GT = (long)cx.G * 512;
    for (long it = gt; it < (long)NCG * NRB; it += GT) {
        const int cgi = (int)(it % NCG), rb = (int)(it / NCG); const int f0 = cgi * 8, r0 = row_lo + rb * RB;
        const int ca = (f0 >> 7) * 256 + (f0 & 127), cbb = ca + 128;
        float wa[3][8], wb[3][8], ba[8], bb[8];
#pragma unroll
        for (int k = 0; k < 3; ++k) { const f32x4 a0 = *(const f32x4*)(cw + k * DFF2 + f0), a1 = *(const f32x4*)(cw + k * DFF2 + f0 + 4), b0 = *(const f32x4*)(cw + k * DFF2 + DFF + f0), b1 = *(const f32x4*)(cw + k * DFF2 + DFF + f0 + 4);
#pragma unroll
            for (int e = 0; e < 4; ++e) { wa[k][e] = a0[e]; wa[k][4 + e] = a1[e]; wb[k][e] = b0[e]; wb[k][4 + e] = b1[e]; } }
        { const f32x4 a0 = *(const f32x4*)(cb + f0), a1 = *(const f32x4*)(cb + f0 + 4), b0 = *(const f32x4*)(cb + DFF + f0), b1 = *(const f32x4*)(cb + DFF + f0 + 4);
#pragma unroll
          for (int e = 0; e < 4; ++e) { ba[e] = a0[e]; ba[4 + e] = a1[e]; bb[e] = b0[e]; bb[4 + e] = b1[e]; } }
        float ha[2][8], hb[2][8];
        const bool smp = r0 >= MP; const int tb = smp ? ((r0 - MP) & 63) : (r0 & (TP - 1));
        if (tb == 0) {
            if (smp) { const float* s = p->in[I_FCV] + (size_t)((r0 - MP) >> 6) * 2 * DFF2;
#pragma unroll
                for (int k = 0; k < 2; ++k)
#pragma unroll
                    for (int e = 0; e < 8; ++e) { ha[k][e] = s[k * DFF2 + f0 + e]; hb[k][e] = s[k * DFF2 + DFF + f0 + e]; }
            } else {
#pragma unroll
                for (int k = 0; k < 2; ++k)
#pragma unroll
                    for (int e = 0; e < 8; ++e) { ha[k][e] = 0.f; hb[k][e] = 0.f; } }
        } else if (half && rb == 0) {
#pragma unroll
            for (int k = 0; k < 2; ++k) { unpack8(*(const u32x4*)(HALO + (size_t)k * DFF2 + ca), ha[k]); unpack8(*(const u32x4*)(HALO + (size_t)k * DFF2 + cbb), hb[k]); }
        } else {
#pragma unroll
            for (int k = 0; k < 2; ++k) { const size_t ro = (size_t)(r0 - row_lo - 2 + k) * DFF2; unpack8(*(const u32x4*)(U + ro + ca), ha[k]); unpack8(*(const u32x4*)(U + ro + cbb), hb[k]); }
        }
#pragma unroll 4
        for (int i = 0; i < RB; ++i) { const int r = r0 + i; const size_t ro = (size_t)(r - row_lo) * DFF2;
            const u32x4 uaw = *(const u32x4*)(U + ro + ca), ubw = *(const u32x4*)(U + ro + cbb);
            float ua[8], ub[8], o[8]; unpack8(uaw, ua); unpack8(ubw, ub);
#pragma unroll
            for (int e = 0; e < 8; ++e) { const float va = ba[e] + wa[0][e] * ha[0][e] + wa[1][e] * ha[1][e] + wa[2][e] * ua[e], vb = bb[e] + wb[0][e] * hb[0][e] + wb[1][e] * hb[1][e] + wb[2][e] * ub[e];
                o[e] = siluf_(va) * vb; ha[0][e] = ha[1][e]; ha[1][e] = ua[e]; hb[0][e] = hb[1][e]; hb[1][e] = ub[e]; }
            *(u32x4*)(Gb + (size_t)r * DFF + f0) = pack8f(o);
            const int tpos = (r >= MP) ? ((r - MP) & 63) : (r & (TP - 1)), tlen = (r >= MP) ? TS : TP;
            if (tpos >= tlen - 2) { float* fo = (r >= MP) ? p->out + O_FCS + ((size_t)((r - MP) >> 6) * 2 + (tpos - (tlen - 2))) * DFF2 : p->out + O_FCP + ((size_t)(r >> 13) * 2 + (tpos - (tlen - 2))) * DFF2;
#pragma unroll
                for (int e = 0; e < 8; ++e) { fo[f0 + e] = ua[e]; fo[DFF + f0 + e] = ub[e]; } }
            if (!half && r >= HALF_ROWS - 2) { *(u32x4*)(HALO + (size_t)(r - (HALF_ROWS - 2)) * DFF2 + ca) = uaw; *(u32x4*)(HALO + (size_t)(r - (HALF_ROWS - 2)) * DFF2 + cbb) = ubw; }
        }
    }
}
constexpr int LDS_TOTAL = 147456;
enum { PH_CONV = 100 };
enum { PH_PREP = 0, PH_N1, PH_G1A, PH_SSD, PH_GN, PH_G1B, PH_G2, PH_G1C, PH_QK, PH_ATT, PH_G3, PH_G4, PH_N2, PH_G5A, PH_CVA, PH_G5B, PH_CVB, PH_G6, PH_COUNT };
__device__ __forceinline__ void run_gemms(KPrm p, const Ctx cx, unsigned char* lds, const int first, const int last, const XcdBarrier& xbar) {
#pragma unroll 1
    for (int ph = first; ph <= last; ++ph) {
        unsigned char* ws = p->ws;
        pg8::Gemm g; Epi E;
        g.A = (const u16*)(ws + W_H); g.Bt = nullptr; g.M = M; g.N = DM; g.K = DM;
        E.mode = 0; E.d0 = E.d1 = E.d2 = nullptr; E.t1 = E.t2 = 1 << 20; E.p0 = E.p1 = E.p2 = 0; E.f32seg2 = 0;
        E.xp = p->in[I_XP]; E.xs = p->in[I_XS]; E.y = p->out; E.mod = (const float*)(ws + W_MOD); E.gbuf = (u16*)(ws + W_GM); E.gf = (const u16*)(ws + W_GF);
        switch (ph) {
        case PH_G1A: g.Bt = (const u16*)(ws + W_WIN); g.N = 41 * 256;
            E.d0 = (u16*)(ws + W_XBC); E.p0 = CD; E.t1 = 24; E.d1 = (u16*)(ws + W_Z); E.p1 = DI; E.t2 = 40; E.d2 = (u16*)(ws + W_SMALL); E.p2 = 256; E.f32seg2 = 1; break;
        case PH_G1B: g.Bt = (const u16*)(ws + W_WIN) + (size_t)10496 * DM; g.N = 16 * 256;
            E.d0 = (u16*)(ws + W_GM); E.p0 = DM; E.t1 = 8; E.d1 = (u16*)(ws + W_GF); E.p1 = DM; break;
        case PH_G2: g.A = (const u16*)(ws + W_Z); g.Bt = (const u16*)(ws + W_WPM); g.K = DI; E.mode = 1; break;
        case PH_G1C: g.Bt = (const u16*)(ws + W_WIN) + (size_t)14592 * DM; g.N = 24 * 256;
            E.d0 = (u16*)(ws + W_Q); E.p0 = DM; E.t1 = 8; E.d1 = (u16*)(ws + W_K); E.p1 = DM; E.t2 = 16; E.d2 = (u16*)(ws + W_V); E.p2 = DM; break;
        case PH_G3: g.A = (const u16*)(ws + W_Q); g.Bt = (const u16*)(ws + W_WPF); E.mode = 2; break;
        case PH_G4: g.A = (const u16*)(ws + W_GM); g.Bt = (const u16*)(ws + W_WOUT); E.mode = 3; break;
        case PH_G5A: g.Bt = (const u16*)(ws + W_WUP); g.M = HALF_ROWS; g.N = DFF2; E.d0 = (u16*)(ws + W_U); E.p0 = DFF2; break;
        case PH_G5B: g.A = (const u16*)(ws + W_H) + (size_t)HALF_ROWS * DM; g.Bt = (const u16*)(ws + W_WUP); g.M = HALF_ROWS; g.N = DFF2; E.d0 = (u16*)(ws + W_U); E.p0 = DFF2; break;
        default:   g.A = (const u16*)(ws + W_G); g.Bt = (const u16*)(ws + W_WDN); g.K = DFF; E.mode = 5; break;
        }
        pg8::StaticOrder S; S.init(g.M, g.N, cx.G, cx.bid);
        pg8::gemm_phase<Epi, pg8::StaticOrder, true, true>((PG8_LAS unsigned char*)lds, g, S, E, cx.tid);
        if (ph < last) xcd_barrier(xbar);
    }
}
#define PH_BEGIN() Ctx cx; { int t_ = threadIdx.x; asm volatile("" : "+v"(t_)); int b_ = blockIdx.x, g_ = gridDim.x; asm volatile("" : "+s"(b_), "+s"(g_)); cx.tid = t_; cx.bid = b_; cx.G = g_; } \
    KPrm p = (KPrm)__builtin_amdgcn_kernarg_segment_ptr(); asm volatile("" : "+s"(p))
#ifdef ONLY_PH
#define PH_ON(k) ((k) == ONLY_PH)
#else
#define PH_ON(k) true
#endif
__global__ void __launch_bounds__(512, 2) mega_fwd(Prm prm_unused) {
    extern __shared__ __attribute__((aligned(16))) unsigned char lds[];
    cg::grid_group grid = cg::this_grid();
    volatile LAS unsigned* bst = (volatile LAS unsigned*)(lds + LDS_TOTAL - 64);
    if (threadIdx.x < 2) bst[threadIdx.x] = 0u;
    __syncthreads();
    XcdBarrier xbar; { KPrm p0 = (KPrm)__builtin_amdgcn_kernarg_segment_ptr(); xbar = xcd_barrier_post((unsigned*)(p0->ws + W_BAR), bst); }
#define GSYNC() xcd_barrier(xbar)
#ifndef EXP
#define EXP 0
#endif
    if (PH_ON(PH_PREP)) { PH_BEGIN(); phase_prep(p, cx, lds); } grid.sync();
#if EXP == 3
    { PH_BEGIN(); phase_prep(p, cx, lds); } GSYNC();
#endif
    if (PH_ON(PH_N1)) { PH_BEGIN(); phase_norm(p, cx, 0); } GSYNC();
    if (PH_ON(PH_G1A)) { PH_BEGIN(); run_gemms(p, cx, lds, PH_G1A, PH_G1A, xbar); } GSYNC();
#if EXP == 1
    { PH_BEGIN(); run_gemms(p, cx, lds, PH_G1A, PH_G1A, xbar); } GSYNC();
#endif
    if (PH_ON(PH_CONV)) { PH_BEGIN(); phase_conv(p, cx); } GSYNC();
    if (PH_ON(PH_SSD)) { PH_BEGIN(); phase_ssd(p, cx, lds); } GSYNC();
#if EXP == 2
    { PH_BEGIN(); run_gemms(p, cx, lds, PH_G1A, PH_G1A, xbar); } GSYNC();
    { PH_BEGIN(); phase_conv(p, cx); } GSYNC();
    { PH_BEGIN(); phase_ssd(p, cx, lds); } GSYNC();
#endif
    if (PH_ON(PH_GN)) { PH_BEGIN(); phase_gn(p, cx); } GSYNC();
    if (PH_ON(PH_G1B)) { PH_BEGIN(); run_gemms(p, cx, lds, PH_G1B, PH_G1C, xbar); } GSYNC();
    if (PH_ON(PH_QK)) { PH_BEGIN(); phase_qk(p, cx); } GSYNC();
    if (PH_ON(PH_ATT)) { PH_BEGIN(); phase_att(p, cx, (char*)lds); } GSYNC();
#if EXP == 4
    { PH_BEGIN(); run_gemms(p, cx, lds, PH_G1C, PH_G1C, xbar); } GSYNC();
    { PH_BEGIN(); phase_qk(p, cx); } GSYNC();
    { PH_BEGIN(); phase_att(p, cx, (char*)lds); } GSYNC();
#endif
    if (PH_ON(PH_G3)) { PH_BEGIN(); run_gemms(p, cx, lds, PH_G3, PH_G4, xbar); } GSYNC();
    if (PH_ON(PH_N2)) { PH_BEGIN(); phase_norm(p, cx, 1); } GSYNC();
    if (PH_ON(PH_G5A)) { PH_BEGIN(); run_gemms(p, cx, lds, PH_G5A, PH_G5A, xbar); } GSYNC();
    if (PH_ON(PH_CVA)) { PH_BEGIN(); phase_cv(p, cx, 0); } GSYNC();
    if (PH_ON(PH_G5B)) { PH_BEGIN(); run_gemms(p, cx, lds, PH_G5B, PH_G5B, xbar); } GSYNC();
    if (PH_ON(PH_CVB)) { PH_BEGIN(); phase_cv(p, cx, 1); } GSYNC();
    if (PH_ON(PH_G6)) { PH_BEGIN(); run_gemms(p, cx, lds, PH_G6, PH_G6, xbar); }
#if EXP == 5
#pragma unroll 1
    for (int r = 0; r < 32; ++r) GSYNC();
#endif
}

extern "C" void kernel_launch(void* const* d_in, const int* in_sizes, int n_in, void* d_out, int out_size, void* d_ws, size_t ws_size, hipStream_t stream) {
    static int grid = 0;
    if (grid == 0) {
        if (n_in != 31 || (size_t)out_size != O_END || ws_size < 1024 * MiB) { fprintf(stderr, "kernel_launch: unexpected sizes n_in %d out %d ws %zu\n", n_in, out_size, ws_size); }
        int dev = 0, cus = 0, per_cu = 0;
        hipGetDevice(&dev); hipDeviceGetAttribute(&cus, hipDeviceAttributeMultiprocessorCount, dev);
        hipFuncSetAttribute((const void*)mega_fwd, hipFuncAttributeMaxDynamicSharedMemorySize, LDS_TOTAL);
        hipOccupancyMaxActiveBlocksPerMultiprocessor(&per_cu, (const void*)mega_fwd, 512, LDS_TOTAL);
        (void)hipGetLastError();
        if (per_cu < 1) per_cu = 1;
        grid = cus;
    }
    (void)hipMemsetAsync((char*)d_ws + W_BAR, 0, 16384, stream);
    Prm prm{};
    for (int i = 0; i < 31; ++i) prm.in[i] = (const float*)d_in[i];
    prm.out = (float*)d_out; prm.ws = (unsigned char*)d_ws;
    void* args[] = {&prm};
    hipError_t e = hipLaunchCooperativeKernel((const void*)mega_fwd, dim3(grid), dim3(512), args, LDS_TOTAL, stream);
    if (e != hipSuccess) fprintf(stderr, "cooperative launch failed: %s (grid %d)\n", hipGetErrorString(e), grid);
}
```

```cpp
#include <hip/hip_runtime.h>
#include <hip/hip_cooperative_groups.h>
#include <hip/hip_bf16.h>
#include <cstdio>
#include <cstdint>
namespace cg = cooperative_groups;
namespace pg8 {
#define PG8_LAS __attribute__((address_space(3)))
typedef unsigned short bf16_t;
typedef short bf16x8 __attribute__((ext_vector_type(8)));
typedef float f32x4 __attribute__((ext_vector_type(4)));
typedef unsigned u32x4 __attribute__((ext_vector_type(4)));
constexpr int BM = 256, BK = 64, HALF = 128, HTB = HALF * BK * 2  , STAGE_BYTES = 8 * HTB, NXCD = 8, WGM = 8;

__host__ __device__ __forceinline__ int lds_byte(int r, int c) { const int st = (r >> 4) * 2 + (c >> 5), rr = r & 15, cc = c & 31, ob = rr * 64 + cc * 2; return st * 1024 + (ob ^ (((ob >> 9) & 1) << 5)); }
__host__ __device__ __forceinline__ void stage_rc(int b, int& R, int& C) { const int st = b / 1024, sb = b % 1024, swz = sb ^ (((sb >> 9) & 1) << 5); R = (st >> 1) * 16 + swz / 64; C = (st & 1) * 32 + (swz % 64) / 2; }
__host__ __device__ __forceinline__ int perm32(int rho) { const int n = rho >> 4, i = rho & 15; return 8 * (i >> 2) + 4 * n + (i & 3); }

struct Unit { int pm, pn; };
struct Gemm { const bf16_t* A; const bf16_t* Bt; int M, N, K; };

struct StaticOrder {
    int nM, nN, nwg, G, c;
    __host__ __device__ void init(int M, int N, int G_, int c_) { nM = M / BM; nN = N / BM; nwg = nM * nN; G = G_; c = c_; }
    __host__ __device__ bool next(int i, Unit& u) const {
        const long L = (long)i * G + c; if (L >= nwg) return false;
        int wgid = (int)L; { const int q = nwg / NXCD, r = nwg % NXCD, xcd = wgid % NXCD, off = wgid / NXCD; wgid = (xcd < r ? xcd * (q + 1) : r * (q + 1) + (xcd - r) * q) + off; }
        const int nig = WGM * nN, gid = wgid / nig, fm = gid * WGM, gsz = (nM - fm) < WGM ? (nM - fm) : WGM;
        u.pm = fm + ((wgid % nig) % gsz); u.pn = (wgid % nig) / gsz; return true;
    }
    __device__ __forceinline__ void a_ready(const Unit&) const {}
    __device__ __forceinline__ void done(const Unit&) const {}
};
__device__ __forceinline__ unsigned cvt_pk_bf16(float lo, float hi) { unsigned r; asm volatile("v_cvt_pk_bf16_f32 %0, %1, %2" : "=v"(r) : "v"(lo), "v"(hi)); return r; }
typedef float f32x2 __attribute__((ext_vector_type(2)));
template <class Epi, class Sched, bool ALIGN_EPI = false, bool SP2 = false>
__device__ __forceinline__ void gemm_phase(PG8_LAS unsigned char* lds, const Gemm g, const Sched& S, const Epi& E, const int tid) {
    const int wid = __builtin_amdgcn_readfirstlane(tid >> 6), lane = tid & 63, wr = wid >> 2, wc = wid & 3, fr = lane & 15, fq = lane >> 4;
    const int K = g.K, nt = K / BK;
    unsigned voffA[2], voffB[2];
#pragma unroll
    for (int i = 0; i < 2; ++i) { int R, C; stage_rc(tid * 16 + i * 8192, R, C); const int Rb = Epi::PERM ? ((R & ~31) + perm32(R & 31)) : R;
        voffA[i] = (unsigned)(R * K + C) * 2u; voffB[i] = (unsigned)(Rb * K + C) * 2u; }
    const size_t kstep = (size_t)(BK * 2);
    const size_t hstep = (size_t)HALF * K * 2;
    const size_t tstep = 2 * hstep;
    const unsigned ldsw = (unsigned)wid * 1024u;
    const int aoff = lds_byte(wr * 64 + fr, fq * 8), boff = lds_byte(wc * 32 + fr, fq * 8);
#define PG8_SA(b, h) (((b) * 2 + (h)) * HTB)
#define PG8_SB(b, h) ((4 + (b) * 2 + (h)) * HTB)
#define PG8_STAGE(bufoff, gbase, voff) do { _Pragma("unroll") for (int _i = 0; _i < 2; ++_i) \
        __builtin_amdgcn_global_load_lds((const unsigned*)((const char*)(gbase) + (voff)[_i]), (PG8_LAS unsigned*)(lds + (bufoff) + ldsw + _i * 8192), 16, 0, 0); } while (0)
#define PG8_LDA(dst, b, h) do { _Pragma("unroll") for (int m = 0; m < 4; ++m) _Pragma("unroll") for (int k = 0; k < 2; ++k) dst[m][k] = *(const PG8_LAS bf16x8*)(lds + PG8_SA(b, h) + aoff + m * 2048 + k * 1024); } while (0)
#define PG8_LDB(dst, b, h) do { _Pragma("unroll") for (int n = 0; n < 2; ++n) _Pragma("unroll") for (int k = 0; k < 2; ++k) dst[n][k] = *(const PG8_LAS bf16x8*)(lds + PG8_SB(b, h) + boff + n * 2048 + k * 1024); } while (0)
#define PG8_MMA(ai, bj, At, Bt) do { __builtin_amdgcn_s_setprio(1); _Pragma("unroll") for (int m = 0; m < 4; ++m) _Pragma("unroll") for (int n = 0; n < 2; ++n) _Pragma("unroll") for (int k = 0; k < 2; ++k) \
        acc[ai][bj][m][n] = __builtin_amdgcn_mfma_f32_16x16x32_bf16(Bt[n][k], At[m][k], acc[ai][bj][m][n], 0, 0, 0); __builtin_amdgcn_s_setprio(0); } while (0)
#define PG8_WAIT_V(n) asm volatile("s_waitcnt vmcnt(" #n ")" ::: "memory")
#define PG8_WAIT_L(n) asm volatile("s_waitcnt lgkmcnt(" #n ")" ::: "memory")
#define PG8_BAR __builtin_amdgcn_s_barrier()
#define PG8_SCHED __builtin_amdgcn_sched_barrier(0)
    Unit cur, nxt; int ui = 0;
    if (!S.next(0, cur)) return;
    f32x4 acc[2][2][4][2];
#pragma unroll
    for (int a = 0; a < 2; ++a)
#pragma unroll
        for (int b = 0; b < 2; ++b)
#pragma unroll
            for (int m = 0; m < 4; ++m)
#pragma unroll
                for (int n = 0; n < 2; ++n) acc[a][b][m][n] = (f32x4){0.f, 0.f, 0.f, 0.f};
    bf16x8 At[4][2], B0[2][2], B1[2][2];
    const char* cA = (const char*)g.A + (size_t)cur.pm * tstep; const char* cB = (const char*)g.Bt + (size_t)cur.pn * tstep;
    S.a_ready(cur);
    if constexpr (SP2) {
        PG8_STAGE(PG8_SB(0, 0), cB, voffB); PG8_STAGE(PG8_SB(0, 1), cB + hstep, voffB); PG8_STAGE(PG8_SA(0, 0), cA, voffA); PG8_STAGE(PG8_SA(0, 1), cA + hstep, voffA);
        if (wr == 1) PG8_BAR;
        PG8_WAIT_V(2); PG8_BAR;
        PG8_STAGE(PG8_SB(1, 0), cB + kstep, voffB); PG8_STAGE(PG8_SA(1, 0), cA + kstep, voffA); PG8_STAGE(PG8_SB(1, 1), cB + hstep + kstep, voffB);
        PG8_WAIT_V(6); PG8_BAR;
    } else {
        PG8_STAGE(PG8_SB(0, 0), cB, voffB); PG8_STAGE(PG8_SA(0, 0), cA, voffA); PG8_STAGE(PG8_SB(0, 1), cB + hstep, voffB); PG8_STAGE(PG8_SA(0, 1), cA + hstep, voffA);
        if (wr == 1) PG8_BAR;
        PG8_WAIT_V(4); PG8_BAR;
        PG8_STAGE(PG8_SB(1, 0), cB + kstep, voffB); PG8_STAGE(PG8_SA(1, 0), cA + kstep, voffA); PG8_STAGE(PG8_SB(1, 1), cB + hstep + kstep, voffB);
        PG8_WAIT_V(6); PG8_BAR;
    }
    for (;;) {
        const bool has_next = S.next(ui + 1, nxt);
        const char* nA = has_next ? (const char*)g.A + (size_t)nxt.pm * tstep : cA; const char* nB = has_next ? (const char*)g.Bt + (size_t)nxt.pn * tstep : cB;
        for (int t = 0; t < nt; t += 2) {
            const bool last = (t == nt - 2);
            const char* a1 = cA + (size_t)(t + 1) * kstep;
            const char* a2 = last ? nA : cA + (size_t)(t + 2) * kstep; const char* b2 = last ? nB : cB + (size_t)(t + 2) * kstep;
            const char* a3 = a2 + kstep; const char* b3 = b2 + kstep;
            if (last && has_next) S.a_ready(nxt);
            if constexpr (SP2) {
            PG8_LDB(B0, 0, 0); PG8_LDB(B1, 0, 1); PG8_SCHED; PG8_LDA(At, 0, 0); PG8_STAGE(PG8_SA(1, 1), a1 + hstep, voffA);
            PG8_WAIT_V(8); PG8_WAIT_L(0); PG8_BAR; PG8_MMA(0, 0, At, B0); PG8_MMA(0, 1, At, B1); PG8_BAR; PG8_SCHED;
            PG8_LDA(At, 0, 1); PG8_STAGE(PG8_SB(0, 0), b2, voffB); PG8_STAGE(PG8_SB(0, 1), b2 + hstep, voffB); PG8_STAGE(PG8_SA(0, 0), a2, voffA);
            PG8_WAIT_V(8); PG8_WAIT_L(0); PG8_BAR; PG8_MMA(1, 0, At, B0); PG8_MMA(1, 1, At, B1); PG8_BAR; PG8_SCHED;
            PG8_LDB(B0, 1, 0); PG8_LDB(B1, 1, 1); PG8_SCHED; PG8_LDA(At, 1, 0); PG8_STAGE(PG8_SA(0, 1), a2 + hstep, voffA);
            PG8_WAIT_V(8); PG8_WAIT_L(0); PG8_BAR; PG8_MMA(0, 0, At, B0); PG8_MMA(0, 1, At, B1); PG8_BAR; PG8_SCHED;
            PG8_LDA(At, 1, 1); PG8_STAGE(PG8_SB(1, 0), b3, voffB); PG8_STAGE(PG8_SB(1, 1), b3 + hstep, voffB); PG8_STAGE(PG8_SA(1, 0), a3, voffA);
            PG8_WAIT_V(8); PG8_WAIT_L(0); PG8_BAR; PG8_MMA(1, 0, At, B0); PG8_MMA(1, 1, At, B1); PG8_BAR; PG8_SCHED;
            } else {
            PG8_LDB(B0, 0, 0); PG8_SCHED; PG8_LDA(At, 0, 0); PG8_STAGE(PG8_SA(1, 1), a1 + hstep, voffA);
            PG8_WAIT_L(8); PG8_BAR; PG8_WAIT_L(0); PG8_MMA(0, 0, At, B0); PG8_BAR; PG8_SCHED;
            PG8_LDB(B1, 0, 1); PG8_STAGE(PG8_SB(0, 0), b2, voffB);
            PG8_BAR; PG8_WAIT_L(0); PG8_MMA(0, 1, At, B1); PG8_BAR;
            PG8_LDA(At, 0, 1); PG8_STAGE(PG8_SA(0, 0), a2, voffA);
            PG8_BAR; PG8_WAIT_L(0); PG8_MMA(1, 0, At, B0); PG8_BAR; PG8_SCHED;
            PG8_STAGE(PG8_SB(0, 1), b2 + hstep, voffB);
            PG8_WAIT_V(6); PG8_BAR; PG8_MMA(1, 1, At, B1); PG8_BAR;
            PG8_LDB(B0, 1, 0); PG8_SCHED; PG8_LDA(At, 1, 0); PG8_STAGE(PG8_SA(0, 1), a2 + hstep, voffA);
            PG8_WAIT_L(8); PG8_BAR; PG8_WAIT_L(0); PG8_MMA(0, 0, At, B0); PG8_BAR; PG8_SCHED;
            PG8_LDB(B1, 1, 1); PG8_STAGE(PG8_SB(1, 0), b3, voffB);
            PG8_BAR; PG8_WAIT_L(0); PG8_MMA(0, 1, At, B1); PG8_BAR;
            PG8_LDA(At, 1, 1); PG8_STAGE(PG8_SA(1, 0), a3, voffA);
            PG8_BAR; PG8_WAIT_L(0); PG8_MMA(1, 0, At, B0); PG8_BAR; PG8_SCHED;
            PG8_STAGE(PG8_SB(1, 1), b3 + hstep, voffB);
            PG8_WAIT_V(6); PG8_BAR; PG8_MMA(1, 1, At, B1); PG8_BAR;
            }
        }
        if constexpr (ALIGN_EPI) { if (wr == 0) PG8_BAR; }
        if constexpr (!Epi::AFTER_DRAIN) { E(acc, cur, wr, wc, fr, fq); S.done(cur); }
        if (!has_next) break;
#pragma unroll
        for (int a = 0; a < 2; ++a)
#pragma unroll
            for (int b = 0; b < 2; ++b)
#pragma unroll
                for (int m = 0; m < 4; ++m)
#pragma unroll
                    for (int n = 0; n < 2; ++n) acc[a][b][m][n] = (f32x4){0.f, 0.f, 0.f, 0.f};
        cur = nxt; cA = nA; cB = nB; ++ui;
        if constexpr (ALIGN_EPI) { if (wr == 1) PG8_BAR; }
    }
    PG8_WAIT_V(0);
    if constexpr (!ALIGN_EPI) { if (wr == 0) PG8_BAR; }
    PG8_BAR;
    if constexpr (Epi::AFTER_DRAIN) { E.fused(acc, cur, wr, wc, fr, fq, lds, wid, lane); S.done(cur); }
#undef PG8_SA
#undef PG8_SB
#undef PG8_STAGE
#undef PG8_LDA
#undef PG8_LDB
#undef PG8_MMA
#undef PG8_WAIT_V
#undef PG8_WAIT_L
#undef PG8_BAR
#undef PG8_SCHED
}
}
namespace att {
constexpr int D = 128, PITCH = 2048, NW = 8, QBLK = 32, KVBLK = 64, QB = NW * QBLK;
constexpr int SHM_V = KVBLK * D * 2, SHM_K = KVBLK * D * 2;
constexpr int LDS_BIAS = 2 * SHM_V + 2 * SHM_K + NW * 64 * 4;
constexpr int NQX = 3, LDS_QX = LDS_BIAS + 512;
constexpr int LDS_BYTES = LDS_QX + NW * NQX * 1024;
constexpr float THR2 = 64.f;
constexpr bool WSKIP = false;
typedef __hip_bfloat16 bf16;
typedef short bf16x8 __attribute__((ext_vector_type(8)));
typedef short s16x4 __attribute__((ext_vector_type(4)));
typedef float f32x16 __attribute__((ext_vector_type(16)));
typedef float f32x4 __attribute__((ext_vector_type(4)));
typedef unsigned u32x4 __attribute__((ext_vector_type(4)));
template <class A, class Bt> struct same_t { static constexpr bool v = false; };
template <class A> struct same_t<A, A> { static constexpr bool v = true; };

#define KSWZ(row, colB) ((row) * 256 + ((colB) ^ (((row) & 7) << 4)))
#define SBAR() __builtin_amdgcn_sched_barrier(0)
__device__ __forceinline__ int v_st(int k, int c) { const int kk = (k & ~0xC) | ((k & 4) << 1) | ((k & 8) >> 1); return ((kk >> 3) * 4 + (c >> 5)) * 512 + ((kk & 7) * 32 + (c & 31)) * 2; }
__device__ __forceinline__ int v_rd_base(int lane) { return ((lane & 3) << 3) | (((lane >> 2) & 3) << 6) | (((lane >> 4) & 1) << 5) | (((lane >> 5) & 1) << 8); }
constexpr int v_rd_off(int d0, int ks, int half) { return d0 * 512 + ks * 4096 + half * 2048; }
__device__ __forceinline__ int crow(int r, int hi) { return (r & 3) + 8 * (r >> 2) + 4 * hi; }
__device__ __forceinline__ unsigned cvtpk(float lo, float hi) {
    unsigned r; asm volatile("v_cvt_pk_bf16_f32 %0, %1, %2" : "=v"(r) : "v"(lo), "v"(hi)); return r;
}
__device__ __forceinline__ bf16x8 pack8(f32x4 a, f32x4 b) {
    u32x4 w = {cvtpk(a[0], a[1]), cvtpk(a[2], a[3]), cvtpk(b[0], b[1]), cvtpk(b[2], b[3])};
    return *reinterpret_cast<bf16x8*>(&w);
}
template <class T> __device__ __forceinline__ bf16x8 load8(const T* p) {
    if constexpr (same_t<T, float>::v) { return pack8(*(const f32x4*)p, *(const f32x4*)(p + 4)); }
    else { return *reinterpret_cast<const bf16x8*>(p); }
}
__device__ __forceinline__ void mask_tile(f32x16& p0, f32x16& p1, int dq, unsigned W) {
    const float NEG = -__builtin_inff();
#pragma unroll
    for (int r = 0; r < 16; ++r) {
        const int c = (r & 3) + 8 * (r >> 2);
        if (dq - c < 0) p0[r] = NEG;
        if (dq - c - 32 < 0) p1[r] = NEG;
    }
}
__device__ __forceinline__ void partialSM(f32x16& p0, f32x16& p1, float& m_reg, float& mn, float& alpha) {
    float pmax = p0[0]; for (int r = 1; r < 16; ++r) pmax = fmaxf(pmax, p0[r]); for (int r = 0; r < 16; ++r) pmax = fmaxf(pmax, p1[r]);
    { auto rr = __builtin_amdgcn_permlane32_swap(__float_as_uint(pmax), __float_as_uint(pmax), false, false);
      pmax = fmaxf(__uint_as_float(rr[0]), __uint_as_float(rr[1])); }
    if (__builtin_expect(__all((pmax - m_reg) <= THR2), 1)) { mn = m_reg; alpha = 1.f; }
    else { mn = fmaxf(m_reg, pmax); alpha = __builtin_amdgcn_exp2f(m_reg - mn); m_reg = mn; }
    for (int r = 0; r < 16; ++r) p0[r] = p0[r] - mn; for (int r = 0; r < 16; ++r) p1[r] = p1[r] - mn;
    for (int r = 0; r < 16; ++r) p0[r] = __builtin_amdgcn_exp2f(p0[r]);
}
__device__ __forceinline__ void finishSM(f32x16& p0, f32x16& p1, float alpha, float& l_reg, bf16x8& pa0, bf16x8& pa1, bf16x8& pa2, bf16x8& pa3) {
    for (int r = 0; r < 16; ++r) p1[r] = __builtin_amdgcn_exp2f(p1[r]);
    float ps = 0; for (int r = 0; r < 16; ++r) ps += p0[r]; for (int r = 0; r < 16; ++r) ps += p1[r];
    { auto rr = __builtin_amdgcn_permlane32_swap(__float_as_uint(ps), __float_as_uint(ps), false, false);
      ps = __uint_as_float(rr[0]) + __uint_as_float(rr[1]); }
    l_reg = l_reg * alpha + ps;
#define PK4(P, B_, OUT) do { unsigned a0 = cvtpk(P[B_+0], P[B_+1]), a1 = cvtpk(P[B_+2], P[B_+3]);                          \
        unsigned b0 = cvtpk(P[B_+4], P[B_+5]), b1 = cvtpk(P[B_+6], P[B_+7]);                                             \
        auto r0 = __builtin_amdgcn_permlane32_swap(a0, b0, false, false); auto r1 = __builtin_amdgcn_permlane32_swap(a1, b1, false, false); \
        u32x4 w = {r0[0], r1[0], r0[1], r1[1]}; OUT = *reinterpret_cast<bf16x8*>(&w); } while (0)
    PK4(p0, 0, pa0); PK4(p0, 8, pa1); PK4(p1, 0, pa2); PK4(p1, 8, pa3);
#undef PK4
}
template <int KB, bool SK>
__device__ __forceinline__ void qkt(f32x16& p0, f32x16& p1, const char* K_lds, int r32, int hi, const bf16x8* qr, bool act, const char* qx) {
    if (SK && !act) { const float NEG = -__builtin_inff();
#pragma unroll
        for (int r = 0; r < 16; ++r) { p0[r] = NEG; p1[r] = NEG; } return; }
    { const float* bl = (const float*)(K_lds - 2 * SHM_V + LDS_BIAS) + KB * 64 + 4 * hi;
#pragma unroll
      for (int g = 0; g < 4; ++g) { const f32x4 u0 = *(const f32x4*)(bl + 8 * g), u1 = *(const f32x4*)(bl + 32 + 8 * g);
        p0[4*g] = u0[0]; p0[4*g+1] = u0[1]; p0[4*g+2] = u0[2]; p0[4*g+3] = u0[3]; p1[4*g] = u1[0]; p1[4*g+1] = u1[1]; p1[4*g+2] = u1[2]; p1[4*g+3] = u1[3]; } }
    const char* kb[4];
#pragma unroll
    for (int dd = 0; dd < 4; ++dd) kb[dd] = K_lds + KB * SHM_K + KSWZ(r32, (dd * 16 + hi * 8) * 2);
#pragma unroll
    for (int d0 = 0; d0 < 8; ++d0) { const char* a = kb[d0 & 3] + (d0 >> 2) * 128;
        bf16x8 b0 = *reinterpret_cast<const bf16x8*>(a);
        bf16x8 b1 = *reinterpret_cast<const bf16x8*>(a + 32 * 256);
        const bf16x8 qv = (d0 < 8 - NQX) ? qr[d0] : *reinterpret_cast<const bf16x8*>(qx + (d0 - (8 - NQX)) * 1024);
        p0 = __builtin_amdgcn_mfma_f32_32x32x16_bf16(b0, qv, p0, 0, 0, 0);
        p1 = __builtin_amdgcn_mfma_f32_32x32x16_bf16(b1, qv, p1, 0, 0, 0); }
}
template <int VB, bool SK>
__device__ __forceinline__ void pv_tile(f32x16* o, int vb0, bf16x8 pa0, bf16x8 pa1, bf16x8 pa2, bf16x8 pa3, bool act) {
    if (SK && !act) return;
#define TRRD(dst, off) asm volatile("ds_read_b64_tr_b16 %0, %1 offset:%2" : "=&v"(dst) : "v"(vb0), "i"(off) : "memory")
#define PV_D0(d0) do { s16x4 l0, l1, l2, l3, h0, h1, h2, h3; constexpr int b_ = VB * SHM_V + v_rd_off(d0, 0, 0);     \
        TRRD(l0, b_); TRRD(h0, b_ + 2048); TRRD(l1, b_ + 4096); TRRD(h1, b_ + 6144); TRRD(l2, b_ + 8192); TRRD(h2, b_ + 10240); TRRD(l3, b_ + 12288); TRRD(h3, b_ + 14336); \
        asm volatile("s_waitcnt lgkmcnt(0)" ::: "memory"); SBAR();                 \
        o[d0] = __builtin_amdgcn_mfma_f32_32x32x16_bf16(pa0, (bf16x8){l0[0], l0[1], l0[2], l0[3], h0[0], h0[1], h0[2], h0[3]}, o[d0], 0, 0, 0);   \
        o[d0] = __builtin_amdgcn_mfma_f32_32x32x16_bf16(pa1, (bf16x8){l1[0], l1[1], l1[2], l1[3], h1[0], h1[1], h1[2], h1[3]}, o[d0], 0, 0, 0);   \
        o[d0] = __builtin_amdgcn_mfma_f32_32x32x16_bf16(pa2, (bf16x8){l2[0], l2[1], l2[2], l2[3], h2[0], h2[1], h2[2], h2[3]}, o[d0], 0, 0, 0);   \
        o[d0] = __builtin_amdgcn_mfma_f32_32x32x16_bf16(pa3, (bf16x8){l3[0], l3[1], l3[2], l3[3], h3[0], h3[1], h3[2], h3[3]}, o[d0], 0, 0, 0); } while (0)
    PV_D0(0); PV_D0(1); PV_D0(2); PV_D0(3);
#undef PV_D0
#undef TRRD
}

template <class TIn, class TOut> struct BlockRef { const TIn* Q; const TIn* K; const TIn* V; TOut* O; const float* Bs; int P0; int nvalid; };
template <class TIn> struct Seam {
    bf16x8 qr[8];
    bf16x8 st_v0, st_v1, st_k0, st_k1; f32x4 sf0, sf1, sf2, sf3;
    f32x4 tq[16];
};
__device__ __forceinline__ int swa_jlo(int P0, int W) { const int lowk = P0 - W + 1; return lowk > 0 ? lowk / KVBLK : 0; }
#define ROW(p, k0, rr) ((p) + (size_t)((k0) + (rr)) * PITCH + sc)
#define VMW() asm volatile("s_waitcnt vmcnt(0)" ::: "memory")
#define VMWN(n) asm volatile("s_waitcnt vmcnt(%0)" :: "i"(n) : "memory")
#define GLDS(gp_, lp_, sz_) __builtin_amdgcn_global_load_lds((const unsigned*)(gp_), (__attribute__((address_space(3))) unsigned*)(lp_), sz_, 0, 0)
#define SLOAD_H(Kp, Vp, Bp, k0, bb_) do { S.st_v0 = load8<TIn>(ROW(Vp, k0, sr)); S.st_v1 = load8<TIn>(ROW(Vp, k0, 32 + sr));              \
                         { const TIn* kg_ = (Kp) + (size_t)(k0) * PITCH; char* kl_ = K_lds + (bb_) * SHM_K + wid * 2048; GLDS(kg_ + ksrc0, kl_, 16); GLDS(kg_ + ksrc1, kl_ + 1024, 16); } \
                         if (wid == 0) GLDS((Bp) + (k0) + lane, lds + LDS_BIAS + (bb_) * 256, 4); } while (0)
#define SWRITE_HK(bf) do { } while (0)
#define SWRITE_HV(bf) do { *(bf16x8*)(V_lds + (bf) * SHM_V + vst0) = S.st_v0; *(bf16x8*)(V_lds + (bf) * SHM_V + vst1) = S.st_v1; } while (0)
#define SWRITE_H(bf) do { SWRITE_HV(bf); SWRITE_HK(bf); } while (0)
#define SLOAD_F(p, k0) do { S.sf0 = *(const f32x4*)ROW(p, k0, sr); S.sf1 = *(const f32x4*)(ROW(p, k0, sr) + 4);                \
                            S.sf2 = *(const f32x4*)ROW(p, k0, 32 + sr); S.sf3 = *(const f32x4*)(ROW(p, k0, 32 + sr) + 4); } while (0)
#define SWRITE_KF(bf) do { *(bf16x8*)(K_lds + (bf) * SHM_K + kws) = pack8(S.sf0, S.sf1); *(bf16x8*)(K_lds + (bf) * SHM_K + kws + 32 * 256) = pack8(S.sf2, S.sf3); } while (0)
#define SWRITE_VF(bf) do { *(bf16x8*)(V_lds + (bf) * SHM_V + vst0) = pack8(S.sf0, S.sf1); *(bf16x8*)(V_lds + (bf) * SHM_V + vst1) = pack8(S.sf2, S.sf3); } while (0)
template <class TIn, class TOut>
__device__ __forceinline__ void causal_swa_prime(const BlockRef<TIn, TOut>& cur, int W, char* lds, Seam<TIn>& S, const int tid) {
    constexpr bool F32 = same_t<TIn, float>::v;
    const int wid = __builtin_amdgcn_readfirstlane(tid >> 6), lane = tid & 63, r32 = lane & 31, hi = lane >> 5;
    const int sr = tid >> 4, sc = (tid & 15) * 8, kws = KSWZ(sr, sc * 2); char* K_lds = lds + 2 * SHM_V; (void)kws;
    const int ksrc0 = (8 * wid + (lane >> 4)) * PITCH + ((lane & 15) ^ (lane >> 4)) * 8, ksrc1 = (8 * wid + 4 + (lane >> 4)) * PITCH + ((lane & 15) ^ (4 + (lane >> 4))) * 8;
    const int kb0 = swa_jlo(cur.P0, W) * KVBLK;
    for (int d0 = 0; d0 < 8; ++d0) S.qr[d0] = load8<TIn>(cur.Q + (size_t)(wid * QBLK + r32) * PITCH + d0 * 16 + hi * 8);
    if constexpr (F32) { SLOAD_F((const float*)cur.K, kb0); VMW(); SWRITE_KF(0); SBAR(); SLOAD_F((const float*)cur.V, kb0); }
    else { SLOAD_H(cur.K, cur.V, cur.Bs, kb0, 0); VMW(); SWRITE_HK(0); }
    __syncthreads();
}
template <class TIn, class TOut>
__device__ __forceinline__ void causal_swa_block(const BlockRef<TIn, TOut>& cur, const BlockRef<TIn, TOut>& nxt, int skv, int W, char* lds, Seam<TIn>& S, const int tid) {
    constexpr bool F32 = same_t<TIn, float>::v;
    const int wid = __builtin_amdgcn_readfirstlane(tid >> 6), lane = tid & 63, r32 = lane & 31, hi = lane >> 5;
    const int j_lo = swa_jlo(cur.P0, W);
    int j_hi = (cur.P0 + QB - 1) / KVBLK + 1; if (j_hi > skv / KVBLK) j_hi = skv / KVBLK;
    const int NT = j_hi - j_lo;
    const int kbn = swa_jlo(nxt.P0, W) * KVBLK;
    const int qlo = cur.P0 + wid * QBLK, qm = qlo + r32 - 4 * hi;
    char* V_lds = lds; char* K_lds = lds + 2 * SHM_V;
    float* ws = (float*)(lds + 2 * SHM_V + 2 * SHM_K) + wid * 64; float* li_l = ws, * al_l = ws + 32;
    float m_reg = -1e30f, l_reg = 0; f32x16 o[4] = {};
    const int sr = tid >> 4, sc = (tid & 15) * 8, vst0 = v_st(sr, sc), vst1 = v_st(32 + sr, sc), kws = KSWZ(sr, sc * 2);
    const int vb0 = (int)(uintptr_t)V_lds + v_rd_base(lane); (void)kws;
    const int ksrc0 = (8 * wid + (lane >> 4)) * PITCH + ((lane & 15) ^ (lane >> 4)) * 8, ksrc1 = (8 * wid + 4 + (lane >> 4)) * PITCH + ((lane & 15) ^ (4 + (lane >> 4))) * 8;
    const TIn* Kh = cur.K; const TIn* Vh = cur.V; const float* Bh = cur.Bs;
#define RESC(a) do { if (__any((a) < 1.f)) { if (hi == 0) al_l[r32] = (a); asm volatile("s_waitcnt lgkmcnt(0)" ::: "memory");              \
                     for (int d_ = 0; d_ < 4; ++d_) for (int r = 0; r < 16; ++r) o[d_][r] *= al_l[crow(r, hi)]; } } while (0)
#define KBASE(t) ((j_lo + (t)) * KVBLK)
#define ACT(t) (KBASE(t) <= qlo + QBLK - 1 && KBASE(t) + KVBLK - 1 >= qlo - W + 1)
#define MASKT(P0_, P1_, t) do { const int kb_ = KBASE(t); if ((!SK || ACT(t)) && (kb_ + KVBLK - 1 > qlo || kb_ <= qlo + QBLK - 1 - W)) mask_tile(P0_, P1_, qm - kb_, (unsigned)W); } while (0)
    constexpr int NQL = F32 ? 16 : 8;
    constexpr bool SK = WSKIP && !F32;
#define SEAM_K0() do { VMWN(NQL); if constexpr (F32) { SWRITE_KF(0); SBAR(); SLOAD_F((const float*)nxt.V, kbn); } else { SWRITE_HK(0); } SBAR(); } while (0)
    f32x16 pA0, pA1, pB0, pB1; float mnA, mnB, alA, alB; bf16x8 pa0, pa1, pa2, pa3;
    char* qx = lds + LDS_QX + wid * (NQX * 1024) + lane * 16;
#pragma unroll
    for (int e = 0; e < NQX; ++e) *reinterpret_cast<bf16x8*>(qx + e * 1024) = S.qr[8 - NQX + e];
    if constexpr (F32) { VMW(); SWRITE_VF(0); SBAR(); } else { SWRITE_HV(0); SBAR(); }
    if (NT > 1) { if constexpr (F32) SLOAD_F((const float*)Kh, KBASE(1)); else SLOAD_H(Kh, Vh, Bh, KBASE(1), 1); }
    SBAR(); qkt<0, SK>(pA0, pA1, K_lds, r32, hi, S.qr, ACT(0), qx);
    if constexpr (F32) { if (NT > 1) { VMW(); SWRITE_KF(1); SBAR(); SLOAD_F((const float*)Vh, KBASE(1)); } }
    MASKT(pA0, pA1, 0); partialSM(pA0, pA1, m_reg, mnA, alA);
    if (NT > 1) { VMW(); if constexpr (F32) { SWRITE_VF(1); SBAR(); if (NT > 2) SLOAD_F((const float*)Kh, KBASE(2)); } else SWRITE_H(1); }
    __syncthreads();
#define HALF_STEP(PX0, PX1, mnX, alX, PY0, PY1, alY, t, KB, VB, SB) do {                                                      \
        SBAR(); qkt<KB, SK>(PX0, PX1, K_lds, r32, hi, S.qr, ACT(t), qx);                                             \
        finishSM(PY0, PY1, alY, l_reg, pa0, pa1, pa2, pa3); SBAR();                                                           \
        if ((t) + 1 < NT) { if constexpr (F32) { VMW(); SWRITE_KF(SB); SBAR(); SLOAD_F((const float*)Vh, KBASE((t) + 1)); }  \
                            else { SLOAD_H(Kh, Vh, Bh, KBASE((t) + 1), SB); } SBAR(); }                                               \
        pv_tile<VB, SK>(o, vb0, pa0, pa1, pa2, pa3, ACT((t) - 1)); MASKT(PX0, PX1, (t)); partialSM(PX0, PX1, m_reg, mnX, alX);                                        \
        __syncthreads();                                                                                                      \
        if ((t) + 1 < NT) { VMW(); if constexpr (F32) { SWRITE_VF(SB); SBAR(); if ((t) + 2 < NT) SLOAD_F((const float*)Kh, KBASE((t) + 2)); } \
                            else { SWRITE_H(SB); } }                                                                          \
        RESC(alX); __syncthreads(); } while (0)
    for (int t = 1; t + 1 < NT; t += 2) {
        HALF_STEP(pB0, pB1, mnB, alB, pA0, pA1, alA, t, 1, 0, 0);
        HALF_STEP(pA0, pA1, mnA, alA, pB0, pB1, alB, t + 1, 0, 1, 1);
    }
    const bool even = (NT & 1) == 0;
    if (even) { SBAR(); qkt<1, SK>(pB0, pB1, K_lds, r32, hi, S.qr, ACT(NT - 1), qx); SBAR(); }
#define QROW(e) (nxt.Q + (size_t)(wid * QBLK + r32) * PITCH + ((e) >> 1) * 16 + hi * 8 + ((e) & 1) * 4)
    if constexpr (F32) { SLOAD_F((const float*)nxt.K, kbn); SBAR();
#pragma unroll
        for (int e = 0; e < 8; ++e) S.tq[e] = *(const f32x4*)QROW(e); }
    else { SLOAD_H(nxt.K, nxt.V, nxt.Bs, kbn, 0); SBAR();
#pragma unroll
        for (int d0 = 0; d0 < 8; ++d0) S.qr[d0] = load8<TIn>(nxt.Q + (size_t)(wid * QBLK + r32) * PITCH + d0 * 16 + hi * 8); }
    SBAR();
    finishSM(pA0, pA1, alA, l_reg, pa0, pa1, pa2, pa3); SBAR();
    if constexpr (F32) {
#pragma unroll
        for (int e = 8; e < 16; ++e) S.tq[e] = *(const f32x4*)QROW(e); SBAR(); }
#undef QROW
    pv_tile<0, SK>(o, vb0, pa0, pa1, pa2, pa3, ACT(even ? NT - 2 : NT - 1));
    if (even) { MASKT(pB0, pB1, NT - 1); partialSM(pB0, pB1, m_reg, mnB, alB); __syncthreads(); RESC(alB);
        finishSM(pB0, pB1, alB, l_reg, pa0, pa1, pa2, pa3); SBAR(); pv_tile<1, SK>(o, vb0, pa0, pa1, pa2, pa3, ACT(NT - 1)); }
    SBAR(); SEAM_K0();
    if (hi == 0) li_l[r32] = l_reg; asm volatile("s_waitcnt lgkmcnt(0)" ::: "memory");
    float rli[16];
#pragma unroll
    for (int r = 0; r < 16; ++r) rli[r] = __builtin_amdgcn_rcpf(li_l[crow(r, hi)]);
    int tidE = tid; asm volatile("" : "+v"(tidE));
    const int widE = __builtin_amdgcn_readfirstlane(tidE >> 6), r32E = tidE & 31, hiE = (tidE >> 5) & 1;
    TOut* Ow = cur.O + (size_t)(widE * QBLK) * PITCH; const bool wval = widE * QBLK < cur.nvalid;
    if (wval) {
#pragma unroll
    for (int r = 0; r < 16; ++r) { const int orow = crow(r, hiE);
#pragma unroll
        for (int d0 = 0; d0 < 4; ++d0) { const float v = o[d0][r] * rli[r];
            if constexpr (same_t<TOut, float>::v) { Ow[(size_t)orow * PITCH + d0 * 32 + r32E] = v; }
            else { const float vn = __shfl_xor(v, 1);
                   if ((r32E & 1) == 0) *(unsigned*)(Ow + (size_t)orow * PITCH + d0 * 32 + r32E) = cvtpk(v, vn); } } } }
    if constexpr (F32) {
#pragma unroll
        for (int d0 = 0; d0 < 8; ++d0) S.qr[d0] = pack8(S.tq[2 * d0], S.tq[2 * d0 + 1]); }
    __syncthreads();
#undef RESC
#undef KBASE
#undef ACT
#undef MASKT
#undef SEAM_K0
#undef HALF_STEP
}
#undef ROW
#undef VMW
#undef VMWN
#undef SLOAD_H
#undef GLDS
#undef SWRITE_HK
#undef SWRITE_HV
#undef SWRITE_H
#undef SLOAD_F
#undef SWRITE_KF
#undef SWRITE_VF

}
#define GAS __attribute__((address_space(1)))
#define LAS __attribute__((address_space(3)))
typedef GAS unsigned gu32;
typedef GAS unsigned long long gu64;
#define RLX_AGENT __ATOMIC_RELAXED, __HIP_MEMORY_SCOPE_AGENT
#define LDS_WAIT() asm volatile("s_waitcnt lgkmcnt(0)" ::: "memory")
#define VM_WAIT() asm volatile("s_waitcnt vmcnt(0)" ::: "memory")
__device__ __forceinline__ unsigned long long rt() { return __builtin_amdgcn_s_memrealtime(); }
#define XB_TMO      128
#define XB_XCNT(j)  (256  + 64 * (j))
#define XB_XSUB(j)  (1280 + 64 * (j))
#define XB_XGEN(j)  (2304 + 64 * (j))
#define XB_TOP      3328
#define XB_TOPGEN   3392
#define XCD_BAR_WORDS 3456
#define XB_SPIN_CAP (1u << 18)

__device__ __forceinline__ unsigned xb_ld(unsigned* p)              { return __hip_atomic_load(p, __ATOMIC_RELAXED, __HIP_MEMORY_SCOPE_AGENT); }
__device__ __forceinline__ unsigned xb_add(unsigned* p, unsigned v) { return __hip_atomic_fetch_add(p, v, __ATOMIC_RELAXED, __HIP_MEMORY_SCOPE_AGENT); }
__device__ __forceinline__ unsigned xb_xcc_id() { return (unsigned)__builtin_amdgcn_s_getreg((3 << 11) | 20) & 0xFu; }
#define XB_SPIN(cond, bar) do { unsigned _sp = 0; while (cond) { __builtin_amdgcn_s_sleep(1); \
    if ((++_sp & 255u) == 0u) { if (xb_ld(&(bar)[XB_TMO])) break; if (_sp > XB_SPIN_CAP) { atomicAdd(&(bar)[XB_TMO], 1u); break; } } } } while (0)

struct XcdBarrier {
    unsigned* bar; unsigned x;
    volatile LAS unsigned* st;
};

__device__ __forceinline__ XcdBarrier xcd_barrier_post(unsigned* bar, volatile LAS unsigned* st) {
    XcdBarrier b; b.bar = bar; b.x = xb_xcc_id(); b.st = st;
    if (threadIdx.x == 0) (void)xb_add(&bar[XB_XCNT(b.x)], 1u);
    return b;
}
__device__ __forceinline__ void xcd_barrier_complete(unsigned* bar, unsigned x, unsigned& nloc, unsigned& nx) {
    const unsigned G = gridDim.x * gridDim.y * gridDim.z;
    unsigned sum, cnt, mine, sp = 0u;
    for (;;) {
        sum = 0u; cnt = 0u; mine = 0u;
#pragma unroll
        for (unsigned j = 0; j < 16; ++j) { const unsigned c = xb_ld(&bar[XB_XCNT(j)]); sum += c; cnt += (c > 0u) ? 1u : 0u; mine = (j == x) ? c : mine; }
        if (sum == G) break;
        __builtin_amdgcn_s_sleep(1);
        if ((++sp & 255u) == 0u) { if (xb_ld(&bar[XB_TMO])) break; if (sp > XB_SPIN_CAP) { atomicAdd(&bar[XB_TMO], 1u); break; } }
    }
    nloc = mine > 0u ? mine : 1u; nx = cnt > 0u ? cnt : 1u;
}

__device__ __forceinline__ void xcd_barrier(const XcdBarrier& b) {
    asm volatile("s_waitcnt vmcnt(0)" ::: "memory");
    __syncthreads();
    if (threadIdx.x == 0) {
        unsigned* bar = b.bar;
        __builtin_amdgcn_s_waitcnt(0);
        unsigned nloc = b.st[0], nx = b.st[1];
        if (nloc == 0u) { xcd_barrier_complete(bar, b.x, nloc, nx); b.st[0] = nloc; b.st[1] = nx; }
        const unsigned old = xb_add(&bar[XB_XSUB(b.x)], 1u);
        const unsigned gen = old / nloc;
        if (old + 1u == (gen + 1u) * nloc) {
            __builtin_amdgcn_fence(__ATOMIC_RELEASE, "agent");
            asm volatile("s_waitcnt vmcnt(0)" ::: "memory");
            const unsigned og = xb_add(&bar[XB_TOP], 1u);
            const unsigned tg = og / nx;
            if (og + 1u == (tg + 1u) * nx) xb_add(&bar[XB_TOPGEN], 1u);
            else XB_SPIN(xb_ld(&bar[XB_TOPGEN]) == tg, bar);
            __builtin_amdgcn_fence(__ATOMIC_ACQUIRE, "agent");
            xb_add(&bar[XB_XGEN(b.x)], 1u);
            asm volatile("s_waitcnt vmcnt(0)" ::: "memory");
        } else {
            XB_SPIN(xb_ld(&bar[XB_XGEN(b.x)]) == gen, bar);
            __builtin_amdgcn_fence(__ATOMIC_ACQUIRE, "agent");
            asm volatile("s_waitcnt vmcnt(0)" ::: "memory");
        }
    }
    __syncthreads();
}

typedef unsigned short u16;
typedef float f32x4 __attribute__((ext_vector_type(4)));
typedef unsigned u32x4 __attribute__((ext_vector_type(4)));
typedef unsigned u32x2 __attribute__((ext_vector_type(2)));
typedef short bf16x8 __attribute__((ext_vector_type(8)));
constexpr int DM = 2048, TP = 8192, NBP = 4, NBS = 8, TS = 64, PAST = 2048, SKVS = PAST + TS;
constexpr int MP = NBP * TP, MS_ = NBS * TS, M = MP + MS_;
constexpr int DI = 4096, CD = 6144, NH = 64, DFF = 5504, DFF2 = 11008, NIN = 20560;
constexpr int NMOD = 12288;
constexpr float EPS = 1e-6f, LOG2E = 1.4426950408889634f;
constexpr int HALF_ROWS = 16640;
constexpr size_t O_YP = 0, O_YS = O_YP + (size_t)MP * DM, O_KP = O_YS + (size_t)MS_ * DM, O_VP = O_KP + (size_t)MP * DM,
    O_LFP = O_VP + (size_t)MP * DM, O_SSMP = O_LFP + (size_t)MP * 16, O_MCP = O_SSMP + (size_t)NBP * 64 * 64 * 128, O_FCP = O_MCP + (size_t)NBP * 3 * CD,
    O_KS = O_FCP + (size_t)NBP * 2 * DFF2, O_VS = O_KS + (size_t)MS_ * DM, O_LFS = O_VS + (size_t)MS_ * DM, O_SSMS = O_LFS + (size_t)MS_ * 16,
    O_MCS = O_SSMS + (size_t)NBS * 64 * 64 * 128, O_FCS = O_MCS + (size_t)NBS * 3 * CD, O_END = O_FCS + (size_t)NBS * 2 * DFF2;
constexpr size_t MiB = 1u << 20;
constexpr size_t W_MOD = 0, W_BAR = 768 * 1024  , W_BIASP = 1 * MiB, W_BIASS = 3 * MiB, W_HALO = 5 * MiB,
    W_WUP = 8 * MiB, W_WDN = 51 * MiB, W_H = 73 * MiB, W_WIN = 203 * MiB, W_WPM = 284 * MiB, W_WPF = 300 * MiB, W_WOUT = 308 * MiB,
    W_SMALL = 316 * MiB, W_R = 349 * MiB,
    W_XBC = W_R, W_Z = W_R + 390 * MiB, W_GM = W_R, W_GF = W_R + 130 * MiB, W_Q = W_R + 260 * MiB, W_K = W_Q + 130 * MiB, W_V = W_K + 130 * MiB,
    W_U = 203 * MiB, W_G = 553 * MiB, W_END = 999 * MiB;
static_assert((size_t)M * DM * 2 == 130 * MiB && (size_t)M * CD * 2 == 390 * MiB && (size_t)M * DI * 2 == 260 * MiB, "sizes");
static_assert(W_U + (size_t)HALF_ROWS * DFF2 * 2 <= W_G && W_G + (size_t)M * DFF * 2 <= 1024 * MiB, "ffn map");
static_assert(W_SMALL + (size_t)M * 256 * 4 <= W_R, "small map");

struct Prm { const float* in[31]; float* out; unsigned char* ws; };
typedef const __attribute__((address_space(4))) Prm* KPrm;
struct Ctx { int tid, bid, G; };
enum { I_XP = 0, I_XS, I_CP, I_CS, I_CK, I_CV, I_CLF, I_SSM, I_MCV, I_FCV, I_N1W, I_N2W, I_WADA, I_BADA, I_WIN, I_MCW, I_MCB, I_DTB, I_ALOG, I_MD, I_MNW,
       I_FB, I_QNW, I_KNW, I_WPM, I_WPF, I_WOUT, I_WUP, I_FCW, I_FCB, I_WDN };

__device__ __forceinline__ float bflo(unsigned w) { return __uint_as_float(w << 16); }
__device__ __forceinline__ float bfhi(unsigned w) { return __uint_as_float(w & 0xffff0000u); }
typedef float f32x2_t __attribute__((ext_vector_type(2))); typedef __bf16 bf16x2_t __attribute__((ext_vector_type(2)));
__device__ __forceinline__ unsigned pk2(float lo, float hi) { f32x2_t v = {lo, hi}; bf16x2_t b = __builtin_convertvector(v, bf16x2_t); return __builtin_bit_cast(unsigned, b); }
__device__ __forceinline__ u16 f2bf(float f) { return (u16)(pk2(f, 0.f) & 0xffffu); }
__device__ __forceinline__ void unpack8(u32x4 w, float* v) { v[0] = bflo(w.x); v[1] = bfhi(w.x); v[2] = bflo(w.y); v[3] = bfhi(w.y); v[4] = bflo(w.z); v[5] = bfhi(w.z); v[6] = bflo(w.w); v[7] = bfhi(w.w); }
__device__ __forceinline__ u32x4 pack8f(const float* v) { u32x4 w; w.x = pk2(v[0], v[1]); w.y = pk2(v[2], v[3]); w.z = pk2(v[4], v[5]); w.w = pk2(v[6], v[7]); return w; }
__device__ __forceinline__ float bfel(const u32x4& w, int e) { const unsigned x = w[e >> 1]; return (e & 1) ? bfhi(x) : bflo(x); }
__device__ __forceinline__ float sigmoidf_(float x) { return 1.f / (1.f + __expf(-x)); }
__device__ __forceinline__ float siluf_(float x) { return x / (1.f + __expf(-x)); }
__device__ __forceinline__ float wave_sum(float v) {
#pragma unroll
    for (int o = 1; o < 64; o <<= 1) v += __shfl_xor(v, o);
    return v;
}
__device__ __forceinline__ int mod_row(int row) { return row < MP ? (row >> 13) : 4 + ((row - MP) >> 6); }

struct Epi {
    static constexpr bool PERM = true, AFTER_DRAIN = false;
    int mode;
    u16* d0; u16* d1; u16* d2; int t1, t2, p0, p1, p2, f32seg2;
    const float* xp; const float* xs; float* y; const float* mod; u16* gbuf; const u16* gf;
    __device__ __forceinline__ void operator()(const f32x4 (&acc)[2][2][4][2], const pg8::Unit& u, int wr, int wc, int fr, int fq) const {
        const int rl = u.pm * 256 + wr * 64 + fr, cl = wc * 32 + 8 * fq;
        if (mode == 0) {
            u16* base; int pitch, ct; bool f32o = false;
            if (u.pn < t1) { base = d0; pitch = p0; ct = u.pn; } else if (u.pn < t2) { base = d1; pitch = p1; ct = u.pn - t1; } else { base = d2; pitch = p2; ct = u.pn - t2; f32o = (f32seg2 != 0); }
            if (!f32o) {
#pragma unroll
                for (int ai = 0; ai < 2; ++ai)
#pragma unroll
                    for (int m = 0; m < 4; ++m) { u16* rp = base + (size_t)(rl + ai * 128 + m * 16) * pitch + ct * 256 + cl;
#pragma unroll
                        for (int bj = 0; bj < 2; ++bj) { const f32x4 v0 = acc[ai][bj][m][0], v1 = acc[ai][bj][m][1]; u32x4 w; w.x = pk2(v0[0], v0[1]); w.y = pk2(v0[2], v0[3]); w.z = pk2(v1[0], v1[1]); w.w = pk2(v1[2], v1[3]);
                            *(u32x4*)(rp + bj * 128) = w; } }
            } else {
                float* fb = (float*)base;
#pragma unroll
                for (int ai = 0; ai < 2; ++ai)
#pragma unroll
                    for (int m = 0; m < 4; ++m) { float* rp = fb + (size_t)(rl + ai * 128 + m * 16) * pitch + ct * 256 + cl;
#pragma unroll
                        for (int bj = 0; bj < 2; ++bj) { *(f32x4*)(rp + bj * 128) = acc[ai][bj][m][0]; *(f32x4*)(rp + bj * 128 + 4) = acc[ai][bj][m][1]; } }
            }
        } else if (mode == 1 || mode == 2) {
#pragma unroll
            for (int ai = 0; ai < 2; ++ai)
#pragma unroll
                for (int m = 0; m < 4; ++m) { const size_t off = (size_t)(rl + ai * 128 + m * 16) * DM + u.pn * 256 + cl;
#pragma unroll
                    for (int bj = 0; bj < 2; ++bj) { const f32x4 v0 = acc[ai][bj][m][0], v1 = acc[ai][bj][m][1];
                        float a[8] = {v0[0], v0[1], v0[2], v0[3], v1[0], v1[1], v1[2], v1[3]}, g[8], o[8];
                        unpack8(*(const u32x4*)(gbuf + off + bj * 128), g);
                        if (mode == 1) {
#pragma unroll
                            for (int e = 0; e < 8; ++e) o[e] = sigmoidf_(g[e]) * a[e];
                        } else { float f[8]; unpack8(*(const u32x4*)(gf + off + bj * 128), f);
#pragma unroll
                            for (int e = 0; e < 8; ++e) o[e] = g[e] + sigmoidf_(f[e]) * a[e]; }
                        *(u32x4*)(gbuf + off + bj * 128) = pack8f(o); } }
        } else {
#pragma unroll
            for (int ai = 0; ai < 2; ++ai) {
                const int mb = (u.pm < 128) ? (u.pm >> 5) : (4 + (u.pm - 128) * 4 + ai * 2 + wr);
                const float* gp = mod + (size_t)mb * NMOD + (mode == 3 ? 4096 : 10240) + u.pn * 256 + cl;
                f32x4 gv[2][2];
#pragma unroll
                for (int bj = 0; bj < 2; ++bj) { gv[bj][0] = *(const f32x4*)(gp + bj * 128); gv[bj][1] = *(const f32x4*)(gp + bj * 128 + 4); }
#pragma unroll
                for (int m = 0; m < 4; ++m) { const int row = rl + ai * 128 + m * 16; const size_t off = (size_t)row * DM + u.pn * 256 + cl;
                    const float* xr = (mode == 3) ? ((row < MP) ? xp + off : xs + (off - (size_t)MP * DM)) : (const float*)(y + off);
#pragma unroll
                    for (int bj = 0; bj < 2; ++bj) { const f32x4 b0 = *(const f32x4*)(xr + bj * 128), b1 = *(const f32x4*)(xr + bj * 128 + 4);
                        *(f32x4*)(y + off + bj * 128) = b0 + gv[bj][0] * acc[ai][bj][m][0]; *(f32x4*)(y + off + bj * 128 + 4) = b1 + gv[bj][1] * acc[ai][bj][m][1]; } }
            }
        }
    }
};

__device__ __forceinline__ int map_in(int n) {
    if (n < 4096) return 6144 + n;
    if (n < 10240) return n - 4096;
    if (n < 10304) return 10240 + (n - 10240);
    if (n < 12352) return 14592 + (n - 10304);
    if (n < 14400) return 16640 + (n - 12352);
    if (n < 16448) return 18688 + (n - 14400);
    if (n < 16464) return 10304 + (n - 16448);
    if (n < 18512) return 10496 + (n - 16464);
    return 12544 + (n - 18512);
}
__device__ __forceinline__ int map_up(int n) { if (n < DFF) return (n >> 7) * 256 + (n & 127); const int f = n - DFF; return (f >> 7) * 256 + 128 + (f & 127); }
template <int MAP> __device__ __forceinline__ void tr_item(const float* __restrict__ W, int K, int N, u16* WT, float* scr, int item, int lane) {
    const int nblk = (N + 31) / 32, kb = item / nblk, nb = item % nblk, k0 = 64 * kb, n0 = 32 * nb;
    const int nn = n0 + (lane & 31);
    float tv[32];
#pragma unroll
    for (int i = 0; i < 32; ++i) { const int kk = 2 * i + (lane >> 5); tv[i] = (nn < N) ? W[(size_t)(k0 + kk) * N + nn] : 0.f; }
#pragma unroll
    for (int i = 0; i < 32; ++i) { const int kk = 2 * i + (lane >> 5); scr[kk * 33 + (lane & 31)] = tv[i]; }
    asm volatile("s_waitcnt lgkmcnt(0)" ::: "memory");
    const int c = lane & 7;
#pragma unroll
    for (int j = 0; j < 4; ++j) { const int n = (lane >> 3) + 8 * j; const float* s = scr + (8 * c) * 33 + n;
        if (n0 + n < N) { const int row = (MAP == 1) ? map_in(n0 + n) : (MAP == 2) ? map_up(n0 + n) : (n0 + n);
            u32x4 o; o.x = pk2(s[0 * 33], s[1 * 33]); o.y = pk2(s[2 * 33], s[3 * 33]); o.z = pk2(s[4 * 33], s[5 * 33]); o.w = pk2(s[6 * 33], s[7 * 33]);
            *(u32x4*)(WT + (size_t)row * K + k0 + 8 * c) = o; } }
    asm volatile("s_waitcnt lgkmcnt(0)" ::: "memory");
}
__device__ __forceinline__ void phase_prep(KPrm p, const Ctx cx, unsigned char* lds) {
    const int tid = cx.tid, lane = tid & 63, wid = tid >> 6, G = cx.G;
    unsigned char* ws = p->ws;
    {
        float* scr = (float*)(lds + wid * 8448);
        const int gw = cx.bid * 8 + wid, NGW = G * 8;
        constexpr int I_IN = 32 * 643, I_PM = 64 * 64, I_PF = 32 * 64, I_OUT = 32 * 64, I_UP = 32 * 344, I_DN = 86 * 64;
        constexpr int NIT = I_IN + I_PM + I_PF + I_OUT + I_UP + I_DN;
        for (int it = gw; it < NIT; it += NGW) {
            int r = it;
            if (r < I_IN) { tr_item<1>(p->in[I_WIN], DM, NIN, (u16*)(ws + W_WIN), scr, r, lane); continue; } r -= I_IN;
            if (r < I_PM) { tr_item<0>(p->in[I_WPM], DI, DM, (u16*)(ws + W_WPM), scr, r, lane); continue; } r -= I_PM;
            if (r < I_PF) { tr_item<0>(p->in[I_WPF], DM, DM, (u16*)(ws + W_WPF), scr, r, lane); continue; } r -= I_PF;
            if (r < I_OUT) { tr_item<0>(p->in[I_WOUT], DM, DM, (u16*)(ws + W_WOUT), scr, r, lane); continue; } r -= I_OUT;
            if (r < I_UP) { tr_item<2>(p->in[I_WUP], DM, DFF2, (u16*)(ws + W_WUP), scr, r, lane); continue; } r -= I_UP;
            tr_item<0>(p->in[I_WDN], DFF, DM, (u16*)(ws + W_WDN), scr, r, lane);
        }
    }
    __syncthreads();
    {
        float* sl = (float*)lds;
        float* red = (float*)(lds + 12 * 2048 * 4);
        for (int e = tid; e < 12 * 2048; e += 512) { const int b = e >> 11, i = e & 2047; const float cv = (b < 4) ? p->in[I_CP][b * 2048 + i] : p->in[I_CS][(b - 4) * 2048 + i]; sl[e] = siluf_(cv); }
        __syncthreads();
        const float* wada = p->in[I_WADA]; float* mod = (float*)(ws + W_MOD);
        const int col = tid & 31, part = tid >> 5;
        for (int item = cx.bid; item < NMOD / 32; item += G) {
            float acc[12];
#pragma unroll
            for (int b = 0; b < 12; ++b) acc[b] = 0.f;
            const float* wp = wada + (size_t)(part * 128) * NMOD + item * 32 + col;
#pragma unroll 8
            for (int d = 0; d < 128; ++d) { const float w = wp[(size_t)d * NMOD];
#pragma unroll
                for (int b = 0; b < 12; ++b) acc[b] += sl[b * 2048 + part * 128 + d] * w; }
#pragma unroll
            for (int b = 0; b < 12; ++b) red[(part * 12 + b) * 32 + col] = acc[b];
            __syncthreads();
            if (tid < 384) { const int b = tid >> 5; float s = p->in[I_BADA][item * 32 + col];
#pragma unroll
                for (int q = 0; q < 16; ++q) s += red[(q * 12 + b) * 32 + col];
                mod[b * NMOD + item * 32 + col] = s; }
            __syncthreads();
        }
    }
    {
        u16* Ks = (u16*)p->out; u16* Vs = Ks + (size_t)NBS * SKVS * DM;
        const size_t tot8 = (size_t)NBS * PAST * DM / 8, gt = (size_t)cx.bid * 512 + tid, GT = (size_t)G * 512;
        for (size_t i0 = gt; i0 < 2 * tot8; i0 += 4 * GT) {
            f32x4 a[4], b[4]; size_t dsto[4]; bool ok[4]; int wh[4];
#pragma unroll
            for (int u = 0; u < 4; ++u) { const size_t i = i0 + (size_t)u * GT; ok[u] = i < 2 * tot8; const size_t ii = ok[u] ? i : 0; wh[u] = ii >= tot8; const size_t j = ii - (wh[u] ? tot8 : 0);
                const size_t sb = j / ((size_t)PAST * 256), rem = j % ((size_t)PAST * 256), row = rem >> 8, c8 = rem & 255;
                const float* src = p->in[wh[u] ? I_CV : I_CK] + ((sb * PAST + row) * DM + c8 * 8);
                a[u] = *(const f32x4*)src; b[u] = *(const f32x4*)(src + 4); dsto[u] = (sb * SKVS + row) * DM + c8 * 8; }
#pragma unroll
            for (int u = 0; u < 4; ++u) if (ok[u]) { u32x4 o; o.x = pk2(a[u][0], a[u][1]); o.y = pk2(a[u][2], a[u][3]); o.z = pk2(b[u][0], b[u][1]); o.w = pk2(b[u][2], b[u][3]);
                *(u32x4*)((wh[u] ? Vs : Ks) + dsto[u]) = o; }
        }
    }
}
__device__ __forceinline__ void phase_norm(KPrm p, const Ctx cx, int which) {
    const int tid = cx.tid, lane = tid & 63, wid = tid >> 6;
    const int gw = cx.bid * 8 + wid, NGW = cx.G * 8;
    const float* mod = (const float*)(p->ws + W_MOD); u16* H = (u16*)(p->ws + W_H);
    const float* nw = p->in[which ? I_N2W : I_N1W];
    const int osh = which ? 6144 : 0, osc = which ? 8192 : 2048;
    for (int row = gw; row < M; row += NGW) {
        const float* xr = which ? (p->out + (size_t)row * DM) : ((row < MP) ? p->in[I_XP] + (size_t)row * DM : p->in[I_XS] + (size_t)(row - MP) * DM);
        const float* mr = mod + (size_t)mod_row(row) * NMOD;
        f32x4 v[8]; float ss = 0.f;
#pragma unroll
        for (int j = 0; j < 8; ++j) { v[j] = ((const f32x4*)xr)[lane + 64 * j]; ss += (v[j][0] * v[j][0] + v[j][1] * v[j][1]) + (v[j][2] * v[j][2] + v[j][3] * v[j][3]); }
        const float rs = rsqrtf(wave_sum(ss) * (1.f / DM) + EPS);
#pragma unroll
        for (int j = 0; j < 8; ++j) { const int col = 4 * (lane + 64 * j);
            const f32x4 w = *(const f32x4*)(nw + col), sc = *(const f32x4*)(mr + osc + col), sh = *(const f32x4*)(mr + osh + col);
            const f32x4 o = v[j] * rs * w * (sc + 1.f) + sh;
            u32x2 q; q.x = pk2(o[0], o[1]); q.y = pk2(o[2], o[3]);
            *(u32x2*)(H + (size_t)row * DM + col) = q; }
    }
}
__device__ __forceinline__ void phase_conv(KPrm p, const Ctx cx) {
    const u16* XBC = (const u16*)(p->ws + W_XBC); u16* ACT = (u16*)(p->out + O_KP);
    const float* cw = p->in[I_MCW]; const float* cb = p->in[I_MCB];
    constexpr int NCG = CD / 8, RB = 16, NRB = M / RB;
    const long gt = (long)cx.bid * 512 + cx.tid, GT = (long)cx.G * 512;
    for (long it = gt; it < (long)NCG * NRB; it += GT) {
        const int cgi = (int)(it % NCG), rb = (int)(it / NCG), c0 = cgi * 8, r0 = rb * RB;
        float w[4][8], bs[8];
#pragma unroll
        for (int j = 0; j < 4; ++j) { const f32x4 a0 = *(const f32x4*)(cw + j * CD + c0), a1 = *(const f32x4*)(cw + j * CD + c0 + 4);
#pragma unroll
            for (int e = 0; e < 4; ++e) { w[j][e] = a0[e]; w[j][4 + e] = a1[e]; } }
        { const f32x4 a0 = *(const f32x4*)(cb + c0), a1 = *(const f32x4*)(cb + c0 + 4);
#pragma unroll
          for (int e = 0; e < 4; ++e) { bs[e] = a0[e]; bs[4 + e] = a1[e]; } }
        float h[3][8];
        const bool smp = r0 >= MP; const int tb = smp ? ((r0 - MP) & 63) : (r0 & (TP - 1));
        if (tb == 0) {
            if (smp) { const float* s = p->in[I_MCV] + (size_t)((r0 - MP) >> 6) * 3 * CD + c0;
#pragma unroll
                for (int k = 0; k < 3; ++k)
#pragma unroll
                    for (int e = 0; e < 8; ++e) h[k][e] = s[k * CD + e];
            } else {
#pragma unroll
                for (int k = 0; k < 3; ++k)
#pragma unroll
                    for (int e = 0; e < 8; ++e) h[k][e] = 0.f; }
        } else {
#pragma unroll
            for (int k = 0; k < 3; ++k) unpack8(*(const u32x4*)(XBC + (size_t)(r0 - 3 + k) * CD + c0), h[k]);
        }
        u32x4 ur[RB];
#pragma unroll
        for (int i = 0; i < RB; ++i) ur[i] = *(const u32x4*)(XBC + (size_t)(r0 + i) * CD + c0);
#pragma unroll
        for (int i = 0; i < RB; ++i) { float u[8], o[8]; unpack8(ur[i], u);
#pragma unroll
            for (int e = 0; e < 8; ++e) { const float v = bs[e] + w[0][e] * h[0][e] + w[1][e] * h[1][e] + w[2][e] * h[2][e] + w[3][e] * u[e];
                o[e] = siluf_(v); h[0][e] = h[1][e]; h[1][e] = h[2][e]; h[2][e] = u[e]; }
            *(u32x4*)(ACT + (size_t)(r0 + i) * CD + c0) = pack8f(o); }
    }
}
constexpr int SXP = 72, SNP = 136, SYP = 68;
constexpr int L_XT = 0, L_CN = L_XT + 64 * SXP * 2, L_BN = L_CN + 64 * SNP * 2, L_BWT = L_BN + 64 * SNP * 2, L_MS = L_BWT + 128 * SXP * 2, L_HS = L_MS + 64 * SXP * 2,
              L_YS = L_HS + 64 * SNP * 2, L_DT = L_YS + 64 * SYP * 4, L_CUM = L_DT + 256, L_SSD_END = L_CUM + 256;
static_assert(L_SSD_END <= 131072, "ssd lds");
__device__ __forceinline__ void phase_ssd(KPrm p, const Ctx cx, unsigned char* lds) {
    const int tid = cx.tid, lane = tid & 63, wid = __builtin_amdgcn_readfirstlane(tid >> 6), quad = lane >> 4, l15 = lane & 15;
    u16* XT = (u16*)(lds + L_XT); u16* CN = (u16*)(lds + L_CN); u16* BN = (u16*)(lds + L_BN); u16* BWT = (u16*)(lds + L_BWT);
    u16* MSm = (u16*)(lds + L_MS); u16* HS = (u16*)(lds + L_HS); float* YS = (float*)(lds + L_YS); float* DT = (float*)(lds + L_DT); float* CUM = (float*)(lds + L_CUM);
    const u16* XBC = (const u16*)(p->out + O_KP);     u16* Z = (u16*)(p->ws + W_Z); const float* SM = (const float*)(p->ws + W_SMALL);
    const int cg8 = tid & 31, tq = tid >> 5, cgx = tid & 7, tx = tid >> 3;
    const int pb = wid >> 1;
    for (int ch = cx.bid; ch < 256 + 512; ch += cx.G) {
        const bool smp = ch >= 256; int b, hd, nc; long rowbase;
        if (!smp) { b = ch >> 6; hd = ch & 63; nc = TP / 64; rowbase = (long)b * TP; } else { const int su = ch - 256; b = su >> 6; hd = su & 63; nc = 1; rowbase = MP + (long)b * TS; }
        const int g = hd >> 3;
        const float a_h = -__expf(p->in[I_ALOG][hd]), dtb = p->in[I_DTB][hd], Dh = p->in[I_MD][hd];
        const int bccol = (cg8 < 16) ? (4096 + g * 128 + cg8 * 8) : (5120 + g * 128 + (cg8 - 16) * 8);
        const int xcol = hd * 64 + cgx * 8;
        f32x4 st[4];
        const int st_off = (pb * 16 + quad * 4) * 128 + (4 * (wid & 1)) * 16 + l15, hs_off = (pb * 16 + quad * 4) * SNP + (4 * (wid & 1)) * 16 + l15;
        { const float* sin_ = p->in[I_SSM] + ((size_t)b * 64 + hd) * 64 * 128 + st_off;
#pragma unroll
          for (int i = 0; i < 4; ++i)
#pragma unroll
            for (int j = 0; j < 4; ++j) st[i][j] = smp ? sin_[j * 128 + i * 16] : 0.f; }
        __syncthreads();
        { u16* hp_ = HS + hs_off;
#pragma unroll
          for (int i = 0; i < 4; ++i)
#pragma unroll
            for (int j = 0; j < 4; ++j) hp_[j * SNP + i * 16] = f2bf(st[i][j]); }
        u32x4 rbcA[4], rxA, znA, rbcB[4], rxB, znB, pend = {0u, 0u, 0u, 0u}; float dtrA = 0.f, dtrB = 0.f;
#define SSD_LOADS(cc, rbc, rx, zn, dtr) do { const int t0_ = (cc) * 64; \
            const u16* pb_ = XBC + (rowbase + t0_ + 4 * tq) * (long)CD + bccol; const u16* px_ = XBC + (rowbase + t0_ + tx) * (long)CD + xcol; \
            asm volatile("" : "+v"(pb_), "+v"(px_));     \
            _Pragma("unroll") for (int i = 0; i < 4; ++i) rbc[i] = *(const u32x4*)(pb_ + i * CD); \
            rx = *(const u32x4*)px_; \
            zn = *(const u32x4*)(Z + (size_t)(rowbase + t0_ + tx) * DI + xcol); \
            dtr = SM[(size_t)(rowbase + t0_ + lane) * 256 + hd]; } while (0)
#define LBAR() do { asm volatile("s_waitcnt lgkmcnt(0)" ::: "memory"); __builtin_amdgcn_s_barrier(); asm volatile("" ::: "memory"); } while (0)
        SSD_LOADS(0, rbcA, rxA, znA, dtrA); if (nc > 1) SSD_LOADS(1, rbcB, rxB, znB, dtrB);
        auto body = [&](const int c, u32x4 (&rbc)[4], u32x4& rx, u32x4& zn, float& dtr) __attribute__((always_inline)) {
            const long r0 = rowbase + (long)c * 64;
            const u32x4 zw = zn;
            float cum_end;
            { const float dr = dtr + dtb; const float dtv = dr > 20.f ? dr : __logf(1.f + __expf(dr));
              float x = dtv * a_h;
#define DPP_ADD(ctrl, rmask) x += __int_as_float(__builtin_amdgcn_update_dpp(0, __float_as_int(x), ctrl, rmask, 0xf, true))
              DPP_ADD(0x111, 0xf); DPP_ADD(0x112, 0xf); DPP_ADD(0x114, 0xf); DPP_ADD(0x118, 0xf);
              DPP_ADD(0x142, 0xa);
              DPP_ADD(0x143, 0xc);
#undef DPP_ADD
              DT[lane] = dtv; CUM[lane] = x; cum_end = __int_as_float(__builtin_amdgcn_readlane(__float_as_int(x), 63)); }
            {
                u16* NAT = (cg8 < 16) ? BN : CN; const int nc0 = (cg8 & 15) * 8;
#pragma unroll
                for (int ii = 0; ii < 4; ++ii) *(u32x4*)(NAT + (4 * tq + ii) * SNP + nc0) = rbc[ii];
                if (cg8 < 16) {
                    float wg[4]; const f32x4 dt4 = *(const f32x4*)(DT + 4 * tq), cu4 = *(const f32x4*)(CUM + 4 * tq);
#pragma unroll
                    for (int ii = 0; ii < 4; ++ii) wg[ii] = dt4[ii] * __expf(cum_end - cu4[ii]);
#pragma unroll
                    for (int e = 0; e < 8; ++e) { u32x2 q; q.x = pk2(bfel(rbc[0], e) * wg[0], bfel(rbc[1], e) * wg[1]); q.y = pk2(bfel(rbc[2], e) * wg[2], bfel(rbc[3], e) * wg[3]);
                        *(u32x2*)(BWT + (nc0 + e) * SXP + 4 * tq) = q; }
                }
            }
            float xv[8]; unpack8(rx, xv);
#pragma unroll
            for (int e = 0; e < 8; ++e) XT[(cgx * 8 + e) * SXP + tx] = (u16)((e & 1) ? (rx[e >> 1] >> 16) : (rx[e >> 1] & 0xffffu));
            LBAR();
            if (c > 0) *(u32x4*)(Z + (size_t)(r0 - 64 + tx) * DI + xcol) = pend;
            if (c + 2 < nc) SSD_LOADS(c + 2, rbc, rx, zn, dtr);
            const int ti = wid >> 1;
            f32x4 yo[2];
            {
                bf16x8 ca[4], bb[2][4], hb[2][4];
#pragma unroll
                for (int kk = 0; kk < 4; ++kk) ca[kk] = *(const bf16x8*)(CN + (ti * 16 + l15) * SNP + kk * 32 + quad * 8);
#pragma unroll
                for (int s2 = 0; s2 < 2; ++s2)
#pragma unroll
                    for (int kk = 0; kk < 4; ++kk) { bb[s2][kk] = *(const bf16x8*)(BN + ((2 * (wid & 1) + s2) * 16 + l15) * SNP + kk * 32 + quad * 8);
                        hb[s2][kk] = *(const bf16x8*)(HS + ((2 * (wid & 1) + s2) * 16 + l15) * SNP + kk * 32 + quad * 8); }
                const f32x4 ct4 = *(const f32x4*)(CUM + ti * 16 + quad * 4);
                float cs[2], ds[2];
#pragma unroll
                for (int s2 = 0; s2 < 2; ++s2) { const int sx = (2 * (wid & 1) + s2) * 16 + l15; cs[s2] = CUM[sx]; ds[s2] = DT[sx]; }
                f32x4 ga[2] = {{0.f, 0.f, 0.f, 0.f}, {0.f, 0.f, 0.f, 0.f}}; yo[0] = (f32x4){0.f, 0.f, 0.f, 0.f}; yo[1] = (f32x4){0.f, 0.f, 0.f, 0.f};
#pragma unroll
                for (int kk = 0; kk < 4; ++kk) {
                    ga[0] = __builtin_amdgcn_mfma_f32_16x16x32_bf16(ca[kk], bb[0][kk], ga[0], 0, 0, 0); ga[1] = __builtin_amdgcn_mfma_f32_16x16x32_bf16(ca[kk], bb[1][kk], ga[1], 0, 0, 0);
                    yo[0] = __builtin_amdgcn_mfma_f32_16x16x32_bf16(ca[kk], hb[0][kk], yo[0], 0, 0, 0); yo[1] = __builtin_amdgcn_mfma_f32_16x16x32_bf16(ca[kk], hb[1][kk], yo[1], 0, 0, 0); }
#pragma unroll
                for (int s2 = 0; s2 < 2; ++s2) { const int s_ = (2 * (wid & 1) + s2) * 16 + l15;
#pragma unroll
                    for (int j = 0; j < 4; ++j) { const int t = ti * 16 + quad * 4 + j; const float msk = (s_ <= t) ? ds[s2] : 0.f;
                        const float val = ga[s2][j] * __expf(fminf(ct4[j] - cs[s2], 0.f)) * msk; MSm[t * SXP + s_] = f2bf(val); } }
#pragma unroll
                for (int p2 = 0; p2 < 2; ++p2)
#pragma unroll
                    for (int j = 0; j < 4; ++j) yo[p2][j] *= __expf(ct4[j]);
            }
            LBAR();
            {
                bf16x8 ma[2], xa[2], xb[2][2], wb[4][2];
#pragma unroll
                for (int kk = 0; kk < 2; ++kk) { ma[kk] = *(const bf16x8*)(MSm + (ti * 16 + l15) * SXP + kk * 32 + quad * 8); xa[kk] = *(const bf16x8*)(XT + (pb * 16 + l15) * SXP + kk * 32 + quad * 8);
#pragma unroll
                    for (int p2 = 0; p2 < 2; ++p2) xb[p2][kk] = *(const bf16x8*)(XT + ((2 * (wid & 1) + p2) * 16 + l15) * SXP + kk * 32 + quad * 8);
#pragma unroll
                    for (int i = 0; i < 4; ++i) wb[i][kk] = *(const bf16x8*)(BWT + ((4 * (wid & 1) + i) * 16 + l15) * SXP + kk * 32 + quad * 8); }
                const float dec = __expf(cum_end);
#pragma unroll
                for (int i = 0; i < 4; ++i) st[i] = st[i] * dec;
#pragma unroll
                for (int kk = 0; kk < 2; ++kk) {
                    yo[0] = __builtin_amdgcn_mfma_f32_16x16x32_bf16(ma[kk], xb[0][kk], yo[0], 0, 0, 0); yo[1] = __builtin_amdgcn_mfma_f32_16x16x32_bf16(ma[kk], xb[1][kk], yo[1], 0, 0, 0);
#pragma unroll
                    for (int i = 0; i < 4; ++i) st[i] = __builtin_amdgcn_mfma_f32_16x16x32_bf16(xa[kk], wb[i][kk], st[i], 0, 0, 0); }
#pragma unroll
                for (int p2 = 0; p2 < 2; ++p2)
#pragma unroll
                    for (int j = 0; j < 4; ++j) YS[(ti * 16 + quad * 4 + j) * SYP + (2 * (wid & 1) + p2) * 16 + l15] = yo[p2][j];
                u16* hp_ = HS + hs_off;
#pragma unroll
                for (int i = 0; i < 4; ++i)
#pragma unroll
                    for (int j = 0; j < 4; ++j) hp_[j * SNP + i * 16] = f2bf(st[i][j]);
            }
            LBAR();
            {
                const f32x4 y0 = *(const f32x4*)(YS + tx * SYP + cgx * 8), y1 = *(const f32x4*)(YS + tx * SYP + cgx * 8 + 4);
                float zf[8], o[8]; unpack8(zw, zf);
#pragma unroll
                for (int e = 0; e < 8; ++e) { const float yv = (e < 4 ? y0[e & 3] : y1[e & 3]) + Dh * xv[e]; o[e] = yv * siluf_(zf[e]); }
                pend = pack8f(o);
            }
        };
        for (int c = 0; c < nc; c += 2) { body(c, rbcA, rxA, znA, dtrA); if (c + 1 < nc) body(c + 1, rbcB, rxB, znB, dtrB); }
        *(u32x4*)(Z + (size_t)(rowbase + (long)(nc - 1) * 64 + tx) * DI + xcol) = pend;
#undef SSD_LOADS
#undef LBAR
        float* so = p->out + (smp ? O_SSMS : O_SSMP) + ((size_t)b * 64 + hd) * 64 * 128 + st_off;
#pragma unroll
        for (int i = 0; i < 4; ++i)
#pragma unroll
            for (int j = 0; j < 4; ++j) so[j * 128 + i * 16] = st[i][j];
        __syncthreads();
    }
}
__device__ __forceinline__ float logsig_(float f) { return fminf(f, 0.f) - log1pf(__expf(-fabsf(f))); }
__device__ __forceinline__ void phase_gn(KPrm p, const Ctx cx) {
    const int tid = cx.tid, lane = tid & 63, wid = tid >> 6;
    const int gw = cx.bid * 8 + wid, NGW = cx.G * 8;
    const float* SM = (const float*)(p->ws + W_SMALL);
    if (gw < 192) {
        if (gw < 64) { const int b = gw >> 4, h = gw & 15; const float fb = p->in[I_FB][h];
            float* bias = (float*)(p->ws + W_BIASP) + (size_t)(b * 16 + h) * TP; float* lo = p->out + O_LFP;
            const int tb = lane * 128; float s = 0.f;
            for (int i = 0; i < 128; ++i) s += logsig_(SM[(size_t)(b * TP + tb + i) * 256 + 64 + h] + fb);
            float inc = s;
#pragma unroll
            for (int o = 1; o < 64; o <<= 1) { const float y = __shfl_up(inc, o); if (lane >= o) inc += y; }
            float run = inc - s;
            for (int i = 0; i < 128; ++i) { const float lf = logsig_(SM[(size_t)(b * TP + tb + i) * 256 + 64 + h] + fb); run += lf;
                lo[(size_t)(b * TP + tb + i) * 16 + h] = lf; bias[tb + i] = -run * LOG2E; }
        } else { const int u = gw - 64, sb = u >> 4, h = u & 15; const float fb = p->in[I_FB][h];
            float* bias = (float*)(p->ws + W_BIASS) + (size_t)(sb * 16 + h) * SKVS; float* lo = p->out + O_LFS;
            const int tb = lane * 33; float s = 0.f;
            for (int i = 0; i < 33; ++i) { const int pos = tb + i;
                s += (pos < PAST) ? p->in[I_CLF][(size_t)(sb * PAST + pos) * 16 + h] : logsig_(SM[(size_t)(MP + sb * TS + pos - PAST) * 256 + 64 + h] + fb); }
            float inc = s;
#pragma unroll
            for (int o = 1; o < 64; o <<= 1) { const float y = __shfl_up(inc, o); if (lane >= o) inc += y; }
            float run = inc - s;
            for (int i = 0; i < 33; ++i) { const int pos = tb + i; float lf;
                if (pos < PAST) lf = p->in[I_CLF][(size_t)(sb * PAST + pos) * 16 + h];
                else { lf = logsig_(SM[(size_t)(MP + sb * TS + pos - PAST) * 256 + 64 + h] + fb); lo[(size_t)(sb * TS + pos - PAST) * 16 + h] = lf; }
                run += lf; bias[pos] = -run * LOG2E; }
        }
    }
    {
        const u16* XBC = (const u16*)(p->ws + W_XBC);
        const int gt = cx.bid * 512 + tid, GT = cx.G * 512;
        for (int i = gt; i < 12 * 3 * CD; i += GT) { const int bb = i / (3 * CD), r = (i / CD) % 3, c = i % CD;
            if (bb < 4) p->out[O_MCP + i] = bflo(XBC[(size_t)(bb * TP + TP - 3 + r) * CD + c]);
            else p->out[O_MCS + (i - 4 * 3 * CD)] = bflo(XBC[(size_t)(MP + (bb - 4) * TS + TS - 3 + r) * CD + c]); }
    }
    u16* Z = (u16*)(p->ws + W_Z); const float* mnw = p->in[I_MNW];
    for (int row = gw; row < M; row += NGW) {
        u32x4 zr[8];
#pragma unroll
        for (int i = 0; i < 8; ++i) zr[i] = *(const u32x4*)(Z + (size_t)row * DI + i * 512 + lane * 8);
#pragma unroll
        for (int i = 0; i < 8; ++i) { const int col = i * 512 + lane * 8; u16* zp = Z + (size_t)row * DI + col;
            float v[8]; unpack8(zr[i], v); float ss = 0.f;
#pragma unroll
            for (int e = 0; e < 8; ++e) ss += v[e] * v[e];
            const float rs = rsqrtf(wave_sum(ss) * (1.f / 512.f) + EPS);
            const f32x4 w0 = *(const f32x4*)(mnw + col), w1 = *(const f32x4*)(mnw + col + 4);
#pragma unroll
            for (int e = 0; e < 8; ++e) v[e] = v[e] * rs * (e < 4 ? w0[e & 3] : w1[e & 3]);
            *(u32x4*)zp = pack8f(v); }
    }
}
__device__ __forceinline__ void phase_qk(KPrm p, const Ctx cx) {
    const int tid = cx.tid, lane = tid & 63, wid = tid >> 6;
    const int gw = cx.bid * 8 + wid, NGW = cx.G * 8;
    u16* Q = (u16*)(p->ws + W_Q); u16* K = (u16*)(p->ws + W_K); const u16* V = (const u16*)(p->ws + W_V);
    u16* Ks = (u16*)p->out; u16* Vs = Ks + (size_t)NBS * SKVS * DM;
    const float QS = 0.08838834764831845f * LOG2E;
    const int hc = (lane & 15) * 8;
    const f32x4 qw0 = *(const f32x4*)(p->in[I_QNW] + hc), qw1 = *(const f32x4*)(p->in[I_QNW] + hc + 4), kw0 = *(const f32x4*)(p->in[I_KNW] + hc), kw1 = *(const f32x4*)(p->in[I_KNW] + hc + 4);
    for (int row = gw; row < M; row += NGW) {
        const bool smp = row >= MP;
        float* ko = smp ? p->out + O_KS + (size_t)(row - MP) * DM : p->out + O_KP + (size_t)row * DM;
        float* vo = smp ? p->out + O_VS + (size_t)(row - MP) * DM : p->out + O_VP + (size_t)row * DM;
        size_t srow = 0; if (smp) { const int sb = (row - MP) >> 6, t = (row - MP) & 63; srow = (size_t)(sb * SKVS + PAST + t) * DM; }
        u32x4 qr_[4], kr_[4], vr_[4];
#pragma unroll
        for (int it = 0; it < 4; ++it) { const size_t off = (size_t)row * DM + it * 512 + lane * 8; qr_[it] = *(const u32x4*)(Q + off); kr_[it] = *(const u32x4*)(K + off); vr_[it] = *(const u32x4*)(V + off); }
#pragma unroll
        for (int it = 0; it < 4; ++it) { const int col = it * 512 + lane * 8; const size_t off = (size_t)row * DM + col;
            float v[8], ss;
            unpack8(qr_[it], v); ss = 0.f;
#pragma unroll
            for (int e = 0; e < 8; ++e) ss += v[e] * v[e];
            ss += __shfl_xor(ss, 1); ss += __shfl_xor(ss, 2); ss += __shfl_xor(ss, 4); ss += __shfl_xor(ss, 8);
            float rs = rsqrtf(ss * (1.f / 128.f) + EPS) * QS;
#pragma unroll
            for (int e = 0; e < 8; ++e) v[e] = v[e] * rs * (e < 4 ? qw0[e & 3] : qw1[e & 3]);
            *(u32x4*)(Q + off) = pack8f(v);
            unpack8(kr_[it], v); ss = 0.f;
#pragma unroll
            for (int e = 0; e < 8; ++e) ss += v[e] * v[e];
            ss += __shfl_xor(ss, 1); ss += __shfl_xor(ss, 2); ss += __shfl_xor(ss, 4); ss += __shfl_xor(ss, 8);
            rs = rsqrtf(ss * (1.f / 128.f) + EPS);
#pragma unroll
            for (int e = 0; e < 8; ++e) v[e] = v[e] * rs * (e < 4 ? kw0[e & 3] : kw1[e & 3]);
            const u32x4 kp = pack8f(v);
            *(u32x4*)(K + off) = kp;
            *(f32x4*)(ko + col) = (f32x4){v[0], v[1], v[2], v[3]}; *(f32x4*)(ko + col + 4) = (f32x4){v[4], v[5], v[6], v[7]};
            const u32x4 vw = vr_[it]; unpack8(vw, v);
            *(f32x4*)(vo + col) = (f32x4){v[0], v[1], v[2], v[3]}; *(f32x4*)(vo + col + 4) = (f32x4){v[4], v[5], v[6], v[7]};
            if (smp) { *(u32x4*)(Ks + srow + col) = kp; *(u32x4*)(Vs + srow + col) = vw; } }
    }
}
typedef att::BlockRef<att::bf16, att::bf16> ARef;
__device__ __forceinline__ ARef att_ref(KPrm p, const Ctx cx, int i, int nbp, int& skv) {
    const int G = cx.G, bid = (cx.G % 8 == 0) ? (cx.bid % 8) * (cx.G / 8) + cx.bid / 8 : cx.bid; ARef r;
    att::bf16* Qb = (att::bf16*)(p->ws + W_Q); const att::bf16* Kb = (const att::bf16*)(p->ws + W_K); const att::bf16* Vb = (const att::bf16*)(p->ws + W_V);
    if (i < nbp) { const int L = bid + (i >> 1) * G, bh = L >> 4, x = L & 15, qb = (i & 1) ? 31 - x : x, b = bh >> 4, h = bh & 15;
        const size_t rq = ((size_t)b * TP + (size_t)qb * 256) * DM + h * 128, rk = (size_t)b * TP * DM + h * 128;
        r.Q = Qb + rq; r.O = Qb + rq; r.K = Kb + rk; r.V = Vb + rk; r.Bs = (const float*)(p->ws + W_BIASP) + (size_t)bh * TP; r.P0 = qb * 256; r.nvalid = 256; skv = TP;
    } else { const int su = bid + (i - nbp) * G, sb = su >> 4, h = su & 15;
        const att::bf16* Ks = (const att::bf16*)p->out; const att::bf16* Vs = Ks + (size_t)NBS * SKVS * DM;
        const size_t rq = ((size_t)MP + (size_t)sb * TS) * DM + h * 128, rk = (size_t)sb * SKVS * DM + h * 128;
        r.Q = Qb + rq; r.O = Qb + rq; r.K = Ks + rk; r.V = Vs + rk; r.Bs = (const float*)(p->ws + W_BIASS) + (size_t)su * SKVS; r.P0 = PAST; r.nvalid = TS; skv = SKVS; }
    return r;
}
__device__ __forceinline__ void phase_att(KPrm p, const Ctx cx, char* lds) {
    const int G = cx.G, bid = (cx.G % 8 == 0) ? (cx.bid % 8) * (cx.G / 8) + cx.bid / 8 : cx.bid;
    const int nip = (bid < 1024) ? (1024 - bid + G - 1) / G : 0, nbp = 2 * nip, nbs = (bid < 128) ? (128 - bid + G - 1) / G : 0, nb = nbp + nbs;
    if (nb == 0) return;
    const int W = 1 << 30;
    int skv, skvn; ARef cur = att_ref(p, cx, 0, nbp, skv);
    att::Seam<att::bf16> S;
    att::causal_swa_prime<att::bf16, att::bf16>(cur, W, lds, S, cx.tid);
    for (int i = 0; i < nb; ++i) {
        const bool last = (i + 1 == nb);
        ARef nxt = cur; skvn = skv; if (!last) nxt = att_ref(p, cx, i + 1, nbp, skvn);
        att::causal_swa_block<att::bf16, att::bf16>(cur, nxt, skv, W, lds, S, cx.tid);
        cur = nxt; skv = skvn;
    }
}
__device__ __forceinline__ void phase_cv(KPrm p, const Ctx cx, int half) {
    const int tid = cx.tid;
    const u16* U = (const u16*)(p->ws + W_U); u16* Gb = (u16*)(p->ws + W_G); u16* HALO = (u16*)(p->ws + W_HALO);
    const float* cw = p->in[I_FCW]; const float* cb = p->in[I_FCB];
    const int row_lo = half ? HALF_ROWS : 0;
    constexpr int NCG = DFF / 8, RB = 16, NRB = HALF_ROWS / RB;
    const long gt = (long)cx.bid * 512 + tid, GT = (long)cx.G * 512;
    for (long it = gt; it < (long)NCG * NRB; it += GT) {
        const int cgi = (int)(it % NCG), rb = (int)(it / NCG); const int f0 = cgi * 8, r0 = row_lo + rb * RB;
        const int ca = (f0 >> 7) * 256 + (f0 & 127), cbb = ca + 128;
        float wa[3][8], wb[3][8], ba[8], bb[8];
#pragma unroll
        for (int k = 0; k < 3; ++k) { const f32x4 a0 = *(const f32x4*)(cw + k * DFF2 + f0), a1 = *(const f32x4*)(cw + k * DFF2 + f0 + 4), b0 = *(const f32x4*)(cw + k * DFF2 + DFF + f0), b1 = *(const f32x4*)(cw + k * DFF2 + DFF + f0 + 4);
#pragma unroll
            for (int e = 0; e < 4; ++e) { wa[k][e] = a0[e]; wa[k][4 + e] = a1[e]; wb[k][e] = b0[e]; wb[k][4 + e] = b1[e]; } }
        { const f32x4 a0 = *(const f32x4*)(cb + f0), a1 = *(const f32x4*)(cb + f0 + 4), b0 = *(const f32x4*)(cb + DFF + f0), b1 = *(const f32x4*)(cb + DFF + f0 + 4);
#pragma unroll
          for (int e = 0; e < 4; ++e) { ba[e] = a0[e]; ba[4 + e] = a1[e]; bb[e] = b0[e]; bb[4 + e] = b1[e]; } }
        float ha[2][8], hb[2][8];
        const bool smp = r0 >= MP; const int tb = smp ? ((r0 - MP) & 63) : (r0 & (TP - 1));
        if (tb == 0) {
            if (smp) { const float* s = p->in[I_FCV] + (size_t)((r0 - MP) >> 6) * 2 * DFF2;
#pragma unroll
                for (int k = 0; k < 2; ++k)
#pragma unroll
                    for (int e = 0; e < 8; ++e) { ha[k][e] = s[k * DFF2 + f0 + e]; hb[k][e] = s[k * DFF2 + DFF + f0 + e]; }
            } else {
#pragma unroll
                for (int k = 0; k < 2; ++k)
#pragma unroll
                    for (int e = 0; e < 8; ++e) { ha[k][e] = 0.f; hb[k][e] = 0.f; } }
        } else if (half && rb == 0) {
#pragma unroll
            for (int k = 0; k < 2; ++k) { unpack8(*(const u32x4*)(HALO + (size_t)k * DFF2 + ca), ha[k]); unpack8(*(const u32x4*)(HALO + (size_t)k * DFF2 + cbb), hb[k]); }
        } else {
#pragma unroll
            for (int k = 0; k < 2; ++k) { const size_t ro = (size_t)(r0 - row_lo - 2 + k) * DFF2; unpack8(*(const u32x4*)(U + ro + ca), ha[k]); unpack8(*(const u32x4*)(U + ro + cbb), hb[k]); }
        }
#pragma unroll 8
        for (int i = 0; i < RB; ++i) { const int r = r0 + i; const size_t ro = (size_t)(r - row_lo) * DFF2;
            const u32x4 uaw = *(const u32x4*)(U + ro + ca), ubw = *(const u32x4*)(U + ro + cbb);
            float ua[8], ub[8], o[8]; unpack8(uaw, ua); unpack8(ubw, ub);
#pragma unroll
            for (int e = 0; e < 8; ++e) { const float va = ba[e] + wa[0][e] * ha[0][e] + wa[1][e] * ha[1][e] + wa[2][e] * ua[e], vb = bb[e] + wb[0][e] * hb[0][e] + wb[1][e] * hb[1][e] + wb[2][e] * ub[e];
                o[e] = siluf_(va) * vb; ha[0][e] = ha[1][e]; ha[1][e] = ua[e]; hb[0][e] = hb[1][e]; hb[1][e] = ub[e]; }
            *(u32x4*)(Gb + (size_t)r * DFF + f0) = pack8f(o);
            const int tpos = (r >= MP) ? ((r - MP) & 63) : (r & (TP - 1)), tlen = (r >= MP) ? TS : TP;
            if (tpos >= tlen - 2) { float* fo = (r >= MP) ? p->out + O_FCS + ((size_t)((r - MP) >> 6) * 2 + (tpos - (tlen - 2))) * DFF2 : p->out + O_FCP + ((size_t)(r >> 13) * 2 + (tpos - (tlen - 2))) * DFF2;
#pragma unroll
                for (int e = 0; e < 8; ++e) { fo[f0 + e] = ua[e]; fo[DFF + f0 + e] = ub[e]; } }
            if (!half && r >= HALF_ROWS - 2) { *(u32x4*)(HALO + (size_t)(r - (HALF_ROWS - 2)) * DFF2 + ca) = uaw; *(u32x4*)(HALO + (size_t)(r - (HALF_ROWS - 2)) * DFF2 + cbb) = ubw; }
        }
    }
}
constexpr int LDS_TOTAL = 147456;
enum { PH_CONV = 100 };
enum { PH_PREP = 0, PH_N1, PH_G1A, PH_SSD, PH_GN, PH_G1B, PH_G2, PH_G1C, PH_QK, PH_ATT, PH_G3, PH_G4, PH_N2, PH_G5A, PH_CVA, PH_G5B, PH_CVB, PH_G6, PH_COUNT };
__device__ __forceinline__ void run_gemms(KPrm p, const Ctx cx, unsigned char* lds, const int first, const int last, const XcdBarrier& xbar) {
#pragma unroll 1
    for (int ph = first; ph <= last; ++ph) {
        unsigned char* ws = p->ws;
        pg8::Gemm g; Epi E;
        g.A = (const u16*)(ws + W_H); g.Bt = nullptr; g.M = M; g.N = DM; g.K = DM;
        E.mode = 0; E.d0 = E.d1 = E.d2 = nullptr; E.t1 = E.t2 = 1 << 20; E.p0 = E.p1 = E.p2 = 0; E.f32seg2 = 0;
        E.xp = p->in[I_XP]; E.xs = p->in[I_XS]; E.y = p->out; E.mod = (const float*)(ws + W_MOD); E.gbuf = (u16*)(ws + W_GM); E.gf = (const u16*)(ws + W_GF);
        switch (ph) {
        case PH_G1A: g.Bt = (const u16*)(ws + W_WIN); g.N = 41 * 256;
            E.d0 = (u16*)(ws + W_XBC); E.p0 = CD; E.t1 = 24; E.d1 = (u16*)(ws + W_Z); E.p1 = DI; E.t2 = 40; E.d2 = (u16*)(ws + W_SMALL); E.p2 = 256; E.f32seg2 = 1; break;
        case PH_G1B: g.Bt = (const u16*)(ws + W_WIN) + (size_t)10496 * DM; g.N = 16 * 256;
            E.d0 = (u16*)(ws + W_GM); E.p0 = DM; E.t1 = 8; E.d1 = (u16*)(ws + W_GF); E.p1 = DM; break;
        case PH_G2: g.A = (const u16*)(ws + W_Z); g.Bt = (const u16*)(ws + W_WPM); g.K = DI; E.mode = 1; break;
        case PH_G1C: g.Bt = (const u16*)(ws + W_WIN) + (size_t)14592 * DM; g.N = 24 * 256;
            E.d0 = (u16*)(ws + W_Q); E.p0 = DM; E.t1 = 8; E.d1 = (u16*)(ws + W_K); E.p1 = DM; E.t2 = 16; E.d2 = (u16*)(ws + W_V); E.p2 = DM; break;
        case PH_G3: g.A = (const u16*)(ws + W_Q); g.Bt = (const u16*)(ws + W_WPF); E.mode = 2; break;
        case PH_G4: g.A = (const u16*)(ws + W_GM); g.Bt = (const u16*)(ws + W_WOUT); E.mode = 3; break;
        case PH_G5A: g.Bt = (const u16*)(ws + W_WUP); g.M = HALF_ROWS; g.N = DFF2; E.d0 = (u16*)(ws + W_U); E.p0 = DFF2; break;
        case PH_G5B: g.A = (const u16*)(ws + W_H) + (size_t)HALF_ROWS * DM; g.Bt = (const u16*)(ws + W_WUP); g.M = HALF_ROWS; g.N = DFF2; E.d0 = (u16*)(ws + W_U); E.p0 = DFF2; break;
        default:   g.A = (const u16*)(ws + W_G); g.Bt = (const u16*)(ws + W_WDN); g.K = DFF; E.mode = 5; break;
        }
        pg8::StaticOrder S; S.init(g.M, g.N, cx.G, cx.bid);
        pg8::gemm_phase<Epi, pg8::StaticOrder, true, true>((PG8_LAS unsigned char*)lds, g, S, E, cx.tid);
        if (ph < last) xcd_barrier(xbar);
    }
}
#define PH_BEGIN() Ctx cx; { int t_ = threadIdx.x; asm volatile("" : "+v"(t_)); int b_ = blockIdx.x, g_ = gridDim.x; asm volatile("" : "+s"(b_), "+s"(g_)); cx.tid = t_; cx.bid = b_; cx.G = g_; } \
    KPrm p = (KPrm)__builtin_amdgcn_kernarg_segment_ptr(); asm volatile("" : "+s"(p))
#ifdef ONLY_PH
#define PH_ON(k) ((k) == ONLY_PH)
#else
#define PH_ON(k) true
#endif
__global__ void __launch_bounds__(512, 2) mega_fwd(Prm prm_unused) {
    extern __shared__ __attribute__((aligned(16))) unsigned char lds[];
    cg::grid_group grid = cg::this_grid();
    volatile LAS unsigned* bst = (volatile LAS unsigned*)(lds + LDS_TOTAL - 64);
    if (threadIdx.x < 2) bst[threadIdx.x] = 0u;
    __syncthreads();
    XcdBarrier xbar; { KPrm p0 = (KPrm)__builtin_amdgcn_kernarg_segment_ptr(); xbar = xcd_barrier_post((unsigned*)(p0->ws + W_BAR), bst); }
#define GSYNC() xcd_barrier(xbar)
#ifndef EXP
#define EXP 0
#endif
    if (PH_ON(PH_PREP)) { PH_BEGIN(); phase_prep(p, cx, lds); } grid.sync();
#if EXP == 3
    { PH_BEGIN(); phase_prep(p, cx, lds); } GSYNC();
#endif
    if (PH_ON(PH_N1)) { PH_BEGIN(); phase_norm(p, cx, 0); } GSYNC();
    if (PH_ON(PH_G1A)) { PH_BEGIN(); run_gemms(p, cx, lds, PH_G1A, PH_G1A, xbar); } GSYNC();
#if EXP == 1
    { PH_BEGIN(); run_gemms(p, cx, lds, PH_G1A, PH_G1A, xbar); } GSYNC();
#endif
    if (PH_ON(PH_CONV)) { PH_BEGIN(); phase_conv(p, cx); } GSYNC();
    if (PH_ON(PH_SSD)) { PH_BEGIN(); phase_ssd(p, cx, lds); } GSYNC();
#if EXP == 2
    { PH_BEGIN(); run_gemms(p, cx, lds, PH_G1A, PH_G1A, xbar); } GSYNC();
    { PH_BEGIN(); phase_conv(p, cx); } GSYNC();
    { PH_BEGIN(); phase_ssd(p, cx, lds); } GSYNC();
#endif
    if (PH_ON(PH_GN)) { PH_BEGIN(); phase_gn(p, cx); } GSYNC();
    if (PH_ON(PH_G1B)) { PH_BEGIN(); run_gemms(p, cx, lds, PH_G1B, PH_G1C, xbar); } GSYNC();
    if (PH_ON(PH_QK)) { PH_BEGIN(); phase_qk(p, cx); } GSYNC();
    if (PH_ON(PH_ATT)) { PH_BEGIN(); phase_att(p, cx, (char*)lds); } GSYNC();
#if EXP == 4
    { PH_BEGIN(); run_gemms(p, cx, lds, PH_G1C, PH_G1C, xbar); } GSYNC();
    { PH_BEGIN(); phase_qk(p, cx); } GSYNC();
    { PH_BEGIN(); phase_att(p, cx, (char*)lds); } GSYNC();
#endif
    if (PH_ON(PH_G3)) { PH_BEGIN(); run_gemms(p, cx, lds, PH_G3, PH_G4, xbar); } GSYNC();
    if (PH_ON(PH_N2)) { PH_BEGIN(); phase_norm(p, cx, 1); } GSYNC();
    if (PH_ON(PH_G5A)) { PH_BEGIN(); run_gemms(p, cx, lds, PH_G5A, PH_G5A, xbar); } GSYNC();
    if (PH_ON(PH_CVA)) { PH_BEGIN(); phase_cv(p, cx, 0); } GSYNC();
    if (PH_ON(PH_G5B)) { PH_BEGIN(); run_gemms(p, cx, lds, PH_G5B, PH_G5B, xbar); } GSYNC();
    if (PH_ON(PH_CVB)) { PH_BEGIN(); phase_cv(p, cx, 1); } GSYNC();
    if (PH_ON(PH_G6)) { PH_BEGIN(); run_gemms(p, cx, lds, PH_G6, PH_G6, xbar); }
#if EXP == 5
#pragma unroll 1
    for (int r = 0; r < 32; ++r) GSYNC();
#endif
}

extern "C" void kernel_launch(void* const* d_in, const int* in_sizes, int n_in, void* d_out, int out_size, void* d_ws, size_t ws_size, hipStream_t stream) {
    static int grid = 0;
    if (grid == 0) {
        if (n_in != 31 || (size_t)out_size != O_END || ws_size < 1024 * MiB) { fprintf(stderr, "kernel_launch: unexpected sizes n_in %d out %d ws %zu\n", n_in, out_size, ws_size); }
        int dev = 0, cus = 0, per_cu = 0;
        hipGetDevice(&dev); hipDeviceGetAttribute(&cus, hipDeviceAttributeMultiprocessorCount, dev);
        hipFuncSetAttribute((const void*)mega_fwd, hipFuncAttributeMaxDynamicSharedMemorySize, LDS_TOTAL);
        hipOccupancyMaxActiveBlocksPerMultiprocessor(&per_cu, (const void*)mega_fwd, 512, LDS_TOTAL);
        (void)hipGetLastError();
        if (per_cu < 1) per_cu = 1;
        grid = cus;
    }
    (void)hipMemsetAsync((char*)d_ws + W_BAR, 0, 16384, stream);
    Prm prm{};
    for (int i = 0; i < 31; ++i) prm.in[i] = (const float*)d_in[i];
    prm.out = (float*)d_out; prm.ws = (unsigned char*)d_ws;
    void* args[] = {&prm};
    hipError_t e = hipLaunchCooperativeKernel((const void*)mega_fwd, dim3(grid), dim3(512), args, LDS_TOTAL, stream);
    if (e != hipSuccess) fprintf(stderr, "cooperative launch failed: %s (grid %d)\n", hipGetErrorString(e), grid);
}
```

```cpp
#include <hip/hip_runtime.h>
#include <hip/hip_cooperative_groups.h>
#include <hip/hip_bf16.h>
#include <cstdio>
#include <cstdint>
namespace cg = cooperative_groups;
namespace pg8 {
#define PG8_LAS __attribute__((address_space(3)))
typedef unsigned short bf16_t;
typedef short bf16x8 __attribute__((ext_vector_type(8)));
typedef float f32x4 __attribute__((ext_vector_type(4)));
typedef unsigned u32x4 __attribute__((ext_vector_type(4)));
constexpr int BM = 256, BK = 64, HALF = 128, HTB = HALF * BK * 2  , STAGE_BYTES = 8 * HTB, NXCD = 8, WGM = 8;

__host__ __device__ __forceinline__ int lds_byte(int r, int c) { const int st = (r >> 4) * 2 + (c >> 5), rr = r & 15, cc = c & 31, ob = rr * 64 + cc * 2; return st * 1024 + (ob ^ (((ob >> 9) & 1) << 5)); }
__host__ __device__ __forceinline__ void stage_rc(int b, int& R, int& C) { const int st = b / 1024, sb = b % 1024, swz = sb ^ (((sb >> 9) & 1) << 5); R = (st >> 1) * 16 + swz / 64; C = (st & 1) * 32 + (swz % 64) / 2; }
__host__ __device__ __forceinline__ int perm32(int rho) { const int n = rho >> 4, i = rho & 15; return 8 * (i >> 2) + 4 * n + (i & 3); }

struct Unit { int pm, pn; };
struct Gemm { const bf16_t* A; const bf16_t* Bt; int M, N, K; };

struct StaticOrder {
    int nM, nN, nwg, G, c;
    __host__ __device__ void init(int M, int N, int G_, int c_) { nM = M / BM; nN = N / BM; nwg = nM * nN; G = G_; c = c_; }
    __host__ __device__ bool next(int i, Unit& u) const {
        const long L = (long)i * G + c; if (L >= nwg) return false;
        int wgid = (int)L; { const int q = nwg / NXCD, r = nwg % NXCD, xcd = wgid % NXCD, off = wgid / NXCD; wgid = (xcd < r ? xcd * (q + 1) : r * (q + 1) + (xcd - r) * q) + off; }
        const int nig = WGM * nN, gid = wgid / nig, fm = gid * WGM, gsz = (nM - fm) < WGM ? (nM - fm) : WGM;
        u.pm = fm + ((wgid % nig) % gsz); u.pn = (wgid % nig) / gsz; return true;
    }
    __device__ __forceinline__ void a_ready(const Unit&) const {}
    __device__ __forceinline__ void done(const Unit&) const {}
};
__device__ __forceinline__ unsigned cvt_pk_bf16(float lo, float hi) { unsigned r; asm volatile("v_cvt_pk_bf16_f32 %0, %1, %2" : "=v"(r) : "v"(lo), "v"(hi)); return r; }
typedef float f32x2 __attribute__((ext_vector_type(2)));
template <class Epi, class Sched, bool ALIGN_EPI = false, bool SP2 = false>
__device__ __forceinline__ void gemm_phase(PG8_LAS unsigned char* lds, const Gemm g, const Sched& S, const Epi& E, const int tid) {
    const int wid = __builtin_amdgcn_readfirstlane(tid >> 6), lane = tid & 63, wr = wid >> 2, wc = wid & 3, fr = lane & 15, fq = lane >> 4;
    const int K = g.K, nt = K / BK;
    unsigned voffA[2], voffB[2];
#pragma unroll
    for (int i = 0; i < 2; ++i) { int R, C; stage_rc(tid * 16 + i * 8192, R, C); const int Rb = Epi::PERM ? ((R & ~31) + perm32(R & 31)) : R;
        voffA[i] = (unsigned)(R * K + C) * 2u; voffB[i] = (unsigned)(Rb * K + C) * 2u; }
    const size_t kstep = (size_t)(BK * 2);
    const size_t hstep = (size_t)HALF * K * 2;
    const size_t tstep = 2 * hstep;
    const unsigned ldsw = (unsigned)wid * 1024u;
    const int aoff = lds_byte(wr * 64 + fr, fq * 8), boff = lds_byte(wc * 32 + fr, fq * 8);
#define PG8_SA(b, h) (((b) * 2 + (h)) * HTB)
#define PG8_SB(b, h) ((4 + (b) * 2 + (h)) * HTB)
#define PG8_STAGE(bufoff, gbase, voff) do { _Pragma("unroll") for (int _i = 0; _i < 2; ++_i) \
        __builtin_amdgcn_global_load_lds((const unsigned*)((const char*)(gbase) + (voff)[_i]), (PG8_LAS unsigned*)(lds + (bufoff) + ldsw + _i * 8192), 16, 0, 0); } while (0)
#define PG8_LDA(dst, b, h) do { _Pragma("unroll") for (int m = 0; m < 4; ++m) _Pragma("unroll") for (int k = 0; k < 2; ++k) dst[m][k] = *(const PG8_LAS bf16x8*)(lds + PG8_SA(b, h) + aoff + m * 2048 + k * 1024); } while (0)
#define PG8_LDB(dst, b, h) do { _Pragma("unroll") for (int n = 0; n < 2; ++n) _Pragma("unroll") for (int k = 0; k < 2; ++k) dst[n][k] = *(const PG8_LAS bf16x8*)(lds + PG8_SB(b, h) + boff + n * 2048 + k * 1024); } while (0)
#define PG8_MMA(ai, bj, At, Bt) do { __builtin_amdgcn_s_setprio(1); _Pragma("unroll") for (int m = 0; m < 4; ++m) _Pragma("unroll") for (int n = 0; n < 2; ++n) _Pragma("unroll") for (int k = 0; k < 2; ++k) \
        acc[ai][bj][m][n] = __builtin_amdgcn_mfma_f32_16x16x32_bf16(Bt[n][k], At[m][k], acc[ai][bj][m][n], 0, 0, 0); __builtin_amdgcn_s_setprio(0); } while (0)
#define PG8_WAIT_V(n) asm volatile("s_waitcnt vmcnt(" #n ")" ::: "memory")
#define PG8_WAIT_L(n) asm volatile("s_waitcnt lgkmcnt(" #n ")" ::: "memory")
#define PG8_BAR __builtin_amdgcn_s_barrier()
#define PG8_SCHED __builtin_amdgcn_sched_barrier(0)
    Unit cur, nxt; int ui = 0;
    if (!S.next(0, cur)) return;
    f32x4 acc[2][2][4][2];
#pragma unroll
    for (int a = 0; a < 2; ++a)
#pragma unroll
        for (int b = 0; b < 2; ++b)
#pragma unroll
            for (int m = 0; m < 4; ++m)
#pragma unroll
                for (int n = 0; n < 2; ++n) acc[a][b][m][n] = (f32x4){0.f, 0.f, 0.f, 0.f};
    bf16x8 At[4][2], B0[2][2], B1[2][2];
    const char* cA = (const char*)g.A + (size_t)cur.pm * tstep; const char* cB = (const char*)g.Bt + (size_t)cur.pn * tstep;
    S.a_ready(cur);
    if constexpr (SP2) {
        PG8_STAGE(PG8_SB(0, 0), cB, voffB); PG8_STAGE(PG8_SB(0, 1), cB + hstep, voffB); PG8_STAGE(PG8_SA(0, 0), cA, voffA); PG8_STAGE(PG8_SA(0, 1), cA + hstep, voffA);
        if (wr == 1) PG8_BAR;
        PG8_WAIT_V(2); PG8_BAR;
        PG8_STAGE(PG8_SB(1, 0), cB + kstep, voffB); PG8_STAGE(PG8_SA(1, 0), cA + kstep, voffA); PG8_STAGE(PG8_SB(1, 1), cB + hstep + kstep, voffB);
        PG8_WAIT_V(6); PG8_BAR;
    } else {
        PG8_STAGE(PG8_SB(0, 0), cB, voffB); PG8_STAGE(PG8_SA(0, 0), cA, voffA); PG8_STAGE(PG8_SB(0, 1), cB + hstep, voffB); PG8_STAGE(PG8_SA(0, 1), cA + hstep, voffA);
        if (wr == 1) PG8_BAR;
        PG8_WAIT_V(4); PG8_BAR;
        PG8_STAGE(PG8_SB(1, 0), cB + kstep, voffB); PG8_STAGE(PG8_SA(1, 0), cA + kstep, voffA); PG8_STAGE(PG8_SB(1, 1), cB + hstep + kstep, voffB);
        PG8_WAIT_V(6); PG8_BAR;
    }
    for (;;) {
        const bool has_next = S.next(ui + 1, nxt);
        const char* nA = has_next ? (const char*)g.A + (size_t)nxt.pm * tstep : cA; const char* nB = has_next ? (const char*)g.Bt + (size_t)nxt.pn * tstep : cB;
        for (int t = 0; t < nt; t += 2) {
            const bool last = (t == nt - 2);
            const char* a1 = cA + (size_t)(t + 1) * kstep;
            const char* a2 = last ? nA : cA + (size_t)(t + 2) * kstep; const char* b2 = last ? nB : cB + (size_t)(t + 2) * kstep;
            const char* a3 = a2 + kstep; const char* b3 = b2 + kstep;
            if (last && has_next) S.a_ready(nxt);
            if constexpr (SP2) {
            PG8_LDB(B0, 0, 0); PG8_LDB(B1, 0, 1); PG8_SCHED; PG8_LDA(At, 0, 0); PG8_STAGE(PG8_SA(1, 1), a1 + hstep, voffA);
            PG8_WAIT_V(8); PG8_WAIT_L(0); PG8_BAR; PG8_MMA(0, 0, At, B0); PG8_MMA(0, 1, At, B1); PG8_BAR; PG8_SCHED;
            PG8_LDA(At, 0, 1); PG8_STAGE(PG8_SB(0, 0), b2, voffB); PG8_STAGE(PG8_SB(0, 1), b2 + hstep, voffB); PG8_STAGE(PG8_SA(0, 0), a2, voffA);
            PG8_WAIT_V(8); PG8_WAIT_L(0); PG8_BAR; PG8_MMA(1, 0, At, B0); PG8_MMA(1, 1, At, B1); PG8_BAR; PG8_SCHED;
            PG8_LDB(B0, 1, 0); PG8_LDB(B1, 1, 1); PG8_SCHED; PG8_LDA(At, 1, 0); PG8_STAGE(PG8_SA(0, 1), a2 + hstep, voffA);
            PG8_WAIT_V(8); PG8_WAIT_L(0); PG8_BAR; PG8_MMA(0, 0, At, B0); PG8_MMA(0, 1, At, B1); PG8_BAR; PG8_SCHED;
            PG8_LDA(At, 1, 1); PG8_STAGE(PG8_SB(1, 0), b3, voffB); PG8_STAGE(PG8_SB(1, 1), b3 + hstep, voffB); PG8_STAGE(PG8_SA(1, 0), a3, voffA);
            PG8_WAIT_V(8); PG8_WAIT_L(0); PG8_BAR; PG8_MMA(1, 0, At, B0); PG8_MMA(1, 1, At, B1); PG8_BAR; PG8_SCHED;
            } else {
            PG8_LDB(B0, 0, 0); PG8_SCHED; PG8_LDA(At, 0, 0); PG8_STAGE(PG8_SA(1, 1), a1 + hstep, voffA);
            PG8_WAIT_L(8); PG8_BAR; PG8_WAIT_L(0); PG8_MMA(0, 0, At, B0); PG8_BAR; PG8_SCHED;
            PG8_LDB(B1, 0, 1); PG8_STAGE(PG8_SB(0, 0), b2, voffB);
            PG8_BAR; PG8_WAIT_L(0); PG8_MMA(0, 1, At, B1); PG8_BAR;
            PG8_LDA(At, 0, 1); PG8_STAGE(PG8_SA(0, 0), a2, voffA);
            PG8_BAR; PG8_WAIT_L(0); PG8_MMA(1, 0, At, B0); PG8_BAR; PG8_SCHED;
            PG8_STAGE(PG8_SB(0, 1), b2 + hstep, voffB);
            PG8_WAIT_V(6); PG8_BAR; PG8_MMA(1, 1, At, B1); PG8_BAR;
            PG8_LDB(B0, 1, 0); PG8_SCHED; PG8_LDA(At, 1, 0); PG8_STAGE(PG8_SA(0, 1), a2 + hstep, voffA);
            PG8_WAIT_L(8); PG8_BAR; PG8_WAIT_L(0); PG8_MMA(0, 0, At, B0); PG8_BAR; PG8_SCHED;
            PG8_LDB(B1, 1, 1); PG8_STAGE(PG8_SB(1, 0), b3, voffB);
            PG8_BAR; PG8_WAIT_L(0); PG8_MMA(0, 1, At, B1); PG8_BAR;
            PG8_LDA(At, 1, 1); PG8_STAGE(PG8_SA(1, 0), a3, voffA);
            PG8_BAR; PG8_WAIT_L(0); PG8_MMA(1, 0, At, B0); PG8_BAR; PG8_SCHED;
            PG8_STAGE(PG8_SB(1, 1), b3 + hstep, voffB);
            PG8_WAIT_V(6); PG8_BAR; PG8_MMA(1, 1, At, B1); PG8_BAR;
            }
        }
        if constexpr (ALIGN_EPI) { if (wr == 0) PG8_BAR; }
        if constexpr (!Epi::AFTER_DRAIN) { E(acc, cur, wr, wc, fr, fq); S.done(cur); }
        if (!has_next) break;
#pragma unroll
        for (int a = 0; a < 2; ++a)
#pragma unroll
            for (int b = 0; b < 2; ++b)
#pragma unroll
                for (int m = 0; m < 4; ++m)
#pragma unroll
                    for (int n = 0; n < 2; ++n) acc[a][b][m][n] = (f32x4){0.f, 0.f, 0.f, 0.f};
        cur = nxt; cA = nA; cB = nB; ++ui;
        if constexpr (ALIGN_EPI) { if (wr == 1) PG8_BAR; }
    }
    PG8_WAIT_V(0);
    if constexpr (!ALIGN_EPI) { if (wr == 0) PG8_BAR; }
    PG8_BAR;
    if constexpr (Epi::AFTER_DRAIN) { E.fused(acc, cur, wr, wc, fr, fq, lds, wid, lane); S.done(cur); }
#undef PG8_SA
#undef PG8_SB
#undef PG8_STAGE
#undef PG8_LDA
#undef PG8_LDB
#undef PG8_MMA
#undef PG8_WAIT_V
#undef PG8_WAIT_L
#undef PG8_BAR
#undef PG8_SCHED
}
}
namespace att {
constexpr int D = 128, PITCH = 2048, NW = 8, QBLK = 32, KVBLK = 64, QB = NW * QBLK;
constexpr int SHM_V = KVBLK * D * 2, SHM_K = KVBLK * D * 2;
constexpr int LDS_BIAS = 2 * SHM_V + 2 * SHM_K + NW * 64 * 4;
constexpr int NQX = 4, LDS_QX = LDS_BIAS + 512;
constexpr int LDS_BYTES = LDS_QX + NW * NQX * 1024;
constexpr float THR2 = 64.f;
constexpr bool WSKIP = false;
typedef __hip_bfloat16 bf16;
typedef short bf16x8 __attribute__((ext_vector_type(8)));
typedef short s16x4 __attribute__((ext_vector_type(4)));
typedef float f32x16 __attribute__((ext_vector_type(16)));
typedef float f32x4 __attribute__((ext_vector_type(4)));
typedef unsigned u32x4 __attribute__((ext_vector_type(4)));
template <class A, class Bt> struct same_t { static constexpr bool v = false; };
template <class A> struct same_t<A, A> { static constexpr bool v = true; };

#define KSWZ(row, colB) ((row) * 256 + ((colB) ^ (((row) & 7) << 4)))
#define SBAR() __builtin_amdgcn_sched_barrier(0)
__device__ __forceinline__ int v_st(int k, int c) { const int kk = (k & ~0xC) | ((k & 4) << 1) | ((k & 8) >> 1); return ((kk >> 3) * 4 + (c >> 5)) * 512 + ((kk & 7) * 32 + (c & 31)) * 2; }
__device__ __forceinline__ int v_rd_base(int lane) { return ((lane & 3) << 3) | (((lane >> 2) & 3) << 6) | (((lane >> 4) & 1) << 5) | (((lane >> 5) & 1) << 8); }
constexpr int v_rd_off(int d0, int ks, int half) { return d0 * 512 + ks * 4096 + half * 2048; }
__device__ __forceinline__ int crow(int r, int hi) { return (r & 3) + 8 * (r >> 2) + 4 * hi; }
__device__ __forceinline__ unsigned cvtpk(float lo, float hi) {
    unsigned r; asm volatile("v_cvt_pk_bf16_f32 %0, %1, %2" : "=v"(r) : "v"(lo), "v"(hi)); return r;
}
__device__ __forceinline__ bf16x8 pack8(f32x4 a, f32x4 b) {
    u32x4 w = {cvtpk(a[0], a[1]), cvtpk(a[2], a[3]), cvtpk(b[0], b[1]), cvtpk(b[2], b[3])};
    return *reinterpret_cast<bf16x8*>(&w);
}
template <class T> __device__ __forceinline__ bf16x8 load8(const T* p) {
    if constexpr (same_t<T, float>::v) { return pack8(*(const f32x4*)p, *(const f32x4*)(p + 4)); }
    else { return *reinterpret_cast<const bf16x8*>(p); }
}
__device__ __forceinline__ void mask_tile(f32x16& p0, f32x16& p1, int dq, unsigned W) {
    const float NEG = -__builtin_inff();
#pragma unroll
    for (int r = 0; r < 16; ++r) {
        const int c = (r & 3) + 8 * (r >> 2);
        if (dq - c < 0) p0[r] = NEG;
        if (dq - c - 32 < 0) p1[r] = NEG;
    }
}
__device__ __forceinline__ void partialSM(f32x16& p0, f32x16& p1, float& m_reg, float& mn, float& alpha) {
    float pmax = p0[0]; for (int r = 1; r < 16; ++r) pmax = fmaxf(pmax, p0[r]); for (int r = 0; r < 16; ++r) pmax = fmaxf(pmax, p1[r]);
    { auto rr = __builtin_amdgcn_permlane32_swap(__float_as_uint(pmax), __float_as_uint(pmax), false, false);
      pmax = fmaxf(__uint_as_float(rr[0]), __uint_as_float(rr[1])); }
    if (__builtin_expect(__all((pmax - m_reg) <= THR2), 1)) { mn = m_reg; alpha = 1.f; }
    else { mn = fmaxf(m_reg, pmax); alpha = __builtin_amdgcn_exp2f(m_reg - mn); m_reg = mn; }
    for (int r = 0; r < 16; ++r) p0[r] = p0[r] - mn; for (int r = 0; r < 16; ++r) p1[r] = p1[r] - mn;
    for (int r = 0; r < 16; ++r) p0[r] = __builtin_amdgcn_exp2f(p0[r]);
}
__device__ __forceinline__ void finishSM(f32x16& p0, f32x16& p1, float alpha, float& l_reg, bf16x8& pa0, bf16x8& pa1, bf16x8& pa2, bf16x8& pa3) {
    for (int r = 0; r < 16; ++r) p1[r] = __builtin_amdgcn_exp2f(p1[r]);
    float ps = 0; for (int r = 0; r < 16; ++r) ps += p0[r]; for (int r = 0; r < 16; ++r) ps += p1[r];
    { auto rr = __builtin_amdgcn_permlane32_swap(__float_as_uint(ps), __float_as_uint(ps), false, false);
      ps = __uint_as_float(rr[0]) + __uint_as_float(rr[1]); }
    l_reg = l_reg * alpha + ps;
#define PK4(P, B_, OUT) do { unsigned a0 = cvtpk(P[B_+0], P[B_+1]), a1 = cvtpk(P[B_+2], P[B_+3]);                          \
        unsigned b0 = cvtpk(P[B_+4], P[B_+5]), b1 = cvtpk(P[B_+6], P[B_+7]);                                             \
        auto r0 = __builtin_amdgcn_permlane32_swap(a0, b0, false, false); auto r1 = __builtin_amdgcn_permlane32_swap(a1, b1, false, false); \
        u32x4 w = {r0[0], r1[0], r0[1], r1[1]}; OUT = *reinterpret_cast<bf16x8*>(&w); } while (0)
    PK4(p0, 0, pa0); PK4(p0, 8, pa1); PK4(p1, 0, pa2); PK4(p1, 8, pa3);
#undef PK4
}
template <int KB, bool SK>
__device__ __forceinline__ void qkt(f32x16& p0, f32x16& p1, const char* K_lds, int r32, int hi, const bf16x8* qr, bool act, const char* qx) {
    if (SK && !act) { const float NEG = -__builtin_inff();
#pragma unroll
        for (int r = 0; r < 16; ++r) { p0[r] = NEG; p1[r] = NEG; } return; }
    { const float* bl = (const float*)(K_lds - 2 * SHM_V + LDS_BIAS) + KB * 64 + 4 * hi;
#pragma unroll
      for (int g = 0; g < 4; ++g) { const f32x4 u0 = *(const f32x4*)(bl + 8 * g), u1 = *(const f32x4*)(bl + 32 + 8 * g);
        p0[4*g] = u0[0]; p0[4*g+1] = u0[1]; p0[4*g+2] = u0[2]; p0[4*g+3] = u0[3]; p1[4*g] = u1[0]; p1[4*g+1] = u1[1]; p1[4*g+2] = u1[2]; p1[4*g+3] = u1[3]; } }
    const char* kb[4];
#pragma unroll
    for (int dd = 0; dd < 4; ++dd) kb[dd] = K_lds + KB * SHM_K + KSWZ(r32, (dd * 16 + hi * 8) * 2);
#pragma unroll
    for (int d0 = 0; d0 < 8; ++d0) { const char* a = kb[d0 & 3] + (d0 >> 2) * 128;
        bf16x8 b0 = *reinterpret_cast<const bf16x8*>(a);
        bf16x8 b1 = *reinterpret_cast<const bf16x8*>(a + 32 * 256);
        const bf16x8 qv = (d0 < 8 - NQX) ? qr[d0] : *reinterpret_cast<const bf16x8*>(qx + (d0 - (8 - NQX)) * 1024);
        p0 = __builtin_amdgcn_mfma_f32_32x32x16_bf16(b0, qv, p0, 0, 0, 0);
        p1 = __builtin_amdgcn_mfma_f32_32x32x16_bf16(b1, qv, p1, 0, 0, 0); }
}
template <int VB, bool SK>
__device__ __forceinline__ void pv_tile(f32x16* o, int vb0, bf16x8 pa0, bf16x8 pa1, bf16x8 pa2, bf16x8 pa3, bool act) {
    if (SK && !act) return;
#define TRRD(dst, off) asm volatile("ds_read_b64_tr_b16 %0, %1 offset:%2" : "=&v"(dst) : "v"(vb0), "i"(off) : "memory")
#define PV_D0(d0) do { s16x4 l0, l1, l2, l3, h0, h1, h2, h3; constexpr int b_ = VB * SHM_V + v_rd_off(d0, 0, 0);     \
        TRRD(l0, b_); TRRD(h0, b_ + 2048); TRRD(l1, b_ + 4096); TRRD(h1, b_ + 6144); TRRD(l2, b_ + 8192); TRRD(h2, b_ + 10240); TRRD(l3, b_ + 12288); TRRD(h3, b_ + 14336); \
        asm volatile("s_waitcnt lgkmcnt(0)" ::: "memory"); SBAR();                 \
        o[d0] = __builtin_amdgcn_mfma_f32_32x32x16_bf16(pa0, (bf16x8){l0[0], l0[1], l0[2], l0[3], h0[0], h0[1], h0[2], h0[3]}, o[d0], 0, 0, 0);   \
        o[d0] = __builtin_amdgcn_mfma_f32_32x32x16_bf16(pa1, (bf16x8){l1[0], l1[1], l1[2], l1[3], h1[0], h1[1], h1[2], h1[3]}, o[d0], 0, 0, 0);   \
        o[d0] = __builtin_amdgcn_mfma_f32_32x32x16_bf16(pa2, (bf16x8){l2[0], l2[1], l2[2], l2[3], h2[0], h2[1], h2[2], h2[3]}, o[d0], 0, 0, 0);   \
        o[d0] = __builtin_amdgcn_mfma_f32_32x32x16_bf16(pa3, (bf16x8){l3[0], l3[1], l3[2], l3[3], h3[0], h3[1], h3[2], h3[3]}, o[d0], 0, 0, 0); } while (0)
    PV_D0(0); PV_D0(1); PV_D0(2); PV_D0(3);
#undef PV_D0
#undef TRRD
}

template <class TIn, class TOut> struct BlockRef { const TIn* Q; const TIn* K; const TIn* V; TOut* O; const float* Bs; int P0; int nvalid; };
template <class TIn> struct Seam {
    bf16x8 qr[8];
    bf16x8 st_v0, st_v1, st_k0, st_k1; f32x4 sf0, sf1, sf2, sf3;
    f32x4 tq[16];
};
__device__ __forceinline__ int swa_jlo(int P0, int W) { const int lowk = P0 - W + 1; return lowk > 0 ? lowk / KVBLK : 0; }
#define ROW(p, k0, rr) ((p) + (size_t)((k0) + (rr)) * PITCH + sc)
#define VMW() asm volatile("s_waitcnt vmcnt(0)" ::: "memory")
#define VMWN(n) asm volatile("s_waitcnt vmcnt(%0)" :: "i"(n) : "memory")
#define GLDS(gp_, lp_, sz_) __builtin_amdgcn_global_load_lds((const unsigned*)(gp_), (__attribute__((address_space(3))) unsigned*)(lp_), sz_, 0, 0)
#define SLOAD_H(Kp, Vp, Bp, k0, bb_) do { S.st_v0 = load8<TIn>(ROW(Vp, k0, sr)); S.st_v1 = load8<TIn>(ROW(Vp, k0, 32 + sr));              \
                         { const TIn* kg_ = (Kp) + (size_t)(k0) * PITCH; char* kl_ = K_lds + (bb_) * SHM_K + wid * 2048; GLDS(kg_ + ksrc0, kl_, 16); GLDS(kg_ + ksrc1, kl_ + 1024, 16); } \
                         if (wid == 0) GLDS((Bp) + (k0) + lane, lds + LDS_BIAS + (bb_) * 256, 4); } while (0)
#define SWRITE_HK(bf) do { } while (0)
#define SWRITE_HV(bf) do { *(bf16x8*)(V_lds + (bf) * SHM_V + vst0) = S.st_v0; *(bf16x8*)(V_lds + (bf) * SHM_V + vst1) = S.st_v1; } while (0)
#define SWRITE_H(bf) do { SWRITE_HV(bf); SWRITE_HK(bf); } while (0)
#define SLOAD_F(p, k0) do { S.sf0 = *(const f32x4*)ROW(p, k0, sr); S.sf1 = *(const f32x4*)(ROW(p, k0, sr) + 4);                \
                            S.sf2 = *(const f32x4*)ROW(p, k0, 32 + sr); S.sf3 = *(const f32x4*)(ROW(p, k0, 32 + sr) + 4); } while (0)
#define SWRITE_KF(bf) do { *(bf16x8*)(K_lds + (bf) * SHM_K + kws) = pack8(S.sf0, S.sf1); *(bf16x8*)(K_lds + (bf) * SHM_K + kws + 32 * 256) = pack8(S.sf2, S.sf3); } while (0)
#define SWRITE_VF(bf) do { *(bf16x8*)(V_lds + (bf) * SHM_V + vst0) = pack8(S.sf0, S.sf1); *(bf16x8*)(V_lds + (bf) * SHM_V + vst1) = pack8(S.sf2, S.sf3); } while (0)
template <class TIn, class TOut>
__device__ __forceinline__ void causal_swa_prime(const BlockRef<TIn, TOut>& cur, int W, char* lds, Seam<TIn>& S, const int tid) {
    constexpr bool F32 = same_t<TIn, float>::v;
    const int wid = __builtin_amdgcn_readfirstlane(tid >> 6), lane = tid & 63, r32 = lane & 31, hi = lane >> 5;
    const int sr = tid >> 4, sc = (tid & 15) * 8, kws = KSWZ(sr, sc * 2); char* K_lds = lds + 2 * SHM_V; (void)kws;
    const int ksrc0 = (8 * wid + (lane >> 4)) * PITCH + ((lane & 15) ^ (lane >> 4)) * 8, ksrc1 = (8 * wid + 4 + (lane >> 4)) * PITCH + ((lane & 15) ^ (4 + (lane >> 4))) * 8;
    const int kb0 = swa_jlo(cur.P0, W) * KVBLK;
    for (int d0 = 0; d0 < 8; ++d0) S.qr[d0] = load8<TIn>(cur.Q + (size_t)(wid * QBLK + r32) * PITCH + d0 * 16 + hi * 8);
    if constexpr (F32) { SLOAD_F((const float*)cur.K, kb0); VMW(); SWRITE_KF(0); SBAR(); SLOAD_F((const float*)cur.V, kb0); }
    else { SLOAD_H(cur.K, cur.V, cur.Bs, kb0, 0); VMW(); SWRITE_HK(0); }
    __syncthreads();
}
template <class TIn, class TOut>
__device__ __forceinline__ void causal_swa_block(const BlockRef<TIn, TOut>& cur, const BlockRef<TIn, TOut>& nxt, int skv, int W, char* lds, Seam<TIn>& S, const int tid, const float* qnw, const float qs) {
    constexpr bool F32 = same_t<TIn, float>::v;
    const int wid = __builtin_amdgcn_readfirstlane(tid >> 6), lane = tid & 63, r32 = lane & 31, hi = lane >> 5;
    const int j_lo = swa_jlo(cur.P0, W);
    int j_hi = (cur.P0 + QB - 1) / KVBLK + 1; if (j_hi > skv / KVBLK) j_hi = skv / KVBLK;
    const int NT = j_hi - j_lo;
    const int kbn = swa_jlo(nxt.P0, W) * KVBLK;
    const int qlo = cur.P0 + wid * QBLK, qm = qlo + r32 - 4 * hi;
    char* V_lds = lds; char* K_lds = lds + 2 * SHM_V;
    float* ws = (float*)(lds + 2 * SHM_V + 2 * SHM_K) + wid * 64; float* li_l = ws, * al_l = ws + 32;
    float m_reg = -1e30f, l_reg = 0; f32x16 o[4] = {};
    const int sr = tid >> 4, sc = (tid & 15) * 8, vst0 = v_st(sr, sc), vst1 = v_st(32 + sr, sc), kws = KSWZ(sr, sc * 2);
    const int vb0 = (int)(uintptr_t)V_lds + v_rd_base(lane); (void)kws;
    const int ksrc0 = (8 * wid + (lane >> 4)) * PITCH + ((lane & 15) ^ (lane >> 4)) * 8, ksrc1 = (8 * wid + 4 + (lane >> 4)) * PITCH + ((lane & 15) ^ (4 + (lane >> 4))) * 8;
    const TIn* Kh = cur.K; const TIn* Vh = cur.V; const float* Bh = cur.Bs;
#define RESC(a) do { if (__any((a) < 1.f)) { if (hi == 0) al_l[r32] = (a); asm volatile("s_waitcnt lgkmcnt(0)" ::: "memory");              \
                     for (int d_ = 0; d_ < 4; ++d_) for (int r = 0; r < 16; ++r) o[d_][r] *= al_l[crow(r, hi)]; } } while (0)
#define KBASE(t) ((j_lo + (t)) * KVBLK)
#define ACT(t) (KBASE(t) <= qlo + QBLK - 1 && KBASE(t) + KVBLK - 1 >= qlo - W + 1)
#define MASKT(P0_, P1_, t) do { const int kb_ = KBASE(t); if ((!SK || ACT(t)) && (kb_ + KVBLK - 1 > qlo || kb_ <= qlo + QBLK - 1 - W)) mask_tile(P0_, P1_, qm - kb_, (unsigned)W); } while (0)
    constexpr int NQL = F32 ? 16 : 8;
    constexpr bool SK = WSKIP && !F32;
#define SEAM_K0() do { VMWN(NQL); if constexpr (F32) { SWRITE_KF(0); SBAR(); SLOAD_F((const float*)nxt.V, kbn); } else { SWRITE_HK(0); } SBAR(); } while (0)
    f32x16 pA0, pA1, pB0, pB1; float mnA, mnB, alA, alB; bf16x8 pa0, pa1, pa2, pa3;
    {
        const float* wq_ = qnw; asm volatile("" : "+s"(wq_));
        float ss_ = 0.f;
#pragma unroll
        for (int d0 = 0; d0 < 8; ++d0) { const u32x4 w_ = __builtin_bit_cast(u32x4, S.qr[d0]);
#pragma unroll
            for (int e = 0; e < 4; ++e) { const float lo_ = __uint_as_float(w_[e] << 16), hi_ = __uint_as_float(w_[e] & 0xffff0000u); ss_ += lo_ * lo_ + hi_ * hi_; } }
        { auto rr = __builtin_amdgcn_permlane32_swap(__float_as_uint(ss_), __float_as_uint(ss_), false, false); ss_ = __uint_as_float(rr[0]) + __uint_as_float(rr[1]); }
        const float rs_ = rsqrtf(ss_ * (1.f / 128.f) + 1e-6f) * qs;
#pragma unroll
        for (int d0 = 0; d0 < 8; ++d0) { const u32x4 w_ = __builtin_bit_cast(u32x4, S.qr[d0]); const f32x4 g0 = *(const f32x4*)(wq_ + d0 * 16 + hi * 8), g1 = *(const f32x4*)(wq_ + d0 * 16 + hi * 8 + 4); u32x4 o_;
#pragma unroll
            for (int e = 0; e < 4; ++e) { const float lo_ = __uint_as_float(w_[e] << 16) * rs_ * (e < 2 ? g0[2 * e] : g1[2 * e - 4]), hi_ = __uint_as_float(w_[e] & 0xffff0000u) * rs_ * (e < 2 ? g0[2 * e + 1] : g1[2 * e - 3]); o_[e] = cvtpk(lo_, hi_); }
            S.qr[d0] = __builtin_bit_cast(bf16x8, o_); }
    }
    char* qx = lds + LDS_QX + wid * (NQX * 1024) + lane * 16;
#pragma unroll
    for (int e = 0; e < NQX; ++e) *reinterpret_cast<bf16x8*>(qx + e * 1024) = S.qr[8 - NQX + e];
    if constexpr (F32) { VMW(); SWRITE_VF(0); SBAR(); } else { SWRITE_HV(0); SBAR(); }
    if (NT > 1) { if constexpr (F32) SLOAD_F((const float*)Kh, KBASE(1)); else SLOAD_H(Kh, Vh, Bh, KBASE(1), 1); }
    SBAR(); qkt<0, SK>(pA0, pA1, K_lds, r32, hi, S.qr, ACT(0), qx);
    if constexpr (F32) { if (NT > 1) { VMW(); SWRITE_KF(1); SBAR(); SLOAD_F((const float*)Vh, KBASE(1)); } }
    MASKT(pA0, pA1, 0); partialSM(pA0, pA1, m_reg, mnA, alA);
    if (NT > 1) { VMW(); if constexpr (F32) { SWRITE_VF(1); SBAR(); if (NT > 2) SLOAD_F((const float*)Kh, KBASE(2)); } else SWRITE_H(1); }
    __syncthreads();
#define HALF_STEP(PX0, PX1, mnX, alX, PY0, PY1, alY, t, KB, VB, SB) do {                                                      \
        SBAR(); qkt<KB, SK>(PX0, PX1, K_lds, r32, hi, S.qr, ACT(t), qx);                                             \
        finishSM(PY0, PY1, alY, l_reg, pa0, pa1, pa2, pa3); SBAR();                                                           \
        if ((t) + 1 < NT) { if constexpr (F32) { VMW(); SWRITE_KF(SB); SBAR(); SLOAD_F((const float*)Vh, KBASE((t) + 1)); }  \
                            else { SLOAD_H(Kh, Vh, Bh, KBASE((t) + 1), SB); } SBAR(); }                                               \
        pv_tile<VB, SK>(o, vb0, pa0, pa1, pa2, pa3, ACT((t) - 1)); MASKT(PX0, PX1, (t)); partialSM(PX0, PX1, m_reg, mnX, alX);                                        \
        __syncthreads();                                                                                                      \
        if ((t) + 1 < NT) { VMW(); if constexpr (F32) { SWRITE_VF(SB); SBAR(); if ((t) + 2 < NT) SLOAD_F((const float*)Kh, KBASE((t) + 2)); } \
                            else { SWRITE_H(SB); } }                                                                          \
        RESC(alX); __syncthreads(); } while (0)
    for (int t = 1; t + 1 < NT; t += 2) {
        HALF_STEP(pB0, pB1, mnB, alB, pA0, pA1, alA, t, 1, 0, 0);
        HALF_STEP(pA0, pA1, mnA, alA, pB0, pB1, alB, t + 1, 0, 1, 1);
    }
    const bool even = (NT & 1) == 0;
    if (even) { SBAR(); qkt<1, SK>(pB0, pB1, K_lds, r32, hi, S.qr, ACT(NT - 1), qx); SBAR(); }
#define QROW(e) (nxt.Q + (size_t)(wid * QBLK + r32) * PITCH + ((e) >> 1) * 16 + hi * 8 + ((e) & 1) * 4)
    if constexpr (F32) { SLOAD_F((const float*)nxt.K, kbn); SBAR();
#pragma unroll
        for (int e = 0; e < 8; ++e) S.tq[e] = *(const f32x4*)QROW(e); }
    else { SLOAD_H(nxt.K, nxt.V, nxt.Bs, kbn, 0); SBAR();
#pragma unroll
        for (int d0 = 0; d0 < 8; ++d0) S.qr[d0] = load8<TIn>(nxt.Q + (size_t)(wid * QBLK + r32) * PITCH + d0 * 16 + hi * 8); }
    SBAR();
    finishSM(pA0, pA1, alA, l_reg, pa0, pa1, pa2, pa3); SBAR();
    if constexpr (F32) {
#pragma unroll
        for (int e = 8; e < 16; ++e) S.tq[e] = *(const f32x4*)QROW(e); SBAR(); }
#undef QROW
    pv_tile<0, SK>(o, vb0, pa0, pa1, pa2, pa3, ACT(even ? NT - 2 : NT - 1));
    if (even) { MASKT(pB0, pB1, NT - 1); partialSM(pB0, pB1, m_reg, mnB, alB); __syncthreads(); RESC(alB);
        finishSM(pB0, pB1, alB, l_reg, pa0, pa1, pa2, pa3); SBAR(); pv_tile<1, SK>(o, vb0, pa0, pa1, pa2, pa3, ACT(NT - 1)); }
    SBAR(); SEAM_K0();
    if (hi == 0) li_l[r32] = l_reg; asm volatile("s_waitcnt lgkmcnt(0)" ::: "memory");
    float rli[16];
#pragma unroll
    for (int r = 0; r < 16; ++r) rli[r] = __builtin_amdgcn_rcpf(li_l[crow(r, hi)]);
    int tidE = tid; asm volatile("" : "+v"(tidE));
    const int widE = __builtin_amdgcn_readfirstlane(tidE >> 6), r32E = tidE & 31, hiE = (tidE >> 5) & 1;
    TOut* Ow = cur.O + (size_t)(widE * QBLK) * PITCH; const bool wval = widE * QBLK < cur.nvalid;
    if (wval) {
#pragma unroll
    for (int r = 0; r < 16; ++r) { const int orow = crow(r, hiE);
#pragma unroll
        for (int d0 = 0; d0 < 4; ++d0) { const float v = o[d0][r] * rli[r];
            if constexpr (same_t<TOut, float>::v) { Ow[(size_t)orow * PITCH + d0 * 32 + r32E] = v; }
            else { const float vn = __shfl_xor(v, 1);
                   if ((r32E & 1) == 0) *(unsigned*)(Ow + (size_t)orow * PITCH + d0 * 32 + r32E) = cvtpk(v, vn); } } } }
    if constexpr (F32) {
#pragma unroll
        for (int d0 = 0; d0 < 8; ++d0) S.qr[d0] = pack8(S.tq[2 * d0], S.tq[2 * d0 + 1]); }
    __syncthreads();
#undef RESC
#undef KBASE
#undef ACT
#undef MASKT
#undef SEAM_K0
#undef HALF_STEP
}
#undef ROW
#undef VMW
#undef VMWN
#undef SLOAD_H
#undef GLDS
#undef SWRITE_HK
#undef SWRITE_HV
#undef SWRITE_H
#undef SLOAD_F
#undef SWRITE_KF
#undef SWRITE_VF

}
#define GAS __attribute__((address_space(1)))
#define LAS __attribute__((address_space(3)))
typedef GAS unsigned gu32;
typedef GAS unsigned long long gu64;
#define RLX_AGENT __ATOMIC_RELAXED, __HIP_MEMORY_SCOPE_AGENT
#define LDS_WAIT() asm volatile("s_waitcnt lgkmcnt(0)" ::: "memory")
#define VM_WAIT() asm volatile("s_waitcnt vmcnt(0)" ::: "memory")
__device__ __forceinline__ unsigned long long rt() { return __builtin_amdgcn_s_memrealtime(); }
#define XB_TMO      128
#define XB_XCNT(j)  (256  + 64 * (j))
#define XB_XSUB(j)  (1280 + 64 * (j))
#define XB_XGEN(j)  (2304 + 64 * (j))
#define XB_TOP      3328
#define XB_TOPGEN   3392
#define XCD_BAR_WORDS 3456
#define XB_SPIN_CAP (1u << 18)

__device__ __forceinline__ unsigned xb_ld(unsigned* p)              { return __hip_atomic_load(p, __ATOMIC_RELAXED, __HIP_MEMORY_SCOPE_AGENT); }
__device__ __forceinline__ unsigned xb_add(unsigned* p, unsigned v) { return __hip_atomic_fetch_add(p, v, __ATOMIC_RELAXED, __HIP_MEMORY_SCOPE_AGENT); }
__device__ __forceinline__ unsigned xb_xcc_id() { return (unsigned)__builtin_amdgcn_s_getreg((3 << 11) | 20) & 0xFu; }
#define XB_SPIN(cond, bar) do { unsigned _sp = 0; while (cond) { __builtin_amdgcn_s_sleep(1); \
    if ((++_sp & 255u) == 0u) { if (xb_ld(&(bar)[XB_TMO])) break; if (_sp > XB_SPIN_CAP) { atomicAdd(&(bar)[XB_TMO], 1u); break; } } } } while (0)

struct XcdBarrier {
    unsigned* bar; unsigned x;
    volatile LAS unsigned* st;
};

__device__ __forceinline__ XcdBarrier xcd_barrier_post(unsigned* bar, volatile LAS unsigned* st) {
    XcdBarrier b; b.bar = bar; b.x = xb_xcc_id(); b.st = st;
    if (threadIdx.x == 0) (void)xb_add(&bar[XB_XCNT(b.x)], 1u);
    return b;
}
__device__ __forceinline__ void xcd_barrier_complete(unsigned* bar, unsigned x, unsigned& nloc, unsigned& nx) {
    const unsigned G = gridDim.x * gridDim.y * gridDim.z;
    unsigned sum, cnt, mine, sp = 0u;
    for (;;) {
        sum = 0u; cnt = 0u; mine = 0u;
#pragma unroll
        for (unsigned j = 0; j < 16; ++j) { const unsigned c = xb_ld(&bar[XB_XCNT(j)]); sum += c; cnt += (c > 0u) ? 1u : 0u; mine = (j == x) ? c : mine; }
        if (sum == G) break;
        __builtin_amdgcn_s_sleep(1);
        if ((++sp & 255u) == 0u) { if (xb_ld(&bar[XB_TMO])) break; if (sp > XB_SPIN_CAP) { atomicAdd(&bar[XB_TMO], 1u); break; } }
    }
    nloc = mine > 0u ? mine : 1u; nx = cnt > 0u ? cnt : 1u;
}

__device__ __forceinline__ void xcd_barrier(const XcdBarrier& b) {
    asm volatile("s_waitcnt vmcnt(0)" ::: "memory");
    __syncthreads();
    if (threadIdx.x == 0) {
        unsigned* bar = b.bar;
        __builtin_amdgcn_s_waitcnt(0);
        unsigned nloc = b.st[0], nx = b.st[1];
        if (nloc == 0u) { xcd_barrier_complete(bar, b.x, nloc, nx); b.st[0] = nloc; b.st[1] = nx; }
        const unsigned old = xb_add(&bar[XB_XSUB(b.x)], 1u);
        const unsigned gen = old / nloc;
        if (old + 1u == (gen + 1u) * nloc) {
            __builtin_amdgcn_fence(__ATOMIC_RELEASE, "agent");
            asm volatile("s_waitcnt vmcnt(0)" ::: "memory");
            const unsigned og = xb_add(&bar[XB_TOP], 1u);
            const unsigned tg = og / nx;
            if (og + 1u == (tg + 1u) * nx) xb_add(&bar[XB_TOPGEN], 1u);
            else XB_SPIN(xb_ld(&bar[XB_TOPGEN]) == tg, bar);
            __builtin_amdgcn_fence(__ATOMIC_ACQUIRE, "agent");
            xb_add(&bar[XB_XGEN(b.x)], 1u);
            asm volatile("s_waitcnt vmcnt(0)" ::: "memory");
        } else {
            XB_SPIN(xb_ld(&bar[XB_XGEN(b.x)]) == gen, bar);
            __builtin_amdgcn_fence(__ATOMIC_ACQUIRE, "agent");
            asm volatile("s_waitcnt vmcnt(0)" ::: "memory");
        }
    }
    __syncthreads();
}

typedef unsigned short u16;
typedef float f32x4 __attribute__((ext_vector_type(4)));
typedef unsigned u32x4 __attribute__((ext_vector_type(4)));
typedef unsigned u32x2 __attribute__((ext_vector_type(2)));
typedef short bf16x8 __attribute__((ext_vector_type(8)));
constexpr int DM = 2048, TP = 8192, NBP = 4, NBS = 8, TS = 64, PAST = 2048, SKVS = PAST + TS;
constexpr int MP = NBP * TP, MS_ = NBS * TS, M = MP + MS_;
constexpr int DI = 4096, CD = 6144, NH = 64, DFF = 5504, DFF2 = 11008, NIN = 20560;
constexpr int NMOD = 12288;
constexpr float EPS = 1e-6f, LOG2E = 1.4426950408889634f;
constexpr int HALF_ROWS = 16640;
constexpr size_t O_YP = 0, O_YS = O_YP + (size_t)MP * DM, O_KP = O_YS + (size_t)MS_ * DM, O_VP = O_KP + (size_t)MP * DM,
    O_LFP = O_VP + (size_t)MP * DM, O_SSMP = O_LFP + (size_t)MP * 16, O_MCP = O_SSMP + (size_t)NBP * 64 * 64 * 128, O_FCP = O_MCP + (size_t)NBP * 3 * CD,
    O_KS = O_FCP + (size_t)NBP * 2 * DFF2, O_VS = O_KS + (size_t)MS_ * DM, O_LFS = O_VS + (size_t)MS_ * DM, O_SSMS = O_LFS + (size_t)MS_ * 16,
    O_MCS = O_SSMS + (size_t)NBS * 64 * 64 * 128, O_FCS = O_MCS + (size_t)NBS * 3 * CD, O_END = O_FCS + (size_t)NBS * 2 * DFF2;
constexpr size_t MiB = 1u << 20;
constexpr size_t W_MOD = 0, W_BAR = 768 * 1024  , W_BIASP = 1 * MiB, W_BIASS = 3 * MiB, W_HALO = 5 * MiB,
    W_WUP = 8 * MiB, W_WDN = 51 * MiB, W_H = 73 * MiB, W_WIN = 203 * MiB, W_WPM = 284 * MiB, W_WPF = 300 * MiB, W_WOUT = 308 * MiB,
    W_SMALL = 316 * MiB, W_R = 349 * MiB,
    W_XBC = W_R, W_Z = W_R + 390 * MiB, W_GM = W_R, W_GF = W_R + 130 * MiB, W_Q = W_R + 260 * MiB, W_K = W_Q + 130 * MiB, W_V = W_K + 130 * MiB,
    W_U = 203 * MiB, W_G = 553 * MiB, W_END = 999 * MiB;
static_assert((size_t)M * DM * 2 == 130 * MiB && (size_t)M * CD * 2 == 390 * MiB && (size_t)M * DI * 2 == 260 * MiB, "sizes");
static_assert(W_U + (size_t)HALF_ROWS * DFF2 * 2 <= W_G && W_G + (size_t)M * DFF * 2 <= 1024 * MiB, "ffn map");
static_assert(W_SMALL + (size_t)M * 256 * 4 <= W_R, "small map");

struct Prm { const float* in[31]; float* out; unsigned char* ws; };
typedef const __attribute__((address_space(4))) Prm* KPrm;
struct Ctx { int tid, bid, G; };
enum { I_XP = 0, I_XS, I_CP, I_CS, I_CK, I_CV, I_CLF, I_SSM, I_MCV, I_FCV, I_N1W, I_N2W, I_WADA, I_BADA, I_WIN, I_MCW, I_MCB, I_DTB, I_ALOG, I_MD, I_MNW,
       I_FB, I_QNW, I_KNW, I_WPM, I_WPF, I_WOUT, I_WUP, I_FCW, I_FCB, I_WDN };

__device__ __forceinline__ float bflo(unsigned w) { return __uint_as_float(w << 16); }
__device__ __forceinline__ float bfhi(unsigned w) { return __uint_as_float(w & 0xffff0000u); }
typedef float f32x2_t __attribute__((ext_vector_type(2))); typedef __bf16 bf16x2_t __attribute__((ext_vector_type(2)));
__device__ __forceinline__ unsigned pk2(float lo, float hi) { f32x2_t v = {lo, hi}; bf16x2_t b = __builtin_convertvector(v, bf16x2_t); return __builtin_bit_cast(unsigned, b); }
__device__ __forceinline__ u16 f2bf(float f) { return (u16)(pk2(f, 0.f) & 0xffffu); }
__device__ __forceinline__ void unpack8(u32x4 w, float* v) { v[0] = bflo(w.x); v[1] = bfhi(w.x); v[2] = bflo(w.y); v[3] = bfhi(w.y); v[4] = bflo(w.z); v[5] = bfhi(w.z); v[6] = bflo(w.w); v[7] = bfhi(w.w); }
__device__ __forceinline__ u32x4 pack8f(const float* v) { u32x4 w; w.x = pk2(v[0], v[1]); w.y = pk2(v[2], v[3]); w.z = pk2(v[4], v[5]); w.w = pk2(v[6], v[7]); return w; }
__device__ __forceinline__ float bfel(const u32x4& w, int e) { const unsigned x = w[e >> 1]; return (e & 1) ? bfhi(x) : bflo(x); }
__device__ __forceinline__ float sigmoidf_(float x) { return 1.f / (1.f + __expf(-x)); }
__device__ __forceinline__ float siluf_(float x) { return x / (1.f + __expf(-x)); }
__device__ __forceinline__ float wave_sum(float v) {
#pragma unroll
    for (int o = 1; o < 64; o <<= 1) v += __shfl_xor(v, o);
    return v;
}
__device__ __forceinline__ int mod_row(int row) { return row < MP ? (row >> 13) : 4 + ((row - MP) >> 6); }

struct Epi {
    static constexpr bool PERM = true, AFTER_DRAIN = false;
    int mode;
    u16* d0; u16* d1; u16* d2; int t1, t2, p0, p1, p2, f32seg2;
    const float* xp; const float* xs; float* y; const float* mod; u16* gbuf; const u16* gf;
    __device__ __forceinline__ void operator()(const f32x4 (&acc)[2][2][4][2], const pg8::Unit& u, int wr, int wc, int fr, int fq) const {
        const int rl = u.pm * 256 + wr * 64 + fr, cl = wc * 32 + 8 * fq;
        if (mode == 0) {
            u16* base; int pitch, ct; bool f32o = false;
            if (u.pn < t1) { base = d0; pitch = p0; ct = u.pn; } else if (u.pn < t2) { base = d1; pitch = p1; ct = u.pn - t1; } else { base = d2; pitch = p2; ct = u.pn - t2; f32o = (f32seg2 != 0); }
            if (!f32o) {
#pragma unroll
                for (int ai = 0; ai < 2; ++ai)
#pragma unroll
                    for (int m = 0; m < 4; ++m) { u16* rp = base + (size_t)(rl + ai * 128 + m * 16) * pitch + ct * 256 + cl;
#pragma unroll
                        for (int bj = 0; bj < 2; ++bj) { const f32x4 v0 = acc[ai][bj][m][0], v1 = acc[ai][bj][m][1]; u32x4 w; w.x = pk2(v0[0], v0[1]); w.y = pk2(v0[2], v0[3]); w.z = pk2(v1[0], v1[1]); w.w = pk2(v1[2], v1[3]);
                            *(u32x4*)(rp + bj * 128) = w; } }
            } else {
                float* fb = (float*)base;
#pragma unroll
                for (int ai = 0; ai < 2; ++ai)
#pragma unroll
                    for (int m = 0; m < 4; ++m) { float* rp = fb + (size_t)(rl + ai * 128 + m * 16) * pitch + ct * 256 + cl;
#pragma unroll
                        for (int bj = 0; bj < 2; ++bj) { *(f32x4*)(rp + bj * 128) = acc[ai][bj][m][0]; *(f32x4*)(rp + bj * 128 + 4) = acc[ai][bj][m][1]; } }
            }
        } else if (mode == 1 || mode == 2) {
#pragma unroll
            for (int ai = 0; ai < 2; ++ai) {
                u32x4 gw[4][2], fw[4][2];
#pragma unroll
                for (int m = 0; m < 4; ++m) { const size_t off = (size_t)(rl + ai * 128 + m * 16) * DM + u.pn * 256 + cl;
#pragma unroll
                    for (int bj = 0; bj < 2; ++bj) { gw[m][bj] = *(const u32x4*)(gbuf + off + bj * 128); if (mode == 2) fw[m][bj] = *(const u32x4*)(gf + off + bj * 128); else fw[m][bj] = gw[m][bj]; } }
#pragma unroll
                for (int m = 0; m < 4; ++m) { const size_t off = (size_t)(rl + ai * 128 + m * 16) * DM + u.pn * 256 + cl;
#pragma unroll
                    for (int bj = 0; bj < 2; ++bj) { const f32x4 v0 = acc[ai][bj][m][0], v1 = acc[ai][bj][m][1];
                        float a[8] = {v0[0], v0[1], v0[2], v0[3], v1[0], v1[1], v1[2], v1[3]}, g[8], o[8];
                        unpack8(gw[m][bj], g);
                        if (mode == 1) {
#pragma unroll
                            for (int e = 0; e < 8; ++e) o[e] = sigmoidf_(g[e]) * a[e];
                        } else { float f[8]; unpack8(fw[m][bj], f);
#pragma unroll
                            for (int e = 0; e < 8; ++e) o[e] = g[e] + sigmoidf_(f[e]) * a[e]; }
                        *(u32x4*)(gbuf + off + bj * 128) = pack8f(o); } }
            }
        } else {
#pragma unroll
            for (int ai = 0; ai < 2; ++ai) {
                const int mb = (u.pm < 128) ? (u.pm >> 5) : (4 + (u.pm - 128) * 4 + ai * 2 + wr);
                const float* gp = mod + (size_t)mb * NMOD + (mode == 3 ? 4096 : 10240) + u.pn * 256 + cl;
                f32x4 gv[2][2], pre[4][2][2];
#pragma unroll
                for (int m = 0; m < 4; ++m) { const int row = rl + ai * 128 + m * 16; const size_t off = (size_t)row * DM + u.pn * 256 + cl;
                    const float* xr = (mode == 3) ? ((row < MP) ? xp + off : xs + (off - (size_t)MP * DM)) : (const float*)(y + off);
#pragma unroll
                    for (int bj = 0; bj < 2; ++bj) { pre[m][bj][0] = *(const f32x4*)(xr + bj * 128); pre[m][bj][1] = *(const f32x4*)(xr + bj * 128 + 4); } }
#pragma unroll
                for (int bj = 0; bj < 2; ++bj) { gv[bj][0] = *(const f32x4*)(gp + bj * 128); gv[bj][1] = *(const f32x4*)(gp + bj * 128 + 4); }
#pragma unroll
                for (int m = 0; m < 4; ++m) { const int row = rl + ai * 128 + m * 16; const size_t off = (size_t)row * DM + u.pn * 256 + cl;
#pragma unroll
                    for (int bj = 0; bj < 2; ++bj) { *(f32x4*)(y + off + bj * 128) = pre[m][bj][0] + gv[bj][0] * acc[ai][bj][m][0]; *(f32x4*)(y + off + bj * 128 + 4) = pre[m][bj][1] + gv[bj][1] * acc[ai][bj][m][1]; } }
            }
        }
    }
};

__device__ __forceinline__ int map_in(int n) {
    if (n < 4096) return 6144 + n;
    if (n < 10240) return n - 4096;
    if (n < 10304) return 10240 + (n - 10240);
    if (n < 12352) return 14592 + (n - 10304);
    if (n < 14400) return 16640 + (n - 12352);
    if (n < 16448) return 18688 + (n - 14400);
    if (n < 16464) return 10304 + (n - 16448);
    if (n < 18512) return 10496 + (n - 16464);
    return 12544 + (n - 18512);
}
__device__ __forceinline__ int map_up(int n) { if (n < DFF) return (n >> 7) * 256 + (n & 127); const int f = n - DFF; return (f >> 7) * 256 + 128 + (f & 127); }
template <int MAP> __device__ __forceinline__ void tr_item(const float* __restrict__ W, int K, int N, u16* WT, float* scr, int item, int lane) {
    const int nblk = (N + 31) / 32, kb = item / nblk, nb = item % nblk, k0 = 64 * kb, n0 = 32 * nb;
    const int nn = n0 + (lane & 31);
    float tv[32];
#pragma unroll
    for (int i = 0; i < 32; ++i) { const int kk = 2 * i + (lane >> 5); tv[i] = (nn < N) ? W[(size_t)(k0 + kk) * N + nn] : 0.f; }
#pragma unroll
    for (int i = 0; i < 32; ++i) { const int kk = 2 * i + (lane >> 5); scr[kk * 33 + (lane & 31)] = tv[i]; }
    asm volatile("s_waitcnt lgkmcnt(0)" ::: "memory");
    const int c = lane & 7;
#pragma unroll
    for (int j = 0; j < 4; ++j) { const int n = (lane >> 3) + 8 * j; const float* s = scr + (8 * c) * 33 + n;
        if (n0 + n < N) { const int row = (MAP == 1) ? map_in(n0 + n) : (MAP == 2) ? map_up(n0 + n) : (n0 + n);
            u32x4 o; o.x = pk2(s[0 * 33], s[1 * 33]); o.y = pk2(s[2 * 33], s[3 * 33]); o.z = pk2(s[4 * 33], s[5 * 33]); o.w = pk2(s[6 * 33], s[7 * 33]);
            *(u32x4*)(WT + (size_t)row * K + k0 + 8 * c) = o; } }
    asm volatile("s_waitcnt lgkmcnt(0)" ::: "memory");
}
__device__ __forceinline__ void phase_prep(KPrm p, const Ctx cx, unsigned char* lds) {
    const int tid = cx.tid, lane = tid & 63, wid = tid >> 6, G = cx.G;
    unsigned char* ws = p->ws;
    {
        float* scr = (float*)(lds + wid * 8448);
        const int gw = cx.bid * 8 + wid, NGW = G * 8;
        constexpr int I_IN = 32 * 643, I_PM = 64 * 64, I_PF = 32 * 64, I_OUT = 32 * 64, I_UP = 32 * 344, I_DN = 86 * 64;
        constexpr int NIT = I_IN + I_PM + I_PF + I_OUT + I_UP + I_DN;
        for (int it = gw; it < NIT; it += NGW) {
            int r = it;
            if (r < I_IN) { tr_item<1>(p->in[I_WIN], DM, NIN, (u16*)(ws + W_WIN), scr, r, lane); continue; } r -= I_IN;
            if (r < I_PM) { tr_item<0>(p->in[I_WPM], DI, DM, (u16*)(ws + W_WPM), scr, r, lane); continue; } r -= I_PM;
            if (r < I_PF) { tr_item<0>(p->in[I_WPF], DM, DM, (u16*)(ws + W_WPF), scr, r, lane); continue; } r -= I_PF;
            if (r < I_OUT) { tr_item<0>(p->in[I_WOUT], DM, DM, (u16*)(ws + W_WOUT), scr, r, lane); continue; } r -= I_OUT;
            if (r < I_UP) { tr_item<2>(p->in[I_WUP], DM, DFF2, (u16*)(ws + W_WUP), scr, r, lane); continue; } r -= I_UP;
            tr_item<0>(p->in[I_WDN], DFF, DM, (u16*)(ws + W_WDN), scr, r, lane);
        }
    }
    __syncthreads();
    {
        float* sl = (float*)lds;
        float* red = (float*)(lds + 12 * 2048 * 4);
        for (int e = tid; e < 12 * 2048; e += 512) { const int b = e >> 11, i = e & 2047; const float cv = (b < 4) ? p->in[I_CP][b * 2048 + i] : p->in[I_CS][(b - 4) * 2048 + i]; sl[e] = siluf_(cv); }
        __syncthreads();
        const float* wada = p->in[I_WADA]; float* mod = (float*)(ws + W_MOD);
        const int col = tid & 31, part = tid >> 5;
        for (int item = cx.bid; item < NMOD / 32; item += G) {
            float acc[12];
#pragma unroll
            for (int b = 0; b < 12; ++b) acc[b] = 0.f;
            const float* wp = wada + (size_t)(part * 128) * NMOD + item * 32 + col;
#pragma unroll 8
            for (int d = 0; d < 128; ++d) { const float w = wp[(size_t)d * NMOD];
#pragma unroll
                for (int b = 0; b < 12; ++b) acc[b] += sl[b * 2048 + part * 128 + d] * w; }
#pragma unroll
            for (int b = 0; b < 12; ++b) red[(part * 12 + b) * 32 + col] = acc[b];
            __syncthreads();
            if (tid < 384) { const int b = tid >> 5; float s = p->in[I_BADA][item * 32 + col];
#pragma unroll
                for (int q = 0; q < 16; ++q) s += red[(q * 12 + b) * 32 + col];
                mod[b * NMOD + item * 32 + col] = s; }
            __syncthreads();
        }
    }
    {
        u16* Ks = (u16*)p->out; u16* Vs = Ks + (size_t)NBS * SKVS * DM;
        const size_t tot8 = (size_t)NBS * PAST * DM / 8, gt = (size_t)cx.bid * 512 + tid, GT = (size_t)G * 512;
        for (size_t i0 = gt; i0 < 2 * tot8; i0 += 4 * GT) {
            f32x4 a[4], b[4]; size_t dsto[4]; bool ok[4]; int wh[4];
#pragma unroll
            for (int u = 0; u < 4; ++u) { const size_t i = i0 + (size_t)u * GT; ok[u] = i < 2 * tot8; const size_t ii = ok[u] ? i : 0; wh[u] = ii >= tot8; const size_t j = ii - (wh[u] ? tot8 : 0);
                const size_t sb = j / ((size_t)PAST * 256), rem = j % ((size_t)PAST * 256), row = rem >> 8, c8 = rem & 255;
                const float* src = p->in[wh[u] ? I_CV : I_CK] + ((sb * PAST + row) * DM + c8 * 8);
                a[u] = *(const f32x4*)src; b[u] = *(const f32x4*)(src + 4); dsto[u] = (sb * SKVS + row) * DM + c8 * 8; }
#pragma unroll
            for (int u = 0; u < 4; ++u) if (ok[u]) { u32x4 o; o.x = pk2(a[u][0], a[u][1]); o.y = pk2(a[u][2], a[u][3]); o.z = pk2(b[u][0], b[u][1]); o.w = pk2(b[u][2], b[u][3]);
                *(u32x4*)((wh[u] ? Vs : Ks) + dsto[u]) = o; }
        }
    }
}
__device__ __forceinline__ void phase_norm(KPrm p, const Ctx cx, int which) {
    const int tid = cx.tid, lane = tid & 63, wid = tid >> 6;
    const int gw = cx.bid * 8 + wid, NGW = cx.G * 8;
    const float* mod = (const float*)(p->ws + W_MOD); u16* H = (u16*)(p->ws + W_H);
    const float* nw = p->in[which ? I_N2W : I_N1W];
    const int osh = which ? 6144 : 0, osc = which ? 8192 : 2048;
    for (int row0 = 2 * gw; row0 < M; row0 += 2 * NGW) {
        f32x4 v[2][8];
#pragma unroll
        for (int rr = 0; rr < 2; ++rr) { const int row = row0 + rr;
            const float* xr = which ? (p->out + (size_t)row * DM) : ((row < MP) ? p->in[I_XP] + (size_t)row * DM : p->in[I_XS] + (size_t)(row - MP) * DM);
#pragma unroll
            for (int j = 0; j < 8; ++j) v[rr][j] = ((const f32x4*)xr)[lane + 64 * j]; }
#pragma unroll
        for (int rr = 0; rr < 2; ++rr) { const int row = row0 + rr;
            const float* mr = mod + (size_t)mod_row(row) * NMOD;
            float ss = 0.f;
#pragma unroll
            for (int j = 0; j < 8; ++j) ss += (v[rr][j][0] * v[rr][j][0] + v[rr][j][1] * v[rr][j][1]) + (v[rr][j][2] * v[rr][j][2] + v[rr][j][3] * v[rr][j][3]);
            const float rs = rsqrtf(wave_sum(ss) * (1.f / DM) + EPS);
#pragma unroll
            for (int j = 0; j < 8; ++j) { const int col = 4 * (lane + 64 * j);
                const f32x4 w = *(const f32x4*)(nw + col), sc = *(const f32x4*)(mr + osc + col), sh = *(const f32x4*)(mr + osh + col);
                const f32x4 o = v[rr][j] * rs * w * (sc + 1.f) + sh;
                u32x2 q; q.x = pk2(o[0], o[1]); q.y = pk2(o[2], o[3]);
                *(u32x2*)(H + (size_t)row * DM + col) = q; } }
    }
}
__device__ __forceinline__ void phase_conv(KPrm p, const Ctx cx) {
    const u16* XBC = (const u16*)(p->ws + W_XBC); u16* ACT = (u16*)(p->out + O_KP);
    const float* cw = p->in[I_MCW]; const float* cb = p->in[I_MCB];
    {
                const int gt2 = cx.bid * 512 + cx.tid, GT2 = cx.G * 512;
        for (int i = gt2; i < 12 * 3 * CD; i += GT2) { const int bb = i / (3 * CD), r = (i / CD) % 3, c = i % CD;
            if (bb < 4) p->out[O_MCP + i] = bflo(XBC[(size_t)(bb * TP + TP - 3 + r) * CD + c]);
            else p->out[O_MCS + (i - 4 * 3 * CD)] = bflo(XBC[(size_t)(MP + (bb - 4) * TS + TS - 3 + r) * CD + c]); }
    }
    constexpr int NCG = CD / 8, RB = 16, NRB = M / RB;
    const long gt = (long)cx.bid * 512 + cx.tid, GT = (long)cx.G * 512;
    for (long it = gt; it < (long)NCG * NRB; it += GT) {
        const int cgi = (int)(it % NCG), rb = (int)(it / NCG), c0 = cgi * 8, r0 = rb * RB;
        float w[4][8], bs[8];
#pragma unroll
        for (int j = 0; j < 4; ++j) { const f32x4 a0 = *(const f32x4*)(cw + j * CD + c0), a1 = *(const f32x4*)(cw + j * CD + c0 + 4);
#pragma unroll
            for (int e = 0; e < 4; ++e) { w[j][e] = a0[e]; w[j][4 + e] = a1[e]; } }
        { const f32x4 a0 = *(const f32x4*)(cb + c0), a1 = *(const f32x4*)(cb + c0 + 4);
#pragma unroll
          for (int e = 0; e < 4; ++e) { bs[e] = a0[e]; bs[4 + e] = a1[e]; } }
        float h[3][8];
        const bool smp = r0 >= MP; const int tb = smp ? ((r0 - MP) & 63) : (r0 & (TP - 1));
        if (tb == 0) {
            if (smp) { const float* s = p->in[I_MCV] + (size_t)((r0 - MP) >> 6) * 3 * CD + c0;
#pragma unroll
                for (int k = 0; k < 3; ++k)
#pragma unroll
                    for (int e = 0; e < 8; ++e) h[k][e] = s[k * CD + e];
            } else {
#pragma unroll
                for (int k = 0; k < 3; ++k)
#pragma unroll
                    for (int e = 0; e < 8; ++e) h[k][e] = 0.f; }
        } else {
#pragma unroll
            for (int k = 0; k < 3; ++k) unpack8(*(const u32x4*)(XBC + (size_t)(r0 - 3 + k) * CD + c0), h[k]);
        }
        u32x4 ur[RB];
#pragma unroll
        for (int i = 0; i < RB; ++i) ur[i] = *(const u32x4*)(XBC + (size_t)(r0 + i) * CD + c0);
#pragma unroll
        for (int i = 0; i < RB; ++i) { float u[8], o[8]; unpack8(ur[i], u);
#pragma unroll
            for (int e = 0; e < 8; ++e) { const float v = bs[e] + w[0][e] * h[0][e] + w[1][e] * h[1][e] + w[2][e] * h[2][e] + w[3][e] * u[e];
                o[e] = siluf_(v); h[0][e] = h[1][e]; h[1][e] = h[2][e]; h[2][e] = u[e]; }
            *(u32x4*)(ACT + (size_t)(r0 + i) * CD + c0) = pack8f(o); }
    }
}
constexpr int SXP = 72, SNP = 136, SYP = 68;
constexpr int L_XT = 0, L_CN = L_XT + 64 * SXP * 2, L_BN = L_CN + 64 * SNP * 2, L_BWT = L_BN + 64 * SNP * 2, L_MS = L_BWT + 128 * SXP * 2, L_HS = L_MS + 64 * SXP * 2,
              L_YS = L_HS + 64 * SNP * 2, L_DT = L_YS + 64 * SYP * 4, L_CUM = L_DT + 256, L_SSD_END = L_CUM + 256;
static_assert(L_SSD_END <= 131072, "ssd lds");
__device__ __forceinline__ void phase_ssd(KPrm p, const Ctx cx, unsigned char* lds) {
    const int tid = cx.tid, lane = tid & 63, wid = __builtin_amdgcn_readfirstlane(tid >> 6), quad = lane >> 4, l15 = lane & 15;
    u16* XT = (u16*)(lds + L_XT); u16* CN = (u16*)(lds + L_CN); u16* BN = (u16*)(lds + L_BN); u16* BWT = (u16*)(lds + L_BWT);
    u16* MSm = (u16*)(lds + L_MS); u16* HS = (u16*)(lds + L_HS); float* YS = (float*)(lds + L_YS); float* DT = (float*)(lds + L_DT); float* CUM = (float*)(lds + L_CUM);
    const u16* XBC = (const u16*)(p->out + O_KP);     u16* Z = (u16*)(p->ws + W_Z); const float* SM = (const float*)(p->ws + W_SMALL);
    const int cg8 = tid & 31, tq = tid >> 5, cgx = tid & 7, tx = tid >> 3;
    const int pb = wid >> 1;
    for (int ch = cx.bid; ch < 256 + 512; ch += cx.G) {
        const bool smp = ch >= 256; int b, hd, nc; long rowbase;
        if (!smp) { b = ch >> 6; hd = ch & 63; nc = TP / 64; rowbase = (long)b * TP; } else { const int su = ch - 256; b = su >> 6; hd = su & 63; nc = 1; rowbase = MP + (long)b * TS; }
        const int g = hd >> 3;
        const float a_h = -__expf(p->in[I_ALOG][hd]), dtb = p->in[I_DTB][hd], Dh = p->in[I_MD][hd];
        const int bccol = (cg8 < 16) ? (4096 + g * 128 + cg8 * 8) : (5120 + g * 128 + (cg8 - 16) * 8);
        const int xcol = hd * 64 + cgx * 8;
        f32x4 st[4];
        const int st_off = (pb * 16 + quad * 4) * 128 + (4 * (wid & 1)) * 16 + l15, hs_off = (pb * 16 + quad * 4) * SNP + (4 * (wid & 1)) * 16 + l15;
        { const float* sin_ = p->in[I_SSM] + ((size_t)b * 64 + hd) * 64 * 128 + st_off;
#pragma unroll
          for (int i = 0; i < 4; ++i)
#pragma unroll
            for (int j = 0; j < 4; ++j) st[i][j] = smp ? sin_[j * 128 + i * 16] : 0.f; }
        __syncthreads();
        { u16* hp_ = HS + hs_off;
#pragma unroll
          for (int i = 0; i < 4; ++i)
#pragma unroll
            for (int j = 0; j < 4; ++j) hp_[j * SNP + i * 16] = f2bf(st[i][j]); }
        u32x4 rbcA[4], rxA, znA, rbcB[4], rxB, znB, pend = {0u, 0u, 0u, 0u}; float dtrA = 0.f, dtrB = 0.f;
#define SSD_LOADS(cc, rbc, rx, zn, dtr) do { const int t0_ = (cc) * 64; \
            const u16* pb_ = XBC + (rowbase + t0_ + 4 * tq) * (long)CD + bccol; const u16* px_ = XBC + (rowbase + t0_ + tx) * (long)CD + xcol; \
            asm volatile("" : "+v"(pb_), "+v"(px_));     \
            _Pragma("unroll") for (int i = 0; i < 4; ++i) rbc[i] = *(const u32x4*)(pb_ + i * CD); \
            rx = *(const u32x4*)px_; \
            zn = *(const u32x4*)(Z + (size_t)(rowbase + t0_ + tx) * DI + xcol); \
            dtr = SM[(size_t)(rowbase + t0_ + lane) * 256 + hd]; } while (0)
#define LBAR() do { asm volatile("s_waitcnt lgkmcnt(0)" ::: "memory"); __builtin_amdgcn_s_barrier(); asm volatile("" ::: "memory"); } while (0)
        SSD_LOADS(0, rbcA, rxA, znA, dtrA); if (nc > 1) SSD_LOADS(1, rbcB, rxB, znB, dtrB);
        auto body = [&](const int c, u32x4 (&rbc)[4], u32x4& rx, u32x4& zn, float& dtr) __attribute__((always_inline)) {
            const long r0 = rowbase + (long)c * 64;
            const u32x4 zw = zn;
            float cum_end;
            { const float dr = dtr + dtb; const float dtv = dr > 20.f ? dr : __logf(1.f + __expf(dr));
              float x = dtv * a_h;
#define DPP_ADD(ctrl, rmask) x += __int_as_float(__builtin_amdgcn_update_dpp(0, __float_as_int(x), ctrl, rmask, 0xf, true))
              DPP_ADD(0x111, 0xf); DPP_ADD(0x112, 0xf); DPP_ADD(0x114, 0xf); DPP_ADD(0x118, 0xf);
              DPP_ADD(0x142, 0xa);
              DPP_ADD(0x143, 0xc);
#undef DPP_ADD
              DT[lane] = dtv; CUM[lane] = x; cum_end = __int_as_float(__builtin_amdgcn_readlane(__float_as_int(x), 63)); }
            {
                u16* NAT = (cg8 < 16) ? BN : CN; const int nc0 = (cg8 & 15) * 8;
#pragma unroll
                for (int ii = 0; ii < 4; ++ii) *(u32x4*)(NAT + (4 * tq + ii) * SNP + nc0) = rbc[ii];
                if (cg8 < 16) {
                    float wg[4]; const f32x4 dt4 = *(const f32x4*)(DT + 4 * tq), cu4 = *(const f32x4*)(CUM + 4 * tq);
#pragma unroll
                    for (int ii = 0; ii < 4; ++ii) wg[ii] = dt4[ii] * __expf(cum_end - cu4[ii]);
#pragma unroll
                    for (int e = 0; e < 8; ++e) { u32x2 q; q.x = pk2(bfel(rbc[0], e) * wg[0], bfel(rbc[1], e) * wg[1]); q.y = pk2(bfel(rbc[2], e) * wg[2], bfel(rbc[3], e) * wg[3]);
                        *(u32x2*)(BWT + (nc0 + e) * SXP + 4 * tq) = q; }
                }
            }
            float xv[8]; unpack8(rx, xv);
#pragma unroll
            for (int e = 0; e < 8; ++e) XT[(cgx * 8 + e) * SXP + tx] = (u16)((e & 1) ? (rx[e >> 1] >> 16) : (rx[e >> 1] & 0xffffu));
            LBAR();
            if (c > 0) *(u32x4*)(Z + (size_t)(r0 - 64 + tx) * DI + xcol) = pend;
            if (c + 2 < nc) SSD_LOADS(c + 2, rbc, rx, zn, dtr);
            const int ti = wid >> 1;
            f32x4 yo[2];
            {
                bf16x8 ca[4], bb[2][4], hb[2][4];
#pragma unroll
                for (int kk = 0; kk < 4; ++kk) ca[kk] = *(const bf16x8*)(CN + (ti * 16 + l15) * SNP + kk * 32 + quad * 8);
#pragma unroll
                for (int s2 = 0; s2 < 2; ++s2)
#pragma unroll
                    for (int kk = 0; kk < 4; ++kk) { bb[s2][kk] = *(const bf16x8*)(BN + ((2 * (wid & 1) + s2) * 16 + l15) * SNP + kk * 32 + quad * 8);
                        hb[s2][kk] = *(const bf16x8*)(HS + ((2 * (wid & 1) + s2) * 16 + l15) * SNP + kk * 32 + quad * 8); }
                const f32x4 ct4 = *(const f32x4*)(CUM + ti * 16 + quad * 4);
                float cs[2], ds[2];
#pragma unroll
                for (int s2 = 0; s2 < 2; ++s2) { const int sx = (2 * (wid & 1) + s2) * 16 + l15; cs[s2] = CUM[sx]; ds[s2] = DT[sx]; }
                f32x4 ga[2] = {{0.f, 0.f, 0.f, 0.f}, {0.f, 0.f, 0.f, 0.f}}; yo[0] = (f32x4){0.f, 0.f, 0.f, 0.f}; yo[1] = (f32x4){0.f, 0.f, 0.f, 0.f};
#pragma unroll
                for (int kk = 0; kk < 4; ++kk) {
                    ga[0] = __builtin_amdgcn_mfma_f32_16x16x32_bf16(ca[kk], bb[0][kk], ga[0], 0, 0, 0); ga[1] = __builtin_amdgcn_mfma_f32_16x16x32_bf16(ca[kk], bb[1][kk], ga[1], 0, 0, 0);
                    yo[0] = __builtin_amdgcn_mfma_f32_16x16x32_bf16(ca[kk], hb[0][kk], yo[0], 0, 0, 0); yo[1] = __builtin_amdgcn_mfma_f32_16x16x32_bf16(ca[kk], hb[1][kk], yo[1], 0, 0, 0); }
#pragma unroll
                for (int s2 = 0; s2 < 2; ++s2) { const int s_ = (2 * (wid & 1) + s2) * 16 + l15;
#pragma unroll
                    for (int j = 0; j < 4; ++j) { const int t = ti * 16 + quad * 4 + j; const float msk = (s_ <= t) ? ds[s2] : 0.f;
                        const float val = ga[s2][j] * __expf(fminf(ct4[j] - cs[s2], 0.f)) * msk; MSm[t * SXP + s_] = f2bf(val); } }
#pragma unroll
                for (int p2 = 0; p2 < 2; ++p2)
#pragma unroll
                    for (int j = 0; j < 4; ++j) yo[p2][j] *= __expf(ct4[j]);
            }
            LBAR();
            {
                bf16x8 ma[2], xa[2], xb[2][2], wb[4][2];
#pragma unroll
                for (int kk = 0; kk < 2; ++kk) { ma[kk] = *(const bf16x8*)(MSm + (ti * 16 + l15) * SXP + kk * 32 + quad * 8); xa[kk] = *(const bf16x8*)(XT + (pb * 16 + l15) * SXP + kk * 32 + quad * 8);
#pragma unroll
                    for (int p2 = 0; p2 < 2; ++p2) xb[p2][kk] = *(const bf16x8*)(XT + ((2 * (wid & 1) + p2) * 16 + l15) * SXP + kk * 32 + quad * 8);
#pragma unroll
                    for (int i = 0; i < 4; ++i) wb[i][kk] = *(const bf16x8*)(BWT + ((4 * (wid & 1) + i) * 16 + l15) * SXP + kk * 32 + quad * 8); }
                const float dec = __expf(cum_end);
#pragma unroll
                for (int i = 0; i < 4; ++i) st[i] = st[i] * dec;
#pragma unroll
                for (int kk = 0; kk < 2; ++kk) {
                    yo[0] = __builtin_amdgcn_mfma_f32_16x16x32_bf16(ma[kk], xb[0][kk], yo[0], 0, 0, 0); yo[1] = __builtin_amdgcn_mfma_f32_16x16x32_bf16(ma[kk], xb[1][kk], yo[1], 0, 0, 0);
#pragma unroll
                    for (int i = 0; i < 4; ++i) st[i] = __builtin_amdgcn_mfma_f32_16x16x32_bf16(xa[kk], wb[i][kk], st[i], 0, 0, 0); }
#pragma unroll
                for (int p2 = 0; p2 < 2; ++p2)
#pragma unroll
                    for (int j = 0; j < 4; ++j) YS[(ti * 16 + quad * 4 + j) * SYP + (2 * (wid & 1) + p2) * 16 + l15] = yo[p2][j];
                u16* hp_ = HS + hs_off;
#pragma unroll
                for (int i = 0; i < 4; ++i)
#pragma unroll
                    for (int j = 0; j < 4; ++j) hp_[j * SNP + i * 16] = f2bf(st[i][j]);
            }
            LBAR();
            {
                const f32x4 y0 = *(const f32x4*)(YS + tx * SYP + cgx * 8), y1 = *(const f32x4*)(YS + tx * SYP + cgx * 8 + 4);
                float zf[8], o[8]; unpack8(zw, zf);
#pragma unroll
                for (int e = 0; e < 8; ++e) { const float yv = (e < 4 ? y0[e & 3] : y1[e & 3]) + Dh * xv[e]; o[e] = yv * siluf_(zf[e]); }
                pend = pack8f(o);
            }
        };
        for (int c = 0; c < nc; c += 2) { body(c, rbcA, rxA, znA, dtrA); if (c + 1 < nc) body(c + 1, rbcB, rxB, znB, dtrB); }
        *(u32x4*)(Z + (size_t)(rowbase + (long)(nc - 1) * 64 + tx) * DI + xcol) = pend;
#undef SSD_LOADS
#undef LBAR
        float* so = p->out + (smp ? O_SSMS : O_SSMP) + ((size_t)b * 64 + hd) * 64 * 128 + st_off;
#pragma unroll
        for (int i = 0; i < 4; ++i)
#pragma unroll
            for (int j = 0; j < 4; ++j) so[j * 128 + i * 16] = st[i][j];
        __syncthreads();
    }
}
__device__ __forceinline__ float logsig_(float f) { return fminf(f, 0.f) - log1pf(__expf(-fabsf(f))); }
__device__ __forceinline__ void phase_gn(KPrm p, const Ctx cx) {
    const int tid = cx.tid, lane = tid & 63, wid = tid >> 6;
    const int gw = cx.bid * 8 + wid, NGW = cx.G * 8;
    const float* SM = (const float*)(p->ws + W_SMALL);
    if (gw < 192) {
        if (gw < 64) { const int b = gw >> 4, h = gw & 15; const float fb = p->in[I_FB][h];
            float* bias = (float*)(p->ws + W_BIASP) + (size_t)(b * 16 + h) * TP; float* lo = p->out + O_LFP;
            const int tb = lane * 128; float s = 0.f;
            for (int i = 0; i < 128; ++i) s += logsig_(SM[(size_t)(b * TP + tb + i) * 256 + 64 + h] + fb);
            float inc = s;
#pragma unroll
            for (int o = 1; o < 64; o <<= 1) { const float y = __shfl_up(inc, o); if (lane >= o) inc += y; }
            float run = inc - s;
            for (int i = 0; i < 128; ++i) { const float lf = logsig_(SM[(size_t)(b * TP + tb + i) * 256 + 64 + h] + fb); run += lf;
                lo[(size_t)(b * TP + tb + i) * 16 + h] = lf; bias[tb + i] = -run * LOG2E; }
        } else { const int u = gw - 64, sb = u >> 4, h = u & 15; const float fb = p->in[I_FB][h];
            float* bias = (float*)(p->ws + W_BIASS) + (size_t)(sb * 16 + h) * SKVS; float* lo = p->out + O_LFS;
            const int tb = lane * 33; float s = 0.f;
            for (int i = 0; i < 33; ++i) { const int pos = tb + i;
                s += (pos < PAST) ? p->in[I_CLF][(size_t)(sb * PAST + pos) * 16 + h] : logsig_(SM[(size_t)(MP + sb * TS + pos - PAST) * 256 + 64 + h] + fb); }
            float inc = s;
#pragma unroll
            for (int o = 1; o < 64; o <<= 1) { const float y = __shfl_up(inc, o); if (lane >= o) inc += y; }
            float run = inc - s;
            for (int i = 0; i < 33; ++i) { const int pos = tb + i; float lf;
                if (pos < PAST) lf = p->in[I_CLF][(size_t)(sb * PAST + pos) * 16 + h];
                else { lf = logsig_(SM[(size_t)(MP + sb * TS + pos - PAST) * 256 + 64 + h] + fb); lo[(size_t)(sb * TS + pos - PAST) * 16 + h] = lf; }
                run += lf; bias[pos] = -run * LOG2E; }
        }
    }
    u16* Z = (u16*)(p->ws + W_Z); const float* mnw = p->in[I_MNW];
    for (int row = gw; row < M; row += NGW) {
        u32x4 zr[8];
#pragma unroll
        for (int i = 0; i < 8; ++i) zr[i] = *(const u32x4*)(Z + (size_t)row * DI + i * 512 + lane * 8);
#pragma unroll
        for (int i = 0; i < 8; ++i) { const int col = i * 512 + lane * 8; u16* zp = Z + (size_t)row * DI + col;
            float v[8]; unpack8(zr[i], v); float ss = 0.f;
#pragma unroll
            for (int e = 0; e < 8; ++e) ss += v[e] * v[e];
            const float rs = rsqrtf(wave_sum(ss) * (1.f / 512.f) + EPS);
            const f32x4 w0 = *(const f32x4*)(mnw + col), w1 = *(const f32x4*)(mnw + col + 4);
#pragma unroll
            for (int e = 0; e < 8; ++e) v[e] = v[e] * rs * (e < 4 ? w0[e & 3] : w1[e & 3]);
            *(u32x4*)zp = pack8f(v); }
    }
}
__device__ __forceinline__ void phase_qk(KPrm p, const Ctx cx) {
    const int tid = cx.tid, lane = tid & 63, wid = tid >> 6;
    const int gw = cx.bid * 8 + wid, NGW = cx.G * 8;
    u16* K = (u16*)(p->ws + W_K); const u16* V = (const u16*)(p->ws + W_V);
    u16* Ks = (u16*)p->out; u16* Vs = Ks + (size_t)NBS * SKVS * DM;
    const int hc = (lane & 15) * 8;
    const f32x4 kw0 = *(const f32x4*)(p->in[I_KNW] + hc), kw1 = *(const f32x4*)(p->in[I_KNW] + hc + 4);
    for (int row = gw; row < M; row += NGW) {
        const bool smp = row >= MP;
        float* ko = smp ? p->out + O_KS + (size_t)(row - MP) * DM : p->out + O_KP + (size_t)row * DM;
        float* vo = smp ? p->out + O_VS + (size_t)(row - MP) * DM : p->out + O_VP + (size_t)row * DM;
        size_t srow = 0; if (smp) { const int sb = (row - MP) >> 6, t = (row - MP) & 63; srow = (size_t)(sb * SKVS + PAST + t) * DM; }
        u32x4 kr_[4], vr_[4];
#pragma unroll
        for (int it = 0; it < 4; ++it) { const size_t off = (size_t)row * DM + it * 512 + lane * 8; kr_[it] = *(const u32x4*)(K + off); vr_[it] = *(const u32x4*)(V + off); }
#pragma unroll
        for (int it = 0; it < 4; ++it) { const int col = it * 512 + lane * 8; const size_t off = (size_t)row * DM + col;
            float v[8], ss;
            unpack8(kr_[it], v); ss = 0.f;
#pragma unroll
            for (int e = 0; e < 8; ++e) ss += v[e] * v[e];
            ss += __shfl_xor(ss, 1); ss += __shfl_xor(ss, 2); ss += __shfl_xor(ss, 4); ss += __shfl_xor(ss, 8);
            const float rs = rsqrtf(ss * (1.f / 128.f) + EPS);
#pragma unroll
            for (int e = 0; e < 8; ++e) v[e] = v[e] * rs * (e < 4 ? kw0[e & 3] : kw1[e & 3]);
            const u32x4 kp = pack8f(v);
            *(u32x4*)(K + off) = kp;
            *(f32x4*)(ko + col) = (f32x4){v[0], v[1], v[2], v[3]}; *(f32x4*)(ko + col + 4) = (f32x4){v[4], v[5], v[6], v[7]};
            const u32x4 vw = vr_[it]; unpack8(vw, v);
            *(f32x4*)(vo + col) = (f32x4){v[0], v[1], v[2], v[3]}; *(f32x4*)(vo + col + 4) = (f32x4){v[4], v[5], v[6], v[7]};
            if (smp) { *(u32x4*)(Ks + srow + col) = kp; *(u32x4*)(Vs + srow + col) = vw; } }
    }
}
typedef att::BlockRef<att::bf16, att::bf16> ARef;
__device__ __forceinline__ ARef att_ref(KPrm p, const Ctx cx, int i, int nbp, int& skv) {
    const int G = cx.G, bid = (cx.G % 8 == 0) ? (cx.bid % 8) * (cx.G / 8) + cx.bid / 8 : cx.bid; ARef r;
    att::bf16* Qb = (att::bf16*)(p->ws + W_Q); const att::bf16* Kb = (const att::bf16*)(p->ws + W_K); const att::bf16* Vb = (const att::bf16*)(p->ws + W_V);
    if (i < nbp) { const int L = bid + (i >> 1) * G, bh = L >> 4, x = L & 15, qb = (i & 1) ? 31 - x : x, b = bh >> 4, h = bh & 15;
        const size_t rq = ((size_t)b * TP + (size_t)qb * 256) * DM + h * 128, rk = (size_t)b * TP * DM + h * 128;
        r.Q = Qb + rq; r.O = Qb + rq; r.K = Kb + rk; r.V = Vb + rk; r.Bs = (const float*)(p->ws + W_BIASP) + (size_t)bh * TP; r.P0 = qb * 256; r.nvalid = 256; skv = TP;
    } else { const int su = bid + (i - nbp) * G, sb = su >> 4, h = su & 15;
        const att::bf16* Ks = (const att::bf16*)p->out; const att::bf16* Vs = Ks + (size_t)NBS * SKVS * DM;
        const size_t rq = ((size_t)MP + (size_t)sb * TS) * DM + h * 128, rk = (size_t)sb * SKVS * DM + h * 128;
        r.Q = Qb + rq; r.O = Qb + rq; r.K = Ks + rk; r.V = Vs + rk; r.Bs = (const float*)(p->ws + W_BIASS) + (size_t)su * SKVS; r.P0 = PAST; r.nvalid = TS; skv = SKVS; }
    return r;
}
__device__ __forceinline__ void phase_att(KPrm p, const Ctx cx, char* lds) {
    const int G = cx.G, bid = (cx.G % 8 == 0) ? (cx.bid % 8) * (cx.G / 8) + cx.bid / 8 : cx.bid;
    const int nip = (bid < 1024) ? (1024 - bid + G - 1) / G : 0, nbp = 2 * nip, nbs = (bid < 128) ? (128 - bid + G - 1) / G : 0, nb = nbp + nbs;
    if (nb == 0) return;
    const int W = 1 << 30;
    int skv, skvn; ARef cur = att_ref(p, cx, 0, nbp, skv);
    att::Seam<att::bf16> S;
    att::causal_swa_prime<att::bf16, att::bf16>(cur, W, lds, S, cx.tid);
    for (int i = 0; i < nb; ++i) {
        const bool last = (i + 1 == nb);
        ARef nxt = cur; skvn = skv; if (!last) nxt = att_ref(p, cx, i + 1, nbp, skvn);
        att::causal_swa_block<att::bf16, att::bf16>(cur, nxt, skv, W, lds, S, cx.tid, p->in[I_QNW], 0.08838834764831845f * LOG2E);
        cur = nxt; skv = skvn;
    }
}
__device__ __forceinline__ void phase_cv(KPrm p, const Ctx cx, int half) {
    const int tid = cx.tid;
    const u16* U = (const u16*)(p->ws + W_U); u16* Gb = (u16*)(p->ws + W_G); u16* HALO = (u16*)(p->ws + W_HALO);
    const float* cw = p->in[I_FCW]; const float* cb = p->in[I_FCB];
    const int row_lo = half ? HALF_ROWS : 0;
    constexpr int NCG = DFF / 8, RB = 16, NRB = HALF_ROWS / RB;
    const long gt = (long)cx.bid * 512 + tid, GT = (long)cx.G * 512;
    for (long it = gt; it < (long)NCG * NRB; it += GT) {
        const int cgi = (int)(it % NCG), rb = (int)(it / NCG); const int f0 = cgi * 8, r0 = row_lo + rb * RB;
        const int ca = (f0 >> 7) * 256 + (f0 & 127), cbb = ca + 128;
        float wa[3][8], wb[3][8], ba[8], bb[8];
#pragma unroll
        for (int k = 0; k < 3; ++k) { const f32x4 a0 = *(const f32x4*)(cw + k * DFF2 + f0), a1 = *(const f32x4*)(cw + k * DFF2 + f0 + 4), b0 = *(const f32x4*)(cw + k * DFF2 + DFF + f0), b1 = *(const f32x4*)(cw + k * DFF2 + DFF + f0 + 4);
#pragma unroll
            for (int e = 0; e < 4; ++e) { wa[k][e] = a0[e]; wa[k][4 + e] = a1[e]; wb[k][e] = b0[e]; wb[k][4 + e] = b1[e]; } }
        { const f32x4 a0 = *(const f32x4*)(cb + f0), a1 = *(const f32x4*)(cb + f0 + 4), b0 = *(const f32x4*)(cb + DFF + f0), b1 = *(const f32x4*)(cb + DFF + f0 + 4);
#pragma unroll
          for (int e = 0; e < 4; ++e) { ba[e] = a0[e]; ba[4 + e] = a1[e]; bb[e] = b0[e]; bb[4 + e] = b1[e]; } }
        float ha[2][8], hb[2][8];
        const bool smp = r0 >= MP; const int tb = smp ? ((r0 - MP) & 63) : (r0 & (TP - 1));
        if (tb == 0) {
            if (smp) { const float* s = p->in[I_FCV] + (size_t)((r0 - MP) >> 6) * 2 * DFF2;
#pragma unroll
                for (int k = 0; k < 2; ++k)
#pragma unroll
                    for (int e = 0; e < 8; ++e) { ha[k][e] = s[k * DFF2 + f0 + e]; hb[k][e] = s[k * DFF2 + DFF + f0 + e]; }
            } else {
#pragma unroll
                for (int k = 0; k < 2; ++k)
#pragma unroll
                    for (int e = 0; e < 8; ++e) { ha[k][e] = 0.f; hb[k][e] = 0.f; } }
        } else if (half && rb == 0) {
#pragma unroll
            for (int k = 0; k < 2; ++k) { unpack8(*(const u32x4*)(HALO + (size_t)k * DFF2 + ca), ha[k]); unpack8(*(const u32x4*)(HALO + (size_t)k * DFF2 + cbb), hb[k]); }
        } else {
#pragma unroll
            for (int k = 0; k < 2; ++k) { const size_t ro = (size_t)(r0 - row_lo - 2 + k) * DFF2; unpack8(*(const u32x4*)(U + ro + ca), ha[k]); unpack8(*(const u32x4*)(U + ro + cbb), hb[k]); }
        }
#pragma unroll 8
        for (int i = 0; i < RB; ++i) { const int r = r0 + i; const size_t ro = (size_t)(r - row_lo) * DFF2;
            const u32x4 uaw = *(const u32x4*)(U + ro + ca), ubw = *(const u32x4*)(U + ro + cbb);
            float ua[8], ub[8], o[8]; unpack8(uaw, ua); unpack8(ubw, ub);
#pragma unroll
            for (int e = 0; e < 8; ++e) { const float va = ba[e] + wa[0][e] * ha[0][e] + wa[1][e] * ha[1][e] + wa[2][e] * ua[e], vb = bb[e] + wb[0][e] * hb[0][e] + wb[1][e] * hb[1][e] + wb[2][e] * ub[e];
                o[e] = siluf_(va) * vb; ha[0][e] = ha[1][e]; ha[1][e] = ua[e]; hb[0][e] = hb[1][e]; hb[1][e] = ub[e]; }
            *(u32x4*)(Gb + (size_t)r * DFF + f0) = pack8f(o);
            const int tpos = (r >= MP) ? ((r - MP) & 63) : (r & (TP - 1)), tlen = (r >= MP) ? TS : TP;
            if (tpos >= tlen - 2) { float* fo = (r >= MP) ? p->out + O_FCS + ((size_t)((r - MP) >> 6) * 2 + (tpos - (tlen - 2))) * DFF2 : p->out + O_FCP + ((size_t)(r >> 13) * 2 + (tpos - (tlen - 2))) * DFF2;
#pragma unroll
                for (int e = 0; e < 8; ++e) { fo[f0 + e] = ua[e]; fo[DFF + f0 + e] = ub[e]; } }
            if (!half && r >= HALF_ROWS - 2) { *(u32x4*)(HALO + (size_t)(r - (HALF_ROWS - 2)) * DFF2 + ca) = uaw; *(u32x4*)(HALO + (size_t)(r - (HALF_ROWS - 2)) * DFF2 + cbb) = ubw; }
        }
    }
}
constexpr int LDS_TOTAL = 147456;
enum { PH_CONV = 100 };
enum { PH_PREP = 0, PH_N1, PH_G1A, PH_SSD, PH_GN, PH_G1B, PH_G2, PH_G1C, PH_QK, PH_ATT, PH_G3, PH_G4, PH_N2, PH_G5A, PH_CVA, PH_G5B, PH_CVB, PH_G6, PH_COUNT };
__device__ __forceinline__ void gsync(unsigned char* lds) {
    KPrm p0 = (KPrm)__builtin_amdgcn_kernarg_segment_ptr(); asm volatile("" : "+s"(p0));
    XcdBarrier xb; xb.bar = (unsigned*)(p0->ws + W_BAR); xb.x = xb_xcc_id(); xb.st = (volatile LAS unsigned*)(lds + LDS_TOTAL - 64);
    xcd_barrier(xb);
}
__device__ __forceinline__ void run_gemms(KPrm p, const Ctx cx, unsigned char* lds, const int first, const int last) {
#pragma unroll 1
    for (int ph = first; ph <= last; ++ph) {
        unsigned char* ws = p->ws;
        pg8::Gemm g; Epi E;
        g.A = (const u16*)(ws + W_H); g.Bt = nullptr; g.M = M; g.N = DM; g.K = DM;
        E.mode = 0; E.d0 = E.d1 = E.d2 = nullptr; E.t1 = E.t2 = 1 << 20; E.p0 = E.p1 = E.p2 = 0; E.f32seg2 = 0;
        E.xp = p->in[I_XP]; E.xs = p->in[I_XS]; E.y = p->out; E.mod = (const float*)(ws + W_MOD); E.gbuf = (u16*)(ws + W_GM); E.gf = (const u16*)(ws + W_GF);
        switch (ph) {
        case PH_G1A: g.Bt = (const u16*)(ws + W_WIN); g.N = 41 * 256;
            E.d0 = (u16*)(ws + W_XBC); E.p0 = CD; E.t1 = 24; E.d1 = (u16*)(ws + W_Z); E.p1 = DI; E.t2 = 40; E.d2 = (u16*)(ws + W_SMALL); E.p2 = 256; E.f32seg2 = 1; break;
        case PH_G1B: g.Bt = (const u16*)(ws + W_WIN) + (size_t)10496 * DM; g.N = 16 * 256;
            E.d0 = (u16*)(ws + W_GM); E.p0 = DM; E.t1 = 8; E.d1 = (u16*)(ws + W_GF); E.p1 = DM; break;
        case PH_G2: g.A = (const u16*)(ws + W_Z); g.Bt = (const u16*)(ws + W_WPM); g.K = DI; E.mode = 1; break;
        case PH_G1C: g.Bt = (const u16*)(ws + W_WIN) + (size_t)14592 * DM; g.N = 24 * 256;
            E.d0 = (u16*)(ws + W_Q); E.p0 = DM; E.t1 = 8; E.d1 = (u16*)(ws + W_K); E.p1 = DM; E.t2 = 16; E.d2 = (u16*)(ws + W_V); E.p2 = DM; break;
        case PH_G3: g.A = (const u16*)(ws + W_Q); g.Bt = (const u16*)(ws + W_WPF); E.mode = 2; break;
        case PH_G4: g.A = (const u16*)(ws + W_GM); g.Bt = (const u16*)(ws + W_WOUT); E.mode = 3; break;
        case PH_G5A: g.Bt = (const u16*)(ws + W_WUP); g.M = HALF_ROWS; g.N = DFF2; E.d0 = (u16*)(ws + W_U); E.p0 = DFF2; break;
        case PH_G5B: g.A = (const u16*)(ws + W_H) + (size_t)HALF_ROWS * DM; g.Bt = (const u16*)(ws + W_WUP); g.M = HALF_ROWS; g.N = DFF2; E.d0 = (u16*)(ws + W_U); E.p0 = DFF2; break;
        default:   g.A = (const u16*)(ws + W_G); g.Bt = (const u16*)(ws + W_WDN); g.K = DFF; E.mode = 5; break;
        }
        pg8::StaticOrder S; S.init(g.M, g.N, cx.G, cx.bid);
        pg8::gemm_phase<Epi, pg8::StaticOrder, true, true>((PG8_LAS unsigned char*)lds, g, S, E, cx.tid);
        if (ph < last) gsync(lds);
    }
}
#define PH_BEGIN() Ctx cx; { int t_ = threadIdx.x; asm volatile("" : "+v"(t_)); int b_ = blockIdx.x, g_ = gridDim.x; asm volatile("" : "+s"(b_), "+s"(g_)); cx.tid = t_; cx.bid = b_; cx.G = g_; } \
    KPrm p = (KPrm)__builtin_amdgcn_kernarg_segment_ptr(); asm volatile("" : "+s"(p))
#ifdef ONLY_PH
#define PH_ON(k) ((k) == ONLY_PH)
#else
#define PH_ON(k) true
#endif
__global__ void __launch_bounds__(512, 2) mega_fwd(Prm prm_unused) {
    extern __shared__ __attribute__((aligned(16))) unsigned char lds[];
    cg::grid_group grid = cg::this_grid();
    volatile LAS unsigned* bst = (volatile LAS unsigned*)(lds + LDS_TOTAL - 64);
    if (threadIdx.x < 2) bst[threadIdx.x] = 0u;
    __syncthreads();
    { KPrm p0 = (KPrm)__builtin_amdgcn_kernarg_segment_ptr(); (void)xcd_barrier_post((unsigned*)(p0->ws + W_BAR), bst); }
#define GSYNC() gsync(lds)
#ifndef EXP
#define EXP 0
#endif
    if (PH_ON(PH_PREP)) { PH_BEGIN(); phase_prep(p, cx, lds); } grid.sync();
#if EXP == 3
    { PH_BEGIN(); phase_prep(p, cx, lds); } GSYNC();
#endif
    if (PH_ON(PH_N1)) { PH_BEGIN(); phase_norm(p, cx, 0); } GSYNC();
    if (PH_ON(PH_G1A)) { PH_BEGIN(); run_gemms(p, cx, lds, PH_G1A, PH_G1A); } GSYNC();
#if EXP == 1
    { PH_BEGIN(); run_gemms(p, cx, lds, PH_G1A, PH_G1A); } GSYNC();
#endif
    if (PH_ON(PH_CONV)) { PH_BEGIN(); phase_conv(p, cx); } GSYNC();
    if (PH_ON(PH_SSD)) { PH_BEGIN(); phase_ssd(p, cx, lds); } GSYNC();
#if EXP == 2
    { PH_BEGIN(); run_gemms(p, cx, lds, PH_G1A, PH_G1A); } GSYNC();
    { PH_BEGIN(); phase_conv(p, cx); } GSYNC();
    { PH_BEGIN(); phase_ssd(p, cx, lds); } GSYNC();
#endif
    if (PH_ON(PH_GN)) { PH_BEGIN(); phase_gn(p, cx); }
    if (PH_ON(PH_G1B)) { PH_BEGIN(); run_gemms(p, cx, lds, PH_G1B, PH_G1C); } GSYNC();
    if (PH_ON(PH_QK)) { PH_BEGIN(); phase_qk(p, cx); } GSYNC();
    if (PH_ON(PH_ATT)) { PH_BEGIN(); phase_att(p, cx, (char*)lds); } GSYNC();
#if EXP == 4
    { PH_BEGIN(); run_gemms(p, cx, lds, PH_G1C, PH_G1C); } GSYNC();
    { PH_BEGIN(); phase_qk(p, cx); } GSYNC();
    { PH_BEGIN(); phase_att(p, cx, (char*)lds); } GSYNC();
#endif
    if (PH_ON(PH_G3)) { PH_BEGIN(); run_gemms(p, cx, lds, PH_G3, PH_G4); } GSYNC();
    if (PH_ON(PH_N2)) { PH_BEGIN(); phase_norm(p, cx, 1); } GSYNC();
    if (PH_ON(PH_G5A)) { PH_BEGIN(); run_gemms(p, cx, lds, PH_G5A, PH_G5A); } GSYNC();
    if (PH_ON(PH_CVA)) { PH_BEGIN(); phase_cv(p, cx, 0); } GSYNC();
    if (PH_ON(PH_G5B)) { PH_BEGIN(); run_gemms(p, cx, lds, PH_G5B, PH_G5B); } GSYNC();
    if (PH_ON(PH_CVB)) { PH_BEGIN(); phase_cv(p, cx, 1); } GSYNC();
    if (PH_ON(PH_G6)) { PH_BEGIN(); run_gemms(p, cx, lds, PH_G6, PH_G6); }
#if EXP == 5
#pragma unroll 1
    for (int r = 0; r < 32; ++r) GSYNC();
#endif
}

extern "C" void kernel_launch(void* const* d_in, const int* in_sizes, int n_in, void* d_out, int out_size, void* d_ws, size_t ws_size, hipStream_t stream) {
    static int grid = 0;
    if (grid == 0) {
        if (n_in != 31 || (size_t)out_size != O_END || ws_size < 1024 * MiB) { fprintf(stderr, "kernel_launch: unexpected sizes n_in %d out %d ws %zu\n", n_in, out_size, ws_size); }
        int dev = 0, cus = 0, per_cu = 0;
        hipGetDevice(&dev); hipDeviceGetAttribute(&cus, hipDeviceAttributeMultiprocessorCount, dev);
        hipFuncSetAttribute((const void*)mega_fwd, hipFuncAttributeMaxDynamicSharedMemorySize, LDS_TOTAL);
        hipOccupancyMaxActiveBlocksPerMultiprocessor(&per_cu, (const void*)mega_fwd, 512, LDS_TOTAL);
        (void)hipGetLastError();
        if (per_cu < 1) per_cu = 1;
        grid = cus;
    }
    (void)hipMemsetAsync((char*)d_ws + W_BAR, 0, 16384, stream);
    Prm prm{};
    for (int i = 0; i < 31; ++i) prm.in[i] = (const float*)d_in[i];
    prm.out = (float*)d_out; prm.ws = (unsigned char*)d_ws;
    void* args[] = {&prm};
    hipError_t e = hipLaunchCooperativeKernel((const void*)mega_fwd, dim3(grid), dim3(512), args, LDS_TOTAL, stream);
    if (e != hipSuccess) fprintf(stderr, "cooperative launch failed: %s (grid %d)\n", hipGetErrorString(e), grid);
}
```

```cpp
#include <hip/hip_runtime.h>
#include <hip/hip_cooperative_groups.h>
#include <hip/hip_bf16.h>
#include <cstdio>
#include <cstdint>
namespace cg = cooperative_groups;
namespace pg8 {
#define PG8_LAS __attribute__((address_space(3)))
typedef unsigned short bf16_t;
typedef short bf16x8 __attribute__((ext_vector_type(8)));
typedef float f32x4 __attribute__((ext_vector_type(4)));
typedef unsigned u32x4 __attribute__((ext_vector_type(4)));
constexpr int BM = 256, BK = 64, HALF = 128, HTB = HALF * BK * 2  , STAGE_BYTES = 8 * HTB, NXCD = 8, WGM = 8;

__host__ __device__ __forceinline__ int lds_byte(int r, int c) { const int st = (r >> 4) * 2 + (c >> 5), rr = r & 15, cc = c & 31, ob = rr * 64 + cc * 2; return st * 1024 + (ob ^ (((ob >> 9) & 1) << 5)); }
__host__ __device__ __forceinline__ void stage_rc(int b, int& R, int& C) { const int st = b / 1024, sb = b % 1024, swz = sb ^ (((sb >> 9) & 1) << 5); R = (st >> 1) * 16 + swz / 64; C = (st & 1) * 32 + (swz % 64) / 2; }
__host__ __device__ __forceinline__ int perm32(int rho) { const int n = rho >> 4, i = rho & 15; return 8 * (i >> 2) + 4 * n + (i & 3); }

struct Unit { int pm, pn, ho, half; };
struct Gemm { const bf16_t* A; const bf16_t* Bt; int M, N, K; };

struct StaticOrder {
    int nM, nN, nwg, G, c, tail;
    __host__ __device__ void init(int M, int N, int G_, int c_, int tail_ = 0) { nM = M / BM; nN = N / BM; nwg = nM * nN; G = G_; c = c_; tail = tail_; }
    __host__ __device__ bool next(int i, Unit& u) const {
        const long L = (long)i * G + c; u.ho = 0; u.half = 0;
        if (L >= nwg) { const int h = (int)(L - nwg); if (h >= tail * nN) return false; const int hm = h / nN; u.pn = h - hm * nN; u.pm = nM + (hm >> 1); u.ho = hm & 1; u.half = 1; return true; }
        int wgid = (int)L; { const int q = nwg / NXCD, r = nwg % NXCD, xcd = wgid % NXCD, off = wgid / NXCD; wgid = (xcd < r ? xcd * (q + 1) : r * (q + 1) + (xcd - r) * q) + off; }
        const int nig = WGM * nN, gid = wgid / nig, fm = gid * WGM, gsz = (nM - fm) < WGM ? (nM - fm) : WGM;
        u.pm = fm + ((wgid % nig) % gsz); u.pn = (wgid % nig) / gsz; return true;
    }
    __device__ __forceinline__ void a_ready(const Unit&) const {}
    __device__ __forceinline__ void done(const Unit&) const {}
};
__device__ __forceinline__ unsigned cvt_pk_bf16(float lo, float hi) { unsigned r; asm volatile("v_cvt_pk_bf16_f32 %0, %1, %2" : "=v"(r) : "v"(lo), "v"(hi)); return r; }
typedef float f32x2 __attribute__((ext_vector_type(2)));
template <class Epi, class Sched, bool ALIGN_EPI = false, bool SP2 = false>
__device__ __forceinline__ void gemm_phase(PG8_LAS unsigned char* lds, const Gemm g, const Sched& S, const Epi& E, const int tid) {
    const int wid = __builtin_amdgcn_readfirstlane(tid >> 6), lane = tid & 63, wr = wid >> 2, wc = wid & 3, fr = lane & 15, fq = lane >> 4;
    const int K = g.K, nt = K / BK;
    unsigned voffA[2], voffB[2];
#pragma unroll
    for (int i = 0; i < 2; ++i) { int R, C; stage_rc(tid * 16 + i * 8192, R, C); const int Rb = Epi::PERM ? ((R & ~31) + perm32(R & 31)) : R;
        voffA[i] = (unsigned)(R * K + C) * 2u; voffB[i] = (unsigned)(Rb * K + C) * 2u; }
    const size_t kstep = (size_t)(BK * 2);
    const size_t hstep = (size_t)HALF * K * 2;
    const size_t tstep = 2 * hstep;
    const unsigned ldsw = (unsigned)wid * 1024u;
    const int aoff = lds_byte(wr * 64 + fr, fq * 8), boff = lds_byte(wc * 32 + fr, fq * 8);
#define PG8_SA(b, h) (((b) * 2 + (h)) * HTB)
#define PG8_SB(b, h) ((4 + (b) * 2 + (h)) * HTB)
#define PG8_STAGE(bufoff, gbase, voff) do { _Pragma("unroll") for (int _i = 0; _i < 2; ++_i) \
        __builtin_amdgcn_global_load_lds((const unsigned*)((const char*)(gbase) + (voff)[_i]), (PG8_LAS unsigned*)(lds + (bufoff) + ldsw + _i * 8192), 16, 0, 0); } while (0)
#define PG8_LDA(dst, b, h) do { _Pragma("unroll") for (int m = 0; m < 4; ++m) _Pragma("unroll") for (int k = 0; k < 2; ++k) dst[m][k] = *(const PG8_LAS bf16x8*)(lds + PG8_SA(b, h) + aoff + m * 2048 + k * 1024); } while (0)
#define PG8_LDB(dst, b, h) do { _Pragma("unroll") for (int n = 0; n < 2; ++n) _Pragma("unroll") for (int k = 0; k < 2; ++k) dst[n][k] = *(const PG8_LAS bf16x8*)(lds + PG8_SB(b, h) + boff + n * 2048 + k * 1024); } while (0)
#define PG8_MMA(ai, bj, At, Bt) do { __builtin_amdgcn_s_setprio(1); _Pragma("unroll") for (int m = 0; m < 4; ++m) _Pragma("unroll") for (int n = 0; n < 2; ++n) _Pragma("unroll") for (int k = 0; k < 2; ++k) \
        acc[ai][bj][m][n] = __builtin_amdgcn_mfma_f32_16x16x32_bf16(Bt[n][k], At[m][k], acc[ai][bj][m][n], 0, 0, 0); __builtin_amdgcn_s_setprio(0); } while (0)
#define PG8_WAIT_V(n) asm volatile("s_waitcnt vmcnt(" #n ")" ::: "memory")
#define PG8_WAIT_L(n) asm volatile("s_waitcnt lgkmcnt(" #n ")" ::: "memory")
#define PG8_BAR __builtin_amdgcn_s_barrier()
#define PG8_SCHED __builtin_amdgcn_sched_barrier(0)
    Unit cur, nxt; int ui = 0;
    if (!S.next(0, cur)) return;
    f32x4 acc[2][2][4][2];
#pragma unroll
    for (int a = 0; a < 2; ++a)
#pragma unroll
        for (int b = 0; b < 2; ++b)
#pragma unroll
            for (int m = 0; m < 4; ++m)
#pragma unroll
                for (int n = 0; n < 2; ++n) acc[a][b][m][n] = (f32x4){0.f, 0.f, 0.f, 0.f};
    bf16x8 At[4][2], B0[2][2], B1[2][2];
    const char* cA = (const char*)g.A + (size_t)cur.pm * tstep + (size_t)cur.ho * hstep; const char* cB = (const char*)g.Bt + (size_t)cur.pn * tstep;
    S.a_ready(cur);
    if constexpr (SP2) {
        PG8_STAGE(PG8_SB(0, 0), cB, voffB); PG8_STAGE(PG8_SB(0, 1), cB + hstep, voffB); PG8_STAGE(PG8_SA(0, 0), cA, voffA); PG8_STAGE(PG8_SA(0, 1), cA + hstep, voffA);
        if (wr == 1) PG8_BAR;
        PG8_WAIT_V(2); PG8_BAR;
        PG8_STAGE(PG8_SB(1, 0), cB + kstep, voffB); PG8_STAGE(PG8_SA(1, 0), cA + kstep, voffA); PG8_STAGE(PG8_SB(1, 1), cB + hstep + kstep, voffB);
        PG8_WAIT_V(6); PG8_BAR;
    } else {
        PG8_STAGE(PG8_SB(0, 0), cB, voffB); PG8_STAGE(PG8_SA(0, 0), cA, voffA); PG8_STAGE(PG8_SB(0, 1), cB + hstep, voffB); PG8_STAGE(PG8_SA(0, 1), cA + hstep, voffA);
        if (wr == 1) PG8_BAR;
        PG8_WAIT_V(4); PG8_BAR;
        PG8_STAGE(PG8_SB(1, 0), cB + kstep, voffB); PG8_STAGE(PG8_SA(1, 0), cA + kstep, voffA); PG8_STAGE(PG8_SB(1, 1), cB + hstep + kstep, voffB);
        PG8_WAIT_V(6); PG8_BAR;
    }
    for (;;) {
        const bool has_next = S.next(ui + 1, nxt);
        const char* nA = has_next ? (const char*)g.A + (size_t)nxt.pm * tstep + (size_t)nxt.ho * hstep : cA; const char* nB = has_next ? (const char*)g.Bt + (size_t)nxt.pn * tstep : cB;
        for (int t = 0; t < nt; t += 2) {
            const bool last = (t == nt - 2);
            const char* a1 = cA + (size_t)(t + 1) * kstep;
            const char* a2 = last ? nA : cA + (size_t)(t + 2) * kstep; const char* b2 = last ? nB : cB + (size_t)(t + 2) * kstep;
            const char* a3 = a2 + kstep; const char* b3 = b2 + kstep;
            if (last && has_next) S.a_ready(nxt);
            if constexpr (SP2) {
            PG8_LDB(B0, 0, 0); PG8_LDB(B1, 0, 1); PG8_SCHED; PG8_LDA(At, 0, 0); PG8_STAGE(PG8_SA(1, 1), a1 + hstep, voffA);
            PG8_WAIT_V(8); PG8_WAIT_L(0); PG8_BAR; PG8_MMA(0, 0, At, B0); PG8_MMA(0, 1, At, B1); PG8_BAR; PG8_SCHED;
            PG8_LDA(At, 0, 1); PG8_STAGE(PG8_SB(0, 0), b2, voffB); PG8_STAGE(PG8_SB(0, 1), b2 + hstep, voffB); PG8_STAGE(PG8_SA(0, 0), a2, voffA);
            PG8_WAIT_V(8); PG8_WAIT_L(0); PG8_BAR; if (!cur.half) { PG8_MMA(1, 0, At, B0); PG8_MMA(1, 1, At, B1); } PG8_BAR; PG8_SCHED;
            PG8_LDB(B0, 1, 0); PG8_LDB(B1, 1, 1); PG8_SCHED; PG8_LDA(At, 1, 0); PG8_STAGE(PG8_SA(0, 1), a2 + hstep, voffA);
            PG8_WAIT_V(8); PG8_WAIT_L(0); PG8_BAR; PG8_MMA(0, 0, At, B0); PG8_MMA(0, 1, At, B1); PG8_BAR; PG8_SCHED;
            PG8_LDA(At, 1, 1); PG8_STAGE(PG8_SB(1, 0), b3, voffB); PG8_STAGE(PG8_SB(1, 1), b3 + hstep, voffB); PG8_STAGE(PG8_SA(1, 0), a3, voffA);
            PG8_WAIT_V(8); PG8_WAIT_L(0); PG8_BAR; if (!cur.half) { PG8_MMA(1, 0, At, B0); PG8_MMA(1, 1, At, B1); } PG8_BAR; PG8_SCHED;
            } else {
            PG8_LDB(B0, 0, 0); PG8_SCHED; PG8_LDA(At, 0, 0); PG8_STAGE(PG8_SA(1, 1), a1 + hstep, voffA);
            PG8_WAIT_L(8); PG8_BAR; PG8_WAIT_L(0); PG8_MMA(0, 0, At, B0); PG8_BAR; PG8_SCHED;
            PG8_LDB(B1, 0, 1); PG8_STAGE(PG8_SB(0, 0), b2, voffB);
            PG8_BAR; PG8_WAIT_L(0); PG8_MMA(0, 1, At, B1); PG8_BAR;
            PG8_LDA(At, 0, 1); PG8_STAGE(PG8_SA(0, 0), a2, voffA);
            PG8_BAR; PG8_WAIT_L(0); PG8_MMA(1, 0, At, B0); PG8_BAR; PG8_SCHED;
            PG8_STAGE(PG8_SB(0, 1), b2 + hstep, voffB);
            PG8_WAIT_V(6); PG8_BAR; PG8_MMA(1, 1, At, B1); PG8_BAR;
            PG8_LDB(B0, 1, 0); PG8_SCHED; PG8_LDA(At, 1, 0); PG8_STAGE(PG8_SA(0, 1), a2 + hstep, voffA);
            PG8_WAIT_L(8); PG8_BAR; PG8_WAIT_L(0); PG8_MMA(0, 0, At, B0); PG8_BAR; PG8_SCHED;
            PG8_LDB(B1, 1, 1); PG8_STAGE(PG8_SB(1, 0), b3, voffB);
            PG8_BAR; PG8_WAIT_L(0); PG8_MMA(0, 1, At, B1); PG8_BAR;
            PG8_LDA(At, 1, 1); PG8_STAGE(PG8_SA(1, 0), a3, voffA);
            PG8_BAR; PG8_WAIT_L(0); PG8_MMA(1, 0, At, B0); PG8_BAR; PG8_SCHED;
            PG8_STAGE(PG8_SB(1, 1), b3 + hstep, voffB);
            PG8_WAIT_V(6); PG8_BAR; PG8_MMA(1, 1, At, B1); PG8_BAR;
            }
        }
        if constexpr (ALIGN_EPI) { if (wr == 0) PG8_BAR; }
        if constexpr (!Epi::AFTER_DRAIN) { E(acc, cur, wr, wc, fr, fq); S.done(cur); }
        if (!has_next) break;
#pragma unroll
        for (int a = 0; a < 2; ++a)
#pragma unroll
            for (int b = 0; b < 2; ++b)
#pragma unroll
                for (int m = 0; m < 4; ++m)
#pragma unroll
                    for (int n = 0; n < 2; ++n) acc[a][b][m][n] = (f32x4){0.f, 0.f, 0.f, 0.f};
        cur = nxt; cA = nA; cB = nB; ++ui;
        if constexpr (ALIGN_EPI) { if (wr == 1) PG8_BAR; }
    }
    PG8_WAIT_V(0);
    if constexpr (!ALIGN_EPI) { if (wr == 0) PG8_BAR; }
    PG8_BAR;
    if constexpr (Epi::AFTER_DRAIN) { E.fused(acc, cur, wr, wc, fr, fq, lds, wid, lane); S.done(cur); }
#undef PG8_SA
#undef PG8_SB
#undef PG8_STAGE
#undef PG8_LDA
#undef PG8_LDB
#undef PG8_MMA
#undef PG8_WAIT_V
#undef PG8_WAIT_L
#undef PG8_BAR
#undef PG8_SCHED
}
}
namespace att {
constexpr int D = 128, PITCH = 2048, NW = 8, QBLK = 32, KVBLK = 64, QB = NW * QBLK;
constexpr int SHM_V = KVBLK * D * 2, SHM_K = KVBLK * D * 2;
constexpr int LDS_BIAS = 2 * SHM_V + 2 * SHM_K + NW * 64 * 4;
constexpr int NQX = 4, LDS_QX = LDS_BIAS + 512;
constexpr int LDS_BYTES = LDS_QX + NW * NQX * 1024;
constexpr float THR2 = 64.f;
constexpr bool WSKIP = false;
typedef __hip_bfloat16 bf16;
typedef short bf16x8 __attribute__((ext_vector_type(8)));
typedef short s16x4 __attribute__((ext_vector_type(4)));
typedef float f32x16 __attribute__((ext_vector_type(16)));
typedef float f32x4 __attribute__((ext_vector_type(4)));
typedef unsigned u32x4 __attribute__((ext_vector_type(4)));
template <class A, class Bt> struct same_t { static constexpr bool v = false; };
template <class A> struct same_t<A, A> { static constexpr bool v = true; };

#define KSWZ(row, colB) ((row) * 256 + ((colB) ^ (((row) & 7) << 4)))
#define SBAR() __builtin_amdgcn_sched_barrier(0)
__device__ __forceinline__ int v_st(int k, int c) { const int kk = (k & ~0xC) | ((k & 4) << 1) | ((k & 8) >> 1); return ((kk >> 3) * 4 + (c >> 5)) * 512 + ((kk & 7) * 32 + (c & 31)) * 2; }
__device__ __forceinline__ int v_rd_base(int lane) { return ((lane & 3) << 3) | (((lane >> 2) & 3) << 6) | (((lane >> 4) & 1) << 5) | (((lane >> 5) & 1) << 8); }
constexpr int v_rd_off(int d0, int ks, int half) { return d0 * 512 + ks * 4096 + half * 2048; }
__device__ __forceinline__ int crow(int r, int hi) { return (r & 3) + 8 * (r >> 2) + 4 * hi; }
__device__ __forceinline__ unsigned cvtpk(float lo, float hi) {
    unsigned r; asm volatile("v_cvt_pk_bf16_f32 %0, %1, %2" : "=v"(r) : "v"(lo), "v"(hi)); return r;
}
__device__ __forceinline__ bf16x8 pack8(f32x4 a, f32x4 b) {
    u32x4 w = {cvtpk(a[0], a[1]), cvtpk(a[2], a[3]), cvtpk(b[0], b[1]), cvtpk(b[2], b[3])};
    return *reinterpret_cast<bf16x8*>(&w);
}
template <class T> __device__ __forceinline__ bf16x8 load8(const T* p) {
    if constexpr (same_t<T, float>::v) { return pack8(*(const f32x4*)p, *(const f32x4*)(p + 4)); }
    else { return *reinterpret_cast<const bf16x8*>(p); }
}
__device__ __forceinline__ void mask_tile(f32x16& p0, f32x16& p1, int dq, unsigned W) {
    const float NEG = -__builtin_inff();
#pragma unroll
    for (int r = 0; r < 16; ++r) {
        const int c = (r & 3) + 8 * (r >> 2);
        if (dq - c < 0) p0[r] = NEG;
        if (dq - c - 32 < 0) p1[r] = NEG;
    }
}
__device__ __forceinline__ void partialSM(f32x16& p0, f32x16& p1, float& m_reg, float& mn, float& alpha) {
    float pmax = p0[0]; for (int r = 1; r < 16; ++r) pmax = fmaxf(pmax, p0[r]); for (int r = 0; r < 16; ++r) pmax = fmaxf(pmax, p1[r]);
    { auto rr = __builtin_amdgcn_permlane32_swap(__float_as_uint(pmax), __float_as_uint(pmax), false, false);
      pmax = fmaxf(__uint_as_float(rr[0]), __uint_as_float(rr[1])); }
    if (__builtin_expect(__all((pmax - m_reg) <= THR2), 1)) { mn = m_reg; alpha = 1.f; }
    else { mn = fmaxf(m_reg, pmax); alpha = __builtin_amdgcn_exp2f(m_reg - mn); m_reg = mn; }
    for (int r = 0; r < 16; ++r) p0[r] = p0[r] - mn; for (int r = 0; r < 16; ++r) p1[r] = p1[r] - mn;
    for (int r = 0; r < 16; ++r) p0[r] = __builtin_amdgcn_exp2f(p0[r]);
}
__device__ __forceinline__ void finishSM(f32x16& p0, f32x16& p1, float alpha, float& l_reg, bf16x8& pa0, bf16x8& pa1, bf16x8& pa2, bf16x8& pa3) {
    for (int r = 0; r < 16; ++r) p1[r] = __builtin_amdgcn_exp2f(p1[r]);
    float ps = 0; for (int r = 0; r < 16; ++r) ps += p0[r]; for (int r = 0; r < 16; ++r) ps += p1[r];
    { auto rr = __builtin_amdgcn_permlane32_swap(__float_as_uint(ps), __float_as_uint(ps), false, false);
      ps = __uint_as_float(rr[0]) + __uint_as_float(rr[1]); }
    l_reg = l_reg * alpha + ps;
#define PK4(P, B_, OUT) do { unsigned a0 = cvtpk(P[B_+0], P[B_+1]), a1 = cvtpk(P[B_+2], P[B_+3]);                          \
        unsigned b0 = cvtpk(P[B_+4], P[B_+5]), b1 = cvtpk(P[B_+6], P[B_+7]);                                             \
        auto r0 = __builtin_amdgcn_permlane32_swap(a0, b0, false, false); auto r1 = __builtin_amdgcn_permlane32_swap(a1, b1, false, false); \
        u32x4 w = {r0[0], r1[0], r0[1], r1[1]}; OUT = *reinterpret_cast<bf16x8*>(&w); } while (0)
    PK4(p0, 0, pa0); PK4(p0, 8, pa1); PK4(p1, 0, pa2); PK4(p1, 8, pa3);
#undef PK4
}
template <int KB, bool SK>
__device__ __forceinline__ void qkt(f32x16& p0, f32x16& p1, const char* K_lds, int r32, int hi, const bf16x8* qr, bool act, const char* qx) {
    if (SK && !act) { const float NEG = -__builtin_inff();
#pragma unroll
        for (int r = 0; r < 16; ++r) { p0[r] = NEG; p1[r] = NEG; } return; }
    { const float* bl = (const float*)(K_lds - 2 * SHM_V + LDS_BIAS) + KB * 64 + 4 * hi;
#pragma unroll
      for (int g = 0; g < 4; ++g) { const f32x4 u0 = *(const f32x4*)(bl + 8 * g), u1 = *(const f32x4*)(bl + 32 + 8 * g);
        p0[4*g] = u0[0]; p0[4*g+1] = u0[1]; p0[4*g+2] = u0[2]; p0[4*g+3] = u0[3]; p1[4*g] = u1[0]; p1[4*g+1] = u1[1]; p1[4*g+2] = u1[2]; p1[4*g+3] = u1[3]; } }
    const char* kb[4];
#pragma unroll
    for (int dd = 0; dd < 4; ++dd) kb[dd] = K_lds + KB * SHM_K + KSWZ(r32, (dd * 16 + hi * 8) * 2);
#pragma unroll
    for (int d0 = 0; d0 < 8; ++d0) { const char* a = kb[d0 & 3] + (d0 >> 2) * 128;
        bf16x8 b0 = *reinterpret_cast<const bf16x8*>(a);
        bf16x8 b1 = *reinterpret_cast<const bf16x8*>(a + 32 * 256);
        const bf16x8 qv = (d0 < 8 - NQX) ? qr[d0] : *reinterpret_cast<const bf16x8*>(qx + (d0 - (8 - NQX)) * 1024);
        p0 = __builtin_amdgcn_mfma_f32_32x32x16_bf16(b0, qv, p0, 0, 0, 0);
        p1 = __builtin_amdgcn_mfma_f32_32x32x16_bf16(b1, qv, p1, 0, 0, 0); }
}
template <int VB, bool SK>
__device__ __forceinline__ void pv_tile(f32x16* o, int vb0, bf16x8 pa0, bf16x8 pa1, bf16x8 pa2, bf16x8 pa3, bool act) {
    if (SK && !act) return;
#define TRRD(dst, off) asm volatile("ds_read_b64_tr_b16 %0, %1 offset:%2" : "=&v"(dst) : "v"(vb0), "i"(off) : "memory")
#define PV_D0(d0) do { s16x4 l0, l1, l2, l3, h0, h1, h2, h3; constexpr int b_ = VB * SHM_V + v_rd_off(d0, 0, 0);     \
        TRRD(l0, b_); TRRD(h0, b_ + 2048); TRRD(l1, b_ + 4096); TRRD(h1, b_ + 6144); TRRD(l2, b_ + 8192); TRRD(h2, b_ + 10240); TRRD(l3, b_ + 12288); TRRD(h3, b_ + 14336); \
        asm volatile("s_waitcnt lgkmcnt(0)" ::: "memory"); SBAR();                 \
        o[d0] = __builtin_amdgcn_mfma_f32_32x32x16_bf16(pa0, (bf16x8){l0[0], l0[1], l0[2], l0[3], h0[0], h0[1], h0[2], h0[3]}, o[d0], 0, 0, 0);   \
        o[d0] = __builtin_amdgcn_mfma_f32_32x32x16_bf16(pa1, (bf16x8){l1[0], l1[1], l1[2], l1[3], h1[0], h1[1], h1[2], h1[3]}, o[d0], 0, 0, 0);   \
        o[d0] = __builtin_amdgcn_mfma_f32_32x32x16_bf16(pa2, (bf16x8){l2[0], l2[1], l2[2], l2[3], h2[0], h2[1], h2[2], h2[3]}, o[d0], 0, 0, 0);   \
        o[d0] = __builtin_amdgcn_mfma_f32_32x32x16_bf16(pa3, (bf16x8){l3[0], l3[1], l3[2], l3[3], h3[0], h3[1], h3[2], h3[3]}, o[d0], 0, 0, 0); } while (0)
    PV_D0(0); PV_D0(1); PV_D0(2); PV_D0(3);
#undef PV_D0
#undef TRRD
}

template <class TIn, class TOut> struct BlockRef { const TIn* Q; const TIn* K; const TIn* V; TOut* O; const float* Bs; int P0; int nvalid; };
template <class TIn> struct Seam {
    bf16x8 qr[8];
    bf16x8 st_v0, st_v1, st_k0, st_k1; f32x4 sf0, sf1, sf2, sf3;
    f32x4 tq[16];
};
__device__ __forceinline__ int swa_jlo(int P0, int W) { const int lowk = P0 - W + 1; return lowk > 0 ? lowk / KVBLK : 0; }
#define ROW(p, k0, rr) ((p) + (size_t)((k0) + (rr)) * PITCH + sc)
#define VMW() asm volatile("s_waitcnt vmcnt(0)" ::: "memory")
#define VMWN(n) asm volatile("s_waitcnt vmcnt(%0)" :: "i"(n) : "memory")
#define GLDS(gp_, lp_, sz_) __builtin_amdgcn_global_load_lds((const unsigned*)(gp_), (__attribute__((address_space(3))) unsigned*)(lp_), sz_, 0, 0)
#define SLOAD_H(Kp, Vp, Bp, k0, bb_) do { S.st_v0 = load8<TIn>(ROW(Vp, k0, sr)); S.st_v1 = load8<TIn>(ROW(Vp, k0, 32 + sr));              \
                         { const TIn* kg_ = (Kp) + (size_t)(k0) * PITCH; char* kl_ = K_lds + (bb_) * SHM_K + wid * 2048; GLDS(kg_ + ksrc0, kl_, 16); GLDS(kg_ + ksrc1, kl_ + 1024, 16); } \
                         if (wid == 0) GLDS((Bp) + (k0) + lane, lds + LDS_BIAS + (bb_) * 256, 4); } while (0)
#define SWRITE_HK(bf) do { } while (0)
#define SWRITE_HV(bf) do { *(bf16x8*)(V_lds + (bf) * SHM_V + vst0) = S.st_v0; *(bf16x8*)(V_lds + (bf) * SHM_V + vst1) = S.st_v1; } while (0)
#define SWRITE_H(bf) do { SWRITE_HV(bf); SWRITE_HK(bf); } while (0)
#define SLOAD_F(p, k0) do { S.sf0 = *(const f32x4*)ROW(p, k0, sr); S.sf1 = *(const f32x4*)(ROW(p, k0, sr) + 4);                \
                            S.sf2 = *(const f32x4*)ROW(p, k0, 32 + sr); S.sf3 = *(const f32x4*)(ROW(p, k0, 32 + sr) + 4); } while (0)
#define SWRITE_KF(bf) do { *(bf16x8*)(K_lds + (bf) * SHM_K + kws) = pack8(S.sf0, S.sf1); *(bf16x8*)(K_lds + (bf) * SHM_K + kws + 32 * 256) = pack8(S.sf2, S.sf3); } while (0)
#define SWRITE_VF(bf) do { *(bf16x8*)(V_lds + (bf) * SHM_V + vst0) = pack8(S.sf0, S.sf1); *(bf16x8*)(V_lds + (bf) * SHM_V + vst1) = pack8(S.sf2, S.sf3); } while (0)
template <class TIn, class TOut>
__device__ __forceinline__ void causal_swa_prime(const BlockRef<TIn, TOut>& cur, int W, char* lds, Seam<TIn>& S, const int tid) {
    constexpr bool F32 = same_t<TIn, float>::v;
    const int wid = __builtin_amdgcn_readfirstlane(tid >> 6), lane = tid & 63, r32 = lane & 31, hi = lane >> 5;
    const int sr = tid >> 4, sc = (tid & 15) * 8, kws = KSWZ(sr, sc * 2); char* K_lds = lds + 2 * SHM_V; (void)kws;
    const int ksrc0 = (8 * wid + (lane >> 4)) * PITCH + ((lane & 15) ^ (lane >> 4)) * 8, ksrc1 = (8 * wid + 4 + (lane >> 4)) * PITCH + ((lane & 15) ^ (4 + (lane >> 4))) * 8;
    const int kb0 = swa_jlo(cur.P0, W) * KVBLK;
    for (int d0 = 0; d0 < 8; ++d0) S.qr[d0] = load8<TIn>(cur.Q + (size_t)(wid * QBLK + r32) * PITCH + d0 * 16 + hi * 8);
    if constexpr (F32) { SLOAD_F((const float*)cur.K, kb0); VMW(); SWRITE_KF(0); SBAR(); SLOAD_F((const float*)cur.V, kb0); }
    else { SLOAD_H(cur.K, cur.V, cur.Bs, kb0, 0); VMW(); SWRITE_HK(0); }
    __syncthreads();
}
template <class TIn, class TOut>
__device__ __forceinline__ void causal_swa_block(const BlockRef<TIn, TOut>& cur, const BlockRef<TIn, TOut>& nxt, int skv, int W, char* lds, Seam<TIn>& S, const int tid, const float* qnw, const float qs) {
    constexpr bool F32 = same_t<TIn, float>::v;
    const int wid = __builtin_amdgcn_readfirstlane(tid >> 6), lane = tid & 63, r32 = lane & 31, hi = lane >> 5;
    const int j_lo = swa_jlo(cur.P0, W);
    int j_hi = (cur.P0 + QB - 1) / KVBLK + 1; if (j_hi > skv / KVBLK) j_hi = skv / KVBLK;
    const int NT = j_hi - j_lo;
    const int kbn = swa_jlo(nxt.P0, W) * KVBLK;
    const int qlo = cur.P0 + wid * QBLK, qm = qlo + r32 - 4 * hi;
    char* V_lds = lds; char* K_lds = lds + 2 * SHM_V;
    float* ws = (float*)(lds + 2 * SHM_V + 2 * SHM_K) + wid * 64; float* li_l = ws, * al_l = ws + 32;
    float m_reg = -1e30f, l_reg = 0; f32x16 o[4] = {};
    const int sr = tid >> 4, sc = (tid & 15) * 8, vst0 = v_st(sr, sc), vst1 = v_st(32 + sr, sc), kws = KSWZ(sr, sc * 2);
    const int vb0 = (int)(uintptr_t)V_lds + v_rd_base(lane); (void)kws;
    const int ksrc0 = (8 * wid + (lane >> 4)) * PITCH + ((lane & 15) ^ (lane >> 4)) * 8, ksrc1 = (8 * wid + 4 + (lane >> 4)) * PITCH + ((lane & 15) ^ (4 + (lane >> 4))) * 8;
    const TIn* Kh = cur.K; const TIn* Vh = cur.V; const float* Bh = cur.Bs;
#define RESC(a) do { if (__any((a) < 1.f)) { if (hi == 0) al_l[r32] = (a); asm volatile("s_waitcnt lgkmcnt(0)" ::: "memory");              \
                     for (int d_ = 0; d_ < 4; ++d_) for (int r = 0; r < 16; ++r) o[d_][r] *= al_l[crow(r, hi)]; } } while (0)
#define KBASE(t) ((j_lo + (t)) * KVBLK)
#define ACT(t) (KBASE(t) <= qlo + QBLK - 1 && KBASE(t) + KVBLK - 1 >= qlo - W + 1)
#define MASKT(P0_, P1_, t) do { const int kb_ = KBASE(t); if ((!SK || ACT(t)) && (kb_ + KVBLK - 1 > qlo || kb_ <= qlo + QBLK - 1 - W)) mask_tile(P0_, P1_, qm - kb_, (unsigned)W); } while (0)
    constexpr int NQL = F32 ? 16 : 8;
    constexpr bool SK = WSKIP && !F32;
#define SEAM_K0() do { VMWN(NQL); if constexpr (F32) { SWRITE_KF(0); SBAR(); SLOAD_F((const float*)nxt.V, kbn); } else { SWRITE_HK(0); } SBAR(); } while (0)
    f32x16 pA0, pA1, pB0, pB1; float mnA, mnB, alA, alB; bf16x8 pa0, pa1, pa2, pa3;
    {
        const float* wq_ = qnw; asm volatile("" : "+s"(wq_));
        float ss_ = 0.f;
#pragma unroll
        for (int d0 = 0; d0 < 8; ++d0) { const u32x4 w_ = __builtin_bit_cast(u32x4, S.qr[d0]);
#pragma unroll
            for (int e = 0; e < 4; ++e) { const float lo_ = __uint_as_float(w_[e] << 16), hi_ = __uint_as_float(w_[e] & 0xffff0000u); ss_ += lo_ * lo_ + hi_ * hi_; } }
        { auto rr = __builtin_amdgcn_permlane32_swap(__float_as_uint(ss_), __float_as_uint(ss_), false, false); ss_ = __uint_as_float(rr[0]) + __uint_as_float(rr[1]); }
        const float rs_ = rsqrtf(ss_ * (1.f / 128.f) + 1e-6f) * qs;
#pragma unroll
        for (int d0 = 0; d0 < 8; ++d0) { const u32x4 w_ = __builtin_bit_cast(u32x4, S.qr[d0]); const f32x4 g0 = *(const f32x4*)(wq_ + d0 * 16 + hi * 8), g1 = *(const f32x4*)(wq_ + d0 * 16 + hi * 8 + 4); u32x4 o_;
#pragma unroll
            for (int e = 0; e < 4; ++e) { const float lo_ = __uint_as_float(w_[e] << 16) * rs_ * (e < 2 ? g0[2 * e] : g1[2 * e - 4]), hi_ = __uint_as_float(w_[e] & 0xffff0000u) * rs_ * (e < 2 ? g0[2 * e + 1] : g1[2 * e - 3]); o_[e] = cvtpk(lo_, hi_); }
            S.qr[d0] = __builtin_bit_cast(bf16x8, o_); }
    }
    char* qx = lds + LDS_QX + wid * (NQX * 1024) + lane * 16;
#pragma unroll
    for (int e = 0; e < NQX; ++e) *reinterpret_cast<bf16x8*>(qx + e * 1024) = S.qr[8 - NQX + e];
    if constexpr (F32) { VMW(); SWRITE_VF(0); SBAR(); } else { SWRITE_HV(0); SBAR(); }
    if (NT > 1) { if constexpr (F32) SLOAD_F((const float*)Kh, KBASE(1)); else SLOAD_H(Kh, Vh, Bh, KBASE(1), 1); }
    SBAR(); qkt<0, SK>(pA0, pA1, K_lds, r32, hi, S.qr, ACT(0), qx);
    if constexpr (F32) { if (NT > 1) { VMW(); SWRITE_KF(1); SBAR(); SLOAD_F((const float*)Vh, KBASE(1)); } }
    MASKT(pA0, pA1, 0); partialSM(pA0, pA1, m_reg, mnA, alA);
    if (NT > 1) { VMW(); if constexpr (F32) { SWRITE_VF(1); SBAR(); if (NT > 2) SLOAD_F((const float*)Kh, KBASE(2)); } else SWRITE_H(1); }
    __syncthreads();
#define HALF_STEP(PX0, PX1, mnX, alX, PY0, PY1, alY, t, KB, VB, SB) do {                                                      \
        SBAR(); qkt<KB, SK>(PX0, PX1, K_lds, r32, hi, S.qr, ACT(t), qx);                                             \
        finishSM(PY0, PY1, alY, l_reg, pa0, pa1, pa2, pa3); SBAR();                                                           \
        if ((t) + 1 < NT) { if constexpr (F32) { VMW(); SWRITE_KF(SB); SBAR(); SLOAD_F((const float*)Vh, KBASE((t) + 1)); }  \
                            else { SLOAD_H(Kh, Vh, Bh, KBASE((t) + 1), SB); } SBAR(); }                                               \
        pv_tile<VB, SK>(o, vb0, pa0, pa1, pa2, pa3, ACT((t) - 1)); MASKT(PX0, PX1, (t)); partialSM(PX0, PX1, m_reg, mnX, alX);                                        \
        __syncthreads();                                                                                                      \
        if ((t) + 1 < NT) { VMW(); if constexpr (F32) { SWRITE_VF(SB); SBAR(); if ((t) + 2 < NT) SLOAD_F((const float*)Kh, KBASE((t) + 2)); } \
                            else { SWRITE_H(SB); } }                                                                          \
        RESC(alX); __syncthreads(); } while (0)
    for (int t = 1; t + 1 < NT; t += 2) {
        HALF_STEP(pB0, pB1, mnB, alB, pA0, pA1, alA, t, 1, 0, 0);
        HALF_STEP(pA0, pA1, mnA, alA, pB0, pB1, alB, t + 1, 0, 1, 1);
    }
    const bool even = (NT & 1) == 0;
    if (even) { SBAR(); qkt<1, SK>(pB0, pB1, K_lds, r32, hi, S.qr, ACT(NT - 1), qx); SBAR(); }
#define QROW(e) (nxt.Q + (size_t)(wid * QBLK + r32) * PITCH + ((e) >> 1) * 16 + hi * 8 + ((e) & 1) * 4)
    if constexpr (F32) { SLOAD_F((const float*)nxt.K, kbn); SBAR();
#pragma unroll
        for (int e = 0; e < 8; ++e) S.tq[e] = *(const f32x4*)QROW(e); }
    else { SLOAD_H(nxt.K, nxt.V, nxt.Bs, kbn, 0); SBAR();
#pragma unroll
        for (int d0 = 0; d0 < 8; ++d0) S.qr[d0] = load8<TIn>(nxt.Q + (size_t)(wid * QBLK + r32) * PITCH + d0 * 16 + hi * 8); }
    SBAR();
    finishSM(pA0, pA1, alA, l_reg, pa0, pa1, pa2, pa3); SBAR();
    if constexpr (F32) {
#pragma unroll
        for (int e = 8; e < 16; ++e) S.tq[e] = *(const f32x4*)QROW(e); SBAR(); }
#undef QROW
    pv_tile<0, SK>(o, vb0, pa0, pa1, pa2, pa3, ACT(even ? NT - 2 : NT - 1));
    if (even) { MASKT(pB0, pB1, NT - 1); partialSM(pB0, pB1, m_reg, mnB, alB); __syncthreads(); RESC(alB);
        finishSM(pB0, pB1, alB, l_reg, pa0, pa1, pa2, pa3); SBAR(); pv_tile<1, SK>(o, vb0, pa0, pa1, pa2, pa3, ACT(NT - 1)); }
    SBAR(); SEAM_K0();
    if (hi == 0) li_l[r32] = l_reg; asm volatile("s_waitcnt lgkmcnt(0)" ::: "memory");
    float rli[16];
#pragma unroll
    for (int r = 0; r < 16; ++r) rli[r] = __builtin_amdgcn_rcpf(li_l[crow(r, hi)]);
    int tidE = tid; asm volatile("" : "+v"(tidE));
    const int widE = __builtin_amdgcn_readfirstlane(tidE >> 6), r32E = tidE & 31, hiE = (tidE >> 5) & 1;
    TOut* Ow = cur.O + (size_t)(widE * QBLK) * PITCH; const bool wval = widE * QBLK < cur.nvalid;
    if (wval) {
#pragma unroll
    for (int r = 0; r < 16; ++r) { const int orow = crow(r, hiE);
#pragma unroll
        for (int d0 = 0; d0 < 4; ++d0) { const float v = o[d0][r] * rli[r];
            if constexpr (same_t<TOut, float>::v) { Ow[(size_t)orow * PITCH + d0 * 32 + r32E] = v; }
            else { const float vn = __shfl_xor(v, 1);
                   if ((r32E & 1) == 0) *(unsigned*)(Ow + (size_t)orow * PITCH + d0 * 32 + r32E) = cvtpk(v, vn); } } } }
    if constexpr (F32) {
#pragma unroll
        for (int d0 = 0; d0 < 8; ++d0) S.qr[d0] = pack8(S.tq[2 * d0], S.tq[2 * d0 + 1]); }
    __syncthreads();
#undef RESC
#undef KBASE
#undef ACT
#undef MASKT
#undef SEAM_K0
#undef HALF_STEP
}
#undef ROW
#undef VMW
#undef VMWN
#undef SLOAD_H
#undef GLDS
#undef SWRITE_HK
#undef SWRITE_HV
#undef SWRITE_H
#undef SLOAD_F
#undef SWRITE_KF
#undef SWRITE_VF

}
#define GAS __attribute__((address_space(1)))
#define LAS __attribute__((address_space(3)))
typedef GAS unsigned gu32;
typedef GAS unsigned long long gu64;
#define RLX_AGENT __ATOMIC_RELAXED, __HIP_MEMORY_SCOPE_AGENT
#define LDS_WAIT() asm volatile("s_waitcnt lgkmcnt(0)" ::: "memory")
#define VM_WAIT() asm volatile("s_waitcnt vmcnt(0)" ::: "memory")
__device__ __forceinline__ unsigned long long rt() { return __builtin_amdgcn_s_memrealtime(); }
#define XB_TMO      128
#define XB_XCNT(j)  (256  + 64 * (j))
#define XB_XSUB(j)  (1280 + 64 * (j))
#define XB_XGEN(j)  (2304 + 64 * (j))
#define XB_TOP      3328
#define XB_TOPGEN   3392
#define XCD_BAR_WORDS 3456
#define XB_SPIN_CAP (1u << 18)

__device__ __forceinline__ unsigned xb_ld(unsigned* p)              { return __hip_atomic_load(p, __ATOMIC_RELAXED, __HIP_MEMORY_SCOPE_AGENT); }
__device__ __forceinline__ unsigned xb_add(unsigned* p, unsigned v) { return __hip_atomic_fetch_add(p, v, __ATOMIC_RELAXED, __HIP_MEMORY_SCOPE_AGENT); }
__device__ __forceinline__ unsigned xb_xcc_id() { return (unsigned)__builtin_amdgcn_s_getreg((3 << 11) | 20) & 0xFu; }
#define XB_SPIN(cond, bar) do { unsigned _sp = 0; while (cond) { __builtin_amdgcn_s_sleep(1); \
    if ((++_sp & 255u) == 0u) { if (xb_ld(&(bar)[XB_TMO])) break; if (_sp > XB_SPIN_CAP) { atomicAdd(&(bar)[XB_TMO], 1u); break; } } } } while (0)

struct XcdBarrier {
    unsigned* bar; unsigned x;
    volatile LAS unsigned* st;
};

__device__ __forceinline__ XcdBarrier xcd_barrier_post(unsigned* bar, volatile LAS unsigned* st) {
    XcdBarrier b; b.bar = bar; b.x = xb_xcc_id(); b.st = st;
    if (threadIdx.x == 0) (void)xb_add(&bar[XB_XCNT(b.x)], 1u);
    return b;
}
__device__ __forceinline__ void xcd_barrier_complete(unsigned* bar, unsigned x, unsigned& nloc, unsigned& nx) {
    const unsigned G = gridDim.x * gridDim.y * gridDim.z;
    unsigned sum, cnt, mine, sp = 0u;
    for (;;) {
        sum = 0u; cnt = 0u; mine = 0u;
#pragma unroll
        for (unsigned j = 0; j < 16; ++j) { const unsigned c = xb_ld(&bar[XB_XCNT(j)]); sum += c; cnt += (c > 0u) ? 1u : 0u; mine = (j == x) ? c : mine; }
        if (sum == G) break;
        __builtin_amdgcn_s_sleep(1);
        if ((++sp & 255u) == 0u) { if (xb_ld(&bar[XB_TMO])) break; if (sp > XB_SPIN_CAP) { atomicAdd(&bar[XB_TMO], 1u); break; } }
    }
    nloc = mine > 0u ? mine : 1u; nx = cnt > 0u ? cnt : 1u;
}

__device__ __forceinline__ void xcd_barrier(const XcdBarrier& b) {
    asm volatile("s_waitcnt vmcnt(0)" ::: "memory");
    __syncthreads();
    if (threadIdx.x == 0) {
        unsigned* bar = b.bar;
        __builtin_amdgcn_s_waitcnt(0);
        unsigned nloc = b.st[0], nx = b.st[1];
        if (nloc == 0u) { xcd_barrier_complete(bar, b.x, nloc, nx); b.st[0] = nloc; b.st[1] = nx; }
        const unsigned old = xb_add(&bar[XB_XSUB(b.x)], 1u);
        const unsigned gen = old / nloc;
        if (old + 1u == (gen + 1u) * nloc) {
            __builtin_amdgcn_fence(__ATOMIC_RELEASE, "agent");
            asm volatile("s_waitcnt vmcnt(0)" ::: "memory");
            const unsigned og = xb_add(&bar[XB_TOP], 1u);
            const unsigned tg = og / nx;
            if (og + 1u == (tg + 1u) * nx) xb_add(&bar[XB_TOPGEN], 1u);
            else XB_SPIN(xb_ld(&bar[XB_TOPGEN]) == tg, bar);
            __builtin_amdgcn_fence(__ATOMIC_ACQUIRE, "agent");
            xb_add(&bar[XB_XGEN(b.x)], 1u);
            asm volatile("s_waitcnt vmcnt(0)" ::: "memory");
        } else {
            XB_SPIN(xb_ld(&bar[XB_XGEN(b.x)]) == gen, bar);
            __builtin_amdgcn_fence(__ATOMIC_ACQUIRE, "agent");
            asm volatile("s_waitcnt vmcnt(0)" ::: "memory");
        }
    }
    __syncthreads();
}

typedef unsigned short u16;
typedef float f32x4 __attribute__((ext_vector_type(4)));
typedef unsigned u32x4 __attribute__((ext_vector_type(4)));
typedef unsigned u32x2 __attribute__((ext_vector_type(2)));
typedef short bf16x8 __attribute__((ext_vector_type(8)));
constexpr int DM = 2048, TP = 8192, NBP = 4, NBS = 8, TS = 64, PAST = 2048, SKVS = PAST + TS;
constexpr int MP = NBP * TP, MS_ = NBS * TS, M = MP + MS_;
constexpr int DI = 4096, CD = 6144, NH = 64, DFF = 5504, DFF2 = 11008, NIN = 20560;
constexpr int NMOD = 12288;
constexpr float EPS = 1e-6f, LOG2E = 1.4426950408889634f;
constexpr int HALF_ROWS = 16640;
constexpr size_t O_YP = 0, O_YS = O_YP + (size_t)MP * DM, O_KP = O_YS + (size_t)MS_ * DM, O_VP = O_KP + (size_t)MP * DM,
    O_LFP = O_VP + (size_t)MP * DM, O_SSMP = O_LFP + (size_t)MP * 16, O_MCP = O_SSMP + (size_t)NBP * 64 * 64 * 128, O_FCP = O_MCP + (size_t)NBP * 3 * CD,
    O_KS = O_FCP + (size_t)NBP * 2 * DFF2, O_VS = O_KS + (size_t)MS_ * DM, O_LFS = O_VS + (size_t)MS_ * DM, O_SSMS = O_LFS + (size_t)MS_ * 16,
    O_MCS = O_SSMS + (size_t)NBS * 64 * 64 * 128, O_FCS = O_MCS + (size_t)NBS * 3 * CD, O_END = O_FCS + (size_t)NBS * 2 * DFF2;
constexpr size_t MiB = 1u << 20;
constexpr size_t W_MOD = 0, W_BAR = 768 * 1024  , W_BIASP = 1 * MiB, W_BIASS = 3 * MiB, W_HALO = 5 * MiB,
    W_WUP = 8 * MiB, W_WDN = 51 * MiB, W_H = 73 * MiB, W_WIN = 203 * MiB, W_WPM = 284 * MiB, W_WPF = 300 * MiB, W_WOUT = 308 * MiB,
    W_SMALL = 316 * MiB, W_R = 349 * MiB,
    W_XBC = W_R, W_Z = W_R + 390 * MiB, W_GM = W_R, W_GF = W_R + 130 * MiB, W_Q = W_R + 260 * MiB, W_K = W_Q + 130 * MiB, W_V = W_K + 130 * MiB,
    W_U = 203 * MiB, W_G = 553 * MiB, W_END = 999 * MiB;
static_assert((size_t)M * DM * 2 == 130 * MiB && (size_t)M * CD * 2 == 390 * MiB && (size_t)M * DI * 2 == 260 * MiB, "sizes");
static_assert(W_U + (size_t)HALF_ROWS * DFF2 * 2 <= W_G && W_G + (size_t)M * DFF * 2 <= 1024 * MiB, "ffn map");
static_assert(W_SMALL + (size_t)M * 256 * 4 <= W_R, "small map");

struct Prm { const float* in[31]; float* out; unsigned char* ws; };
typedef const __attribute__((address_space(4))) Prm* KPrm;
struct Ctx { int tid, bid, G; };
enum { I_XP = 0, I_XS, I_CP, I_CS, I_CK, I_CV, I_CLF, I_SSM, I_MCV, I_FCV, I_N1W, I_N2W, I_WADA, I_BADA, I_WIN, I_MCW, I_MCB, I_DTB, I_ALOG, I_MD, I_MNW,
       I_FB, I_QNW, I_KNW, I_WPM, I_WPF, I_WOUT, I_WUP, I_FCW, I_FCB, I_WDN };

__device__ __forceinline__ float bflo(unsigned w) { return __uint_as_float(w << 16); }
__device__ __forceinline__ float bfhi(unsigned w) { return __uint_as_float(w & 0xffff0000u); }
typedef float f32x2_t __attribute__((ext_vector_type(2))); typedef __bf16 bf16x2_t __attribute__((ext_vector_type(2)));
__device__ __forceinline__ unsigned pk2(float lo, float hi) { f32x2_t v = {lo, hi}; bf16x2_t b = __builtin_convertvector(v, bf16x2_t); return __builtin_bit_cast(unsigned, b); }
__device__ __forceinline__ u16 f2bf(float f) { return (u16)(pk2(f, 0.f) & 0xffffu); }
__device__ __forceinline__ void unpack8(u32x4 w, float* v) { v[0] = bflo(w.x); v[1] = bfhi(w.x); v[2] = bflo(w.y); v[3] = bfhi(w.y); v[4] = bflo(w.z); v[5] = bfhi(w.z); v[6] = bflo(w.w); v[7] = bfhi(w.w); }
__device__ __forceinline__ u32x4 pack8f(const float* v) { u32x4 w; w.x = pk2(v[0], v[1]); w.y = pk2(v[2], v[3]); w.z = pk2(v[4], v[5]); w.w = pk2(v[6], v[7]); return w; }
__device__ __forceinline__ float bfel(const u32x4& w, int e) { const unsigned x = w[e >> 1]; return (e & 1) ? bfhi(x) : bflo(x); }
__device__ __forceinline__ float sigmoidf_(float x) { return 1.f / (1.f + __expf(-x)); }
__device__ __forceinline__ float siluf_(float x) { return x / (1.f + __expf(-x)); }
__device__ __forceinline__ float wave_sum(float v) {
#pragma unroll
    for (int o = 1; o < 64; o <<= 1) v += __shfl_xor(v, o);
    return v;
}
__device__ __forceinline__ int mod_row(int row) { return row < MP ? (row >> 13) : 4 + ((row - MP) >> 6); }

struct Epi {
    static constexpr bool PERM = true, AFTER_DRAIN = false;
    int mode;
    u16* d0; u16* d1; u16* d2; int t1, t2, p0, p1, p2, f32seg2, vseg2; float* vout; u16* vslab;
    const float* xp; const float* xs; float* y; const float* mod; u16* gbuf; const u16* gf;
    __device__ __forceinline__ void operator()(const f32x4 (&acc)[2][2][4][2], const pg8::Unit& u, int wr, int wc, int fr, int fq) const {
        const int rl = u.pm * 256 + u.ho * 128 + wr * 64 + fr, cl = wc * 32 + 8 * fq;
        const int nai = u.half ? 1 : 2;
        if (mode == 0) {
            u16* base; int pitch, ct; bool f32o = false;
            if (u.pn < t1) { base = d0; pitch = p0; ct = u.pn; } else if (u.pn < t2) { base = d1; pitch = p1; ct = u.pn - t1; } else { base = d2; pitch = p2; ct = u.pn - t2; f32o = (f32seg2 != 0); }
            if (!f32o) {
#pragma unroll
                for (int ai = 0; ai < nai; ++ai)
#pragma unroll
                    for (int m = 0; m < 4; ++m) { u16* rp = base + (size_t)(rl + ai * 128 + m * 16) * pitch + ct * 256 + cl;
#pragma unroll
                        for (int bj = 0; bj < 2; ++bj) { const f32x4 v0 = acc[ai][bj][m][0], v1 = acc[ai][bj][m][1]; u32x4 w; w.x = pk2(v0[0], v0[1]); w.y = pk2(v0[2], v0[3]); w.z = pk2(v1[0], v1[1]); w.w = pk2(v1[2], v1[3]);
                            *(u32x4*)(rp + bj * 128) = w; } }
                if (vseg2 && u.pn >= t2) {
#pragma unroll
                    for (int ai = 0; ai < nai; ++ai)
#pragma unroll
                        for (int m = 0; m < 4; ++m) { const int row = rl + ai * 128 + m * 16; const int col = ct * 256 + cl;
                            float* vo = (row < MP) ? vout + (size_t)row * DM + col : vout + (O_VS - O_VP) + (size_t)(row - MP) * DM + col;
#pragma unroll
                            for (int bj = 0; bj < 2; ++bj) { *(f32x4*)(vo + bj * 128) = acc[ai][bj][m][0]; *(f32x4*)(vo + bj * 128 + 4) = acc[ai][bj][m][1]; }
                            if (row >= MP) { const int sb = (row - MP) >> 6, t = (row - MP) & 63; u16* sp = vslab + (size_t)(sb * SKVS + PAST + t) * DM + col;
#pragma unroll
                                for (int bj = 0; bj < 2; ++bj) { const f32x4 v0 = acc[ai][bj][m][0], v1 = acc[ai][bj][m][1]; u32x4 w; w.x = pk2(v0[0], v0[1]); w.y = pk2(v0[2], v0[3]); w.z = pk2(v1[0], v1[1]); w.w = pk2(v1[2], v1[3]);
                                    *(u32x4*)(sp + bj * 128) = w; } } }
                }
            } else {
                float* fb = (float*)base;
#pragma unroll
                for (int ai = 0; ai < nai; ++ai)
#pragma unroll
                    for (int m = 0; m < 4; ++m) { float* rp = fb + (size_t)(rl + ai * 128 + m * 16) * pitch + ct * 256 + cl;
#pragma unroll
                        for (int bj = 0; bj < 2; ++bj) { *(f32x4*)(rp + bj * 128) = acc[ai][bj][m][0]; *(f32x4*)(rp + bj * 128 + 4) = acc[ai][bj][m][1]; } }
            }
        } else if (mode == 1 || mode == 2) {
#pragma unroll
            for (int ai = 0; ai < nai; ++ai) {
                u32x4 gw[4][2], fw[4][2];
#pragma unroll
                for (int m = 0; m < 4; ++m) { const size_t off = (size_t)(rl + ai * 128 + m * 16) * DM + u.pn * 256 + cl;
#pragma unroll
                    for (int bj = 0; bj < 2; ++bj) { gw[m][bj] = *(const u32x4*)(gbuf + off + bj * 128); if (mode == 2) fw[m][bj] = *(const u32x4*)(gf + off + bj * 128); else fw[m][bj] = gw[m][bj]; } }
#pragma unroll
                for (int m = 0; m < 4; ++m) { const size_t off = (size_t)(rl + ai * 128 + m * 16) * DM + u.pn * 256 + cl;
#pragma unroll
                    for (int bj = 0; bj < 2; ++bj) { const f32x4 v0 = acc[ai][bj][m][0], v1 = acc[ai][bj][m][1];
                        float a[8] = {v0[0], v0[1], v0[2], v0[3], v1[0], v1[1], v1[2], v1[3]}, g[8], o[8];
                        unpack8(gw[m][bj], g);
                        if (mode == 1) {
#pragma unroll
                            for (int e = 0; e < 8; ++e) o[e] = sigmoidf_(g[e]) * a[e];
                        } else { float f[8]; unpack8(fw[m][bj], f);
#pragma unroll
                            for (int e = 0; e < 8; ++e) o[e] = g[e] + sigmoidf_(f[e]) * a[e]; }
                        *(u32x4*)(gbuf + off + bj * 128) = pack8f(o); } }
            }
        } else {
#pragma unroll
            for (int ai = 0; ai < nai; ++ai) {
                const int mb = (u.pm < 128) ? (u.pm >> 5) : (4 + (u.pm - 128) * 4 + u.ho * 2 + ai * 2 + wr);
                const float* gp = mod + (size_t)mb * NMOD + (mode == 3 ? 4096 : 10240) + u.pn * 256 + cl;
                f32x4 gv[2][2], pre[4][2][2];
#pragma unroll
                for (int m = 0; m < 4; ++m) { const int row = rl + ai * 128 + m * 16; const size_t off = (size_t)row * DM + u.pn * 256 + cl;
                    const float* xr = (mode == 3) ? ((row < MP) ? xp + off : xs + (off - (size_t)MP * DM)) : (const float*)(y + off);
#pragma unroll
                    for (int bj = 0; bj < 2; ++bj) { pre[m][bj][0] = *(const f32x4*)(xr + bj * 128); pre[m][bj][1] = *(const f32x4*)(xr + bj * 128 + 4); } }
#pragma unroll
                for (int bj = 0; bj < 2; ++bj) { gv[bj][0] = *(const f32x4*)(gp + bj * 128); gv[bj][1] = *(const f32x4*)(gp + bj * 128 + 4); }
#pragma unroll
                for (int m = 0; m < 4; ++m) { const int row = rl + ai * 128 + m * 16; const size_t off = (size_t)row * DM + u.pn * 256 + cl;
#pragma unroll
                    for (int bj = 0; bj < 2; ++bj) { *(f32x4*)(y + off + bj * 128) = pre[m][bj][0] + gv[bj][0] * acc[ai][bj][m][0]; *(f32x4*)(y + off + bj * 128 + 4) = pre[m][bj][1] + gv[bj][1] * acc[ai][bj][m][1]; } }
            }
        }
    }
};

__device__ __forceinline__ int map_in(int n) {
    if (n < 4096) return 6144 + n;
    if (n < 10240) return n - 4096;
    if (n < 10304) return 10240 + (n - 10240);
    if (n < 12352) return 14592 + (n - 10304);
    if (n < 14400) return 16640 + (n - 12352);
    if (n < 16448) return 18688 + (n - 14400);
    if (n < 16464) return 10304 + (n - 16448);
    if (n < 18512) return 10496 + (n - 16464);
    return 12544 + (n - 18512);
}
__device__ __forceinline__ int map_up(int n) { if (n < DFF) return (n >> 7) * 256 + (n & 127); const int f = n - DFF; return (f >> 7) * 256 + 128 + (f & 127); }
template <int MAP> __device__ __forceinline__ void tr_item(const float* __restrict__ W, int K, int N, u16* WT, float* scr, int item, int lane) {
    const int nblk = (N + 31) / 32, kb = item / nblk, nb = item % nblk, k0 = 64 * kb, n0 = 32 * nb;
    const int nn = n0 + (lane & 31);
    float tv[32];
#pragma unroll
    for (int i = 0; i < 32; ++i) { const int kk = 2 * i + (lane >> 5); tv[i] = (nn < N) ? W[(size_t)(k0 + kk) * N + nn] : 0.f; }
#pragma unroll
    for (int i = 0; i < 32; ++i) { const int kk = 2 * i + (lane >> 5); scr[kk * 33 + (lane & 31)] = tv[i]; }
    asm volatile("s_waitcnt lgkmcnt(0)" ::: "memory");
    const int c = lane & 7;
#pragma unroll
    for (int j = 0; j < 4; ++j) { const int n = (lane >> 3) + 8 * j; const float* s = scr + (8 * c) * 33 + n;
        if (n0 + n < N) { const int row = (MAP == 1) ? map_in(n0 + n) : (MAP == 2) ? map_up(n0 + n) : (n0 + n);
            u32x4 o; o.x = pk2(s[0 * 33], s[1 * 33]); o.y = pk2(s[2 * 33], s[3 * 33]); o.z = pk2(s[4 * 33], s[5 * 33]); o.w = pk2(s[6 * 33], s[7 * 33]);
            *(u32x4*)(WT + (size_t)row * K + k0 + 8 * c) = o; } }
    asm volatile("s_waitcnt lgkmcnt(0)" ::: "memory");
}
__device__ __forceinline__ void phase_prep(KPrm p, const Ctx cx, unsigned char* lds) {
    const int tid = cx.tid, lane = tid & 63, wid = tid >> 6, G = cx.G;
    unsigned char* ws = p->ws;
    {
        float* scr = (float*)(lds + wid * 8448);
        const int gw = cx.bid * 8 + wid, NGW = G * 8;
        constexpr int I_IN = 32 * 643, I_PM = 64 * 64, I_PF = 32 * 64, I_OUT = 32 * 64, I_UP = 32 * 344, I_DN = 86 * 64;
        constexpr int NIT = I_IN + I_PM + I_PF + I_OUT + I_UP + I_DN;
        for (int it = gw; it < NIT; it += NGW) {
            int r = it;
            if (r < I_IN) { tr_item<1>(p->in[I_WIN], DM, NIN, (u16*)(ws + W_WIN), scr, r, lane); continue; } r -= I_IN;
            if (r < I_PM) { tr_item<0>(p->in[I_WPM], DI, DM, (u16*)(ws + W_WPM), scr, r, lane); continue; } r -= I_PM;
            if (r < I_PF) { tr_item<0>(p->in[I_WPF], DM, DM, (u16*)(ws + W_WPF), scr, r, lane); continue; } r -= I_PF;
            if (r < I_OUT) { tr_item<0>(p->in[I_WOUT], DM, DM, (u16*)(ws + W_WOUT), scr, r, lane); continue; } r -= I_OUT;
            if (r < I_UP) { tr_item<2>(p->in[I_WUP], DM, DFF2, (u16*)(ws + W_WUP), scr, r, lane); continue; } r -= I_UP;
            tr_item<0>(p->in[I_WDN], DFF, DM, (u16*)(ws + W_WDN), scr, r, lane);
        }
    }
    __syncthreads();
    {
        float* sl = (float*)lds;
        float* red = (float*)(lds + 12 * 2048 * 4);
        for (int e = tid; e < 12 * 2048; e += 512) { const int b = e >> 11, i = e & 2047; const float cv = (b < 4) ? p->in[I_CP][b * 2048 + i] : p->in[I_CS][(b - 4) * 2048 + i]; sl[e] = siluf_(cv); }
        __syncthreads();
        const float* wada = p->in[I_WADA]; float* mod = (float*)(ws + W_MOD);
        const int col = tid & 31, part = tid >> 5;
        for (int item = cx.bid; item < NMOD / 32; item += G) {
            float acc[12];
#pragma unroll
            for (int b = 0; b < 12; ++b) acc[b] = 0.f;
            const float* wp = wada + (size_t)(part * 128) * NMOD + item * 32 + col;
#pragma unroll 8
            for (int d = 0; d < 128; ++d) { const float w = wp[(size_t)d * NMOD];
#pragma unroll
                for (int b = 0; b < 12; ++b) acc[b] += sl[b * 2048 + part * 128 + d] * w; }
#pragma unroll
            for (int b = 0; b < 12; ++b) red[(part * 12 + b) * 32 + col] = acc[b];
            __syncthreads();
            if (tid < 384) { const int b = tid >> 5; float s = p->in[I_BADA][item * 32 + col];
#pragma unroll
                for (int q = 0; q < 16; ++q) s += red[(q * 12 + b) * 32 + col];
                mod[b * NMOD + item * 32 + col] = s; }
            __syncthreads();
        }
    }
    {
        u16* Ks = (u16*)p->out; u16* Vs = Ks + (size_t)NBS * SKVS * DM;
        const size_t tot8 = (size_t)NBS * PAST * DM / 8, gt = (size_t)cx.bid * 512 + tid, GT = (size_t)G * 512;
        for (size_t i0 = gt; i0 < 2 * tot8; i0 += 4 * GT) {
            f32x4 a[4], b[4]; size_t dsto[4]; bool ok[4]; int wh[4];
#pragma unroll
            for (int u = 0; u < 4; ++u) { const size_t i = i0 + (size_t)u * GT; ok[u] = i < 2 * tot8; const size_t ii = ok[u] ? i : 0; wh[u] = ii >= tot8; const size_t j = ii - (wh[u] ? tot8 : 0);
                const size_t sb = j / ((size_t)PAST * 256), rem = j % ((size_t)PAST * 256), row = rem >> 8, c8 = rem & 255;
                const float* src = p->in[wh[u] ? I_CV : I_CK] + ((sb * PAST + row) * DM + c8 * 8);
                a[u] = *(const f32x4*)src; b[u] = *(const f32x4*)(src + 4); dsto[u] = (sb * SKVS + row) * DM + c8 * 8; }
#pragma unroll
            for (int u = 0; u < 4; ++u) if (ok[u]) { u32x4 o; o.x = pk2(a[u][0], a[u][1]); o.y = pk2(a[u][2], a[u][3]); o.z = pk2(b[u][0], b[u][1]); o.w = pk2(b[u][2], b[u][3]);
                *(u32x4*)((wh[u] ? Vs : Ks) + dsto[u]) = o; }
        }
    }
}
__device__ __forceinline__ void phase_norm(KPrm p, const Ctx cx, int which) {
    const int tid = cx.tid, lane = tid & 63, wid = tid >> 6;
    const int gw = cx.bid * 8 + wid, NGW = cx.G * 8;
    const float* mod = (const float*)(p->ws + W_MOD); u16* H = (u16*)(p->ws + W_H);
    const float* nw = p->in[which ? I_N2W : I_N1W];
    const int osh = which ? 6144 : 0, osc = which ? 8192 : 2048;
    for (int row0 = 2 * gw; row0 < M; row0 += 2 * NGW) {
        f32x4 v[2][8];
#pragma unroll
        for (int rr = 0; rr < 2; ++rr) { const int row = row0 + rr;
            const float* xr = which ? (p->out + (size_t)row * DM) : ((row < MP) ? p->in[I_XP] + (size_t)row * DM : p->in[I_XS] + (size_t)(row - MP) * DM);
#pragma unroll
            for (int j = 0; j < 8; ++j) v[rr][j] = ((const f32x4*)xr)[lane + 64 * j]; }
#pragma unroll
        for (int rr = 0; rr < 2; ++rr) { const int row = row0 + rr;
            const float* mr = mod + (size_t)mod_row(row) * NMOD;
            float ss = 0.f;
#pragma unroll
            for (int j = 0; j < 8; ++j) ss += (v[rr][j][0] * v[rr][j][0] + v[rr][j][1] * v[rr][j][1]) + (v[rr][j][2] * v[rr][j][2] + v[rr][j][3] * v[rr][j][3]);
            const float rs = rsqrtf(wave_sum(ss) * (1.f / DM) + EPS);
#pragma unroll
            for (int j = 0; j < 8; ++j) { const int col = 4 * (lane + 64 * j);
                const f32x4 w = *(const f32x4*)(nw + col), sc = *(const f32x4*)(mr + osc + col), sh = *(const f32x4*)(mr + osh + col);
                const f32x4 o = v[rr][j] * rs * w * (sc + 1.f) + sh;
                u32x2 q; q.x = pk2(o[0], o[1]); q.y = pk2(o[2], o[3]);
                *(u32x2*)(H + (size_t)row * DM + col) = q; } }
    }
}
__device__ __forceinline__ void phase_conv(KPrm p, const Ctx cx) {
    const u16* XBC = (const u16*)(p->ws + W_XBC); u16* ACT = (u16*)(p->out + O_KP);
    const float* cw = p->in[I_MCW]; const float* cb = p->in[I_MCB];
    {
                const int gt2 = cx.bid * 512 + cx.tid, GT2 = cx.G * 512;
        for (int i = gt2; i < 12 * 3 * CD; i += GT2) { const int bb = i / (3 * CD), r = (i / CD) % 3, c = i % CD;
            if (bb < 4) p->out[O_MCP + i] = bflo(XBC[(size_t)(bb * TP + TP - 3 + r) * CD + c]);
            else p->out[O_MCS + (i - 4 * 3 * CD)] = bflo(XBC[(size_t)(MP + (bb - 4) * TS + TS - 3 + r) * CD + c]); }
    }
    constexpr int NCG = CD / 8, RB = 16, NRB = M / RB;
    const long gt = (long)cx.bid * 512 + cx.tid, GT = (long)cx.G * 512;
    for (long it = gt; it < (long)NCG * NRB; it += GT) {
        const int cgi = (int)(it % NCG), rb = (int)(it / NCG), c0 = cgi * 8, r0 = rb * RB;
        float w[4][8], bs[8];
#pragma unroll
        for (int j = 0; j < 4; ++j) { const f32x4 a0 = *(const f32x4*)(cw + j * CD + c0), a1 = *(const f32x4*)(cw + j * CD + c0 + 4);
#pragma unroll
            for (int e = 0; e < 4; ++e) { w[j][e] = a0[e]; w[j][4 + e] = a1[e]; } }
        { const f32x4 a0 = *(const f32x4*)(cb + c0), a1 = *(const f32x4*)(cb + c0 + 4);
#pragma unroll
          for (int e = 0; e < 4; ++e) { bs[e] = a0[e]; bs[4 + e] = a1[e]; } }
        float h[3][8];
        const bool smp = r0 >= MP; const int tb = smp ? ((r0 - MP) & 63) : (r0 & (TP - 1));
        if (tb == 0) {
            if (smp) { const float* s = p->in[I_MCV] + (size_t)((r0 - MP) >> 6) * 3 * CD + c0;
#pragma unroll
                for (int k = 0; k < 3; ++k)
#pragma unroll
                    for (int e = 0; e < 8; ++e) h[k][e] = s[k * CD + e];
            } else {
#pragma unroll
                for (int k = 0; k < 3; ++k)
#pragma unroll
                    for (int e = 0; e < 8; ++e) h[k][e] = 0.f; }
        } else {
#pragma unroll
            for (int k = 0; k < 3; ++k) unpack8(*(const u32x4*)(XBC + (size_t)(r0 - 3 + k) * CD + c0), h[k]);
        }
        u32x4 ur[RB];
#pragma unroll
        for (int i = 0; i < RB; ++i) ur[i] = *(const u32x4*)(XBC + (size_t)(r0 + i) * CD + c0);
#pragma unroll
        for (int i = 0; i < RB; ++i) { float u[8], o[8]; unpack8(ur[i], u);
#pragma unroll
            for (int e = 0; e < 8; ++e) { const float v = bs[e] + w[0][e] * h[0][e] + w[1][e] * h[1][e] + w[2][e] * h[2][e] + w[3][e] * u[e];
                o[e] = siluf_(v); h[0][e] = h[1][e]; h[1][e] = h[2][e]; h[2][e] = u[e]; }
            *(u32x4*)(ACT + (size_t)(r0 + i) * CD + c0) = pack8f(o); }
    }
}
constexpr int SXP = 72, SNP = 136, SYP = 68;
constexpr int L_XT = 0, L_CN = L_XT + 64 * SXP * 2, L_BN = L_CN + 64 * SNP * 2, L_BWT = L_BN + 64 * SNP * 2, L_MS = L_BWT + 128 * SXP * 2, L_HS = L_MS + 64 * SXP * 2,
              L_YS = L_HS + 64 * SNP * 2, L_DT = L_YS + 64 * SYP * 4, L_CUM = L_DT + 256, L_SSD_END = L_CUM + 256;
static_assert(L_SSD_END <= 131072, "ssd lds");
__device__ __forceinline__ void phase_ssd(KPrm p, const Ctx cx, unsigned char* lds) {
    const int tid = cx.tid, lane = tid & 63, wid = __builtin_amdgcn_readfirstlane(tid >> 6), quad = lane >> 4, l15 = lane & 15;
    u16* XT = (u16*)(lds + L_XT); u16* CN = (u16*)(lds + L_CN); u16* BN = (u16*)(lds + L_BN); u16* BWT = (u16*)(lds + L_BWT);
    u16* MSm = (u16*)(lds + L_MS); u16* HS = (u16*)(lds + L_HS); float* YS = (float*)(lds + L_YS); float* DT = (float*)(lds + L_DT); float* CUM = (float*)(lds + L_CUM);
    const u16* XBC = (const u16*)(p->out + O_KP);     u16* Z = (u16*)(p->ws + W_Z); const float* SM = (const float*)(p->ws + W_SMALL);
    const int cg8 = tid & 31, tq = tid >> 5, cgx = tid & 7, tx = tid >> 3;
    const int pb = wid >> 1;
    for (int ch = cx.bid; ch < 256 + 512; ch += cx.G) {
        const bool smp = ch >= 256; int b, hd, nc; long rowbase;
        if (!smp) { b = ch >> 6; hd = ch & 63; nc = TP / 64; rowbase = (long)b * TP; } else { const int su = ch - 256; b = su >> 6; hd = su & 63; nc = 1; rowbase = MP + (long)b * TS; }
        const int g = hd >> 3;
        const float a_h = -__expf(p->in[I_ALOG][hd]), dtb = p->in[I_DTB][hd], Dh = p->in[I_MD][hd];
        const int bccol = (cg8 < 16) ? (4096 + g * 128 + cg8 * 8) : (5120 + g * 128 + (cg8 - 16) * 8);
        const int xcol = hd * 64 + cgx * 8;
        f32x4 st[4];
        const int st_off = (pb * 16 + quad * 4) * 128 + (4 * (wid & 1)) * 16 + l15, hs_off = (pb * 16 + quad * 4) * SNP + (4 * (wid & 1)) * 16 + l15;
        { const float* sin_ = p->in[I_SSM] + ((size_t)b * 64 + hd) * 64 * 128 + st_off;
#pragma unroll
          for (int i = 0; i < 4; ++i)
#pragma unroll
            for (int j = 0; j < 4; ++j) st[i][j] = smp ? sin_[j * 128 + i * 16] : 0.f; }
        __syncthreads();
        { u16* hp_ = HS + hs_off;
#pragma unroll
          for (int i = 0; i < 4; ++i)
#pragma unroll
            for (int j = 0; j < 4; ++j) hp_[j * SNP + i * 16] = f2bf(st[i][j]); }
        u32x4 rbcA[4], rxA, znA, rbcB[4], rxB, znB, pend = {0u, 0u, 0u, 0u}; float dtrA = 0.f, dtrB = 0.f;
#define SSD_LOADS(cc, rbc, rx, zn, dtr) do { const int t0_ = (cc) * 64; \
            const u16* pb_ = XBC + (rowbase + t0_ + 4 * tq) * (long)CD + bccol; const u16* px_ = XBC + (rowbase + t0_ + tx) * (long)CD + xcol; \
            asm volatile("" : "+v"(pb_), "+v"(px_));     \
            _Pragma("unroll") for (int i = 0; i < 4; ++i) rbc[i] = *(const u32x4*)(pb_ + i * CD); \
            rx = *(const u32x4*)px_; \
            zn = *(const u32x4*)(Z + (size_t)(rowbase + t0_ + tx) * DI + xcol); \
            dtr = SM[(size_t)(rowbase + t0_ + lane) * 256 + hd]; } while (0)
#define LBAR() do { asm volatile("s_waitcnt lgkmcnt(0)" ::: "memory"); __builtin_amdgcn_s_barrier(); asm volatile("" ::: "memory"); } while (0)
        SSD_LOADS(0, rbcA, rxA, znA, dtrA); if (nc > 1) SSD_LOADS(1, rbcB, rxB, znB, dtrB);
        auto body = [&](const int c, u32x4 (&rbc)[4], u32x4& rx, u32x4& zn, float& dtr) __attribute__((always_inline)) {
            const long r0 = rowbase + (long)c * 64;
            const u32x4 zw = zn;
            float cum_end;
            { const float dr = dtr + dtb; const float dtv = dr > 20.f ? dr : __logf(1.f + __expf(dr));
              float x = dtv * a_h;
#define DPP_ADD(ctrl, rmask) x += __int_as_float(__builtin_amdgcn_update_dpp(0, __float_as_int(x), ctrl, rmask, 0xf, true))
              DPP_ADD(0x111, 0xf); DPP_ADD(0x112, 0xf); DPP_ADD(0x114, 0xf); DPP_ADD(0x118, 0xf);
              DPP_ADD(0x142, 0xa);
              DPP_ADD(0x143, 0xc);
#undef DPP_ADD
              DT[lane] = dtv; CUM[lane] = x; cum_end = __int_as_float(__builtin_amdgcn_readlane(__float_as_int(x), 63)); }
            {
                u16* NAT = (cg8 < 16) ? BN : CN; const int nc0 = (cg8 & 15) * 8;
#pragma unroll
                for (int ii = 0; ii < 4; ++ii) *(u32x4*)(NAT + (4 * tq + ii) * SNP + nc0) = rbc[ii];
                if (cg8 < 16) {
                    float wg[4]; const f32x4 dt4 = *(const f32x4*)(DT + 4 * tq), cu4 = *(const f32x4*)(CUM + 4 * tq);
#pragma unroll
                    for (int ii = 0; ii < 4; ++ii) wg[ii] = dt4[ii] * __expf(cum_end - cu4[ii]);
#pragma unroll
                    for (int e = 0; e < 8; ++e) { u32x2 q; q.x = pk2(bfel(rbc[0], e) * wg[0], bfel(rbc[1], e) * wg[1]); q.y = pk2(bfel(rbc[2], e) * wg[2], bfel(rbc[3], e) * wg[3]);
                        *(u32x2*)(BWT + (nc0 + e) * SXP + 4 * tq) = q; }
                }
            }
            float xv[8]; unpack8(rx, xv);
#pragma unroll
            for (int e = 0; e < 8; ++e) XT[(cgx * 8 + e) * SXP + tx] = (u16)((e & 1) ? (rx[e >> 1] >> 16) : (rx[e >> 1] & 0xffffu));
            LBAR();
            if (c > 0) *(u32x4*)(Z + (size_t)(r0 - 64 + tx) * DI + xcol) = pend;
            if (c + 2 < nc) SSD_LOADS(c + 2, rbc, rx, zn, dtr);
            const int ti = wid >> 1;
            f32x4 yo[2];
            {
                bf16x8 ca[4], bb[2][4], hb[2][4];
#pragma unroll
                for (int kk = 0; kk < 4; ++kk) ca[kk] = *(const bf16x8*)(CN + (ti * 16 + l15) * SNP + kk * 32 + quad * 8);
#pragma unroll
                for (int s2 = 0; s2 < 2; ++s2)
#pragma unroll
                    for (int kk = 0; kk < 4; ++kk) { bb[s2][kk] = *(const bf16x8*)(BN + ((2 * (wid & 1) + s2) * 16 + l15) * SNP + kk * 32 + quad * 8);
                        hb[s2][kk] = *(const bf16x8*)(HS + ((2 * (wid & 1) + s2) * 16 + l15) * SNP + kk * 32 + quad * 8); }
                const f32x4 ct4 = *(const f32x4*)(CUM + ti * 16 + quad * 4);
                float cs[2], ds[2];
#pragma unroll
                for (int s2 = 0; s2 < 2; ++s2) { const int sx = (2 * (wid & 1) + s2) * 16 + l15; cs[s2] = CUM[sx]; ds[s2] = DT[sx]; }
                f32x4 ga[2] = {{0.f, 0.f, 0.f, 0.f}, {0.f, 0.f, 0.f, 0.f}}; yo[0] = (f32x4){0.f, 0.f, 0.f, 0.f}; yo[1] = (f32x4){0.f, 0.f, 0.f, 0.f};
#pragma unroll
                for (int kk = 0; kk < 4; ++kk) {
                    ga[0] = __builtin_amdgcn_mfma_f32_16x16x32_bf16(ca[kk], bb[0][kk], ga[0], 0, 0, 0); ga[1] = __builtin_amdgcn_mfma_f32_16x16x32_bf16(ca[kk], bb[1][kk], ga[1], 0, 0, 0);
                    yo[0] = __builtin_amdgcn_mfma_f32_16x16x32_bf16(ca[kk], hb[0][kk], yo[0], 0, 0, 0); yo[1] = __builtin_amdgcn_mfma_f32_16x16x32_bf16(ca[kk], hb[1][kk], yo[1], 0, 0, 0); }
#pragma unroll
                for (int s2 = 0; s2 < 2; ++s2) { const int s_ = (2 * (wid & 1) + s2) * 16 + l15;
#pragma unroll
                    for (int j = 0; j < 4; ++j) { const int t = ti * 16 + quad * 4 + j; const float msk = (s_ <= t) ? ds[s2] : 0.f;
                        const float val = ga[s2][j] * __expf(fminf(ct4[j] - cs[s2], 0.f)) * msk; MSm[t * SXP + s_] = f2bf(val); } }
#pragma unroll
                for (int p2 = 0; p2 < 2; ++p2)
#pragma unroll
                    for (int j = 0; j < 4; ++j) yo[p2][j] *= __expf(ct4[j]);
            }
            LBAR();
            {
                bf16x8 ma[2], xa[2], xb[2][2], wb[4][2];
#pragma unroll
                for (int kk = 0; kk < 2; ++kk) { ma[kk] = *(const bf16x8*)(MSm + (ti * 16 + l15) * SXP + kk * 32 + quad * 8); xa[kk] = *(const bf16x8*)(XT + (pb * 16 + l15) * SXP + kk * 32 + quad * 8);
#pragma unroll
                    for (int p2 = 0; p2 < 2; ++p2) xb[p2][kk] = *(const bf16x8*)(XT + ((2 * (wid & 1) + p2) * 16 + l15) * SXP + kk * 32 + quad * 8);
#pragma unroll
                    for (int i = 0; i < 4; ++i) wb[i][kk] = *(const bf16x8*)(BWT + ((4 * (wid & 1) + i) * 16 + l15) * SXP + kk * 32 + quad * 8); }
                const float dec = __expf(cum_end);
#pragma unroll
                for (int i = 0; i < 4; ++i) st[i] = st[i] * dec;
#pragma unroll
                for (int kk = 0; kk < 2; ++kk) {
                    yo[0] = __builtin_amdgcn_mfma_f32_16x16x32_bf16(ma[kk], xb[0][kk], yo[0], 0, 0, 0); yo[1] = __builtin_amdgcn_mfma_f32_16x16x32_bf16(ma[kk], xb[1][kk], yo[1], 0, 0, 0);
#pragma unroll
                    for (int i = 0; i < 4; ++i) st[i] = __builtin_amdgcn_mfma_f32_16x16x32_bf16(xa[kk], wb[i][kk], st[i], 0, 0, 0); }
#pragma unroll
                for (int p2 = 0; p2 < 2; ++p2)
#pragma unroll
                    for (int j = 0; j < 4; ++j) YS[(ti * 16 + quad * 4 + j) * SYP + (2 * (wid & 1) + p2) * 16 + l15] = yo[p2][j];
                u16* hp_ = HS + hs_off;
#pragma unroll
                for (int i = 0; i < 4; ++i)
#pragma unroll
                    for (int j = 0; j < 4; ++j) hp_[j * SNP + i * 16] = f2bf(st[i][j]);
            }
            LBAR();
            {
                const f32x4 y0 = *(const f32x4*)(YS + tx * SYP + cgx * 8), y1 = *(const f32x4*)(YS + tx * SYP + cgx * 8 + 4);
                float zf[8], o[8]; unpack8(zw, zf);
#pragma unroll
                for (int e = 0; e < 8; ++e) { const float yv = (e < 4 ? y0[e & 3] : y1[e & 3]) + Dh * xv[e]; o[e] = yv * siluf_(zf[e]); }
                pend = pack8f(o);
            }
        };
        for (int c = 0; c < nc; c += 2) { body(c, rbcA, rxA, znA, dtrA); if (c + 1 < nc) body(c + 1, rbcB, rxB, znB, dtrB); }
        *(u32x4*)(Z + (size_t)(rowbase + (long)(nc - 1) * 64 + tx) * DI + xcol) = pend;
#undef SSD_LOADS
#undef LBAR
        float* so = p->out + (smp ? O_SSMS : O_SSMP) + ((size_t)b * 64 + hd) * 64 * 128 + st_off;
#pragma unroll
        for (int i = 0; i < 4; ++i)
#pragma unroll
            for (int j = 0; j < 4; ++j) so[j * 128 + i * 16] = st[i][j];
        __syncthreads();
    }
}
__device__ __forceinline__ float logsig_(float f) { return fminf(f, 0.f) - log1pf(__expf(-fabsf(f))); }
__device__ __forceinline__ void phase_gn(KPrm p, const Ctx cx) {
    const int tid = cx.tid, lane = tid & 63, wid = tid >> 6;
    const int gw = cx.bid * 8 + wid, NGW = cx.G * 8;
    const float* SM = (const float*)(p->ws + W_SMALL);
    if (gw < 192) {
        if (gw < 64) { const int b = gw >> 4, h = gw & 15; const float fb = p->in[I_FB][h];
            float* bias = (float*)(p->ws + W_BIASP) + (size_t)(b * 16 + h) * TP; float* lo = p->out + O_LFP;
            const int tb = lane * 128; float s = 0.f;
            for (int i = 0; i < 128; ++i) s += logsig_(SM[(size_t)(b * TP + tb + i) * 256 + 64 + h] + fb);
            float inc = s;
#pragma unroll
            for (int o = 1; o < 64; o <<= 1) { const float y = __shfl_up(inc, o); if (lane >= o) inc += y; }
            float run = inc - s;
            for (int i = 0; i < 128; ++i) { const float lf = logsig_(SM[(size_t)(b * TP + tb + i) * 256 + 64 + h] + fb); run += lf;
                lo[(size_t)(b * TP + tb + i) * 16 + h] = lf; bias[tb + i] = -run * LOG2E; }
        } else { const int u = gw - 64, sb = u >> 4, h = u & 15; const float fb = p->in[I_FB][h];
            float* bias = (float*)(p->ws + W_BIASS) + (size_t)(sb * 16 + h) * SKVS; float* lo = p->out + O_LFS;
            const int tb = lane * 33; float s = 0.f;
            for (int i = 0; i < 33; ++i) { const int pos = tb + i;
                s += (pos < PAST) ? p->in[I_CLF][(size_t)(sb * PAST + pos) * 16 + h] : logsig_(SM[(size_t)(MP + sb * TS + pos - PAST) * 256 + 64 + h] + fb); }
            float inc = s;
#pragma unroll
            for (int o = 1; o < 64; o <<= 1) { const float y = __shfl_up(inc, o); if (lane >= o) inc += y; }
            float run = inc - s;
            for (int i = 0; i < 33; ++i) { const int pos = tb + i; float lf;
                if (pos < PAST) lf = p->in[I_CLF][(size_t)(sb * PAST + pos) * 16 + h];
                else { lf = logsig_(SM[(size_t)(MP + sb * TS + pos - PAST) * 256 + 64 + h] + fb); lo[(size_t)(sb * TS + pos - PAST) * 16 + h] = lf; }
                run += lf; bias[pos] = -run * LOG2E; }
        }
    }
    u16* Z = (u16*)(p->ws + W_Z); const float* mnw = p->in[I_MNW];
    for (int row = gw; row < M; row += NGW) {
        u32x4 zr[8];
#pragma unroll
        for (int i = 0; i < 8; ++i) zr[i] = *(const u32x4*)(Z + (size_t)row * DI + i * 512 + lane * 8);
#pragma unroll
        for (int i = 0; i < 8; ++i) { const int col = i * 512 + lane * 8; u16* zp = Z + (size_t)row * DI + col;
            float v[8]; unpack8(zr[i], v); float ss = 0.f;
#pragma unroll
            for (int e = 0; e < 8; ++e) ss += v[e] * v[e];
            const float rs = rsqrtf(wave_sum(ss) * (1.f / 512.f) + EPS);
            const f32x4 w0 = *(const f32x4*)(mnw + col), w1 = *(const f32x4*)(mnw + col + 4);
#pragma unroll
            for (int e = 0; e < 8; ++e) v[e] = v[e] * rs * (e < 4 ? w0[e & 3] : w1[e & 3]);
            *(u32x4*)zp = pack8f(v); }
    }
}
__device__ __forceinline__ void phase_qk(KPrm p, const Ctx cx) {
    const int tid = cx.tid, lane = tid & 63, wid = tid >> 6;
    const int gw = cx.bid * 8 + wid, NGW = cx.G * 8;
    u16* K = (u16*)(p->ws + W_K);
    u16* Ks = (u16*)p->out;
    const int hc = (lane & 15) * 8;
    const f32x4 kw0 = *(const f32x4*)(p->in[I_KNW] + hc), kw1 = *(const f32x4*)(p->in[I_KNW] + hc + 4);
    for (int row = gw; row < M; row += NGW) {
        const bool smp = row >= MP;
        float* ko = smp ? p->out + O_KS + (size_t)(row - MP) * DM : p->out + O_KP + (size_t)row * DM;
        size_t srow = 0; if (smp) { const int sb = (row - MP) >> 6, t = (row - MP) & 63; srow = (size_t)(sb * SKVS + PAST + t) * DM; }
        u32x4 kr_[4];
#pragma unroll
        for (int it = 0; it < 4; ++it) { const size_t off = (size_t)row * DM + it * 512 + lane * 8; kr_[it] = *(const u32x4*)(K + off); }
#pragma unroll
        for (int it = 0; it < 4; ++it) { const int col = it * 512 + lane * 8; const size_t off = (size_t)row * DM + col;
            float v[8], ss;
            unpack8(kr_[it], v); ss = 0.f;
#pragma unroll
            for (int e = 0; e < 8; ++e) ss += v[e] * v[e];
            ss += __shfl_xor(ss, 1); ss += __shfl_xor(ss, 2); ss += __shfl_xor(ss, 4); ss += __shfl_xor(ss, 8);
            const float rs = rsqrtf(ss * (1.f / 128.f) + EPS);
#pragma unroll
            for (int e = 0; e < 8; ++e) v[e] = v[e] * rs * (e < 4 ? kw0[e & 3] : kw1[e & 3]);
            const u32x4 kp = pack8f(v);
            *(u32x4*)(K + off) = kp;
            *(f32x4*)(ko + col) = (f32x4){v[0], v[1], v[2], v[3]}; *(f32x4*)(ko + col + 4) = (f32x4){v[4], v[5], v[6], v[7]};
            if (smp) *(u32x4*)(Ks + srow + col) = kp; }
    }
}
typedef att::BlockRef<att::bf16, att::bf16> ARef;
__device__ __forceinline__ ARef att_ref(KPrm p, const Ctx cx, int i, int nbp, int& skv) {
    const int G = cx.G, bid = (cx.G % 8 == 0) ? (cx.bid % 8) * (cx.G / 8) + cx.bid / 8 : cx.bid; ARef r;
    att::bf16* Qb = (att::bf16*)(p->ws + W_Q); const att::bf16* Kb = (const att::bf16*)(p->ws + W_K); const att::bf16* Vb = (const att::bf16*)(p->ws + W_V);
    if (i < nbp) { const int L = bid + (i >> 1) * G, bh = L >> 4, x = L & 15, qb = (i & 1) ? 31 - x : x, b = bh >> 4, h = bh & 15;
        const size_t rq = ((size_t)b * TP + (size_t)qb * 256) * DM + h * 128, rk = (size_t)b * TP * DM + h * 128;
        r.Q = Qb + rq; r.O = Qb + rq; r.K = Kb + rk; r.V = Vb + rk; r.Bs = (const float*)(p->ws + W_BIASP) + (size_t)bh * TP; r.P0 = qb * 256; r.nvalid = 256; skv = TP;
    } else { const int su = bid + (i - nbp) * G, sb = su >> 4, h = su & 15;
        const att::bf16* Ks = (const att::bf16*)p->out; const att::bf16* Vs = Ks + (size_t)NBS * SKVS * DM;
        const size_t rq = ((size_t)MP + (size_t)sb * TS) * DM + h * 128, rk = (size_t)sb * SKVS * DM + h * 128;
        r.Q = Qb + rq; r.O = Qb + rq; r.K = Ks + rk; r.V = Vs + rk; r.Bs = (const float*)(p->ws + W_BIASS) + (size_t)su * SKVS; r.P0 = PAST; r.nvalid = TS; skv = SKVS; }
    return r;
}
__device__ __forceinline__ void phase_att(KPrm p, const Ctx cx, char* lds) {
    const int G = cx.G, bid = (cx.G % 8 == 0) ? (cx.bid % 8) * (cx.G / 8) + cx.bid / 8 : cx.bid;
    const int nip = (bid < 1024) ? (1024 - bid + G - 1) / G : 0, nbp = 2 * nip, nbs = (bid < 128) ? (128 - bid + G - 1) / G : 0, nb = nbp + nbs;
    if (nb == 0) return;
    const int W = 1 << 30;
    int skv, skvn; ARef cur = att_ref(p, cx, 0, nbp, skv);
    att::Seam<att::bf16> S;
    att::causal_swa_prime<att::bf16, att::bf16>(cur, W, lds, S, cx.tid);
    for (int i = 0; i < nb; ++i) {
        const bool last = (i + 1 == nb);
        ARef nxt = cur; skvn = skv; if (!last) nxt = att_ref(p, cx, i + 1, nbp, skvn);
        att::causal_swa_block<att::bf16, att::bf16>(cur, nxt, skv, W, lds, S, cx.tid, p->in[I_QNW], 0.08838834764831845f * LOG2E);
        cur = nxt; skv = skvn;
    }
}
__device__ __forceinline__ void phase_cv(KPrm p, const Ctx cx, int half) {
    const int tid = cx.tid;
    const u16* U = (const u16*)(p->ws + W_U); u16* Gb = (u16*)(p->ws + W_G); u16* HALO = (u16*)(p->ws + W_HALO);
    const float* cw = p->in[I_FCW]; const float* cb = p->in[I_FCB];
    const int row_lo = half ? HALF_ROWS : 0;
    constexpr int NCG = DFF / 8, RB = 16, NRB = HALF_ROWS / RB;
    const long gt = (long)cx.bid * 512 + tid, GT = (long)cx.G * 512;
    for (long it = gt; it < (long)NCG * NRB; it += GT) {
        const int cgi = (int)(it % NCG), rb = (int)(it / NCG); const int f0 = cgi * 8, r0 = row_lo + rb * RB;
        const int ca = (f0 >> 7) * 256 + (f0 & 127), cbb = ca + 128;
        float wa[3][8], wb[3][8], ba[8], bb[8];
#pragma unroll
        for (int k = 0; k < 3; ++k) { const f32x4 a0 = *(const f32x4*)(cw + k * DFF2 + f0), a1 = *(const f32x4*)(cw + k * DFF2 + f0 + 4), b0 = *(const f32x4*)(cw + k * DFF2 + DFF + f0), b1 = *(const f32x4*)(cw + k * DFF2 + DFF + f0 + 4);
#pragma unroll
            for (int e = 0; e < 4; ++e) { wa[k][e] = a0[e]; wa[k][4 + e] = a1[e]; wb[k][e] = b0[e]; wb[k][4 + e] = b1[e]; } }
        { const f32x4 a0 = *(const f32x4*)(cb + f0), a1 = *(const f32x4*)(cb + f0 + 4), b0 = *(const f32x4*)(cb + DFF + f0), b1 = *(const f32x4*)(cb + DFF + f0 + 4);
#pragma unroll
          for (int e = 0; e < 4; ++e) { ba[e] = a0[e]; ba[4 + e] = a1[e]; bb[e] = b0[e]; bb[4 + e] = b1[e]; } }
        float ha[2][8], hb[2][8];
        const bool smp = r0 >= MP; const int tb = smp ? ((r0 - MP) & 63) : (r0 & (TP - 1));
        if (tb == 0) {
            if (smp) { const float* s = p->in[I_FCV] + (size_t)((r0 - MP) >> 6) * 2 * DFF2;
#pragma unroll
                for (int k = 0; k < 2; ++k)
#pragma unroll
                    for (int e = 0; e < 8; ++e) { ha[k][e] = s[k * DFF2 + f0 + e]; hb[k][e] = s[k * DFF2 + DFF + f0 + e]; }
            } else {
#pragma unroll
                for (int k = 0; k < 2; ++k)
#pragma unroll
                    for (int e = 0; e < 8; ++e) { ha[k][e] = 0.f; hb[k][e] = 0.f; } }
        } else if (half && rb == 0) {
#pragma unroll
            for (int k = 0; k < 2; ++k) { unpack8(*(const u32x4*)(HALO + (size_t)k * DFF2 + ca), ha[k]); unpack8(*(const u32x4*)(HALO + (size_t)k * DFF2 + cbb), hb[k]); }
        } else {
#pragma unroll
            for (int k = 0; k < 2; ++k) { const size_t ro = (size_t)(r0 - row_lo - 2 + k) * DFF2; unpack8(*(const u32x4*)(U + ro + ca), ha[k]); unpack8(*(const u32x4*)(U + ro + cbb), hb[k]); }
        }
#pragma unroll 8
        for (int i = 0; i < RB; ++i) { const int r = r0 + i; const size_t ro = (size_t)(r - row_lo) * DFF2;
            const u32x4 uaw = *(const u32x4*)(U + ro + ca), ubw = *(const u32x4*)(U + ro + cbb);
            float ua[8], ub[8], o[8]; unpack8(uaw, ua); unpack8(ubw, ub);
#pragma unroll
            for (int e = 0; e < 8; ++e) { const float va = ba[e] + wa[0][e] * ha[0][e] + wa[1][e] * ha[1][e] + wa[2][e] * ua[e], vb = bb[e] + wb[0][e] * hb[0][e] + wb[1][e] * hb[1][e] + wb[2][e] * ub[e];
                o[e] = siluf_(va) * vb; ha[0][e] = ha[1][e]; ha[1][e] = ua[e]; hb[0][e] = hb[1][e]; hb[1][e] = ub[e]; }
            *(u32x4*)(Gb + (size_t)r * DFF + f0) = pack8f(o);
            const int tpos = (r >= MP) ? ((r - MP) & 63) : (r & (TP - 1)), tlen = (r >= MP) ? TS : TP;
            if (tpos >= tlen - 2) { float* fo = (r >= MP) ? p->out + O_FCS + ((size_t)((r - MP) >> 6) * 2 + (tpos - (tlen - 2))) * DFF2 : p->out + O_FCP + ((size_t)(r >> 13) * 2 + (tpos - (tlen - 2))) * DFF2;
#pragma unroll
                for (int e = 0; e < 8; ++e) { fo[f0 + e] = ua[e]; fo[DFF + f0 + e] = ub[e]; } }
            if (!half && r >= HALF_ROWS - 2) { *(u32x4*)(HALO + (size_t)(r - (HALF_ROWS - 2)) * DFF2 + ca) = uaw; *(u32x4*)(HALO + (size_t)(r - (HALF_ROWS - 2)) * DFF2 + cbb) = ubw; }
        }
    }
}
constexpr int LDS_TOTAL = 147456;
enum { PH_CONV = 100 };
enum { PH_PREP = 0, PH_N1, PH_G1A, PH_SSD, PH_GN, PH_G1B, PH_G2, PH_G1C, PH_QK, PH_ATT, PH_G3, PH_G4, PH_N2, PH_G5A, PH_CVA, PH_G5B, PH_CVB, PH_G6, PH_COUNT };
__device__ __forceinline__ void gsync(unsigned char* lds) {
    KPrm p0 = (KPrm)__builtin_amdgcn_kernarg_segment_ptr(); asm volatile("" : "+s"(p0));
    XcdBarrier xb; xb.bar = (unsigned*)(p0->ws + W_BAR); xb.x = xb_xcc_id(); xb.st = (volatile LAS unsigned*)(lds + LDS_TOTAL - 64);
    xcd_barrier(xb);
}
__device__ __forceinline__ void run_gemms(KPrm p, const Ctx cx, unsigned char* lds, const int first, const int last) {
#pragma unroll 1
    for (int ph = first; ph <= last; ++ph) {
        unsigned char* ws = p->ws;
        pg8::Gemm g; Epi E;
        g.A = (const u16*)(ws + W_H); g.Bt = nullptr; g.M = M; g.N = DM; g.K = DM;
        E.mode = 0; E.d0 = E.d1 = E.d2 = nullptr; E.t1 = E.t2 = 1 << 20; E.p0 = E.p1 = E.p2 = 0; E.f32seg2 = 0; E.vseg2 = 0; E.vout = p->out + O_VP; E.vslab = (u16*)p->out + (size_t)NBS * SKVS * DM;
        E.xp = p->in[I_XP]; E.xs = p->in[I_XS]; E.y = p->out; E.mod = (const float*)(ws + W_MOD); E.gbuf = (u16*)(ws + W_GM); E.gf = (const u16*)(ws + W_GF);
        switch (ph) {
        case PH_G1A: g.Bt = (const u16*)(ws + W_WIN); g.N = 41 * 256;
            E.d0 = (u16*)(ws + W_XBC); E.p0 = CD; E.t1 = 24; E.d1 = (u16*)(ws + W_Z); E.p1 = DI; E.t2 = 40; E.d2 = (u16*)(ws + W_SMALL); E.p2 = 256; E.f32seg2 = 1; break;
        case PH_G1B: g.Bt = (const u16*)(ws + W_WIN) + (size_t)10496 * DM; g.N = 16 * 256;
            E.d0 = (u16*)(ws + W_GM); E.p0 = DM; E.t1 = 8; E.d1 = (u16*)(ws + W_GF); E.p1 = DM; break;
        case PH_G2: g.A = (const u16*)(ws + W_Z); g.Bt = (const u16*)(ws + W_WPM); g.K = DI; E.mode = 1; break;
        case PH_G1C: g.Bt = (const u16*)(ws + W_WIN) + (size_t)14592 * DM; g.N = 24 * 256;
            E.d0 = (u16*)(ws + W_Q); E.p0 = DM; E.t1 = 8; E.d1 = (u16*)(ws + W_K); E.p1 = DM; E.t2 = 16; E.d2 = (u16*)(ws + W_V); E.p2 = DM; E.vseg2 = 1; break;
        case PH_G3: g.A = (const u16*)(ws + W_Q); g.Bt = (const u16*)(ws + W_WPF); E.mode = 2; break;
        case PH_G4: g.A = (const u16*)(ws + W_GM); g.Bt = (const u16*)(ws + W_WOUT); E.mode = 3; break;
        case PH_G5A: g.Bt = (const u16*)(ws + W_WUP); g.M = HALF_ROWS; g.N = DFF2; E.d0 = (u16*)(ws + W_U); E.p0 = DFF2; break;
        case PH_G5B: g.A = (const u16*)(ws + W_H) + (size_t)HALF_ROWS * DM; g.Bt = (const u16*)(ws + W_WUP); g.M = HALF_ROWS; g.N = DFF2; E.d0 = (u16*)(ws + W_U); E.p0 = DFF2; break;
        default:   g.A = (const u16*)(ws + W_G); g.Bt = (const u16*)(ws + W_WDN); g.K = DFF; E.mode = 5; break;
        }
        int tail = 0; if (ph == PH_G2 || ph == PH_G3 || ph == PH_G4 || ph == PH_G6) { g.M = MP; tail = 4; }
        pg8::StaticOrder S; S.init(g.M, g.N, cx.G, cx.bid, tail);
        pg8::gemm_phase<Epi, pg8::StaticOrder, true, true>((PG8_LAS unsigned char*)lds, g, S, E, cx.tid);
        if (ph < last) gsync(lds);
    }
}
#define PH_BEGIN() Ctx cx; { int t_ = threadIdx.x; asm volatile("" : "+v"(t_)); int b_ = blockIdx.x, g_ = gridDim.x; asm volatile("" : "+s"(b_), "+s"(g_)); cx.tid = t_; cx.bid = b_; cx.G = g_; } \
    KPrm p = (KPrm)__builtin_amdgcn_kernarg_segment_ptr(); asm volatile("" : "+s"(p))
#ifdef ONLY_PH
#define PH_ON(k) ((k) == ONLY_PH)
#else
#define PH_ON(k) true
#endif
__global__ void __launch_bounds__(512, 2) mega_fwd(Prm prm_unused) {
    extern __shared__ __attribute__((aligned(16))) unsigned char lds[];
    cg::grid_group grid = cg::this_grid();
    volatile LAS unsigned* bst = (volatile LAS unsigned*)(lds + LDS_TOTAL - 64);
    if (threadIdx.x < 2) bst[threadIdx.x] = 0u;
    __syncthreads();
    { KPrm p0 = (KPrm)__builtin_amdgcn_kernarg_segment_ptr(); (void)xcd_barrier_post((unsigned*)(p0->ws + W_BAR), bst); }
#define GSYNC() gsync(lds)
#ifndef EXP
#define EXP 0
#endif
    if (PH_ON(PH_PREP)) { PH_BEGIN(); phase_prep(p, cx, lds); } grid.sync();
#if EXP == 3
    { PH_BEGIN(); phase_prep(p, cx, lds); } GSYNC();
#endif
    if (PH_ON(PH_N1)) { PH_BEGIN(); phase_norm(p, cx, 0); } GSYNC();
    if (PH_ON(PH_G1A)) { PH_BEGIN(); run_gemms(p, cx, lds, PH_G1A, PH_G1A); } GSYNC();
#if EXP == 1
    { PH_BEGIN(); run_gemms(p, cx, lds, PH_G1A, PH_G1A); } GSYNC();
#endif
    if (PH_ON(PH_CONV)) { PH_BEGIN(); phase_conv(p, cx); } GSYNC();
    if (PH_ON(PH_SSD)) { PH_BEGIN(); phase_ssd(p, cx, lds); } GSYNC();
#if EXP == 2
    { PH_BEGIN(); run_gemms(p, cx, lds, PH_G1A, PH_G1A); } GSYNC();
    { PH_BEGIN(); phase_conv(p, cx); } GSYNC();
    { PH_BEGIN(); phase_ssd(p, cx, lds); } GSYNC();
#endif
    if (PH_ON(PH_GN)) { PH_BEGIN(); phase_gn(p, cx); }
    if (PH_ON(PH_G1B)) { PH_BEGIN(); run_gemms(p, cx, lds, PH_G1B, PH_G1C); } GSYNC();
    if (PH_ON(PH_QK)) { PH_BEGIN(); phase_qk(p, cx); } GSYNC();
    if (PH_ON(PH_ATT)) { PH_BEGIN(); phase_att(p, cx, (char*)lds); } GSYNC();
#if EXP == 4
    { PH_BEGIN(); run_gemms(p, cx, lds, PH_G1C, PH_G1C); } GSYNC();
    { PH_BEGIN(); phase_qk(p, cx); } GSYNC();
    { PH_BEGIN(); phase_att(p, cx, (char*)lds); } GSYNC();
#endif
    if (PH_ON(PH_G3)) { PH_BEGIN(); run_gemms(p, cx, lds, PH_G3, PH_G4); } GSYNC();
    if (PH_ON(PH_N2)) { PH_BEGIN(); phase_norm(p, cx, 1); } GSYNC();
    if (PH_ON(PH_G5A)) { PH_BEGIN(); run_gemms(p, cx, lds, PH_G5A, PH_G5A); } GSYNC();
    if (PH_ON(PH_CVA)) { PH_BEGIN(); phase_cv(p, cx, 0); } GSYNC();
    if (PH_ON(PH_G5B)) { PH_BEGIN(); run_gemms(p, cx, lds, PH_G5B, PH_G5B); } GSYNC();
    if (PH_ON(PH_CVB)) { PH_BEGIN(); phase_cv(p, cx, 1); } GSYNC();
    if (PH_ON(PH_G6)) { PH_BEGIN(); run_gemms(p, cx, lds, PH_G6, PH_G6); }
#if EXP == 5
#pragma unroll 1
    for (int r = 0; r < 32; ++r) GSYNC();
#endif
}

extern "C" void kernel_launch(void* const* d_in, const int* in_sizes, int n_in, void* d_out, int out_size, void* d_ws, size_t ws_size, hipStream_t stream) {
    static int grid = 0;
    if (grid == 0) {
        if (n_in != 31 || (size_t)out_size != O_END || ws_size < 1024 * MiB) { fprintf(stderr, "kernel_launch: unexpected sizes n_in %d out %d ws %zu\n", n_in, out_size, ws_size); }
        int dev = 0, cus = 0, per_cu = 0;
        hipGetDevice(&dev); hipDeviceGetAttribute(&cus, hipDeviceAttributeMultiprocessorCount, dev);
        hipFuncSetAttribute((const void*)mega_fwd, hipFuncAttributeMaxDynamicSharedMemorySize, LDS_TOTAL);
        hipOccupancyMaxActiveBlocksPerMultiprocessor(&per_cu, (const void*)mega_fwd, 512, LDS_TOTAL);
        (void)hipGetLastError();
        if (per_cu < 1) per_cu = 1;
        grid = cus;
    }
    (void)hipMemsetAsync((char*)d_ws + W_BAR, 0, 16384, stream);
    Prm prm{};
    for (int i = 0; i < 31; ++i) prm.in[i] = (const float*)d_in[i];
    prm.out = (float*)d_out; prm.ws = (unsigned char*)d_ws;
    void* args[] = {&prm};
    hipError_t e = hipLaunchCooperativeKernel((const void*)mega_fwd, dim3(grid), dim3(512), args, LDS_TOTAL, stream);
    if (e != hipSuccess) fprintf(stderr, "cooperative launch failed: %s (grid %d)\n", hipGetErrorString(e), grid);
}
```

```cpp
#define WGM_OF(N) ((N) == 2048 ? 8 : 4)
#include <hip/hip_runtime.h>
#include <hip/hip_cooperative_groups.h>
#include <hip/hip_bf16.h>
#include <cstdio>
#include <cstdint>
namespace cg = cooperative_groups;
namespace pg8 {
#define PG8_LAS __attribute__((address_space(3)))
typedef unsigned short bf16_t;
typedef short bf16x8 __attribute__((ext_vector_type(8)));
typedef float f32x4 __attribute__((ext_vector_type(4)));
typedef unsigned u32x4 __attribute__((ext_vector_type(4)));
constexpr int BM = 256, BK = 64, HALF = 128, HTB = HALF * BK * 2  , STAGE_BYTES = 8 * HTB, NXCD = 8, WGM = 8;

__host__ __device__ __forceinline__ int lds_byte(int r, int c) { const int st = (r >> 4) * 2 + (c >> 5), rr = r & 15, cc = c & 31, ob = rr * 64 + cc * 2; return st * 1024 + (ob ^ (((ob >> 9) & 1) << 5)); }
__host__ __device__ __forceinline__ void stage_rc(int b, int& R, int& C) { const int st = b / 1024, sb = b % 1024, swz = sb ^ (((sb >> 9) & 1) << 5); R = (st >> 1) * 16 + swz / 64; C = (st & 1) * 32 + (swz % 64) / 2; }
__host__ __device__ __forceinline__ int perm32(int rho) { const int n = rho >> 4, i = rho & 15; return 8 * (i >> 2) + 4 * n + (i & 3); }

struct Unit { int pm, pn, ho, half; };
struct Gemm { const bf16_t* A; const bf16_t* Bt; int M, N, K; };

struct StaticOrder {
    int nM, nN, nwg, G, c, tail, wgm;
    __host__ __device__ void init(int M, int N, int G_, int c_, int tail_ = 0, int wgm_ = 4) { nM = M / BM; nN = N / BM; nwg = nM * nN; G = G_; c = c_; tail = tail_; wgm = wgm_; }
    __host__ __device__ bool next(int i, Unit& u) const {
        const long L = (long)i * G + c; u.ho = 0; u.half = 0;
        if (L >= nwg) { const int h = (int)(L - nwg); if (h >= tail * nN) return false; const int hm = h / nN; u.pn = h - hm * nN; u.pm = nM + (hm >> 1); u.ho = hm & 1; u.half = 1; return true; }
        int wgid = (int)L; { const int q = nwg / NXCD, r = nwg % NXCD, xcd = wgid % NXCD, off = wgid / NXCD; wgid = (xcd < r ? xcd * (q + 1) : r * (q + 1) + (xcd - r) * q) + off; }
        const int nig = wgm * nN, gid = wgid / nig, fm = gid * wgm, gsz = (nM - fm) < wgm ? (nM - fm) : wgm;
        u.pm = fm + ((wgid % nig) % gsz); u.pn = (wgid % nig) / gsz; return true;
    }
    __device__ __forceinline__ void a_ready(const Unit&) const {}
    __device__ __forceinline__ void done(const Unit&) const {}
};
__device__ __forceinline__ unsigned cvt_pk_bf16(float lo, float hi) { unsigned r; asm volatile("v_cvt_pk_bf16_f32 %0, %1, %2" : "=v"(r) : "v"(lo), "v"(hi)); return r; }
typedef float f32x2 __attribute__((ext_vector_type(2)));
template <class Epi, class Sched, bool ALIGN_EPI = false, bool SP2 = false>
__device__ __forceinline__ void gemm_phase(PG8_LAS unsigned char* lds, const Gemm g, const Sched& S, const Epi& E, const int tid) {
    const int wid = __builtin_amdgcn_readfirstlane(tid >> 6), lane = tid & 63, wr = wid >> 2, wc = wid & 3, fr = lane & 15, fq = lane >> 4;
    const int K = g.K, nt = K / BK;
    unsigned voffA[2], voffB[2];
#pragma unroll
    for (int i = 0; i < 2; ++i) { int R, C; stage_rc(tid * 16 + i * 8192, R, C); const int Rb = Epi::PERM ? ((R & ~31) + perm32(R & 31)) : R;
        voffA[i] = (unsigned)(R * K + C) * 2u; voffB[i] = (unsigned)(Rb * K + C) * 2u; }
    const size_t kstep = (size_t)(BK * 2);
    const size_t hstep = (size_t)HALF * K * 2;
    const size_t tstep = 2 * hstep;
    const unsigned ldsw = (unsigned)wid * 1024u;
    const int aoff = lds_byte(wr * 64 + fr, fq * 8), boff = lds_byte(wc * 32 + fr, fq * 8);
#define PG8_SA(b, h) (((b) * 2 + (h)) * HTB)
#define PG8_SB(b, h) ((4 + (b) * 2 + (h)) * HTB)
#define PG8_STAGE(bufoff, gbase, voff) do { _Pragma("unroll") for (int _i = 0; _i < 2; ++_i) \
        __builtin_amdgcn_global_load_lds((const unsigned*)((const char*)(gbase) + (voff)[_i]), (PG8_LAS unsigned*)(lds + (bufoff) + ldsw + _i * 8192), 16, 0, 0); } while (0)
#define PG8_LDA(dst, b, h) do { _Pragma("unroll") for (int m = 0; m < 4; ++m) _Pragma("unroll") for (int k = 0; k < 2; ++k) dst[m][k] = *(const PG8_LAS bf16x8*)(lds + PG8_SA(b, h) + aoff + m * 2048 + k * 1024); } while (0)
#define PG8_LDB(dst, b, h) do { _Pragma("unroll") for (int n = 0; n < 2; ++n) _Pragma("unroll") for (int k = 0; k < 2; ++k) dst[n][k] = *(const PG8_LAS bf16x8*)(lds + PG8_SB(b, h) + boff + n * 2048 + k * 1024); } while (0)
#define PG8_MMA(ai, bj, At, Bt) do { __builtin_amdgcn_s_setprio(1); _Pragma("unroll") for (int m = 0; m < 4; ++m) _Pragma("unroll") for (int n = 0; n < 2; ++n) _Pragma("unroll") for (int k = 0; k < 2; ++k) \
        acc[ai][bj][m][n] = __builtin_amdgcn_mfma_f32_16x16x32_bf16(Bt[n][k], At[m][k], acc[ai][bj][m][n], 0, 0, 0); __builtin_amdgcn_s_setprio(0); } while (0)
#define PG8_WAIT_V(n) asm volatile("s_waitcnt vmcnt(" #n ")" ::: "memory")
#define PG8_WAIT_L(n) asm volatile("s_waitcnt lgkmcnt(" #n ")" ::: "memory")
#define PG8_BAR __builtin_amdgcn_s_barrier()
#define PG8_SCHED __builtin_amdgcn_sched_barrier(0)
    Unit cur, nxt; int ui = 0;
    if (!S.next(0, cur)) return;
    f32x4 acc[2][2][4][2];
#pragma unroll
    for (int a = 0; a < 2; ++a)
#pragma unroll
        for (int b = 0; b < 2; ++b)
#pragma unroll
            for (int m = 0; m < 4; ++m)
#pragma unroll
                for (int n = 0; n < 2; ++n) acc[a][b][m][n] = (f32x4){0.f, 0.f, 0.f, 0.f};
    bf16x8 At[4][2], B0[2][2], B1[2][2];
    const char* cA = (const char*)g.A + (size_t)cur.pm * tstep + (size_t)cur.ho * hstep; const char* cB = (const char*)g.Bt + (size_t)cur.pn * tstep;
    S.a_ready(cur);
    if constexpr (SP2) {
        PG8_STAGE(PG8_SB(0, 0), cB, voffB); PG8_STAGE(PG8_SB(0, 1), cB + hstep, voffB); PG8_STAGE(PG8_SA(0, 0), cA, voffA); PG8_STAGE(PG8_SA(0, 1), cA + hstep, voffA);
        if (wr == 1) PG8_BAR;
        PG8_WAIT_V(2); PG8_BAR;
        PG8_STAGE(PG8_SB(1, 0), cB + kstep, voffB); PG8_STAGE(PG8_SA(1, 0), cA + kstep, voffA); PG8_STAGE(PG8_SB(1, 1), cB + hstep + kstep, voffB);
        PG8_WAIT_V(6); PG8_BAR;
    } else {
        PG8_STAGE(PG8_SB(0, 0), cB, voffB); PG8_STAGE(PG8_SA(0, 0), cA, voffA); PG8_STAGE(PG8_SB(0, 1), cB + hstep, voffB); PG8_STAGE(PG8_SA(0, 1), cA + hstep, voffA);
        if (wr == 1) PG8_BAR;
        PG8_WAIT_V(4); PG8_BAR;
        PG8_STAGE(PG8_SB(1, 0), cB + kstep, voffB); PG8_STAGE(PG8_SA(1, 0), cA + kstep, voffA); PG8_STAGE(PG8_SB(1, 1), cB + hstep + kstep, voffB);
        PG8_WAIT_V(6); PG8_BAR;
    }
    for (;;) {
        const bool has_next = S.next(ui + 1, nxt);
        const char* nA = has_next ? (const char*)g.A + (size_t)nxt.pm * tstep + (size_t)nxt.ho * hstep : cA; const char* nB = has_next ? (const char*)g.Bt + (size_t)nxt.pn * tstep : cB;
        for (int t = 0; t < nt; t += 2) {
            const bool last = (t == nt - 2);
            const char* a1 = cA + (size_t)(t + 1) * kstep;
            const char* a2 = last ? nA : cA + (size_t)(t + 2) * kstep; const char* b2 = last ? nB : cB + (size_t)(t + 2) * kstep;
            const char* a3 = a2 + kstep; const char* b3 = b2 + kstep;
            if (last && has_next) S.a_ready(nxt);
            if constexpr (SP2) {
            PG8_LDB(B0, 0, 0); PG8_LDB(B1, 0, 1); PG8_SCHED; PG8_LDA(At, 0, 0); PG8_STAGE(PG8_SA(1, 1), a1 + hstep, voffA);
            PG8_WAIT_V(8); PG8_WAIT_L(0); PG8_BAR; PG8_MMA(0, 0, At, B0); PG8_MMA(0, 1, At, B1); PG8_BAR; PG8_SCHED;
            PG8_LDA(At, 0, 1); PG8_STAGE(PG8_SB(0, 0), b2, voffB); PG8_STAGE(PG8_SB(0, 1), b2 + hstep, voffB); PG8_STAGE(PG8_SA(0, 0), a2, voffA);
            PG8_WAIT_V(8); PG8_WAIT_L(0); PG8_BAR; if (!cur.half) { PG8_MMA(1, 0, At, B0); PG8_MMA(1, 1, At, B1); } PG8_BAR; PG8_SCHED;
            PG8_LDB(B0, 1, 0); PG8_LDB(B1, 1, 1); PG8_SCHED; PG8_LDA(At, 1, 0); PG8_STAGE(PG8_SA(0, 1), a2 + hstep, voffA);
            PG8_WAIT_V(8); PG8_WAIT_L(0); PG8_BAR; PG8_MMA(0, 0, At, B0); PG8_MMA(0, 1, At, B1); PG8_BAR; PG8_SCHED;
            PG8_LDA(At, 1, 1); PG8_STAGE(PG8_SB(1, 0), b3, voffB); PG8_STAGE(PG8_SB(1, 1), b3 + hstep, voffB); PG8_STAGE(PG8_SA(1, 0), a3, voffA);
            PG8_WAIT_V(8); PG8_WAIT_L(0); PG8_BAR; if (!cur.half) { PG8_MMA(1, 0, At, B0); PG8_MMA(1, 1, At, B1); } PG8_BAR; PG8_SCHED;
            } else {
            PG8_LDB(B0, 0, 0); PG8_SCHED; PG8_LDA(At, 0, 0); PG8_STAGE(PG8_SA(1, 1), a1 + hstep, voffA);
            PG8_WAIT_L(8); PG8_BAR; PG8_WAIT_L(0); PG8_MMA(0, 0, At, B0); PG8_BAR; PG8_SCHED;
            PG8_LDB(B1, 0, 1); PG8_STAGE(PG8_SB(0, 0), b2, voffB);
            PG8_BAR; PG8_WAIT_L(0); PG8_MMA(0, 1, At, B1); PG8_BAR;
            PG8_LDA(At, 0, 1); PG8_STAGE(PG8_SA(0, 0), a2, voffA);
            PG8_BAR; PG8_WAIT_L(0); PG8_MMA(1, 0, At, B0); PG8_BAR; PG8_SCHED;
            PG8_STAGE(PG8_SB(0, 1), b2 + hstep, voffB);
            PG8_WAIT_V(6); PG8_BAR; PG8_MMA(1, 1, At, B1); PG8_BAR;
            PG8_LDB(B0, 1, 0); PG8_SCHED; PG8_LDA(At, 1, 0); PG8_STAGE(PG8_SA(0, 1), a2 + hstep, voffA);
            PG8_WAIT_L(8); PG8_BAR; PG8_WAIT_L(0); PG8_MMA(0, 0, At, B0); PG8_BAR; PG8_SCHED;
            PG8_LDB(B1, 1, 1); PG8_STAGE(PG8_SB(1, 0), b3, voffB);
            PG8_BAR; PG8_WAIT_L(0); PG8_MMA(0, 1, At, B1); PG8_BAR;
            PG8_LDA(At, 1, 1); PG8_STAGE(PG8_SA(1, 0), a3, voffA);
            PG8_BAR; PG8_WAIT_L(0); PG8_MMA(1, 0, At, B0); PG8_BAR; PG8_SCHED;
            PG8_STAGE(PG8_SB(1, 1), b3 + hstep, voffB);
            PG8_WAIT_V(6); PG8_BAR; PG8_MMA(1, 1, At, B1); PG8_BAR;
            }
        }
        if constexpr (ALIGN_EPI) { if (wr == 0) PG8_BAR; }
        if constexpr (!Epi::AFTER_DRAIN) { E(acc, cur, wr, wc, fr, fq); S.done(cur); }
        if (!has_next) break;
#pragma unroll
        for (int a = 0; a < 2; ++a)
#pragma unroll
            for (int b = 0; b < 2; ++b)
#pragma unroll
                for (int m = 0; m < 4; ++m)
#pragma unroll
                    for (int n = 0; n < 2; ++n) acc[a][b][m][n] = (f32x4){0.f, 0.f, 0.f, 0.f};
        cur = nxt; cA = nA; cB = nB; ++ui;
        if constexpr (ALIGN_EPI) { if (wr == 1) PG8_BAR; }
    }
    PG8_WAIT_V(0);
    if constexpr (!ALIGN_EPI) { if (wr == 0) PG8_BAR; }
    PG8_BAR;
    if constexpr (Epi::AFTER_DRAIN) { E.fused(acc, cur, wr, wc, fr, fq, lds, wid, lane); S.done(cur); }
#undef PG8_SA
#undef PG8_SB
#undef PG8_STAGE
#undef PG8_LDA
#undef PG8_LDB
#undef PG8_MMA
#undef PG8_WAIT_V
#undef PG8_WAIT_L
#undef PG8_BAR
#undef PG8_SCHED
}
}
namespace att {
constexpr int D = 128, PITCH = 2048, NW = 8, QBLK = 32, KVBLK = 64, QB = NW * QBLK;
constexpr int SHM_V = KVBLK * D * 2, SHM_K = KVBLK * D * 2;
constexpr int LDS_BIAS = 2 * SHM_V + 2 * SHM_K + NW * 64 * 4;
constexpr int NQX = 4, LDS_QX = LDS_BIAS + 512;
constexpr int LDS_BYTES = LDS_QX + NW * NQX * 1024;
constexpr float THR2 = 64.f;
constexpr bool WSKIP = false;
typedef __hip_bfloat16 bf16;
typedef short bf16x8 __attribute__((ext_vector_type(8)));
typedef short s16x4 __attribute__((ext_vector_type(4)));
typedef float f32x16 __attribute__((ext_vector_type(16)));
typedef float f32x4 __attribute__((ext_vector_type(4)));
typedef unsigned u32x4 __attribute__((ext_vector_type(4)));
template <class A, class Bt> struct same_t { static constexpr bool v = false; };
template <class A> struct same_t<A, A> { static constexpr bool v = true; };

#define KSWZ(row, colB) ((row) * 256 + ((colB) ^ (((row) & 7) << 4)))
#define SBAR() __builtin_amdgcn_sched_barrier(0)
__device__ __forceinline__ int v_st(int k, int c) { const int kk = (k & ~0xC) | ((k & 4) << 1) | ((k & 8) >> 1); return ((kk >> 3) * 4 + (c >> 5)) * 512 + ((kk & 7) * 32 + (c & 31)) * 2; }
__device__ __forceinline__ int v_rd_base(int lane) { return ((lane & 3) << 3) | (((lane >> 2) & 3) << 6) | (((lane >> 4) & 1) << 5) | (((lane >> 5) & 1) << 8); }
constexpr int v_rd_off(int d0, int ks, int half) { return d0 * 512 + ks * 4096 + half * 2048; }
__device__ __forceinline__ int crow(int r, int hi) { return (r & 3) + 8 * (r >> 2) + 4 * hi; }
__device__ __forceinline__ unsigned cvtpk(float lo, float hi) {
    unsigned r; asm volatile("v_cvt_pk_bf16_f32 %0, %1, %2" : "=v"(r) : "v"(lo), "v"(hi)); return r;
}
__device__ __forceinline__ bf16x8 pack8(f32x4 a, f32x4 b) {
    u32x4 w = {cvtpk(a[0], a[1]), cvtpk(a[2], a[3]), cvtpk(b[0], b[1]), cvtpk(b[2], b[3])};
    return *reinterpret_cast<bf16x8*>(&w);
}
template <class T> __device__ __forceinline__ bf16x8 load8(const T* p) {
    if constexpr (same_t<T, float>::v) { return pack8(*(const f32x4*)p, *(const f32x4*)(p + 4)); }
    else { return *reinterpret_cast<const bf16x8*>(p); }
}
__device__ __forceinline__ void mask_tile(f32x16& p0, f32x16& p1, int dq, unsigned W) {
    const float NEG = -__builtin_inff();
#pragma unroll
    for (int r = 0; r < 16; ++r) {
        const int c = (r & 3) + 8 * (r >> 2);
        if (dq - c < 0) p0[r] = NEG;
        if (dq - c - 32 < 0) p1[r] = NEG;
    }
}
__device__ __forceinline__ void partialSM(f32x16& p0, f32x16& p1, float& m_reg, float& mn, float& alpha) {
    float pmax = p0[0]; for (int r = 1; r < 16; ++r) pmax = fmaxf(pmax, p0[r]); for (int r = 0; r < 16; ++r) pmax = fmaxf(pmax, p1[r]);
    { auto rr = __builtin_amdgcn_permlane32_swap(__float_as_uint(pmax), __float_as_uint(pmax), false, false);
      pmax = fmaxf(__uint_as_float(rr[0]), __uint_as_float(rr[1])); }
    if (__builtin_expect(__all((pmax - m_reg) <= THR2), 1)) { mn = m_reg; alpha = 1.f; }
    else { mn = fmaxf(m_reg, pmax); alpha = __builtin_amdgcn_exp2f(m_reg - mn); m_reg = mn; }
    for (int r = 0; r < 16; ++r) p0[r] = p0[r] - mn; for (int r = 0; r < 16; ++r) p1[r] = p1[r] - mn;
    for (int r = 0; r < 16; ++r) p0[r] = __builtin_amdgcn_exp2f(p0[r]);
}
__device__ __forceinline__ void finishSM(f32x16& p0, f32x16& p1, float alpha, float& l_reg, bf16x8& pa0, bf16x8& pa1, bf16x8& pa2, bf16x8& pa3) {
    for (int r = 0; r < 16; ++r) p1[r] = __builtin_amdgcn_exp2f(p1[r]);
    float ps = 0; for (int r = 0; r < 16; ++r) ps += p0[r]; for (int r = 0; r < 16; ++r) ps += p1[r];
    { auto rr = __builtin_amdgcn_permlane32_swap(__float_as_uint(ps), __float_as_uint(ps), false, false);
      ps = __uint_as_float(rr[0]) + __uint_as_float(rr[1]); }
    l_reg = l_reg * alpha + ps;
#define PK4(P, B_, OUT) do { unsigned a0 = cvtpk(P[B_+0], P[B_+1]), a1 = cvtpk(P[B_+2], P[B_+3]);                          \
        unsigned b0 = cvtpk(P[B_+4], P[B_+5]), b1 = cvtpk(P[B_+6], P[B_+7]);                                             \
        auto r0 = __builtin_amdgcn_permlane32_swap(a0, b0, false, false); auto r1 = __builtin_amdgcn_permlane32_swap(a1, b1, false, false); \
        u32x4 w = {r0[0], r1[0], r0[1], r1[1]}; OUT = *reinterpret_cast<bf16x8*>(&w); } while (0)
    PK4(p0, 0, pa0); PK4(p0, 8, pa1); PK4(p1, 0, pa2); PK4(p1, 8, pa3);
#undef PK4
}
template <int KB, bool SK>
__device__ __forceinline__ void qkt(f32x16& p0, f32x16& p1, const char* K_lds, int r32, int hi, const bf16x8* qr, bool act, const char* qx) {
    if (SK && !act) { const float NEG = -__builtin_inff();
#pragma unroll
        for (int r = 0; r < 16; ++r) { p0[r] = NEG; p1[r] = NEG; } return; }
    { const float* bl = (const float*)(K_lds - 2 * SHM_V + LDS_BIAS) + KB * 64 + 4 * hi;
#pragma unroll
      for (int g = 0; g < 4; ++g) { const f32x4 u0 = *(const f32x4*)(bl + 8 * g), u1 = *(const f32x4*)(bl + 32 + 8 * g);
        p0[4*g] = u0[0]; p0[4*g+1] = u0[1]; p0[4*g+2] = u0[2]; p0[4*g+3] = u0[3]; p1[4*g] = u1[0]; p1[4*g+1] = u1[1]; p1[4*g+2] = u1[2]; p1[4*g+3] = u1[3]; } }
    const char* kb[4];
#pragma unroll
    for (int dd = 0; dd < 4; ++dd) kb[dd] = K_lds + KB * SHM_K + KSWZ(r32, (dd * 16 + hi * 8) * 2);
#pragma unroll
    for (int d0 = 0; d0 < 8; ++d0) { const char* a = kb[d0 & 3] + (d0 >> 2) * 128;
        bf16x8 b0 = *reinterpret_cast<const bf16x8*>(a);
        bf16x8 b1 = *reinterpret_cast<const bf16x8*>(a + 32 * 256);
        const bf16x8 qv = (d0 < 8 - NQX) ? qr[d0] : *reinterpret_cast<const bf16x8*>(qx + (d0 - (8 - NQX)) * 1024);
        p0 = __builtin_amdgcn_mfma_f32_32x32x16_bf16(b0, qv, p0, 0, 0, 0);
        p1 = __builtin_amdgcn_mfma_f32_32x32x16_bf16(b1, qv, p1, 0, 0, 0); }
}
template <int VB, bool SK>
__device__ __forceinline__ void pv_tile(f32x16* o, int vb0, bf16x8 pa0, bf16x8 pa1, bf16x8 pa2, bf16x8 pa3, bool act) {
    if (SK && !act) return;
#define TRRD(dst, off) asm volatile("ds_read_b64_tr_b16 %0, %1 offset:%2" : "=&v"(dst) : "v"(vb0), "i"(off) : "memory")
#define PV_D0(d0) do { s16x4 l0, l1, l2, l3, h0, h1, h2, h3; constexpr int b_ = VB * SHM_V + v_rd_off(d0, 0, 0);     \
        TRRD(l0, b_); TRRD(h0, b_ + 2048); TRRD(l1, b_ + 4096); TRRD(h1, b_ + 6144); TRRD(l2, b_ + 8192); TRRD(h2, b_ + 10240); TRRD(l3, b_ + 12288); TRRD(h3, b_ + 14336); \
        asm volatile("s_waitcnt lgkmcnt(0)" ::: "memory"); SBAR();                 \
        o[d0] = __builtin_amdgcn_mfma_f32_32x32x16_bf16(pa0, (bf16x8){l0[0], l0[1], l0[2], l0[3], h0[0], h0[1], h0[2], h0[3]}, o[d0], 0, 0, 0);   \
        o[d0] = __builtin_amdgcn_mfma_f32_32x32x16_bf16(pa1, (bf16x8){l1[0], l1[1], l1[2], l1[3], h1[0], h1[1], h1[2], h1[3]}, o[d0], 0, 0, 0);   \
        o[d0] = __builtin_amdgcn_mfma_f32_32x32x16_bf16(pa2, (bf16x8){l2[0], l2[1], l2[2], l2[3], h2[0], h2[1], h2[2], h2[3]}, o[d0], 0, 0, 0);   \
        o[d0] = __builtin_amdgcn_mfma_f32_32x32x16_bf16(pa3, (bf16x8){l3[0], l3[1], l3[2], l3[3], h3[0], h3[1], h3[2], h3[3]}, o[d0], 0, 0, 0); } while (0)
    PV_D0(0); PV_D0(1); PV_D0(2); PV_D0(3);
#undef PV_D0
#undef TRRD
}

template <class TIn, class TOut> struct BlockRef { const TIn* Q; const TIn* K; const TIn* V; TOut* O; const float* Bs; int P0; int nvalid; };
template <class TIn> struct Seam {
    bf16x8 qr[8];
    bf16x8 st_v0, st_v1, st_k0, st_k1; f32x4 sf0, sf1, sf2, sf3;
    f32x4 tq[16];
};
__device__ __forceinline__ int swa_jlo(int P0, int W) { const int lowk = P0 - W + 1; return lowk > 0 ? lowk / KVBLK : 0; }
#define ROW(p, k0, rr) ((p) + (size_t)((k0) + (rr)) * PITCH + sc)
#define VMW() asm volatile("s_waitcnt vmcnt(0)" ::: "memory")
#define VMWN(n) asm volatile("s_waitcnt vmcnt(%0)" :: "i"(n) : "memory")
#define GLDS(gp_, lp_, sz_) __builtin_amdgcn_global_load_lds((const unsigned*)(gp_), (__attribute__((address_space(3))) unsigned*)(lp_), sz_, 0, 0)
#define SLOAD_H(Kp, Vp, Bp, k0, bb_) do { S.st_v0 = load8<TIn>(ROW(Vp, k0, sr)); S.st_v1 = load8<TIn>(ROW(Vp, k0, 32 + sr));              \
                         { const TIn* kg_ = (Kp) + (size_t)(k0) * PITCH; char* kl_ = K_lds + (bb_) * SHM_K + wid * 2048; GLDS(kg_ + ksrc0, kl_, 16); GLDS(kg_ + ksrc1, kl_ + 1024, 16); } \
                         if (wid == 0) GLDS((Bp) + (k0) + lane, lds + LDS_BIAS + (bb_) * 256, 4); } while (0)
#define SWRITE_HK(bf) do { } while (0)
#define SWRITE_HV(bf) do { *(bf16x8*)(V_lds + (bf) * SHM_V + vst0) = S.st_v0; *(bf16x8*)(V_lds + (bf) * SHM_V + vst1) = S.st_v1; } while (0)
#define SWRITE_H(bf) do { SWRITE_HV(bf); SWRITE_HK(bf); } while (0)
#define SLOAD_F(p, k0) do { S.sf0 = *(const f32x4*)ROW(p, k0, sr); S.sf1 = *(const f32x4*)(ROW(p, k0, sr) + 4);                \
                            S.sf2 = *(const f32x4*)ROW(p, k0, 32 + sr); S.sf3 = *(const f32x4*)(ROW(p, k0, 32 + sr) + 4); } while (0)
#define SWRITE_KF(bf) do { *(bf16x8*)(K_lds + (bf) * SHM_K + kws) = pack8(S.sf0, S.sf1); *(bf16x8*)(K_lds + (bf) * SHM_K + kws + 32 * 256) = pack8(S.sf2, S.sf3); } while (0)
#define SWRITE_VF(bf) do { *(bf16x8*)(V_lds + (bf) * SHM_V + vst0) = pack8(S.sf0, S.sf1); *(bf16x8*)(V_lds + (bf) * SHM_V + vst1) = pack8(S.sf2, S.sf3); } while (0)
template <class TIn, class TOut>
__device__ __forceinline__ void causal_swa_prime(const BlockRef<TIn, TOut>& cur, int W, char* lds, Seam<TIn>& S, const int tid) {
    constexpr bool F32 = same_t<TIn, float>::v;
    const int wid = __builtin_amdgcn_readfirstlane(tid >> 6), lane = tid & 63, r32 = lane & 31, hi = lane >> 5;
    const int sr = tid >> 4, sc = (tid & 15) * 8, kws = KSWZ(sr, sc * 2); char* K_lds = lds + 2 * SHM_V; (void)kws;
    const int ksrc0 = (8 * wid + (lane >> 4)) * PITCH + ((lane & 15) ^ (lane >> 4)) * 8, ksrc1 = (8 * wid + 4 + (lane >> 4)) * PITCH + ((lane & 15) ^ (4 + (lane >> 4))) * 8;
    const int kb0 = swa_jlo(cur.P0, W) * KVBLK;
    for (int d0 = 0; d0 < 8; ++d0) S.qr[d0] = load8<TIn>(cur.Q + (size_t)(wid * QBLK + r32) * PITCH + d0 * 16 + hi * 8);
    if constexpr (F32) { SLOAD_F((const float*)cur.K, kb0); VMW(); SWRITE_KF(0); SBAR(); SLOAD_F((const float*)cur.V, kb0); }
    else { SLOAD_H(cur.K, cur.V, cur.Bs, kb0, 0); VMW(); SWRITE_HK(0); }
    __syncthreads();
}
template <class TIn, class TOut>
__device__ __forceinline__ void causal_swa_block(const BlockRef<TIn, TOut>& cur, const BlockRef<TIn, TOut>& nxt, int skv, int W, char* lds, Seam<TIn>& S, const int tid, const float* qnw, const float qs) {
    constexpr bool F32 = same_t<TIn, float>::v;
    const int wid = __builtin_amdgcn_readfirstlane(tid >> 6), lane = tid & 63, r32 = lane & 31, hi = lane >> 5;
    const int j_lo = swa_jlo(cur.P0, W);
    int j_hi = (cur.P0 + QB - 1) / KVBLK + 1; if (j_hi > skv / KVBLK) j_hi = skv / KVBLK;
    const int NT = j_hi - j_lo;
    const int kbn = swa_jlo(nxt.P0, W) * KVBLK;
    const int qlo = cur.P0 + wid * QBLK, qm = qlo + r32 - 4 * hi;
    char* V_lds = lds; char* K_lds = lds + 2 * SHM_V;
    float* ws = (float*)(lds + 2 * SHM_V + 2 * SHM_K) + wid * 64; float* li_l = ws, * al_l = ws + 32;
    float m_reg = -1e30f, l_reg = 0; f32x16 o[4] = {};
    const int sr = tid >> 4, sc = (tid & 15) * 8, vst0 = v_st(sr, sc), vst1 = v_st(32 + sr, sc), kws = KSWZ(sr, sc * 2);
    const int vb0 = (int)(uintptr_t)V_lds + v_rd_base(lane); (void)kws;
    const int ksrc0 = (8 * wid + (lane >> 4)) * PITCH + ((lane & 15) ^ (lane >> 4)) * 8, ksrc1 = (8 * wid + 4 + (lane >> 4)) * PITCH + ((lane & 15) ^ (4 + (lane >> 4))) * 8;
    const TIn* Kh = cur.K; const TIn* Vh = cur.V; const float* Bh = cur.Bs;
#define RESC(a) do { if (__any((a) < 1.f)) { if (hi == 0) al_l[r32] = (a); asm volatile("s_waitcnt lgkmcnt(0)" ::: "memory");              \
                     for (int d_ = 0; d_ < 4; ++d_) for (int r = 0; r < 16; ++r) o[d_][r] *= al_l[crow(r, hi)]; } } while (0)
#define KBASE(t) ((j_lo + (t)) * KVBLK)
#define ACT(t) (KBASE(t) <= qlo + QBLK - 1 && KBASE(t) + KVBLK - 1 >= qlo - W + 1)
#define MASKT(P0_, P1_, t) do { const int kb_ = KBASE(t); if ((!SK || ACT(t)) && (kb_ + KVBLK - 1 > qlo || kb_ <= qlo + QBLK - 1 - W)) mask_tile(P0_, P1_, qm - kb_, (unsigned)W); } while (0)
    constexpr int NQL = F32 ? 16 : 8;
    constexpr bool SK = WSKIP && !F32;
#define SEAM_K0() do { VMWN(NQL); if constexpr (F32) { SWRITE_KF(0); SBAR(); SLOAD_F((const float*)nxt.V, kbn); } else { SWRITE_HK(0); } SBAR(); } while (0)
    f32x16 pA0, pA1, pB0, pB1; float mnA, mnB, alA, alB; bf16x8 pa0, pa1, pa2, pa3;
    {
        const float* wq_ = qnw; asm volatile("" : "+s"(wq_));
        float ss_ = 0.f;
#pragma unroll
        for (int d0 = 0; d0 < 8; ++d0) { const u32x4 w_ = __builtin_bit_cast(u32x4, S.qr[d0]);
#pragma unroll
            for (int e = 0; e < 4; ++e) { const float lo_ = __uint_as_float(w_[e] << 16), hi_ = __uint_as_float(w_[e] & 0xffff0000u); ss_ += lo_ * lo_ + hi_ * hi_; } }
        { auto rr = __builtin_amdgcn_permlane32_swap(__float_as_uint(ss_), __float_as_uint(ss_), false, false); ss_ = __uint_as_float(rr[0]) + __uint_as_float(rr[1]); }
        const float rs_ = rsqrtf(ss_ * (1.f / 128.f) + 1e-6f) * qs;
#pragma unroll
        for (int d0 = 0; d0 < 8; ++d0) { const u32x4 w_ = __builtin_bit_cast(u32x4, S.qr[d0]); const f32x4 g0 = *(const f32x4*)(wq_ + d0 * 16 + hi * 8), g1 = *(const f32x4*)(wq_ + d0 * 16 + hi * 8 + 4); u32x4 o_;
#pragma unroll
            for (int e = 0; e < 4; ++e) { const float lo_ = __uint_as_float(w_[e] << 16) * rs_ * (e < 2 ? g0[2 * e] : g1[2 * e - 4]), hi_ = __uint_as_float(w_[e] & 0xffff0000u) * rs_ * (e < 2 ? g0[2 * e + 1] : g1[2 * e - 3]); o_[e] = cvtpk(lo_, hi_); }
            S.qr[d0] = __builtin_bit_cast(bf16x8, o_); }
    }
    char* qx = lds + LDS_QX + wid * (NQX * 1024) + lane * 16;
#pragma unroll
    for (int e = 0; e < NQX; ++e) *reinterpret_cast<bf16x8*>(qx + e * 1024) = S.qr[8 - NQX + e];
    if constexpr (F32) { VMW(); SWRITE_VF(0); SBAR(); } else { SWRITE_HV(0); SBAR(); }
    if (NT > 1) { if constexpr (F32) SLOAD_F((const float*)Kh, KBASE(1)); else SLOAD_H(Kh, Vh, Bh, KBASE(1), 1); }
    SBAR(); qkt<0, SK>(pA0, pA1, K_lds, r32, hi, S.qr, ACT(0), qx);
    if constexpr (F32) { if (NT > 1) { VMW(); SWRITE_KF(1); SBAR(); SLOAD_F((const float*)Vh, KBASE(1)); } }
    MASKT(pA0, pA1, 0); partialSM(pA0, pA1, m_reg, mnA, alA);
    if (NT > 1) { VMW(); if constexpr (F32) { SWRITE_VF(1); SBAR(); if (NT > 2) SLOAD_F((const float*)Kh, KBASE(2)); } else SWRITE_H(1); }
    __syncthreads();
#define HALF_STEP(PX0, PX1, mnX, alX, PY0, PY1, alY, t, KB, VB, SB) do {                                                      \
        SBAR(); qkt<KB, SK>(PX0, PX1, K_lds, r32, hi, S.qr, ACT(t), qx);                                             \
        finishSM(PY0, PY1, alY, l_reg, pa0, pa1, pa2, pa3); SBAR();                                                           \
        if ((t) + 1 < NT) { if constexpr (F32) { VMW(); SWRITE_KF(SB); SBAR(); SLOAD_F((const float*)Vh, KBASE((t) + 1)); }  \
                            else { SLOAD_H(Kh, Vh, Bh, KBASE((t) + 1), SB); } SBAR(); }                                               \
        pv_tile<VB, SK>(o, vb0, pa0, pa1, pa2, pa3, ACT((t) - 1)); MASKT(PX0, PX1, (t)); partialSM(PX0, PX1, m_reg, mnX, alX);                                        \
        __syncthreads();                                                                                                      \
        if ((t) + 1 < NT) { VMW(); if constexpr (F32) { SWRITE_VF(SB); SBAR(); if ((t) + 2 < NT) SLOAD_F((const float*)Kh, KBASE((t) + 2)); } \
                            else { SWRITE_H(SB); } }                                                                          \
        RESC(alX); __syncthreads(); } while (0)
    for (int t = 1; t + 1 < NT; t += 2) {
        HALF_STEP(pB0, pB1, mnB, alB, pA0, pA1, alA, t, 1, 0, 0);
        HALF_STEP(pA0, pA1, mnA, alA, pB0, pB1, alB, t + 1, 0, 1, 1);
    }
    const bool even = (NT & 1) == 0;
    if (even) { SBAR(); qkt<1, SK>(pB0, pB1, K_lds, r32, hi, S.qr, ACT(NT - 1), qx); SBAR(); }
#define QROW(e) (nxt.Q + (size_t)(wid * QBLK + r32) * PITCH + ((e) >> 1) * 16 + hi * 8 + ((e) & 1) * 4)
    if constexpr (F32) { SLOAD_F((const float*)nxt.K, kbn); SBAR();
#pragma unroll
        for (int e = 0; e < 8; ++e) S.tq[e] = *(const f32x4*)QROW(e); }
    else { SLOAD_H(nxt.K, nxt.V, nxt.Bs, kbn, 0); SBAR();
#pragma unroll
        for (int d0 = 0; d0 < 8; ++d0) S.qr[d0] = load8<TIn>(nxt.Q + (size_t)(wid * QBLK + r32) * PITCH + d0 * 16 + hi * 8); }
    SBAR();
    finishSM(pA0, pA1, alA, l_reg, pa0, pa1, pa2, pa3); SBAR();
    if constexpr (F32) {
#pragma unroll
        for (int e = 8; e < 16; ++e) S.tq[e] = *(const f32x4*)QROW(e); SBAR(); }
#undef QROW
    pv_tile<0, SK>(o, vb0, pa0, pa1, pa2, pa3, ACT(even ? NT - 2 : NT - 1));
    if (even) { MASKT(pB0, pB1, NT - 1); partialSM(pB0, pB1, m_reg, mnB, alB); __syncthreads(); RESC(alB);
        finishSM(pB0, pB1, alB, l_reg, pa0, pa1, pa2, pa3); SBAR(); pv_tile<1, SK>(o, vb0, pa0, pa1, pa2, pa3, ACT(NT - 1)); }
    SBAR(); SEAM_K0();
    if (hi == 0) li_l[r32] = l_reg; asm volatile("s_waitcnt lgkmcnt(0)" ::: "memory");
    float rli[16];
#pragma unroll
    for (int r = 0; r < 16; ++r) rli[r] = __builtin_amdgcn_rcpf(li_l[crow(r, hi)]);
    int tidE = tid; asm volatile("" : "+v"(tidE));
    const int widE = __builtin_amdgcn_readfirstlane(tidE >> 6), r32E = tidE & 31, hiE = (tidE >> 5) & 1;
    TOut* Ow = cur.O + (size_t)(widE * QBLK) * PITCH; const bool wval = widE * QBLK < cur.nvalid;
    if (wval) {
#pragma unroll
    for (int r = 0; r < 16; ++r) { const int orow = crow(r, hiE);
#pragma unroll
        for (int d0 = 0; d0 < 4; ++d0) { const float v = o[d0][r] * rli[r];
            if constexpr (same_t<TOut, float>::v) { Ow[(size_t)orow * PITCH + d0 * 32 + r32E] = v; }
            else { const float vn = __shfl_xor(v, 1);
                   if ((r32E & 1) == 0) *(unsigned*)(Ow + (size_t)orow * PITCH + d0 * 32 + r32E) = cvtpk(v, vn); } } } }
    if constexpr (F32) {
#pragma unroll
        for (int d0 = 0; d0 < 8; ++d0) S.qr[d0] = pack8(S.tq[2 * d0], S.tq[2 * d0 + 1]); }
    __syncthreads();
#undef RESC
#undef KBASE
#undef ACT
#undef MASKT
#undef SEAM_K0
#undef HALF_STEP
}
#undef ROW
#undef VMW
#undef VMWN
#undef SLOAD_H
#undef GLDS
#undef SWRITE_HK
#undef SWRITE_HV
#undef SWRITE_H
#undef SLOAD_F
#undef SWRITE_KF
#undef SWRITE_VF

}
#define GAS __attribute__((address_space(1)))
#define LAS __attribute__((address_space(3)))
typedef GAS unsigned gu32;
typedef GAS unsigned long long gu64;
#define RLX_AGENT __ATOMIC_RELAXED, __HIP_MEMORY_SCOPE_AGENT
#define LDS_WAIT() asm volatile("s_waitcnt lgkmcnt(0)" ::: "memory")
#define VM_WAIT() asm volatile("s_waitcnt vmcnt(0)" ::: "memory")
__device__ __forceinline__ unsigned long long rt() { return __builtin_amdgcn_s_memrealtime(); }
#define XB_TMO      128
#define XB_XCNT(j)  (256  + 64 * (j))
#define XB_XSUB(j)  (1280 + 64 * (j))
#define XB_XGEN(j)  (2304 + 64 * (j))
#define XB_TOP      3328
#define XB_TOPGEN   3392
#define XCD_BAR_WORDS 3456
#define XB_SPIN_CAP (1u << 18)

__device__ __forceinline__ unsigned xb_ld(unsigned* p)              { return __hip_atomic_load(p, __ATOMIC_RELAXED, __HIP_MEMORY_SCOPE_AGENT); }
__device__ __forceinline__ unsigned xb_add(unsigned* p, unsigned v) { return __hip_atomic_fetch_add(p, v, __ATOMIC_RELAXED, __HIP_MEMORY_SCOPE_AGENT); }
__device__ __forceinline__ unsigned xb_xcc_id() { return (unsigned)__builtin_amdgcn_s_getreg((3 << 11) | 20) & 0xFu; }
#define XB_SPIN(cond, bar) do { unsigned _sp = 0; while (cond) { __builtin_amdgcn_s_sleep(1); \
    if ((++_sp & 255u) == 0u) { if (xb_ld(&(bar)[XB_TMO])) break; if (_sp > XB_SPIN_CAP) { atomicAdd(&(bar)[XB_TMO], 1u); break; } } } } while (0)

struct XcdBarrier {
    unsigned* bar; unsigned x;
    volatile LAS unsigned* st;
};

__device__ __forceinline__ XcdBarrier xcd_barrier_post(unsigned* bar, volatile LAS unsigned* st) {
    XcdBarrier b; b.bar = bar; b.x = xb_xcc_id(); b.st = st;
    if (threadIdx.x == 0) (void)xb_add(&bar[XB_XCNT(b.x)], 1u);
    return b;
}
__device__ __forceinline__ void xcd_barrier_complete(unsigned* bar, unsigned x, unsigned& nloc, unsigned& nx) {
    const unsigned G = gridDim.x * gridDim.y * gridDim.z;
    unsigned sum, cnt, mine, sp = 0u;
    for (;;) {
        sum = 0u; cnt = 0u; mine = 0u;
#pragma unroll
        for (unsigned j = 0; j < 16; ++j) { const unsigned c = xb_ld(&bar[XB_XCNT(j)]); sum += c; cnt += (c > 0u) ? 1u : 0u; mine = (j == x) ? c : mine; }
        if (sum == G) break;
        __builtin_amdgcn_s_sleep(1);
        if ((++sp & 255u) == 0u) { if (xb_ld(&bar[XB_TMO])) break; if (sp > XB_SPIN_CAP) { atomicAdd(&bar[XB_TMO], 1u); break; } }
    }
    nloc = mine > 0u ? mine : 1u; nx = cnt > 0u ? cnt : 1u;
}

__device__ __forceinline__ void xcd_barrier(const XcdBarrier& b) {
    asm volatile("s_waitcnt vmcnt(0)" ::: "memory");
    __syncthreads();
    if (threadIdx.x == 0) {
        unsigned* bar = b.bar;
        __builtin_amdgcn_s_waitcnt(0);
        unsigned nloc = b.st[0], nx = b.st[1];
        if (nloc == 0u) { xcd_barrier_complete(bar, b.x, nloc, nx); b.st[0] = nloc; b.st[1] = nx; }
        const unsigned old = xb_add(&bar[XB_XSUB(b.x)], 1u);
        const unsigned gen = old / nloc;
        if (old + 1u == (gen + 1u) * nloc) {
            __builtin_amdgcn_fence(__ATOMIC_RELEASE, "agent");
            asm volatile("s_waitcnt vmcnt(0)" ::: "memory");
            const unsigned og = xb_add(&bar[XB_TOP], 1u);
            const unsigned tg = og / nx;
            if (og + 1u == (tg + 1u) * nx) xb_add(&bar[XB_TOPGEN], 1u);
            else XB_SPIN(xb_ld(&bar[XB_TOPGEN]) == tg, bar);
            __builtin_amdgcn_fence(__ATOMIC_ACQUIRE, "agent");
            xb_add(&bar[XB_XGEN(b.x)], 1u);
            asm volatile("s_waitcnt vmcnt(0)" ::: "memory");
        } else {
            XB_SPIN(xb_ld(&bar[XB_XGEN(b.x)]) == gen, bar);
            __builtin_amdgcn_fence(__ATOMIC_ACQUIRE, "agent");
            asm volatile("s_waitcnt vmcnt(0)" ::: "memory");
        }
    }
    __syncthreads();
}

typedef unsigned short u16;
typedef float f32x4 __attribute__((ext_vector_type(4)));
typedef unsigned u32x4 __attribute__((ext_vector_type(4)));
typedef unsigned u32x2 __attribute__((ext_vector_type(2)));
typedef short bf16x8 __attribute__((ext_vector_type(8)));
constexpr int DM = 2048, TP = 8192, NBP = 4, NBS = 8, TS = 64, PAST = 2048, SKVS = PAST + TS;
constexpr int MP = NBP * TP, MS_ = NBS * TS, M = MP + MS_;
constexpr int DI = 4096, CD = 6144, NH = 64, DFF = 5504, DFF2 = 11008, NIN = 20560;
constexpr int NMOD = 12288;
constexpr float EPS = 1e-6f, LOG2E = 1.4426950408889634f;
constexpr int HALF_ROWS = 16640;
constexpr size_t O_YP = 0, O_YS = O_YP + (size_t)MP * DM, O_KP = O_YS + (size_t)MS_ * DM, O_VP = O_KP + (size_t)MP * DM,
    O_LFP = O_VP + (size_t)MP * DM, O_SSMP = O_LFP + (size_t)MP * 16, O_MCP = O_SSMP + (size_t)NBP * 64 * 64 * 128, O_FCP = O_MCP + (size_t)NBP * 3 * CD,
    O_KS = O_FCP + (size_t)NBP * 2 * DFF2, O_VS = O_KS + (size_t)MS_ * DM, O_LFS = O_VS + (size_t)MS_ * DM, O_SSMS = O_LFS + (size_t)MS_ * 16,
    O_MCS = O_SSMS + (size_t)NBS * 64 * 64 * 128, O_FCS = O_MCS + (size_t)NBS * 3 * CD, O_END = O_FCS + (size_t)NBS * 2 * DFF2;
constexpr size_t MiB = 1u << 20;
constexpr size_t W_MOD = 0, W_BAR = 768 * 1024  , W_BIASP = 1 * MiB, W_BIASS = 3 * MiB, W_HALO = 5 * MiB,
    W_WUP = 8 * MiB, W_WDN = 51 * MiB, W_H = 73 * MiB, W_WIN = 203 * MiB, W_WPM = 284 * MiB, W_WPF = 300 * MiB, W_WOUT = 308 * MiB,
    W_SMALL = 316 * MiB, W_R = 349 * MiB,
    W_XBC = W_R, W_Z = W_R + 390 * MiB, W_GM = W_R, W_GF = W_R + 130 * MiB, W_Q = W_R + 260 * MiB, W_K = W_Q + 130 * MiB, W_V = W_K + 130 * MiB,
    W_U = 203 * MiB, W_G = 553 * MiB, W_END = 999 * MiB;
static_assert((size_t)M * DM * 2 == 130 * MiB && (size_t)M * CD * 2 == 390 * MiB && (size_t)M * DI * 2 == 260 * MiB, "sizes");
static_assert(W_U + (size_t)HALF_ROWS * DFF2 * 2 <= W_G && W_G + (size_t)M * DFF * 2 <= 1024 * MiB, "ffn map");
static_assert(W_SMALL + (size_t)M * 256 * 4 <= W_R, "small map");

struct Prm { const float* in[31]; float* out; unsigned char* ws; };
typedef const __attribute__((address_space(4))) Prm* KPrm;
struct Ctx { int tid, bid, G; };
enum { I_XP = 0, I_XS, I_CP, I_CS, I_CK, I_CV, I_CLF, I_SSM, I_MCV, I_FCV, I_N1W, I_N2W, I_WADA, I_BADA, I_WIN, I_MCW, I_MCB, I_DTB, I_ALOG, I_MD, I_MNW,
       I_FB, I_QNW, I_KNW, I_WPM, I_WPF, I_WOUT, I_WUP, I_FCW, I_FCB, I_WDN };

__device__ __forceinline__ float bflo(unsigned w) { return __uint_as_float(w << 16); }
__device__ __forceinline__ float bfhi(unsigned w) { return __uint_as_float(w & 0xffff0000u); }
typedef float f32x2_t __attribute__((ext_vector_type(2))); typedef __bf16 bf16x2_t __attribute__((ext_vector_type(2)));
__device__ __forceinline__ unsigned pk2(float lo, float hi) { f32x2_t v = {lo, hi}; bf16x2_t b = __builtin_convertvector(v, bf16x2_t); return __builtin_bit_cast(unsigned, b); }
__device__ __forceinline__ u16 f2bf(float f) { return (u16)(pk2(f, 0.f) & 0xffffu); }
__device__ __forceinline__ void unpack8(u32x4 w, float* v) { v[0] = bflo(w.x); v[1] = bfhi(w.x); v[2] = bflo(w.y); v[3] = bfhi(w.y); v[4] = bflo(w.z); v[5] = bfhi(w.z); v[6] = bflo(w.w); v[7] = bfhi(w.w); }
__device__ __forceinline__ u32x4 pack8f(const float* v) { u32x4 w; w.x = pk2(v[0], v[1]); w.y = pk2(v[2], v[3]); w.z = pk2(v[4], v[5]); w.w = pk2(v[6], v[7]); return w; }
__device__ __forceinline__ float bfel(const u32x4& w, int e) { const unsigned x = w[e >> 1]; return (e & 1) ? bfhi(x) : bflo(x); }
__device__ __forceinline__ float sigmoidf_(float x) { return 1.f / (1.f + __expf(-x)); }
__device__ __forceinline__ float siluf_(float x) { return x / (1.f + __expf(-x)); }
__device__ __forceinline__ float wave_sum(float v) {
#pragma unroll
    for (int o = 1; o < 64; o <<= 1) v += __shfl_xor(v, o);
    return v;
}
__device__ __forceinline__ int mod_row(int row) { return row < MP ? (row >> 13) : 4 + ((row - MP) >> 6); }

struct Epi {
    static constexpr bool PERM = true, AFTER_DRAIN = false;
    int mode;
    u16* d0; u16* d1; u16* d2; int t1, t2, p0, p1, p2, f32seg2, vseg2; float* vout; u16* vslab;
    const float* xp; const float* xs; float* y; const float* mod; u16* gbuf; const u16* gf;
    __device__ __forceinline__ void operator()(const f32x4 (&acc)[2][2][4][2], const pg8::Unit& u, int wr, int wc, int fr, int fq) const {
        const int rl = u.pm * 256 + u.ho * 128 + wr * 64 + fr, cl = wc * 32 + 8 * fq;
        const int nai = u.half ? 1 : 2;
        if (mode == 0) {
            u16* base; int pitch, ct; bool f32o = false;
            if (u.pn < t1) { base = d0; pitch = p0; ct = u.pn; } else if (u.pn < t2) { base = d1; pitch = p1; ct = u.pn - t1; } else { base = d2; pitch = p2; ct = u.pn - t2; f32o = (f32seg2 != 0); }
            if (!f32o) {
#pragma unroll
                for (int ai = 0; ai < nai; ++ai)
#pragma unroll
                    for (int m = 0; m < 4; ++m) { u16* rp = base + (size_t)(rl + ai * 128 + m * 16) * pitch + ct * 256 + cl;
#pragma unroll
                        for (int bj = 0; bj < 2; ++bj) { const f32x4 v0 = acc[ai][bj][m][0], v1 = acc[ai][bj][m][1]; u32x4 w; w.x = pk2(v0[0], v0[1]); w.y = pk2(v0[2], v0[3]); w.z = pk2(v1[0], v1[1]); w.w = pk2(v1[2], v1[3]);
                            *(u32x4*)(rp + bj * 128) = w; } }
                if (vseg2 && u.pn >= t2) {
#pragma unroll
                    for (int ai = 0; ai < nai; ++ai)
#pragma unroll
                        for (int m = 0; m < 4; ++m) { const int row = rl + ai * 128 + m * 16; const int col = ct * 256 + cl;
                            float* vo = (row < MP) ? vout + (size_t)row * DM + col : vout + (O_VS - O_VP) + (size_t)(row - MP) * DM + col;
#pragma unroll
                            for (int bj = 0; bj < 2; ++bj) { *(f32x4*)(vo + bj * 128) = acc[ai][bj][m][0]; *(f32x4*)(vo + bj * 128 + 4) = acc[ai][bj][m][1]; }
                            if (row >= MP) { const int sb = (row - MP) >> 6, t = (row - MP) & 63; u16* sp = vslab + (size_t)(sb * SKVS + PAST + t) * DM + col;
#pragma unroll
                                for (int bj = 0; bj < 2; ++bj) { const f32x4 v0 = acc[ai][bj][m][0], v1 = acc[ai][bj][m][1]; u32x4 w; w.x = pk2(v0[0], v0[1]); w.y = pk2(v0[2], v0[3]); w.z = pk2(v1[0], v1[1]); w.w = pk2(v1[2], v1[3]);
                                    *(u32x4*)(sp + bj * 128) = w; } } }
                }
            } else {
                float* fb = (float*)base;
#pragma unroll
                for (int ai = 0; ai < nai; ++ai)
#pragma unroll
                    for (int m = 0; m < 4; ++m) { float* rp = fb + (size_t)(rl + ai * 128 + m * 16) * pitch + ct * 256 + cl;
#pragma unroll
                        for (int bj = 0; bj < 2; ++bj) { *(f32x4*)(rp + bj * 128) = acc[ai][bj][m][0]; *(f32x4*)(rp + bj * 128 + 4) = acc[ai][bj][m][1]; } }
            }
        } else if (mode == 1 || mode == 2) {
#pragma unroll
            for (int ai = 0; ai < nai; ++ai) {
                u32x4 gw[4][2], fw[4][2];
#pragma unroll
                for (int m = 0; m < 4; ++m) { const size_t off = (size_t)(rl + ai * 128 + m * 16) * DM + u.pn * 256 + cl;
#pragma unroll
                    for (int bj = 0; bj < 2; ++bj) { gw[m][bj] = *(const u32x4*)(gbuf + off + bj * 128); if (mode == 2) fw[m][bj] = *(const u32x4*)(gf + off + bj * 128); else fw[m][bj] = gw[m][bj]; } }
#pragma unroll
                for (int m = 0; m < 4; ++m) { const size_t off = (size_t)(rl + ai * 128 + m * 16) * DM + u.pn * 256 + cl;
#pragma unroll
                    for (int bj = 0; bj < 2; ++bj) { const f32x4 v0 = acc[ai][bj][m][0], v1 = acc[ai][bj][m][1];
                        float a[8] = {v0[0], v0[1], v0[2], v0[3], v1[0], v1[1], v1[2], v1[3]}, g[8], o[8];
                        unpack8(gw[m][bj], g);
                        if (mode == 1) {
#pragma unroll
                            for (int e = 0; e < 8; ++e) o[e] = sigmoidf_(g[e]) * a[e];
                        } else { float f[8]; unpack8(fw[m][bj], f);
#pragma unroll
                            for (int e = 0; e < 8; ++e) o[e] = g[e] + sigmoidf_(f[e]) * a[e]; }
                        *(u32x4*)(gbuf + off + bj * 128) = pack8f(o); } }
            }
        } else {
#pragma unroll
            for (int ai = 0; ai < nai; ++ai) {
                const int mb = (u.pm < 128) ? (u.pm >> 5) : (4 + (u.pm - 128) * 4 + u.ho * 2 + ai * 2 + wr);
                const float* gp = mod + (size_t)mb * NMOD + (mode == 3 ? 4096 : 10240) + u.pn * 256 + cl;
                f32x4 gv[2][2], pre[4][2][2];
#pragma unroll
                for (int m = 0; m < 4; ++m) { const int row = rl + ai * 128 + m * 16; const size_t off = (size_t)row * DM + u.pn * 256 + cl;
                    const float* xr = (mode == 3) ? ((row < MP) ? xp + off : xs + (off - (size_t)MP * DM)) : (const float*)(y + off);
#pragma unroll
                    for (int bj = 0; bj < 2; ++bj) { pre[m][bj][0] = *(const f32x4*)(xr + bj * 128); pre[m][bj][1] = *(const f32x4*)(xr + bj * 128 + 4); } }
#pragma unroll
                for (int bj = 0; bj < 2; ++bj) { gv[bj][0] = *(const f32x4*)(gp + bj * 128); gv[bj][1] = *(const f32x4*)(gp + bj * 128 + 4); }
#pragma unroll
                for (int m = 0; m < 4; ++m) { const int row = rl + ai * 128 + m * 16; const size_t off = (size_t)row * DM + u.pn * 256 + cl;
#pragma unroll
                    for (int bj = 0; bj < 2; ++bj) { *(f32x4*)(y + off + bj * 128) = pre[m][bj][0] + gv[bj][0] * acc[ai][bj][m][0]; *(f32x4*)(y + off + bj * 128 + 4) = pre[m][bj][1] + gv[bj][1] * acc[ai][bj][m][1]; } }
            }
        }
    }
};

__device__ __forceinline__ int map_in(int n) {
    if (n < 4096) return 6144 + n;
    if (n < 10240) return n - 4096;
    if (n < 10304) return 10240 + (n - 10240);
    if (n < 12352) return 14592 + (n - 10304);
    if (n < 14400) return 16640 + (n - 12352);
    if (n < 16448) return 18688 + (n - 14400);
    if (n < 16464) return 10304 + (n - 16448);
    if (n < 18512) return 10496 + (n - 16464);
    return 12544 + (n - 18512);
}
__device__ __forceinline__ int map_up(int n) { if (n < DFF) return (n >> 7) * 256 + (n & 127); const int f = n - DFF; return (f >> 7) * 256 + 128 + (f & 127); }
template <int MAP> __device__ __forceinline__ void tr_item(const float* __restrict__ W, int K, int N, u16* WT, float* scr, int item, int lane) {
    const int nblk = (N + 31) / 32, kb = item / nblk, nb = item % nblk, k0 = 64 * kb, n0 = 32 * nb;
    const int nn = n0 + (lane & 31);
    float tv[32];
#pragma unroll
    for (int i = 0; i < 32; ++i) { const int kk = 2 * i + (lane >> 5); tv[i] = (nn < N) ? W[(size_t)(k0 + kk) * N + nn] : 0.f; }
#pragma unroll
    for (int i = 0; i < 32; ++i) { const int kk = 2 * i + (lane >> 5); scr[kk * 33 + (lane & 31)] = tv[i]; }
    asm volatile("s_waitcnt lgkmcnt(0)" ::: "memory");
    const int c = lane & 7;
#pragma unroll
    for (int j = 0; j < 4; ++j) { const int n = (lane >> 3) + 8 * j; const float* s = scr + (8 * c) * 33 + n;
        if (n0 + n < N) { const int row = (MAP == 1) ? map_in(n0 + n) : (MAP == 2) ? map_up(n0 + n) : (n0 + n);
            u32x4 o; o.x = pk2(s[0 * 33], s[1 * 33]); o.y = pk2(s[2 * 33], s[3 * 33]); o.z = pk2(s[4 * 33], s[5 * 33]); o.w = pk2(s[6 * 33], s[7 * 33]);
            *(u32x4*)(WT + (size_t)row * K + k0 + 8 * c) = o; } }
    asm volatile("s_waitcnt lgkmcnt(0)" ::: "memory");
}
__device__ __forceinline__ void phase_prep(KPrm p, const Ctx cx, unsigned char* lds) {
    const int tid = cx.tid, lane = tid & 63, wid = tid >> 6, G = cx.G;
    unsigned char* ws = p->ws;
    {
        float* scr = (float*)(lds + wid * 8448);
        const int gw = cx.bid * 8 + wid, NGW = G * 8;
        constexpr int I_IN = 32 * 643, I_PM = 64 * 64, I_PF = 32 * 64, I_OUT = 32 * 64, I_UP = 32 * 344, I_DN = 86 * 64;
        constexpr int NIT = I_IN + I_PM + I_PF + I_OUT + I_UP + I_DN;
        for (int it = gw; it < NIT; it += NGW) {
            int r = it;
            if (r < I_IN) { tr_item<1>(p->in[I_WIN], DM, NIN, (u16*)(ws + W_WIN), scr, r, lane); continue; } r -= I_IN;
            if (r < I_PM) { tr_item<0>(p->in[I_WPM], DI, DM, (u16*)(ws + W_WPM), scr, r, lane); continue; } r -= I_PM;
            if (r < I_PF) { tr_item<0>(p->in[I_WPF], DM, DM, (u16*)(ws + W_WPF), scr, r, lane); continue; } r -= I_PF;
            if (r < I_OUT) { tr_item<0>(p->in[I_WOUT], DM, DM, (u16*)(ws + W_WOUT), scr, r, lane); continue; } r -= I_OUT;
            if (r < I_UP) { tr_item<2>(p->in[I_WUP], DM, DFF2, (u16*)(ws + W_WUP), scr, r, lane); continue; } r -= I_UP;
            tr_item<0>(p->in[I_WDN], DFF, DM, (u16*)(ws + W_WDN), scr, r, lane);
        }
    }
    __syncthreads();
    {
        float* sl = (float*)lds;
        float* red = (float*)(lds + 12 * 2048 * 4);
        for (int e = tid; e < 12 * 2048; e += 512) { const int b = e >> 11, i = e & 2047; const float cv = (b < 4) ? p->in[I_CP][b * 2048 + i] : p->in[I_CS][(b - 4) * 2048 + i]; sl[e] = siluf_(cv); }
        __syncthreads();
        const float* wada = p->in[I_WADA]; float* mod = (float*)(ws + W_MOD);
        const int col = tid & 31, part = tid >> 5;
        for (int item = cx.bid; item < NMOD / 32; item += G) {
            float acc[12];
#pragma unroll
            for (int b = 0; b < 12; ++b) acc[b] = 0.f;
            const float* wp = wada + (size_t)(part * 128) * NMOD + item * 32 + col;
#pragma unroll 8
            for (int d = 0; d < 128; ++d) { const float w = wp[(size_t)d * NMOD];
#pragma unroll
                for (int b = 0; b < 12; ++b) acc[b] += sl[b * 2048 + part * 128 + d] * w; }
#pragma unroll
            for (int b = 0; b < 12; ++b) red[(part * 12 + b) * 32 + col] = acc[b];
            __syncthreads();
            if (tid < 384) { const int b = tid >> 5; float s = p->in[I_BADA][item * 32 + col];
#pragma unroll
                for (int q = 0; q < 16; ++q) s += red[(q * 12 + b) * 32 + col];
                mod[b * NMOD + item * 32 + col] = s; }
            __syncthreads();
        }
    }
    {
        u16* Ks = (u16*)p->out; u16* Vs = Ks + (size_t)NBS * SKVS * DM;
        const size_t tot8 = (size_t)NBS * PAST * DM / 8, gt = (size_t)cx.bid * 512 + tid, GT = (size_t)G * 512;
        for (size_t i0 = gt; i0 < 2 * tot8; i0 += 4 * GT) {
            f32x4 a[4], b[4]; size_t dsto[4]; bool ok[4]; int wh[4];
#pragma unroll
            for (int u = 0; u < 4; ++u) { const size_t i = i0 + (size_t)u * GT; ok[u] = i < 2 * tot8; const size_t ii = ok[u] ? i : 0; wh[u] = ii >= tot8; const size_t j = ii - (wh[u] ? tot8 : 0);
                const size_t sb = j / ((size_t)PAST * 256), rem = j % ((size_t)PAST * 256), row = rem >> 8, c8 = rem & 255;
                const float* src = p->in[wh[u] ? I_CV : I_CK] + ((sb * PAST + row) * DM + c8 * 8);
                a[u] = *(const f32x4*)src; b[u] = *(const f32x4*)(src + 4); dsto[u] = (sb * SKVS + row) * DM + c8 * 8; }
#pragma unroll
            for (int u = 0; u < 4; ++u) if (ok[u]) { u32x4 o; o.x = pk2(a[u][0], a[u][1]); o.y = pk2(a[u][2], a[u][3]); o.z = pk2(b[u][0], b[u][1]); o.w = pk2(b[u][2], b[u][3]);
                *(u32x4*)((wh[u] ? Vs : Ks) + dsto[u]) = o; }
        }
    }
}
__device__ __forceinline__ void phase_norm(KPrm p, const Ctx cx, int which) {
    const int tid = cx.tid, lane = tid & 63, wid = tid >> 6;
    const int gw = cx.bid * 8 + wid, NGW = cx.G * 8;
    const float* mod = (const float*)(p->ws + W_MOD); u16* H = (u16*)(p->ws + W_H);
    const float* nw = p->in[which ? I_N2W : I_N1W];
    const int osh = which ? 6144 : 0, osc = which ? 8192 : 2048;
    for (int row0 = 2 * gw; row0 < M; row0 += 2 * NGW) {
        f32x4 v[2][8];
#pragma unroll
        for (int rr = 0; rr < 2; ++rr) { const int row = row0 + rr;
            const float* xr = which ? (p->out + (size_t)row * DM) : ((row < MP) ? p->in[I_XP] + (size_t)row * DM : p->in[I_XS] + (size_t)(row - MP) * DM);
#pragma unroll
            for (int j = 0; j < 8; ++j) v[rr][j] = ((const f32x4*)xr)[lane + 64 * j]; }
#pragma unroll
        for (int rr = 0; rr < 2; ++rr) { const int row = row0 + rr;
            const float* mr = mod + (size_t)mod_row(row) * NMOD;
            float ss = 0.f;
#pragma unroll
            for (int j = 0; j < 8; ++j) ss += (v[rr][j][0] * v[rr][j][0] + v[rr][j][1] * v[rr][j][1]) + (v[rr][j][2] * v[rr][j][2] + v[rr][j][3] * v[rr][j][3]);
            const float rs = rsqrtf(wave_sum(ss) * (1.f / DM) + EPS);
#pragma unroll
            for (int j = 0; j < 8; ++j) { const int col = 4 * (lane + 64 * j);
                const f32x4 w = *(const f32x4*)(nw + col), sc = *(const f32x4*)(mr + osc + col), sh = *(const f32x4*)(mr + osh + col);
                const f32x4 o = v[rr][j] * rs * w * (sc + 1.f) + sh;
                u32x2 q; q.x = pk2(o[0], o[1]); q.y = pk2(o[2], o[3]);
                *(u32x2*)(H + (size_t)row * DM + col) = q; } }
    }
}
__device__ __forceinline__ void phase_conv(KPrm p, const Ctx cx) {
    const u16* XBC = (const u16*)(p->ws + W_XBC); u16* ACT = (u16*)(p->out + O_KP);
    const float* cw = p->in[I_MCW]; const float* cb = p->in[I_MCB];
    {
                const int gt2 = cx.bid * 512 + cx.tid, GT2 = cx.G * 512;
        for (int i = gt2; i < 12 * 3 * CD; i += GT2) { const int bb = i / (3 * CD), r = (i / CD) % 3, c = i % CD;
            if (bb < 4) p->out[O_MCP + i] = bflo(XBC[(size_t)(bb * TP + TP - 3 + r) * CD + c]);
            else p->out[O_MCS + (i - 4 * 3 * CD)] = bflo(XBC[(size_t)(MP + (bb - 4) * TS + TS - 3 + r) * CD + c]); }
    }
    constexpr int NCG = CD / 8, RB = 16, NRB = M / RB;
    const long gt = (long)cx.bid * 512 + cx.tid, GT = (long)cx.G * 512;
    for (long it = gt; it < (long)NCG * NRB; it += GT) {
        const int cgi = (int)(it % NCG), rb = (int)(it / NCG), c0 = cgi * 8, r0 = rb * RB;
        float w[4][8], bs[8];
#pragma unroll
        for (int j = 0; j < 4; ++j) { const f32x4 a0 = *(const f32x4*)(cw + j * CD + c0), a1 = *(const f32x4*)(cw + j * CD + c0 + 4);
#pragma unroll
            for (int e = 0; e < 4; ++e) { w[j][e] = a0[e]; w[j][4 + e] = a1[e]; } }
        { const f32x4 a0 = *(const f32x4*)(cb + c0), a1 = *(const f32x4*)(cb + c0 + 4);
#pragma unroll
          for (int e = 0; e < 4; ++e) { bs[e] = a0[e]; bs[4 + e] = a1[e]; } }
        float h[3][8];
        const bool smp = r0 >= MP; const int tb = smp ? ((r0 - MP) & 63) : (r0 & (TP - 1));
        if (tb == 0) {
            if (smp) { const float* s = p->in[I_MCV] + (size_t)((r0 - MP) >> 6) * 3 * CD + c0;
#pragma unroll
                for (int k = 0; k < 3; ++k)
#pragma unroll
                    for (int e = 0; e < 8; ++e) h[k][e] = s[k * CD + e];
            } else {
#pragma unroll
                for (int k = 0; k < 3; ++k)
#pragma unroll
                    for (int e = 0; e < 8; ++e) h[k][e] = 0.f; }
        } else {
#pragma unroll
            for (int k = 0; k < 3; ++k) unpack8(*(const u32x4*)(XBC + (size_t)(r0 - 3 + k) * CD + c0), h[k]);
        }
        u32x4 ur[RB];
#pragma unroll
        for (int i = 0; i < RB; ++i) ur[i] = *(const u32x4*)(XBC + (size_t)(r0 + i) * CD + c0);
#pragma unroll
        for (int i = 0; i < RB; ++i) { float u[8], o[8]; unpack8(ur[i], u);
#pragma unroll
            for (int e = 0; e < 8; ++e) { const float v = bs[e] + w[0][e] * h[0][e] + w[1][e] * h[1][e] + w[2][e] * h[2][e] + w[3][e] * u[e];
                o[e] = siluf_(v); h[0][e] = h[1][e]; h[1][e] = h[2][e]; h[2][e] = u[e]; }
            *(u32x4*)(ACT + (size_t)(r0 + i) * CD + c0) = pack8f(o); }
    }
}
constexpr int SXP = 72, SNP = 136, SYP = 68;
constexpr int L_XT = 0, L_CN = L_XT + 64 * SXP * 2, L_BN = L_CN + 64 * SNP * 2, L_BWT = L_BN + 64 * SNP * 2, L_MS = L_BWT + 128 * SXP * 2, L_HS = L_MS + 64 * SXP * 2,
              L_YS = L_HS + 64 * SNP * 2, L_DT = L_YS + 64 * SYP * 4, L_CUM = L_DT + 256, L_SSD_END = L_CUM + 256;
static_assert(L_SSD_END <= 131072, "ssd lds");
__device__ __forceinline__ void phase_ssd(KPrm p, const Ctx cx, unsigned char* lds) {
    const int tid = cx.tid, lane = tid & 63, wid = __builtin_amdgcn_readfirstlane(tid >> 6), quad = lane >> 4, l15 = lane & 15;
    u16* XT = (u16*)(lds + L_XT); u16* CN = (u16*)(lds + L_CN); u16* BN = (u16*)(lds + L_BN); u16* BWT = (u16*)(lds + L_BWT);
    u16* MSm = (u16*)(lds + L_MS); u16* HS = (u16*)(lds + L_HS); float* YS = (float*)(lds + L_YS); float* DT = (float*)(lds + L_DT); float* CUM = (float*)(lds + L_CUM);
    const u16* XBC = (const u16*)(p->out + O_KP);     u16* Z = (u16*)(p->ws + W_Z); const float* SM = (const float*)(p->ws + W_SMALL);
    const int cg8 = tid & 31, tq = tid >> 5, cgx = tid & 7, tx = tid >> 3;
    const int pb = wid >> 1;
    for (int ch = cx.bid; ch < 256 + 512; ch += cx.G) {
        const bool smp = ch >= 256; int b, hd, nc; long rowbase;
        if (!smp) { b = ch >> 6; hd = ch & 63; nc = TP / 64; rowbase = (long)b * TP; } else { const int su = ch - 256; b = su >> 6; hd = su & 63; nc = 1; rowbase = MP + (long)b * TS; }
        const int g = hd >> 3;
        const float a_h = -__expf(p->in[I_ALOG][hd]), dtb = p->in[I_DTB][hd], Dh = p->in[I_MD][hd];
        const int bccol = (cg8 < 16) ? (4096 + g * 128 + cg8 * 8) : (5120 + g * 128 + (cg8 - 16) * 8);
        const int xcol = hd * 64 + cgx * 8;
        f32x4 st[4];
        const int st_off = (pb * 16 + quad * 4) * 128 + (4 * (wid & 1)) * 16 + l15, hs_off = (pb * 16 + quad * 4) * SNP + (4 * (wid & 1)) * 16 + l15;
        { const float* sin_ = p->in[I_SSM] + ((size_t)b * 64 + hd) * 64 * 128 + st_off;
#pragma unroll
          for (int i = 0; i < 4; ++i)
#pragma unroll
            for (int j = 0; j < 4; ++j) st[i][j] = smp ? sin_[j * 128 + i * 16] : 0.f; }
        __syncthreads();
        { u16* hp_ = HS + hs_off;
#pragma unroll
          for (int i = 0; i < 4; ++i)
#pragma unroll
            for (int j = 0; j < 4; ++j) hp_[j * SNP + i * 16] = f2bf(st[i][j]); }
        u32x4 rbcA[4], rxA, znA, rbcB[4], rxB, znB, pend = {0u, 0u, 0u, 0u}; float dtrA = 0.f, dtrB = 0.f;
#define SSD_LOADS(cc, rbc, rx, zn, dtr) do { const int t0_ = (cc) * 64; \
            const u16* pb_ = XBC + (rowbase + t0_ + 4 * tq) * (long)CD + bccol; const u16* px_ = XBC + (rowbase + t0_ + tx) * (long)CD + xcol; \
            asm volatile("" : "+v"(pb_), "+v"(px_));     \
            _Pragma("unroll") for (int i = 0; i < 4; ++i) rbc[i] = *(const u32x4*)(pb_ + i * CD); \
            rx = *(const u32x4*)px_; \
            zn = *(const u32x4*)(Z + (size_t)(rowbase + t0_ + tx) * DI + xcol); \
            dtr = SM[(size_t)(rowbase + t0_ + lane) * 256 + hd]; } while (0)
#define LBAR() do { asm volatile("s_waitcnt lgkmcnt(0)" ::: "memory"); __builtin_amdgcn_s_barrier(); asm volatile("" ::: "memory"); } while (0)
        SSD_LOADS(0, rbcA, rxA, znA, dtrA); if (nc > 1) SSD_LOADS(1, rbcB, rxB, znB, dtrB);
        auto body = [&](const int c, u32x4 (&rbc)[4], u32x4& rx, u32x4& zn, float& dtr) __attribute__((always_inline)) {
            const long r0 = rowbase + (long)c * 64;
            const u32x4 zw = zn;
            float cum_end;
            { const float dr = dtr + dtb; const float dtv = dr > 20.f ? dr : __logf(1.f + __expf(dr));
              float x = dtv * a_h;
#define DPP_ADD(ctrl, rmask) x += __int_as_float(__builtin_amdgcn_update_dpp(0, __float_as_int(x), ctrl, rmask, 0xf, true))
              DPP_ADD(0x111, 0xf); DPP_ADD(0x112, 0xf); DPP_ADD(0x114, 0xf); DPP_ADD(0x118, 0xf);
              DPP_ADD(0x142, 0xa);
              DPP_ADD(0x143, 0xc);
#undef DPP_ADD
              DT[lane] = dtv; CUM[lane] = x; cum_end = __int_as_float(__builtin_amdgcn_readlane(__float_as_int(x), 63)); }
            {
                u16* NAT = (cg8 < 16) ? BN : CN; const int nc0 = (cg8 & 15) * 8;
#pragma unroll
                for (int ii = 0; ii < 4; ++ii) *(u32x4*)(NAT + (4 * tq + ii) * SNP + nc0) = rbc[ii];
                if (cg8 < 16) {
                    float wg[4]; const f32x4 dt4 = *(const f32x4*)(DT + 4 * tq), cu4 = *(const f32x4*)(CUM + 4 * tq);
#pragma unroll
                    for (int ii = 0; ii < 4; ++ii) wg[ii] = dt4[ii] * __expf(cum_end - cu4[ii]);
#pragma unroll
                    for (int e = 0; e < 8; ++e) { u32x2 q; q.x = pk2(bfel(rbc[0], e) * wg[0], bfel(rbc[1], e) * wg[1]); q.y = pk2(bfel(rbc[2], e) * wg[2], bfel(rbc[3], e) * wg[3]);
                        *(u32x2*)(BWT + (nc0 + e) * SXP + 4 * tq) = q; }
                }
            }
            float xv[8]; unpack8(rx, xv);
#pragma unroll
            for (int e = 0; e < 8; ++e) XT[(cgx * 8 + e) * SXP + tx] = (u16)((e & 1) ? (rx[e >> 1] >> 16) : (rx[e >> 1] & 0xffffu));
            LBAR();
            if (c > 0) *(u32x4*)(Z + (size_t)(r0 - 64 + tx) * DI + xcol) = pend;
            if (c + 2 < nc) SSD_LOADS(c + 2, rbc, rx, zn, dtr);
            const int ti = wid >> 1;
            f32x4 yo[2];
            {
                bf16x8 ca[4], bb[2][4], hb[2][4];
#pragma unroll
                for (int kk = 0; kk < 4; ++kk) ca[kk] = *(const bf16x8*)(CN + (ti * 16 + l15) * SNP + kk * 32 + quad * 8);
#pragma unroll
                for (int s2 = 0; s2 < 2; ++s2)
#pragma unroll
                    for (int kk = 0; kk < 4; ++kk) { bb[s2][kk] = *(const bf16x8*)(BN + ((2 * (wid & 1) + s2) * 16 + l15) * SNP + kk * 32 + quad * 8);
                        hb[s2][kk] = *(const bf16x8*)(HS + ((2 * (wid & 1) + s2) * 16 + l15) * SNP + kk * 32 + quad * 8); }
                const f32x4 ct4 = *(const f32x4*)(CUM + ti * 16 + quad * 4);
                float cs[2], ds[2];
#pragma unroll
                for (int s2 = 0; s2 < 2; ++s2) { const int sx = (2 * (wid & 1) + s2) * 16 + l15; cs[s2] = CUM[sx]; ds[s2] = DT[sx]; }
                f32x4 ga[2] = {{0.f, 0.f, 0.f, 0.f}, {0.f, 0.f, 0.f, 0.f}}; yo[0] = (f32x4){0.f, 0.f, 0.f, 0.f}; yo[1] = (f32x4){0.f, 0.f, 0.f, 0.f};
#pragma unroll
                for (int kk = 0; kk < 4; ++kk) {
                    ga[0] = __builtin_amdgcn_mfma_f32_16x16x32_bf16(ca[kk], bb[0][kk], ga[0], 0, 0, 0); ga[1] = __builtin_amdgcn_mfma_f32_16x16x32_bf16(ca[kk], bb[1][kk], ga[1], 0, 0, 0);
                    yo[0] = __builtin_amdgcn_mfma_f32_16x16x32_bf16(ca[kk], hb[0][kk], yo[0], 0, 0, 0); yo[1] = __builtin_amdgcn_mfma_f32_16x16x32_bf16(ca[kk], hb[1][kk], yo[1], 0, 0, 0); }
#pragma unroll
                for (int s2 = 0; s2 < 2; ++s2) { const int s_ = (2 * (wid & 1) + s2) * 16 + l15;
#pragma unroll
                    for (int j = 0; j < 4; ++j) { const int t = ti * 16 + quad * 4 + j; const float msk = (s_ <= t) ? ds[s2] : 0.f;
                        const float val = ga[s2][j] * __expf(fminf(ct4[j] - cs[s2], 0.f)) * msk; MSm[t * SXP + s_] = f2bf(val); } }
#pragma unroll
                for (int p2 = 0; p2 < 2; ++p2)
#pragma unroll
                    for (int j = 0; j < 4; ++j) yo[p2][j] *= __expf(ct4[j]);
            }
            LBAR();
            {
                bf16x8 ma[2], xa[2], xb[2][2], wb[4][2];
#pragma unroll
                for (int kk = 0; kk < 2; ++kk) { ma[kk] = *(const bf16x8*)(MSm + (ti * 16 + l15) * SXP + kk * 32 + quad * 8); xa[kk] = *(const bf16x8*)(XT + (pb * 16 + l15) * SXP + kk * 32 + quad * 8);
#pragma unroll
                    for (int p2 = 0; p2 < 2; ++p2) xb[p2][kk] = *(const bf16x8*)(XT + ((2 * (wid & 1) + p2) * 16 + l15) * SXP + kk * 32 + quad * 8);
#pragma unroll
                    for (int i = 0; i < 4; ++i) wb[i][kk] = *(const bf16x8*)(BWT + ((4 * (wid & 1) + i) * 16 + l15) * SXP + kk * 32 + quad * 8); }
                const float dec = __expf(cum_end);
#pragma unroll
                for (int i = 0; i < 4; ++i) st[i] = st[i] * dec;
#pragma unroll
                for (int kk = 0; kk < 2; ++kk) {
                    yo[0] = __builtin_amdgcn_mfma_f32_16x16x32_bf16(ma[kk], xb[0][kk], yo[0], 0, 0, 0); yo[1] = __builtin_amdgcn_mfma_f32_16x16x32_bf16(ma[kk], xb[1][kk], yo[1], 0, 0, 0);
#pragma unroll
                    for (int i = 0; i < 4; ++i) st[i] = __builtin_amdgcn_mfma_f32_16x16x32_bf16(xa[kk], wb[i][kk], st[i], 0, 0, 0); }
#pragma unroll
                for (int p2 = 0; p2 < 2; ++p2)
#pragma unroll
                    for (int j = 0; j < 4; ++j) YS[(ti * 16 + quad * 4 + j) * SYP + (2 * (wid & 1) + p2) * 16 + l15] = yo[p2][j];
                u16* hp_ = HS + hs_off;
#pragma unroll
                for (int i = 0; i < 4; ++i)
#pragma unroll
                    for (int j = 0; j < 4; ++j) hp_[j * SNP + i * 16] = f2bf(st[i][j]);
            }
            LBAR();
            {
                const f32x4 y0 = *(const f32x4*)(YS + tx * SYP + cgx * 8), y1 = *(const f32x4*)(YS + tx * SYP + cgx * 8 + 4);
                float zf[8], o[8]; unpack8(zw, zf);
#pragma unroll
                for (int e = 0; e < 8; ++e) { const float yv = (e < 4 ? y0[e & 3] : y1[e & 3]) + Dh * xv[e]; o[e] = yv * siluf_(zf[e]); }
                pend = pack8f(o);
            }
        };
        for (int c = 0; c < nc; c += 2) { body(c, rbcA, rxA, znA, dtrA); if (c + 1 < nc) body(c + 1, rbcB, rxB, znB, dtrB); }
        *(u32x4*)(Z + (size_t)(rowbase + (long)(nc - 1) * 64 + tx) * DI + xcol) = pend;
#undef SSD_LOADS
#undef LBAR
        float* so = p->out + (smp ? O_SSMS : O_SSMP) + ((size_t)b * 64 + hd) * 64 * 128 + st_off;
#pragma unroll
        for (int i = 0; i < 4; ++i)
#pragma unroll
            for (int j = 0; j < 4; ++j) so[j * 128 + i * 16] = st[i][j];
        __syncthreads();
    }
}
__device__ __forceinline__ float logsig_(float f) { return fminf(f, 0.f) - log1pf(__expf(-fabsf(f))); }
__device__ __forceinline__ void phase_gn(KPrm p, const Ctx cx) {
    const int tid = cx.tid, lane = tid & 63, wid = tid >> 6;
    const int gw = cx.bid * 8 + wid, NGW = cx.G * 8;
    const float* SM = (const float*)(p->ws + W_SMALL);
    if (gw < 192) {
        if (gw < 64) { const int b = gw >> 4, h = gw & 15; const float fb = p->in[I_FB][h];
            float* bias = (float*)(p->ws + W_BIASP) + (size_t)(b * 16 + h) * TP; float* lo = p->out + O_LFP;
            const int tb = lane * 128; float s = 0.f;
            for (int i = 0; i < 128; ++i) s += logsig_(SM[(size_t)(b * TP + tb + i) * 256 + 64 + h] + fb);
            float inc = s;
#pragma unroll
            for (int o = 1; o < 64; o <<= 1) { const float y = __shfl_up(inc, o); if (lane >= o) inc += y; }
            float run = inc - s;
            for (int i = 0; i < 128; ++i) { const float lf = logsig_(SM[(size_t)(b * TP + tb + i) * 256 + 64 + h] + fb); run += lf;
                lo[(size_t)(b * TP + tb + i) * 16 + h] = lf; bias[tb + i] = -run * LOG2E; }
        } else { const int u = gw - 64, sb = u >> 4, h = u & 15; const float fb = p->in[I_FB][h];
            float* bias = (float*)(p->ws + W_BIASS) + (size_t)(sb * 16 + h) * SKVS; float* lo = p->out + O_LFS;
            const int tb = lane * 33; float s = 0.f;
            for (int i = 0; i < 33; ++i) { const int pos = tb + i;
                s += (pos < PAST) ? p->in[I_CLF][(size_t)(sb * PAST + pos) * 16 + h] : logsig_(SM[(size_t)(MP + sb * TS + pos - PAST) * 256 + 64 + h] + fb); }
            float inc = s;
#pragma unroll
            for (int o = 1; o < 64; o <<= 1) { const float y = __shfl_up(inc, o); if (lane >= o) inc += y; }
            float run = inc - s;
            for (int i = 0; i < 33; ++i) { const int pos = tb + i; float lf;
                if (pos < PAST) lf = p->in[I_CLF][(size_t)(sb * PAST + pos) * 16 + h];
                else { lf = logsig_(SM[(size_t)(MP + sb * TS + pos - PAST) * 256 + 64 + h] + fb); lo[(size_t)(sb * TS + pos - PAST) * 16 + h] = lf; }
                run += lf; bias[pos] = -run * LOG2E; }
        }
    }
    u16* Z = (u16*)(p->ws + W_Z); const float* mnw = p->in[I_MNW];
    for (int row = gw; row < M; row += NGW) {
        u32x4 zr[8];
#pragma unroll
        for (int i = 0; i < 8; ++i) zr[i] = *(const u32x4*)(Z + (size_t)row * DI + i * 512 + lane * 8);
#pragma unroll
        for (int i = 0; i < 8; ++i) { const int col = i * 512 + lane * 8; u16* zp = Z + (size_t)row * DI + col;
            float v[8]; unpack8(zr[i], v); float ss = 0.f;
#pragma unroll
            for (int e = 0; e < 8; ++e) ss += v[e] * v[e];
            const float rs = rsqrtf(wave_sum(ss) * (1.f / 512.f) + EPS);
            const f32x4 w0 = *(const f32x4*)(mnw + col), w1 = *(const f32x4*)(mnw + col + 4);
#pragma unroll
            for (int e = 0; e < 8; ++e) v[e] = v[e] * rs * (e < 4 ? w0[e & 3] : w1[e & 3]);
            *(u32x4*)zp = pack8f(v); }
    }
}
__device__ __forceinline__ void phase_qk(KPrm p, const Ctx cx) {
    const int tid = cx.tid, lane = tid & 63, wid = tid >> 6;
    const int gw = cx.bid * 8 + wid, NGW = cx.G * 8;
    u16* K = (u16*)(p->ws + W_K);
    u16* Ks = (u16*)p->out;
    const int hc = (lane & 15) * 8;
    const f32x4 kw0 = *(const f32x4*)(p->in[I_KNW] + hc), kw1 = *(const f32x4*)(p->in[I_KNW] + hc + 4);
    for (int row = gw; row < M; row += NGW) {
        const bool smp = row >= MP;
        float* ko = smp ? p->out + O_KS + (size_t)(row - MP) * DM : p->out + O_KP + (size_t)row * DM;
        size_t srow = 0; if (smp) { const int sb = (row - MP) >> 6, t = (row - MP) & 63; srow = (size_t)(sb * SKVS + PAST + t) * DM; }
        u32x4 kr_[4];
#pragma unroll
        for (int it = 0; it < 4; ++it) { const size_t off = (size_t)row * DM + it * 512 + lane * 8; kr_[it] = *(const u32x4*)(K + off); }
#pragma unroll
        for (int it = 0; it < 4; ++it) { const int col = it * 512 + lane * 8; const size_t off = (size_t)row * DM + col;
            float v[8], ss;
            unpack8(kr_[it], v); ss = 0.f;
#pragma unroll
            for (int e = 0; e < 8; ++e) ss += v[e] * v[e];
            ss += __shfl_xor(ss, 1); ss += __shfl_xor(ss, 2); ss += __shfl_xor(ss, 4); ss += __shfl_xor(ss, 8);
            const float rs = rsqrtf(ss * (1.f / 128.f) + EPS);
#pragma unroll
            for (int e = 0; e < 8; ++e) v[e] = v[e] * rs * (e < 4 ? kw0[e & 3] : kw1[e & 3]);
            const u32x4 kp = pack8f(v);
            *(u32x4*)(K + off) = kp;
            *(f32x4*)(ko + col) = (f32x4){v[0], v[1], v[2], v[3]}; *(f32x4*)(ko + col + 4) = (f32x4){v[4], v[5], v[6], v[7]};
            if (smp) *(u32x4*)(Ks + srow + col) = kp; }
    }
}
typedef att::BlockRef<att::bf16, att::bf16> ARef;
__device__ __forceinline__ ARef att_ref(KPrm p, const Ctx cx, int i, int nbp, int& skv) {
    const int G = cx.G, bid = (cx.G % 8 == 0) ? (cx.bid % 8) * (cx.G / 8) + cx.bid / 8 : cx.bid; ARef r;
    att::bf16* Qb = (att::bf16*)(p->ws + W_Q); const att::bf16* Kb = (const att::bf16*)(p->ws + W_K); const att::bf16* Vb = (const att::bf16*)(p->ws + W_V);
    if (i < nbp) { const int L = bid + (i >> 1) * G, bh = L >> 4, x = L & 15, qb = (i & 1) ? 31 - x : x, b = bh >> 4, h = bh & 15;
        const size_t rq = ((size_t)b * TP + (size_t)qb * 256) * DM + h * 128, rk = (size_t)b * TP * DM + h * 128;
        r.Q = Qb + rq; r.O = Qb + rq; r.K = Kb + rk; r.V = Vb + rk; r.Bs = (const float*)(p->ws + W_BIASP) + (size_t)bh * TP; r.P0 = qb * 256; r.nvalid = 256; skv = TP;
    } else { const int su = bid + (i - nbp) * G, sb = su >> 4, h = su & 15;
        const att::bf16* Ks = (const att::bf16*)p->out; const att::bf16* Vs = Ks + (size_t)NBS * SKVS * DM;
        const size_t rq = ((size_t)MP + (size_t)sb * TS) * DM + h * 128, rk = (size_t)sb * SKVS * DM + h * 128;
        r.Q = Qb + rq; r.O = Qb + rq; r.K = Ks + rk; r.V = Vs + rk; r.Bs = (const float*)(p->ws + W_BIASS) + (size_t)su * SKVS; r.P0 = PAST; r.nvalid = TS; skv = SKVS; }
    return r;
}
__device__ __forceinline__ void phase_att(KPrm p, const Ctx cx, char* lds) {
    const int G = cx.G, bid = (cx.G % 8 == 0) ? (cx.bid % 8) * (cx.G / 8) + cx.bid / 8 : cx.bid;
    const int nip = (bid < 1024) ? (1024 - bid + G - 1) / G : 0, nbp = 2 * nip, nbs = (bid < 128) ? (128 - bid + G - 1) / G : 0, nb = nbp + nbs;
    if (nb == 0) return;
    const int W = 1 << 30;
    int skv, skvn; ARef cur = att_ref(p, cx, 0, nbp, skv);
    att::Seam<att::bf16> S;
    att::causal_swa_prime<att::bf16, att::bf16>(cur, W, lds, S, cx.tid);
    for (int i = 0; i < nb; ++i) {
        const bool last = (i + 1 == nb);
        ARef nxt = cur; skvn = skv; if (!last) nxt = att_ref(p, cx, i + 1, nbp, skvn);
        att::causal_swa_block<att::bf16, att::bf16>(cur, nxt, skv, W, lds, S, cx.tid, p->in[I_QNW], 0.08838834764831845f * LOG2E);
        cur = nxt; skv = skvn;
    }
}
__device__ __forceinline__ void phase_cv(KPrm p, const Ctx cx, int half) {
    const int tid = cx.tid;
    const u16* U = (const u16*)(p->ws + W_U); u16* Gb = (u16*)(p->ws + W_G); u16* HALO = (u16*)(p->ws + W_HALO);
    const float* cw = p->in[I_FCW]; const float* cb = p->in[I_FCB];
    const int row_lo = half ? HALF_ROWS : 0;
    constexpr int NCG = DFF / 8, RB = 16, NRB = HALF_ROWS / RB;
    const long gt = (long)cx.bid * 512 + tid, GT = (long)cx.G * 512;
    for (long it = gt; it < (long)NCG * NRB; it += GT) {
        const int cgi = (int)(it % NCG), rb = (int)(it / NCG); const int f0 = cgi * 8, r0 = row_lo + rb * RB;
        const int ca = (f0 >> 7) * 256 + (f0 & 127), cbb = ca + 128;
        float wa[3][8], wb[3][8], ba[8], bb[8];
#pragma unroll
        for (int k = 0; k < 3; ++k) { const f32x4 a0 = *(const f32x4*)(cw + k * DFF2 + f0), a1 = *(const f32x4*)(cw + k * DFF2 + f0 + 4), b0 = *(const f32x4*)(cw + k * DFF2 + DFF + f0), b1 = *(const f32x4*)(cw + k * DFF2 + DFF + f0 + 4);
#pragma unroll
            for (int e = 0; e < 4; ++e) { wa[k][e] = a0[e]; wa[k][4 + e] = a1[e]; wb[k][e] = b0[e]; wb[k][4 + e] = b1[e]; } }
        { const f32x4 a0 = *(const f32x4*)(cb + f0), a1 = *(const f32x4*)(cb + f0 + 4), b0 = *(const f32x4*)(cb + DFF + f0), b1 = *(const f32x4*)(cb + DFF + f0 + 4);
#pragma unroll
          for (int e = 0; e < 4; ++e) { ba[e] = a0[e]; ba[4 + e] = a1[e]; bb[e] = b0[e]; bb[4 + e] = b1[e]; } }
        float ha[2][8], hb[2][8];
        const bool smp = r0 >= MP; const int tb = smp ? ((r0 - MP) & 63) : (r0 & (TP - 1));
        if (tb == 0) {
            if (smp) { const float* s = p->in[I_FCV] + (size_t)((r0 - MP) >> 6) * 2 * DFF2;
#pragma unroll
                for (int k = 0; k < 2; ++k)
#pragma unroll
                    for (int e = 0; e < 8; ++e) { ha[k][e] = s[k * DFF2 + f0 + e]; hb[k][e] = s[k * DFF2 + DFF + f0 + e]; }
            } else {
#pragma unroll
                for (int k = 0; k < 2; ++k)
#pragma unroll
                    for (int e = 0; e < 8; ++e) { ha[k][e] = 0.f; hb[k][e] = 0.f; } }
        } else if (half && rb == 0) {
#pragma unroll
            for (int k = 0; k < 2; ++k) { unpack8(*(const u32x4*)(HALO + (size_t)k * DFF2 + ca), ha[k]); unpack8(*(const u32x4*)(HALO + (size_t)k * DFF2 + cbb), hb[k]); }
        } else {
#pragma unroll
            for (int k = 0; k < 2; ++k) { const size_t ro = (size_t)(r0 - row_lo - 2 + k) * DFF2; unpack8(*(const u32x4*)(U + ro + ca), ha[k]); unpack8(*(const u32x4*)(U + ro + cbb), hb[k]); }
        }
#pragma unroll 8
        for (int i = 0; i < RB; ++i) { const int r = r0 + i; const size_t ro = (size_t)(r - row_lo) * DFF2;
            const u32x4 uaw = *(const u32x4*)(U + ro + ca), ubw = *(const u32x4*)(U + ro + cbb);
            float ua[8], ub[8], o[8]; unpack8(uaw, ua); unpack8(ubw, ub);
#pragma unroll
            for (int e = 0; e < 8; ++e) { const float va = ba[e] + wa[0][e] * ha[0][e] + wa[1][e] * ha[1][e] + wa[2][e] * ua[e], vb = bb[e] + wb[0][e] * hb[0][e] + wb[1][e] * hb[1][e] + wb[2][e] * ub[e];
                o[e] = siluf_(va) * vb; ha[0][e] = ha[1][e]; ha[1][e] = ua[e]; hb[0][e] = hb[1][e]; hb[1][e] = ub[e]; }
            *(u32x4*)(Gb + (size_t)r * DFF + f0) = pack8f(o);
            const int tpos = (r >= MP) ? ((r - MP) & 63) : (r & (TP - 1)), tlen = (r >= MP) ? TS : TP;
            if (tpos >= tlen - 2) { float* fo = (r >= MP) ? p->out + O_FCS + ((size_t)((r - MP) >> 6) * 2 + (tpos - (tlen - 2))) * DFF2 : p->out + O_FCP + ((size_t)(r >> 13) * 2 + (tpos - (tlen - 2))) * DFF2;
#pragma unroll
                for (int e = 0; e < 8; ++e) { fo[f0 + e] = ua[e]; fo[DFF + f0 + e] = ub[e]; } }
            if (!half && r >= HALF_ROWS - 2) { *(u32x4*)(HALO + (size_t)(r - (HALF_ROWS - 2)) * DFF2 + ca) = uaw; *(u32x4*)(HALO + (size_t)(r - (HALF_ROWS - 2)) * DFF2 + cbb) = ubw; }
        }
    }
}
constexpr int LDS_TOTAL = 147456;
enum { PH_CONV = 100 };
enum { PH_PREP = 0, PH_N1, PH_G1A, PH_SSD, PH_GN, PH_G1B, PH_G2, PH_G1C, PH_QK, PH_ATT, PH_G3, PH_G4, PH_N2, PH_G5A, PH_CVA, PH_G5B, PH_CVB, PH_G6, PH_COUNT };
__device__ __forceinline__ void gsync(unsigned char* lds) {
    KPrm p0 = (KPrm)__builtin_amdgcn_kernarg_segment_ptr(); asm volatile("" : "+s"(p0));
    XcdBarrier xb; xb.bar = (unsigned*)(p0->ws + W_BAR); xb.x = xb_xcc_id(); xb.st = (volatile LAS unsigned*)(lds + LDS_TOTAL - 64);
    xcd_barrier(xb);
}
#ifndef WGM_OF
#define WGM_OF(N) 4
#endif
__device__ __forceinline__ void run_gemms(KPrm p, const Ctx cx, unsigned char* lds, const int first, const int last) {
#pragma unroll 1
    for (int ph = first; ph <= last; ++ph) {
        unsigned char* ws = p->ws;
        pg8::Gemm g; Epi E;
        g.A = (const u16*)(ws + W_H); g.Bt = nullptr; g.M = M; g.N = DM; g.K = DM;
        E.mode = 0; E.d0 = E.d1 = E.d2 = nullptr; E.t1 = E.t2 = 1 << 20; E.p0 = E.p1 = E.p2 = 0; E.f32seg2 = 0; E.vseg2 = 0; E.vout = p->out + O_VP; E.vslab = (u16*)p->out + (size_t)NBS * SKVS * DM;
        E.xp = p->in[I_XP]; E.xs = p->in[I_XS]; E.y = p->out; E.mod = (const float*)(ws + W_MOD); E.gbuf = (u16*)(ws + W_GM); E.gf = (const u16*)(ws + W_GF);
        switch (ph) {
        case PH_G1A: g.Bt = (const u16*)(ws + W_WIN); g.N = 41 * 256;
            E.d0 = (u16*)(ws + W_XBC); E.p0 = CD; E.t1 = 24; E.d1 = (u16*)(ws + W_Z); E.p1 = DI; E.t2 = 40; E.d2 = (u16*)(ws + W_SMALL); E.p2 = 256; E.f32seg2 = 1; break;
        case PH_G1B: g.Bt = (const u16*)(ws + W_WIN) + (size_t)10496 * DM; g.N = 16 * 256;
            E.d0 = (u16*)(ws + W_GM); E.p0 = DM; E.t1 = 8; E.d1 = (u16*)(ws + W_GF); E.p1 = DM; break;
        case PH_G2: g.A = (const u16*)(ws + W_Z); g.Bt = (const u16*)(ws + W_WPM); g.K = DI; E.mode = 1; break;
        case PH_G1C: g.Bt = (const u16*)(ws + W_WIN) + (size_t)14592 * DM; g.N = 24 * 256;
            E.d0 = (u16*)(ws + W_Q); E.p0 = DM; E.t1 = 8; E.d1 = (u16*)(ws + W_K); E.p1 = DM; E.t2 = 16; E.d2 = (u16*)(ws + W_V); E.p2 = DM; E.vseg2 = 1; break;
        case PH_G3: g.A = (const u16*)(ws + W_Q); g.Bt = (const u16*)(ws + W_WPF); E.mode = 2; break;
        case PH_G4: g.A = (const u16*)(ws + W_GM); g.Bt = (const u16*)(ws + W_WOUT); E.mode = 3; break;
        case PH_G5A: g.Bt = (const u16*)(ws + W_WUP); g.M = HALF_ROWS; g.N = DFF2; E.d0 = (u16*)(ws + W_U); E.p0 = DFF2; break;
        case PH_G5B: g.A = (const u16*)(ws + W_H) + (size_t)HALF_ROWS * DM; g.Bt = (const u16*)(ws + W_WUP); g.M = HALF_ROWS; g.N = DFF2; E.d0 = (u16*)(ws + W_U); E.p0 = DFF2; break;
        default:   g.A = (const u16*)(ws + W_G); g.Bt = (const u16*)(ws + W_WDN); g.K = DFF; E.mode = 5; break;
        }
        int tail = 0; if (ph == PH_G2 || ph == PH_G3 || ph == PH_G4 || ph == PH_G6 || ph == PH_G1B || ph == PH_G1C) { g.M = MP; tail = 4; }
        pg8::StaticOrder S; S.init(g.M, g.N, cx.G, cx.bid, tail, WGM_OF(g.N));
        pg8::gemm_phase<Epi, pg8::StaticOrder, true, true>((PG8_LAS unsigned char*)lds, g, S, E, cx.tid);
        if (ph < last) gsync(lds);
    }
}
#define PH_BEGIN() Ctx cx; { int t_ = threadIdx.x; asm volatile("" : "+v"(t_)); int b_ = blockIdx.x, g_ = gridDim.x; asm volatile("" : "+s"(b_), "+s"(g_)); cx.tid = t_; cx.bid = b_; cx.G = g_; } \
    KPrm p = (KPrm)__builtin_amdgcn_kernarg_segment_ptr(); asm volatile("" : "+s"(p))
#ifdef ONLY_PH
#define PH_ON(k) ((k) == ONLY_PH)
#else
#define PH_ON(k) true
#endif
__global__ void __launch_bounds__(512, 2) mega_fwd(Prm prm_unused) {
    extern __shared__ __attribute__((aligned(16))) unsigned char lds[];
    cg::grid_group grid = cg::this_grid();
    volatile LAS unsigned* bst = (volatile LAS unsigned*)(lds + LDS_TOTAL - 64);
    if (threadIdx.x < 2) bst[threadIdx.x] = 0u;
    __syncthreads();
    { KPrm p0 = (KPrm)__builtin_amdgcn_kernarg_segment_ptr(); (void)xcd_barrier_post((unsigned*)(p0->ws + W_BAR), bst); }
#define GSYNC() gsync(lds)
#ifndef EXP
#define EXP 0
#endif
    if (PH_ON(PH_PREP)) { PH_BEGIN(); phase_prep(p, cx, lds); } grid.sync();
#if EXP == 3
    { PH_BEGIN(); phase_prep(p, cx, lds); } GSYNC();
#endif
    if (PH_ON(PH_N1)) { PH_BEGIN(); phase_norm(p, cx, 0); } GSYNC();
    if (PH_ON(PH_G1A)) { PH_BEGIN(); run_gemms(p, cx, lds, PH_G1A, PH_G1A); } GSYNC();
#if EXP == 1
    { PH_BEGIN(); run_gemms(p, cx, lds, PH_G1A, PH_G1A); } GSYNC();
#endif
    if (PH_ON(PH_CONV)) { PH_BEGIN(); phase_conv(p, cx); } GSYNC();
    if (PH_ON(PH_SSD)) { PH_BEGIN(); phase_ssd(p, cx, lds); } GSYNC();
#if EXP == 2
    { PH_BEGIN(); run_gemms(p, cx, lds, PH_G1A, PH_G1A); } GSYNC();
    { PH_BEGIN(); phase_conv(p, cx); } GSYNC();
    { PH_BEGIN(); phase_ssd(p, cx, lds); } GSYNC();
#endif
    if (PH_ON(PH_GN)) { PH_BEGIN(); phase_gn(p, cx); }
    if (PH_ON(PH_G1B)) { PH_BEGIN(); run_gemms(p, cx, lds, PH_G1B, PH_G1C); } GSYNC();
    if (PH_ON(PH_QK)) { PH_BEGIN(); phase_qk(p, cx); } GSYNC();
    if (PH_ON(PH_ATT)) { PH_BEGIN(); phase_att(p, cx, (char*)lds); } GSYNC();
#if EXP == 4
    { PH_BEGIN(); run_gemms(p, cx, lds, PH_G1C, PH_G1C); } GSYNC();
    { PH_BEGIN(); phase_qk(p, cx); } GSYNC();
    { PH_BEGIN(); phase_att(p, cx, (char*)lds); } GSYNC();
#endif
    if (PH_ON(PH_G3)) { PH_BEGIN(); run_gemms(p, cx, lds, PH_G3, PH_G4); } GSYNC();
    if (PH_ON(PH_N2)) { PH_BEGIN(); phase_norm(p, cx, 1); } GSYNC();
    if (PH_ON(PH_G5A)) { PH_BEGIN(); run_gemms(p, cx, lds, PH_G5A, PH_G5A); } GSYNC();
    if (PH_ON(PH_CVA)) { PH_BEGIN(); phase_cv(p, cx, 0); } GSYNC();
    if (PH_ON(PH_G5B)) { PH_BEGIN(); run_gemms(p, cx, lds, PH_G5B, PH_G5B); } GSYNC();
    if (PH_ON(PH_CVB)) { PH_BEGIN(); phase_cv(p, cx, 1); } GSYNC();
    if (PH_ON(PH_G6)) { PH_BEGIN(); run_gemms(p, cx, lds, PH_G6, PH_G6); }
#if EXP == 5
#pragma unroll 1
    for (int r = 0; r < 32; ++r) GSYNC();
#endif
}

extern "C" void kernel_launch(void* const* d_in, const int* in_sizes, int n_in, void* d_out, int out_size, void* d_ws, size_t ws_size, hipStream_t stream) {
    static int grid = 0;
    if (grid == 0) {
        if (n_in != 31 || (size_t)out_size != O_END || ws_size < 1024 * MiB) { fprintf(stderr, "kernel_launch: unexpected sizes n_in %d out %d ws %zu\n", n_in, out_size, ws_size); }
        int dev = 0, cus = 0, per_cu = 0;
        hipGetDevice(&dev); hipDeviceGetAttribute(&cus, hipDeviceAttributeMultiprocessorCount, dev);
        hipFuncSetAttribute((const void*)mega_fwd, hipFuncAttributeMaxDynamicSharedMemorySize, LDS_TOTAL);
        hipOccupancyMaxActiveBlocksPerMultiprocessor(&per_cu, (const void*)mega_fwd, 512, LDS_TOTAL);
        (void)hipGetLastError();
        if (per_cu < 1) per_cu = 1;
        grid = cus;
    }
    (void)hipMemsetAsync((char*)d_ws + W_BAR, 0, 16384, stream);
    Prm prm{};
    for (int i = 0; i < 31; ++i) prm.in[i] = (const float*)d_in[i];
    prm.out = (float*)d_out; prm.ws = (unsigned char*)d_ws;
    void* args[] = {&prm};
    hipError_t e = hipLaunchCooperativeKernel((const void*)mega_fwd, dim3(grid), dim3(512), args, LDS_TOTAL, stream);
    if (e != hipSuccess) fprintf(stderr, "cooperative launch failed: %s (grid %d)\n", hipGetErrorString(e), grid);
}
```

```cpp
#include <hip/hip_runtime.h>
#include <hip/hip_cooperative_groups.h>
#include <hip/hip_bf16.h>
#include <cstdio>
#include <cstdint>
namespace cg = cooperative_groups;
namespace pg8 {
#define PG8_LAS __attribute__((address_space(3)))
typedef unsigned short bf16_t;
typedef short bf16x8 __attribute__((ext_vector_type(8)));
typedef float f32x4 __attribute__((ext_vector_type(4)));
typedef unsigned u32x4 __attribute__((ext_vector_type(4)));
constexpr int BM = 256, BK = 64, HALF = 128, HTB = HALF * BK * 2  , STAGE_BYTES = 8 * HTB, NXCD = 8, WGM = 8;

__host__ __device__ __forceinline__ int lds_byte(int r, int c) { const int st = (r >> 4) * 2 + (c >> 5), rr = r & 15, cc = c & 31, ob = rr * 64 + cc * 2; return st * 1024 + (ob ^ (((ob >> 9) & 1) << 5)); }
__host__ __device__ __forceinline__ void stage_rc(int b, int& R, int& C) { const int st = b / 1024, sb = b % 1024, swz = sb ^ (((sb >> 9) & 1) << 5); R = (st >> 1) * 16 + swz / 64; C = (st & 1) * 32 + (swz % 64) / 2; }
__host__ __device__ __forceinline__ int perm32(int rho) { const int n = rho >> 4, i = rho & 15; return 8 * (i >> 2) + 4 * n + (i & 3); }

struct Unit { int pm, pn, ho, half; };
struct Gemm { const bf16_t* A; const bf16_t* Bt; int M, N, K; };

struct StaticOrder {
    int nM, nN, nwg, G, c, tail, wgm;
    __host__ __device__ void init(int M, int N, int G_, int c_, int tail_ = 0, int wgm_ = 4) { nM = M / BM; nN = N / BM; nwg = nM * nN; G = G_; c = c_; tail = tail_; wgm = wgm_; }
    __host__ __device__ bool next(int i, Unit& u) const {
        const long L = (long)i * G + c; u.ho = 0; u.half = 0;
        if (L >= nwg) { const int h = (int)(L - nwg); if (h >= tail * nN) return false; const int hm = h / nN; u.pn = h - hm * nN; u.pm = nM + (hm >> 1); u.ho = hm & 1; u.half = 1; return true; }
        int wgid = (int)L; { const int q = nwg / NXCD, r = nwg % NXCD, xcd = wgid % NXCD, off = wgid / NXCD; wgid = (xcd < r ? xcd * (q + 1) : r * (q + 1) + (xcd - r) * q) + off; }
        const int nig = wgm * nN, gid = wgid / nig, fm = gid * wgm, gsz = (nM - fm) < wgm ? (nM - fm) : wgm;
        u.pm = fm + ((wgid % nig) % gsz); u.pn = (wgid % nig) / gsz; return true;
    }
    __device__ __forceinline__ void a_ready(const Unit&) const {}
    __device__ __forceinline__ void done(const Unit&) const {}
};
__device__ __forceinline__ unsigned cvt_pk_bf16(float lo, float hi) { unsigned r; asm volatile("v_cvt_pk_bf16_f32 %0, %1, %2" : "=v"(r) : "v"(lo), "v"(hi)); return r; }
typedef float f32x2 __attribute__((ext_vector_type(2)));
template <class Epi, class Sched, bool ALIGN_EPI = false, bool SP2 = false>
__device__ __forceinline__ void gemm_phase(PG8_LAS unsigned char* lds, const Gemm g, const Sched& S, const Epi& E, const int tid) {
    const int wid = __builtin_amdgcn_readfirstlane(tid >> 6), lane = tid & 63, wr = wid >> 2, wc = wid & 3, fr = lane & 15, fq = lane >> 4;
    const int K = g.K, nt = K / BK;
    unsigned voffA[2], voffB[2];
#pragma unroll
    for (int i = 0; i < 2; ++i) { int R, C; stage_rc(tid * 16 + i * 8192, R, C); const int Rb = Epi::PERM ? ((R & ~31) + perm32(R & 31)) : R;
        voffA[i] = (unsigned)(R * K + C) * 2u; voffB[i] = (unsigned)(Rb * K + C) * 2u; }
    const size_t kstep = (size_t)(BK * 2);
    const size_t hstep = (size_t)HALF * K * 2;
    const size_t tstep = 2 * hstep;
    const unsigned ldsw = (unsigned)wid * 1024u;
    const int aoff = lds_byte(wr * 64 + fr, fq * 8), boff = lds_byte(wc * 32 + fr, fq * 8);
#define PG8_SA(b, h) (((b) * 2 + (h)) * HTB)
#define PG8_SB(b, h) ((4 + (b) * 2 + (h)) * HTB)
#define PG8_STAGE(bufoff, gbase, voff) do { _Pragma("unroll") for (int _i = 0; _i < 2; ++_i) \
        __builtin_amdgcn_global_load_lds((const unsigned*)((const char*)(gbase) + (voff)[_i]), (PG8_LAS unsigned*)(lds + (bufoff) + ldsw + _i * 8192), 16, 0, 0); } while (0)
#define PG8_LDA(dst, b, h) do { _Pragma("unroll") for (int m = 0; m < 4; ++m) _Pragma("unroll") for (int k = 0; k < 2; ++k) dst[m][k] = *(const PG8_LAS bf16x8*)(lds + PG8_SA(b, h) + aoff + m * 2048 + k * 1024); } while (0)
#define PG8_LDB(dst, b, h) do { _Pragma("unroll") for (int n = 0; n < 2; ++n) _Pragma("unroll") for (int k = 0; k < 2; ++k) dst[n][k] = *(const PG8_LAS bf16x8*)(lds + PG8_SB(b, h) + boff + n * 2048 + k * 1024); } while (0)
#define PG8_MMA(ai, bj, At, Bt) do { __builtin_amdgcn_s_setprio(1); _Pragma("unroll") for (int m = 0; m < 4; ++m) _Pragma("unroll") for (int n = 0; n < 2; ++n) _Pragma("unroll") for (int k = 0; k < 2; ++k) \
        acc[ai][bj][m][n] = __builtin_amdgcn_mfma_f32_16x16x32_bf16(Bt[n][k], At[m][k], acc[ai][bj][m][n], 0, 0, 0); __builtin_amdgcn_s_setprio(0); } while (0)
#define PG8_WAIT_V(n) asm volatile("s_waitcnt vmcnt(" #n ")" ::: "memory")
#define PG8_WAIT_L(n) asm volatile("s_waitcnt lgkmcnt(" #n ")" ::: "memory")
#define PG8_BAR __builtin_amdgcn_s_barrier()
#define PG8_SCHED __builtin_amdgcn_sched_barrier(0)
    Unit cur, nxt; int ui = 0;
    if (!S.next(0, cur)) return;
    f32x4 acc[2][2][4][2];
#pragma unroll
    for (int a = 0; a < 2; ++a)
#pragma unroll
        for (int b = 0; b < 2; ++b)
#pragma unroll
            for (int m = 0; m < 4; ++m)
#pragma unroll
                for (int n = 0; n < 2; ++n) acc[a][b][m][n] = (f32x4){0.f, 0.f, 0.f, 0.f};
    bf16x8 At[4][2], B0[2][2], B1[2][2];
    const char* cA = (const char*)g.A + (size_t)cur.pm * tstep + (size_t)cur.ho * hstep; const char* cB = (const char*)g.Bt + (size_t)cur.pn * tstep;
    S.a_ready(cur);
    if constexpr (SP2) {
        PG8_STAGE(PG8_SB(0, 0), cB, voffB); PG8_STAGE(PG8_SB(0, 1), cB + hstep, voffB); PG8_STAGE(PG8_SA(0, 0), cA, voffA); PG8_STAGE(PG8_SA(0, 1), cA + hstep, voffA);
        if (wr == 1) PG8_BAR;
        PG8_WAIT_V(2); PG8_BAR;
        PG8_STAGE(PG8_SB(1, 0), cB + kstep, voffB); PG8_STAGE(PG8_SA(1, 0), cA + kstep, voffA); PG8_STAGE(PG8_SB(1, 1), cB + hstep + kstep, voffB);
        PG8_WAIT_V(6); PG8_BAR;
    } else {
        PG8_STAGE(PG8_SB(0, 0), cB, voffB); PG8_STAGE(PG8_SA(0, 0), cA, voffA); PG8_STAGE(PG8_SB(0, 1), cB + hstep, voffB); PG8_STAGE(PG8_SA(0, 1), cA + hstep, voffA);
        if (wr == 1) PG8_BAR;
        PG8_WAIT_V(4); PG8_BAR;
        PG8_STAGE(PG8_SB(1, 0), cB + kstep, voffB); PG8_STAGE(PG8_SA(1, 0), cA + kstep, voffA); PG8_STAGE(PG8_SB(1, 1), cB + hstep + kstep, voffB);
        PG8_WAIT_V(6); PG8_BAR;
    }
    for (;;) {
        const bool has_next = S.next(ui + 1, nxt);
        const char* nA = has_next ? (const char*)g.A + (size_t)nxt.pm * tstep + (size_t)nxt.ho * hstep : cA; const char* nB = has_next ? (const char*)g.Bt + (size_t)nxt.pn * tstep : cB;
        for (int t = 0; t < nt; t += 2) {
            const bool last = (t == nt - 2);
            const char* a1 = cA + (size_t)(t + 1) * kstep;
            const char* a2 = last ? nA : cA + (size_t)(t + 2) * kstep; const char* b2 = last ? nB : cB + (size_t)(t + 2) * kstep;
            const char* a3 = a2 + kstep; const char* b3 = b2 + kstep;
            if (last && has_next) S.a_ready(nxt);
            if constexpr (SP2) {
            PG8_LDB(B0, 0, 0); PG8_LDB(B1, 0, 1); PG8_SCHED; PG8_LDA(At, 0, 0); PG8_STAGE(PG8_SA(1, 1), a1 + hstep, voffA);
            PG8_WAIT_V(8); PG8_WAIT_L(0); PG8_BAR; PG8_MMA(0, 0, At, B0); PG8_MMA(0, 1, At, B1); PG8_BAR; PG8_SCHED;
            PG8_LDA(At, 0, 1); PG8_STAGE(PG8_SB(0, 0), b2, voffB); PG8_STAGE(PG8_SB(0, 1), b2 + hstep, voffB); PG8_STAGE(PG8_SA(0, 0), a2, voffA);
            PG8_WAIT_V(8); PG8_WAIT_L(0); PG8_BAR; if (!cur.half) { PG8_MMA(1, 0, At, B0); PG8_MMA(1, 1, At, B1); } PG8_BAR; PG8_SCHED;
            PG8_LDB(B0, 1, 0); PG8_LDB(B1, 1, 1); PG8_SCHED; PG8_LDA(At, 1, 0); PG8_STAGE(PG8_SA(0, 1), a2 + hstep, voffA);
            PG8_WAIT_V(8); PG8_WAIT_L(0); PG8_BAR; PG8_MMA(0, 0, At, B0); PG8_MMA(0, 1, At, B1); PG8_BAR; PG8_SCHED;
            PG8_LDA(At, 1, 1); PG8_STAGE(PG8_SB(1, 0), b3, voffB); PG8_STAGE(PG8_SB(1, 1), b3 + hstep, voffB); PG8_STAGE(PG8_SA(1, 0), a3, voffA);
            PG8_WAIT_V(8); PG8_WAIT_L(0); PG8_BAR; if (!cur.half) { PG8_MMA(1, 0, At, B0); PG8_MMA(1, 1, At, B1); } PG8_BAR; PG8_SCHED;
            } else {
            PG8_LDB(B0, 0, 0); PG8_SCHED; PG8_LDA(At, 0, 0); PG8_STAGE(PG8_SA(1, 1), a1 + hstep, voffA);
            PG8_WAIT_L(8); PG8_BAR; PG8_WAIT_L(0); PG8_MMA(0, 0, At, B0); PG8_BAR; PG8_SCHED;
            PG8_LDB(B1, 0, 1); PG8_STAGE(PG8_SB(0, 0), b2, voffB);
            PG8_BAR; PG8_WAIT_L(0); PG8_MMA(0, 1, At, B1); PG8_BAR;
            PG8_LDA(At, 0, 1); PG8_STAGE(PG8_SA(0, 0), a2, voffA);
            PG8_BAR; PG8_WAIT_L(0); PG8_MMA(1, 0, At, B0); PG8_BAR; PG8_SCHED;
            PG8_STAGE(PG8_SB(0, 1), b2 + hstep, voffB);
            PG8_WAIT_V(6); PG8_BAR; PG8_MMA(1, 1, At, B1); PG8_BAR;
            PG8_LDB(B0, 1, 0); PG8_SCHED; PG8_LDA(At, 1, 0); PG8_STAGE(PG8_SA(0, 1), a2 + hstep, voffA);
            PG8_WAIT_L(8); PG8_BAR; PG8_WAIT_L(0); PG8_MMA(0, 0, At, B0); PG8_BAR; PG8_SCHED;
            PG8_LDB(B1, 1, 1); PG8_STAGE(PG8_SB(1, 0), b3, voffB);
            PG8_BAR; PG8_WAIT_L(0); PG8_MMA(0, 1, At, B1); PG8_BAR;
            PG8_LDA(At, 1, 1); PG8_STAGE(PG8_SA(1, 0), a3, voffA);
            PG8_BAR; PG8_WAIT_L(0); PG8_MMA(1, 0, At, B0); PG8_BAR; PG8_SCHED;
            PG8_STAGE(PG8_SB(1, 1), b3 + hstep, voffB);
            PG8_WAIT_V(6); PG8_BAR; PG8_MMA(1, 1, At, B1); PG8_BAR;
            }
        }
        if constexpr (ALIGN_EPI) { if (wr == 0) PG8_BAR; }
        if constexpr (!Epi::AFTER_DRAIN) { E(acc, cur, wr, wc, fr, fq); S.done(cur); }
        if (!has_next) break;
#pragma unroll
        for (int a = 0; a < 2; ++a)
#pragma unroll
            for (int b = 0; b < 2; ++b)
#pragma unroll
                for (int m = 0; m < 4; ++m)
#pragma unroll
                    for (int n = 0; n < 2; ++n) acc[a][b][m][n] = (f32x4){0.f, 0.f, 0.f, 0.f};
        cur = nxt; cA = nA; cB = nB; ++ui;
        if constexpr (ALIGN_EPI) { if (wr == 1) PG8_BAR; }
    }
    PG8_WAIT_V(0);
    if constexpr (!ALIGN_EPI) { if (wr == 0) PG8_BAR; }
    PG8_BAR;
    if constexpr (Epi::AFTER_DRAIN) { E.fused(acc, cur, wr, wc, fr, fq, lds, wid, lane); S.done(cur); }
#undef PG8_SA
#undef PG8_SB
#undef PG8_STAGE
#undef PG8_LDA
#undef PG8_LDB
#undef PG8_MMA
#undef PG8_WAIT_V
#undef PG8_WAIT_L
#undef PG8_BAR
#undef PG8_SCHED
}
}
namespace att {
constexpr int D = 128, PITCH = 2048, NW = 8, QBLK = 32, KVBLK = 64, QB = NW * QBLK;
constexpr int SHM_V = KVBLK * D * 2, SHM_K = KVBLK * D * 2;
constexpr int LDS_BIAS = 2 * SHM_V + 2 * SHM_K + NW * 64 * 4;
constexpr int NQX = 4, LDS_QX = LDS_BIAS + 512;
constexpr int LDS_BYTES = LDS_QX + NW * NQX * 1024;
constexpr float THR2 = 64.f;
constexpr bool WSKIP = false;
typedef __hip_bfloat16 bf16;
typedef short bf16x8 __attribute__((ext_vector_type(8)));
typedef short s16x4 __attribute__((ext_vector_type(4)));
typedef float f32x16 __attribute__((ext_vector_type(16)));
typedef float f32x4 __attribute__((ext_vector_type(4)));
typedef unsigned u32x4 __attribute__((ext_vector_type(4)));
template <class A, class Bt> struct same_t { static constexpr bool v = false; };
template <class A> struct same_t<A, A> { static constexpr bool v = true; };

#define KSWZ(row, colB) ((row) * 256 + ((colB) ^ (((row) & 7) << 4)))
#define SBAR() __builtin_amdgcn_sched_barrier(0)
__device__ __forceinline__ int v_st(int k, int c) { const int kk = (k & ~0xC) | ((k & 4) << 1) | ((k & 8) >> 1); return ((kk >> 3) * 4 + (c >> 5)) * 512 + ((kk & 7) * 32 + (c & 31)) * 2; }
__device__ __forceinline__ int v_rd_base(int lane) { return ((lane & 3) << 3) | (((lane >> 2) & 3) << 6) | (((lane >> 4) & 1) << 5) | (((lane >> 5) & 1) << 8); }
constexpr int v_rd_off(int d0, int ks, int half) { return d0 * 512 + ks * 4096 + half * 2048; }
__device__ __forceinline__ int crow(int r, int hi) { return (r & 3) + 8 * (r >> 2) + 4 * hi; }
__device__ __forceinline__ unsigned cvtpk(float lo, float hi) {
    unsigned r; asm volatile("v_cvt_pk_bf16_f32 %0, %1, %2" : "=v"(r) : "v"(lo), "v"(hi)); return r;
}
__device__ __forceinline__ bf16x8 pack8(f32x4 a, f32x4 b) {
    u32x4 w = {cvtpk(a[0], a[1]), cvtpk(a[2], a[3]), cvtpk(b[0], b[1]), cvtpk(b[2], b[3])};
    return *reinterpret_cast<bf16x8*>(&w);
}
template <class T> __device__ __forceinline__ bf16x8 load8(const T* p) {
    if constexpr (same_t<T, float>::v) { return pack8(*(const f32x4*)p, *(const f32x4*)(p + 4)); }
    else { return *reinterpret_cast<const bf16x8*>(p); }
}
__device__ __forceinline__ void mask_tile(f32x16& p0, f32x16& p1, int dq, unsigned W) {
    const float NEG = -__builtin_inff();
#pragma unroll
    for (int r = 0; r < 16; ++r) {
        const int c = (r & 3) + 8 * (r >> 2);
        if (dq - c < 0) p0[r] = NEG;
        if (dq - c - 32 < 0) p1[r] = NEG;
    }
}
__device__ __forceinline__ void partialSM(f32x16& p0, f32x16& p1, float& m_reg, float& mn, float& alpha) {
    float pmax = p0[0]; for (int r = 1; r < 16; ++r) pmax = fmaxf(pmax, p0[r]); for (int r = 0; r < 16; ++r) pmax = fmaxf(pmax, p1[r]);
    { auto rr = __builtin_amdgcn_permlane32_swap(__float_as_uint(pmax), __float_as_uint(pmax), false, false);
      pmax = fmaxf(__uint_as_float(rr[0]), __uint_as_float(rr[1])); }
    if (__builtin_expect(__all((pmax - m_reg) <= THR2), 1)) { mn = m_reg; alpha = 1.f; }
    else { mn = fmaxf(m_reg, pmax); alpha = __builtin_amdgcn_exp2f(m_reg - mn); m_reg = mn; }
    for (int r = 0; r < 16; ++r) p0[r] = p0[r] - mn; for (int r = 0; r < 16; ++r) p1[r] = p1[r] - mn;
    for (int r = 0; r < 16; ++r) p0[r] = __builtin_amdgcn_exp2f(p0[r]);
}
__device__ __forceinline__ void finishSM(f32x16& p0, f32x16& p1, float alpha, float& l_reg, bf16x8& pa0, bf16x8& pa1, bf16x8& pa2, bf16x8& pa3) {
    for (int r = 0; r < 16; ++r) p1[r] = __builtin_amdgcn_exp2f(p1[r]);
    float ps = 0; for (int r = 0; r < 16; ++r) ps += p0[r]; for (int r = 0; r < 16; ++r) ps += p1[r];
    { auto rr = __builtin_amdgcn_permlane32_swap(__float_as_uint(ps), __float_as_uint(ps), false, false);
      ps = __uint_as_float(rr[0]) + __uint_as_float(rr[1]); }
    l_reg = l_reg * alpha + ps;
#define PK4(P, B_, OUT) do { unsigned a0 = cvtpk(P[B_+0], P[B_+1]), a1 = cvtpk(P[B_+2], P[B_+3]);                          \
        unsigned b0 = cvtpk(P[B_+4], P[B_+5]), b1 = cvtpk(P[B_+6], P[B_+7]);                                             \
        auto r0 = __builtin_amdgcn_permlane32_swap(a0, b0, false, false); auto r1 = __builtin_amdgcn_permlane32_swap(a1, b1, false, false); \
        u32x4 w = {r0[0], r1[0], r0[1], r1[1]}; OUT = *reinterpret_cast<bf16x8*>(&w); } while (0)
    PK4(p0, 0, pa0); PK4(p0, 8, pa1); PK4(p1, 0, pa2); PK4(p1, 8, pa3);
#undef PK4
}
template <int KB, bool SK>
__device__ __forceinline__ void qkt(f32x16& p0, f32x16& p1, const char* K_lds, int r32, int hi, const bf16x8* qr, bool act, const char* qx) {
    if (SK && !act) { const float NEG = -__builtin_inff();
#pragma unroll
        for (int r = 0; r < 16; ++r) { p0[r] = NEG; p1[r] = NEG; } return; }
    { const float* bl = (const float*)(K_lds - 2 * SHM_V + LDS_BIAS) + KB * 64 + 4 * hi;
#pragma unroll
      for (int g = 0; g < 4; ++g) { const f32x4 u0 = *(const f32x4*)(bl + 8 * g), u1 = *(const f32x4*)(bl + 32 + 8 * g);
        p0[4*g] = u0[0]; p0[4*g+1] = u0[1]; p0[4*g+2] = u0[2]; p0[4*g+3] = u0[3]; p1[4*g] = u1[0]; p1[4*g+1] = u1[1]; p1[4*g+2] = u1[2]; p1[4*g+3] = u1[3]; } }
    const char* kb[4];
#pragma unroll
    for (int dd = 0; dd < 4; ++dd) kb[dd] = K_lds + KB * SHM_K + KSWZ(r32, (dd * 16 + hi * 8) * 2);
#pragma unroll
    for (int d0 = 0; d0 < 8; ++d0) { const char* a = kb[d0 & 3] + (d0 >> 2) * 128;
        bf16x8 b0 = *reinterpret_cast<const bf16x8*>(a);
        bf16x8 b1 = *reinterpret_cast<const bf16x8*>(a + 32 * 256);
        const bf16x8 qv = (d0 < 8 - NQX) ? qr[d0] : *reinterpret_cast<const bf16x8*>(qx + (d0 - (8 - NQX)) * 1024);
        p0 = __builtin_amdgcn_mfma_f32_32x32x16_bf16(b0, qv, p0, 0, 0, 0);
        p1 = __builtin_amdgcn_mfma_f32_32x32x16_bf16(b1, qv, p1, 0, 0, 0); }
}
template <int VB, bool SK>
__device__ __forceinline__ void pv_tile(f32x16* o, int vb0, bf16x8 pa0, bf16x8 pa1, bf16x8 pa2, bf16x8 pa3, bool act) {
    if (SK && !act) return;
#define TRRD(dst, off) asm volatile("ds_read_b64_tr_b16 %0, %1 offset:%2" : "=&v"(dst) : "v"(vb0), "i"(off) : "memory")
#define PV_D0(d0) do { s16x4 l0, l1, l2, l3, h0, h1, h2, h3; constexpr int b_ = VB * SHM_V + v_rd_off(d0, 0, 0);     \
        TRRD(l0, b_); TRRD(h0, b_ + 2048); TRRD(l1, b_ + 4096); TRRD(h1, b_ + 6144); TRRD(l2, b_ + 8192); TRRD(h2, b_ + 10240); TRRD(l3, b_ + 12288); TRRD(h3, b_ + 14336); \
        asm volatile("s_waitcnt lgkmcnt(0)" ::: "memory"); SBAR();                 \
        o[d0] = __builtin_amdgcn_mfma_f32_32x32x16_bf16(pa0, (bf16x8){l0[0], l0[1], l0[2], l0[3], h0[0], h0[1], h0[2], h0[3]}, o[d0], 0, 0, 0);   \
        o[d0] = __builtin_amdgcn_mfma_f32_32x32x16_bf16(pa1, (bf16x8){l1[0], l1[1], l1[2], l1[3], h1[0], h1[1], h1[2], h1[3]}, o[d0], 0, 0, 0);   \
        o[d0] = __builtin_amdgcn_mfma_f32_32x32x16_bf16(pa2, (bf16x8){l2[0], l2[1], l2[2], l2[3], h2[0], h2[1], h2[2], h2[3]}, o[d0], 0, 0, 0);   \
        o[d0] = __builtin_amdgcn_mfma_f32_32x32x16_bf16(pa3, (bf16x8){l3[0], l3[1], l3[2], l3[3], h3[0], h3[1], h3[2], h3[3]}, o[d0], 0, 0, 0); } while (0)
    PV_D0(0); PV_D0(1); PV_D0(2); PV_D0(3);
#undef PV_D0
#undef TRRD
}

template <class TIn, class TOut> struct BlockRef { const TIn* Q; const TIn* K; const TIn* V; TOut* O; const float* Bs; int P0; int nvalid; };
template <class TIn> struct Seam {
    bf16x8 qr[8];
    bf16x8 st_v0, st_v1, st_k0, st_k1; f32x4 sf0, sf1, sf2, sf3;
    f32x4 tq[16];
};
__device__ __forceinline__ int swa_jlo(int P0, int W) { const int lowk = P0 - W + 1; return lowk > 0 ? lowk / KVBLK : 0; }
#define ROW(p, k0, rr) ((p) + (size_t)((k0) + (rr)) * PITCH + sc)
#define VMW() asm volatile("s_waitcnt vmcnt(0)" ::: "memory")
#define VMWN(n) asm volatile("s_waitcnt vmcnt(%0)" :: "i"(n) : "memory")
#define GLDS(gp_, lp_, sz_) __builtin_amdgcn_global_load_lds((const unsigned*)(gp_), (__attribute__((address_space(3))) unsigned*)(lp_), sz_, 0, 0)
#define SLOAD_H(Kp, Vp, Bp, k0, bb_) do { S.st_v0 = load8<TIn>(ROW(Vp, k0, sr)); S.st_v1 = load8<TIn>(ROW(Vp, k0, 32 + sr));              \
                         { const TIn* kg_ = (Kp) + (size_t)(k0) * PITCH; char* kl_ = K_lds + (bb_) * SHM_K + wid * 2048; GLDS(kg_ + ksrc0, kl_, 16); GLDS(kg_ + ksrc1, kl_ + 1024, 16); } \
                         if (wid == 0) GLDS((Bp) + (k0) + lane, lds + LDS_BIAS + (bb_) * 256, 4); } while (0)
#define SWRITE_HK(bf) do { } while (0)
#define SWRITE_HV(bf) do { *(bf16x8*)(V_lds + (bf) * SHM_V + vst0) = S.st_v0; *(bf16x8*)(V_lds + (bf) * SHM_V + vst1) = S.st_v1; } while (0)
#define SWRITE_H(bf) do { SWRITE_HV(bf); SWRITE_HK(bf); } while (0)
#define SLOAD_F(p, k0) do { S.sf0 = *(const f32x4*)ROW(p, k0, sr); S.sf1 = *(const f32x4*)(ROW(p, k0, sr) + 4);                \
                            S.sf2 = *(const f32x4*)ROW(p, k0, 32 + sr); S.sf3 = *(const f32x4*)(ROW(p, k0, 32 + sr) + 4); } while (0)
#define SWRITE_KF(bf) do { *(bf16x8*)(K_lds + (bf) * SHM_K + kws) = pack8(S.sf0, S.sf1); *(bf16x8*)(K_lds + (bf) * SHM_K + kws + 32 * 256) = pack8(S.sf2, S.sf3); } while (0)
#define SWRITE_VF(bf) do { *(bf16x8*)(V_lds + (bf) * SHM_V + vst0) = pack8(S.sf0, S.sf1); *(bf16x8*)(V_lds + (bf) * SHM_V + vst1) = pack8(S.sf2, S.sf3); } while (0)
template <class TIn, class TOut>
__device__ __forceinline__ void causal_swa_prime(const BlockRef<TIn, TOut>& cur, int W, char* lds, Seam<TIn>& S, const int tid) {
    constexpr bool F32 = same_t<TIn, float>::v;
    const int wid = __builtin_amdgcn_readfirstlane(tid >> 6), lane = tid & 63, r32 = lane & 31, hi = lane >> 5;
    const int sr = tid >> 4, sc = (tid & 15) * 8, kws = KSWZ(sr, sc * 2); char* K_lds = lds + 2 * SHM_V; (void)kws;
    const int ksrc0 = (8 * wid + (lane >> 4)) * PITCH + ((lane & 15) ^ (lane >> 4)) * 8, ksrc1 = (8 * wid + 4 + (lane >> 4)) * PITCH + ((lane & 15) ^ (4 + (lane >> 4))) * 8;
    const int kb0 = swa_jlo(cur.P0, W) * KVBLK;
    for (int d0 = 0; d0 < 8; ++d0) S.qr[d0] = load8<TIn>(cur.Q + (size_t)(wid * QBLK + r32) * PITCH + d0 * 16 + hi * 8);
    if constexpr (F32) { SLOAD_F((const float*)cur.K, kb0); VMW(); SWRITE_KF(0); SBAR(); SLOAD_F((const float*)cur.V, kb0); }
    else { SLOAD_H(cur.K, cur.V, cur.Bs, kb0, 0); VMW(); SWRITE_HK(0); }
    __syncthreads();
}
template <class TIn, class TOut>
__device__ __forceinline__ void causal_swa_block(const BlockRef<TIn, TOut>& cur, const BlockRef<TIn, TOut>& nxt, int skv, int W, char* lds, Seam<TIn>& S, const int tid, const float* qnw, const float qs) {
    constexpr bool F32 = same_t<TIn, float>::v;
    const int wid = __builtin_amdgcn_readfirstlane(tid >> 6), lane = tid & 63, r32 = lane & 31, hi = lane >> 5;
    const int j_lo = swa_jlo(cur.P0, W);
    int j_hi = (cur.P0 + QB - 1) / KVBLK + 1; if (j_hi > skv / KVBLK) j_hi = skv / KVBLK;
    const int NT = j_hi - j_lo;
    const int kbn = swa_jlo(nxt.P0, W) * KVBLK;
    const int qlo = cur.P0 + wid * QBLK, qm = qlo + r32 - 4 * hi;
    char* V_lds = lds; char* K_lds = lds + 2 * SHM_V;
    float* ws = (float*)(lds + 2 * SHM_V + 2 * SHM_K) + wid * 64; float* li_l = ws, * al_l = ws + 32;
    float m_reg = -1e30f, l_reg = 0; f32x16 o[4] = {};
    const int sr = tid >> 4, sc = (tid & 15) * 8, vst0 = v_st(sr, sc), vst1 = v_st(32 + sr, sc), kws = KSWZ(sr, sc * 2);
    const int vb0 = (int)(uintptr_t)V_lds + v_rd_base(lane); (void)kws;
    const int ksrc0 = (8 * wid + (lane >> 4)) * PITCH + ((lane & 15) ^ (lane >> 4)) * 8, ksrc1 = (8 * wid + 4 + (lane >> 4)) * PITCH + ((lane & 15) ^ (4 + (lane >> 4))) * 8;
    const TIn* Kh = cur.K; const TIn* Vh = cur.V; const float* Bh = cur.Bs;
#define RESC(a) do { if (__any((a) < 1.f)) { if (hi == 0) al_l[r32] = (a); asm volatile("s_waitcnt lgkmcnt(0)" ::: "memory");              \
                     for (int d_ = 0; d_ < 4; ++d_) for (int r = 0; r < 16; ++r) o[d_][r] *= al_l[crow(r, hi)]; } } while (0)
#define KBASE(t) ((j_lo + (t)) * KVBLK)
#define ACT(t) (KBASE(t) <= qlo + QBLK - 1 && KBASE(t) + KVBLK - 1 >= qlo - W + 1)
#define MASKT(P0_, P1_, t) do { const int kb_ = KBASE(t); if ((!SK || ACT(t)) && (kb_ + KVBLK - 1 > qlo || kb_ <= qlo + QBLK - 1 - W)) mask_tile(P0_, P1_, qm - kb_, (unsigned)W); } while (0)
    constexpr int NQL = F32 ? 16 : 8;
    constexpr bool SK = WSKIP && !F32;
#define SEAM_K0() do { VMWN(NQL); if constexpr (F32) { SWRITE_KF(0); SBAR(); SLOAD_F((const float*)nxt.V, kbn); } else { SWRITE_HK(0); } SBAR(); } while (0)
    f32x16 pA0, pA1, pB0, pB1; float mnA, mnB, alA, alB; bf16x8 pa0, pa1, pa2, pa3;
    {
        const float* wq_ = qnw; asm volatile("" : "+s"(wq_));
        float ss_ = 0.f;
#pragma unroll
        for (int d0 = 0; d0 < 8; ++d0) { const u32x4 w_ = __builtin_bit_cast(u32x4, S.qr[d0]);
#pragma unroll
            for (int e = 0; e < 4; ++e) { const float lo_ = __uint_as_float(w_[e] << 16), hi_ = __uint_as_float(w_[e] & 0xffff0000u); ss_ += lo_ * lo_ + hi_ * hi_; } }
        { auto rr = __builtin_amdgcn_permlane32_swap(__float_as_uint(ss_), __float_as_uint(ss_), false, false); ss_ = __uint_as_float(rr[0]) + __uint_as_float(rr[1]); }
        const float rs_ = rsqrtf(ss_ * (1.f / 128.f) + 1e-6f) * qs;
#pragma unroll
        for (int d0 = 0; d0 < 8; ++d0) { const u32x4 w_ = __builtin_bit_cast(u32x4, S.qr[d0]); const f32x4 g0 = *(const f32x4*)(wq_ + d0 * 16 + hi * 8), g1 = *(const f32x4*)(wq_ + d0 * 16 + hi * 8 + 4); u32x4 o_;
#pragma unroll
            for (int e = 0; e < 4; ++e) { const float lo_ = __uint_as_float(w_[e] << 16) * rs_ * (e < 2 ? g0[2 * e] : g1[2 * e - 4]), hi_ = __uint_as_float(w_[e] & 0xffff0000u) * rs_ * (e < 2 ? g0[2 * e + 1] : g1[2 * e - 3]); o_[e] = cvtpk(lo_, hi_); }
            S.qr[d0] = __builtin_bit_cast(bf16x8, o_); }
    }
    char* qx = lds + LDS_QX + wid * (NQX * 1024) + lane * 16;
#pragma unroll
    for (int e = 0; e < NQX; ++e) *reinterpret_cast<bf16x8*>(qx + e * 1024) = S.qr[8 - NQX + e];
    if constexpr (F32) { VMW(); SWRITE_VF(0); SBAR(); } else { SWRITE_HV(0); SBAR(); }
    if (NT > 1) { if constexpr (F32) SLOAD_F((const float*)Kh, KBASE(1)); else SLOAD_H(Kh, Vh, Bh, KBASE(1), 1); }
    SBAR(); qkt<0, SK>(pA0, pA1, K_lds, r32, hi, S.qr, ACT(0), qx);
    if constexpr (F32) { if (NT > 1) { VMW(); SWRITE_KF(1); SBAR(); SLOAD_F((const float*)Vh, KBASE(1)); } }
    MASKT(pA0, pA1, 0); partialSM(pA0, pA1, m_reg, mnA, alA);
    if (NT > 1) { VMW(); if constexpr (F32) { SWRITE_VF(1); SBAR(); if (NT > 2) SLOAD_F((const float*)Kh, KBASE(2)); } else SWRITE_H(1); }
    __syncthreads();
#define HALF_STEP(PX0, PX1, mnX, alX, PY0, PY1, alY, t, KB, VB, SB) do {                                                      \
        SBAR(); qkt<KB, SK>(PX0, PX1, K_lds, r32, hi, S.qr, ACT(t), qx);                                             \
        finishSM(PY0, PY1, alY, l_reg, pa0, pa1, pa2, pa3); SBAR();                                                           \
        if ((t) + 1 < NT) { if constexpr (F32) { VMW(); SWRITE_KF(SB); SBAR(); SLOAD_F((const float*)Vh, KBASE((t) + 1)); }  \
                            else { SLOAD_H(Kh, Vh, Bh, KBASE((t) + 1), SB); } SBAR(); }                                               \
        pv_tile<VB, SK>(o, vb0, pa0, pa1, pa2, pa3, ACT((t) - 1)); MASKT(PX0, PX1, (t)); partialSM(PX0, PX1, m_reg, mnX, alX);                                        \
        __syncthreads();                                                                                                      \
        if ((t) + 1 < NT) { VMW(); if constexpr (F32) { SWRITE_VF(SB); SBAR(); if ((t) + 2 < NT) SLOAD_F((const float*)Kh, KBASE((t) + 2)); } \
                            else { SWRITE_H(SB); } }                                                                          \
        RESC(alX); __syncthreads(); } while (0)
    for (int t = 1; t + 1 < NT; t += 2) {
        HALF_STEP(pB0, pB1, mnB, alB, pA0, pA1, alA, t, 1, 0, 0);
        HALF_STEP(pA0, pA1, mnA, alA, pB0, pB1, alB, t + 1, 0, 1, 1);
    }
    const bool even = (NT & 1) == 0;
    if (even) { SBAR(); qkt<1, SK>(pB0, pB1, K_lds, r32, hi, S.qr, ACT(NT - 1), qx); SBAR(); }
#define QROW(e) (nxt.Q + (size_t)(wid * QBLK + r32) * PITCH + ((e) >> 1) * 16 + hi * 8 + ((e) & 1) * 4)
    if constexpr (F32) { SLOAD_F((const float*)nxt.K, kbn); SBAR();
#pragma unroll
        for (int e = 0; e < 8; ++e) S.tq[e] = *(const f32x4*)QROW(e); }
    else { SLOAD_H(nxt.K, nxt.V, nxt.Bs, kbn, 0); SBAR();
#pragma unroll
        for (int d0 = 0; d0 < 8; ++d0) S.qr[d0] = load8<TIn>(nxt.Q + (size_t)(wid * QBLK + r32) * PITCH + d0 * 16 + hi * 8); }
    SBAR();
    finishSM(pA0, pA1, alA, l_reg, pa0, pa1, pa2, pa3); SBAR();
    if constexpr (F32) {
#pragma unroll
        for (int e = 8; e < 16; ++e) S.tq[e] = *(const f32x4*)QROW(e); SBAR(); }
#undef QROW
    pv_tile<0, SK>(o, vb0, pa0, pa1, pa2, pa3, ACT(even ? NT - 2 : NT - 1));
    if (even) { MASKT(pB0, pB1, NT - 1); partialSM(pB0, pB1, m_reg, mnB, alB); __syncthreads(); RESC(alB);
        finishSM(pB0, pB1, alB, l_reg, pa0, pa1, pa2, pa3); SBAR(); pv_tile<1, SK>(o, vb0, pa0, pa1, pa2, pa3, ACT(NT - 1)); }
    SBAR(); SEAM_K0();
    if (hi == 0) li_l[r32] = l_reg; asm volatile("s_waitcnt lgkmcnt(0)" ::: "memory");
    float rli[16];
#pragma unroll
    for (int r = 0; r < 16; ++r) rli[r] = __builtin_amdgcn_rcpf(li_l[crow(r, hi)]);
    int tidE = tid; asm volatile("" : "+v"(tidE));
    const int widE = __builtin_amdgcn_readfirstlane(tidE >> 6), r32E = tidE & 31, hiE = (tidE >> 5) & 1;
    TOut* Ow = cur.O + (size_t)(widE * QBLK) * PITCH; const bool wval = widE * QBLK < cur.nvalid;
    if (wval) {
#pragma unroll
    for (int r = 0; r < 16; ++r) { const int orow = crow(r, hiE);
#pragma unroll
        for (int d0 = 0; d0 < 4; ++d0) { const float v = o[d0][r] * rli[r];
            if constexpr (same_t<TOut, float>::v) { Ow[(size_t)orow * PITCH + d0 * 32 + r32E] = v; }
            else { const float vn = __shfl_xor(v, 1);
                   if ((r32E & 1) == 0) *(unsigned*)(Ow + (size_t)orow * PITCH + d0 * 32 + r32E) = cvtpk(v, vn); } } } }
    if constexpr (F32) {
#pragma unroll
        for (int d0 = 0; d0 < 8; ++d0) S.qr[d0] = pack8(S.tq[2 * d0], S.tq[2 * d0 + 1]); }
    __syncthreads();
#undef RESC
#undef KBASE
#undef ACT
#undef MASKT
#undef SEAM_K0
#undef HALF_STEP
}
#undef ROW
#undef VMW
#undef VMWN
#undef SLOAD_H
#undef GLDS
#undef SWRITE_HK
#undef SWRITE_HV
#undef SWRITE_H
#undef SLOAD_F
#undef SWRITE_KF
#undef SWRITE_VF

}
#define GAS __attribute__((address_space(1)))
#define LAS __attribute__((address_space(3)))
typedef GAS unsigned gu32;
typedef GAS unsigned long long gu64;
#define RLX_AGENT __ATOMIC_RELAXED, __HIP_MEMORY_SCOPE_AGENT
#define LDS_WAIT() asm volatile("s_waitcnt lgkmcnt(0)" ::: "memory")
#define VM_WAIT() asm volatile("s_waitcnt vmcnt(0)" ::: "memory")
__device__ __forceinline__ unsigned long long rt() { return __builtin_amdgcn_s_memrealtime(); }
#define XB_TMO      128
#define XB_XCNT(j)  (256  + 64 * (j))
#define XB_XSUB(j)  (1280 + 64 * (j))
#define XB_XGEN(j)  (2304 + 64 * (j))
#define XB_TOP      3328
#define XB_TOPGEN   3392
#define XCD_BAR_WORDS 3456
#define XB_SPIN_CAP (1u << 18)

__device__ __forceinline__ unsigned xb_ld(unsigned* p)              { return __hip_atomic_load(p, __ATOMIC_RELAXED, __HIP_MEMORY_SCOPE_AGENT); }
__device__ __forceinline__ unsigned xb_add(unsigned* p, unsigned v) { return __hip_atomic_fetch_add(p, v, __ATOMIC_RELAXED, __HIP_MEMORY_SCOPE_AGENT); }
__device__ __forceinline__ unsigned xb_xcc_id() { return (unsigned)__builtin_amdgcn_s_getreg((3 << 11) | 20) & 0xFu; }
#define XB_SPIN(cond, bar) do { unsigned _sp = 0; while (cond) { __builtin_amdgcn_s_sleep(1); \
    if ((++_sp & 255u) == 0u) { if (xb_ld(&(bar)[XB_TMO])) break; if (_sp > XB_SPIN_CAP) { atomicAdd(&(bar)[XB_TMO], 1u); break; } } } } while (0)

struct XcdBarrier {
    unsigned* bar; unsigned x;
    volatile LAS unsigned* st;
};

__device__ __forceinline__ XcdBarrier xcd_barrier_post(unsigned* bar, volatile LAS unsigned* st) {
    XcdBarrier b; b.bar = bar; b.x = xb_xcc_id(); b.st = st;
    if (threadIdx.x == 0) (void)xb_add(&bar[XB_XCNT(b.x)], 1u);
    return b;
}
__device__ __forceinline__ void xcd_barrier_complete(unsigned* bar, unsigned x, unsigned& nloc, unsigned& nx) {
    const unsigned G = gridDim.x * gridDim.y * gridDim.z;
    unsigned sum, cnt, mine, sp = 0u;
    for (;;) {
        sum = 0u; cnt = 0u; mine = 0u;
#pragma unroll
        for (unsigned j = 0; j < 16; ++j) { const unsigned c = xb_ld(&bar[XB_XCNT(j)]); sum += c; cnt += (c > 0u) ? 1u : 0u; mine = (j == x) ? c : mine; }
        if (sum == G) break;
        __builtin_amdgcn_s_sleep(1);
        if ((++sp & 255u) == 0u) { if (xb_ld(&bar[XB_TMO])) break; if (sp > XB_SPIN_CAP) { atomicAdd(&bar[XB_TMO], 1u); break; } }
    }
    nloc = mine > 0u ? mine : 1u; nx = cnt > 0u ? cnt : 1u;
}

__device__ __forceinline__ void xcd_barrier(const XcdBarrier& b) {
    asm volatile("s_waitcnt vmcnt(0)" ::: "memory");
    __syncthreads();
    if (threadIdx.x == 0) {
        unsigned* bar = b.bar;
        __builtin_amdgcn_s_waitcnt(0);
        unsigned nloc = b.st[0], nx = b.st[1];
        if (nloc == 0u) { xcd_barrier_complete(bar, b.x, nloc, nx); b.st[0] = nloc; b.st[1] = nx; }
        const unsigned old = xb_add(&bar[XB_XSUB(b.x)], 1u);
        const unsigned gen = old / nloc;
        if (old + 1u == (gen + 1u) * nloc) {
            __builtin_amdgcn_fence(__ATOMIC_RELEASE, "agent");
            asm volatile("s_waitcnt vmcnt(0)" ::: "memory");
            const unsigned og = xb_add(&bar[XB_TOP], 1u);
            const unsigned tg = og / nx;
            if (og + 1u == (tg + 1u) * nx) xb_add(&bar[XB_TOPGEN], 1u);
            else XB_SPIN(xb_ld(&bar[XB_TOPGEN]) == tg, bar);
            __builtin_amdgcn_fence(__ATOMIC_ACQUIRE, "agent");
            xb_add(&bar[XB_XGEN(b.x)], 1u);
            asm volatile("s_waitcnt vmcnt(0)" ::: "memory");
        } else {
            XB_SPIN(xb_ld(&bar[XB_XGEN(b.x)]) == gen, bar);
            __builtin_amdgcn_fence(__ATOMIC_ACQUIRE, "agent");
            asm volatile("s_waitcnt vmcnt(0)" ::: "memory");
        }
    }
    __syncthreads();
}

typedef unsigned short u16;
typedef float f32x4 __attribute__((ext_vector_type(4)));
typedef unsigned u32x4 __attribute__((ext_vector_type(4)));
typedef unsigned u32x2 __attribute__((ext_vector_type(2)));
typedef short bf16x8 __attribute__((ext_vector_type(8)));
constexpr int DM = 2048, TP = 8192, NBP = 4, NBS = 8, TS = 64, PAST = 2048, SKVS = PAST + TS;
constexpr int MP = NBP * TP, MS_ = NBS * TS, M = MP + MS_;
constexpr int DI = 4096, CD = 6144, NH = 64, DFF = 5504, DFF2 = 11008, NIN = 20560;
constexpr int NMOD = 12288;
constexpr float EPS = 1e-6f, LOG2E = 1.4426950408889634f;
constexpr int HALF_ROWS = 16640;
constexpr size_t O_YP = 0, O_YS = O_YP + (size_t)MP * DM, O_KP = O_YS + (size_t)MS_ * DM, O_VP = O_KP + (size_t)MP * DM,
    O_LFP = O_VP + (size_t)MP * DM, O_SSMP = O_LFP + (size_t)MP * 16, O_MCP = O_SSMP + (size_t)NBP * 64 * 64 * 128, O_FCP = O_MCP + (size_t)NBP * 3 * CD,
    O_KS = O_FCP + (size_t)NBP * 2 * DFF2, O_VS = O_KS + (size_t)MS_ * DM, O_LFS = O_VS + (size_t)MS_ * DM, O_SSMS = O_LFS + (size_t)MS_ * 16,
    O_MCS = O_SSMS + (size_t)NBS * 64 * 64 * 128, O_FCS = O_MCS + (size_t)NBS * 3 * CD, O_END = O_FCS + (size_t)NBS * 2 * DFF2;
constexpr size_t MiB = 1u << 20;
constexpr size_t W_MOD = 0, W_BAR = 768 * 1024  , W_BIASP = 1 * MiB, W_BIASS = 3 * MiB, W_HALO = 5 * MiB,
    W_WUP = 8 * MiB, W_WDN = 51 * MiB, W_H = 73 * MiB, W_WIN = 203 * MiB, W_WPM = 284 * MiB, W_WPF = 300 * MiB, W_WOUT = 308 * MiB,
    W_SMALL = 316 * MiB, W_R = 349 * MiB,
    W_XBC = W_R, W_Z = W_R + 390 * MiB, W_GM = W_R, W_GF = W_R + 130 * MiB, W_Q = W_R + 260 * MiB, W_K = W_Q + 130 * MiB, W_V = W_K + 130 * MiB,
    W_U = 203 * MiB, W_G = 553 * MiB, W_END = 999 * MiB;
static_assert((size_t)M * DM * 2 == 130 * MiB && (size_t)M * CD * 2 == 390 * MiB && (size_t)M * DI * 2 == 260 * MiB, "sizes");
static_assert(W_U + (size_t)HALF_ROWS * DFF2 * 2 <= W_G && W_G + (size_t)M * DFF * 2 <= 1024 * MiB, "ffn map");
static_assert(W_SMALL + (size_t)M * 256 * 4 <= W_R, "small map");

struct Prm { const float* in[31]; float* out; unsigned char* ws; };
typedef const __attribute__((address_space(4))) Prm* KPrm;
struct Ctx { int tid, bid, G; };
enum { I_XP = 0, I_XS, I_CP, I_CS, I_CK, I_CV, I_CLF, I_SSM, I_MCV, I_FCV, I_N1W, I_N2W, I_WADA, I_BADA, I_WIN, I_MCW, I_MCB, I_DTB, I_ALOG, I_MD, I_MNW,
       I_FB, I_QNW, I_KNW, I_WPM, I_WPF, I_WOUT, I_WUP, I_FCW, I_FCB, I_WDN };

__device__ __forceinline__ float bflo(unsigned w) { return __uint_as_float(w << 16); }
__device__ __forceinline__ float bfhi(unsigned w) { return __uint_as_float(w & 0xffff0000u); }
typedef float f32x2_t __attribute__((ext_vector_type(2))); typedef __bf16 bf16x2_t __attribute__((ext_vector_type(2)));
__device__ __forceinline__ unsigned pk2(float lo, float hi) { f32x2_t v = {lo, hi}; bf16x2_t b = __builtin_convertvector(v, bf16x2_t); return __builtin_bit_cast(unsigned, b); }
__device__ __forceinline__ u16 f2bf(float f) { return (u16)(pk2(f, 0.f) & 0xffffu); }
__device__ __forceinline__ void unpack8(u32x4 w, float* v) { v[0] = bflo(w.x); v[1] = bfhi(w.x); v[2] = bflo(w.y); v[3] = bfhi(w.y); v[4] = bflo(w.z); v[5] = bfhi(w.z); v[6] = bflo(w.w); v[7] = bfhi(w.w); }
__device__ __forceinline__ u32x4 pack8f(const float* v) { u32x4 w; w.x = pk2(v[0], v[1]); w.y = pk2(v[2], v[3]); w.z = pk2(v[4], v[5]); w.w = pk2(v[6], v[7]); return w; }
__device__ __forceinline__ float bfel(const u32x4& w, int e) { const unsigned x = w[e >> 1]; return (e & 1) ? bfhi(x) : bflo(x); }
__device__ __forceinline__ float sigmoidf_(float x) { return 1.f / (1.f + __expf(-x)); }
__device__ __forceinline__ float siluf_(float x) { return x / (1.f + __expf(-x)); }
__device__ __forceinline__ float wave_sum(float v) {
#pragma unroll
    for (int o = 1; o < 64; o <<= 1) v += __shfl_xor(v, o);
    return v;
}
__device__ __forceinline__ int mod_row(int row) { return row < MP ? (row >> 13) : 4 + ((row - MP) >> 6); }

struct Epi {
    static constexpr bool PERM = true, AFTER_DRAIN = false;
    int mode;
    u16* d0; u16* d1; u16* d2; int t1, t2, p0, p1, p2, f32seg2, vseg2; float* vout; u16* vslab;
    const float* xp; const float* xs; float* y; const float* mod; u16* gbuf; const u16* gf;
    __device__ __forceinline__ void operator()(const f32x4 (&acc)[2][2][4][2], const pg8::Unit& u, int wr, int wc, int fr, int fq) const {
        const int rl = u.pm * 256 + u.ho * 128 + wr * 64 + fr, cl = wc * 32 + 8 * fq;
        const int nai = u.half ? 1 : 2;
        if (mode == 0) {
            u16* base; int pitch, ct; bool f32o = false;
            if (u.pn < t1) { base = d0; pitch = p0; ct = u.pn; } else if (u.pn < t2) { base = d1; pitch = p1; ct = u.pn - t1; } else { base = d2; pitch = p2; ct = u.pn - t2; f32o = (f32seg2 != 0); }
            if (!f32o) {
#pragma unroll
                for (int ai = 0; ai < nai; ++ai)
#pragma unroll
                    for (int m = 0; m < 4; ++m) { u16* rp = base + (size_t)(rl + ai * 128 + m * 16) * pitch + ct * 256 + cl;
#pragma unroll
                        for (int bj = 0; bj < 2; ++bj) { const f32x4 v0 = acc[ai][bj][m][0], v1 = acc[ai][bj][m][1]; u32x4 w; w.x = pk2(v0[0], v0[1]); w.y = pk2(v0[2], v0[3]); w.z = pk2(v1[0], v1[1]); w.w = pk2(v1[2], v1[3]);
                            *(u32x4*)(rp + bj * 128) = w; } }
                if (vseg2 && u.pn >= t2) {
#pragma unroll
                    for (int ai = 0; ai < nai; ++ai)
#pragma unroll
                        for (int m = 0; m < 4; ++m) { const int row = rl + ai * 128 + m * 16; const int col = ct * 256 + cl;
                            float* vo = (row < MP) ? vout + (size_t)row * DM + col : vout + (O_VS - O_VP) + (size_t)(row - MP) * DM + col;
#pragma unroll
                            for (int bj = 0; bj < 2; ++bj) { __builtin_nontemporal_store(acc[ai][bj][m][0], (f32x4*)(vo + bj * 128)); __builtin_nontemporal_store(acc[ai][bj][m][1], (f32x4*)(vo + bj * 128 + 4)); }
                            if (row >= MP) { const int sb = (row - MP) >> 6, t = (row - MP) & 63; u16* sp = vslab + (size_t)(sb * SKVS + PAST + t) * DM + col;
#pragma unroll
                                for (int bj = 0; bj < 2; ++bj) { const f32x4 v0 = acc[ai][bj][m][0], v1 = acc[ai][bj][m][1]; u32x4 w; w.x = pk2(v0[0], v0[1]); w.y = pk2(v0[2], v0[3]); w.z = pk2(v1[0], v1[1]); w.w = pk2(v1[2], v1[3]);
                                    *(u32x4*)(sp + bj * 128) = w; } } }
                }
            } else {
                float* fb = (float*)base;
#pragma unroll
                for (int ai = 0; ai < nai; ++ai)
#pragma unroll
                    for (int m = 0; m < 4; ++m) { float* rp = fb + (size_t)(rl + ai * 128 + m * 16) * pitch + ct * 256 + cl;
#pragma unroll
                        for (int bj = 0; bj < 2; ++bj) { *(f32x4*)(rp + bj * 128) = acc[ai][bj][m][0]; *(f32x4*)(rp + bj * 128 + 4) = acc[ai][bj][m][1]; } }
            }
        } else if (mode == 1 || mode == 2) {
#pragma unroll
            for (int ai = 0; ai < nai; ++ai) {
                u32x4 gw[4][2], fw[4][2];
#pragma unroll
                for (int m = 0; m < 4; ++m) { const size_t off = (size_t)(rl + ai * 128 + m * 16) * DM + u.pn * 256 + cl;
#pragma unroll
                    for (int bj = 0; bj < 2; ++bj) { gw[m][bj] = *(const u32x4*)(gbuf + off + bj * 128); if (mode == 2) fw[m][bj] = *(const u32x4*)(gf + off + bj * 128); else fw[m][bj] = gw[m][bj]; } }
#pragma unroll
                for (int m = 0; m < 4; ++m) { const size_t off = (size_t)(rl + ai * 128 + m * 16) * DM + u.pn * 256 + cl;
#pragma unroll
                    for (int bj = 0; bj < 2; ++bj) { const f32x4 v0 = acc[ai][bj][m][0], v1 = acc[ai][bj][m][1];
                        float a[8] = {v0[0], v0[1], v0[2], v0[3], v1[0], v1[1], v1[2], v1[3]}, g[8], o[8];
                        unpack8(gw[m][bj], g);
                        if (mode == 1) {
#pragma unroll
                            for (int e = 0; e < 8; ++e) o[e] = sigmoidf_(g[e]) * a[e];
                        } else { float f[8]; unpack8(fw[m][bj], f);
#pragma unroll
                            for (int e = 0; e < 8; ++e) o[e] = g[e] + sigmoidf_(f[e]) * a[e]; }
                        *(u32x4*)(gbuf + off + bj * 128) = pack8f(o); } }
            }
        } else {
#pragma unroll
            for (int ai = 0; ai < nai; ++ai) {
                const int mb = (u.pm < 128) ? (u.pm >> 5) : (4 + (u.pm - 128) * 4 + u.ho * 2 + ai * 2 + wr);
                const float* gp = mod + (size_t)mb * NMOD + (mode == 3 ? 4096 : 10240) + u.pn * 256 + cl;
                f32x4 gv[2][2], pre[4][2][2];
#pragma unroll
                for (int m = 0; m < 4; ++m) { const int row = rl + ai * 128 + m * 16; const size_t off = (size_t)row * DM + u.pn * 256 + cl;
                    const float* xr = (mode == 3) ? ((row < MP) ? xp + off : xs + (off - (size_t)MP * DM)) : (const float*)(y + off);
#pragma unroll
                    for (int bj = 0; bj < 2; ++bj) { pre[m][bj][0] = *(const f32x4*)(xr + bj * 128); pre[m][bj][1] = *(const f32x4*)(xr + bj * 128 + 4); } }
#pragma unroll
                for (int bj = 0; bj < 2; ++bj) { gv[bj][0] = *(const f32x4*)(gp + bj * 128); gv[bj][1] = *(const f32x4*)(gp + bj * 128 + 4); }
#pragma unroll
                for (int m = 0; m < 4; ++m) { const int row = rl + ai * 128 + m * 16; const size_t off = (size_t)row * DM + u.pn * 256 + cl;
#pragma unroll
                    for (int bj = 0; bj < 2; ++bj) { *(f32x4*)(y + off + bj * 128) = pre[m][bj][0] + gv[bj][0] * acc[ai][bj][m][0]; *(f32x4*)(y + off + bj * 128 + 4) = pre[m][bj][1] + gv[bj][1] * acc[ai][bj][m][1]; } }
            }
        }
    }
};

__device__ __forceinline__ int map_in(int n) {
    if (n < 4096) return 6144 + n;
    if (n < 10240) return n - 4096;
    if (n < 10304) return 10240 + (n - 10240);
    if (n < 12352) return 14592 + (n - 10304);
    if (n < 14400) return 16640 + (n - 12352);
    if (n < 16448) return 18688 + (n - 14400);
    if (n < 16464) return 10304 + (n - 16448);
    if (n < 18512) return 10496 + (n - 16464);
    return 12544 + (n - 18512);
}
__device__ __forceinline__ int map_up(int n) { if (n < DFF) return (n >> 7) * 256 + (n & 127); const int f = n - DFF; return (f >> 7) * 256 + 128 + (f & 127); }
template <int MAP> __device__ __forceinline__ void tr_item(const float* __restrict__ W, int K, int N, u16* WT, float* scr, int item, int lane) {
    const int nblk = (N + 31) / 32, kb = item / nblk, nb = item % nblk, k0 = 64 * kb, n0 = 32 * nb;
    const int nn = n0 + (lane & 31);
    float tv[32];
#pragma unroll
    for (int i = 0; i < 32; ++i) { const int kk = 2 * i + (lane >> 5); tv[i] = (nn < N) ? W[(size_t)(k0 + kk) * N + nn] : 0.f; }
#pragma unroll
    for (int i = 0; i < 32; ++i) { const int kk = 2 * i + (lane >> 5); scr[kk * 33 + (lane & 31)] = tv[i]; }
    asm volatile("s_waitcnt lgkmcnt(0)" ::: "memory");
    const int c = lane & 7;
#pragma unroll
    for (int j = 0; j < 4; ++j) { const int n = (lane >> 3) + 8 * j; const float* s = scr + (8 * c) * 33 + n;
        if (n0 + n < N) { const int row = (MAP == 1) ? map_in(n0 + n) : (MAP == 2) ? map_up(n0 + n) : (n0 + n);
            u32x4 o; o.x = pk2(s[0 * 33], s[1 * 33]); o.y = pk2(s[2 * 33], s[3 * 33]); o.z = pk2(s[4 * 33], s[5 * 33]); o.w = pk2(s[6 * 33], s[7 * 33]);
            *(u32x4*)(WT + (size_t)row * K + k0 + 8 * c) = o; } }
    asm volatile("s_waitcnt lgkmcnt(0)" ::: "memory");
}
__device__ __forceinline__ void phase_prep(KPrm p, const Ctx cx, unsigned char* lds) {
    const int tid = cx.tid, lane = tid & 63, wid = tid >> 6, G = cx.G;
    unsigned char* ws = p->ws;
    {
        float* scr = (float*)(lds + wid * 8448);
        const int gw = cx.bid * 8 + wid, NGW = G * 8;
        constexpr int I_IN = 32 * 643, I_PM = 64 * 64, I_PF = 32 * 64, I_OUT = 32 * 64, I_UP = 32 * 344, I_DN = 86 * 64;
        constexpr int NIT = I_IN + I_PM + I_PF + I_OUT + I_UP + I_DN;
        for (int it = gw; it < NIT; it += NGW) {
            int r = it;
            if (r < I_IN) { tr_item<1>(p->in[I_WIN], DM, NIN, (u16*)(ws + W_WIN), scr, r, lane); continue; } r -= I_IN;
            if (r < I_PM) { tr_item<0>(p->in[I_WPM], DI, DM, (u16*)(ws + W_WPM), scr, r, lane); continue; } r -= I_PM;
            if (r < I_PF) { tr_item<0>(p->in[I_WPF], DM, DM, (u16*)(ws + W_WPF), scr, r, lane); continue; } r -= I_PF;
            if (r < I_OUT) { tr_item<0>(p->in[I_WOUT], DM, DM, (u16*)(ws + W_WOUT), scr, r, lane); continue; } r -= I_OUT;
            if (r < I_UP) { tr_item<2>(p->in[I_WUP], DM, DFF2, (u16*)(ws + W_WUP), scr, r, lane); continue; } r -= I_UP;
            tr_item<0>(p->in[I_WDN], DFF, DM, (u16*)(ws + W_WDN), scr, r, lane);
        }
    }
    __syncthreads();
    {
        float* sl = (float*)lds;
        float* red = (float*)(lds + 12 * 2048 * 4);
        for (int e = tid; e < 12 * 2048; e += 512) { const int b = e >> 11, i = e & 2047; const float cv = (b < 4) ? p->in[I_CP][b * 2048 + i] : p->in[I_CS][(b - 4) * 2048 + i]; sl[e] = siluf_(cv); }
        __syncthreads();
        const float* wada = p->in[I_WADA]; float* mod = (float*)(ws + W_MOD);
        const int col = tid & 31, part = tid >> 5;
        for (int item = cx.bid; item < NMOD / 32; item += G) {
            float acc[12];
#pragma unroll
            for (int b = 0; b < 12; ++b) acc[b] = 0.f;
            const float* wp = wada + (size_t)(part * 128) * NMOD + item * 32 + col;
#pragma unroll 8
            for (int d = 0; d < 128; ++d) { const float w = wp[(size_t)d * NMOD];
#pragma unroll
                for (int b = 0; b < 12; ++b) acc[b] += sl[b * 2048 + part * 128 + d] * w; }
#pragma unroll
            for (int b = 0; b < 12; ++b) red[(part * 12 + b) * 32 + col] = acc[b];
            __syncthreads();
            if (tid < 384) { const int b = tid >> 5; float s = p->in[I_BADA][item * 32 + col];
#pragma unroll
                for (int q = 0; q < 16; ++q) s += red[(q * 12 + b) * 32 + col];
                mod[b * NMOD + item * 32 + col] = s; }
            __syncthreads();
        }
    }
    {
        u16* Ks = (u16*)p->out; u16* Vs = Ks + (size_t)NBS * SKVS * DM;
        const size_t tot8 = (size_t)NBS * PAST * DM / 8, gt = (size_t)cx.bid * 512 + tid, GT = (size_t)G * 512;
        for (size_t i0 = gt; i0 < 2 * tot8; i0 += 4 * GT) {
            f32x4 a[4], b[4]; size_t dsto[4]; bool ok[4]; int wh[4];
#pragma unroll
            for (int u = 0; u < 4; ++u) { const size_t i = i0 + (size_t)u * GT; ok[u] = i < 2 * tot8; const size_t ii = ok[u] ? i : 0; wh[u] = ii >= tot8; const size_t j = ii - (wh[u] ? tot8 : 0);
                const size_t sb = j / ((size_t)PAST * 256), rem = j % ((size_t)PAST * 256), row = rem >> 8, c8 = rem & 255;
                const float* src = p->in[wh[u] ? I_CV : I_CK] + ((sb * PAST + row) * DM + c8 * 8);
                a[u] = *(const f32x4*)src; b[u] = *(const f32x4*)(src + 4); dsto[u] = (sb * SKVS + row) * DM + c8 * 8; }
#pragma unroll
            for (int u = 0; u < 4; ++u) if (ok[u]) { u32x4 o; o.x = pk2(a[u][0], a[u][1]); o.y = pk2(a[u][2], a[u][3]); o.z = pk2(b[u][0], b[u][1]); o.w = pk2(b[u][2], b[u][3]);
                *(u32x4*)((wh[u] ? Vs : Ks) + dsto[u]) = o; }
        }
    }
}
__device__ __forceinline__ void phase_norm(KPrm p, const Ctx cx, int which) {
    const int tid = cx.tid, lane = tid & 63, wid = tid >> 6;
    const int gw = cx.bid * 8 + wid, NGW = cx.G * 8;
    const float* mod = (const float*)(p->ws + W_MOD); u16* H = (u16*)(p->ws + W_H);
    const float* nw = p->in[which ? I_N2W : I_N1W];
    const int osh = which ? 6144 : 0, osc = which ? 8192 : 2048;
    for (int row0 = 2 * gw; row0 < M; row0 += 2 * NGW) {
        f32x4 v[2][8];
#pragma unroll
        for (int rr = 0; rr < 2; ++rr) { const int row = row0 + rr;
            const float* xr = which ? (p->out + (size_t)row * DM) : ((row < MP) ? p->in[I_XP] + (size_t)row * DM : p->in[I_XS] + (size_t)(row - MP) * DM);
#pragma unroll
            for (int j = 0; j < 8; ++j) v[rr][j] = ((const f32x4*)xr)[lane + 64 * j]; }
#pragma unroll
        for (int rr = 0; rr < 2; ++rr) { const int row = row0 + rr;
            const float* mr = mod + (size_t)mod_row(row) * NMOD;
            float ss = 0.f;
#pragma unroll
            for (int j = 0; j < 8; ++j) ss += (v[rr][j][0] * v[rr][j][0] + v[rr][j][1] * v[rr][j][1]) + (v[rr][j][2] * v[rr][j][2] + v[rr][j][3] * v[rr][j][3]);
            const float rs = rsqrtf(wave_sum(ss) * (1.f / DM) + EPS);
#pragma unroll
            for (int j = 0; j < 8; ++j) { const int col = 4 * (lane + 64 * j);
                const f32x4 w = *(const f32x4*)(nw + col), sc = *(const f32x4*)(mr + osc + col), sh = *(const f32x4*)(mr + osh + col);
                const f32x4 o = v[rr][j] * rs * w * (sc + 1.f) + sh;
                u32x2 q; q.x = pk2(o[0], o[1]); q.y = pk2(o[2], o[3]);
                *(u32x2*)(H + (size_t)row * DM + col) = q; } }
    }
}
__device__ __forceinline__ void phase_conv(KPrm p, const Ctx cx) {
    const u16* XBC = (const u16*)(p->ws + W_XBC); u16* ACT = (u16*)(p->out + O_KP);
    const float* cw = p->in[I_MCW]; const float* cb = p->in[I_MCB];
    {
                const int gt2 = cx.bid * 512 + cx.tid, GT2 = cx.G * 512;
        for (int i = gt2; i < 12 * 3 * CD; i += GT2) { const int bb = i / (3 * CD), r = (i / CD) % 3, c = i % CD;
            if (bb < 4) p->out[O_MCP + i] = bflo(XBC[(size_t)(bb * TP + TP - 3 + r) * CD + c]);
            else p->out[O_MCS + (i - 4 * 3 * CD)] = bflo(XBC[(size_t)(MP + (bb - 4) * TS + TS - 3 + r) * CD + c]); }
    }
    constexpr int NCG = CD / 8, RB = 16, NRB = M / RB;
    const long gt = (long)cx.bid * 512 + cx.tid, GT = (long)cx.G * 512;
    for (long it = gt; it < (long)NCG * NRB; it += GT) {
        const int cgi = (int)(it % NCG), rb = (int)(it / NCG), c0 = cgi * 8, r0 = rb * RB;
        float w[4][8], bs[8];
#pragma unroll
        for (int j = 0; j < 4; ++j) { const f32x4 a0 = *(const f32x4*)(cw + j * CD + c0), a1 = *(const f32x4*)(cw + j * CD + c0 + 4);
#pragma unroll
            for (int e = 0; e < 4; ++e) { w[j][e] = a0[e]; w[j][4 + e] = a1[e]; } }
        { const f32x4 a0 = *(const f32x4*)(cb + c0), a1 = *(const f32x4*)(cb + c0 + 4);
#pragma unroll
          for (int e = 0; e < 4; ++e) { bs[e] = a0[e]; bs[4 + e] = a1[e]; } }
        float h[3][8];
        const bool smp = r0 >= MP; const int tb = smp ? ((r0 - MP) & 63) : (r0 & (TP - 1));
        if (tb == 0) {
            if (smp) { const float* s = p->in[I_MCV] + (size_t)((r0 - MP) >> 6) * 3 * CD + c0;
#pragma unroll
                for (int k = 0; k < 3; ++k)
#pragma unroll
                    for (int e = 0; e < 8; ++e) h[k][e] = s[k * CD + e];
            } else {
#pragma unroll
                for (int k = 0; k < 3; ++k)
#pragma unroll
                    for (int e = 0; e < 8; ++e) h[k][e] = 0.f; }
        } else {
#pragma unroll
            for (int k = 0; k < 3; ++k) unpack8(*(const u32x4*)(XBC + (size_t)(r0 - 3 + k) * CD + c0), h[k]);
        }
        u32x4 ur[RB];
#pragma unroll
        for (int i = 0; i < RB; ++i) ur[i] = *(const u32x4*)(XBC + (size_t)(r0 + i) * CD + c0);
#pragma unroll
        for (int i = 0; i < RB; ++i) { float u[8], o[8]; unpack8(ur[i], u);
#pragma unroll
            for (int e = 0; e < 8; ++e) { const float v = bs[e] + w[0][e] * h[0][e] + w[1][e] * h[1][e] + w[2][e] * h[2][e] + w[3][e] * u[e];
                o[e] = siluf_(v); h[0][e] = h[1][e]; h[1][e] = h[2][e]; h[2][e] = u[e]; }
            *(u32x4*)(ACT + (size_t)(r0 + i) * CD + c0) = pack8f(o); }
    }
}
constexpr int SXP = 72, SNP = 136, SYP = 68;
constexpr int L_XT = 0, L_CN = L_XT + 64 * SXP * 2, L_BN = L_CN + 64 * SNP * 2, L_BWT = L_BN + 64 * SNP * 2, L_MS = L_BWT + 128 * SXP * 2, L_HS = L_MS + 64 * SXP * 2,
              L_YS = L_HS + 64 * SNP * 2, L_DT = L_YS + 64 * SYP * 4, L_CUM = L_DT + 256, L_SSD_END = L_CUM + 256;
static_assert(L_SSD_END <= 131072, "ssd lds");
__device__ __forceinline__ void phase_ssd(KPrm p, const Ctx cx, unsigned char* lds) {
    const int tid = cx.tid, lane = tid & 63, wid = __builtin_amdgcn_readfirstlane(tid >> 6), quad = lane >> 4, l15 = lane & 15;
    u16* XT = (u16*)(lds + L_XT); u16* CN = (u16*)(lds + L_CN); u16* BN = (u16*)(lds + L_BN); u16* BWT = (u16*)(lds + L_BWT);
    u16* MSm = (u16*)(lds + L_MS); u16* HS = (u16*)(lds + L_HS); float* YS = (float*)(lds + L_YS); float* DT = (float*)(lds + L_DT); float* CUM = (float*)(lds + L_CUM);
    const u16* XBC = (const u16*)(p->out + O_KP);     u16* Z = (u16*)(p->ws + W_Z); const float* SM = (const float*)(p->ws + W_SMALL);
    const int cg8 = tid & 31, tq = tid >> 5, cgx = tid & 7, tx = tid >> 3;
    const int pb = wid >> 1;
    for (int ch = cx.bid; ch < 256 + 512; ch += cx.G) {
        const bool smp = ch >= 256; int b, hd, nc; long rowbase;
        if (!smp) { b = ch >> 6; hd = ch & 63; nc = TP / 64; rowbase = (long)b * TP; } else { const int su = ch - 256; b = su >> 6; hd = su & 63; nc = 1; rowbase = MP + (long)b * TS; }
        const int g = hd >> 3;
        const float a_h = -__expf(p->in[I_ALOG][hd]), dtb = p->in[I_DTB][hd], Dh = p->in[I_MD][hd];
        const int bccol = (cg8 < 16) ? (4096 + g * 128 + cg8 * 8) : (5120 + g * 128 + (cg8 - 16) * 8);
        const int xcol = hd * 64 + cgx * 8;
        f32x4 st[4];
        const int st_off = (pb * 16 + quad * 4) * 128 + (4 * (wid & 1)) * 16 + l15, hs_off = (pb * 16 + quad * 4) * SNP + (4 * (wid & 1)) * 16 + l15;
        { const float* sin_ = p->in[I_SSM] + ((size_t)b * 64 + hd) * 64 * 128 + st_off;
#pragma unroll
          for (int i = 0; i < 4; ++i)
#pragma unroll
            for (int j = 0; j < 4; ++j) st[i][j] = smp ? sin_[j * 128 + i * 16] : 0.f; }
        __syncthreads();
        { u16* hp_ = HS + hs_off;
#pragma unroll
          for (int i = 0; i < 4; ++i)
#pragma unroll
            for (int j = 0; j < 4; ++j) hp_[j * SNP + i * 16] = f2bf(st[i][j]); }
        u32x4 rbcA[4], rxA, znA, rbcB[4], rxB, znB, pend = {0u, 0u, 0u, 0u}; float dtrA = 0.f, dtrB = 0.f;
#define SSD_LOADS(cc, rbc, rx, zn, dtr) do { const int t0_ = (cc) * 64; \
            const u16* pb_ = XBC + (rowbase + t0_ + 4 * tq) * (long)CD + bccol; const u16* px_ = XBC + (rowbase + t0_ + tx) * (long)CD + xcol; \
            asm volatile("" : "+v"(pb_), "+v"(px_));     \
            _Pragma("unroll") for (int i = 0; i < 4; ++i) rbc[i] = *(const u32x4*)(pb_ + i * CD); \
            rx = *(const u32x4*)px_; \
            zn = *(const u32x4*)(Z + (size_t)(rowbase + t0_ + tx) * DI + xcol); \
            dtr = SM[(size_t)(rowbase + t0_ + lane) * 256 + hd]; } while (0)
#define LBAR() do { asm volatile("s_waitcnt lgkmcnt(0)" ::: "memory"); __builtin_amdgcn_s_barrier(); asm volatile("" ::: "memory"); } while (0)
        SSD_LOADS(0, rbcA, rxA, znA, dtrA); if (nc > 1) SSD_LOADS(1, rbcB, rxB, znB, dtrB);
        auto body = [&](const int c, u32x4 (&rbc)[4], u32x4& rx, u32x4& zn, float& dtr) __attribute__((always_inline)) {
            const long r0 = rowbase + (long)c * 64;
            const u32x4 zw = zn;
            float cum_end;
            { const float dr = dtr + dtb; const float dtv = dr > 20.f ? dr : __logf(1.f + __expf(dr));
              float x = dtv * a_h;
#define DPP_ADD(ctrl, rmask) x += __int_as_float(__builtin_amdgcn_update_dpp(0, __float_as_int(x), ctrl, rmask, 0xf, true))
              DPP_ADD(0x111, 0xf); DPP_ADD(0x112, 0xf); DPP_ADD(0x114, 0xf); DPP_ADD(0x118, 0xf);
              DPP_ADD(0x142, 0xa);
              DPP_ADD(0x143, 0xc);
#undef DPP_ADD
              DT[lane] = dtv; CUM[lane] = x; cum_end = __int_as_float(__builtin_amdgcn_readlane(__float_as_int(x), 63)); }
            {
                u16* NAT = (cg8 < 16) ? BN : CN; const int nc0 = (cg8 & 15) * 8;
#pragma unroll
                for (int ii = 0; ii < 4; ++ii) *(u32x4*)(NAT + (4 * tq + ii) * SNP + nc0) = rbc[ii];
                if (cg8 < 16) {
                    float wg[4]; const f32x4 dt4 = *(const f32x4*)(DT + 4 * tq), cu4 = *(const f32x4*)(CUM + 4 * tq);
#pragma unroll
                    for (int ii = 0; ii < 4; ++ii) wg[ii] = dt4[ii] * __expf(cum_end - cu4[ii]);
#pragma unroll
                    for (int e = 0; e < 8; ++e) { u32x2 q; q.x = pk2(bfel(rbc[0], e) * wg[0], bfel(rbc[1], e) * wg[1]); q.y = pk2(bfel(rbc[2], e) * wg[2], bfel(rbc[3], e) * wg[3]);
                        *(u32x2*)(BWT + (nc0 + e) * SXP + 4 * tq) = q; }
                }
            }
            float xv[8]; unpack8(rx, xv);
#pragma unroll
            for (int e = 0; e < 8; ++e) XT[(cgx * 8 + e) * SXP + tx] = (u16)((e & 1) ? (rx[e >> 1] >> 16) : (rx[e >> 1] & 0xffffu));
            LBAR();
            if (c > 0) *(u32x4*)(Z + (size_t)(r0 - 64 + tx) * DI + xcol) = pend;
            if (c + 2 < nc) SSD_LOADS(c + 2, rbc, rx, zn, dtr);
            const int ti = wid >> 1;
            f32x4 yo[2];
            {
                bf16x8 ca[4], bb[2][4], hb[2][4];
#pragma unroll
                for (int kk = 0; kk < 4; ++kk) ca[kk] = *(const bf16x8*)(CN + (ti * 16 + l15) * SNP + kk * 32 + quad * 8);
#pragma unroll
                for (int s2 = 0; s2 < 2; ++s2)
#pragma unroll
                    for (int kk = 0; kk < 4; ++kk) { bb[s2][kk] = *(const bf16x8*)(BN + ((2 * (wid & 1) + s2) * 16 + l15) * SNP + kk * 32 + quad * 8);
                        hb[s2][kk] = *(const bf16x8*)(HS + ((2 * (wid & 1) + s2) * 16 + l15) * SNP + kk * 32 + quad * 8); }
                const f32x4 ct4 = *(const f32x4*)(CUM + ti * 16 + quad * 4);
                float cs[2], ds[2];
#pragma unroll
                for (int s2 = 0; s2 < 2; ++s2) { const int sx = (2 * (wid & 1) + s2) * 16 + l15; cs[s2] = CUM[sx]; ds[s2] = DT[sx]; }
                f32x4 ga[2] = {{0.f, 0.f, 0.f, 0.f}, {0.f, 0.f, 0.f, 0.f}}; yo[0] = (f32x4){0.f, 0.f, 0.f, 0.f}; yo[1] = (f32x4){0.f, 0.f, 0.f, 0.f};
#pragma unroll
                for (int kk = 0; kk < 4; ++kk) {
                    ga[0] = __builtin_amdgcn_mfma_f32_16x16x32_bf16(ca[kk], bb[0][kk], ga[0], 0, 0, 0); ga[1] = __builtin_amdgcn_mfma_f32_16x16x32_bf16(ca[kk], bb[1][kk], ga[1], 0, 0, 0);
                    yo[0] = __builtin_amdgcn_mfma_f32_16x16x32_bf16(ca[kk], hb[0][kk], yo[0], 0, 0, 0); yo[1] = __builtin_amdgcn_mfma_f32_16x16x32_bf16(ca[kk], hb[1][kk], yo[1], 0, 0, 0); }
#pragma unroll
                for (int s2 = 0; s2 < 2; ++s2) { const int s_ = (2 * (wid & 1) + s2) * 16 + l15;
#pragma unroll
                    for (int j = 0; j < 4; ++j) { const int t = ti * 16 + quad * 4 + j; const float msk = (s_ <= t) ? ds[s2] : 0.f;
                        const float val = ga[s2][j] * __expf(fminf(ct4[j] - cs[s2], 0.f)) * msk; MSm[t * SXP + s_] = f2bf(val); } }
#pragma unroll
                for (int p2 = 0; p2 < 2; ++p2)
#pragma unroll
                    for (int j = 0; j < 4; ++j) yo[p2][j] *= __expf(ct4[j]);
            }
            LBAR();
            {
                bf16x8 ma[2], xa[2], xb[2][2], wb[4][2];
#pragma unroll
                for (int kk = 0; kk < 2; ++kk) { ma[kk] = *(const bf16x8*)(MSm + (ti * 16 + l15) * SXP + kk * 32 + quad * 8); xa[kk] = *(const bf16x8*)(XT + (pb * 16 + l15) * SXP + kk * 32 + quad * 8);
#pragma unroll
                    for (int p2 = 0; p2 < 2; ++p2) xb[p2][kk] = *(const bf16x8*)(XT + ((2 * (wid & 1) + p2) * 16 + l15) * SXP + kk * 32 + quad * 8);
#pragma unroll
                    for (int i = 0; i < 4; ++i) wb[i][kk] = *(const bf16x8*)(BWT + ((4 * (wid & 1) + i) * 16 + l15) * SXP + kk * 32 + quad * 8); }
                const float dec = __expf(cum_end);
#pragma unroll
                for (int i = 0; i < 4; ++i) st[i] = st[i] * dec;
#pragma unroll
                for (int kk = 0; kk < 2; ++kk) {
                    yo[0] = __builtin_amdgcn_mfma_f32_16x16x32_bf16(ma[kk], xb[0][kk], yo[0], 0, 0, 0); yo[1] = __builtin_amdgcn_mfma_f32_16x16x32_bf16(ma[kk], xb[1][kk], yo[1], 0, 0, 0);
#pragma unroll
                    for (int i = 0; i < 4; ++i) st[i] = __builtin_amdgcn_mfma_f32_16x16x32_bf16(xa[kk], wb[i][kk], st[i], 0, 0, 0); }
#pragma unroll
                for (int p2 = 0; p2 < 2; ++p2)
#pragma unroll
                    for (int j = 0; j < 4; ++j) YS[(ti * 16 + quad * 4 + j) * SYP + (2 * (wid & 1) + p2) * 16 + l15] = yo[p2][j];
                u16* hp_ = HS + hs_off;
#pragma unroll
                for (int i = 0; i < 4; ++i)
#pragma unroll
                    for (int j = 0; j < 4; ++j) hp_[j * SNP + i * 16] = f2bf(st[i][j]);
            }
            LBAR();
            {
                const f32x4 y0 = *(const f32x4*)(YS + tx * SYP + cgx * 8), y1 = *(const f32x4*)(YS + tx * SYP + cgx * 8 + 4);
                float zf[8], o[8]; unpack8(zw, zf);
#pragma unroll
                for (int e = 0; e < 8; ++e) { const float yv = (e < 4 ? y0[e & 3] : y1[e & 3]) + Dh * xv[e]; o[e] = yv * siluf_(zf[e]); }
                pend = pack8f(o);
            }
        };
        for (int c = 0; c < nc; c += 2) { body(c, rbcA, rxA, znA, dtrA); if (c + 1 < nc) body(c + 1, rbcB, rxB, znB, dtrB); }
        *(u32x4*)(Z + (size_t)(rowbase + (long)(nc - 1) * 64 + tx) * DI + xcol) = pend;
#undef SSD_LOADS
#undef LBAR
        float* so = p->out + (smp ? O_SSMS : O_SSMP) + ((size_t)b * 64 + hd) * 64 * 128 + st_off;
#pragma unroll
        for (int i = 0; i < 4; ++i)
#pragma unroll
            for (int j = 0; j < 4; ++j) so[j * 128 + i * 16] = st[i][j];
        __syncthreads();
    }
}
__device__ __forceinline__ float logsig_(float f) { return fminf(f, 0.f) - log1pf(__expf(-fabsf(f))); }
__device__ __forceinline__ void phase_gn(KPrm p, const Ctx cx) {
    const int tid = cx.tid, lane = tid & 63, wid = tid >> 6;
    const int gw = cx.bid * 8 + wid, NGW = cx.G * 8;
    const float* SM = (const float*)(p->ws + W_SMALL);
    if (gw < 192) {
        if (gw < 64) { const int b = gw >> 4, h = gw & 15; const float fb = p->in[I_FB][h];
            float* bias = (float*)(p->ws + W_BIASP) + (size_t)(b * 16 + h) * TP; float* lo = p->out + O_LFP;
            const int tb = lane * 128; float s = 0.f;
            for (int i = 0; i < 128; ++i) s += logsig_(SM[(size_t)(b * TP + tb + i) * 256 + 64 + h] + fb);
            float inc = s;
#pragma unroll
            for (int o = 1; o < 64; o <<= 1) { const float y = __shfl_up(inc, o); if (lane >= o) inc += y; }
            float run = inc - s;
            for (int i = 0; i < 128; ++i) { const float lf = logsig_(SM[(size_t)(b * TP + tb + i) * 256 + 64 + h] + fb); run += lf;
                lo[(size_t)(b * TP + tb + i) * 16 + h] = lf; bias[tb + i] = -run * LOG2E; }
        } else { const int u = gw - 64, sb = u >> 4, h = u & 15; const float fb = p->in[I_FB][h];
            float* bias = (float*)(p->ws + W_BIASS) + (size_t)(sb * 16 + h) * SKVS; float* lo = p->out + O_LFS;
            const int tb = lane * 33; float s = 0.f;
            for (int i = 0; i < 33; ++i) { const int pos = tb + i;
                s += (pos < PAST) ? p->in[I_CLF][(size_t)(sb * PAST + pos) * 16 + h] : logsig_(SM[(size_t)(MP + sb * TS + pos - PAST) * 256 + 64 + h] + fb); }
            float inc = s;
#pragma unroll
            for (int o = 1; o < 64; o <<= 1) { const float y = __shfl_up(inc, o); if (lane >= o) inc += y; }
            float run = inc - s;
            for (int i = 0; i < 33; ++i) { const int pos = tb + i; float lf;
                if (pos < PAST) lf = p->in[I_CLF][(size_t)(sb * PAST + pos) * 16 + h];
                else { lf = logsig_(SM[(size_t)(MP + sb * TS + pos - PAST) * 256 + 64 + h] + fb); lo[(size_t)(sb * TS + pos - PAST) * 16 + h] = lf; }
                run += lf; bias[pos] = -run * LOG2E; }
        }
    }
    u16* Z = (u16*)(p->ws + W_Z); const float* mnw = p->in[I_MNW];
    for (int row = gw; row < M; row += NGW) {
        u32x4 zr[8];
#pragma unroll
        for (int i = 0; i < 8; ++i) zr[i] = *(const u32x4*)(Z + (size_t)row * DI + i * 512 + lane * 8);
#pragma unroll
        for (int i = 0; i < 8; ++i) { const int col = i * 512 + lane * 8; u16* zp = Z + (size_t)row * DI + col;
            float v[8]; unpack8(zr[i], v); float ss = 0.f;
#pragma unroll
            for (int e = 0; e < 8; ++e) ss += v[e] * v[e];
            const float rs = rsqrtf(wave_sum(ss) * (1.f / 512.f) + EPS);
            const f32x4 w0 = *(const f32x4*)(mnw + col), w1 = *(const f32x4*)(mnw + col + 4);
#pragma unroll
            for (int e = 0; e < 8; ++e) v[e] = v[e] * rs * (e < 4 ? w0[e & 3] : w1[e & 3]);
            *(u32x4*)zp = pack8f(v); }
    }
}
__device__ __forceinline__ void phase_qk(KPrm p, const Ctx cx) {
    const int tid = cx.tid, lane = tid & 63, wid = tid >> 6;
    const int gw = cx.bid * 8 + wid, NGW = cx.G * 8;
    u16* K = (u16*)(p->ws + W_K);
    u16* Ks = (u16*)p->out;
    const int hc = (lane & 15) * 8;
    const f32x4 kw0 = *(const f32x4*)(p->in[I_KNW] + hc), kw1 = *(const f32x4*)(p->in[I_KNW] + hc + 4);
    for (int row = gw; row < M; row += NGW) {
        const bool smp = row >= MP;
        float* ko = smp ? p->out + O_KS + (size_t)(row - MP) * DM : p->out + O_KP + (size_t)row * DM;
        size_t srow = 0; if (smp) { const int sb = (row - MP) >> 6, t = (row - MP) & 63; srow = (size_t)(sb * SKVS + PAST + t) * DM; }
        u32x4 kr_[4];
#pragma unroll
        for (int it = 0; it < 4; ++it) { const size_t off = (size_t)row * DM + it * 512 + lane * 8; kr_[it] = *(const u32x4*)(K + off); }
#pragma unroll
        for (int it = 0; it < 4; ++it) { const int col = it * 512 + lane * 8; const size_t off = (size_t)row * DM + col;
            float v[8], ss;
            unpack8(kr_[it], v); ss = 0.f;
#pragma unroll
            for (int e = 0; e < 8; ++e) ss += v[e] * v[e];
            ss += __shfl_xor(ss, 1); ss += __shfl_xor(ss, 2); ss += __shfl_xor(ss, 4); ss += __shfl_xor(ss, 8);
            const float rs = rsqrtf(ss * (1.f / 128.f) + EPS);
#pragma unroll
            for (int e = 0; e < 8; ++e) v[e] = v[e] * rs * (e < 4 ? kw0[e & 3] : kw1[e & 3]);
            const u32x4 kp = pack8f(v);
            *(u32x4*)(K + off) = kp;
            __builtin_nontemporal_store((f32x4){v[0], v[1], v[2], v[3]}, (f32x4*)(ko + col)); __builtin_nontemporal_store((f32x4){v[4], v[5], v[6], v[7]}, (f32x4*)(ko + col + 4));
            if (smp) *(u32x4*)(Ks + srow + col) = kp; }
    }
}
typedef att::BlockRef<att::bf16, att::bf16> ARef;
__device__ __forceinline__ ARef att_ref(KPrm p, const Ctx cx, int i, int nbp, int& skv) {
    const int G = cx.G, bid = (cx.G % 8 == 0) ? (cx.bid % 8) * (cx.G / 8) + cx.bid / 8 : cx.bid; ARef r;
    att::bf16* Qb = (att::bf16*)(p->ws + W_Q); const att::bf16* Kb = (const att::bf16*)(p->ws + W_K); const att::bf16* Vb = (const att::bf16*)(p->ws + W_V);
    if (i < nbp) { const int L = bid + (i >> 1) * G, bh = L >> 4, x = L & 15, qb = (i & 1) ? 31 - x : x, b = bh >> 4, h = bh & 15;
        const size_t rq = ((size_t)b * TP + (size_t)qb * 256) * DM + h * 128, rk = (size_t)b * TP * DM + h * 128;
        r.Q = Qb + rq; r.O = Qb + rq; r.K = Kb + rk; r.V = Vb + rk; r.Bs = (const float*)(p->ws + W_BIASP) + (size_t)bh * TP; r.P0 = qb * 256; r.nvalid = 256; skv = TP;
    } else { const int su = bid + (i - nbp) * G, sb = su >> 4, h = su & 15;
        const att::bf16* Ks = (const att::bf16*)p->out; const att::bf16* Vs = Ks + (size_t)NBS * SKVS * DM;
        const size_t rq = ((size_t)MP + (size_t)sb * TS) * DM + h * 128, rk = (size_t)sb * SKVS * DM + h * 128;
        r.Q = Qb + rq; r.O = Qb + rq; r.K = Ks + rk; r.V = Vs + rk; r.Bs = (const float*)(p->ws + W_BIASS) + (size_t)su * SKVS; r.P0 = PAST; r.nvalid = TS; skv = SKVS; }
    return r;
}
__device__ __forceinline__ void phase_att(KPrm p, const Ctx cx, char* lds) {
    const int G = cx.G, bid = (cx.G % 8 == 0) ? (cx.bid % 8) * (cx.G / 8) + cx.bid / 8 : cx.bid;
    const int nip = (bid < 1024) ? (1024 - bid + G - 1) / G : 0, nbp = 2 * nip, nbs = (bid < 128) ? (128 - bid + G - 1) / G : 0, nb = nbp + nbs;
    if (nb == 0) return;
    const int W = 1 << 30;
    int skv, skvn; ARef cur = att_ref(p, cx, 0, nbp, skv);
    att::Seam<att::bf16> S;
    att::causal_swa_prime<att::bf16, att::bf16>(cur, W, lds, S, cx.tid);
    for (int i = 0; i < nb; ++i) {
        const bool last = (i + 1 == nb);
        ARef nxt = cur; skvn = skv; if (!last) nxt = att_ref(p, cx, i + 1, nbp, skvn);
        att::causal_swa_block<att::bf16, att::bf16>(cur, nxt, skv, W, lds, S, cx.tid, p->in[I_QNW], 0.08838834764831845f * LOG2E);
        cur = nxt; skv = skvn;
    }
}
__device__ __forceinline__ void phase_cv(KPrm p, const Ctx cx, int half) {
    const int tid = cx.tid;
    const u16* U = (const u16*)(p->ws + W_U); u16* Gb = (u16*)(p->ws + W_G); u16* HALO = (u16*)(p->ws + W_HALO);
    const float* cw = p->in[I_FCW]; const float* cb = p->in[I_FCB];
    const int row_lo = half ? HALF_ROWS : 0;
    constexpr int NCG = DFF / 8, RB = 16, NRB = HALF_ROWS / RB;
    const long gt = (long)cx.bid * 512 + tid, GT = (long)cx.G * 512;
    for (long it = gt; it < (long)NCG * NRB; it += GT) {
        const int cgi = (int)(it % NCG), rb = (int)(it / NCG); const int f0 = cgi * 8, r0 = row_lo + rb * RB;
        const int ca = (f0 >> 7) * 256 + (f0 & 127), cbb = ca + 128;
        float wa[3][8], wb[3][8], ba[8], bb[8];
#pragma unroll
        for (int k = 0; k < 3; ++k) { const f32x4 a0 = *(const f32x4*)(cw + k * DFF2 + f0), a1 = *(const f32x4*)(cw + k * DFF2 + f0 + 4), b0 = *(const f32x4*)(cw + k * DFF2 + DFF + f0), b1 = *(const f32x4*)(cw + k * DFF2 + DFF + f0 + 4);
#pragma unroll
            for (int e = 0; e < 4; ++e) { wa[k][e] = a0[e]; wa[k][4 + e] = a1[e]; wb[k][e] = b0[e]; wb[k][4 + e] = b1[e]; } }
        { const f32x4 a0 = *(const f32x4*)(cb + f0), a1 = *(const f32x4*)(cb + f0 + 4), b0 = *(const f32x4*)(cb + DFF + f0), b1 = *(const f32x4*)(cb + DFF + f0 + 4);
#pragma unroll
          for (int e = 0; e < 4; ++e) { ba[e] = a0[e]; ba[4 + e] = a1[e]; bb[e] = b0[e]; bb[4 + e] = b1[e]; } }
        float ha[2][8], hb[2][8];
        const bool smp = r0 >= MP; const int tb = smp ? ((r0 - MP) & 63) : (r0 & (TP - 1));
        if (tb == 0) {
            if (smp) { const float* s = p->in[I_FCV] + (size_t)((r0 - MP) >> 6) * 2 * DFF2;
#pragma unroll
                for (int k = 0; k < 2; ++k)
#pragma unroll
                    for (int e = 0; e < 8; ++e) { ha[k][e] = s[k * DFF2 + f0 + e]; hb[k][e] = s[k * DFF2 + DFF + f0 + e]; }
            } else {
#pragma unroll
                for (int k = 0; k < 2; ++k)
#pragma unroll
                    for (int e = 0; e < 8; ++e) { ha[k][e] = 0.f; hb[k][e] = 0.f; } }
        } else if (half && rb == 0) {
#pragma unroll
            for (int k = 0; k < 2; ++k) { unpack8(*(const u32x4*)(HALO + (size_t)k * DFF2 + ca), ha[k]); unpack8(*(const u32x4*)(HALO + (size_t)k * DFF2 + cbb), hb[k]); }
        } else {
#pragma unroll
            for (int k = 0; k < 2; ++k) { const size_t ro = (size_t)(r0 - row_lo - 2 + k) * DFF2; unpack8(*(const u32x4*)(U + ro + ca), ha[k]); unpack8(*(const u32x4*)(U + ro + cbb), hb[k]); }
        }
#pragma unroll 8
        for (int i = 0; i < RB; ++i) { const int r = r0 + i; const size_t ro = (size_t)(r - row_lo) * DFF2;
            const u32x4 uaw = *(const u32x4*)(U + ro + ca), ubw = *(const u32x4*)(U + ro + cbb);
            float ua[8], ub[8], o[8]; unpack8(uaw, ua); unpack8(ubw, ub);
#pragma unroll
            for (int e = 0; e < 8; ++e) { const float va = ba[e] + wa[0][e] * ha[0][e] + wa[1][e] * ha[1][e] + wa[2][e] * ua[e], vb = bb[e] + wb[0][e] * hb[0][e] + wb[1][e] * hb[1][e] + wb[2][e] * ub[e];
                o[e] = siluf_(va) * vb; ha[0][e] = ha[1][e]; ha[1][e] = ua[e]; hb[0][e] = hb[1][e]; hb[1][e] = ub[e]; }
            *(u32x4*)(Gb + (size_t)r * DFF + f0) = pack8f(o);
            const int tpos = (r >= MP) ? ((r - MP) & 63) : (r & (TP - 1)), tlen = (r >= MP) ? TS : TP;
            if (tpos >= tlen - 2) { float* fo = (r >= MP) ? p->out + O_FCS + ((size_t)((r - MP) >> 6) * 2 + (tpos - (tlen - 2))) * DFF2 : p->out + O_FCP + ((size_t)(r >> 13) * 2 + (tpos - (tlen - 2))) * DFF2;
#pragma unroll
                for (int e = 0; e < 8; ++e) { fo[f0 + e] = ua[e]; fo[DFF + f0 + e] = ub[e]; } }
            if (!half && r >= HALF_ROWS - 2) { *(u32x4*)(HALO + (size_t)(r - (HALF_ROWS - 2)) * DFF2 + ca) = uaw; *(u32x4*)(HALO + (size_t)(r - (HALF_ROWS - 2)) * DFF2 + cbb) = ubw; }
        }
    }
}
constexpr int LDS_TOTAL = 147456;
enum { PH_CONV = 100 };
enum { PH_PREP = 0, PH_N1, PH_G1A, PH_SSD, PH_GN, PH_G1B, PH_G2, PH_G1C, PH_QK, PH_ATT, PH_G3, PH_G4, PH_N2, PH_G5A, PH_CVA, PH_G5B, PH_CVB, PH_G6, PH_COUNT };
__device__ __forceinline__ void gsync(unsigned char* lds) {
    KPrm p0 = (KPrm)__builtin_amdgcn_kernarg_segment_ptr(); asm volatile("" : "+s"(p0));
    XcdBarrier xb; xb.bar = (unsigned*)(p0->ws + W_BAR); xb.x = xb_xcc_id(); xb.st = (volatile LAS unsigned*)(lds + LDS_TOTAL - 64);
    xcd_barrier(xb);
}
#ifndef WGM_OF
#define WGM_OF(N) ((N) == 2048 ? 8 : 4)
#endif
__device__ __forceinline__ void run_gemms(KPrm p, const Ctx cx, unsigned char* lds, const int first, const int last) {
#pragma unroll 1
    for (int ph = first; ph <= last; ++ph) {
        unsigned char* ws = p->ws;
        pg8::Gemm g; Epi E;
        g.A = (const u16*)(ws + W_H); g.Bt = nullptr; g.M = M; g.N = DM; g.K = DM;
        E.mode = 0; E.d0 = E.d1 = E.d2 = nullptr; E.t1 = E.t2 = 1 << 20; E.p0 = E.p1 = E.p2 = 0; E.f32seg2 = 0; E.vseg2 = 0; E.vout = p->out + O_VP; E.vslab = (u16*)p->out + (size_t)NBS * SKVS * DM;
        E.xp = p->in[I_XP]; E.xs = p->in[I_XS]; E.y = p->out; E.mod = (const float*)(ws + W_MOD); E.gbuf = (u16*)(ws + W_GM); E.gf = (const u16*)(ws + W_GF);
        switch (ph) {
        case PH_G1A: g.Bt = (const u16*)(ws + W_WIN); g.N = 41 * 256;
            E.d0 = (u16*)(ws + W_XBC); E.p0 = CD; E.t1 = 24; E.d1 = (u16*)(ws + W_Z); E.p1 = DI; E.t2 = 40; E.d2 = (u16*)(ws + W_SMALL); E.p2 = 256; E.f32seg2 = 1; break;
        case PH_G1B: g.Bt = (const u16*)(ws + W_WIN) + (size_t)10496 * DM; g.N = 16 * 256;
            E.d0 = (u16*)(ws + W_GM); E.p0 = DM; E.t1 = 8; E.d1 = (u16*)(ws + W_GF); E.p1 = DM; break;
        case PH_G2: g.A = (const u16*)(ws + W_Z); g.Bt = (const u16*)(ws + W_WPM); g.K = DI; E.mode = 1; break;
        case PH_G1C: g.Bt = (const u16*)(ws + W_WIN) + (size_t)14592 * DM; g.N = 24 * 256;
            E.d0 = (u16*)(ws + W_Q); E.p0 = DM; E.t1 = 8; E.d1 = (u16*)(ws + W_K); E.p1 = DM; E.t2 = 16; E.d2 = (u16*)(ws + W_V); E.p2 = DM; E.vseg2 = 1; break;
        case PH_G3: g.A = (const u16*)(ws + W_Q); g.Bt = (const u16*)(ws + W_WPF); E.mode = 2; break;
        case PH_G4: g.A = (const u16*)(ws + W_GM); g.Bt = (const u16*)(ws + W_WOUT); E.mode = 3; break;
        case PH_G5A: g.Bt = (const u16*)(ws + W_WUP); g.M = HALF_ROWS; g.N = DFF2; E.d0 = (u16*)(ws + W_U); E.p0 = DFF2; break;
        case PH_G5B: g.A = (const u16*)(ws + W_H) + (size_t)HALF_ROWS * DM; g.Bt = (const u16*)(ws + W_WUP); g.M = HALF_ROWS; g.N = DFF2; E.d0 = (u16*)(ws + W_U); E.p0 = DFF2; break;
        default:   g.A = (const u16*)(ws + W_G); g.Bt = (const u16*)(ws + W_WDN); g.K = DFF; E.mode = 5; break;
        }
        int tail = 0; if (ph == PH_G2 || ph == PH_G3 || ph == PH_G4 || ph == PH_G6 || ph == PH_G1B || ph == PH_G1C) { g.M = MP; tail = 4; }
        pg8::StaticOrder S; S.init(g.M, g.N, cx.G, cx.bid, tail, WGM_OF(g.N));
        pg8::gemm_phase<Epi, pg8::StaticOrder, true, true>((PG8_LAS unsigned char*)lds, g, S, E, cx.tid);
        if (ph < last) gsync(lds);
    }
}
#define PH_BEGIN() Ctx cx; { int t_ = threadIdx.x; asm volatile("" : "+v"(t_)); int b_ = blockIdx.x, g_ = gridDim.x; asm volatile("" : "+s"(b_), "+s"(g_)); cx.tid = t_; cx.bid = b_; cx.G = g_; } \
    KPrm p = (KPrm)__builtin_amdgcn_kernarg_segment_ptr(); asm volatile("" : "+s"(p))
#ifdef ONLY_PH
#define PH_ON(k) ((k) == ONLY_PH)
#else
#define PH_ON(k) true
#endif
__global__ void __launch_bounds__(512, 2) mega_fwd(Prm prm_unused) {
    extern __shared__ __attribute__((aligned(16))) unsigned char lds[];
    cg::grid_group grid = cg::this_grid();
    volatile LAS unsigned* bst = (volatile LAS unsigned*)(lds + LDS_TOTAL - 64);
    if (threadIdx.x < 2) bst[threadIdx.x] = 0u;
    __syncthreads();
    { KPrm p0 = (KPrm)__builtin_amdgcn_kernarg_segment_ptr(); (void)xcd_barrier_post((unsigned*)(p0->ws + W_BAR), bst); }
#define GSYNC() gsync(lds)
#ifndef EXP
#define EXP 0
#endif
    if (PH_ON(PH_PREP)) { PH_BEGIN(); phase_prep(p, cx, lds); } grid.sync();
#if EXP == 3
    { PH_BEGIN(); phase_prep(p, cx, lds); } GSYNC();
#endif
    if (PH_ON(PH_N1)) { PH_BEGIN(); phase_norm(p, cx, 0); } GSYNC();
    if (PH_ON(PH_G1A)) { PH_BEGIN(); run_gemms(p, cx, lds, PH_G1A, PH_G1A); } GSYNC();
#if EXP == 1
    { PH_BEGIN(); run_gemms(p, cx, lds, PH_G1A, PH_G1A); } GSYNC();
#endif
    if (PH_ON(PH_CONV)) { PH_BEGIN(); phase_conv(p, cx); } GSYNC();
    if (PH_ON(PH_SSD)) { PH_BEGIN(); phase_ssd(p, cx, lds); } GSYNC();
#if EXP == 2
    { PH_BEGIN(); run_gemms(p, cx, lds, PH_G1A, PH_G1A); } GSYNC();
    { PH_BEGIN(); phase_conv(p, cx); } GSYNC();
    { PH_BEGIN(); phase_ssd(p, cx, lds); } GSYNC();
#endif
    if (PH_ON(PH_GN)) { PH_BEGIN(); phase_gn(p, cx); }
    if (PH_ON(PH_G1B)) { PH_BEGIN(); run_gemms(p, cx, lds, PH_G1B, PH_G1C); } GSYNC();
    if (PH_ON(PH_QK)) { PH_BEGIN(); phase_qk(p, cx); } GSYNC();
    if (PH_ON(PH_ATT)) { PH_BEGIN(); phase_att(p, cx, (char*)lds); } GSYNC();
#if EXP == 4
    { PH_BEGIN(); run_gemms(p, cx, lds, PH_G1C, PH_G1C); } GSYNC();
    { PH_BEGIN(); phase_qk(p, cx); } GSYNC();
    { PH_BEGIN(); phase_att(p, cx, (char*)lds); } GSYNC();
#endif
    if (PH_ON(PH_G3)) { PH_BEGIN(); run_gemms(p, cx, lds, PH_G3, PH_G4); } GSYNC();
    if (PH_ON(PH_N2)) { PH_BEGIN(); phase_norm(p, cx, 1); } GSYNC();
    if (PH_ON(PH_G5A)) { PH_BEGIN(); run_gemms(p, cx, lds, PH_G5A, PH_G5A); } GSYNC();
    if (PH_ON(PH_CVA)) { PH_BEGIN(); phase_cv(p, cx, 0); } GSYNC();
    if (PH_ON(PH_G5B)) { PH_BEGIN(); run_gemms(p, cx, lds, PH_G5B, PH_G5B); } GSYNC();
    if (PH_ON(PH_CVB)) { PH_BEGIN(); phase_cv(p, cx, 1); } GSYNC();
    if (PH_ON(PH_G6)) { PH_BEGIN(); run_gemms(p, cx, lds, PH_G6, PH_G6); }
#if EXP == 5
#pragma unroll 1
    for (int r = 0; r < 32; ++r) GSYNC();
#endif
}

extern "C" void kernel_launch(void* const* d_in, const int* in_sizes, int n_in, void* d_out, int out_size, void* d_ws, size_t ws_size, hipStream_t stream) {
    static int grid = 0;
    if (grid == 0) {
        if (n_in != 31 || (size_t)out_size != O_END || ws_size < 1024 * MiB) { fprintf(stderr, "kernel_launch: unexpected sizes n_in %d out %d ws %zu\n", n_in, out_size, ws_size); }
        int dev = 0, cus = 0, per_cu = 0;
        hipGetDevice(&dev); hipDeviceGetAttribute(&cus, hipDeviceAttributeMultiprocessorCount, dev);
        hipFuncSetAttribute((const void*)mega_fwd, hipFuncAttributeMaxDynamicSharedMemorySize, LDS_TOTAL);
        hipOccupancyMaxActiveBlocksPerMultiprocessor(&per_cu, (const void*)mega_fwd, 512, LDS_TOTAL);
        (void)hipGetLastError();
        if (per_cu < 1) per_cu = 1;
        grid = cus;
    }
    (void)hipMemsetAsync((char*)d_ws + W_BAR, 0, 16384, stream);
    Prm prm{};
    for (int i = 0; i < 31; ++i) prm.in[i] = (const float*)d_in[i];
    prm.out = (float*)d_out; prm.ws = (unsigned char*)d_ws;
    void* args[] = {&prm};
    hipError_t e = hipLaunchCooperativeKernel((const void*)mega_fwd, dim3(grid), dim3(512), args, LDS_TOTAL, stream);
    if (e != hipSuccess) fprintf(stderr, "cooperative launch failed: %s (grid %d)\n", hipGetErrorString(e), grid);
}
```

```cpp
#include <hip/hip_runtime.h>
#include <hip/hip_cooperative_groups.h>
#include <hip/hip_bf16.h>
#include <cstdio>
#include <cstdint>
namespace cg = cooperative_groups;
namespace pg8 {
#define PG8_LAS __attribute__((address_space(3)))
typedef unsigned short bf16_t;
typedef short bf16x8 __attribute__((ext_vector_type(8)));
typedef float f32x4 __attribute__((ext_vector_type(4)));
typedef unsigned u32x4 __attribute__((ext_vector_type(4)));
constexpr int BM = 256, BK = 64, HALF = 128, HTB = HALF * BK * 2  , STAGE_BYTES = 8 * HTB, NXCD = 8, WGM = 8;

__host__ __device__ __forceinline__ int lds_byte(int r, int c) { const int st = (r >> 4) * 2 + (c >> 5), rr = r & 15, cc = c & 31, ob = rr * 64 + cc * 2; return st * 1024 + (ob ^ (((ob >> 9) & 1) << 5)); }
__host__ __device__ __forceinline__ void stage_rc(int b, int& R, int& C) { const int st = b / 1024, sb = b % 1024, swz = sb ^ (((sb >> 9) & 1) << 5); R = (st >> 1) * 16 + swz / 64; C = (st & 1) * 32 + (swz % 64) / 2; }
__host__ __device__ __forceinline__ int perm32(int rho) { const int n = rho >> 4, i = rho & 15; return 8 * (i >> 2) + 4 * n + (i & 3); }

struct Unit { int pm, pn, ho, half; };
struct Gemm { const bf16_t* A; const bf16_t* Bt; int M, N, K; };

struct StaticOrder {
    int nM, nN, nwg, G, c, tail, wgm;
    __host__ __device__ void init(int M, int N, int G_, int c_, int tail_ = 0, int wgm_ = 4) { nM = M / BM; nN = N / BM; nwg = nM * nN; G = G_; c = c_; tail = tail_; wgm = wgm_; }
    __host__ __device__ bool next(int i, Unit& u) const {
        const long L = (long)i * G + c; u.ho = 0; u.half = 0;
        if (L >= nwg) { const int h = (int)(L - nwg); if (h >= tail * nN) return false; const int hm = h / nN; u.pn = h - hm * nN; u.pm = nM + (hm >> 1); u.ho = hm & 1; u.half = 1; return true; }
        int wgid = (int)L; { const int q = nwg / NXCD, r = nwg % NXCD, xcd = wgid % NXCD, off = wgid / NXCD; wgid = (xcd < r ? xcd * (q + 1) : r * (q + 1) + (xcd - r) * q) + off; }
        const int nig = wgm * nN, gid = wgid / nig, fm = gid * wgm, gsz = (nM - fm) < wgm ? (nM - fm) : wgm;
        u.pm = fm + ((wgid % nig) % gsz); u.pn = (wgid % nig) / gsz; return true;
    }
    __device__ __forceinline__ void a_ready(const Unit&) const {}
    __device__ __forceinline__ void done(const Unit&) const {}
};
__device__ __forceinline__ unsigned cvt_pk_bf16(float lo, float hi) { unsigned r; asm volatile("v_cvt_pk_bf16_f32 %0, %1, %2" : "=v"(r) : "v"(lo), "v"(hi)); return r; }
typedef float f32x2 __attribute__((ext_vector_type(2)));
template <class Epi, class Sched, bool ALIGN_EPI = false, bool SP2 = false>
__device__ __forceinline__ void gemm_phase(PG8_LAS unsigned char* lds, const Gemm g, const Sched& S, const Epi& E, const int tid) {
    const int wid = __builtin_amdgcn_readfirstlane(tid >> 6), lane = tid & 63, wr = wid >> 2, wc = wid & 3, fr = lane & 15, fq = lane >> 4;
    const int K = g.K, nt = K / BK;
    unsigned voffA[2], voffB[2];
#pragma unroll
    for (int i = 0; i < 2; ++i) { int R, C; stage_rc(tid * 16 + i * 8192, R, C); const int Rb = Epi::PERM ? ((R & ~31) + perm32(R & 31)) : R;
        voffA[i] = (unsigned)(R * K + C) * 2u; voffB[i] = (unsigned)(Rb * K + C) * 2u; }
    const size_t kstep = (size_t)(BK * 2);
    const size_t hstep = (size_t)HALF * K * 2;
    const size_t tstep = 2 * hstep;
    const unsigned ldsw = (unsigned)wid * 1024u;
    const int aoff = lds_byte(wr * 64 + fr, fq * 8), boff = lds_byte(wc * 32 + fr, fq * 8);
#define PG8_SA(b, h) (((b) * 2 + (h)) * HTB)
#define PG8_SB(b, h) ((4 + (b) * 2 + (h)) * HTB)
#define PG8_STAGE(bufoff, gbase, voff) do { _Pragma("unroll") for (int _i = 0; _i < 2; ++_i) \
        __builtin_amdgcn_global_load_lds((const unsigned*)((const char*)(gbase) + (voff)[_i]), (PG8_LAS unsigned*)(lds + (bufoff) + ldsw + _i * 8192), 16, 0, 0); } while (0)
#define PG8_LDA(dst, b, h) do { _Pragma("unroll") for (int m = 0; m < 4; ++m) _Pragma("unroll") for (int k = 0; k < 2; ++k) dst[m][k] = *(const PG8_LAS bf16x8*)(lds + PG8_SA(b, h) + aoff + m * 2048 + k * 1024); } while (0)
#define PG8_LDB(dst, b, h) do { _Pragma("unroll") for (int n = 0; n < 2; ++n) _Pragma("unroll") for (int k = 0; k < 2; ++k) dst[n][k] = *(const PG8_LAS bf16x8*)(lds + PG8_SB(b, h) + boff + n * 2048 + k * 1024); } while (0)
#define PG8_MMA(ai, bj, At, Bt) do { __builtin_amdgcn_s_setprio(1); _Pragma("unroll") for (int m = 0; m < 4; ++m) _Pragma("unroll") for (int n = 0; n < 2; ++n) _Pragma("unroll") for (int k = 0; k < 2; ++k) \
        acc[ai][bj][m][n] = __builtin_amdgcn_mfma_f32_16x16x32_bf16(Bt[n][k], At[m][k], acc[ai][bj][m][n], 0, 0, 0); __builtin_amdgcn_s_setprio(0); } while (0)
#define PG8_WAIT_V(n) asm volatile("s_waitcnt vmcnt(" #n ")" ::: "memory")
#define PG8_WAIT_L(n) asm volatile("s_waitcnt lgkmcnt(" #n ")" ::: "memory")
#define PG8_BAR __builtin_amdgcn_s_barrier()
#define PG8_SCHED __builtin_amdgcn_sched_barrier(0)
    Unit cur, nxt; int ui = 0;
    if (!S.next(0, cur)) return;
    f32x4 acc[2][2][4][2];
#pragma unroll
    for (int a = 0; a < 2; ++a)
#pragma unroll
        for (int b = 0; b < 2; ++b)
#pragma unroll
            for (int m = 0; m < 4; ++m)
#pragma unroll
                for (int n = 0; n < 2; ++n) acc[a][b][m][n] = (f32x4){0.f, 0.f, 0.f, 0.f};
    bf16x8 At[4][2], B0[2][2], B1[2][2];
    const char* cA = (const char*)g.A + (size_t)cur.pm * tstep + (size_t)cur.ho * hstep; const char* cB = (const char*)g.Bt + (size_t)cur.pn * tstep;
    S.a_ready(cur);
    if constexpr (SP2) {
        PG8_STAGE(PG8_SB(0, 0), cB, voffB); PG8_STAGE(PG8_SB(0, 1), cB + hstep, voffB); PG8_STAGE(PG8_SA(0, 0), cA, voffA); PG8_STAGE(PG8_SA(0, 1), cA + hstep, voffA);
        if (wr == 1) PG8_BAR;
        PG8_WAIT_V(2); PG8_BAR;
        PG8_STAGE(PG8_SB(1, 0), cB + kstep, voffB); PG8_STAGE(PG8_SA(1, 0), cA + kstep, voffA); PG8_STAGE(PG8_SB(1, 1), cB + hstep + kstep, voffB);
        PG8_WAIT_V(6); PG8_BAR;
    } else {
        PG8_STAGE(PG8_SB(0, 0), cB, voffB); PG8_STAGE(PG8_SA(0, 0), cA, voffA); PG8_STAGE(PG8_SB(0, 1), cB + hstep, voffB); PG8_STAGE(PG8_SA(0, 1), cA + hstep, voffA);
        if (wr == 1) PG8_BAR;
        PG8_WAIT_V(4); PG8_BAR;
        PG8_STAGE(PG8_SB(1, 0), cB + kstep, voffB); PG8_STAGE(PG8_SA(1, 0), cA + kstep, voffA); PG8_STAGE(PG8_SB(1, 1), cB + hstep + kstep, voffB);
        PG8_WAIT_V(6); PG8_BAR;
    }
    for (;;) {
        const bool has_next = S.next(ui + 1, nxt);
        const char* nA = has_next ? (const char*)g.A + (size_t)nxt.pm * tstep + (size_t)nxt.ho * hstep : cA; const char* nB = has_next ? (const char*)g.Bt + (size_t)nxt.pn * tstep : cB;
        for (int t = 0; t < nt; t += 2) {
            const bool last = (t == nt - 2);
            const char* a1 = cA + (size_t)(t + 1) * kstep;
            const char* a2 = last ? nA : cA + (size_t)(t + 2) * kstep; const char* b2 = last ? nB : cB + (size_t)(t + 2) * kstep;
            const char* a3 = a2 + kstep; const char* b3 = b2 + kstep;
            if (last && has_next) S.a_ready(nxt);
            if constexpr (SP2) {
            PG8_LDB(B0, 0, 0); PG8_LDB(B1, 0, 1); PG8_SCHED; PG8_LDA(At, 0, 0); PG8_STAGE(PG8_SA(1, 1), a1 + hstep, voffA);
            PG8_WAIT_V(8); PG8_WAIT_L(0); PG8_BAR; PG8_MMA(0, 0, At, B0); PG8_MMA(0, 1, At, B1); PG8_BAR; PG8_SCHED;
            PG8_LDA(At, 0, 1); PG8_STAGE(PG8_SB(0, 0), b2, voffB); PG8_STAGE(PG8_SB(0, 1), b2 + hstep, voffB); PG8_STAGE(PG8_SA(0, 0), a2, voffA);
            PG8_WAIT_V(8); PG8_WAIT_L(0); PG8_BAR; if (!cur.half) { PG8_MMA(1, 0, At, B0); PG8_MMA(1, 1, At, B1); } PG8_BAR; PG8_SCHED;
            PG8_LDB(B0, 1, 0); PG8_LDB(B1, 1, 1); PG8_SCHED; PG8_LDA(At, 1, 0); PG8_STAGE(PG8_SA(0, 1), a2 + hstep, voffA);
            PG8_WAIT_V(8); PG8_WAIT_L(0); PG8_BAR; PG8_MMA(0, 0, At, B0); PG8_MMA(0, 1, At, B1); PG8_BAR; PG8_SCHED;
            PG8_LDA(At, 1, 1); PG8_STAGE(PG8_SB(1, 0), b3, voffB); PG8_STAGE(PG8_SB(1, 1), b3 + hstep, voffB); PG8_STAGE(PG8_SA(1, 0), a3, voffA);
            PG8_WAIT_V(8); PG8_WAIT_L(0); PG8_BAR; if (!cur.half) { PG8_MMA(1, 0, At, B0); PG8_MMA(1, 1, At, B1); } PG8_BAR; PG8_SCHED;
            } else {
            PG8_LDB(B0, 0, 0); PG8_SCHED; PG8_LDA(At, 0, 0); PG8_STAGE(PG8_SA(1, 1), a1 + hstep, voffA);
            PG8_WAIT_L(8); PG8_BAR; PG8_WAIT_L(0); PG8_MMA(0, 0, At, B0); PG8_BAR; PG8_SCHED;
            PG8_LDB(B1, 0, 1); PG8_STAGE(PG8_SB(0, 0), b2, voffB);
            PG8_BAR; PG8_WAIT_L(0); PG8_MMA(0, 1, At, B1); PG8_BAR;
            PG8_LDA(At, 0, 1); PG8_STAGE(PG8_SA(0, 0), a2, voffA);
            PG8_BAR; PG8_WAIT_L(0); PG8_MMA(1, 0, At, B0); PG8_BAR; PG8_SCHED;
            PG8_STAGE(PG8_SB(0, 1), b2 + hstep, voffB);
            PG8_WAIT_V(6); PG8_BAR; PG8_MMA(1, 1, At, B1); PG8_BAR;
            PG8_LDB(B0, 1, 0); PG8_SCHED; PG8_LDA(At, 1, 0); PG8_STAGE(PG8_SA(0, 1), a2 + hstep, voffA);
            PG8_WAIT_L(8); PG8_BAR; PG8_WAIT_L(0); PG8_MMA(0, 0, At, B0); PG8_BAR; PG8_SCHED;
            PG8_LDB(B1, 1, 1); PG8_STAGE(PG8_SB(1, 0), b3, voffB);
            PG8_BAR; PG8_WAIT_L(0); PG8_MMA(0, 1, At, B1); PG8_BAR;
            PG8_LDA(At, 1, 1); PG8_STAGE(PG8_SA(1, 0), a3, voffA);
            PG8_BAR; PG8_WAIT_L(0); PG8_MMA(1, 0, At, B0); PG8_BAR; PG8_SCHED;
            PG8_STAGE(PG8_SB(1, 1), b3 + hstep, voffB);
            PG8_WAIT_V(6); PG8_BAR; PG8_MMA(1, 1, At, B1); PG8_BAR;
            }
        }
        if constexpr (ALIGN_EPI) { if (wr == 0) PG8_BAR; }
        if constexpr (!Epi::AFTER_DRAIN) { E(acc, cur, wr, wc, fr, fq); S.done(cur); }
        if (!has_next) break;
#pragma unroll
        for (int a = 0; a < 2; ++a)
#pragma unroll
            for (int b = 0; b < 2; ++b)
#pragma unroll
                for (int m = 0; m < 4; ++m)
#pragma unroll
                    for (int n = 0; n < 2; ++n) acc[a][b][m][n] = (f32x4){0.f, 0.f, 0.f, 0.f};
        cur = nxt; cA = nA; cB = nB; ++ui;
        if constexpr (ALIGN_EPI) { if (wr == 1) PG8_BAR; }
    }
    PG8_WAIT_V(0);
    if constexpr (!ALIGN_EPI) { if (wr == 0) PG8_BAR; }
    PG8_BAR;
    if constexpr (Epi::AFTER_DRAIN) { E.fused(acc, cur, wr, wc, fr, fq, lds, wid, lane); S.done(cur); }
#undef PG8_SA
#undef PG8_SB
#undef PG8_STAGE
#undef PG8_LDA
#undef PG8_LDB
#undef PG8_MMA
#undef PG8_WAIT_V
#undef PG8_WAIT_L
#undef PG8_BAR
#undef PG8_SCHED
}
}
namespace att {
constexpr int D = 128, PITCH = 2048, NW = 8, QBLK = 32, KVBLK = 64, QB = NW * QBLK;
constexpr int SHM_V = KVBLK * D * 2, SHM_K = KVBLK * D * 2;
constexpr int LDS_BIAS = 2 * SHM_V + 2 * SHM_K + NW * 64 * 4;
constexpr int NQX = 4, LDS_QX = LDS_BIAS + 512;
constexpr int LDS_BYTES = LDS_QX + NW * NQX * 1024;
constexpr float THR2 = 64.f;
constexpr bool WSKIP = false;
typedef __hip_bfloat16 bf16;
typedef short bf16x8 __attribute__((ext_vector_type(8)));
typedef short s16x4 __attribute__((ext_vector_type(4)));
typedef float f32x16 __attribute__((ext_vector_type(16)));
typedef float f32x4 __attribute__((ext_vector_type(4)));
typedef unsigned u32x4 __attribute__((ext_vector_type(4)));
template <class A, class Bt> struct same_t { static constexpr bool v = false; };
template <class A> struct same_t<A, A> { static constexpr bool v = true; };

#define KSWZ(row, colB) ((row) * 256 + ((colB) ^ (((row) & 7) << 4)))
#define SBAR() __builtin_amdgcn_sched_barrier(0)
__device__ __forceinline__ int v_st(int k, int c) { const int kk = (k & ~0xC) | ((k & 4) << 1) | ((k & 8) >> 1); return ((kk >> 3) * 4 + (c >> 5)) * 512 + ((kk & 7) * 32 + (c & 31)) * 2; }
__device__ __forceinline__ int v_rd_base(int lane) { return ((lane & 3) << 3) | (((lane >> 2) & 3) << 6) | (((lane >> 4) & 1) << 5) | (((lane >> 5) & 1) << 8); }
constexpr int v_rd_off(int d0, int ks, int half) { return d0 * 512 + ks * 4096 + half * 2048; }
__device__ __forceinline__ int crow(int r, int hi) { return (r & 3) + 8 * (r >> 2) + 4 * hi; }
__device__ __forceinline__ unsigned cvtpk(float lo, float hi) {
    unsigned r; asm volatile("v_cvt_pk_bf16_f32 %0, %1, %2" : "=v"(r) : "v"(lo), "v"(hi)); return r;
}
__device__ __forceinline__ bf16x8 pack8(f32x4 a, f32x4 b) {
    u32x4 w = {cvtpk(a[0], a[1]), cvtpk(a[2], a[3]), cvtpk(b[0], b[1]), cvtpk(b[2], b[3])};
    return *reinterpret_cast<bf16x8*>(&w);
}
template <class T> __device__ __forceinline__ bf16x8 load8(const T* p) {
    if constexpr (same_t<T, float>::v) { return pack8(*(const f32x4*)p, *(const f32x4*)(p + 4)); }
    else { return *reinterpret_cast<const bf16x8*>(p); }
}
__device__ __forceinline__ void mask_tile(f32x16& p0, f32x16& p1, int dq, unsigned W) {
    const float NEG = -__builtin_inff();
#pragma unroll
    for (int r = 0; r < 16; ++r) {
        const int c = (r & 3) + 8 * (r >> 2);
        if (dq - c < 0) p0[r] = NEG;
        if (dq - c - 32 < 0) p1[r] = NEG;
    }
}
__device__ __forceinline__ void partialSM(f32x16& p0, f32x16& p1, float& m_reg, float& mn, float& alpha) {
    float pmax = p0[0]; for (int r = 1; r < 16; ++r) pmax = fmaxf(pmax, p0[r]); for (int r = 0; r < 16; ++r) pmax = fmaxf(pmax, p1[r]);
    { auto rr = __builtin_amdgcn_permlane32_swap(__float_as_uint(pmax), __float_as_uint(pmax), false, false);
      pmax = fmaxf(__uint_as_float(rr[0]), __uint_as_float(rr[1])); }
    if (__builtin_expect(__all((pmax - m_reg) <= THR2), 1)) { mn = m_reg; alpha = 1.f; }
    else { mn = fmaxf(m_reg, pmax); alpha = __builtin_amdgcn_exp2f(m_reg - mn); m_reg = mn; }
    for (int r = 0; r < 16; ++r) p0[r] = p0[r] - mn; for (int r = 0; r < 16; ++r) p1[r] = p1[r] - mn;
    for (int r = 0; r < 16; ++r) p0[r] = __builtin_amdgcn_exp2f(p0[r]);
}
__device__ __forceinline__ void finishSM(f32x16& p0, f32x16& p1, float alpha, float& l_reg, bf16x8& pa0, bf16x8& pa1, bf16x8& pa2, bf16x8& pa3) {
    for (int r = 0; r < 16; ++r) p1[r] = __builtin_amdgcn_exp2f(p1[r]);
    float ps = 0; for (int r = 0; r < 16; ++r) ps += p0[r]; for (int r = 0; r < 16; ++r) ps += p1[r];
    { auto rr = __builtin_amdgcn_permlane32_swap(__float_as_uint(ps), __float_as_uint(ps), false, false);
      ps = __uint_as_float(rr[0]) + __uint_as_float(rr[1]); }
    l_reg = l_reg * alpha + ps;
#define PK4(P, B_, OUT) do { unsigned a0 = cvtpk(P[B_+0], P[B_+1]), a1 = cvtpk(P[B_+2], P[B_+3]);                          \
        unsigned b0 = cvtpk(P[B_+4], P[B_+5]), b1 = cvtpk(P[B_+6], P[B_+7]);                                             \
        auto r0 = __builtin_amdgcn_permlane32_swap(a0, b0, false, false); auto r1 = __builtin_amdgcn_permlane32_swap(a1, b1, false, false); \
        u32x4 w = {r0[0], r1[0], r0[1], r1[1]}; OUT = *reinterpret_cast<bf16x8*>(&w); } while (0)
    PK4(p0, 0, pa0); PK4(p0, 8, pa1); PK4(p1, 0, pa2); PK4(p1, 8, pa3);
#undef PK4
}
template <int KB, bool SK>
__device__ __forceinline__ void qkt(f32x16& p0, f32x16& p1, const char* K_lds, int r32, int hi, const bf16x8* qr, bool act, const char* qx) {
    if (SK && !act) { const float NEG = -__builtin_inff();
#pragma unroll
        for (int r = 0; r < 16; ++r) { p0[r] = NEG; p1[r] = NEG; } return; }
    { const float* bl = (const float*)(K_lds - 2 * SHM_V + LDS_BIAS) + KB * 64 + 4 * hi;
#pragma unroll
      for (int g = 0; g < 4; ++g) { const f32x4 u0 = *(const f32x4*)(bl + 8 * g), u1 = *(const f32x4*)(bl + 32 + 8 * g);
        p0[4*g] = u0[0]; p0[4*g+1] = u0[1]; p0[4*g+2] = u0[2]; p0[4*g+3] = u0[3]; p1[4*g] = u1[0]; p1[4*g+1] = u1[1]; p1[4*g+2] = u1[2]; p1[4*g+3] = u1[3]; } }
    const char* kb[4];
#pragma unroll
    for (int dd = 0; dd < 4; ++dd) kb[dd] = K_lds + KB * SHM_K + KSWZ(r32, (dd * 16 + hi * 8) * 2);
#pragma unroll
    for (int d0 = 0; d0 < 8; ++d0) { const char* a = kb[d0 & 3] + (d0 >> 2) * 128;
        bf16x8 b0 = *reinterpret_cast<const bf16x8*>(a);
        bf16x8 b1 = *reinterpret_cast<const bf16x8*>(a + 32 * 256);
        const bf16x8 qv = (d0 < 8 - NQX) ? qr[d0] : *reinterpret_cast<const bf16x8*>(qx + (d0 - (8 - NQX)) * 1024);
        p0 = __builtin_amdgcn_mfma_f32_32x32x16_bf16(b0, qv, p0, 0, 0, 0);
        p1 = __builtin_amdgcn_mfma_f32_32x32x16_bf16(b1, qv, p1, 0, 0, 0); }
}
template <int VB, bool SK>
__device__ __forceinline__ void pv_tile(f32x16* o, int vb0, bf16x8 pa0, bf16x8 pa1, bf16x8 pa2, bf16x8 pa3, bool act) {
    if (SK && !act) return;
#define TRRD(dst, off) asm volatile("ds_read_b64_tr_b16 %0, %1 offset:%2" : "=&v"(dst) : "v"(vb0), "i"(off) : "memory")
#define PV_D0(d0) do { s16x4 l0, l1, l2, l3, h0, h1, h2, h3; constexpr int b_ = VB * SHM_V + v_rd_off(d0, 0, 0);     \
        TRRD(l0, b_); TRRD(h0, b_ + 2048); TRRD(l1, b_ + 4096); TRRD(h1, b_ + 6144); TRRD(l2, b_ + 8192); TRRD(h2, b_ + 10240); TRRD(l3, b_ + 12288); TRRD(h3, b_ + 14336); \
        asm volatile("s_waitcnt lgkmcnt(0)" ::: "memory"); SBAR();                 \
        o[d0] = __builtin_amdgcn_mfma_f32_32x32x16_bf16(pa0, (bf16x8){l0[0], l0[1], l0[2], l0[3], h0[0], h0[1], h0[2], h0[3]}, o[d0], 0, 0, 0);   \
        o[d0] = __builtin_amdgcn_mfma_f32_32x32x16_bf16(pa1, (bf16x8){l1[0], l1[1], l1[2], l1[3], h1[0], h1[1], h1[2], h1[3]}, o[d0], 0, 0, 0);   \
        o[d0] = __builtin_amdgcn_mfma_f32_32x32x16_bf16(pa2, (bf16x8){l2[0], l2[1], l2[2], l2[3], h2[0], h2[1], h2[2], h2[3]}, o[d0], 0, 0, 0);   \
        o[d0] = __builtin_amdgcn_mfma_f32_32x32x16_bf16(pa3, (bf16x8){l3[0], l3[1], l3[2], l3[3], h3[0], h3[1], h3[2], h3[3]}, o[d0], 0, 0, 0); } while (0)
    PV_D0(0); PV_D0(1); PV_D0(2); PV_D0(3);
#undef PV_D0
#undef TRRD
}

template <class TIn, class TOut> struct BlockRef { const TIn* Q; const TIn* K; const TIn* V; TOut* O; const float* Bs; int P0; int nvalid; };
template <class TIn> struct Seam {
    bf16x8 qr[8];
    bf16x8 st_v0, st_v1, st_k0, st_k1; f32x4 sf0, sf1, sf2, sf3;
    f32x4 tq[16];
};
__device__ __forceinline__ int swa_jlo(int P0, int W) { const int lowk = P0 - W + 1; return lowk > 0 ? lowk / KVBLK : 0; }
#define ROW(p, k0, rr) ((p) + (size_t)((k0) + (rr)) * PITCH + sc)
#define VMW() asm volatile("s_waitcnt vmcnt(0)" ::: "memory")
#define VMWN(n) asm volatile("s_waitcnt vmcnt(%0)" :: "i"(n) : "memory")
#define GLDS(gp_, lp_, sz_) __builtin_amdgcn_global_load_lds((const unsigned*)(gp_), (__attribute__((address_space(3))) unsigned*)(lp_), sz_, 0, 0)
#define SLOAD_H(Kp, Vp, Bp, k0, bb_) do { S.st_v0 = load8<TIn>(ROW(Vp, k0, sr)); S.st_v1 = load8<TIn>(ROW(Vp, k0, 32 + sr));              \
                         { const TIn* kg_ = (Kp) + (size_t)(k0) * PITCH; char* kl_ = K_lds + (bb_) * SHM_K + wid * 2048; GLDS(kg_ + ksrc0, kl_, 16); GLDS(kg_ + ksrc1, kl_ + 1024, 16); } \
                         if (wid == 0) GLDS((Bp) + (k0) + lane, lds + LDS_BIAS + (bb_) * 256, 4); } while (0)
#define SWRITE_HK(bf) do { } while (0)
#define SWRITE_HV(bf) do { *(bf16x8*)(V_lds + (bf) * SHM_V + vst0) = S.st_v0; *(bf16x8*)(V_lds + (bf) * SHM_V + vst1) = S.st_v1; } while (0)
#define SWRITE_H(bf) do { SWRITE_HV(bf); SWRITE_HK(bf); } while (0)
#define SLOAD_F(p, k0) do { S.sf0 = *(const f32x4*)ROW(p, k0, sr); S.sf1 = *(const f32x4*)(ROW(p, k0, sr) + 4);                \
                            S.sf2 = *(const f32x4*)ROW(p, k0, 32 + sr); S.sf3 = *(const f32x4*)(ROW(p, k0, 32 + sr) + 4); } while (0)
#define SWRITE_KF(bf) do { *(bf16x8*)(K_lds + (bf) * SHM_K + kws) = pack8(S.sf0, S.sf1); *(bf16x8*)(K_lds + (bf) * SHM_K + kws + 32 * 256) = pack8(S.sf2, S.sf3); } while (0)
#define SWRITE_VF(bf) do { *(bf16x8*)(V_lds + (bf) * SHM_V + vst0) = pack8(S.sf0, S.sf1); *(bf16x8*)(V_lds + (bf) * SHM_V + vst1) = pack8(S.sf2, S.sf3); } while (0)
template <class TIn, class TOut>
__device__ __forceinline__ void causal_swa_prime(const BlockRef<TIn, TOut>& cur, int W, char* lds, Seam<TIn>& S, const int tid) {
    constexpr bool F32 = same_t<TIn, float>::v;
    const int wid = __builtin_amdgcn_readfirstlane(tid >> 6), lane = tid & 63, r32 = lane & 31, hi = lane >> 5;
    const int sr = tid >> 4, sc = (tid & 15) * 8, kws = KSWZ(sr, sc * 2); char* K_lds = lds + 2 * SHM_V; (void)kws;
    const int ksrc0 = (8 * wid + (lane >> 4)) * PITCH + ((lane & 15) ^ (lane >> 4)) * 8, ksrc1 = (8 * wid + 4 + (lane >> 4)) * PITCH + ((lane & 15) ^ (4 + (lane >> 4))) * 8;
    const int kb0 = swa_jlo(cur.P0, W) * KVBLK;
    for (int d0 = 0; d0 < 8; ++d0) S.qr[d0] = load8<TIn>(cur.Q + (size_t)(wid * QBLK + r32) * PITCH + d0 * 16 + hi * 8);
    if constexpr (F32) { SLOAD_F((const float*)cur.K, kb0); VMW(); SWRITE_KF(0); SBAR(); SLOAD_F((const float*)cur.V, kb0); }
    else { SLOAD_H(cur.K, cur.V, cur.Bs, kb0, 0); VMW(); SWRITE_HK(0); }
    __syncthreads();
}
template <class TIn, class TOut>
__device__ __forceinline__ void causal_swa_block(const BlockRef<TIn, TOut>& cur, const BlockRef<TIn, TOut>& nxt, int skv, int W, char* lds, Seam<TIn>& S, const int tid, const float* qnw, const float qs) {
    constexpr bool F32 = same_t<TIn, float>::v;
    const int wid = __builtin_amdgcn_readfirstlane(tid >> 6), lane = tid & 63, r32 = lane & 31, hi = lane >> 5;
    const int j_lo = swa_jlo(cur.P0, W);
    int j_hi = (cur.P0 + QB - 1) / KVBLK + 1; if (j_hi > skv / KVBLK) j_hi = skv / KVBLK;
    const int NT = j_hi - j_lo;
    const int kbn = swa_jlo(nxt.P0, W) * KVBLK;
    const int qlo = cur.P0 + wid * QBLK, qm = qlo + r32 - 4 * hi;
    char* V_lds = lds; char* K_lds = lds + 2 * SHM_V;
    float* ws = (float*)(lds + 2 * SHM_V + 2 * SHM_K) + wid * 64; float* li_l = ws, * al_l = ws + 32;
    float m_reg = -1e30f, l_reg = 0; f32x16 o[4] = {};
    const int sr = tid >> 4, sc = (tid & 15) * 8, vst0 = v_st(sr, sc), vst1 = v_st(32 + sr, sc), kws = KSWZ(sr, sc * 2);
    const int vb0 = (int)(uintptr_t)V_lds + v_rd_base(lane); (void)kws;
    const int ksrc0 = (8 * wid + (lane >> 4)) * PITCH + ((lane & 15) ^ (lane >> 4)) * 8, ksrc1 = (8 * wid + 4 + (lane >> 4)) * PITCH + ((lane & 15) ^ (4 + (lane >> 4))) * 8;
    const TIn* Kh = cur.K; const TIn* Vh = cur.V; const float* Bh = cur.Bs;
#define RESC(a) do { if (__any((a) < 1.f)) { if (hi == 0) al_l[r32] = (a); asm volatile("s_waitcnt lgkmcnt(0)" ::: "memory");              \
                     for (int d_ = 0; d_ < 4; ++d_) for (int r = 0; r < 16; ++r) o[d_][r] *= al_l[crow(r, hi)]; } } while (0)
#define KBASE(t) ((j_lo + (t)) * KVBLK)
#define ACT(t) (KBASE(t) <= qlo + QBLK - 1 && KBASE(t) + KVBLK - 1 >= qlo - W + 1)
#define MASKT(P0_, P1_, t) do { const int kb_ = KBASE(t); if ((!SK || ACT(t)) && (kb_ + KVBLK - 1 > qlo || kb_ <= qlo + QBLK - 1 - W)) mask_tile(P0_, P1_, qm - kb_, (unsigned)W); } while (0)
    constexpr int NQL = F32 ? 16 : 8;
    constexpr bool SK = WSKIP && !F32;
#define SEAM_K0() do { VMWN(NQL); if constexpr (F32) { SWRITE_KF(0); SBAR(); SLOAD_F((const float*)nxt.V, kbn); } else { SWRITE_HK(0); } SBAR(); } while (0)
    f32x16 pA0, pA1, pB0, pB1; float mnA, mnB, alA, alB; bf16x8 pa0, pa1, pa2, pa3;
    {
        const float* wq_ = qnw; asm volatile("" : "+s"(wq_));
        float ss_ = 0.f;
#pragma unroll
        for (int d0 = 0; d0 < 8; ++d0) { const u32x4 w_ = __builtin_bit_cast(u32x4, S.qr[d0]);
#pragma unroll
            for (int e = 0; e < 4; ++e) { const float lo_ = __uint_as_float(w_[e] << 16), hi_ = __uint_as_float(w_[e] & 0xffff0000u); ss_ += lo_ * lo_ + hi_ * hi_; } }
        { auto rr = __builtin_amdgcn_permlane32_swap(__float_as_uint(ss_), __float_as_uint(ss_), false, false); ss_ = __uint_as_float(rr[0]) + __uint_as_float(rr[1]); }
        const float rs_ = rsqrtf(ss_ * (1.f / 128.f) + 1e-6f) * qs;
#pragma unroll
        for (int d0 = 0; d0 < 8; ++d0) { const u32x4 w_ = __builtin_bit_cast(u32x4, S.qr[d0]); const f32x4 g0 = *(const f32x4*)(wq_ + d0 * 16 + hi * 8), g1 = *(const f32x4*)(wq_ + d0 * 16 + hi * 8 + 4); u32x4 o_;
#pragma unroll
            for (int e = 0; e < 4; ++e) { const float lo_ = __uint_as_float(w_[e] << 16) * rs_ * (e < 2 ? g0[2 * e] : g1[2 * e - 4]), hi_ = __uint_as_float(w_[e] & 0xffff0000u) * rs_ * (e < 2 ? g0[2 * e + 1] : g1[2 * e - 3]); o_[e] = cvtpk(lo_, hi_); }
            S.qr[d0] = __builtin_bit_cast(bf16x8, o_); }
    }
    char* qx = lds + LDS_QX + wid * (NQX * 1024) + lane * 16;
#pragma unroll
    for (int e = 0; e < NQX; ++e) *reinterpret_cast<bf16x8*>(qx + e * 1024) = S.qr[8 - NQX + e];
    if constexpr (F32) { VMW(); SWRITE_VF(0); SBAR(); } else { SWRITE_HV(0); SBAR(); }
    if (NT > 1) { if constexpr (F32) SLOAD_F((const float*)Kh, KBASE(1)); else SLOAD_H(Kh, Vh, Bh, KBASE(1), 1); }
    SBAR(); qkt<0, SK>(pA0, pA1, K_lds, r32, hi, S.qr, ACT(0), qx);
    if constexpr (F32) { if (NT > 1) { VMW(); SWRITE_KF(1); SBAR(); SLOAD_F((const float*)Vh, KBASE(1)); } }
    MASKT(pA0, pA1, 0); partialSM(pA0, pA1, m_reg, mnA, alA);
    if (NT > 1) { VMW(); if constexpr (F32) { SWRITE_VF(1); SBAR(); if (NT > 2) SLOAD_F((const float*)Kh, KBASE(2)); } else SWRITE_H(1); }
    __syncthreads();
#define HALF_STEP(PX0, PX1, mnX, alX, PY0, PY1, alY, t, KB, VB, SB) do {                                                      \
        SBAR(); qkt<KB, SK>(PX0, PX1, K_lds, r32, hi, S.qr, ACT(t), qx);                                             \
        finishSM(PY0, PY1, alY, l_reg, pa0, pa1, pa2, pa3); SBAR();                                                           \
        if ((t) + 1 < NT) { if constexpr (F32) { VMW(); SWRITE_KF(SB); SBAR(); SLOAD_F((const float*)Vh, KBASE((t) + 1)); }  \
                            else { SLOAD_H(Kh, Vh, Bh, KBASE((t) + 1), SB); } SBAR(); }                                               \
        pv_tile<VB, SK>(o, vb0, pa0, pa1, pa2, pa3, ACT((t) - 1)); MASKT(PX0, PX1, (t)); partialSM(PX0, PX1, m_reg, mnX, alX);                                        \
        __syncthreads();                                                                                                      \
        if ((t) + 1 < NT) { VMW(); if constexpr (F32) { SWRITE_VF(SB); SBAR(); if ((t) + 2 < NT) SLOAD_F((const float*)Kh, KBASE((t) + 2)); } \
                            else { SWRITE_H(SB); } }                                                                          \
        RESC(alX); __syncthreads(); } while (0)
    for (int t = 1; t + 1 < NT; t += 2) {
        HALF_STEP(pB0, pB1, mnB, alB, pA0, pA1, alA, t, 1, 0, 0);
        HALF_STEP(pA0, pA1, mnA, alA, pB0, pB1, alB, t + 1, 0, 1, 1);
    }
    const bool even = (NT & 1) == 0;
    if (even) { SBAR(); qkt<1, SK>(pB0, pB1, K_lds, r32, hi, S.qr, ACT(NT - 1), qx); SBAR(); }
#define QROW(e) (nxt.Q + (size_t)(wid * QBLK + r32) * PITCH + ((e) >> 1) * 16 + hi * 8 + ((e) & 1) * 4)
    if constexpr (F32) { SLOAD_F((const float*)nxt.K, kbn); SBAR();
#pragma unroll
        for (int e = 0; e < 8; ++e) S.tq[e] = *(const f32x4*)QROW(e); }
    else { SLOAD_H(nxt.K, nxt.V, nxt.Bs, kbn, 0); SBAR();
#pragma unroll
        for (int d0 = 0; d0 < 8; ++d0) S.qr[d0] = load8<TIn>(nxt.Q + (size_t)(wid * QBLK + r32) * PITCH + d0 * 16 + hi * 8); }
    SBAR();
    finishSM(pA0, pA1, alA, l_reg, pa0, pa1, pa2, pa3); SBAR();
    if constexpr (F32) {
#pragma unroll
        for (int e = 8; e < 16; ++e) S.tq[e] = *(const f32x4*)QROW(e); SBAR(); }
#undef QROW
    pv_tile<0, SK>(o, vb0, pa0, pa1, pa2, pa3, ACT(even ? NT - 2 : NT - 1));
    if (even) { MASKT(pB0, pB1, NT - 1); partialSM(pB0, pB1, m_reg, mnB, alB); __syncthreads(); RESC(alB);
        finishSM(pB0, pB1, alB, l_reg, pa0, pa1, pa2, pa3); SBAR(); pv_tile<1, SK>(o, vb0, pa0, pa1, pa2, pa3, ACT(NT - 1)); }
    SBAR(); SEAM_K0();
    if (hi == 0) li_l[r32] = l_reg; asm volatile("s_waitcnt lgkmcnt(0)" ::: "memory");
    float rli[16];
#pragma unroll
    for (int r = 0; r < 16; ++r) rli[r] = __builtin_amdgcn_rcpf(li_l[crow(r, hi)]);
    int tidE = tid; asm volatile("" : "+v"(tidE));
    const int widE = __builtin_amdgcn_readfirstlane(tidE >> 6), r32E = tidE & 31, hiE = (tidE >> 5) & 1;
    TOut* Ow = cur.O + (size_t)(widE * QBLK) * PITCH; const bool wval = widE * QBLK < cur.nvalid;
    if (wval) {
#pragma unroll
    for (int r = 0; r < 16; ++r) { const int orow = crow(r, hiE);
#pragma unroll
        for (int d0 = 0; d0 < 4; ++d0) { const float v = o[d0][r] * rli[r];
            if constexpr (same_t<TOut, float>::v) { Ow[(size_t)orow * PITCH + d0 * 32 + r32E] = v; }
            else { const float vn = __shfl_xor(v, 1);
                   if ((r32E & 1) == 0) *(unsigned*)(Ow + (size_t)orow * PITCH + d0 * 32 + r32E) = cvtpk(v, vn); } } } }
    if constexpr (F32) {
#pragma unroll
        for (int d0 = 0; d0 < 8; ++d0) S.qr[d0] = pack8(S.tq[2 * d0], S.tq[2 * d0 + 1]); }
    __syncthreads();
#undef RESC
#undef KBASE
#undef ACT
#undef MASKT
#undef SEAM_K0
#undef HALF_STEP
}
#undef ROW
#undef VMW
#undef VMWN
#undef SLOAD_H
#undef GLDS
#undef SWRITE_HK
#undef SWRITE_HV
#undef SWRITE_H
#undef SLOAD_F
#undef SWRITE_KF
#undef SWRITE_VF

}
#define GAS __attribute__((address_space(1)))
#define LAS __attribute__((address_space(3)))
typedef GAS unsigned gu32;
typedef GAS unsigned long long gu64;
#define RLX_AGENT __ATOMIC_RELAXED, __HIP_MEMORY_SCOPE_AGENT
#define LDS_WAIT() asm volatile("s_waitcnt lgkmcnt(0)" ::: "memory")
#define VM_WAIT() asm volatile("s_waitcnt vmcnt(0)" ::: "memory")
__device__ __forceinline__ unsigned long long rt() { return __builtin_amdgcn_s_memrealtime(); }
#define XB_TMO      128
#define XB_XCNT(j)  (256  + 64 * (j))
#define XB_XSUB(j)  (1280 + 64 * (j))
#define XB_XGEN(j)  (2304 + 64 * (j))
#define XB_TOP      3328
#define XB_TOPGEN   3392
#define XCD_BAR_WORDS 3456
#define XB_SPIN_CAP (1u << 18)

__device__ __forceinline__ unsigned xb_ld(unsigned* p)              { return __hip_atomic_load(p, __ATOMIC_RELAXED, __HIP_MEMORY_SCOPE_AGENT); }
__device__ __forceinline__ unsigned xb_add(unsigned* p, unsigned v) { return __hip_atomic_fetch_add(p, v, __ATOMIC_RELAXED, __HIP_MEMORY_SCOPE_AGENT); }
__device__ __forceinline__ unsigned xb_xcc_id() { return (unsigned)__builtin_amdgcn_s_getreg((3 << 11) | 20) & 0xFu; }
#define XB_SPIN(cond, bar) do { unsigned _sp = 0; while (cond) { __builtin_amdgcn_s_sleep(1); \
    if ((++_sp & 255u) == 0u) { if (xb_ld(&(bar)[XB_TMO])) break; if (_sp > XB_SPIN_CAP) { atomicAdd(&(bar)[XB_TMO], 1u); break; } } } } while (0)

struct XcdBarrier {
    unsigned* bar; unsigned x;
    volatile LAS unsigned* st;
};

__device__ __forceinline__ XcdBarrier xcd_barrier_post(unsigned* bar, volatile LAS unsigned* st) {
    XcdBarrier b; b.bar = bar; b.x = xb_xcc_id(); b.st = st;
    if (threadIdx.x == 0) (void)xb_add(&bar[XB_XCNT(b.x)], 1u);
    return b;
}
__device__ __forceinline__ void xcd_barrier_complete(unsigned* bar, unsigned x, unsigned& nloc, unsigned& nx) {
    const unsigned G = gridDim.x * gridDim.y * gridDim.z;
    unsigned sum, cnt, mine, sp = 0u;
    for (;;) {
        sum = 0u; cnt = 0u; mine = 0u;
#pragma unroll
        for (unsigned j = 0; j < 16; ++j) { const unsigned c = xb_ld(&bar[XB_XCNT(j)]); sum += c; cnt += (c > 0u) ? 1u : 0u; mine = (j == x) ? c : mine; }
        if (sum == G) break;
        __builtin_amdgcn_s_sleep(1);
        if ((++sp & 255u) == 0u) { if (xb_ld(&bar[XB_TMO])) break; if (sp > XB_SPIN_CAP) { atomicAdd(&bar[XB_TMO], 1u); break; } }
    }
    nloc = mine > 0u ? mine : 1u; nx = cnt > 0u ? cnt : 1u;
}

__device__ __forceinline__ void xcd_barrier(const XcdBarrier& b) {
    asm volatile("s_waitcnt vmcnt(0)" ::: "memory");
    __syncthreads();
    if (threadIdx.x == 0) {
        unsigned* bar = b.bar;
        __builtin_amdgcn_s_waitcnt(0);
        unsigned nloc = b.st[0], nx = b.st[1];
        if (nloc == 0u) { xcd_barrier_complete(bar, b.x, nloc, nx); b.st[0] = nloc; b.st[1] = nx; }
        const unsigned old = xb_add(&bar[XB_XSUB(b.x)], 1u);
        const unsigned gen = old / nloc;
        if (old + 1u == (gen + 1u) * nloc) {
            __builtin_amdgcn_fence(__ATOMIC_RELEASE, "agent");
            asm volatile("s_waitcnt vmcnt(0)" ::: "memory");
            const unsigned og = xb_add(&bar[XB_TOP], 1u);
            const unsigned tg = og / nx;
            if (og + 1u == (tg + 1u) * nx) xb_add(&bar[XB_TOPGEN], 1u);
            else XB_SPIN(xb_ld(&bar[XB_TOPGEN]) == tg, bar);
            __builtin_amdgcn_fence(__ATOMIC_ACQUIRE, "agent");
            xb_add(&bar[XB_XGEN(b.x)], 1u);
            asm volatile("s_waitcnt vmcnt(0)" ::: "memory");
        } else {
            XB_SPIN(xb_ld(&bar[XB_XGEN(b.x)]) == gen, bar);
            __builtin_amdgcn_fence(__ATOMIC_ACQUIRE, "agent");
            asm volatile("s_waitcnt vmcnt(0)" ::: "memory");
        }
    }
    __syncthreads();
}

typedef unsigned short u16;
typedef float f32x4 __attribute__((ext_vector_type(4)));
typedef unsigned u32x4 __attribute__((ext_vector_type(4)));
typedef unsigned u32x2 __attribute__((ext_vector_type(2)));
typedef short bf16x8 __attribute__((ext_vector_type(8)));
constexpr int DM = 2048, TP = 8192, NBP = 4, NBS = 8, TS = 64, PAST = 2048, SKVS = PAST + TS;
constexpr int MP = NBP * TP, MS_ = NBS * TS, M = MP + MS_;
constexpr int DI = 4096, CD = 6144, NH = 64, DFF = 5504, DFF2 = 11008, NIN = 20560;
constexpr int NMOD = 12288;
constexpr float EPS = 1e-6f, LOG2E = 1.4426950408889634f;
constexpr int HALF_ROWS = 16640;
constexpr size_t O_YP = 0, O_YS = O_YP + (size_t)MP * DM, O_KP = O_YS + (size_t)MS_ * DM, O_VP = O_KP + (size_t)MP * DM,
    O_LFP = O_VP + (size_t)MP * DM, O_SSMP = O_LFP + (size_t)MP * 16, O_MCP = O_SSMP + (size_t)NBP * 64 * 64 * 128, O_FCP = O_MCP + (size_t)NBP * 3 * CD,
    O_KS = O_FCP + (size_t)NBP * 2 * DFF2, O_VS = O_KS + (size_t)MS_ * DM, O_LFS = O_VS + (size_t)MS_ * DM, O_SSMS = O_LFS + (size_t)MS_ * 16,
    O_MCS = O_SSMS + (size_t)NBS * 64 * 64 * 128, O_FCS = O_MCS + (size_t)NBS * 3 * CD, O_END = O_FCS + (size_t)NBS * 2 * DFF2;
constexpr size_t MiB = 1u << 20;
constexpr size_t W_MOD = 0, W_BAR = 768 * 1024  , W_BIASP = 1 * MiB, W_BIASS = 3 * MiB, W_HALO = 5 * MiB,
    W_WUP = 8 * MiB, W_WDN = 51 * MiB, W_H = 73 * MiB, W_WIN = 203 * MiB, W_WPM = 284 * MiB, W_WPF = 300 * MiB, W_WOUT = 308 * MiB,
    W_SMALL = 316 * MiB, W_R = 349 * MiB,
    W_XBC = W_R, W_Z = W_R + 390 * MiB, W_GM = W_R, W_GF = W_R + 130 * MiB, W_Q = W_R + 260 * MiB, W_K = W_Q + 130 * MiB, W_V = W_K + 130 * MiB,
    W_U = 203 * MiB, W_G = 553 * MiB, W_END = 999 * MiB;
static_assert((size_t)M * DM * 2 == 130 * MiB && (size_t)M * CD * 2 == 390 * MiB && (size_t)M * DI * 2 == 260 * MiB, "sizes");
static_assert(W_U + (size_t)HALF_ROWS * DFF2 * 2 <= W_G && W_G + (size_t)M * DFF * 2 <= 1024 * MiB, "ffn map");
static_assert(W_SMALL + (size_t)M * 256 * 4 <= W_R, "small map");

struct Prm { const float* in[31]; float* out; unsigned char* ws; };
typedef const __attribute__((address_space(4))) Prm* KPrm;
struct Ctx { int tid, bid, G; };
enum { I_XP = 0, I_XS, I_CP, I_CS, I_CK, I_CV, I_CLF, I_SSM, I_MCV, I_FCV, I_N1W, I_N2W, I_WADA, I_BADA, I_WIN, I_MCW, I_MCB, I_DTB, I_ALOG, I_MD, I_MNW,
       I_FB, I_QNW, I_KNW, I_WPM, I_WPF, I_WOUT, I_WUP, I_FCW, I_FCB, I_WDN };

__device__ __forceinline__ float bflo(unsigned w) { return __uint_as_float(w << 16); }
__device__ __forceinline__ float bfhi(unsigned w) { return __uint_as_float(w & 0xffff0000u); }
typedef float f32x2_t __attribute__((ext_vector_type(2))); typedef __bf16 bf16x2_t __attribute__((ext_vector_type(2)));
__device__ __forceinline__ unsigned pk2(float lo, float hi) { f32x2_t v = {lo, hi}; bf16x2_t b = __builtin_convertvector(v, bf16x2_t); return __builtin_bit_cast(unsigned, b); }
__device__ __forceinline__ u16 f2bf(float f) { return (u16)(pk2(f, 0.f) & 0xffffu); }
__device__ __forceinline__ void unpack8(u32x4 w, float* v) { v[0] = bflo(w.x); v[1] = bfhi(w.x); v[2] = bflo(w.y); v[3] = bfhi(w.y); v[4] = bflo(w.z); v[5] = bfhi(w.z); v[6] = bflo(w.w); v[7] = bfhi(w.w); }
__device__ __forceinline__ u32x4 pack8f(const float* v) { u32x4 w; w.x = pk2(v[0], v[1]); w.y = pk2(v[2], v[3]); w.z = pk2(v[4], v[5]); w.w = pk2(v[6], v[7]); return w; }
__device__ __forceinline__ float bfel(const u32x4& w, int e) { const unsigned x = w[e >> 1]; return (e & 1) ? bfhi(x) : bflo(x); }
__device__ __forceinline__ float sigmoidf_(float x) { return 1.f / (1.f + __expf(-x)); }
__device__ __forceinline__ float siluf_(float x) { return x / (1.f + __expf(-x)); }
__device__ __forceinline__ float wave_sum(float v) {
#pragma unroll
    for (int o = 1; o < 64; o <<= 1) v += __shfl_xor(v, o);
    return v;
}
__device__ __forceinline__ int mod_row(int row) { return row < MP ? (row >> 13) : 4 + ((row - MP) >> 6); }

struct Epi {
    static constexpr bool PERM = true, AFTER_DRAIN = false;
    int mode;
    u16* d0; u16* d1; u16* d2; int t1, t2, p0, p1, p2, f32seg2, vseg2; float* vout; u16* vslab;
    const float* xp; const float* xs; float* y; const float* mod; u16* gbuf; const u16* gf;
    __device__ __forceinline__ void operator()(const f32x4 (&acc)[2][2][4][2], const pg8::Unit& u, int wr, int wc, int fr, int fq) const {
        const int rl = u.pm * 256 + u.ho * 128 + wr * 64 + fr, cl = wc * 32 + 8 * fq;
        const int nai = u.half ? 1 : 2;
        if (mode == 0) {
            u16* base; int pitch, ct; bool f32o = false;
            if (u.pn < t1) { base = d0; pitch = p0; ct = u.pn; } else if (u.pn < t2) { base = d1; pitch = p1; ct = u.pn - t1; } else { base = d2; pitch = p2; ct = u.pn - t2; f32o = (f32seg2 != 0); }
            if (!f32o) {
#pragma unroll
                for (int ai = 0; ai < nai; ++ai)
#pragma unroll
                    for (int m = 0; m < 4; ++m) { u16* rp = base + (size_t)(rl + ai * 128 + m * 16) * pitch + ct * 256 + cl;
#pragma unroll
                        for (int bj = 0; bj < 2; ++bj) { const f32x4 v0 = acc[ai][bj][m][0], v1 = acc[ai][bj][m][1]; u32x4 w; w.x = pk2(v0[0], v0[1]); w.y = pk2(v0[2], v0[3]); w.z = pk2(v1[0], v1[1]); w.w = pk2(v1[2], v1[3]);
                            *(u32x4*)(rp + bj * 128) = w; } }
                if (vseg2 && u.pn >= t2) {
#pragma unroll
                    for (int ai = 0; ai < nai; ++ai)
#pragma unroll
                        for (int m = 0; m < 4; ++m) { const int row = rl + ai * 128 + m * 16; const int col = ct * 256 + cl;
                            float* vo = (row < MP) ? vout + (size_t)row * DM + col : vout + (O_VS - O_VP) + (size_t)(row - MP) * DM + col;
#pragma unroll
                            for (int bj = 0; bj < 2; ++bj) { __builtin_nontemporal_store(acc[ai][bj][m][0], (f32x4*)(vo + bj * 128)); __builtin_nontemporal_store(acc[ai][bj][m][1], (f32x4*)(vo + bj * 128 + 4)); }
                            if (row >= MP) { const int sb = (row - MP) >> 6, t = (row - MP) & 63; u16* sp = vslab + (size_t)(sb * SKVS + PAST + t) * DM + col;
#pragma unroll
                                for (int bj = 0; bj < 2; ++bj) { const f32x4 v0 = acc[ai][bj][m][0], v1 = acc[ai][bj][m][1]; u32x4 w; w.x = pk2(v0[0], v0[1]); w.y = pk2(v0[2], v0[3]); w.z = pk2(v1[0], v1[1]); w.w = pk2(v1[2], v1[3]);
                                    *(u32x4*)(sp + bj * 128) = w; } } }
                }
            } else {
                float* fb = (float*)base;
#pragma unroll
                for (int ai = 0; ai < nai; ++ai)
#pragma unroll
                    for (int m = 0; m < 4; ++m) { float* rp = fb + (size_t)(rl + ai * 128 + m * 16) * pitch + ct * 256 + cl;
#pragma unroll
                        for (int bj = 0; bj < 2; ++bj) { *(f32x4*)(rp + bj * 128) = acc[ai][bj][m][0]; *(f32x4*)(rp + bj * 128 + 4) = acc[ai][bj][m][1]; } }
            }
        } else if (mode == 1 || mode == 2) {
#pragma unroll
            for (int ai = 0; ai < nai; ++ai) {
                u32x4 gw[4][2], fw[4][2];
#pragma unroll
                for (int m = 0; m < 4; ++m) { const size_t off = (size_t)(rl + ai * 128 + m * 16) * DM + u.pn * 256 + cl;
#pragma unroll
                    for (int bj = 0; bj < 2; ++bj) { gw[m][bj] = *(const u32x4*)(gbuf + off + bj * 128); if (mode == 2) fw[m][bj] = *(const u32x4*)(gf + off + bj * 128); else fw[m][bj] = gw[m][bj]; } }
#pragma unroll
                for (int m = 0; m < 4; ++m) { const size_t off = (size_t)(rl + ai * 128 + m * 16) * DM + u.pn * 256 + cl;
#pragma unroll
                    for (int bj = 0; bj < 2; ++bj) { const f32x4 v0 = acc[ai][bj][m][0], v1 = acc[ai][bj][m][1];
                        float a[8] = {v0[0], v0[1], v0[2], v0[3], v1[0], v1[1], v1[2], v1[3]}, g[8], o[8];
                        unpack8(gw[m][bj], g);
                        if (mode == 1) {
#pragma unroll
                            for (int e = 0; e < 8; ++e) o[e] = sigmoidf_(g[e]) * a[e];
                        } else { float f[8]; unpack8(fw[m][bj], f);
#pragma unroll
                            for (int e = 0; e < 8; ++e) o[e] = g[e] + sigmoidf_(f[e]) * a[e]; }
                        *(u32x4*)(gbuf + off + bj * 128) = pack8f(o); } }
            }
        } else {
#pragma unroll
            for (int ai = 0; ai < nai; ++ai) {
                const int mb = (u.pm < 128) ? (u.pm >> 5) : (4 + (u.pm - 128) * 4 + u.ho * 2 + ai * 2 + wr);
                const float* gp = mod + (size_t)mb * NMOD + (mode == 3 ? 4096 : 10240) + u.pn * 256 + cl;
                f32x4 gv[2][2], pre[4][2][2];
#pragma unroll
                for (int m = 0; m < 4; ++m) { const int row = rl + ai * 128 + m * 16; const size_t off = (size_t)row * DM + u.pn * 256 + cl;
                    const float* xr = (mode == 3) ? ((row < MP) ? xp + off : xs + (off - (size_t)MP * DM)) : (const float*)(y + off);
#pragma unroll
                    for (int bj = 0; bj < 2; ++bj) { pre[m][bj][0] = *(const f32x4*)(xr + bj * 128); pre[m][bj][1] = *(const f32x4*)(xr + bj * 128 + 4); } }
#pragma unroll
                for (int bj = 0; bj < 2; ++bj) { gv[bj][0] = *(const f32x4*)(gp + bj * 128); gv[bj][1] = *(const f32x4*)(gp + bj * 128 + 4); }
#pragma unroll
                for (int m = 0; m < 4; ++m) { const int row = rl + ai * 128 + m * 16; const size_t off = (size_t)row * DM + u.pn * 256 + cl;
#pragma unroll
                    for (int bj = 0; bj < 2; ++bj) { *(f32x4*)(y + off + bj * 128) = pre[m][bj][0] + gv[bj][0] * acc[ai][bj][m][0]; *(f32x4*)(y + off + bj * 128 + 4) = pre[m][bj][1] + gv[bj][1] * acc[ai][bj][m][1]; } }
            }
        }
    }
};

__device__ __forceinline__ int map_in(int n) {
    if (n < 4096) return 6144 + n;
    if (n < 10240) return n - 4096;
    if (n < 10304) return 10240 + (n - 10240);
    if (n < 12352) return 14592 + (n - 10304);
    if (n < 14400) return 16640 + (n - 12352);
    if (n < 16448) return 18688 + (n - 14400);
    if (n < 16464) return 10304 + (n - 16448);
    if (n < 18512) return 10496 + (n - 16464);
    return 12544 + (n - 18512);
}
__device__ __forceinline__ int map_up(int n) { if (n < DFF) return (n >> 7) * 256 + (n & 127); const int f = n - DFF; return (f >> 7) * 256 + 128 + (f & 127); }
template <int MAP> __device__ __forceinline__ void tr_item(const float* __restrict__ W, int K, int N, u16* WT, float* scr, int item, int lane) {
    const int nblk = (N + 31) / 32, kb = item / nblk, nb = item % nblk, k0 = 64 * kb, n0 = 32 * nb;
    const int nn = n0 + (lane & 31);
    float tv[32];
#pragma unroll
    for (int i = 0; i < 32; ++i) { const int kk = 2 * i + (lane >> 5); tv[i] = (nn < N) ? W[(size_t)(k0 + kk) * N + nn] : 0.f; }
#pragma unroll
    for (int i = 0; i < 32; ++i) { const int kk = 2 * i + (lane >> 5); scr[kk * 33 + (lane & 31)] = tv[i]; }
    asm volatile("s_waitcnt lgkmcnt(0)" ::: "memory");
    const int c = lane & 7;
#pragma unroll
    for (int j = 0; j < 4; ++j) { const int n = (lane >> 3) + 8 * j; const float* s = scr + (8 * c) * 33 + n;
        if (n0 + n < N) { const int row = (MAP == 1) ? map_in(n0 + n) : (MAP == 2) ? map_up(n0 + n) : (n0 + n);
            u32x4 o; o.x = pk2(s[0 * 33], s[1 * 33]); o.y = pk2(s[2 * 33], s[3 * 33]); o.z = pk2(s[4 * 33], s[5 * 33]); o.w = pk2(s[6 * 33], s[7 * 33]);
            *(u32x4*)(WT + (size_t)row * K + k0 + 8 * c) = o; } }
    asm volatile("s_waitcnt lgkmcnt(0)" ::: "memory");
}
__device__ __forceinline__ void phase_prep(KPrm p, const Ctx cx, unsigned char* lds) {
    const int tid = cx.tid, lane = tid & 63, wid = tid >> 6, G = cx.G;
    unsigned char* ws = p->ws;
    {
        float* scr = (float*)(lds + wid * 8448);
        const int gw = cx.bid * 8 + wid, NGW = G * 8;
        constexpr int I_IN = 32 * 643, I_PM = 64 * 64, I_PF = 32 * 64, I_OUT = 32 * 64, I_UP = 32 * 344, I_DN = 86 * 64;
        constexpr int NIT = I_IN + I_PM + I_PF + I_OUT + I_UP + I_DN;
        for (int it = gw; it < NIT; it += NGW) {
            int r = it;
            if (r < I_IN) { tr_item<1>(p->in[I_WIN], DM, NIN, (u16*)(ws + W_WIN), scr, r, lane); continue; } r -= I_IN;
            if (r < I_PM) { tr_item<0>(p->in[I_WPM], DI, DM, (u16*)(ws + W_WPM), scr, r, lane); continue; } r -= I_PM;
            if (r < I_PF) { tr_item<0>(p->in[I_WPF], DM, DM, (u16*)(ws + W_WPF), scr, r, lane); continue; } r -= I_PF;
            if (r < I_OUT) { tr_item<0>(p->in[I_WOUT], DM, DM, (u16*)(ws + W_WOUT), scr, r, lane); continue; } r -= I_OUT;
            if (r < I_UP) { tr_item<2>(p->in[I_WUP], DM, DFF2, (u16*)(ws + W_WUP), scr, r, lane); continue; } r -= I_UP;
            tr_item<0>(p->in[I_WDN], DFF, DM, (u16*)(ws + W_WDN), scr, r, lane);
        }
    }
    __syncthreads();
    {
        float* sl = (float*)lds;
        float* red = (float*)(lds + 12 * 2048 * 4);
        for (int e = tid; e < 12 * 2048; e += 512) { const int b = e >> 11, i = e & 2047; const float cv = (b < 4) ? p->in[I_CP][b * 2048 + i] : p->in[I_CS][(b - 4) * 2048 + i]; sl[e] = siluf_(cv); }
        __syncthreads();
        const float* wada = p->in[I_WADA]; float* mod = (float*)(ws + W_MOD);
        const int col = tid & 31, part = tid >> 5;
        for (int item = cx.bid; item < NMOD / 32; item += G) {
            float acc[12];
#pragma unroll
            for (int b = 0; b < 12; ++b) acc[b] = 0.f;
            const float* wp = wada + (size_t)(part * 128) * NMOD + item * 32 + col;
#pragma unroll 8
            for (int d = 0; d < 128; ++d) { const float w = wp[(size_t)d * NMOD];
#pragma unroll
                for (int b = 0; b < 12; ++b) acc[b] += sl[b * 2048 + part * 128 + d] * w; }
#pragma unroll
            for (int b = 0; b < 12; ++b) red[(part * 12 + b) * 32 + col] = acc[b];
            __syncthreads();
            if (tid < 384) { const int b = tid >> 5; float s = p->in[I_BADA][item * 32 + col];
#pragma unroll
                for (int q = 0; q < 16; ++q) s += red[(q * 12 + b) * 32 + col];
                mod[b * NMOD + item * 32 + col] = s; }
            __syncthreads();
        }
    }
    {
        u16* Ks = (u16*)p->out; u16* Vs = Ks + (size_t)NBS * SKVS * DM;
        const size_t tot8 = (size_t)NBS * PAST * DM / 8, gt = (size_t)cx.bid * 512 + tid, GT = (size_t)G * 512;
        for (size_t i0 = gt; i0 < 2 * tot8; i0 += 4 * GT) {
            f32x4 a[4], b[4]; size_t dsto[4]; bool ok[4]; int wh[4];
#pragma unroll
            for (int u = 0; u < 4; ++u) { const size_t i = i0 + (size_t)u * GT; ok[u] = i < 2 * tot8; const size_t ii = ok[u] ? i : 0; wh[u] = ii >= tot8; const size_t j = ii - (wh[u] ? tot8 : 0);
                const size_t sb = j / ((size_t)PAST * 256), rem = j % ((size_t)PAST * 256), row = rem >> 8, c8 = rem & 255;
                const float* src = p->in[wh[u] ? I_CV : I_CK] + ((sb * PAST + row) * DM + c8 * 8);
                a[u] = *(const f32x4*)src; b[u] = *(const f32x4*)(src + 4); dsto[u] = (sb * SKVS + row) * DM + c8 * 8; }
#pragma unroll
            for (int u = 0; u < 4; ++u) if (ok[u]) { u32x4 o; o.x = pk2(a[u][0], a[u][1]); o.y = pk2(a[u][2], a[u][3]); o.z = pk2(b[u][0], b[u][1]); o.w = pk2(b[u][2], b[u][3]);
                *(u32x4*)((wh[u] ? Vs : Ks) + dsto[u]) = o; }
        }
    }
}
__device__ __forceinline__ void phase_norm(KPrm p, const Ctx cx, int which) {
    const int tid = cx.tid, lane = tid & 63, wid = tid >> 6;
    const int gw = cx.bid * 8 + wid, NGW = cx.G * 8;
    const float* mod = (const float*)(p->ws + W_MOD); u16* H = (u16*)(p->ws + W_H);
    const float* nw = p->in[which ? I_N2W : I_N1W];
    const int osh = which ? 6144 : 0, osc = which ? 8192 : 2048;
    for (int row0 = 2 * gw; row0 < M; row0 += 2 * NGW) {
        f32x4 v[2][8];
#pragma unroll
        for (int rr = 0; rr < 2; ++rr) { const int row = row0 + rr;
            const float* xr = which ? (p->out + (size_t)row * DM) : ((row < MP) ? p->in[I_XP] + (size_t)row * DM : p->in[I_XS] + (size_t)(row - MP) * DM);
#pragma unroll
            for (int j = 0; j < 8; ++j) v[rr][j] = ((const f32x4*)xr)[lane + 64 * j]; }
#pragma unroll
        for (int rr = 0; rr < 2; ++rr) { const int row = row0 + rr;
            const float* mr = mod + (size_t)mod_row(row) * NMOD;
            float ss = 0.f;
#pragma unroll
            for (int j = 0; j < 8; ++j) ss += (v[rr][j][0] * v[rr][j][0] + v[rr][j][1] * v[rr][j][1]) + (v[rr][j][2] * v[rr][j][2] + v[rr][j][3] * v[rr][j][3]);
            const float rs = rsqrtf(wave_sum(ss) * (1.f / DM) + EPS);
#pragma unroll
            for (int j = 0; j < 8; ++j) { const int col = 4 * (lane + 64 * j);
                const f32x4 w = *(const f32x4*)(nw + col), sc = *(const f32x4*)(mr + osc + col), sh = *(const f32x4*)(mr + osh + col);
                const f32x4 o = v[rr][j] * rs * w * (sc + 1.f) + sh;
                u32x2 q; q.x = pk2(o[0], o[1]); q.y = pk2(o[2], o[3]);
                *(u32x2*)(H + (size_t)row * DM + col) = q; } }
    }
}
__device__ __forceinline__ void phase_conv(KPrm p, const Ctx cx) {
    const u16* XBC = (const u16*)(p->ws + W_XBC); u16* ACT = (u16*)(p->out + O_KP);
    const float* cw = p->in[I_MCW]; const float* cb = p->in[I_MCB];
    {
                const int gt2 = cx.bid * 512 + cx.tid, GT2 = cx.G * 512;
        for (int i = gt2; i < 12 * 3 * CD; i += GT2) { const int bb = i / (3 * CD), r = (i / CD) % 3, c = i % CD;
            if (bb < 4) p->out[O_MCP + i] = bflo(XBC[(size_t)(bb * TP + TP - 3 + r) * CD + c]);
            else p->out[O_MCS + (i - 4 * 3 * CD)] = bflo(XBC[(size_t)(MP + (bb - 4) * TS + TS - 3 + r) * CD + c]); }
    }
    constexpr int NCG = CD / 8, RB = 16, NRB = M / RB;
    const long gt = (long)cx.bid * 512 + cx.tid, GT = (long)cx.G * 512;
    for (long it = gt; it < (long)NCG * NRB; it += GT) {
        const int cgi = (int)(it % NCG), rb = (int)(it / NCG), c0 = cgi * 8, r0 = rb * RB;
        float w[4][8], bs[8];
#pragma unroll
        for (int j = 0; j < 4; ++j) { const f32x4 a0 = *(const f32x4*)(cw + j * CD + c0), a1 = *(const f32x4*)(cw + j * CD + c0 + 4);
#pragma unroll
            for (int e = 0; e < 4; ++e) { w[j][e] = a0[e]; w[j][4 + e] = a1[e]; } }
        { const f32x4 a0 = *(const f32x4*)(cb + c0), a1 = *(const f32x4*)(cb + c0 + 4);
#pragma unroll
          for (int e = 0; e < 4; ++e) { bs[e] = a0[e]; bs[4 + e] = a1[e]; } }
        float h[3][8];
        const bool smp = r0 >= MP; const int tb = smp ? ((r0 - MP) & 63) : (r0 & (TP - 1));
        if (tb == 0) {
            if (smp) { const float* s = p->in[I_MCV] + (size_t)((r0 - MP) >> 6) * 3 * CD + c0;
#pragma unroll
                for (int k = 0; k < 3; ++k)
#pragma unroll
                    for (int e = 0; e < 8; ++e) h[k][e] = s[k * CD + e];
            } else {
#pragma unroll
                for (int k = 0; k < 3; ++k)
#pragma unroll
                    for (int e = 0; e < 8; ++e) h[k][e] = 0.f; }
        } else {
#pragma unroll
            for (int k = 0; k < 3; ++k) unpack8(*(const u32x4*)(XBC + (size_t)(r0 - 3 + k) * CD + c0), h[k]);
        }
        u32x4 ur[RB];
#pragma unroll
        for (int i = 0; i < RB; ++i) ur[i] = *(const u32x4*)(XBC + (size_t)(r0 + i) * CD + c0);
#pragma unroll
        for (int i = 0; i < RB; ++i) { float u[8], o[8]; unpack8(ur[i], u);
#pragma unroll
            for (int e = 0; e < 8; ++e) { const float v = bs[e] + w[0][e] * h[0][e] + w[1][e] * h[1][e] + w[2][e] * h[2][e] + w[3][e] * u[e];
                o[e] = siluf_(v); h[0][e] = h[1][e]; h[1][e] = h[2][e]; h[2][e] = u[e]; }
            *(u32x4*)(ACT + (size_t)(r0 + i) * CD + c0) = pack8f(o); }
    }
}
constexpr int SXP = 72, SNP = 136, SYP = 68;
constexpr int L_XT = 0, L_CN = L_XT + 64 * SXP * 2, L_BN = L_CN + 64 * SNP * 2, L_BWT = L_BN + 64 * SNP * 2, L_MS = L_BWT + 128 * SXP * 2, L_HS = L_MS + 64 * SXP * 2,
              L_YS = L_HS + 64 * SNP * 2, L_DT = L_YS + 64 * SYP * 4, L_CUM = L_DT + 256, L_SSD_END = L_CUM + 256;
static_assert(L_SSD_END <= 131072, "ssd lds");
__device__ __forceinline__ void phase_ssd(KPrm p, const Ctx cx, unsigned char* lds) {
    const int tid = cx.tid, lane = tid & 63, wid = __builtin_amdgcn_readfirstlane(tid >> 6), quad = lane >> 4, l15 = lane & 15;
    u16* XT = (u16*)(lds + L_XT); u16* CN = (u16*)(lds + L_CN); u16* BN = (u16*)(lds + L_BN); u16* BWT = (u16*)(lds + L_BWT);
    u16* MSm = (u16*)(lds + L_MS); u16* HS = (u16*)(lds + L_HS); float* YS = (float*)(lds + L_YS); float* DT = (float*)(lds + L_DT); float* CUM = (float*)(lds + L_CUM);
    const u16* XBC = (const u16*)(p->out + O_KP);     u16* Z = (u16*)(p->ws + W_Z); const float* SM = (const float*)(p->ws + W_SMALL);
    const int cg8 = tid & 31, tq = tid >> 5, cgx = tid & 7, tx = tid >> 3;
    const int pb = wid >> 1;
    for (int ch = cx.bid; ch < 256 + 512; ch += cx.G) {
        const bool smp = ch >= 256; int b, hd, nc; long rowbase;
        if (!smp) { b = ch >> 6; hd = ch & 63; nc = TP / 64; rowbase = (long)b * TP; } else { const int su = ch - 256; b = su >> 6; hd = su & 63; nc = 1; rowbase = MP + (long)b * TS; }
        const int g = hd >> 3;
        const float a_h = -__expf(p->in[I_ALOG][hd]), dtb = p->in[I_DTB][hd], Dh = p->in[I_MD][hd];
        const int bccol = (cg8 < 16) ? (4096 + g * 128 + cg8 * 8) : (5120 + g * 128 + (cg8 - 16) * 8);
        const int xcol = hd * 64 + cgx * 8;
        f32x4 st[4];
        const int st_off = (pb * 16 + quad * 4) * 128 + (4 * (wid & 1)) * 16 + l15, hs_off = (pb * 16 + quad * 4) * SNP + (4 * (wid & 1)) * 16 + l15;
        { const float* sin_ = p->in[I_SSM] + ((size_t)b * 64 + hd) * 64 * 128 + st_off;
#pragma unroll
          for (int i = 0; i < 4; ++i)
#pragma unroll
            for (int j = 0; j < 4; ++j) st[i][j] = smp ? sin_[j * 128 + i * 16] : 0.f; }
        __syncthreads();
        { u16* hp_ = HS + hs_off;
#pragma unroll
          for (int i = 0; i < 4; ++i)
#pragma unroll
            for (int j = 0; j < 4; ++j) hp_[j * SNP + i * 16] = f2bf(st[i][j]); }
        u32x4 rbcA[4], rxA, znA, rbcB[4], rxB, znB, pend = {0u, 0u, 0u, 0u}; float dtrA = 0.f, dtrB = 0.f;
#define SSD_LOADS(cc, rbc, rx, zn, dtr) do { const int t0_ = (cc) * 64; \
            const u16* pb_ = XBC + (rowbase + t0_ + 4 * tq) * (long)CD + bccol; const u16* px_ = XBC + (rowbase + t0_ + tx) * (long)CD + xcol; \
            asm volatile("" : "+v"(pb_), "+v"(px_));     \
            _Pragma("unroll") for (int i = 0; i < 4; ++i) rbc[i] = *(const u32x4*)(pb_ + i * CD); \
            rx = *(const u32x4*)px_; \
            zn = *(const u32x4*)(Z + (size_t)(rowbase + t0_ + tx) * DI + xcol); \
            dtr = SM[(size_t)(rowbase + t0_ + lane) * 256 + hd]; } while (0)
#define LBAR() do { asm volatile("s_waitcnt lgkmcnt(0)" ::: "memory"); __builtin_amdgcn_s_barrier(); asm volatile("" ::: "memory"); } while (0)
        SSD_LOADS(0, rbcA, rxA, znA, dtrA); if (nc > 1) SSD_LOADS(1, rbcB, rxB, znB, dtrB);
        auto body = [&](const int c, u32x4 (&rbc)[4], u32x4& rx, u32x4& zn, float& dtr) __attribute__((always_inline)) {
            const long r0 = rowbase + (long)c * 64;
            const u32x4 zw = zn;
            float cum_end;
            { const float dr = dtr + dtb; const float dtv = dr > 20.f ? dr : __logf(1.f + __expf(dr));
              float x = dtv * a_h;
#define DPP_ADD(ctrl, rmask) x += __int_as_float(__builtin_amdgcn_update_dpp(0, __float_as_int(x), ctrl, rmask, 0xf, true))
              DPP_ADD(0x111, 0xf); DPP_ADD(0x112, 0xf); DPP_ADD(0x114, 0xf); DPP_ADD(0x118, 0xf);
              DPP_ADD(0x142, 0xa);
              DPP_ADD(0x143, 0xc);
#undef DPP_ADD
              DT[lane] = dtv; CUM[lane] = x; cum_end = __int_as_float(__builtin_amdgcn_readlane(__float_as_int(x), 63)); }
            {
                u16* NAT = (cg8 < 16) ? BN : CN; const int nc0 = (cg8 & 15) * 8;
#pragma unroll
                for (int ii = 0; ii < 4; ++ii) *(u32x4*)(NAT + (4 * tq + ii) * SNP + nc0) = rbc[ii];
                if (cg8 < 16) {
                    float wg[4]; const f32x4 dt4 = *(const f32x4*)(DT + 4 * tq), cu4 = *(const f32x4*)(CUM + 4 * tq);
#pragma unroll
                    for (int ii = 0; ii < 4; ++ii) wg[ii] = dt4[ii] * __expf(cum_end - cu4[ii]);
#pragma unroll
                    for (int e = 0; e < 8; ++e) { u32x2 q; q.x = pk2(bfel(rbc[0], e) * wg[0], bfel(rbc[1], e) * wg[1]); q.y = pk2(bfel(rbc[2], e) * wg[2], bfel(rbc[3], e) * wg[3]);
                        *(u32x2*)(BWT + (nc0 + e) * SXP + 4 * tq) = q; }
                }
            }
            float xv[8]; unpack8(rx, xv);
#pragma unroll
            for (int e = 0; e < 8; ++e) XT[(cgx * 8 + e) * SXP + tx] = (u16)((e & 1) ? (rx[e >> 1] >> 16) : (rx[e >> 1] & 0xffffu));
            LBAR();
            if (c > 0) *(u32x4*)(Z + (size_t)(r0 - 64 + tx) * DI + xcol) = pend;
            if (c + 2 < nc) SSD_LOADS(c + 2, rbc, rx, zn, dtr);
            const int ti = wid >> 1;
            f32x4 yo[2];
            {
                bf16x8 ca[4], bb[2][4], hb[2][4];
#pragma unroll
                for (int kk = 0; kk < 4; ++kk) ca[kk] = *(const bf16x8*)(CN + (ti * 16 + l15) * SNP + kk * 32 + quad * 8);
#pragma unroll
                for (int s2 = 0; s2 < 2; ++s2)
#pragma unroll
                    for (int kk = 0; kk < 4; ++kk) { bb[s2][kk] = *(const bf16x8*)(BN + ((2 * (wid & 1) + s2) * 16 + l15) * SNP + kk * 32 + quad * 8);
                        hb[s2][kk] = *(const bf16x8*)(HS + ((2 * (wid & 1) + s2) * 16 + l15) * SNP + kk * 32 + quad * 8); }
                const f32x4 ct4 = *(const f32x4*)(CUM + ti * 16 + quad * 4);
                float cs[2], ds[2];
#pragma unroll
                for (int s2 = 0; s2 < 2; ++s2) { const int sx = (2 * (wid & 1) + s2) * 16 + l15; cs[s2] = CUM[sx]; ds[s2] = DT[sx]; }
                f32x4 ga[2] = {{0.f, 0.f, 0.f, 0.f}, {0.f, 0.f, 0.f, 0.f}}; yo[0] = (f32x4){0.f, 0.f, 0.f, 0.f}; yo[1] = (f32x4){0.f, 0.f, 0.f, 0.f};
#pragma unroll
                for (int kk = 0; kk < 4; ++kk) {
                    ga[0] = __builtin_amdgcn_mfma_f32_16x16x32_bf16(ca[kk], bb[0][kk], ga[0], 0, 0, 0); ga[1] = __builtin_amdgcn_mfma_f32_16x16x32_bf16(ca[kk], bb[1][kk], ga[1], 0, 0, 0);
                    yo[0] = __builtin_amdgcn_mfma_f32_16x16x32_bf16(ca[kk], hb[0][kk], yo[0], 0, 0, 0); yo[1] = __builtin_amdgcn_mfma_f32_16x16x32_bf16(ca[kk], hb[1][kk], yo[1], 0, 0, 0); }
#pragma unroll
                for (int s2 = 0; s2 < 2; ++s2) { const int s_ = (2 * (wid & 1) + s2) * 16 + l15;
#pragma unroll
                    for (int j = 0; j < 4; ++j) { const int t = ti * 16 + quad * 4 + j; const float msk = (s_ <= t) ? ds[s2] : 0.f;
                        const float val = ga[s2][j] * __expf(fminf(ct4[j] - cs[s2], 0.f)) * msk; MSm[t * SXP + s_] = f2bf(val); } }
#pragma unroll
                for (int p2 = 0; p2 < 2; ++p2)
#pragma unroll
                    for (int j = 0; j < 4; ++j) yo[p2][j] *= __expf(ct4[j]);
            }
            LBAR();
            {
                bf16x8 ma[2], xa[2], xb[2][2], wb[4][2];
#pragma unroll
                for (int kk = 0; kk < 2; ++kk) { ma[kk] = *(const bf16x8*)(MSm + (ti * 16 + l15) * SXP + kk * 32 + quad * 8); xa[kk] = *(const bf16x8*)(XT + (pb * 16 + l15) * SXP + kk * 32 + quad * 8);
#pragma unroll
                    for (int p2 = 0; p2 < 2; ++p2) xb[p2][kk] = *(const bf16x8*)(XT + ((2 * (wid & 1) + p2) * 16 + l15) * SXP + kk * 32 + quad * 8);
#pragma unroll
                    for (int i = 0; i < 4; ++i) wb[i][kk] = *(const bf16x8*)(BWT + ((4 * (wid & 1) + i) * 16 + l15) * SXP + kk * 32 + quad * 8); }
                const float dec = __expf(cum_end);
#pragma unroll
                for (int i = 0; i < 4; ++i) st[i] = st[i] * dec;
#pragma unroll
                for (int kk = 0; kk < 2; ++kk) {
                    yo[0] = __builtin_amdgcn_mfma_f32_16x16x32_bf16(ma[kk], xb[0][kk], yo[0], 0, 0, 0); yo[1] = __builtin_amdgcn_mfma_f32_16x16x32_bf16(ma[kk], xb[1][kk], yo[1], 0, 0, 0);
#pragma unroll
                    for (int i = 0; i < 4; ++i) st[i] = __builtin_amdgcn_mfma_f32_16x16x32_bf16(xa[kk], wb[i][kk], st[i], 0, 0, 0); }
#pragma unroll
                for (int p2 = 0; p2 < 2; ++p2)
#pragma unroll
                    for (int j = 0; j < 4; ++j) YS[(ti * 16 + quad * 4 + j) * SYP + (2 * (wid & 1) + p2) * 16 + l15] = yo[p2][j];
                u16* hp_ = HS + hs_off;
#pragma unroll
                for (int i = 0; i < 4; ++i)
#pragma unroll
                    for (int j = 0; j < 4; ++j) hp_[j * SNP + i * 16] = f2bf(st[i][j]);
            }
            LBAR();
            {
                const f32x4 y0 = *(const f32x4*)(YS + tx * SYP + cgx * 8), y1 = *(const f32x4*)(YS + tx * SYP + cgx * 8 + 4);
                float zf[8], o[8]; unpack8(zw, zf);
#pragma unroll
                for (int e = 0; e < 8; ++e) { const float yv = (e < 4 ? y0[e & 3] : y1[e & 3]) + Dh * xv[e]; o[e] = yv * siluf_(zf[e]); }
                pend = pack8f(o);
            }
        };
        for (int c = 0; c < nc; c += 2) { body(c, rbcA, rxA, znA, dtrA); if (c + 1 < nc) body(c + 1, rbcB, rxB, znB, dtrB); }
        *(u32x4*)(Z + (size_t)(rowbase + (long)(nc - 1) * 64 + tx) * DI + xcol) = pend;
#undef SSD_LOADS
#undef LBAR
        float* so = p->out + (smp ? O_SSMS : O_SSMP) + ((size_t)b * 64 + hd) * 64 * 128 + st_off;
#pragma unroll
        for (int i = 0; i < 4; ++i)
#pragma unroll
            for (int j = 0; j < 4; ++j) so[j * 128 + i * 16] = st[i][j];
        __syncthreads();
    }
}
__device__ __forceinline__ float logsig_(float f) { return fminf(f, 0.f) - log1pf(__expf(-fabsf(f))); }
__device__ __forceinline__ void phase_gn(KPrm p, const Ctx cx) {
    const int tid = cx.tid, lane = tid & 63, wid = tid >> 6;
    const int gw = cx.bid * 8 + wid, NGW = cx.G * 8;
    const float* SM = (const float*)(p->ws + W_SMALL);
    if (gw < 192) {
        if (gw < 64) { const int b = gw >> 4, h = gw & 15; const float fb = p->in[I_FB][h];
            float* bias = (float*)(p->ws + W_BIASP) + (size_t)(b * 16 + h) * TP; float* lo = p->out + O_LFP;
            const int tb = lane * 128; float s = 0.f;
            for (int i = 0; i < 128; ++i) s += logsig_(SM[(size_t)(b * TP + tb + i) * 256 + 64 + h] + fb);
            float inc = s;
#pragma unroll
            for (int o = 1; o < 64; o <<= 1) { const float y = __shfl_up(inc, o); if (lane >= o) inc += y; }
            float run = inc - s;
            for (int i = 0; i < 128; ++i) { const float lf = logsig_(SM[(size_t)(b * TP + tb + i) * 256 + 64 + h] + fb); run += lf;
                lo[(size_t)(b * TP + tb + i) * 16 + h] = lf; bias[tb + i] = -run * LOG2E; }
        } else { const int u = gw - 64, sb = u >> 4, h = u & 15; const float fb = p->in[I_FB][h];
            float* bias = (float*)(p->ws + W_BIASS) + (size_t)(sb * 16 + h) * SKVS; float* lo = p->out + O_LFS;
            const int tb = lane * 33; float s = 0.f;
            for (int i = 0; i < 33; ++i) { const int pos = tb + i;
                s += (pos < PAST) ? p->in[I_CLF][(size_t)(sb * PAST + pos) * 16 + h] : logsig_(SM[(size_t)(MP + sb * TS + pos - PAST) * 256 + 64 + h] + fb); }
            float inc = s;
#pragma unroll
            for (int o = 1; o < 64; o <<= 1) { const float y = __shfl_up(inc, o); if (lane >= o) inc += y; }
            float run = inc - s;
            for (int i = 0; i < 33; ++i) { const int pos = tb + i; float lf;
                if (pos < PAST) lf = p->in[I_CLF][(size_t)(sb * PAST + pos) * 16 + h];
                else { lf = logsig_(SM[(size_t)(MP + sb * TS + pos - PAST) * 256 + 64 + h] + fb); lo[(size_t)(sb * TS + pos - PAST) * 16 + h] = lf; }
                run += lf; bias[pos] = -run * LOG2E; }
        }
    }
    u16* Z = (u16*)(p->ws + W_Z); const float* mnw = p->in[I_MNW];
    for (int row = gw; row < M; row += NGW) {
        u32x4 zr[8];
#pragma unroll
        for (int i = 0; i < 8; ++i) zr[i] = *(const u32x4*)(Z + (size_t)row * DI + i * 512 + lane * 8);
#pragma unroll
        for (int i = 0; i < 8; ++i) { const int col = i * 512 + lane * 8; u16* zp = Z + (size_t)row * DI + col;
            float v[8]; unpack8(zr[i], v); float ss = 0.f;
#pragma unroll
            for (int e = 0; e < 8; ++e) ss += v[e] * v[e];
            const float rs = rsqrtf(wave_sum(ss) * (1.f / 512.f) + EPS);
            const f32x4 w0 = *(const f32x4*)(mnw + col), w1 = *(const f32x4*)(mnw + col + 4);
#pragma unroll
            for (int e = 0; e < 8; ++e) v[e] = v[e] * rs * (e < 4 ? w0[e & 3] : w1[e & 3]);
            *(u32x4*)zp = pack8f(v); }
    }
}
__device__ __forceinline__ void phase_qk(KPrm p, const Ctx cx) {
    const int tid = cx.tid, lane = tid & 63, wid = tid >> 6;
    const int gw = cx.bid * 8 + wid, NGW = cx.G * 8;
    u16* K = (u16*)(p->ws + W_K);
    u16* Ks = (u16*)p->out;
    const int hc = (lane & 15) * 8;
    const f32x4 kw0 = *(const f32x4*)(p->in[I_KNW] + hc), kw1 = *(const f32x4*)(p->in[I_KNW] + hc + 4);
    for (int row = gw; row < M; row += NGW) {
        const bool smp = row >= MP;
        float* ko = smp ? p->out + O_KS + (size_t)(row - MP) * DM : p->out + O_KP + (size_t)row * DM;
        size_t srow = 0; if (smp) { const int sb = (row - MP) >> 6, t = (row - MP) & 63; srow = (size_t)(sb * SKVS + PAST + t) * DM; }
        u32x4 kr_[4];
#pragma unroll
        for (int it = 0; it < 4; ++it) { const size_t off = (size_t)row * DM + it * 512 + lane * 8; kr_[it] = *(const u32x4*)(K + off); }
#pragma unroll
        for (int it = 0; it < 4; ++it) { const int col = it * 512 + lane * 8; const size_t off = (size_t)row * DM + col;
            float v[8], ss;
            unpack8(kr_[it], v); ss = 0.f;
#pragma unroll
            for (int e = 0; e < 8; ++e) ss += v[e] * v[e];
            ss += __shfl_xor(ss, 1); ss += __shfl_xor(ss, 2); ss += __shfl_xor(ss, 4); ss += __shfl_xor(ss, 8);
            const float rs = rsqrtf(ss * (1.f / 128.f) + EPS);
#pragma unroll
            for (int e = 0; e < 8; ++e) v[e] = v[e] * rs * (e < 4 ? kw0[e & 3] : kw1[e & 3]);
            const u32x4 kp = pack8f(v);
            *(u32x4*)(K + off) = kp;
            __builtin_nontemporal_store((f32x4){v[0], v[1], v[2], v[3]}, (f32x4*)(ko + col)); __builtin_nontemporal_store((f32x4){v[4], v[5], v[6], v[7]}, (f32x4*)(ko + col + 4));
            if (smp) *(u32x4*)(Ks + srow + col) = kp; }
    }
}
typedef att::BlockRef<att::bf16, att::bf16> ARef;
__device__ __forceinline__ ARef att_ref(KPrm p, const Ctx cx, int i, int nbp, int& skv) {
    const int G = cx.G, bid = (cx.G % 8 == 0) ? (cx.bid % 8) * (cx.G / 8) + cx.bid / 8 : cx.bid; ARef r;
    att::bf16* Qb = (att::bf16*)(p->ws + W_Q); const att::bf16* Kb = (const att::bf16*)(p->ws + W_K); const att::bf16* Vb = (const att::bf16*)(p->ws + W_V);
    if (i < nbp) { const int L = bid + (i >> 1) * G, bh = L >> 4, x = L & 15, b = bh >> 4, h = bh & 15;
        int qb; if (G == 256) { qb = (x < 8) ? ((i & 1) ? 30 - 2 * x : 2 * x) : ((i & 1) ? 31 - 2 * (x - 8) : 2 * (x - 8) + 1); }
        else qb = (i & 1) ? 31 - x : x;
        const size_t rq = ((size_t)b * TP + (size_t)qb * 256) * DM + h * 128, rk = (size_t)b * TP * DM + h * 128;
        r.Q = Qb + rq; r.O = Qb + rq; r.K = Kb + rk; r.V = Vb + rk; r.Bs = (const float*)(p->ws + W_BIASP) + (size_t)bh * TP; r.P0 = qb * 256; r.nvalid = 256; skv = TP;
    } else { const int su = (G == 256) ? ((bid >> 4) * 8 + (bid & 15)) : bid + (i - nbp) * G, sb = su >> 4, h = su & 15;
        const att::bf16* Ks = (const att::bf16*)p->out; const att::bf16* Vs = Ks + (size_t)NBS * SKVS * DM;
        const size_t rq = ((size_t)MP + (size_t)sb * TS) * DM + h * 128, rk = (size_t)sb * SKVS * DM + h * 128;
        r.Q = Qb + rq; r.O = Qb + rq; r.K = Ks + rk; r.V = Vs + rk; r.Bs = (const float*)(p->ws + W_BIASS) + (size_t)su * SKVS; r.P0 = PAST; r.nvalid = TS; skv = SKVS; }
    return r;
}
__device__ __forceinline__ void phase_att(KPrm p, const Ctx cx, char* lds) {
    const int G = cx.G, bid = (cx.G % 8 == 0) ? (cx.bid % 8) * (cx.G / 8) + cx.bid / 8 : cx.bid;
    const int nip = (bid < 1024) ? (1024 - bid + G - 1) / G : 0, nbp = 2 * nip, nbs = (G == 256) ? (((bid & 15) < 8) ? 1 : 0) : ((bid < 128) ? (128 - bid + G - 1) / G : 0), nb = nbp + nbs;
    if (nb == 0) return;
    const int W = 1 << 30;
    int skv, skvn; ARef cur = att_ref(p, cx, 0, nbp, skv);
    att::Seam<att::bf16> S;
    att::causal_swa_prime<att::bf16, att::bf16>(cur, W, lds, S, cx.tid);
    for (int i = 0; i < nb; ++i) {
        const bool last = (i + 1 == nb);
        ARef nxt = cur; skvn = skv; if (!last) nxt = att_ref(p, cx, i + 1, nbp, skvn);
        att::causal_swa_block<att::bf16, att::bf16>(cur, nxt, skv, W, lds, S, cx.tid, p->in[I_QNW], 0.08838834764831845f * LOG2E);
        cur = nxt; skv = skvn;
    }
}
__device__ __forceinline__ void phase_cv(KPrm p, const Ctx cx, int half) {
    const int tid = cx.tid;
    const u16* U = (const u16*)(p->ws + W_U); u16* Gb = (u16*)(p->ws + W_G); u16* HALO = (u16*)(p->ws + W_HALO);
    const float* cw = p->in[I_FCW]; const float* cb = p->in[I_FCB];
    const int row_lo = half ? HALF_ROWS : 0;
    constexpr int NCG = DFF / 8, RB = 16, NRB = HALF_ROWS / RB;
    const long gt = (long)cx.bid * 512 + tid, GT = (long)cx.G * 512;
    for (long it = gt; it < (long)NCG * NRB; it += GT) {
        const int cgi = (int)(it % NCG), rb = (int)(it / NCG); const int f0 = cgi * 8, r0 = row_lo + rb * RB;
        const int ca = (f0 >> 7) * 256 + (f0 & 127), cbb = ca + 128;
        float wa[3][8], wb[3][8], ba[8], bb[8];
#pragma unroll
        for (int k = 0; k < 3; ++k) { const f32x4 a0 = *(const f32x4*)(cw + k * DFF2 + f0), a1 = *(const f32x4*)(cw + k * DFF2 + f0 + 4), b0 = *(const f32x4*)(cw + k * DFF2 + DFF + f0), b1 = *(const f32x4*)(cw + k * DFF2 + DFF + f0 + 4);
#pragma unroll
            for (int e = 0; e < 4; ++e) { wa[k][e] = a0[e]; wa[k][4 + e] = a1[e]; wb[k][e] = b0[e]; wb[k][4 + e] = b1[e]; } }
        { const f32x4 a0 = *(const f32x4*)(cb + f0), a1 = *(const f32x4*)(cb + f0 + 4), b0 = *(const f32x4*)(cb + DFF + f0), b1 = *(const f32x4*)(cb + DFF + f0 + 4);
#pragma unroll
          for (int e = 0; e < 4; ++e) { ba[e] = a0[e]; ba[4 + e] = a1[e]; bb[e] = b0[e]; bb[4 + e] = b1[e]; } }
        float ha[2][8], hb[2][8];
        const bool smp = r0 >= MP; const int tb = smp ? ((r0 - MP) & 63) : (r0 & (TP - 1));
        if (tb == 0) {
            if (smp) { const float* s = p->in[I_FCV] + (size_t)((r0 - MP) >> 6) * 2 * DFF2;
#pragma unroll
                for (int k = 0; k < 2; ++k)
#pragma unroll
                    for (int e = 0; e < 8; ++e) { ha[k][e] = s[k * DFF2 + f0 + e]; hb[k][e] = s[k * DFF2 + DFF + f0 + e]; }
            } else {
#pragma unroll
                for (int k = 0; k < 2; ++k)
#pragma unroll
                    for (int e = 0; e < 8; ++e) { ha[k][e] = 0.f; hb[k][e] = 0.f; } }
        } else if (half && rb == 0) {
#pragma unroll
            for (int k = 0; k < 2; ++k) { unpack8(*(const u32x4*)(HALO + (size_t)k * DFF2 + ca), ha[k]); unpack8(*(const u32x4*)(HALO + (size_t)k * DFF2 + cbb), hb[k]); }
        } else {
#pragma unroll
            for (int k = 0; k < 2; ++k) { const size_t ro = (size_t)(r0 - row_lo - 2 + k) * DFF2; unpack8(*(const u32x4*)(U + ro + ca), ha[k]); unpack8(*(const u32x4*)(U + ro + cbb), hb[k]); }
        }
#pragma unroll 8
        for (int i = 0; i < RB; ++i) { const int r = r0 + i; const size_t ro = (size_t)(r - row_lo) * DFF2;
            const u32x4 uaw = *(const u32x4*)(U + ro + ca), ubw = *(const u32x4*)(U + ro + cbb);
            float ua[8], ub[8], o[8]; unpack8(uaw, ua); unpack8(ubw, ub);
#pragma unroll
            for (int e = 0; e < 8; ++e) { const float va = ba[e] + wa[0][e] * ha[0][e] + wa[1][e] * ha[1][e] + wa[2][e] * ua[e], vb = bb[e] + wb[0][e] * hb[0][e] + wb[1][e] * hb[1][e] + wb[2][e] * ub[e];
                o[e] = siluf_(va) * vb; ha[0][e] = ha[1][e]; ha[1][e] = ua[e]; hb[0][e] = hb[1][e]; hb[1][e] = ub[e]; }
            *(u32x4*)(Gb + (size_t)r * DFF + f0) = pack8f(o);
            const int tpos = (r >= MP) ? ((r - MP) & 63) : (r & (TP - 1)), tlen = (r >= MP) ? TS : TP;
            if (tpos >= tlen - 2) { float* fo = (r >= MP) ? p->out + O_FCS + ((size_t)((r - MP) >> 6) * 2 + (tpos - (tlen - 2))) * DFF2 : p->out + O_FCP + ((size_t)(r >> 13) * 2 + (tpos - (tlen - 2))) * DFF2;
#pragma unroll
                for (int e = 0; e < 8; ++e) { fo[f0 + e] = ua[e]; fo[DFF + f0 + e] = ub[e]; } }
            if (!half && r >= HALF_ROWS - 2) { *(u32x4*)(HALO + (size_t)(r - (HALF_ROWS - 2)) * DFF2 + ca) = uaw; *(u32x4*)(HALO + (size_t)(r - (HALF_ROWS - 2)) * DFF2 + cbb) = ubw; }
        }
    }
}
constexpr int LDS_TOTAL = 147456;
enum { PH_CONV = 100 };
enum { PH_PREP = 0, PH_N1, PH_G1A, PH_SSD, PH_GN, PH_G1B, PH_G2, PH_G1C, PH_QK, PH_ATT, PH_G3, PH_G4, PH_N2, PH_G5A, PH_CVA, PH_G5B, PH_CVB, PH_G6, PH_COUNT };
__device__ __forceinline__ void gsync(unsigned char* lds) {
    KPrm p0 = (KPrm)__builtin_amdgcn_kernarg_segment_ptr(); asm volatile("" : "+s"(p0));
    XcdBarrier xb; xb.bar = (unsigned*)(p0->ws + W_BAR); xb.x = xb_xcc_id(); xb.st = (volatile LAS unsigned*)(lds + LDS_TOTAL - 64);
    xcd_barrier(xb);
}
#ifndef WGM_OF
#define WGM_OF(N) ((N) == 2048 ? 8 : 4)
#endif
__device__ __forceinline__ void run_gemms(KPrm p, const Ctx cx, unsigned char* lds, const int first, const int last) {
#pragma unroll 1
    for (int ph = first; ph <= last; ++ph) {
        unsigned char* ws = p->ws;
        pg8::Gemm g; Epi E;
        g.A = (const u16*)(ws + W_H); g.Bt = nullptr; g.M = M; g.N = DM; g.K = DM;
        E.mode = 0; E.d0 = E.d1 = E.d2 = nullptr; E.t1 = E.t2 = 1 << 20; E.p0 = E.p1 = E.p2 = 0; E.f32seg2 = 0; E.vseg2 = 0; E.vout = p->out + O_VP; E.vslab = (u16*)p->out + (size_t)NBS * SKVS * DM;
        E.xp = p->in[I_XP]; E.xs = p->in[I_XS]; E.y = p->out; E.mod = (const float*)(ws + W_MOD); E.gbuf = (u16*)(ws + W_GM); E.gf = (const u16*)(ws + W_GF);
        switch (ph) {
        case PH_G1A: g.Bt = (const u16*)(ws + W_WIN); g.N = 41 * 256;
            E.d0 = (u16*)(ws + W_XBC); E.p0 = CD; E.t1 = 24; E.d1 = (u16*)(ws + W_Z); E.p1 = DI; E.t2 = 40; E.d2 = (u16*)(ws + W_SMALL); E.p2 = 256; E.f32seg2 = 1; break;
        case PH_G1B: g.Bt = (const u16*)(ws + W_WIN) + (size_t)10496 * DM; g.N = 16 * 256;
            E.d0 = (u16*)(ws + W_GM); E.p0 = DM; E.t1 = 8; E.d1 = (u16*)(ws + W_GF); E.p1 = DM; break;
        case PH_G2: g.A = (const u16*)(ws + W_Z); g.Bt = (const u16*)(ws + W_WPM); g.K = DI; E.mode = 1; break;
        case PH_G1C: g.Bt = (const u16*)(ws + W_WIN) + (size_t)14592 * DM; g.N = 24 * 256;
            E.d0 = (u16*)(ws + W_Q); E.p0 = DM; E.t1 = 8; E.d1 = (u16*)(ws + W_K); E.p1 = DM; E.t2 = 16; E.d2 = (u16*)(ws + W_V); E.p2 = DM; E.vseg2 = 1; break;
        case PH_G3: g.A = (const u16*)(ws + W_Q); g.Bt = (const u16*)(ws + W_WPF); E.mode = 2; break;
        case PH_G4: g.A = (const u16*)(ws + W_GM); g.Bt = (const u16*)(ws + W_WOUT); E.mode = 3; break;
        case PH_G5A: g.Bt = (const u16*)(ws + W_WUP); g.M = HALF_ROWS; g.N = DFF2; E.d0 = (u16*)(ws + W_U); E.p0 = DFF2; break;
        case PH_G5B: g.A = (const u16*)(ws + W_H) + (size_t)HALF_ROWS * DM; g.Bt = (const u16*)(ws + W_WUP); g.M = HALF_ROWS; g.N = DFF2; E.d0 = (u16*)(ws + W_U); E.p0 = DFF2; break;
        default:   g.A = (const u16*)(ws + W_G); g.Bt = (const u16*)(ws + W_WDN); g.K = DFF; E.mode = 5; break;
        }
        int tail = 0; if (ph == PH_G2 || ph == PH_G3 || ph == PH_G4 || ph == PH_G6 || ph == PH_G1B || ph == PH_G1C) { g.M = MP; tail = 4; }
        pg8::StaticOrder S; S.init(g.M, g.N, cx.G, cx.bid, tail, WGM_OF(g.N));
        pg8::gemm_phase<Epi, pg8::StaticOrder, true, true>((PG8_LAS unsigned char*)lds, g, S, E, cx.tid);
        if (ph < last) gsync(lds);
    }
}
#define PH_BEGIN() Ctx cx; { int t_ = threadIdx.x; asm volatile("" : "+v"(t_)); int b_ = blockIdx.x, g_ = gridDim.x; asm volatile("" : "+s"(b_), "+s"(g_)); cx.tid = t_; cx.bid = b_; cx.G = g_; } \
    KPrm p = (KPrm)__builtin_amdgcn_kernarg_segment_ptr(); asm volatile("" : "+s"(p))
#ifdef ONLY_PH
#define PH_ON(k) ((k) == ONLY_PH)
#else
#define PH_ON(k) true
#endif
__global__ void __launch_bounds__(512, 2) mega_fwd(Prm prm_unused) {
    extern __shared__ __attribute__((aligned(16))) unsigned char lds[];
    cg::grid_group grid = cg::this_grid();
    volatile LAS unsigned* bst = (volatile LAS unsigned*)(lds + LDS_TOTAL - 64);
    if (threadIdx.x < 2) bst[threadIdx.x] = 0u;
    __syncthreads();
    { KPrm p0 = (KPrm)__builtin_amdgcn_kernarg_segment_ptr(); (void)xcd_barrier_post((unsigned*)(p0->ws + W_BAR), bst); }
#define GSYNC() gsync(lds)
#ifndef EXP
#define EXP 0
#endif
    if (PH_ON(PH_PREP)) { PH_BEGIN(); phase_prep(p, cx, lds); } grid.sync();
#if EXP == 3
    { PH_BEGIN(); phase_prep(p, cx, lds); } GSYNC();
#endif
    if (PH_ON(PH_N1)) { PH_BEGIN(); phase_norm(p, cx, 0); } GSYNC();
    if (PH_ON(PH_G1A)) { PH_BEGIN(); run_gemms(p, cx, lds, PH_G1A, PH_G1A); } GSYNC();
#if EXP == 1
    { PH_BEGIN(); run_gemms(p, cx, lds, PH_G1A, PH_G1A); } GSYNC();
#endif
    if (PH_ON(PH_CONV)) { PH_BEGIN(); phase_conv(p, cx); } GSYNC();
    if (PH_ON(PH_SSD)) { PH_BEGIN(); phase_ssd(p, cx, lds); } GSYNC();
#if EXP == 2
    { PH_BEGIN(); run_gemms(p, cx, lds, PH_G1A, PH_G1A); } GSYNC();
    { PH_BEGIN(); phase_conv(p, cx); } GSYNC();
    { PH_BEGIN(); phase_ssd(p, cx, lds); } GSYNC();
#endif
    if (PH_ON(PH_GN)) { PH_BEGIN(); phase_gn(p, cx); }
    if (PH_ON(PH_G1B)) { PH_BEGIN(); run_gemms(p, cx, lds, PH_G1B, PH_G1C); } GSYNC();
    if (PH_ON(PH_QK)) { PH_BEGIN(); phase_qk(p, cx); } GSYNC();
    if (PH_ON(PH_ATT)) { PH_BEGIN(); phase_att(p, cx, (char*)lds); } GSYNC();
#if EXP == 4
    { PH_BEGIN(); run_gemms(p, cx, lds, PH_G1C, PH_G1C); } GSYNC();
    { PH_BEGIN(); phase_qk(p, cx); } GSYNC();
    { PH_BEGIN(); phase_att(p, cx, (char*)lds); } GSYNC();
#endif
    if (PH_ON(PH_G3)) { PH_BEGIN(); run_gemms(p, cx, lds, PH_G3, PH_G4); } GSYNC();
    if (PH_ON(PH_N2)) { PH_BEGIN(); phase_norm(p, cx, 1); } GSYNC();
    if (PH_ON(PH_G5A)) { PH_BEGIN(); run_gemms(p, cx, lds, PH_G5A, PH_G5A); } GSYNC();
    if (PH_ON(PH_CVA)) { PH_BEGIN(); phase_cv(p, cx, 0); } GSYNC();
    if (PH_ON(PH_G5B)) { PH_BEGIN(); run_gemms(p, cx, lds, PH_G5B, PH_G5B); } GSYNC();
    if (PH_ON(PH_CVB)) { PH_BEGIN(); phase_cv(p, cx, 1); } GSYNC();
    if (PH_ON(PH_G6)) { PH_BEGIN(); run_gemms(p, cx, lds, PH_G6, PH_G6); }
#if EXP == 5
#pragma unroll 1
    for (int r = 0; r < 32; ++r) GSYNC();
#endif
}

extern "C" void kernel_launch(void* const* d_in, const int* in_sizes, int n_in, void* d_out, int out_size, void* d_ws, size_t ws_size, hipStream_t stream) {
    static int grid = 0;
    if (grid == 0) {
        if (n_in != 31 || (size_t)out_size != O_END || ws_size < 1024 * MiB) { fprintf(stderr, "kernel_launch: unexpected sizes n_in %d out %d ws %zu\n", n_in, out_size, ws_size); }
        int dev = 0, cus = 0, per_cu = 0;
        hipGetDevice(&dev); hipDeviceGetAttribute(&cus, hipDeviceAttributeMultiprocessorCount, dev);
        hipFuncSetAttribute((const void*)mega_fwd, hipFuncAttributeMaxDynamicSharedMemorySize, LDS_TOTAL);
        hipOccupancyMaxActiveBlocksPerMultiprocessor(&per_cu, (const void*)mega_fwd, 512, LDS_TOTAL);
        (void)hipGetLastError();
        if (per_cu < 1) per_cu = 1;
        grid = cus;
    }
    (void)hipMemsetAsync((char*)d_ws + W_BAR, 0, 16384, stream);
    Prm prm{};
    for (int i = 0; i < 31; ++i) prm.in[i] = (const float*)d_in[i];
    prm.out = (float*)d_out; prm.ws = (unsigned char*)d_ws;
    void* args[] = {&prm};
    hipError_t e = hipLaunchCooperativeKernel((const void*)mega_fwd, dim3(grid), dim3(512), args, LDS_TOTAL, stream);
    if (e != hipSuccess) fprintf(stderr, "cooperative launch failed: %s (grid %d)\n", hipGetErrorString(e), grid);
}
```

```cpp
#include <hip/hip_runtime.h>
#include <hip/hip_cooperative_groups.h>
#include <hip/hip_bf16.h>
#include <cstdio>
#include <cstdint>
namespace cg = cooperative_groups;
namespace pg8 {
#define PG8_LAS __attribute__((address_space(3)))
typedef unsigned short bf16_t;
typedef short bf16x8 __attribute__((ext_vector_type(8)));
typedef float f32x4 __attribute__((ext_vector_type(4)));
typedef unsigned u32x4 __attribute__((ext_vector_type(4)));
constexpr int BM = 256, BK = 64, HALF = 128, HTB = HALF * BK * 2  , STAGE_BYTES = 8 * HTB, NXCD = 8, WGM = 8;

__host__ __device__ __forceinline__ int lds_byte(int r, int c) { const int st = (r >> 4) * 2 + (c >> 5), rr = r & 15, cc = c & 31, ob = rr * 64 + cc * 2; return st * 1024 + (ob ^ (((ob >> 9) & 1) << 5)); }
__host__ __device__ __forceinline__ void stage_rc(int b, int& R, int& C) { const int st = b / 1024, sb = b % 1024, swz = sb ^ (((sb >> 9) & 1) << 5); R = (st >> 1) * 16 + swz / 64; C = (st & 1) * 32 + (swz % 64) / 2; }
__host__ __device__ __forceinline__ int perm32(int rho) { const int n = rho >> 4, i = rho & 15; return 8 * (i >> 2) + 4 * n + (i & 3); }

struct Unit { int pm, pn, ho, half; };
struct Gemm { const bf16_t* A; const bf16_t* Bt; int M, N, K; };

struct StaticOrder {
    int nM, nN, nwg, G, c, tail, wgm;
    __host__ __device__ void init(int M, int N, int G_, int c_, int tail_ = 0, int wgm_ = 4) { nM = M / BM; nN = N / BM; nwg = nM * nN; G = G_; c = c_; tail = tail_; wgm = wgm_; }
    __host__ __device__ bool next(int i, Unit& u) const {
        const long L = (long)i * G + c; u.ho = 0; u.half = 0;
        if (L >= nwg) { const int h = (int)(L - nwg); if (h >= tail * nN) return false; const int hm = h / nN; u.pn = h - hm * nN; u.pm = nM + (hm >> 1); u.ho = hm & 1; u.half = 1; return true; }
        int wgid = (int)L; { const int q = nwg / NXCD, r = nwg % NXCD, xcd = wgid % NXCD, off = wgid / NXCD; wgid = (xcd < r ? xcd * (q + 1) : r * (q + 1) + (xcd - r) * q) + off; }
        const int nig = wgm * nN, gid = wgid / nig, fm = gid * wgm, gsz = (nM - fm) < wgm ? (nM - fm) : wgm;
        u.pm = fm + ((wgid % nig) % gsz); u.pn = (wgid % nig) / gsz; return true;
    }
    __device__ __forceinline__ void a_ready(const Unit&) const {}
    __device__ __forceinline__ void done(const Unit&) const {}
};
__device__ __forceinline__ unsigned cvt_pk_bf16(float lo, float hi) { unsigned r; asm volatile("v_cvt_pk_bf16_f32 %0, %1, %2" : "=v"(r) : "v"(lo), "v"(hi)); return r; }
typedef float f32x2 __attribute__((ext_vector_type(2)));
template <class Epi, class Sched, bool ALIGN_EPI = false, bool SP2 = false>
__device__ __forceinline__ void gemm_phase(PG8_LAS unsigned char* lds, const Gemm g, const Sched& S, const Epi& E, const int tid) {
    const int wid = __builtin_amdgcn_readfirstlane(tid >> 6), lane = tid & 63, wr = wid >> 2, wc = wid & 3, fr = lane & 15, fq = lane >> 4;
    const int K = g.K, nt = K / BK;
    unsigned voffA[2], voffB[2];
#pragma unroll
    for (int i = 0; i < 2; ++i) { int R, C; stage_rc(tid * 16 + i * 8192, R, C); const int Rb = Epi::PERM ? ((R & ~31) + perm32(R & 31)) : R;
        voffA[i] = (unsigned)(R * K + C) * 2u; voffB[i] = (unsigned)(Rb * K + C) * 2u; }
    const size_t kstep = (size_t)(BK * 2);
    const size_t hstep = (size_t)HALF * K * 2;
    const size_t tstep = 2 * hstep;
    const unsigned ldsw = (unsigned)wid * 1024u;
    const int aoff = lds_byte(wr * 64 + fr, fq * 8), boff = lds_byte(wc * 32 + fr, fq * 8);
#define PG8_SA(b, h) (((b) * 2 + (h)) * HTB)
#define PG8_SB(b, h) ((4 + (b) * 2 + (h)) * HTB)
#define PG8_STAGE(bufoff, gbase, voff) do { _Pragma("unroll") for (int _i = 0; _i < 2; ++_i) \
        __builtin_amdgcn_global_load_lds((const unsigned*)((const char*)(gbase) + (voff)[_i]), (PG8_LAS unsigned*)(lds + (bufoff) + ldsw + _i * 8192), 16, 0, 0); } while (0)
#define PG8_LDA(dst, b, h) do { _Pragma("unroll") for (int m = 0; m < 4; ++m) _Pragma("unroll") for (int k = 0; k < 2; ++k) dst[m][k] = *(const PG8_LAS bf16x8*)(lds + PG8_SA(b, h) + aoff + m * 2048 + k * 1024); } while (0)
#define PG8_LDB(dst, b, h) do { _Pragma("unroll") for (int n = 0; n < 2; ++n) _Pragma("unroll") for (int k = 0; k < 2; ++k) dst[n][k] = *(const PG8_LAS bf16x8*)(lds + PG8_SB(b, h) + boff + n * 2048 + k * 1024); } while (0)
#define PG8_MMA(ai, bj, At, Bt) do { __builtin_amdgcn_s_setprio(1); _Pragma("unroll") for (int m = 0; m < 4; ++m) _Pragma("unroll") for (int n = 0; n < 2; ++n) _Pragma("unroll") for (int k = 0; k < 2; ++k) \
        acc[ai][bj][m][n] = __builtin_amdgcn_mfma_f32_16x16x32_bf16(Bt[n][k], At[m][k], acc[ai][bj][m][n], 0, 0, 0); __builtin_amdgcn_s_setprio(0); } while (0)
#define PG8_WAIT_V(n) asm volatile("s_waitcnt vmcnt(" #n ")" ::: "memory")
#define PG8_WAIT_L(n) asm volatile("s_waitcnt lgkmcnt(" #n ")" ::: "memory")
#define PG8_BAR __builtin_amdgcn_s_barrier()
#define PG8_SCHED __builtin_amdgcn_sched_barrier(0)
    Unit cur, nxt; int ui = 0;
    if (!S.next(0, cur)) return;
    f32x4 acc[2][2][4][2];
#pragma unroll
    for (int a = 0; a < 2; ++a)
#pragma unroll
        for (int b = 0; b < 2; ++b)
#pragma unroll
            for (int m = 0; m < 4; ++m)
#pragma unroll
                for (int n = 0; n < 2; ++n) acc[a][b][m][n] = (f32x4){0.f, 0.f, 0.f, 0.f};
    bf16x8 At[4][2], B0[2][2], B1[2][2];
    const char* cA = (const char*)g.A + (size_t)cur.pm * tstep + (size_t)cur.ho * hstep; const char* cB = (const char*)g.Bt + (size_t)cur.pn * tstep;
    S.a_ready(cur);
    if constexpr (SP2) {
        PG8_STAGE(PG8_SB(0, 0), cB, voffB); PG8_STAGE(PG8_SB(0, 1), cB + hstep, voffB); PG8_STAGE(PG8_SA(0, 0), cA, voffA); PG8_STAGE(PG8_SA(0, 1), cA + hstep, voffA);
        if (wr == 1) PG8_BAR;
        PG8_WAIT_V(2); PG8_BAR;
        PG8_STAGE(PG8_SB(1, 0), cB + kstep, voffB); PG8_STAGE(PG8_SA(1, 0), cA + kstep, voffA); PG8_STAGE(PG8_SB(1, 1), cB + hstep + kstep, voffB);
        PG8_WAIT_V(6); PG8_BAR;
    } else {
        PG8_STAGE(PG8_SB(0, 0), cB, voffB); PG8_STAGE(PG8_SA(0, 0), cA, voffA); PG8_STAGE(PG8_SB(0, 1), cB + hstep, voffB); PG8_STAGE(PG8_SA(0, 1), cA + hstep, voffA);
        if (wr == 1) PG8_BAR;
        PG8_WAIT_V(4); PG8_BAR;
        PG8_STAGE(PG8_SB(1, 0), cB + kstep, voffB); PG8_STAGE(PG8_SA(1, 0), cA + kstep, voffA); PG8_STAGE(PG8_SB(1, 1), cB + hstep + kstep, voffB);
        PG8_WAIT_V(6); PG8_BAR;
    }
    for (;;) {
        const bool has_next = S.next(ui + 1, nxt);
        const char* nA = has_next ? (const char*)g.A + (size_t)nxt.pm * tstep + (size_t)nxt.ho * hstep : cA; const char* nB = has_next ? (const char*)g.Bt + (size_t)nxt.pn * tstep : cB;
        for (int t = 0; t < nt; t += 2) {
            const bool last = (t == nt - 2);
            const char* a1 = cA + (size_t)(t + 1) * kstep;
            const char* a2 = last ? nA : cA + (size_t)(t + 2) * kstep; const char* b2 = last ? nB : cB + (size_t)(t + 2) * kstep;
            const char* a3 = a2 + kstep; const char* b3 = b2 + kstep;
            if (last && has_next) S.a_ready(nxt);
            if constexpr (SP2) {
            PG8_LDB(B0, 0, 0); PG8_LDB(B1, 0, 1); PG8_SCHED; PG8_LDA(At, 0, 0); PG8_STAGE(PG8_SA(1, 1), a1 + hstep, voffA);
            PG8_WAIT_V(8); PG8_WAIT_L(0); PG8_BAR; PG8_MMA(0, 0, At, B0); PG8_MMA(0, 1, At, B1); PG8_BAR; PG8_SCHED;
            PG8_LDA(At, 0, 1); PG8_STAGE(PG8_SB(0, 0), b2, voffB); PG8_STAGE(PG8_SB(0, 1), b2 + hstep, voffB); PG8_STAGE(PG8_SA(0, 0), a2, voffA);
            PG8_WAIT_V(8); PG8_WAIT_L(0); PG8_BAR; if (!cur.half) { PG8_MMA(1, 0, At, B0); PG8_MMA(1, 1, At, B1); } PG8_BAR; PG8_SCHED;
            PG8_LDB(B0, 1, 0); PG8_LDB(B1, 1, 1); PG8_SCHED; PG8_LDA(At, 1, 0); PG8_STAGE(PG8_SA(0, 1), a2 + hstep, voffA);
            PG8_WAIT_V(8); PG8_WAIT_L(0); PG8_BAR; PG8_MMA(0, 0, At, B0); PG8_MMA(0, 1, At, B1); PG8_BAR; PG8_SCHED;
            PG8_LDA(At, 1, 1); PG8_STAGE(PG8_SB(1, 0), b3, voffB); PG8_STAGE(PG8_SB(1, 1), b3 + hstep, voffB); PG8_STAGE(PG8_SA(1, 0), a3, voffA);
            PG8_WAIT_V(8); PG8_WAIT_L(0); PG8_BAR; if (!cur.half) { PG8_MMA(1, 0, At, B0); PG8_MMA(1, 1, At, B1); } PG8_BAR; PG8_SCHED;
            } else {
            PG8_LDB(B0, 0, 0); PG8_SCHED; PG8_LDA(At, 0, 0); PG8_STAGE(PG8_SA(1, 1), a1 + hstep, voffA);
            PG8_WAIT_L(8); PG8_BAR; PG8_WAIT_L(0); PG8_MMA(0, 0, At, B0); PG8_BAR; PG8_SCHED;
            PG8_LDB(B1, 0, 1); PG8_STAGE(PG8_SB(0, 0), b2, voffB);
            PG8_BAR; PG8_WAIT_L(0); PG8_MMA(0, 1, At, B1); PG8_BAR;
            PG8_LDA(At, 0, 1); PG8_STAGE(PG8_SA(0, 0), a2, voffA);
            PG8_BAR; PG8_WAIT_L(0); PG8_MMA(1, 0, At, B0); PG8_BAR; PG8_SCHED;
            PG8_STAGE(PG8_SB(0, 1), b2 + hstep, voffB);
            PG8_WAIT_V(6); PG8_BAR; PG8_MMA(1, 1, At, B1); PG8_BAR;
            PG8_LDB(B0, 1, 0); PG8_SCHED; PG8_LDA(At, 1, 0); PG8_STAGE(PG8_SA(0, 1), a2 + hstep, voffA);
            PG8_WAIT_L(8); PG8_BAR; PG8_WAIT_L(0); PG8_MMA(0, 0, At, B0); PG8_BAR; PG8_SCHED;
            PG8_LDB(B1, 1, 1); PG8_STAGE(PG8_SB(1, 0), b3, voffB);
            PG8_BAR; PG8_WAIT_L(0); PG8_MMA(0, 1, At, B1); PG8_BAR;
            PG8_LDA(At, 1, 1); PG8_STAGE(PG8_SA(1, 0), a3, voffA);
            PG8_BAR; PG8_WAIT_L(0); PG8_MMA(1, 0, At, B0); PG8_BAR; PG8_SCHED;
            PG8_STAGE(PG8_SB(1, 1), b3 + hstep, voffB);
            PG8_WAIT_V(6); PG8_BAR; PG8_MMA(1, 1, At, B1); PG8_BAR;
            }
        }
        if constexpr (ALIGN_EPI) { if (wr == 0) PG8_BAR; }
        if constexpr (!Epi::AFTER_DRAIN) { E(acc, cur, wr, wc, fr, fq); S.done(cur); }
        if (!has_next) break;
#pragma unroll
        for (int a = 0; a < 2; ++a)
#pragma unroll
            for (int b = 0; b < 2; ++b)
#pragma unroll
                for (int m = 0; m < 4; ++m)
#pragma unroll
                    for (int n = 0; n < 2; ++n) acc[a][b][m][n] = (f32x4){0.f, 0.f, 0.f, 0.f};
        cur = nxt; cA = nA; cB = nB; ++ui;
        if constexpr (ALIGN_EPI) { if (wr == 1) PG8_BAR; }
    }
    PG8_WAIT_V(0);
    if constexpr (!ALIGN_EPI) { if (wr == 0) PG8_BAR; }
    PG8_BAR;
    if constexpr (Epi::AFTER_DRAIN) { E.fused(acc, cur, wr, wc, fr, fq, lds, wid, lane); S.done(cur); }
#undef PG8_SA
#undef PG8_SB
#undef PG8_STAGE
#undef PG8_LDA
#undef PG8_LDB
#undef PG8_MMA
#undef PG8_WAIT_V
#undef PG8_WAIT_L
#undef PG8_BAR
#undef PG8_SCHED
}
}
namespace att {
constexpr int D = 128, PITCH = 2048, NW = 8, QBLK = 32, KVBLK = 64, QB = NW * QBLK;
constexpr int SHM_V = KVBLK * D * 2, SHM_K = KVBLK * D * 2;
constexpr int LDS_BIAS = 2 * SHM_V + 2 * SHM_K + NW * 64 * 4;
constexpr int NQX = 4, LDS_QX = LDS_BIAS + 512;
constexpr int LDS_BYTES = LDS_QX + NW * NQX * 1024;
constexpr float THR2 = 64.f;
constexpr bool WSKIP = false;
typedef __hip_bfloat16 bf16;
typedef short bf16x8 __attribute__((ext_vector_type(8)));
typedef short s16x4 __attribute__((ext_vector_type(4)));
typedef float f32x16 __attribute__((ext_vector_type(16)));
typedef float f32x4 __attribute__((ext_vector_type(4)));
typedef unsigned u32x4 __attribute__((ext_vector_type(4)));
template <class A, class Bt> struct same_t { static constexpr bool v = false; };
template <class A> struct same_t<A, A> { static constexpr bool v = true; };

#define KSWZ(row, colB) ((row) * 256 + ((colB) ^ (((row) & 7) << 4)))
#define SBAR() __builtin_amdgcn_sched_barrier(0)
__device__ __forceinline__ int v_st(int k, int c) { const int kk = (k & ~0xC) | ((k & 4) << 1) | ((k & 8) >> 1); return ((kk >> 3) * 4 + (c >> 5)) * 512 + ((kk & 7) * 32 + (c & 31)) * 2; }
__device__ __forceinline__ int v_rd_base(int lane) { return ((lane & 3) << 3) | (((lane >> 2) & 3) << 6) | (((lane >> 4) & 1) << 5) | (((lane >> 5) & 1) << 8); }
constexpr int v_rd_off(int d0, int ks, int half) { return d0 * 512 + ks * 4096 + half * 2048; }
__device__ __forceinline__ int crow(int r, int hi) { return (r & 3) + 8 * (r >> 2) + 4 * hi; }
__device__ __forceinline__ unsigned cvtpk(float lo, float hi) {
    unsigned r; asm volatile("v_cvt_pk_bf16_f32 %0, %1, %2" : "=v"(r) : "v"(lo), "v"(hi)); return r;
}
__device__ __forceinline__ bf16x8 pack8(f32x4 a, f32x4 b) {
    u32x4 w = {cvtpk(a[0], a[1]), cvtpk(a[2], a[3]), cvtpk(b[0], b[1]), cvtpk(b[2], b[3])};
    return *reinterpret_cast<bf16x8*>(&w);
}
template <class T> __device__ __forceinline__ bf16x8 load8(const T* p) {
    if constexpr (same_t<T, float>::v) { return pack8(*(const f32x4*)p, *(const f32x4*)(p + 4)); }
    else { return *reinterpret_cast<const bf16x8*>(p); }
}
__device__ __forceinline__ void mask_tile(f32x16& p0, f32x16& p1, int dq, unsigned W) {
    const float NEG = -__builtin_inff();
#pragma unroll
    for (int r = 0; r < 16; ++r) {
        const int c = (r & 3) + 8 * (r >> 2);
        if (dq - c < 0) p0[r] = NEG;
        if (dq - c - 32 < 0) p1[r] = NEG;
    }
}
__device__ __forceinline__ void partialSM(f32x16& p0, f32x16& p1, float& m_reg, float& mn, float& alpha) {
    float pmax = p0[0]; for (int r = 1; r < 16; ++r) pmax = fmaxf(pmax, p0[r]); for (int r = 0; r < 16; ++r) pmax = fmaxf(pmax, p1[r]);
    { auto rr = __builtin_amdgcn_permlane32_swap(__float_as_uint(pmax), __float_as_uint(pmax), false, false);
      pmax = fmaxf(__uint_as_float(rr[0]), __uint_as_float(rr[1])); }
    if (__builtin_expect(__all((pmax - m_reg) <= THR2), 1)) { mn = m_reg; alpha = 1.f; }
    else { mn = fmaxf(m_reg, pmax); alpha = __builtin_amdgcn_exp2f(m_reg - mn); m_reg = mn; }
    for (int r = 0; r < 16; ++r) p0[r] = p0[r] - mn; for (int r = 0; r < 16; ++r) p1[r] = p1[r] - mn;
    for (int r = 0; r < 16; ++r) p0[r] = __builtin_amdgcn_exp2f(p0[r]);
}
__device__ __forceinline__ void finishSM(f32x16& p0, f32x16& p1, float alpha, float& l_reg, bf16x8& pa0, bf16x8& pa1, bf16x8& pa2, bf16x8& pa3) {
    for (int r = 0; r < 16; ++r) p1[r] = __builtin_amdgcn_exp2f(p1[r]);
    float ps = 0; for (int r = 0; r < 16; ++r) ps += p0[r]; for (int r = 0; r < 16; ++r) ps += p1[r];
    { auto rr = __builtin_amdgcn_permlane32_swap(__float_as_uint(ps), __float_as_uint(ps), false, false);
      ps = __uint_as_float(rr[0]) + __uint_as_float(rr[1]); }
    l_reg = l_reg * alpha + ps;
#define PK4(P, B_, OUT) do { unsigned a0 = cvtpk(P[B_+0], P[B_+1]), a1 = cvtpk(P[B_+2], P[B_+3]);                          \
        unsigned b0 = cvtpk(P[B_+4], P[B_+5]), b1 = cvtpk(P[B_+6], P[B_+7]);                                             \
        auto r0 = __builtin_amdgcn_permlane32_swap(a0, b0, false, false); auto r1 = __builtin_amdgcn_permlane32_swap(a1, b1, false, false); \
        u32x4 w = {r0[0], r1[0], r0[1], r1[1]}; OUT = *reinterpret_cast<bf16x8*>(&w); } while (0)
    PK4(p0, 0, pa0); PK4(p0, 8, pa1); PK4(p1, 0, pa2); PK4(p1, 8, pa3);
#undef PK4
}
template <int KB, bool SK>
__device__ __forceinline__ void qkt(f32x16& p0, f32x16& p1, const char* K_lds, int r32, int hi, const bf16x8* qr, bool act, const char* qx) {
    if (SK && !act) { const float NEG = -__builtin_inff();
#pragma unroll
        for (int r = 0; r < 16; ++r) { p0[r] = NEG; p1[r] = NEG; } return; }
    { const float* bl = (const float*)(K_lds - 2 * SHM_V + LDS_BIAS) + KB * 64 + 4 * hi;
#pragma unroll
      for (int g = 0; g < 4; ++g) { const f32x4 u0 = *(const f32x4*)(bl + 8 * g), u1 = *(const f32x4*)(bl + 32 + 8 * g);
        p0[4*g] = u0[0]; p0[4*g+1] = u0[1]; p0[4*g+2] = u0[2]; p0[4*g+3] = u0[3]; p1[4*g] = u1[0]; p1[4*g+1] = u1[1]; p1[4*g+2] = u1[2]; p1[4*g+3] = u1[3]; } }
    const char* kb[4];
#pragma unroll
    for (int dd = 0; dd < 4; ++dd) kb[dd] = K_lds + KB * SHM_K + KSWZ(r32, (dd * 16 + hi * 8) * 2);
#pragma unroll
    for (int d0 = 0; d0 < 8; ++d0) { const char* a = kb[d0 & 3] + (d0 >> 2) * 128;
        bf16x8 b0 = *reinterpret_cast<const bf16x8*>(a);
        bf16x8 b1 = *reinterpret_cast<const bf16x8*>(a + 32 * 256);
        const bf16x8 qv = (d0 < 8 - NQX) ? qr[d0] : *reinterpret_cast<const bf16x8*>(qx + (d0 - (8 - NQX)) * 1024);
        p0 = __builtin_amdgcn_mfma_f32_32x32x16_bf16(b0, qv, p0, 0, 0, 0);
        p1 = __builtin_amdgcn_mfma_f32_32x32x16_bf16(b1, qv, p1, 0, 0, 0); }
}
template <int VB, bool SK>
__device__ __forceinline__ void pv_tile(f32x16* o, int vb0, bf16x8 pa0, bf16x8 pa1, bf16x8 pa2, bf16x8 pa3, bool act) {
    if (SK && !act) return;
#define TRRD(dst, off) asm volatile("ds_read_b64_tr_b16 %0, %1 offset:%2" : "=&v"(dst) : "v"(vb0), "i"(off) : "memory")
#define PV_D0(d0) do { s16x4 l0, l1, l2, l3, h0, h1, h2, h3; constexpr int b_ = VB * SHM_V + v_rd_off(d0, 0, 0);     \
        TRRD(l0, b_); TRRD(h0, b_ + 2048); TRRD(l1, b_ + 4096); TRRD(h1, b_ + 6144); TRRD(l2, b_ + 8192); TRRD(h2, b_ + 10240); TRRD(l3, b_ + 12288); TRRD(h3, b_ + 14336); \
        asm volatile("s_waitcnt lgkmcnt(0)" ::: "memory"); SBAR();                 \
        o[d0] = __builtin_amdgcn_mfma_f32_32x32x16_bf16(pa0, (bf16x8){l0[0], l0[1], l0[2], l0[3], h0[0], h0[1], h0[2], h0[3]}, o[d0], 0, 0, 0);   \
        o[d0] = __builtin_amdgcn_mfma_f32_32x32x16_bf16(pa1, (bf16x8){l1[0], l1[1], l1[2], l1[3], h1[0], h1[1], h1[2], h1[3]}, o[d0], 0, 0, 0);   \
        o[d0] = __builtin_amdgcn_mfma_f32_32x32x16_bf16(pa2, (bf16x8){l2[0], l2[1], l2[2], l2[3], h2[0], h2[1], h2[2], h2[3]}, o[d0], 0, 0, 0);   \
        o[d0] = __builtin_amdgcn_mfma_f32_32x32x16_bf16(pa3, (bf16x8){l3[0], l3[1], l3[2], l3[3], h3[0], h3[1], h3[2], h3[3]}, o[d0], 0, 0, 0); } while (0)
    PV_D0(0); PV_D0(1); PV_D0(2); PV_D0(3);
#undef PV_D0
#undef TRRD
}

template <class TIn, class TOut> struct BlockRef { const TIn* Q; const TIn* K; const TIn* V; TOut* O; const float* Bs; int P0; int nvalid; };
template <class TIn> struct Seam {
    bf16x8 qr[8];
    bf16x8 st_v0, st_v1, st_k0, st_k1; f32x4 sf0, sf1, sf2, sf3;
    f32x4 tq[16];
};
__device__ __forceinline__ int swa_jlo(int P0, int W) { const int lowk = P0 - W + 1; return lowk > 0 ? lowk / KVBLK : 0; }
#define ROW(p, k0, rr) ((p) + (size_t)((k0) + (rr)) * PITCH + sc)
#define VMW() asm volatile("s_waitcnt vmcnt(0)" ::: "memory")
#define VMWN(n) asm volatile("s_waitcnt vmcnt(%0)" :: "i"(n) : "memory")
#define GLDS(gp_, lp_, sz_) __builtin_amdgcn_global_load_lds((const unsigned*)(gp_), (__attribute__((address_space(3))) unsigned*)(lp_), sz_, 0, 0)
#define SLOAD_H(Kp, Vp, Bp, k0, bb_) do { S.st_v0 = load8<TIn>(ROW(Vp, k0, sr)); S.st_v1 = load8<TIn>(ROW(Vp, k0, 32 + sr));              \
                         { const TIn* kg_ = (Kp) + (size_t)(k0) * PITCH; char* kl_ = K_lds + (bb_) * SHM_K + wid * 2048; GLDS(kg_ + ksrc0, kl_, 16); GLDS(kg_ + ksrc1, kl_ + 1024, 16); } \
                         if (wid == 0) GLDS((Bp) + (k0) + lane, lds + LDS_BIAS + (bb_) * 256, 4); } while (0)
#define SWRITE_HK(bf) do { } while (0)
#define SWRITE_HV(bf) do { *(bf16x8*)(V_lds + (bf) * SHM_V + vst0) = S.st_v0; *(bf16x8*)(V_lds + (bf) * SHM_V + vst1) = S.st_v1; } while (0)
#define SWRITE_H(bf) do { SWRITE_HV(bf); SWRITE_HK(bf); } while (0)
#define SLOAD_F(p, k0) do { S.sf0 = *(const f32x4*)ROW(p, k0, sr); S.sf1 = *(const f32x4*)(ROW(p, k0, sr) + 4);                \
                            S.sf2 = *(const f32x4*)ROW(p, k0, 32 + sr); S.sf3 = *(const f32x4*)(ROW(p, k0, 32 + sr) + 4); } while (0)
#define SWRITE_KF(bf) do { *(bf16x8*)(K_lds + (bf) * SHM_K + kws) = pack8(S.sf0, S.sf1); *(bf16x8*)(K_lds + (bf) * SHM_K + kws + 32 * 256) = pack8(S.sf2, S.sf3); } while (0)
#define SWRITE_VF(bf) do { *(bf16x8*)(V_lds + (bf) * SHM_V + vst0) = pack8(S.sf0, S.sf1); *(bf16x8*)(V_lds + (bf) * SHM_V + vst1) = pack8(S.sf2, S.sf3); } while (0)
template <class TIn, class TOut>
__device__ __forceinline__ void causal_swa_prime(const BlockRef<TIn, TOut>& cur, int W, char* lds, Seam<TIn>& S, const int tid) {
    constexpr bool F32 = same_t<TIn, float>::v;
    const int wid = __builtin_amdgcn_readfirstlane(tid >> 6), lane = tid & 63, r32 = lane & 31, hi = lane >> 5;
    const int sr = tid >> 4, sc = (tid & 15) * 8, kws = KSWZ(sr, sc * 2); char* K_lds = lds + 2 * SHM_V; (void)kws;
    const int ksrc0 = (8 * wid + (lane >> 4)) * PITCH + ((lane & 15) ^ (lane >> 4)) * 8, ksrc1 = (8 * wid + 4 + (lane >> 4)) * PITCH + ((lane & 15) ^ (4 + (lane >> 4))) * 8;
    const int kb0 = swa_jlo(cur.P0, W) * KVBLK;
    for (int d0 = 0; d0 < 8; ++d0) S.qr[d0] = load8<TIn>(cur.Q + (size_t)(wid * QBLK + r32) * PITCH + d0 * 16 + hi * 8);
    if constexpr (F32) { SLOAD_F((const float*)cur.K, kb0); VMW(); SWRITE_KF(0); SBAR(); SLOAD_F((const float*)cur.V, kb0); }
    else { SLOAD_H(cur.K, cur.V, cur.Bs, kb0, 0); VMW(); SWRITE_HK(0); }
    __syncthreads();
}
template <class TIn, class TOut>
__device__ __forceinline__ void causal_swa_block(const BlockRef<TIn, TOut>& cur, const BlockRef<TIn, TOut>& nxt, int skv, int W, char* lds, Seam<TIn>& S, const int tid, const float* qnw, const float qs) {
    constexpr bool F32 = same_t<TIn, float>::v;
    const int wid = __builtin_amdgcn_readfirstlane(tid >> 6), lane = tid & 63, r32 = lane & 31, hi = lane >> 5;
    const int j_lo = swa_jlo(cur.P0, W);
    int j_hi = (cur.P0 + QB - 1) / KVBLK + 1; if (j_hi > skv / KVBLK) j_hi = skv / KVBLK;
    const int NT = j_hi - j_lo;
    const int kbn = swa_jlo(nxt.P0, W) * KVBLK;
    const int qlo = cur.P0 + wid * QBLK, qm = qlo + r32 - 4 * hi;
    char* V_lds = lds; char* K_lds = lds + 2 * SHM_V;
    float* ws = (float*)(lds + 2 * SHM_V + 2 * SHM_K) + wid * 64; float* li_l = ws, * al_l = ws + 32;
    float m_reg = -1e30f, l_reg = 0; f32x16 o[4] = {};
    const int sr = tid >> 4, sc = (tid & 15) * 8, vst0 = v_st(sr, sc), vst1 = v_st(32 + sr, sc), kws = KSWZ(sr, sc * 2);
    const int vb0 = (int)(uintptr_t)V_lds + v_rd_base(lane); (void)kws;
    const int ksrc0 = (8 * wid + (lane >> 4)) * PITCH + ((lane & 15) ^ (lane >> 4)) * 8, ksrc1 = (8 * wid + 4 + (lane >> 4)) * PITCH + ((lane & 15) ^ (4 + (lane >> 4))) * 8;
    const TIn* Kh = cur.K; const TIn* Vh = cur.V; const float* Bh = cur.Bs;
#define RESC(a) do { if (__any((a) < 1.f)) { if (hi == 0) al_l[r32] = (a); asm volatile("s_waitcnt lgkmcnt(0)" ::: "memory");              \
                     for (int d_ = 0; d_ < 4; ++d_) for (int r = 0; r < 16; ++r) o[d_][r] *= al_l[crow(r, hi)]; } } while (0)
#define KBASE(t) ((j_lo + (t)) * KVBLK)
#define ACT(t) (KBASE(t) <= qlo + QBLK - 1 && KBASE(t) + KVBLK - 1 >= qlo - W + 1)
#define MASKT(P0_, P1_, t) do { const int kb_ = KBASE(t); if ((!SK || ACT(t)) && (kb_ + KVBLK - 1 > qlo || kb_ <= qlo + QBLK - 1 - W)) mask_tile(P0_, P1_, qm - kb_, (unsigned)W); } while (0)
    constexpr int NQL = F32 ? 16 : 8;
    constexpr bool SK = WSKIP && !F32;
#define SEAM_K0() do { VMWN(NQL); if constexpr (F32) { SWRITE_KF(0); SBAR(); SLOAD_F((const float*)nxt.V, kbn); } else { SWRITE_HK(0); } SBAR(); } while (0)
    f32x16 pA0, pA1, pB0, pB1; float mnA, mnB, alA, alB; bf16x8 pa0, pa1, pa2, pa3;
    {
        const float* wq_ = qnw; asm volatile("" : "+s"(wq_));
        float ss_ = 0.f;
#pragma unroll
        for (int d0 = 0; d0 < 8; ++d0) { const u32x4 w_ = __builtin_bit_cast(u32x4, S.qr[d0]);
#pragma unroll
            for (int e = 0; e < 4; ++e) { const float lo_ = __uint_as_float(w_[e] << 16), hi_ = __uint_as_float(w_[e] & 0xffff0000u); ss_ += lo_ * lo_ + hi_ * hi_; } }
        { auto rr = __builtin_amdgcn_permlane32_swap(__float_as_uint(ss_), __float_as_uint(ss_), false, false); ss_ = __uint_as_float(rr[0]) + __uint_as_float(rr[1]); }
        const float rs_ = rsqrtf(ss_ * (1.f / 128.f) + 1e-6f) * qs;
#pragma unroll
        for (int d0 = 0; d0 < 8; ++d0) { const u32x4 w_ = __builtin_bit_cast(u32x4, S.qr[d0]); const f32x4 g0 = *(const f32x4*)(wq_ + d0 * 16 + hi * 8), g1 = *(const f32x4*)(wq_ + d0 * 16 + hi * 8 + 4); u32x4 o_;
#pragma unroll
            for (int e = 0; e < 4; ++e) { const float lo_ = __uint_as_float(w_[e] << 16) * rs_ * (e < 2 ? g0[2 * e] : g1[2 * e - 4]), hi_ = __uint_as_float(w_[e] & 0xffff0000u) * rs_ * (e < 2 ? g0[2 * e + 1] : g1[2 * e - 3]); o_[e] = cvtpk(lo_, hi_); }
            S.qr[d0] = __builtin_bit_cast(bf16x8, o_); }
    }
    char* qx = lds + LDS_QX + wid * (NQX * 1024) + lane * 16;
#pragma unroll
    for (int e = 0; e < NQX; ++e) *reinterpret_cast<bf16x8*>(qx + e * 1024) = S.qr[8 - NQX + e];
    if constexpr (F32) { VMW(); SWRITE_VF(0); SBAR(); } else { SWRITE_HV(0); SBAR(); }
    if (NT > 1) { if constexpr (F32) SLOAD_F((const float*)Kh, KBASE(1)); else SLOAD_H(Kh, Vh, Bh, KBASE(1), 1); }
    SBAR(); qkt<0, SK>(pA0, pA1, K_lds, r32, hi, S.qr, ACT(0), qx);
    if constexpr (F32) { if (NT > 1) { VMW(); SWRITE_KF(1); SBAR(); SLOAD_F((const float*)Vh, KBASE(1)); } }
    MASKT(pA0, pA1, 0); partialSM(pA0, pA1, m_reg, mnA, alA);
    if (NT > 1) { VMW(); if constexpr (F32) { SWRITE_VF(1); SBAR(); if (NT > 2) SLOAD_F((const float*)Kh, KBASE(2)); } else SWRITE_H(1); }
    __syncthreads();
#define HALF_STEP(PX0, PX1, mnX, alX, PY0, PY1, alY, t, KB, VB, SB) do {                                                      \
        SBAR(); qkt<KB, SK>(PX0, PX1, K_lds, r32, hi, S.qr, ACT(t), qx);                                             \
        finishSM(PY0, PY1, alY, l_reg, pa0, pa1, pa2, pa3); SBAR();                                                           \
        if ((t) + 1 < NT) { if constexpr (F32) { VMW(); SWRITE_KF(SB); SBAR(); SLOAD_F((const float*)Vh, KBASE((t) + 1)); }  \
                            else { SLOAD_H(Kh, Vh, Bh, KBASE((t) + 1), SB); } SBAR(); }                                               \
        pv_tile<VB, SK>(o, vb0, pa0, pa1, pa2, pa3, ACT((t) - 1)); MASKT(PX0, PX1, (t)); partialSM(PX0, PX1, m_reg, mnX, alX);                                        \
        __syncthreads();                                                                                                      \
        if ((t) + 1 < NT) { VMW(); if constexpr (F32) { SWRITE_VF(SB); SBAR(); if ((t) + 2 < NT) SLOAD_F((const float*)Kh, KBASE((t) + 2)); } \
                            else { SWRITE_H(SB); } }                                                                          \
        RESC(alX); __syncthreads(); } while (0)
    for (int t = 1; t + 1 < NT; t += 2) {
        HALF_STEP(pB0, pB1, mnB, alB, pA0, pA1, alA, t, 1, 0, 0);
        HALF_STEP(pA0, pA1, mnA, alA, pB0, pB1, alB, t + 1, 0, 1, 1);
    }
    const bool even = (NT & 1) == 0;
    if (even) { SBAR(); qkt<1, SK>(pB0, pB1, K_lds, r32, hi, S.qr, ACT(NT - 1), qx); SBAR(); }
#define QROW(e) (nxt.Q + (size_t)(wid * QBLK + r32) * PITCH + ((e) >> 1) * 16 + hi * 8 + ((e) & 1) * 4)
    if constexpr (F32) { SLOAD_F((const float*)nxt.K, kbn); SBAR();
#pragma unroll
        for (int e = 0; e < 8; ++e) S.tq[e] = *(const f32x4*)QROW(e); }
    else { SLOAD_H(nxt.K, nxt.V, nxt.Bs, kbn, 0); SBAR();
#pragma unroll
        for (int d0 = 0; d0 < 8; ++d0) S.qr[d0] = load8<TIn>(nxt.Q + (size_t)(wid * QBLK + r32) * PITCH + d0 * 16 + hi * 8); }
    SBAR();
    finishSM(pA0, pA1, alA, l_reg, pa0, pa1, pa2, pa3); SBAR();
    if constexpr (F32) {
#pragma unroll
        for (int e = 8; e < 16; ++e) S.tq[e] = *(const f32x4*)QROW(e); SBAR(); }
#undef QROW
    pv_tile<0, SK>(o, vb0, pa0, pa1, pa2, pa3, ACT(even ? NT - 2 : NT - 1));
    if (even) { MASKT(pB0, pB1, NT - 1); partialSM(pB0, pB1, m_reg, mnB, alB); __syncthreads(); RESC(alB);
        finishSM(pB0, pB1, alB, l_reg, pa0, pa1, pa2, pa3); SBAR(); pv_tile<1, SK>(o, vb0, pa0, pa1, pa2, pa3, ACT(NT - 1)); }
    SBAR(); SEAM_K0();
    if (hi == 0) li_l[r32] = l_reg; asm volatile("s_waitcnt lgkmcnt(0)" ::: "memory");
    float rli[16];
#pragma unroll
    for (int r = 0; r < 16; ++r) rli[r] = __builtin_amdgcn_rcpf(li_l[crow(r, hi)]);
    int tidE = tid; asm volatile("" : "+v"(tidE));
    const int widE = __builtin_amdgcn_readfirstlane(tidE >> 6), r32E = tidE & 31, hiE = (tidE >> 5) & 1;
    TOut* Ow = cur.O + (size_t)(widE * QBLK) * PITCH; const bool wval = widE * QBLK < cur.nvalid;
    if (wval) {
#pragma unroll
    for (int r = 0; r < 16; ++r) { const int orow = crow(r, hiE);
#pragma unroll
        for (int d0 = 0; d0 < 4; ++d0) { const float v = o[d0][r] * rli[r];
            if constexpr (same_t<TOut, float>::v) { Ow[(size_t)orow * PITCH + d0 * 32 + r32E] = v; }
            else { const float vn = __shfl_xor(v, 1);
                   if ((r32E & 1) == 0) *(unsigned*)(Ow + (size_t)orow * PITCH + d0 * 32 + r32E) = cvtpk(v, vn); } } } }
    if constexpr (F32) {
#pragma unroll
        for (int d0 = 0; d0 < 8; ++d0) S.qr[d0] = pack8(S.tq[2 * d0], S.tq[2 * d0 + 1]); }
    __syncthreads();
#undef RESC
#undef KBASE
#undef ACT
#undef MASKT
#undef SEAM_K0
#undef HALF_STEP
}
#undef ROW
#undef VMW
#undef VMWN
#undef SLOAD_H
#undef GLDS
#undef SWRITE_HK
#undef SWRITE_HV
#undef SWRITE_H
#undef SLOAD_F
#undef SWRITE_KF
#undef SWRITE_VF

}
#define GAS __attribute__((address_space(1)))
#define LAS __attribute__((address_space(3)))
typedef GAS unsigned gu32;
typedef GAS unsigned long long gu64;
#define RLX_AGENT __ATOMIC_RELAXED, __HIP_MEMORY_SCOPE_AGENT
#define LDS_WAIT() asm volatile("s_waitcnt lgkmcnt(0)" ::: "memory")
#define VM_WAIT() asm volatile("s_waitcnt vmcnt(0)" ::: "memory")
__device__ __forceinline__ unsigned long long rt() { return __builtin_amdgcn_s_memrealtime(); }
#define XB_TMO      128
#define XB_XCNT(j)  (256  + 64 * (j))
#define XB_XSUB(j)  (1280 + 64 * (j))
#define XB_XGEN(j)  (2304 + 64 * (j))
#define XB_TOP      3328
#define XB_TOPGEN   3392
#define XCD_BAR_WORDS 3456
#define XB_SPIN_CAP (1u << 18)

__device__ __forceinline__ unsigned xb_ld(unsigned* p)              { return __hip_atomic_load(p, __ATOMIC_RELAXED, __HIP_MEMORY_SCOPE_AGENT); }
__device__ __forceinline__ unsigned xb_add(unsigned* p, unsigned v) { return __hip_atomic_fetch_add(p, v, __ATOMIC_RELAXED, __HIP_MEMORY_SCOPE_AGENT); }
__device__ __forceinline__ unsigned xb_xcc_id() { return (unsigned)__builtin_amdgcn_s_getreg((3 << 11) | 20) & 0xFu; }
#define XB_SPIN(cond, bar) do { unsigned _sp = 0; while (cond) { __builtin_amdgcn_s_sleep(1); \
    if ((++_sp & 255u) == 0u) { if (xb_ld(&(bar)[XB_TMO])) break; if (_sp > XB_SPIN_CAP) { atomicAdd(&(bar)[XB_TMO], 1u); break; } } } } while (0)

struct XcdBarrier {
    unsigned* bar; unsigned x;
    volatile LAS unsigned* st;
};

__device__ __forceinline__ XcdBarrier xcd_barrier_post(unsigned* bar, volatile LAS unsigned* st) {
    XcdBarrier b; b.bar = bar; b.x = xb_xcc_id(); b.st = st;
    if (threadIdx.x == 0) (void)xb_add(&bar[XB_XCNT(b.x)], 1u);
    return b;
}
__device__ __forceinline__ void xcd_barrier_complete(unsigned* bar, unsigned x, unsigned& nloc, unsigned& nx) {
    const unsigned G = gridDim.x * gridDim.y * gridDim.z;
    unsigned sum, cnt, mine, sp = 0u;
    for (;;) {
        sum = 0u; cnt = 0u; mine = 0u;
#pragma unroll
        for (unsigned j = 0; j < 16; ++j) { const unsigned c = xb_ld(&bar[XB_XCNT(j)]); sum += c; cnt += (c > 0u) ? 1u : 0u; mine = (j == x) ? c : mine; }
        if (sum == G) break;
        __builtin_amdgcn_s_sleep(1);
        if ((++sp & 255u) == 0u) { if (xb_ld(&bar[XB_TMO])) break; if (sp > XB_SPIN_CAP) { atomicAdd(&bar[XB_TMO], 1u); break; } }
    }
    nloc = mine > 0u ? mine : 1u; nx = cnt > 0u ? cnt : 1u;
}

__device__ __forceinline__ void xcd_barrier(const XcdBarrier& b) {
    asm volatile("s_waitcnt vmcnt(0)" ::: "memory");
    __syncthreads();
    if (threadIdx.x == 0) {
        unsigned* bar = b.bar;
        __builtin_amdgcn_s_waitcnt(0);
        unsigned nloc = b.st[0], nx = b.st[1];
        if (nloc == 0u) { xcd_barrier_complete(bar, b.x, nloc, nx); b.st[0] = nloc; b.st[1] = nx; }
        const unsigned old = xb_add(&bar[XB_XSUB(b.x)], 1u);
        const unsigned gen = old / nloc;
        if (old + 1u == (gen + 1u) * nloc) {
            __builtin_amdgcn_fence(__ATOMIC_RELEASE, "agent");
            asm volatile("s_waitcnt vmcnt(0)" ::: "memory");
            const unsigned og = xb_add(&bar[XB_TOP], 1u);
            const unsigned tg = og / nx;
            if (og + 1u == (tg + 1u) * nx) xb_add(&bar[XB_TOPGEN], 1u);
            else XB_SPIN(xb_ld(&bar[XB_TOPGEN]) == tg, bar);
            __builtin_amdgcn_fence(__ATOMIC_ACQUIRE, "agent");
            xb_add(&bar[XB_XGEN(b.x)], 1u);
            asm volatile("s_waitcnt vmcnt(0)" ::: "memory");
        } else {
            XB_SPIN(xb_ld(&bar[XB_XGEN(b.x)]) == gen, bar);
            __builtin_amdgcn_fence(__ATOMIC_ACQUIRE, "agent");
            asm volatile("s_waitcnt vmcnt(0)" ::: "memory");
        }
    }
    __syncthreads();
}

typedef unsigned short u16;
typedef float f32x4 __attribute__((ext_vector_type(4)));
typedef unsigned u32x4 __attribute__((ext_vector_type(4)));
typedef unsigned u32x2 __attribute__((ext_vector_type(2)));
typedef short bf16x8 __attribute__((ext_vector_type(8)));
constexpr int DM = 2048, TP = 8192, NBP = 4, NBS = 8, TS = 64, PAST = 2048, SKVS = PAST + TS;
constexpr int MP = NBP * TP, MS_ = NBS * TS, M = MP + MS_;
constexpr int DI = 4096, CD = 6144, NH = 64, DFF = 5504, DFF2 = 11008, NIN = 20560;
constexpr int NMOD = 12288;
constexpr float EPS = 1e-6f, LOG2E = 1.4426950408889634f;
constexpr int HALF_ROWS = 16640;
constexpr size_t O_YP = 0, O_YS = O_YP + (size_t)MP * DM, O_KP = O_YS + (size_t)MS_ * DM, O_VP = O_KP + (size_t)MP * DM,
    O_LFP = O_VP + (size_t)MP * DM, O_SSMP = O_LFP + (size_t)MP * 16, O_MCP = O_SSMP + (size_t)NBP * 64 * 64 * 128, O_FCP = O_MCP + (size_t)NBP * 3 * CD,
    O_KS = O_FCP + (size_t)NBP * 2 * DFF2, O_VS = O_KS + (size_t)MS_ * DM, O_LFS = O_VS + (size_t)MS_ * DM, O_SSMS = O_LFS + (size_t)MS_ * 16,
    O_MCS = O_SSMS + (size_t)NBS * 64 * 64 * 128, O_FCS = O_MCS + (size_t)NBS * 3 * CD, O_END = O_FCS + (size_t)NBS * 2 * DFF2;
constexpr size_t MiB = 1u << 20;
constexpr size_t W_MOD = 0, W_BAR = 768 * 1024  , W_BIASP = 1 * MiB, W_BIASS = 3 * MiB, W_HALO = 5 * MiB,
    W_WUP = 8 * MiB, W_WDN = 51 * MiB, W_H = 73 * MiB, W_WIN = 203 * MiB, W_WPM = 284 * MiB, W_WPF = 300 * MiB, W_WOUT = 308 * MiB,
    W_SMALL = 316 * MiB, W_R = 349 * MiB,
    W_XBC = W_R, W_Z = W_R + 390 * MiB, W_GM = W_R, W_GF = W_R + 130 * MiB, W_Q = W_R + 260 * MiB, W_K = W_Q + 130 * MiB, W_V = W_K + 130 * MiB,
    W_U = 203 * MiB, W_G = 553 * MiB, W_END = 999 * MiB;
static_assert((size_t)M * DM * 2 == 130 * MiB && (size_t)M * CD * 2 == 390 * MiB && (size_t)M * DI * 2 == 260 * MiB, "sizes");
static_assert(W_U + (size_t)HALF_ROWS * DFF2 * 2 <= W_G && W_G + (size_t)M * DFF * 2 <= 1024 * MiB, "ffn map");
static_assert(W_SMALL + (size_t)M * 256 * 4 <= W_R, "small map");

struct Prm { const float* in[31]; float* out; unsigned char* ws; };
typedef const __attribute__((address_space(4))) Prm* KPrm;
struct Ctx { int tid, bid, G; };
enum { I_XP = 0, I_XS, I_CP, I_CS, I_CK, I_CV, I_CLF, I_SSM, I_MCV, I_FCV, I_N1W, I_N2W, I_WADA, I_BADA, I_WIN, I_MCW, I_MCB, I_DTB, I_ALOG, I_MD, I_MNW,
       I_FB, I_QNW, I_KNW, I_WPM, I_WPF, I_WOUT, I_WUP, I_FCW, I_FCB, I_WDN };

__device__ __forceinline__ float bflo(unsigned w) { return __uint_as_float(w << 16); }
__device__ __forceinline__ float bfhi(unsigned w) { return __uint_as_float(w & 0xffff0000u); }
typedef float f32x2_t __attribute__((ext_vector_type(2))); typedef __bf16 bf16x2_t __attribute__((ext_vector_type(2)));
__device__ __forceinline__ unsigned pk2(float lo, float hi) { f32x2_t v = {lo, hi}; bf16x2_t b = __builtin_convertvector(v, bf16x2_t); return __builtin_bit_cast(unsigned, b); }
__device__ __forceinline__ u16 f2bf(float f) { return (u16)(pk2(f, 0.f) & 0xffffu); }
__device__ __forceinline__ void unpack8(u32x4 w, float* v) { v[0] = bflo(w.x); v[1] = bfhi(w.x); v[2] = bflo(w.y); v[3] = bfhi(w.y); v[4] = bflo(w.z); v[5] = bfhi(w.z); v[6] = bflo(w.w); v[7] = bfhi(w.w); }
__device__ __forceinline__ u32x4 pack8f(const float* v) { u32x4 w; w.x = pk2(v[0], v[1]); w.y = pk2(v[2], v[3]); w.z = pk2(v[4], v[5]); w.w = pk2(v[6], v[7]); return w; }
__device__ __forceinline__ float bfel(const u32x4& w, int e) { const unsigned x = w[e >> 1]; return (e & 1) ? bfhi(x) : bflo(x); }
__device__ __forceinline__ float sigmoidf_(float x) { return 1.f / (1.f + __expf(-x)); }
__device__ __forceinline__ float siluf_(float x) { return x / (1.f + __expf(-x)); }
__device__ __forceinline__ float wave_sum(float v) {
#pragma unroll
    for (int o = 1; o < 64; o <<= 1) v += __shfl_xor(v, o);
    return v;
}
__device__ __forceinline__ int mod_row(int row) { return row < MP ? (row >> 13) : 4 + ((row - MP) >> 6); }

struct Epi {
    static constexpr bool PERM = true, AFTER_DRAIN = false;
    int mode;
    u16* d0; u16* d1; u16* d2; int t1, t2, p0, p1, p2, f32seg2, vseg2; float* vout; u16* vslab;
    const float* xp; const float* xs; float* y; const float* mod; u16* gbuf; const u16* gf;
    __device__ __forceinline__ void operator()(const f32x4 (&acc)[2][2][4][2], const pg8::Unit& u, int wr, int wc, int fr, int fq) const {
        const int rl = u.pm * 256 + u.ho * 128 + wr * 64 + fr, cl = wc * 32 + 8 * fq;
        const int nai = u.half ? 1 : 2;
        if (mode == 0) {
            u16* base; int pitch, ct; bool f32o = false;
            if (u.pn < t1) { base = d0; pitch = p0; ct = u.pn; } else if (u.pn < t2) { base = d1; pitch = p1; ct = u.pn - t1; } else { base = d2; pitch = p2; ct = u.pn - t2; f32o = (f32seg2 != 0); }
            if (!f32o) {
#pragma unroll
                for (int ai = 0; ai < nai; ++ai)
#pragma unroll
                    for (int m = 0; m < 4; ++m) { u16* rp = base + (size_t)(rl + ai * 128 + m * 16) * pitch + ct * 256 + cl;
#pragma unroll
                        for (int bj = 0; bj < 2; ++bj) { const f32x4 v0 = acc[ai][bj][m][0], v1 = acc[ai][bj][m][1]; u32x4 w; w.x = pk2(v0[0], v0[1]); w.y = pk2(v0[2], v0[3]); w.z = pk2(v1[0], v1[1]); w.w = pk2(v1[2], v1[3]);
                            *(u32x4*)(rp + bj * 128) = w; } }
                if (vseg2 && u.pn >= t2) {
#pragma unroll
                    for (int ai = 0; ai < nai; ++ai)
#pragma unroll
                        for (int m = 0; m < 4; ++m) { const int row = rl + ai * 128 + m * 16; const int col = ct * 256 + cl;
                            float* vo = (row < MP) ? vout + (size_t)row * DM + col : vout + (O_VS - O_VP) + (size_t)(row - MP) * DM + col;
#pragma unroll
                            for (int bj = 0; bj < 2; ++bj) { __builtin_nontemporal_store(acc[ai][bj][m][0], (f32x4*)(vo + bj * 128)); __builtin_nontemporal_store(acc[ai][bj][m][1], (f32x4*)(vo + bj * 128 + 4)); }
                            if (row >= MP) { const int sb = (row - MP) >> 6, t = (row - MP) & 63; u16* sp = vslab + (size_t)(sb * SKVS + PAST + t) * DM + col;
#pragma unroll
                                for (int bj = 0; bj < 2; ++bj) { const f32x4 v0 = acc[ai][bj][m][0], v1 = acc[ai][bj][m][1]; u32x4 w; w.x = pk2(v0[0], v0[1]); w.y = pk2(v0[2], v0[3]); w.z = pk2(v1[0], v1[1]); w.w = pk2(v1[2], v1[3]);
                                    *(u32x4*)(sp + bj * 128) = w; } } }
                }
            } else {
                float* fb = (float*)base;
#pragma unroll
                for (int ai = 0; ai < nai; ++ai)
#pragma unroll
                    for (int m = 0; m < 4; ++m) { float* rp = fb + (size_t)(rl + ai * 128 + m * 16) * pitch + ct * 256 + cl;
#pragma unroll
                        for (int bj = 0; bj < 2; ++bj) { *(f32x4*)(rp + bj * 128) = acc[ai][bj][m][0]; *(f32x4*)(rp + bj * 128 + 4) = acc[ai][bj][m][1]; } }
            }
        } else if (mode == 1 || mode == 2) {
#pragma unroll
            for (int ai = 0; ai < nai; ++ai) {
                u32x4 gw[4][2], fw[4][2];
#pragma unroll
                for (int m = 0; m < 4; ++m) { const size_t off = (size_t)(rl + ai * 128 + m * 16) * DM + u.pn * 256 + cl;
#pragma unroll
                    for (int bj = 0; bj < 2; ++bj) { gw[m][bj] = *(const u32x4*)(gbuf + off + bj * 128); if (mode == 2) fw[m][bj] = *(const u32x4*)(gf + off + bj * 128); else fw[m][bj] = gw[m][bj]; } }
#pragma unroll
                for (int m = 0; m < 4; ++m) { const size_t off = (size_t)(rl + ai * 128 + m * 16) * DM + u.pn * 256 + cl;
#pragma unroll
                    for (int bj = 0; bj < 2; ++bj) { const f32x4 v0 = acc[ai][bj][m][0], v1 = acc[ai][bj][m][1];
                        float a[8] = {v0[0], v0[1], v0[2], v0[3], v1[0], v1[1], v1[2], v1[3]}, g[8], o[8];
                        unpack8(gw[m][bj], g);
                        if (mode == 1) {
#pragma unroll
                            for (int e = 0; e < 8; ++e) o[e] = sigmoidf_(g[e]) * a[e];
                        } else { float f[8]; unpack8(fw[m][bj], f);
#pragma unroll
                            for (int e = 0; e < 8; ++e) o[e] = g[e] + sigmoidf_(f[e]) * a[e]; }
                        *(u32x4*)(gbuf + off + bj * 128) = pack8f(o); } }
            }
        } else {
#pragma unroll
            for (int ai = 0; ai < nai; ++ai) {
                const int mb = (u.pm < 128) ? (u.pm >> 5) : (4 + (u.pm - 128) * 4 + u.ho * 2 + ai * 2 + wr);
                const float* gp = mod + (size_t)mb * NMOD + (mode == 3 ? 4096 : 10240) + u.pn * 256 + cl;
                f32x4 gv[2][2], pre[4][2][2];
#pragma unroll
                for (int m = 0; m < 4; ++m) { const int row = rl + ai * 128 + m * 16; const size_t off = (size_t)row * DM + u.pn * 256 + cl;
                    const float* xr = (mode == 3) ? ((row < MP) ? xp + off : xs + (off - (size_t)MP * DM)) : (const float*)(y + off);
#pragma unroll
                    for (int bj = 0; bj < 2; ++bj) { pre[m][bj][0] = *(const f32x4*)(xr + bj * 128); pre[m][bj][1] = *(const f32x4*)(xr + bj * 128 + 4); } }
#pragma unroll
                for (int bj = 0; bj < 2; ++bj) { gv[bj][0] = *(const f32x4*)(gp + bj * 128); gv[bj][1] = *(const f32x4*)(gp + bj * 128 + 4); }
#pragma unroll
                for (int m = 0; m < 4; ++m) { const int row = rl + ai * 128 + m * 16; const size_t off = (size_t)row * DM + u.pn * 256 + cl;
#pragma unroll
                    for (int bj = 0; bj < 2; ++bj) { *(f32x4*)(y + off + bj * 128) = pre[m][bj][0] + gv[bj][0] * acc[ai][bj][m][0]; *(f32x4*)(y + off + bj * 128 + 4) = pre[m][bj][1] + gv[bj][1] * acc[ai][bj][m][1]; } }
            }
        }
    }
};

__device__ __forceinline__ int map_in(int n) {
    if (n < 4096) return 6144 + n;
    if (n < 10240) return n - 4096;
    if (n < 10304) return 10240 + (n - 10240);
    if (n < 12352) return 14592 + (n - 10304);
    if (n < 14400) return 16640 + (n - 12352);
    if (n < 16448) return 18688 + (n - 14400);
    if (n < 16464) return 10304 + (n - 16448);
    if (n < 18512) return 10496 + (n - 16464);
    return 12544 + (n - 18512);
}
__device__ __forceinline__ int map_up(int n) { if (n < DFF) return (n >> 7) * 256 + (n & 127); const int f = n - DFF; return (f >> 7) * 256 + 128 + (f & 127); }
template <int MAP> __device__ __forceinline__ void tr_item(const float* __restrict__ W, int K, int N, u16* WT, float* scr, int item, int lane) {
    const int nblk = (N + 31) / 32, kb = item / nblk, nb = item % nblk, k0 = 64 * kb, n0 = 32 * nb;
    const int nn = n0 + (lane & 31);
    float tv[32];
#pragma unroll
    for (int i = 0; i < 32; ++i) { const int kk = 2 * i + (lane >> 5); tv[i] = (nn < N) ? W[(size_t)(k0 + kk) * N + nn] : 0.f; }
#pragma unroll
    for (int i = 0; i < 32; ++i) { const int kk = 2 * i + (lane >> 5); scr[kk * 33 + (lane & 31)] = tv[i]; }
    asm volatile("s_waitcnt lgkmcnt(0)" ::: "memory");
    const int c = lane & 7;
#pragma unroll
    for (int j = 0; j < 4; ++j) { const int n = (lane >> 3) + 8 * j; const float* s = scr + (8 * c) * 33 + n;
        if (n0 + n < N) { const int row = (MAP == 1) ? map_in(n0 + n) : (MAP == 2) ? map_up(n0 + n) : (n0 + n);
            u32x4 o; o.x = pk2(s[0 * 33], s[1 * 33]); o.y = pk2(s[2 * 33], s[3 * 33]); o.z = pk2(s[4 * 33], s[5 * 33]); o.w = pk2(s[6 * 33], s[7 * 33]);
            *(u32x4*)(WT + (size_t)row * K + k0 + 8 * c) = o; } }
    asm volatile("s_waitcnt lgkmcnt(0)" ::: "memory");
}
__device__ __forceinline__ void phase_prep(KPrm p, const Ctx cx, unsigned char* lds) {
    const int tid = cx.tid, lane = tid & 63, wid = tid >> 6, G = cx.G;
    unsigned char* ws = p->ws;
    {
        float* scr = (float*)(lds + wid * 8448);
        const int gw = cx.bid * 8 + wid, NGW = G * 8;
        constexpr int I_IN = 32 * 643, I_PM = 64 * 64, I_PF = 32 * 64, I_OUT = 32 * 64, I_UP = 32 * 344, I_DN = 86 * 64;
        constexpr int NIT = I_IN + I_PM + I_PF + I_OUT + I_UP + I_DN;
        for (int it = gw; it < NIT; it += NGW) {
            int r = it;
            if (r < I_IN) { tr_item<1>(p->in[I_WIN], DM, NIN, (u16*)(ws + W_WIN), scr, r, lane); continue; } r -= I_IN;
            if (r < I_PM) { tr_item<0>(p->in[I_WPM], DI, DM, (u16*)(ws + W_WPM), scr, r, lane); continue; } r -= I_PM;
            if (r < I_PF) { tr_item<0>(p->in[I_WPF], DM, DM, (u16*)(ws + W_WPF), scr, r, lane); continue; } r -= I_PF;
            if (r < I_OUT) { tr_item<0>(p->in[I_WOUT], DM, DM, (u16*)(ws + W_WOUT), scr, r, lane); continue; } r -= I_OUT;
            if (r < I_UP) { tr_item<2>(p->in[I_WUP], DM, DFF2, (u16*)(ws + W_WUP), scr, r, lane); continue; } r -= I_UP;
            tr_item<0>(p->in[I_WDN], DFF, DM, (u16*)(ws + W_WDN), scr, r, lane);
        }
    }
    __syncthreads();
    {
        float* sl = (float*)lds;
        float* red = (float*)(lds + 12 * 2048 * 4);
        for (int e = tid; e < 12 * 2048; e += 512) { const int b = e >> 11, i = e & 2047; const float cv = (b < 4) ? p->in[I_CP][b * 2048 + i] : p->in[I_CS][(b - 4) * 2048 + i]; sl[e] = siluf_(cv); }
        __syncthreads();
        const float* wada = p->in[I_WADA]; float* mod = (float*)(ws + W_MOD);
        const int col = tid & 31, part = tid >> 5;
        for (int item = cx.bid; item < NMOD / 32; item += G) {
            float acc[12];
#pragma unroll
            for (int b = 0; b < 12; ++b) acc[b] = 0.f;
            const float* wp = wada + (size_t)(part * 128) * NMOD + item * 32 + col;
#pragma unroll 8
            for (int d = 0; d < 128; ++d) { const float w = wp[(size_t)d * NMOD];
#pragma unroll
                for (int b = 0; b < 12; ++b) acc[b] += sl[b * 2048 + part * 128 + d] * w; }
#pragma unroll
            for (int b = 0; b < 12; ++b) red[(part * 12 + b) * 32 + col] = acc[b];
            __syncthreads();
            if (tid < 384) { const int b = tid >> 5; float s = p->in[I_BADA][item * 32 + col];
#pragma unroll
                for (int q = 0; q < 16; ++q) s += red[(q * 12 + b) * 32 + col];
                mod[b * NMOD + item * 32 + col] = s; }
            __syncthreads();
        }
    }
    {
        u16* Ks = (u16*)p->out; u16* Vs = Ks + (size_t)NBS * SKVS * DM;
        const size_t tot8 = (size_t)NBS * PAST * DM / 8, gt = (size_t)cx.bid * 512 + tid, GT = (size_t)G * 512;
        for (size_t i0 = gt; i0 < 2 * tot8; i0 += 4 * GT) {
            f32x4 a[4], b[4]; size_t dsto[4]; bool ok[4]; int wh[4];
#pragma unroll
            for (int u = 0; u < 4; ++u) { const size_t i = i0 + (size_t)u * GT; ok[u] = i < 2 * tot8; const size_t ii = ok[u] ? i : 0; wh[u] = ii >= tot8; const size_t j = ii - (wh[u] ? tot8 : 0);
                const size_t sb = j / ((size_t)PAST * 256), rem = j % ((size_t)PAST * 256), row = rem >> 8, c8 = rem & 255;
                const float* src = p->in[wh[u] ? I_CV : I_CK] + ((sb * PAST + row) * DM + c8 * 8);
                a[u] = *(const f32x4*)src; b[u] = *(const f32x4*)(src + 4); dsto[u] = (sb * SKVS + row) * DM + c8 * 8; }
#pragma unroll
            for (int u = 0; u < 4; ++u) if (ok[u]) { u32x4 o; o.x = pk2(a[u][0], a[u][1]); o.y = pk2(a[u][2], a[u][3]); o.z = pk2(b[u][0], b[u][1]); o.w = pk2(b[u][2], b[u][3]);
                *(u32x4*)((wh[u] ? Vs : Ks) + dsto[u]) = o; }
        }
    }
}
__device__ __forceinline__ void phase_norm(KPrm p, const Ctx cx, int which) {
    const int tid = cx.tid, lane = tid & 63, wid = tid >> 6;
    const int gw = cx.bid * 8 + wid, NGW = cx.G * 8;
    const float* mod = (const float*)(p->ws + W_MOD); u16* H = (u16*)(p->ws + W_H);
    const float* nw = p->in[which ? I_N2W : I_N1W];
    const int osh = which ? 6144 : 0, osc = which ? 8192 : 2048;
    for (int row0 = 2 * gw; row0 < M; row0 += 2 * NGW) {
        f32x4 v[2][8];
#pragma unroll
        for (int rr = 0; rr < 2; ++rr) { const int row = row0 + rr;
            const float* xr = which ? (p->out + (size_t)row * DM) : ((row < MP) ? p->in[I_XP] + (size_t)row * DM : p->in[I_XS] + (size_t)(row - MP) * DM);
#pragma unroll
            for (int j = 0; j < 8; ++j) v[rr][j] = ((const f32x4*)xr)[lane + 64 * j]; }
#pragma unroll
        for (int rr = 0; rr < 2; ++rr) { const int row = row0 + rr;
            const float* mr = mod + (size_t)mod_row(row) * NMOD;
            float ss = 0.f;
#pragma unroll
            for (int j = 0; j < 8; ++j) ss += (v[rr][j][0] * v[rr][j][0] + v[rr][j][1] * v[rr][j][1]) + (v[rr][j][2] * v[rr][j][2] + v[rr][j][3] * v[rr][j][3]);
            const float rs = rsqrtf(wave_sum(ss) * (1.f / DM) + EPS);
#pragma unroll
            for (int j = 0; j < 8; ++j) { const int col = 4 * (lane + 64 * j);
                const f32x4 w = *(const f32x4*)(nw + col), sc = *(const f32x4*)(mr + osc + col), sh = *(const f32x4*)(mr + osh + col);
                const f32x4 o = v[rr][j] * rs * w * (sc + 1.f) + sh;
                u32x2 q; q.x = pk2(o[0], o[1]); q.y = pk2(o[2], o[3]);
                *(u32x2*)(H + (size_t)row * DM + col) = q; } }
    }
}
__device__ __forceinline__ void phase_conv(KPrm p, const Ctx cx) {
    const u16* XBC = (const u16*)(p->ws + W_XBC); u16* ACT = (u16*)(p->out + O_KP);
    const float* cw = p->in[I_MCW]; const float* cb = p->in[I_MCB];
    {
                const int gt2 = cx.bid * 512 + cx.tid, GT2 = cx.G * 512;
        for (int i = gt2; i < 12 * 3 * CD; i += GT2) { const int bb = i / (3 * CD), r = (i / CD) % 3, c = i % CD;
            if (bb < 4) p->out[O_MCP + i] = bflo(XBC[(size_t)(bb * TP + TP - 3 + r) * CD + c]);
            else p->out[O_MCS + (i - 4 * 3 * CD)] = bflo(XBC[(size_t)(MP + (bb - 4) * TS + TS - 3 + r) * CD + c]); }
    }
    constexpr int NCG = CD / 8, RB = 16, NRB = M / RB;
    const long gt = (long)cx.bid * 512 + cx.tid, GT = (long)cx.G * 512;
    for (long it = gt; it < (long)NCG * NRB; it += GT) {
        const int cgi = (int)(it % NCG), rb = (int)(it / NCG), c0 = cgi * 8, r0 = rb * RB;
        float w[4][8], bs[8];
#pragma unroll
        for (int j = 0; j < 4; ++j) { const f32x4 a0 = *(const f32x4*)(cw + j * CD + c0), a1 = *(const f32x4*)(cw + j * CD + c0 + 4);
#pragma unroll
            for (int e = 0; e < 4; ++e) { w[j][e] = a0[e]; w[j][4 + e] = a1[e]; } }
        { const f32x4 a0 = *(const f32x4*)(cb + c0), a1 = *(const f32x4*)(cb + c0 + 4);
#pragma unroll
          for (int e = 0; e < 4; ++e) { bs[e] = a0[e]; bs[4 + e] = a1[e]; } }
        float h[3][8];
        const bool smp = r0 >= MP; const int tb = smp ? ((r0 - MP) & 63) : (r0 & (TP - 1));
        if (tb == 0) {
            if (smp) { const float* s = p->in[I_MCV] + (size_t)((r0 - MP) >> 6) * 3 * CD + c0;
#pragma unroll
                for (int k = 0; k < 3; ++k)
#pragma unroll
                    for (int e = 0; e < 8; ++e) h[k][e] = s[k * CD + e];
            } else {
#pragma unroll
                for (int k = 0; k < 3; ++k)
#pragma unroll
                    for (int e = 0; e < 8; ++e) h[k][e] = 0.f; }
        } else {
#pragma unroll
            for (int k = 0; k < 3; ++k) unpack8(*(const u32x4*)(XBC + (size_t)(r0 - 3 + k) * CD + c0), h[k]);
        }
        u32x4 ur[RB];
#pragma unroll
        for (int i = 0; i < RB; ++i) ur[i] = *(const u32x4*)(XBC + (size_t)(r0 + i) * CD + c0);
#pragma unroll
        for (int i = 0; i < RB; ++i) { float u[8], o[8]; unpack8(ur[i], u);
#pragma unroll
            for (int e = 0; e < 8; ++e) { const float v = bs[e] + w[0][e] * h[0][e] + w[1][e] * h[1][e] + w[2][e] * h[2][e] + w[3][e] * u[e];
                o[e] = siluf_(v); h[0][e] = h[1][e]; h[1][e] = h[2][e]; h[2][e] = u[e]; }
            *(u32x4*)(ACT + (size_t)(r0 + i) * CD + c0) = pack8f(o); }
    }
}
constexpr int SXP = 72, SNP = 136, SYP = 68;
constexpr int L_XT = 0, L_CN = L_XT + 64 * SXP * 2, L_BN = L_CN + 64 * SNP * 2, L_BWT = L_BN + 64 * SNP * 2, L_MS = L_BWT + 128 * SXP * 2, L_HS = L_MS + 64 * SXP * 2,
              L_YS = L_HS + 64 * SNP * 2, L_DT = L_YS + 64 * SYP * 4, L_CUM = L_DT + 256, L_SSD_END = L_CUM + 256;
static_assert(L_SSD_END <= 131072, "ssd lds");
__device__ __forceinline__ void phase_ssd(KPrm p, const Ctx cx, unsigned char* lds) {
    const int tid = cx.tid, lane = tid & 63, wid = __builtin_amdgcn_readfirstlane(tid >> 6), quad = lane >> 4, l15 = lane & 15;
    u16* XT = (u16*)(lds + L_XT); u16* CN = (u16*)(lds + L_CN); u16* BN = (u16*)(lds + L_BN); u16* BWT = (u16*)(lds + L_BWT);
    u16* MSm = (u16*)(lds + L_MS); u16* HS = (u16*)(lds + L_HS); float* YS = (float*)(lds + L_YS); float* DT = (float*)(lds + L_DT); float* CUM = (float*)(lds + L_CUM);
    const u16* XBC = (const u16*)(p->out + O_KP);     u16* Z = (u16*)(p->ws + W_Z); const float* SM = (const float*)(p->ws + W_SMALL);
    const int cg8 = tid & 31, tq = tid >> 5, cgx = tid & 7, tx = tid >> 3;
    const int pb = wid >> 1;
    for (int ch = cx.bid; ch < 256 + 512; ch += cx.G) {
        const bool smp = ch >= 256; int b, hd, nc; long rowbase;
        if (!smp) { b = ch >> 6; hd = ch & 63; nc = TP / 64; rowbase = (long)b * TP; } else { const int su = ch - 256; b = su >> 6; hd = su & 63; nc = 1; rowbase = MP + (long)b * TS; }
        const int g = hd >> 3;
        const float a_h = -__expf(p->in[I_ALOG][hd]), dtb = p->in[I_DTB][hd], Dh = p->in[I_MD][hd];
        const int bccol = (cg8 < 16) ? (4096 + g * 128 + cg8 * 8) : (5120 + g * 128 + (cg8 - 16) * 8);
        const int xcol = hd * 64 + cgx * 8;
        f32x4 st[4];
        const int st_off = (pb * 16 + quad * 4) * 128 + (4 * (wid & 1)) * 16 + l15, hs_off = (pb * 16 + quad * 4) * SNP + (4 * (wid & 1)) * 16 + l15;
        { const float* sin_ = p->in[I_SSM] + ((size_t)b * 64 + hd) * 64 * 128 + st_off;
#pragma unroll
          for (int i = 0; i < 4; ++i)
#pragma unroll
            for (int j = 0; j < 4; ++j) st[i][j] = smp ? sin_[j * 128 + i * 16] : 0.f; }
        __syncthreads();
        { u16* hp_ = HS + hs_off;
#pragma unroll
          for (int i = 0; i < 4; ++i)
#pragma unroll
            for (int j = 0; j < 4; ++j) hp_[j * SNP + i * 16] = f2bf(st[i][j]); }
        u32x4 rbcA[4], rxA, znA, rbcB[4], rxB, znB, pend = {0u, 0u, 0u, 0u}; float dtrA = 0.f, dtrB = 0.f;
#define SSD_LOADS(cc, rbc, rx, zn, dtr) do { const int t0_ = (cc) * 64; \
            const u16* pb_ = XBC + (rowbase + t0_ + 4 * tq) * (long)CD + bccol; const u16* px_ = XBC + (rowbase + t0_ + tx) * (long)CD + xcol; \
            asm volatile("" : "+v"(pb_), "+v"(px_));     \
            _Pragma("unroll") for (int i = 0; i < 4; ++i) rbc[i] = *(const u32x4*)(pb_ + i * CD); \
            rx = *(const u32x4*)px_; \
            zn = *(const u32x4*)(Z + (size_t)(rowbase + t0_ + tx) * DI + xcol); \
            dtr = SM[(size_t)(rowbase + t0_ + lane) * 256 + hd]; } while (0)
#define LBAR() do { asm volatile("s_waitcnt lgkmcnt(0)" ::: "memory"); __builtin_amdgcn_s_barrier(); asm volatile("" ::: "memory"); } while (0)
        SSD_LOADS(0, rbcA, rxA, znA, dtrA); if (nc > 1) SSD_LOADS(1, rbcB, rxB, znB, dtrB);
        auto body = [&](const int c, u32x4 (&rbc)[4], u32x4& rx, u32x4& zn, float& dtr) __attribute__((always_inline)) {
            const long r0 = rowbase + (long)c * 64;
            const u32x4 zw = zn;
            float cum_end;
            { const float dr = dtr + dtb; const float dtv = dr > 20.f ? dr : __logf(1.f + __expf(dr));
              float x = dtv * a_h;
#define DPP_ADD(ctrl, rmask) x += __int_as_float(__builtin_amdgcn_update_dpp(0, __float_as_int(x), ctrl, rmask, 0xf, true))
              DPP_ADD(0x111, 0xf); DPP_ADD(0x112, 0xf); DPP_ADD(0x114, 0xf); DPP_ADD(0x118, 0xf);
              DPP_ADD(0x142, 0xa);
              DPP_ADD(0x143, 0xc);
#undef DPP_ADD
              DT[lane] = dtv; CUM[lane] = x; cum_end = __int_as_float(__builtin_amdgcn_readlane(__float_as_int(x), 63)); }
            {
                u16* NAT = (cg8 < 16) ? BN : CN; const int nc0 = (cg8 & 15) * 8;
#pragma unroll
                for (int ii = 0; ii < 4; ++ii) *(u32x4*)(NAT + (4 * tq + ii) * SNP + nc0) = rbc[ii];
                if (cg8 < 16) {
                    float wg[4]; const f32x4 dt4 = *(const f32x4*)(DT + 4 * tq), cu4 = *(const f32x4*)(CUM + 4 * tq);
#pragma unroll
                    for (int ii = 0; ii < 4; ++ii) wg[ii] = dt4[ii] * __expf(cum_end - cu4[ii]);
#pragma unroll
                    for (int e = 0; e < 8; ++e) { u32x2 q; q.x = pk2(bfel(rbc[0], e) * wg[0], bfel(rbc[1], e) * wg[1]); q.y = pk2(bfel(rbc[2], e) * wg[2], bfel(rbc[3], e) * wg[3]);
                        *(u32x2*)(BWT + (nc0 + e) * SXP + ((((tq >> 1) ^ (cg8 & 7)) << 3) + ((tq & 1) << 2))) = q; }
                }
            }
            float xv[8]; unpack8(rx, xv);
#pragma unroll
            for (int e = 0; e < 8; ++e) XT[(cgx * 8 + e) * SXP + ((((tx >> 3) ^ cgx) << 3) + (tx & 7))] = (u16)((e & 1) ? (rx[e >> 1] >> 16) : (rx[e >> 1] & 0xffffu));
            LBAR();
            if (c > 0) *(u32x4*)(Z + (size_t)(r0 - 64 + tx) * DI + xcol) = pend;
            if (c + 2 < nc) SSD_LOADS(c + 2, rbc, rx, zn, dtr);
            const int ti = wid >> 1;
            f32x4 yo[2];
            {
                bf16x8 ca[4], bb[2][4], hb[2][4];
#pragma unroll
                for (int kk = 0; kk < 4; ++kk) ca[kk] = *(const bf16x8*)(CN + (ti * 16 + l15) * SNP + kk * 32 + quad * 8);
#pragma unroll
                for (int s2 = 0; s2 < 2; ++s2)
#pragma unroll
                    for (int kk = 0; kk < 4; ++kk) { bb[s2][kk] = *(const bf16x8*)(BN + ((2 * (wid & 1) + s2) * 16 + l15) * SNP + kk * 32 + quad * 8);
                        hb[s2][kk] = *(const bf16x8*)(HS + ((2 * (wid & 1) + s2) * 16 + l15) * SNP + kk * 32 + quad * 8); }
                const f32x4 ct4 = *(const f32x4*)(CUM + ti * 16 + quad * 4);
                float cs[2], ds[2];
#pragma unroll
                for (int s2 = 0; s2 < 2; ++s2) { const int sx = (2 * (wid & 1) + s2) * 16 + l15; cs[s2] = CUM[sx]; ds[s2] = DT[sx]; }
                f32x4 ga[2] = {{0.f, 0.f, 0.f, 0.f}, {0.f, 0.f, 0.f, 0.f}}; yo[0] = (f32x4){0.f, 0.f, 0.f, 0.f}; yo[1] = (f32x4){0.f, 0.f, 0.f, 0.f};
#pragma unroll
                for (int kk = 0; kk < 4; ++kk) {
                    ga[0] = __builtin_amdgcn_mfma_f32_16x16x32_bf16(ca[kk], bb[0][kk], ga[0], 0, 0, 0); ga[1] = __builtin_amdgcn_mfma_f32_16x16x32_bf16(ca[kk], bb[1][kk], ga[1], 0, 0, 0);
                    yo[0] = __builtin_amdgcn_mfma_f32_16x16x32_bf16(ca[kk], hb[0][kk], yo[0], 0, 0, 0); yo[1] = __builtin_amdgcn_mfma_f32_16x16x32_bf16(ca[kk], hb[1][kk], yo[1], 0, 0, 0); }
#pragma unroll
                for (int s2 = 0; s2 < 2; ++s2) { const int s_ = (2 * (wid & 1) + s2) * 16 + l15;
#pragma unroll
                    for (int j = 0; j < 4; ++j) { const int t = ti * 16 + quad * 4 + j; const float msk = (s_ <= t) ? ds[s2] : 0.f;
                        const float val = ga[s2][j] * __expf(fminf(ct4[j] - cs[s2], 0.f)) * msk; MSm[t * SXP + s_] = f2bf(val); } }
#pragma unroll
                for (int p2 = 0; p2 < 2; ++p2)
#pragma unroll
                    for (int j = 0; j < 4; ++j) yo[p2][j] *= __expf(ct4[j]);
            }
            LBAR();
            {
                bf16x8 ma[2], xa[2], xb[2][2], wb[4][2];
#pragma unroll
                for (int kk = 0; kk < 2; ++kk) { ma[kk] = *(const bf16x8*)(MSm + (ti * 16 + l15) * SXP + kk * 32 + quad * 8); xa[kk] = *(const bf16x8*)(XT + (pb * 16 + l15) * SXP + (((kk * 4 + quad) ^ ((pb * 2 + (l15 >> 3)) & 7)) << 3));
#pragma unroll
                    for (int p2 = 0; p2 < 2; ++p2) xb[p2][kk] = *(const bf16x8*)(XT + ((2 * (wid & 1) + p2) * 16 + l15) * SXP + (((kk * 4 + quad) ^ (((2 * (wid & 1) + p2) * 2 + (l15 >> 3)) & 7)) << 3));
#pragma unroll
                    for (int i = 0; i < 4; ++i) wb[i][kk] = *(const bf16x8*)(BWT + ((4 * (wid & 1) + i) * 16 + l15) * SXP + (((kk * 4 + quad) ^ (((4 * (wid & 1) + i) * 2 + (l15 >> 3)) & 7)) << 3)); }
                const float dec = __expf(cum_end);
#pragma unroll
                for (int i = 0; i < 4; ++i) st[i] = st[i] * dec;
#pragma unroll
                for (int kk = 0; kk < 2; ++kk) {
                    yo[0] = __builtin_amdgcn_mfma_f32_16x16x32_bf16(ma[kk], xb[0][kk], yo[0], 0, 0, 0); yo[1] = __builtin_amdgcn_mfma_f32_16x16x32_bf16(ma[kk], xb[1][kk], yo[1], 0, 0, 0);
#pragma unroll
                    for (int i = 0; i < 4; ++i) st[i] = __builtin_amdgcn_mfma_f32_16x16x32_bf16(xa[kk], wb[i][kk], st[i], 0, 0, 0); }
#pragma unroll
                for (int p2 = 0; p2 < 2; ++p2)
#pragma unroll
                    for (int j = 0; j < 4; ++j) YS[(ti * 16 + quad * 4 + j) * SYP + (2 * (wid & 1) + p2) * 16 + l15] = yo[p2][j];
                u16* hp_ = HS + hs_off;
#pragma unroll
                for (int i = 0; i < 4; ++i)
#pragma unroll
                    for (int j = 0; j < 4; ++j) hp_[j * SNP + i * 16] = f2bf(st[i][j]);
            }
            LBAR();
            {
                const f32x4 y0 = *(const f32x4*)(YS + tx * SYP + cgx * 8), y1 = *(const f32x4*)(YS + tx * SYP + cgx * 8 + 4);
                float zf[8], o[8]; unpack8(zw, zf);
#pragma unroll
                for (int e = 0; e < 8; ++e) { const float yv = (e < 4 ? y0[e & 3] : y1[e & 3]) + Dh * xv[e]; o[e] = yv * siluf_(zf[e]); }
                pend = pack8f(o);
            }
        };
        for (int c = 0; c < nc; c += 2) { body(c, rbcA, rxA, znA, dtrA); if (c + 1 < nc) body(c + 1, rbcB, rxB, znB, dtrB); }
        *(u32x4*)(Z + (size_t)(rowbase + (long)(nc - 1) * 64 + tx) * DI + xcol) = pend;
#undef SSD_LOADS
#undef LBAR
        float* so = p->out + (smp ? O_SSMS : O_SSMP) + ((size_t)b * 64 + hd) * 64 * 128 + st_off;
#pragma unroll
        for (int i = 0; i < 4; ++i)
#pragma unroll
            for (int j = 0; j < 4; ++j) so[j * 128 + i * 16] = st[i][j];
        __syncthreads();
    }
}
__device__ __forceinline__ float logsig_(float f) { return fminf(f, 0.f) - log1pf(__expf(-fabsf(f))); }
__device__ __forceinline__ void phase_gn(KPrm p, const Ctx cx) {
    const int tid = cx.tid, lane = tid & 63, wid = tid >> 6;
    const int gw = cx.bid * 8 + wid, NGW = cx.G * 8;
    const float* SM = (const float*)(p->ws + W_SMALL);
    if (gw < 192) {
        if (gw < 64) { const int b = gw >> 4, h = gw & 15; const float fb = p->in[I_FB][h];
            float* bias = (float*)(p->ws + W_BIASP) + (size_t)(b * 16 + h) * TP; float* lo = p->out + O_LFP;
            const int tb = lane * 128; float s = 0.f;
            for (int i = 0; i < 128; ++i) s += logsig_(SM[(size_t)(b * TP + tb + i) * 256 + 64 + h] + fb);
            float inc = s;
#pragma unroll
            for (int o = 1; o < 64; o <<= 1) { const float y = __shfl_up(inc, o); if (lane >= o) inc += y; }
            float run = inc - s;
            for (int i = 0; i < 128; ++i) { const float lf = logsig_(SM[(size_t)(b * TP + tb + i) * 256 + 64 + h] + fb); run += lf;
                lo[(size_t)(b * TP + tb + i) * 16 + h] = lf; bias[tb + i] = -run * LOG2E; }
        } else { const int u = gw - 64, sb = u >> 4, h = u & 15; const float fb = p->in[I_FB][h];
            float* bias = (float*)(p->ws + W_BIASS) + (size_t)(sb * 16 + h) * SKVS; float* lo = p->out + O_LFS;
            const int tb = lane * 33; float s = 0.f;
            for (int i = 0; i < 33; ++i) { const int pos = tb + i;
                s += (pos < PAST) ? p->in[I_CLF][(size_t)(sb * PAST + pos) * 16 + h] : logsig_(SM[(size_t)(MP + sb * TS + pos - PAST) * 256 + 64 + h] + fb); }
            float inc = s;
#pragma unroll
            for (int o = 1; o < 64; o <<= 1) { const float y = __shfl_up(inc, o); if (lane >= o) inc += y; }
            float run = inc - s;
            for (int i = 0; i < 33; ++i) { const int pos = tb + i; float lf;
                if (pos < PAST) lf = p->in[I_CLF][(size_t)(sb * PAST + pos) * 16 + h];
                else { lf = logsig_(SM[(size_t)(MP + sb * TS + pos - PAST) * 256 + 64 + h] + fb); lo[(size_t)(sb * TS + pos - PAST) * 16 + h] = lf; }
                run += lf; bias[pos] = -run * LOG2E; }
        }
    }
    u16* Z = (u16*)(p->ws + W_Z); const float* mnw = p->in[I_MNW];
    for (int row = gw; row < M; row += NGW) {
        u32x4 zr[8];
#pragma unroll
        for (int i = 0; i < 8; ++i) zr[i] = *(const u32x4*)(Z + (size_t)row * DI + i * 512 + lane * 8);
#pragma unroll
        for (int i = 0; i < 8; ++i) { const int col = i * 512 + lane * 8; u16* zp = Z + (size_t)row * DI + col;
            float v[8]; unpack8(zr[i], v); float ss = 0.f;
#pragma unroll
            for (int e = 0; e < 8; ++e) ss += v[e] * v[e];
            const float rs = rsqrtf(wave_sum(ss) * (1.f / 512.f) + EPS);
            const f32x4 w0 = *(const f32x4*)(mnw + col), w1 = *(const f32x4*)(mnw + col + 4);
#pragma unroll
            for (int e = 0; e < 8; ++e) v[e] = v[e] * rs * (e < 4 ? w0[e & 3] : w1[e & 3]);
            *(u32x4*)zp = pack8f(v); }
    }
}
__device__ __forceinline__ void phase_qk(KPrm p, const Ctx cx) {
    const int tid = cx.tid, lane = tid & 63, wid = tid >> 6;
    const int gw = cx.bid * 8 + wid, NGW = cx.G * 8;
    u16* K = (u16*)(p->ws + W_K);
    u16* Ks = (u16*)p->out;
    const int hc = (lane & 15) * 8;
    const f32x4 kw0 = *(const f32x4*)(p->in[I_KNW] + hc), kw1 = *(const f32x4*)(p->in[I_KNW] + hc + 4);
    for (int row = gw; row < M; row += NGW) {
        const bool smp = row >= MP;
        float* ko = smp ? p->out + O_KS + (size_t)(row - MP) * DM : p->out + O_KP + (size_t)row * DM;
        size_t srow = 0; if (smp) { const int sb = (row - MP) >> 6, t = (row - MP) & 63; srow = (size_t)(sb * SKVS + PAST + t) * DM; }
        u32x4 kr_[4];
#pragma unroll
        for (int it = 0; it < 4; ++it) { const size_t off = (size_t)row * DM + it * 512 + lane * 8; kr_[it] = *(const u32x4*)(K + off); }
#pragma unroll
        for (int it = 0; it < 4; ++it) { const int col = it * 512 + lane * 8; const size_t off = (size_t)row * DM + col;
            float v[8], ss;
            unpack8(kr_[it], v); ss = 0.f;
#pragma unroll
            for (int e = 0; e < 8; ++e) ss += v[e] * v[e];
            ss += __shfl_xor(ss, 1); ss += __shfl_xor(ss, 2); ss += __shfl_xor(ss, 4); ss += __shfl_xor(ss, 8);
            const float rs = rsqrtf(ss * (1.f / 128.f) + EPS);
#pragma unroll
            for (int e = 0; e < 8; ++e) v[e] = v[e] * rs * (e < 4 ? kw0[e & 3] : kw1[e & 3]);
            const u32x4 kp = pack8f(v);
            *(u32x4*)(K + off) = kp;
            __builtin_nontemporal_store((f32x4){v[0], v[1], v[2], v[3]}, (f32x4*)(ko + col)); __builtin_nontemporal_store((f32x4){v[4], v[5], v[6], v[7]}, (f32x4*)(ko + col + 4));
            if (smp) *(u32x4*)(Ks + srow + col) = kp; }
    }
}
typedef att::BlockRef<att::bf16, att::bf16> ARef;
__device__ __forceinline__ ARef att_ref(KPrm p, const Ctx cx, int i, int nbp, int& skv) {
    const int G = cx.G, bid = (cx.G % 8 == 0) ? (cx.bid % 8) * (cx.G / 8) + cx.bid / 8 : cx.bid; ARef r;
    att::bf16* Qb = (att::bf16*)(p->ws + W_Q); const att::bf16* Kb = (const att::bf16*)(p->ws + W_K); const att::bf16* Vb = (const att::bf16*)(p->ws + W_V);
    if (i < nbp) { const int L = bid + (i >> 1) * G, bh = L >> 4, x = L & 15, b = bh >> 4, h = bh & 15;
        int qb; if (G == 256) { qb = (x < 8) ? ((i & 1) ? 30 - 2 * x : 2 * x) : ((i & 1) ? 31 - 2 * (x - 8) : 2 * (x - 8) + 1); }
        else qb = (i & 1) ? 31 - x : x;
        const size_t rq = ((size_t)b * TP + (size_t)qb * 256) * DM + h * 128, rk = (size_t)b * TP * DM + h * 128;
        r.Q = Qb + rq; r.O = Qb + rq; r.K = Kb + rk; r.V = Vb + rk; r.Bs = (const float*)(p->ws + W_BIASP) + (size_t)bh * TP; r.P0 = qb * 256; r.nvalid = 256; skv = TP;
    } else { const int su = (G == 256) ? ((bid >> 4) * 8 + (bid & 15)) : bid + (i - nbp) * G, sb = su >> 4, h = su & 15;
        const att::bf16* Ks = (const att::bf16*)p->out; const att::bf16* Vs = Ks + (size_t)NBS * SKVS * DM;
        const size_t rq = ((size_t)MP + (size_t)sb * TS) * DM + h * 128, rk = (size_t)sb * SKVS * DM + h * 128;
        r.Q = Qb + rq; r.O = Qb + rq; r.K = Ks + rk; r.V = Vs + rk; r.Bs = (const float*)(p->ws + W_BIASS) + (size_t)su * SKVS; r.P0 = PAST; r.nvalid = TS; skv = SKVS; }
    return r;
}
__device__ __forceinline__ void phase_att(KPrm p, const Ctx cx, char* lds) {
    const int G = cx.G, bid = (cx.G % 8 == 0) ? (cx.bid % 8) * (cx.G / 8) + cx.bid / 8 : cx.bid;
    const int nip = (bid < 1024) ? (1024 - bid + G - 1) / G : 0, nbp = 2 * nip, nbs = (G == 256) ? (((bid & 15) < 8) ? 1 : 0) : ((bid < 128) ? (128 - bid + G - 1) / G : 0), nb = nbp + nbs;
    if (nb == 0) return;
    const int W = 1 << 30;
    int skv, skvn; ARef cur = att_ref(p, cx, 0, nbp, skv);
    att::Seam<att::bf16> S;
    att::causal_swa_prime<att::bf16, att::bf16>(cur, W, lds, S, cx.tid);
    for (int i = 0; i < nb; ++i) {
        const bool last = (i + 1 == nb);
        ARef nxt = cur; skvn = skv; if (!last) nxt = att_ref(p, cx, i + 1, nbp, skvn);
        att::causal_swa_block<att::bf16, att::bf16>(cur, nxt, skv, W, lds, S, cx.tid, p->in[I_QNW], 0.08838834764831845f * LOG2E);
        cur = nxt; skv = skvn;
    }
}
__device__ __forceinline__ void phase_cv(KPrm p, const Ctx cx, int half) {
    const int tid = cx.tid;
    const u16* U = (const u16*)(p->ws + W_U); u16* Gb = (u16*)(p->ws + W_G); u16* HALO = (u16*)(p->ws + W_HALO);
    const float* cw = p->in[I_FCW]; const float* cb = p->in[I_FCB];
    const int row_lo = half ? HALF_ROWS : 0;
    constexpr int NCG = DFF / 8, RB = 16, NRB = HALF_ROWS / RB;
    const long gt = (long)cx.bid * 512 + tid, GT = (long)cx.G * 512;
    for (long it = gt; it < (long)NCG * NRB; it += GT) {
        const int cgi = (int)(it % NCG), rb = (int)(it / NCG); const int f0 = cgi * 8, r0 = row_lo + rb * RB;
        const int ca = (f0 >> 7) * 256 + (f0 & 127), cbb = ca + 128;
        float wa[3][8], wb[3][8], ba[8], bb[8];
#pragma unroll
        for (int k = 0; k < 3; ++k) { const f32x4 a0 = *(const f32x4*)(cw + k * DFF2 + f0), a1 = *(const f32x4*)(cw + k * DFF2 + f0 + 4), b0 = *(const f32x4*)(cw + k * DFF2 + DFF + f0), b1 = *(const f32x4*)(cw + k * DFF2 + DFF + f0 + 4);
#pragma unroll
            for (int e = 0; e < 4; ++e) { wa[k][e] = a0[e]; wa[k][4 + e] = a1[e]; wb[k][e] = b0[e]; wb[k][4 + e] = b1[e]; } }
        { const f32x4 a0 = *(const f32x4*)(cb + f0), a1 = *(const f32x4*)(cb + f0 + 4), b0 = *(const f32x4*)(cb + DFF + f0), b1 = *(const f32x4*)(cb + DFF + f0 + 4);
#pragma unroll
          for (int e = 0; e < 4; ++e) { ba[e] = a0[e]; ba[4 + e] = a1[e]; bb[e] = b0[e]; bb[4 + e] = b1[e]; } }
        float ha[2][8], hb[2][8];
        const bool smp = r0 >= MP; const int tb = smp ? ((r0 - MP) & 63) : (r0 & (TP - 1));
        if (tb == 0) {
            if (smp) { const float* s = p->in[I_FCV] + (size_t)((r0 - MP) >> 6) * 2 * DFF2;
#pragma unroll
                for (int k = 0; k < 2; ++k)
#pragma unroll
                    for (int e = 0; e < 8; ++e) { ha[k][e] = s[k * DFF2 + f0 + e]; hb[k][e] = s[k * DFF2 + DFF + f0 + e]; }
            } else {
#pragma unroll
                for (int k = 0; k < 2; ++k)
#pragma unroll
                    for (int e = 0; e < 8; ++e) { ha[k][e] = 0.f; hb[k][e] = 0.f; } }
        } else if (half && rb == 0) {
#pragma unroll
            for (int k = 0; k < 2; ++k) { unpack8(*(const u32x4*)(HALO + (size_t)k * DFF2 + ca), ha[k]); unpack8(*(const u32x4*)(HALO + (size_t)k * DFF2 + cbb), hb[k]); }
        } else {
#pragma unroll
            for (int k = 0; k < 2; ++k) { const size_t ro = (size_t)(r0 - row_lo - 2 + k) * DFF2; unpack8(*(const u32x4*)(U + ro + ca), ha[k]); unpack8(*(const u32x4*)(U + ro + cbb), hb[k]); }
        }
#pragma unroll 8
        for (int i = 0; i < RB; ++i) { const int r = r0 + i; const size_t ro = (size_t)(r - row_lo) * DFF2;
            const u32x4 uaw = *(const u32x4*)(U + ro + ca), ubw = *(const u32x4*)(U + ro + cbb);
            float ua[8], ub[8], o[8]; unpack8(uaw, ua); unpack8(ubw, ub);
#pragma unroll
            for (int e = 0; e < 8; ++e) { const float va = ba[e] + wa[0][e] * ha[0][e] + wa[1][e] * ha[1][e] + wa[2][e] * ua[e], vb = bb[e] + wb[0][e] * hb[0][e] + wb[1][e] * hb[1][e] + wb[2][e] * ub[e];
                o[e] = siluf_(va) * vb; ha[0][e] = ha[1][e]; ha[1][e] = ua[e]; hb[0][e] = hb[1][e]; hb[1][e] = ub[e]; }
            *(u32x4*)(Gb + (size_t)r * DFF + f0) = pack8f(o);
            const int tpos = (r >= MP) ? ((r - MP) & 63) : (r & (TP - 1)), tlen = (r >= MP) ? TS : TP;
            if (tpos >= tlen - 2) { float* fo = (r >= MP) ? p->out + O_FCS + ((size_t)((r - MP) >> 6) * 2 + (tpos - (tlen - 2))) * DFF2 : p->out + O_FCP + ((size_t)(r >> 13) * 2 + (tpos - (tlen - 2))) * DFF2;
#pragma unroll
                for (int e = 0; e < 8; ++e) { fo[f0 + e] = ua[e]; fo[DFF + f0 + e] = ub[e]; } }
            if (!half && r >= HALF_ROWS - 2) { *(u32x4*)(HALO + (size_t)(r - (HALF_ROWS - 2)) * DFF2 + ca) = uaw; *(u32x4*)(HALO + (size_t)(r - (HALF_ROWS - 2)) * DFF2 + cbb) = ubw; }
        }
    }
}
constexpr int LDS_TOTAL = 147456;
enum { PH_CONV = 100 };
enum { PH_PREP = 0, PH_N1, PH_G1A, PH_SSD, PH_GN, PH_G1B, PH_G2, PH_G1C, PH_QK, PH_ATT, PH_G3, PH_G4, PH_N2, PH_G5A, PH_CVA, PH_G5B, PH_CVB, PH_G6, PH_COUNT };
__device__ __forceinline__ void gsync(unsigned char* lds) {
    KPrm p0 = (KPrm)__builtin_amdgcn_kernarg_segment_ptr(); asm volatile("" : "+s"(p0));
    XcdBarrier xb; xb.bar = (unsigned*)(p0->ws + W_BAR); xb.x = xb_xcc_id(); xb.st = (volatile LAS unsigned*)(lds + LDS_TOTAL - 64);
    xcd_barrier(xb);
}
#ifndef WGM_OF
#define WGM_OF(N) ((N) == 2048 ? 8 : 4)
#endif
__device__ __forceinline__ void run_gemms(KPrm p, const Ctx cx, unsigned char* lds, const int first, const int last) {
#pragma unroll 1
    for (int ph = first; ph <= last; ++ph) {
        unsigned char* ws = p->ws;
        pg8::Gemm g; Epi E;
        g.A = (const u16*)(ws + W_H); g.Bt = nullptr; g.M = M; g.N = DM; g.K = DM;
        E.mode = 0; E.d0 = E.d1 = E.d2 = nullptr; E.t1 = E.t2 = 1 << 20; E.p0 = E.p1 = E.p2 = 0; E.f32seg2 = 0; E.vseg2 = 0; E.vout = p->out + O_VP; E.vslab = (u16*)p->out + (size_t)NBS * SKVS * DM;
        E.xp = p->in[I_XP]; E.xs = p->in[I_XS]; E.y = p->out; E.mod = (const float*)(ws + W_MOD); E.gbuf = (u16*)(ws + W_GM); E.gf = (const u16*)(ws + W_GF);
        switch (ph) {
        case PH_G1A: g.Bt = (const u16*)(ws + W_WIN); g.N = 41 * 256;
            E.d0 = (u16*)(ws + W_XBC); E.p0 = CD; E.t1 = 24; E.d1 = (u16*)(ws + W_Z); E.p1 = DI; E.t2 = 40; E.d2 = (u16*)(ws + W_SMALL); E.p2 = 256; E.f32seg2 = 1; break;
        case PH_G1B: g.Bt = (const u16*)(ws + W_WIN) + (size_t)10496 * DM; g.N = 16 * 256;
            E.d0 = (u16*)(ws + W_GM); E.p0 = DM; E.t1 = 8; E.d1 = (u16*)(ws + W_GF); E.p1 = DM; break;
        case PH_G2: g.A = (const u16*)(ws + W_Z); g.Bt = (const u16*)(ws + W_WPM); g.K = DI; E.mode = 1; break;
        case PH_G1C: g.Bt = (const u16*)(ws + W_WIN) + (size_t)14592 * DM; g.N = 24 * 256;
            E.d0 = (u16*)(ws + W_Q); E.p0 = DM; E.t1 = 8; E.d1 = (u16*)(ws + W_K); E.p1 = DM; E.t2 = 16; E.d2 = (u16*)(ws + W_V); E.p2 = DM; E.vseg2 = 1; break;
        case PH_G3: g.A = (const u16*)(ws + W_Q); g.Bt = (const u16*)(ws + W_WPF); E.mode = 2; break;
        case PH_G4: g.A = (const u16*)(ws + W_GM); g.Bt = (const u16*)(ws + W_WOUT); E.mode = 3; break;
        case PH_G5A: g.Bt = (const u16*)(ws + W_WUP); g.M = HALF_ROWS; g.N = DFF2; E.d0 = (u16*)(ws + W_U); E.p0 = DFF2; break;
        case PH_G5B: g.A = (const u16*)(ws + W_H) + (size_t)HALF_ROWS * DM; g.Bt = (const u16*)(ws + W_WUP); g.M = HALF_ROWS; g.N = DFF2; E.d0 = (u16*)(ws + W_U); E.p0 = DFF2; break;
        default:   g.A = (const u16*)(ws + W_G); g.Bt = (const u16*)(ws + W_WDN); g.K = DFF; E.mode = 5; break;
        }
        int tail = 0; if (ph == PH_G2 || ph == PH_G3 || ph == PH_G4 || ph == PH_G6 || ph == PH_G1B || ph == PH_G1C) { g.M = MP; tail = 4; }
        pg8::StaticOrder S; S.init(g.M, g.N, cx.G, cx.bid, tail, WGM_OF(g.N));
        pg8::gemm_phase<Epi, pg8::StaticOrder, true, true>((PG8_LAS unsigned char*)lds, g, S, E, cx.tid);
        if (ph < last) gsync(lds);
    }
}
#define PH_BEGIN() Ctx cx; { int t_ = threadIdx.x; asm volatile("" : "+v"(t_)); int b_ = blockIdx.x, g_ = gridDim.x; asm volatile("" : "+s"(b_), "+s"(g_)); cx.tid = t_; cx.bid = b_; cx.G = g_; } \
    KPrm p = (KPrm)__builtin_amdgcn_kernarg_segment_ptr(); asm volatile("" : "+s"(p))
#ifdef ONLY_PH
#define PH_ON(k) ((k) == ONLY_PH)
#else
#define PH_ON(k) true
#endif
__global__ void __launch_bounds__(512, 2) mega_fwd(Prm prm_unused) {
    extern __shared__ __attribute__((aligned(16))) unsigned char lds[];
    cg::grid_group grid = cg::this_grid();
    volatile LAS unsigned* bst = (volatile LAS unsigned*)(lds + LDS_TOTAL - 64);
    if (threadIdx.x < 2) bst[threadIdx.x] = 0u;
    __syncthreads();
    { KPrm p0 = (KPrm)__builtin_amdgcn_kernarg_segment_ptr(); (void)xcd_barrier_post((unsigned*)(p0->ws + W_BAR), bst); }
#define GSYNC() gsync(lds)
#ifndef EXP
#define EXP 0
#endif
    if (PH_ON(PH_PREP)) { PH_BEGIN(); phase_prep(p, cx, lds); } grid.sync();
#if EXP == 3
    { PH_BEGIN(); phase_prep(p, cx, lds); } GSYNC();
#endif
    if (PH_ON(PH_N1)) { PH_BEGIN(); phase_norm(p, cx, 0); } GSYNC();
    if (PH_ON(PH_G1A)) { PH_BEGIN(); run_gemms(p, cx, lds, PH_G1A, PH_G1A); } GSYNC();
#if EXP == 1
    { PH_BEGIN(); run_gemms(p, cx, lds, PH_G1A, PH_G1A); } GSYNC();
#endif
    if (PH_ON(PH_CONV)) { PH_BEGIN(); phase_conv(p, cx); } GSYNC();
    if (PH_ON(PH_SSD)) { PH_BEGIN(); phase_ssd(p, cx, lds); } GSYNC();
#if EXP == 2
    { PH_BEGIN(); run_gemms(p, cx, lds, PH_G1A, PH_G1A); } GSYNC();
    { PH_BEGIN(); phase_conv(p, cx); } GSYNC();
    { PH_BEGIN(); phase_ssd(p, cx, lds); } GSYNC();
#endif
    if (PH_ON(PH_GN)) { PH_BEGIN(); phase_gn(p, cx); }
    if (PH_ON(PH_G1B)) { PH_BEGIN(); run_gemms(p, cx, lds, PH_G1B, PH_G1C); } GSYNC();
    if (PH_ON(PH_QK)) { PH_BEGIN(); phase_qk(p, cx); } GSYNC();
    if (PH_ON(PH_ATT)) { PH_BEGIN(); phase_att(p, cx, (char*)lds); } GSYNC();
#if EXP == 4
    { PH_BEGIN(); run_gemms(p, cx, lds, PH_G1C, PH_G1C); } GSYNC();
    { PH_BEGIN(); phase_qk(p, cx); } GSYNC();
    { PH_BEGIN(); phase_att(p, cx, (char*)lds); } GSYNC();
#endif
    if (PH_ON(PH_G3)) { PH_BEGIN(); run_gemms(p, cx, lds, PH_G3, PH_G4); } GSYNC();
    if (PH_ON(PH_N2)) { PH_BEGIN(); phase_norm(p, cx, 1); } GSYNC();
    if (PH_ON(PH_G5A)) { PH_BEGIN(); run_gemms(p, cx, lds, PH_G5A, PH_G5A); } GSYNC();
    if (PH_ON(PH_CVA)) { PH_BEGIN(); phase_cv(p, cx, 0); } GSYNC();
    if (PH_ON(PH_G5B)) { PH_BEGIN(); run_gemms(p, cx, lds, PH_G5B, PH_G5B); } GSYNC();
    if (PH_ON(PH_CVB)) { PH_BEGIN(); phase_cv(p, cx, 1); } GSYNC();
    if (PH_ON(PH_G6)) { PH_BEGIN(); run_gemms(p, cx, lds, PH_G6, PH_G6); }
#if EXP == 5
#pragma unroll 1
    for (int r = 0; r < 32; ++r) GSYNC();
#endif
}

extern "C" void kernel_launch(void* const* d_in, const int* in_sizes, int n_in, void* d_out, int out_size, void* d_ws, size_t ws_size, hipStream_t stream) {
    static int grid = 0;
    if (grid == 0) {
        if (n_in != 31 || (size_t)out_size != O_END || ws_size < 1024 * MiB) { fprintf(stderr, "kernel_launch: unexpected sizes n_in %d out %d ws %zu\n", n_in, out_size, ws_size); }
        int dev = 0, cus = 0, per_cu = 0;
        hipGetDevice(&dev); hipDeviceGetAttribute(&cus, hipDeviceAttributeMultiprocessorCount, dev);
        hipFuncSetAttribute((const void*)mega_fwd, hipFuncAttributeMaxDynamicSharedMemorySize, LDS_TOTAL);
        hipOccupancyMaxActiveBlocksPerMultiprocessor(&per_cu, (const void*)mega_fwd, 512, LDS_TOTAL);
        (void)hipGetLastError();
        if (per_cu < 1) per_cu = 1;
        grid = cus;
    }
    (void)hipMemsetAsync((char*)d_ws + W_BAR, 0, 16384, stream);
    Prm prm{};
    for (int i = 0; i < 31; ++i) prm.in[i] = (const float*)d_in[i];
    prm.out = (float*)d_out; prm.ws = (unsigned char*)d_ws;
    void* args[] = {&prm};
    hipError_t e = hipLaunchCooperativeKernel((const void*)mega_fwd, dim3(grid), dim3(512), args, LDS_TOTAL, stream);
    if (e != hipSuccess) fprintf(stderr, "cooperative launch failed: %s (grid %d)\n", hipGetErrorString(e), grid);
}
```
